# Optimizing an MI355X kernel written in HIP

```python
import math
import jax, jax.numpy as jnp
from jax import lax
import numpy as np

D_MODEL = 1024
BATCH = 16
SEQ = 2048
DEPTH = 4

CHUNK = 64
DENSE_Q_BLOCK = 128
SPARSE_Q_BLOCK = 64

HA = 4
DA = 64
HB = 4
DB = 64
BAND_CHUNKS = 8
REL_CLIP = 128
HC = 4
DC = 64
HI = 8
DI = 32
TOPK_MAX = 256

N_ALIBI = HA + HC

COL_SIZES = (HA * 2 * DA, HA * 2 * DA, HA * 2 * DA,
             HB * DB, HB * DB, HB * DB,
             HC * DC, HC * DC, HC * DC,
             HI * DI, DI, HI)
SPLIT_POINTS = tuple(sum(COL_SIZES[:i + 1]) for i in range(len(COL_SIZES) - 1))
D_IN = sum(COL_SIZES)
D_MIX = HA * 2 * DA + HB * DB + HC * DC

N_EXPERTS = 32
TOP_K = 4
D_EXPERT = D_MODEL
SWIGLU_LIMIT = 7.0
SWIGLU_ALPHA = 1.702
EXPERT_BLOCK = 128

DEEPNORM_ALPHA = (2 * DEPTH) ** 0.25
DEEPNORM_BETA = (8 * DEPTH) ** -0.25
EPS = 1e-5
NEG_INF = -1e30

kernel_name = 'hybrid_chunk_causal_diffattn_band_dsa_moe_deepnorm'


def layer_norm(x, g, b):
    xf = x.astype(jnp.float32)
    mu = jnp.mean(xf, axis=-1, keepdims=True)
    var = jnp.mean(jnp.square(xf - mu), axis=-1, keepdims=True)
    return ((xf - mu) * lax.rsqrt(var + EPS) * g.astype(jnp.float32) + b.astype(jnp.float32)).astype(x.dtype)


def rms_norm(x, g):
    xf = x.astype(jnp.float32)
    ms = jnp.mean(jnp.square(xf), axis=-1, keepdims=True)
    return (xf * lax.rsqrt(ms + EPS) * g.astype(jnp.float32)).astype(x.dtype)


def alibi_slopes(n):
    return jnp.exp2(-8.0 * jnp.arange(1, n + 1, dtype=jnp.float32) / n)


def to_blocks(a, blk):
    b, s = a.shape[:2]
    return jnp.moveaxis(a.reshape((b, s // blk, blk) + a.shape[2:]), 1, 0)


def from_blocks(a):
    a = jnp.moveaxis(a, 0, 1)
    return a.reshape((a.shape[0], a.shape[1] * a.shape[2]) + a.shape[3:])


def diff_attention(q, k, v, lam, lam_init, sub_g, slopes):
    bsz, seq = q.shape[:2]
    pos = jnp.arange(seq)
    key_chunk = pos // CHUNK
    scale = DA ** -0.5
    k1, k2 = k[..., 0, :], k[..., 1, :]

    def block(args):
        qb, qpos = args
        s1 = jnp.einsum('bqhd,bshd->bhqs', qb[..., 0, :], k1).astype(jnp.float32) * scale
        s2 = jnp.einsum('bqhd,bshd->bhqs', qb[..., 1, :], k2).astype(jnp.float32) * scale
        dist = jnp.abs(qpos[:, None] - pos[None, :]).astype(jnp.float32)
        allowed = key_chunk[None, :] <= (qpos // CHUNK)[:, None]
        bias = jnp.where(allowed[None], -slopes[:, None, None] * dist[None], NEG_INF)
        p1 = jax.nn.softmax(s1 + bias, axis=-1)
        p2 = jax.nn.softmax(s2 + bias, axis=-1)
        a = (p1 - lam * p2).astype(v.dtype)
        return jnp.einsum('bhqs,bshe->bqhe', a, v)

    qpos_blocks = pos.reshape(-1, DENSE_Q_BLOCK)
    out = from_blocks(lax.map(block, (to_blocks(q, DENSE_Q_BLOCK), qpos_blocks)))
    out = rms_norm(out, sub_g) * (1.0 - lam_init)
    return out.reshape(bsz, seq, HA * 2 * DA)


def band_attention(q, k, v, rel_bias):
    bsz, seq = q.shape[:2]
    nc = seq // CHUNK
    pad = BAND_CHUNKS * CHUNK
    band = (BAND_CHUNKS + 1) * CHUNK
    scale = DB ** -0.5

    def gather_band(a):
        ap = jnp.pad(a, ((0, 0), (pad, 0), (0, 0), (0, 0)))
        ac = ap.reshape(bsz, nc + BAND_CHUNKS, CHUNK, HB, DB)
        return jnp.concatenate([ac[:, j:j + nc] for j in range(BAND_CHUNKS + 1)], axis=2)

    kb, vb = gather_band(k), gather_band(v)
    qc = q.reshape(bsz, nc, CHUNK, HB, DB)
    s = jnp.einsum('bcqhd,bckhd->bhcqk', qc, kb).astype(jnp.float32) * scale
    i = jnp.arange(CHUNK)
    j = jnp.arange(band)
    rel = pad + i[:, None] - j[None, :]
    bias = rel_bias.astype(jnp.float32)[:, jnp.clip(rel, -REL_CLIP, REL_CLIP) + REL_CLIP]
    key_pos = (jnp.arange(nc)[:, None] - BAND_CHUNKS) * CHUNK + j[None, :]
    valid = key_pos >= 0
    s = jnp.where(valid[None, None, :, None, :], s + bias[None, :, None], NEG_INF)
    p = jax.nn.softmax(s, axis=-1).astype(v.dtype)
    out = jnp.einsum('bhcqk,bckhd->bcqhd', p, vb)
    return out.reshape(bsz, seq, HB * DB)


def dsa_attention(q, k, v, q_idx, k_idx, w_idx, slopes):
    bsz, seq = q.shape[:2]
    n_sel = min(TOPK_MAX, seq // 4)
    pos = jnp.arange(seq)
    key_chunk = pos // CHUNK
    scale = DC ** -0.5
    w_scale = (HI ** -0.5) * (DI ** -0.5)
    gather_rows = jax.vmap(lambda a, idx: a[idx])

    def block(args):
        qb, qib, wb, qpos = args
        q_chunk = qpos // CHUNK
        rel = jax.nn.relu(jnp.einsum('bqhd,bsd->bqhs', qib, k_idx).astype(jnp.float32))
        score = jnp.einsum('bqh,bqhs->bqs', wb.astype(jnp.float32) * w_scale, rel)
        allowed = key_chunk[None, :] <= q_chunk[:, None]
        score = jnp.where(allowed[None], score, NEG_INF)
        _, idx = lax.top_k(score, n_sel)
        ks = gather_rows(k, idx)
        vs = gather_rows(v, idx)
        s = jnp.einsum('bqhd,bqkhd->bhqk', qb, ks).astype(jnp.float32) * scale
        dist = jnp.abs(qpos[None, :, None] - idx).astype(jnp.float32)
        valid = (idx // CHUNK) <= q_chunk[None, :, None]
        s = jnp.where(valid[:, None], s - slopes[None, :, None, None] * dist[:, None], NEG_INF)
        p = jax.nn.softmax(s, axis=-1).astype(v.dtype)
        return jnp.einsum('bhqk,bqkhd->bqhd', p, vs)

    qpos_blocks = pos.reshape(-1, SPARSE_Q_BLOCK)
    out = lax.map(block, (to_blocks(q, SPARSE_Q_BLOCK), to_blocks(q_idx, SPARSE_Q_BLOCK),
                          to_blocks(w_idx, SPARSE_Q_BLOCK), qpos_blocks))
    return from_blocks(out).reshape(bsz, seq, HC * DC)


def moe_ffn(x, w_router, b_router, w_gu, b_gu, w_down, b_down):
    bsz, seq, d = x.shape
    n_tok = bsz * seq
    xf = x.reshape(n_tok, d)
    logits = (xf @ w_router).astype(jnp.float32) + b_router.astype(jnp.float32)
    top_val, top_e = lax.top_k(logits, TOP_K)
    gates = jax.nn.softmax(top_val, axis=-1)
    e_flat = top_e.reshape(-1)
    n_asg = n_tok * TOP_K
    order = jnp.argsort(e_flat)
    e_sorted = e_flat[order]
    counts = jnp.bincount(e_flat, length=N_EXPERTS)
    padded = (counts + EXPERT_BLOCK - 1) // EXPERT_BLOCK * EXPERT_BLOCK
    start = jnp.cumsum(counts) - counts
    pend = jnp.cumsum(padded)
    pstart = pend - padded
    rank = jnp.arange(n_asg, dtype=jnp.int32) - start[e_sorted]
    dest = jnp.zeros((n_asg,), jnp.int32).at[order].set(pstart[e_sorted] + rank)
    n_rows = n_asg + N_EXPERTS * EXPERT_BLOCK
    n_blocks = n_rows // EXPERT_BLOCK
    row_token = jnp.full((n_rows,), n_tok, jnp.int32).at[dest].set(
        jnp.arange(n_asg, dtype=jnp.int32) // TOP_K)
    x_pad = jnp.concatenate([xf, jnp.zeros((1, d), xf.dtype)], axis=0)
    x_rows = x_pad[row_token].reshape(n_blocks, EXPERT_BLOCK, d)
    block_expert = jnp.minimum(
        jnp.searchsorted(pend, jnp.arange(n_blocks) * EXPERT_BLOCK, side='right'), N_EXPERTS - 1)

    def expert_block(args):
        xb, e = args
        h = xb @ w_gu[e] + b_gu[e]
        gate = jnp.minimum(h[:, :D_EXPERT], SWIGLU_LIMIT)
        up = jnp.clip(h[:, D_EXPERT:], -SWIGLU_LIMIT, SWIGLU_LIMIT)
        glu = gate * jax.nn.sigmoid(SWIGLU_ALPHA * gate)
        return ((up + 1.0) * glu) @ w_down[e] + b_down[e]

    y_rows = lax.map(expert_block, (x_rows, block_expert)).reshape(n_rows, d)
    y = y_rows[dest].reshape(n_tok, TOP_K, d)
    out = jnp.einsum('tk,tkd->td', gates.astype(y.dtype), y)
    return out.reshape(bsz, seq, d)


def setup_inputs(seed: int = 0) -> dict:
    key = jax.random.key(seed)
    ks = jax.random.split(key, 19)
    f32 = jnp.float32

    def nrm(k, shape, scale):
        return jax.random.normal(k, shape, f32) * scale

    col_scale = np.ones((D_IN,), np.float32)
    for part in (2, 5, 8):
        col_scale[SPLIT_POINTS[part - 1]:SPLIT_POINTS[part]] = DEEPNORM_BETA

    x = nrm(ks[0], (BATCH, SEQ, D_MODEL), 1.0)
    w_in = nrm(ks[1], (DEPTH, D_MODEL, D_IN), D_MODEL ** -0.5) * jnp.asarray(col_scale)
    lam_q1 = nrm(ks[2], (DEPTH, DA), 0.1)
    lam_k1 = nrm(ks[3], (DEPTH, DA), 0.1)
    lam_q2 = nrm(ks[4], (DEPTH, DA), 0.1)
    lam_k2 = nrm(ks[5], (DEPTH, DA), 0.1)
    subln_g = 1.0 + nrm(ks[6], (DEPTH, 2 * DA), 0.02)
    rel_bias = nrm(ks[7], (DEPTH, HB, 2 * REL_CLIP + 1), 0.2)
    w_out = nrm(ks[8], (DEPTH, D_MIX, D_MODEL), D_MIX ** -0.5 * DEEPNORM_BETA)
    ln1_g = 1.0 + nrm(ks[9], (DEPTH, D_MODEL), 0.02)
    ln1_b = nrm(ks[10], (DEPTH, D_MODEL), 0.02)
    w_router = nrm(ks[11], (DEPTH, D_MODEL, N_EXPERTS), D_MODEL ** -0.5)
    b_router = nrm(ks[12], (DEPTH, N_EXPERTS), 0.01)
    w_gu = nrm(ks[13], (DEPTH, N_EXPERTS, D_MODEL, 2 * D_EXPERT), D_MODEL ** -0.5)
    b_gu = nrm(ks[14], (DEPTH, N_EXPERTS, 2 * D_EXPERT), 0.02)
    w_down = nrm(ks[15], (DEPTH, N_EXPERTS, D_EXPERT, D_MODEL), D_EXPERT ** -0.5 * DEEPNORM_BETA)
    b_down = nrm(ks[16], (DEPTH, N_EXPERTS, D_MODEL), 0.02)
    ln2_g = 1.0 + nrm(ks[17], (DEPTH, D_MODEL), 0.02)
    ln2_b = nrm(ks[18], (DEPTH, D_MODEL), 0.02)
    return {'x': x, 'w_in': w_in, 'lam_q1': lam_q1, 'lam_k1': lam_k1, 'lam_q2': lam_q2,
            'lam_k2': lam_k2, 'subln_g': subln_g, 'rel_bias': rel_bias, 'w_out': w_out,
            'ln1_g': ln1_g, 'ln1_b': ln1_b, 'w_router': w_router, 'b_router': b_router,
            'w_gu': w_gu, 'b_gu': b_gu, 'w_down': w_down, 'b_down': b_down,
            'ln2_g': ln2_g, 'ln2_b': ln2_b}


def reference(x, w_in, lam_q1, lam_k1, lam_q2, lam_k2, subln_g, rel_bias, w_out,
              ln1_g, ln1_b, w_router, b_router, w_gu, b_gu, w_down, b_down, ln2_g, ln2_b):
    bsz, seq, _ = x.shape
    slopes = alibi_slopes(N_ALIBI)
    slopes_a, slopes_c = slopes[0::2], slopes[1::2]
    for l in range(DEPTH):
        h = x @ w_in[l]
        qa, ka, va, qb, kb, vb, qc, kc, vc, qi, ki, wi = jnp.split(h, SPLIT_POINTS, axis=-1)
        lam_init = 0.8 - 0.6 * math.exp(-0.3 * l)
        lam = (jnp.exp(jnp.sum(lam_q1[l].astype(jnp.float32) * lam_k1[l].astype(jnp.float32)))
               - jnp.exp(jnp.sum(lam_q2[l].astype(jnp.float32) * lam_k2[l].astype(jnp.float32)))
               + lam_init)
        out_a = diff_attention(qa.reshape(bsz, seq, HA, 2, DA), ka.reshape(bsz, seq, HA, 2, DA),
                               va.reshape(bsz, seq, HA, 2 * DA), lam, lam_init, subln_g[l], slopes_a)
        out_b = band_attention(qb.reshape(bsz, seq, HB, DB), kb.reshape(bsz, seq, HB, DB),
                               vb.reshape(bsz, seq, HB, DB), rel_bias[l])
        out_c = dsa_attention(qc.reshape(bsz, seq, HC, DC), kc.reshape(bsz, seq, HC, DC),
                              vc.reshape(bsz, seq, HC, DC), qi.reshape(bsz, seq, HI, DI), ki, wi, slopes_c)
        mix = jnp.concatenate([out_a, out_b, out_c], axis=-1)
        x = layer_norm(DEEPNORM_ALPHA * x + mix @ w_out[l], ln1_g[l], ln1_b[l])
        ffn = moe_ffn(x, w_router[l], b_router[l], w_gu[l], b_gu[l], w_down[l], b_down[l])
        x = layer_norm(DEEPNORM_ALPHA * x + ffn, ln2_g[l], ln2_b[l])
    return x
```

```cpp
#include <hip/hip_runtime.h>
#include <stdint.h>

constexpr int D = 1024, BATCH = 16, SEQ = 2048, T = BATCH * SEQ, DEPTH = 4;
constexpr int DIN = 3368;
constexpr int NE = 32, TOPK = 4;
constexpr int OFF_QA = 0, OFF_KA = 512, OFF_VA = 1024, OFF_QB = 1536, OFF_KB = 1792, OFF_VB = 2048,
              OFF_QC = 2304, OFF_KC = 2560, OFF_VC = 2816, OFF_QI = 3072, OFF_KI = 3328, OFF_WI = 3360;
constexpr int NASG = T * TOPK;
constexpr int EB = 128;
constexpr int NROWS = NASG + NE * EB;
constexpr int NTILES = NROWS / EB;
constexpr float ALPHA = 1.681792830507429f;
constexpr float EPS = 1e-5f;

__device__ __forceinline__ float wave_sum(float v) { for (int o = 32; o > 0; o >>= 1) v += __shfl_xor(v, o); return v; }
__device__ __forceinline__ float wave_max(float v) { for (int o = 32; o > 0; o >>= 1) v = fmaxf(v, __shfl_xor(v, o)); return v; }
__device__ __forceinline__ int wave_sum_i(int v) { for (int o = 32; o > 0; o >>= 1) v += __shfl_xor(v, o); return v; }

struct GemmArgs {
    const float* A; int lda; const int* arow;
    const float* B; int ldb; long strideB;
    float* C; int ldc;
    const float* bias; long strideBias;
    const float* R; int ldr;
    const int* tile_e;
    int M, N, K;
};
template <int EPI>
__global__ __launch_bounds__(256) void k_gemm(GemmArgs g) {
    __shared__ float As[16][132];
    __shared__ float Bs[16][132];
    const int tid = threadIdx.x, tx = tid & 15, ty = tid >> 4;
    const int row0 = blockIdx.y * 128, col0 = blockIdx.x * 128;
    const float* B = g.B; const float* bias = g.bias;
    if (g.tile_e) { const int e = g.tile_e[blockIdx.y]; if (e < 0) return; B += (long)e * g.strideB; if (bias) bias += (long)e * g.strideBias; }
    float acc[8][8];
#pragma unroll
    for (int i = 0; i < 8; ++i)
#pragma unroll
        for (int j = 0; j < 8; ++j) acc[i][j] = 0.f;
    const int ar = tid >> 1, ak = (tid & 1) * 8;
    long asrc = row0 + ar;
    if (g.arow) asrc = g.arow[row0 + ar];
    const float* ap = (asrc >= 0) ? g.A + asrc * (long)g.lda + ak : nullptr;
    const int bk = tid >> 4, bc = (tid & 15) * 8;
    const bool bok = (col0 + bc) < g.N;
    const float* bp = B + (long)bk * g.ldb + col0 + bc;
    for (int k0 = 0; k0 < g.K; k0 += 16) {
        float4 a0 = make_float4(0, 0, 0, 0), a1 = a0, b0 = a0, b1 = a0;
        if (ap) { a0 = *(const float4*)(ap + k0); a1 = *(const float4*)(ap + k0 + 4); }
        if (bok) { b0 = *(const float4*)(bp + (long)k0 * g.ldb); b1 = *(const float4*)(bp + (long)k0 * g.ldb + 4); }
        __syncthreads();
        As[ak + 0][ar] = a0.x; As[ak + 1][ar] = a0.y; As[ak + 2][ar] = a0.z; As[ak + 3][ar] = a0.w;
        As[ak + 4][ar] = a1.x; As[ak + 5][ar] = a1.y; As[ak + 6][ar] = a1.z; As[ak + 7][ar] = a1.w;
        *(float4*)&Bs[bk][bc] = b0; *(float4*)&Bs[bk][bc + 4] = b1;
        __syncthreads();
#pragma unroll
        for (int kk = 0; kk < 16; ++kk) {
            float a[8], b[8];
            *(float4*)&a[0] = *(const float4*)&As[kk][ty * 8]; *(float4*)&a[4] = *(const float4*)&As[kk][ty * 8 + 4];
            *(float4*)&b[0] = *(const float4*)&Bs[kk][tx * 8]; *(float4*)&b[4] = *(const float4*)&Bs[kk][tx * 8 + 4];
#pragma unroll
            for (int i = 0; i < 8; ++i)
#pragma unroll
                for (int j = 0; j < 8; ++j) acc[i][j] = fmaf(a[i], b[j], acc[i][j]);
        }
    }
    const int c0 = col0 + tx * 8;
    if (c0 >= g.N) return;
#pragma unroll
    for (int i = 0; i < 8; ++i) {
        const long r = row0 + ty * 8 + i;
        float o[8];
#pragma unroll
        for (int j = 0; j < 8; ++j) {
            float v = acc[i][j];
            if (EPI == 1) v += bias[c0 + j];
            if (EPI == 2) v += ALPHA * g.R[r * g.ldr + c0 + j];
            o[j] = v;
        }
        *(float4*)(g.C + r * g.ldc + c0) = *(float4*)&o[0];
        *(float4*)(g.C + r * g.ldc + c0 + 4) = *(float4*)&o[4];
    }
}

__global__ __launch_bounds__(256) void k_attnB(const float* __restrict__ h, float* __restrict__ mix, const float* __restrict__ relb) {
    __shared__ float sc[4][576];
    const int w = threadIdx.x >> 6, lane = threadIdx.x & 63;
    const int qid = blockIdx.x * 4 + w;
    const int t = qid % SEQ, hh = (qid / SEQ) % 4, b = qid / (SEQ * 4);
    const float* hb = h + (size_t)b * SEQ * DIN;
    const float4* qp = (const float4*)(hb + (size_t)t * DIN + OFF_QB + hh * 64);
    float q[64];
#pragma unroll
    for (int i = 0; i < 16; ++i) { float4 v = qp[i]; q[4 * i] = v.x; q[4 * i + 1] = v.y; q[4 * i + 2] = v.z; q[4 * i + 3] = v.w; }
    const int c = t >> 6;
    const int s0 = (c - 8) * 64 < 0 ? 0 : (c - 8) * 64, s1 = (c + 1) * 64;
    float m = -3e38f;
    for (int s = s0 + lane; s < s1; s += 64) {
        const float4* kp = (const float4*)(hb + (size_t)s * DIN + OFF_KB + hh * 64);
        float d = 0.f;
#pragma unroll
        for (int i = 0; i < 16; ++i) { float4 kv = kp[i]; d += q[4 * i] * kv.x + q[4 * i + 1] * kv.y + q[4 * i + 2] * kv.z + q[4 * i + 3] * kv.w; }
        int rel = t - s; rel = rel < -128 ? -128 : (rel > 128 ? 128 : rel);
        const float sv = d * 0.125f + relb[hh * 257 + rel + 128];
        sc[w][s - s0] = sv; m = fmaxf(m, sv);
    }
    m = wave_max(m);
    float l = 0.f;
    for (int s = s0 + lane; s < s1; s += 64) { const float p = __expf(sc[w][s - s0] - m); sc[w][s - s0] = p; l += p; }
    l = wave_sum(l);
    __syncthreads();
    const float cinv = 1.0f / l;
    float a0 = 0.f;
    const float* vp = hb + OFF_VB + hh * 64 + lane;
#pragma unroll 4
    for (int s = s0; s < s1; ++s) a0 = fmaf(sc[w][s - s0], vp[(size_t)s * DIN], a0);
    mix[(size_t)(b * SEQ + t) * 1024 + 512 + hh * 64 + lane] = a0 * cinv;
}

__device__ __forceinline__ unsigned f2key(float f) { unsigned u = __float_as_uint(f); return (u & 0x80000000u) ? ~u : (u | 0x80000000u); }
__global__ __launch_bounds__(256) void k_index(const float* __restrict__ h, unsigned long long* __restrict__ masks) {
    __shared__ unsigned keys[4][2048];
    __shared__ float qs[4][256];
    const int w = threadIdx.x >> 6, lane = threadIdx.x & 63;
    const int qid = blockIdx.x * 4 + w;
    const int t = qid % SEQ, b = qid / SEQ;
    const float* hb = h + (size_t)b * SEQ * DIN;
    const float* hp = hb + (size_t)t * DIN;
    unsigned long long* mo = masks + (size_t)(b * SEQ + t) * 32;
    const int nk = ((t >> 6) + 1) * 64;
    if (nk <= 256) {
        if (lane < 32) mo[lane] = (lane < (nk >> 6)) ? ~0ull : 0ull;
        return;
    }
    *(float4*)&qs[w][lane * 4] = *(const float4*)(hp + OFF_QI + lane * 4);
    __builtin_amdgcn_wave_barrier();
    float ws[8];
#pragma unroll
    for (int i = 0; i < 8; ++i) ws[i] = hp[OFF_WI + i] * 0.0625f;
#pragma unroll 1
    for (int s = lane; s < nk; s += 64) {
        asm volatile("" ::: "memory");
        const float4* kp = (const float4*)(hb + (size_t)s * DIN + OFF_KI);
        float ki[32];
#pragma unroll
        for (int i = 0; i < 8; ++i) { float4 v = kp[i]; ki[4 * i] = v.x; ki[4 * i + 1] = v.y; ki[4 * i + 2] = v.z; ki[4 * i + 3] = v.w; }
        float acc = 0.f;
#pragma unroll
        for (int hh = 0; hh < 8; ++hh) {
            float d = 0.f;
#pragma unroll
            for (int i = 0; i < 8; ++i) { const float4 qv = *(const float4*)&qs[w][hh * 32 + i * 4]; d += qv.x * ki[4 * i] + qv.y * ki[4 * i + 1] + qv.z * ki[4 * i + 2] + qv.w * ki[4 * i + 3]; }
            acc += ws[hh] * fmaxf(d, 0.f);
        }
        acc += 0.0f;
        keys[w][s] = f2key(acc);
    }
    __builtin_amdgcn_wave_barrier();
    const int nb = nk >> 6;
    unsigned prefix = 0u;
#pragma unroll 1
    for (int bit = 31; bit >= 0; --bit) {
        const unsigned cand = prefix | (1u << bit);
        int c = 0;
#pragma unroll 1
        for (int i = 0; i < nb; ++i) c += (keys[w][i * 64 + lane] >= cand) ? 1 : 0;
        c = wave_sum_i(c);
        if (c >= 256) prefix = cand;
    }
    const unsigned thr = prefix;
    int cg = 0;
#pragma unroll 1
    for (int i = 0; i < nb; ++i) cg += (keys[w][i * 64 + lane] > thr) ? 1 : 0;
    cg = wave_sum_i(cg);
    const int quota = 256 - cg;
    int taken = 0;
#pragma unroll 1
    for (int i = 0; i < 32; ++i) {
        unsigned long long m = 0ull;
        if (i < nb) {
            const unsigned k = keys[w][i * 64 + lane];
            const bool eq = (k == thr);
            const unsigned long long eqm = __ballot(eq);
            const int before = __popcll(eqm & ((1ull << lane) - 1ull));
            const bool sel = (k > thr) || (eq && (taken + before < quota));
            m = __ballot(sel);
            taken += __popcll(eqm);
        }
        if (lane == 0) mo[i] = m;
    }
}

__global__ __launch_bounds__(256) void k_attnC(const float* __restrict__ h, float* __restrict__ mix, const unsigned long long* __restrict__ masks) {
    __shared__ float sc[4][2048];
    const int w = threadIdx.x >> 6, lane = threadIdx.x & 63;
    const int qid = blockIdx.x * 4 + w;
    const int t = qid % SEQ, hh = (qid / SEQ) % 4, b = qid / (SEQ * 4);
    const float* hb = h + (size_t)b * SEQ * DIN;
    const float4* qp = (const float4*)(hb + (size_t)t * DIN + OFF_QC + hh * 64);
    const unsigned long long* mo = masks + (size_t)(b * SEQ + t) * 32;
    float q[64];
#pragma unroll
    for (int i = 0; i < 16; ++i) { float4 v = qp[i]; q[4 * i] = v.x; q[4 * i + 1] = v.y; q[4 * i + 2] = v.z; q[4 * i + 3] = v.w; }
    const int nk = ((t >> 6) + 1) * 64;
    const float slope = exp2f(-(float)(2 * hh + 2));
    float m = -3e38f;
    for (int s = lane; s < nk; s += 64) {
        const bool sel = (mo[s >> 6] >> lane) & 1ull;
        float sv = -3e38f;
        if (sel) {
            const float4* kp = (const float4*)(hb + (size_t)s * DIN + OFF_KC + hh * 64);
            float d = 0.f;
#pragma unroll
            for (int i = 0; i < 16; ++i) { float4 kv = kp[i]; d += q[4 * i] * kv.x + q[4 * i + 1] * kv.y + q[4 * i + 2] * kv.z + q[4 * i + 3] * kv.w; }
            sv = d * 0.125f - slope * fabsf((float)(t - s));
        }
        sc[w][s] = sv; m = fmaxf(m, sv);
    }
    m = wave_max(m);
    float l = 0.f;
    for (int s = lane; s < nk; s += 64) { const float sv = sc[w][s]; const float p = (sv > -1e38f) ? __expf(sv - m) : 0.f; sc[w][s] = p; l += p; }
    l = wave_sum(l);
    __syncthreads();
    const float cinv = 1.0f / l;
    float a0 = 0.f;
    const float* vp = hb + OFF_VC + hh * 64 + lane;
#pragma unroll 4
    for (int s = 0; s < nk; ++s) a0 = fmaf(sc[w][s], vp[(size_t)s * DIN], a0);
    mix[(size_t)(b * SEQ + t) * 1024 + 768 + hh * 64 + lane] = a0 * cinv;
}

__global__ __launch_bounds__(256) void k_ln_router(const float* __restrict__ y1, float* __restrict__ x1, const float* __restrict__ g1, const float* __restrict__ b1,
                                                   const float* __restrict__ wr, const float* __restrict__ br, int* __restrict__ cnt,
                                                   int* __restrict__ top_e, float* __restrict__ gates, int* __restrict__ slots) {
    const int w = threadIdx.x >> 6, lane = threadIdx.x & 63;
    const int t = blockIdx.x * 4 + w;
    float v[16];
#pragma unroll
    for (int i = 0; i < 4; ++i) { const float4 u = *(const float4*)(y1 + (size_t)t * D + i * 256 + lane * 4); v[4 * i] = u.x; v[4 * i + 1] = u.y; v[4 * i + 2] = u.z; v[4 * i + 3] = u.w; }
    float s = 0.f;
#pragma unroll
    for (int i = 0; i < 16; ++i) s += v[i];
    const float mean = wave_sum(s) * (1.0f / 1024.0f);
    float qv = 0.f;
#pragma unroll
    for (int i = 0; i < 16; ++i) { const float d = v[i] - mean; qv += d * d; }
    const float rstd = rsqrtf(wave_sum(qv) * (1.0f / 1024.0f) + EPS);
    float part[32];
#pragma unroll
    for (int e = 0; e < 32; ++e) part[e] = 0.f;
#pragma unroll
    for (int i = 0; i < 4; ++i) {
        const int c0 = i * 256 + lane * 4;
        const float4 gg = *(const float4*)(g1 + c0), bb = *(const float4*)(b1 + c0);
        float o[4];
        o[0] = (v[4 * i] - mean) * rstd * gg.x + bb.x; o[1] = (v[4 * i + 1] - mean) * rstd * gg.y + bb.y;
        o[2] = (v[4 * i + 2] - mean) * rstd * gg.z + bb.z; o[3] = (v[4 * i + 3] - mean) * rstd * gg.w + bb.w;
        *(float4*)(x1 + (size_t)t * D + c0) = make_float4(o[0], o[1], o[2], o[3]);
#pragma unroll
        for (int j = 0; j < 4; ++j) {
            const float4* wp = (const float4*)(wr + (size_t)(c0 + j) * 32);
#pragma unroll
            for (int e4 = 0; e4 < 8; ++e4) { const float4 wv = wp[e4]; part[4 * e4] = fmaf(o[j], wv.x, part[4 * e4]); part[4 * e4 + 1] = fmaf(o[j], wv.y, part[4 * e4 + 1]);
                part[4 * e4 + 2] = fmaf(o[j], wv.z, part[4 * e4 + 2]); part[4 * e4 + 3] = fmaf(o[j], wv.w, part[4 * e4 + 3]); }
        }
    }
#pragma unroll
    for (int e = 0; e < 32; ++e) part[e] = wave_sum(part[e]) + br[e];
    int be[4]; float bv[4];
#pragma unroll
    for (int k = 0; k < 4; ++k) {
        float best = -3e38f; int bi = 0;
#pragma unroll
        for (int e = 0; e < 32; ++e) if (part[e] > best) { best = part[e]; bi = e; }
#pragma unroll
        for (int e = 0; e < 32; ++e) if (e == bi) part[e] = -3e38f;
        be[k] = bi; bv[k] = best;
    }
    float ex[4], es = 0.f;
#pragma unroll
    for (int k = 0; k < 4; ++k) { ex[k] = __expf(bv[k] - bv[0]); es += ex[k]; }
    if (lane == 0) {
#pragma unroll
        for (int k = 0; k < 4; ++k) {
            const int sl = atomicAdd(&cnt[be[k]], 1);
            top_e[t * 4 + k] = be[k]; gates[t * 4 + k] = ex[k] / es; slots[t * 4 + k] = sl;
        }
    }
}

__global__ void k_offsets(const int* __restrict__ cnt, int* __restrict__ pstart, int* __restrict__ tile_e) {
    __shared__ int ps[33];
    if (threadIdx.x == 0) { int a = 0; for (int e = 0; e < NE; ++e) { ps[e] = a; a += (cnt[e] + EB - 1) / EB * EB; } ps[32] = a; }
    __syncthreads();
    if (threadIdx.x < NE) pstart[threadIdx.x] = ps[threadIdx.x];
    for (int tl = threadIdx.x; tl < NTILES; tl += blockDim.x) {
        const int r = tl * EB; int e = -1;
        for (int k = 0; k < NE; ++k) if (r >= ps[k] && r < ps[k + 1]) e = k;
        tile_e[tl] = e;
    }
}
__global__ void k_scatter(const int* __restrict__ top_e, const int* __restrict__ slots, const int* __restrict__ pstart, int* __restrict__ row_token, int* __restrict__ dest) {
    const int i = blockIdx.x * blockDim.x + threadIdx.x;
    if (i >= NASG) return;
    const int row = pstart[top_e[i]] + slots[i];
    row_token[row] = i >> 2; dest[i] = row;
}
__global__ void k_swiglu(const float* __restrict__ hgu, float* __restrict__ act, const int* __restrict__ tile_e) {
    const int row = blockIdx.x;
    if (tile_e[row / EB] < 0) return;
    const float* hp = hgu + (size_t)row * 2048;
    for (int j = threadIdx.x; j < 1024; j += blockDim.x) {
        const float gate = fminf(hp[j], 7.0f);
        const float up = fminf(fmaxf(hp[1024 + j], -7.0f), 7.0f);
        const float glu = gate / (1.0f + __expf(-1.702f * gate));
        act[(size_t)row * 1024 + j] = (up + 1.0f) * glu;
    }
}
__global__ __launch_bounds__(256) void k_combine_ln2(const float* __restrict__ x1, const float* __restrict__ yrows, const int* __restrict__ dest, const float* __restrict__ gates,
                                                     const float* __restrict__ g2, const float* __restrict__ b2, float* __restrict__ out) {
    const int w = threadIdx.x >> 6, lane = threadIdx.x & 63;
    const int t = blockIdx.x * 4 + w;
    float v[16];
#pragma unroll
    for (int i = 0; i < 4; ++i) { const float4 u = *(const float4*)(x1 + (size_t)t * D + i * 256 + lane * 4); v[4 * i] = ALPHA * u.x; v[4 * i + 1] = ALPHA * u.y; v[4 * i + 2] = ALPHA * u.z; v[4 * i + 3] = ALPHA * u.w; }
    float f[16];
#pragma unroll
    for (int i = 0; i < 16; ++i) f[i] = 0.f;
#pragma unroll
    for (int k = 0; k < 4; ++k) {
        const float gk = gates[t * 4 + k]; const float* yp = yrows + (size_t)dest[t * 4 + k] * D;
#pragma unroll
        for (int i = 0; i < 4; ++i) { const float4 u = *(const float4*)(yp + i * 256 + lane * 4); f[4 * i] += gk * u.x; f[4 * i + 1] += gk * u.y; f[4 * i + 2] += gk * u.z; f[4 * i + 3] += gk * u.w; }
    }
    float s = 0.f;
#pragma unroll
    for (int i = 0; i < 16; ++i) { v[i] += f[i]; s += v[i]; }
    const float mean = wave_sum(s) * (1.0f / 1024.0f);
    float qv = 0.f;
#pragma unroll
    for (int i = 0; i < 16; ++i) { const float d = v[i] - mean; qv += d * d; }
    const float rstd = rsqrtf(wave_sum(qv) * (1.0f / 1024.0f) + EPS);
#pragma unroll
    for (int i = 0; i < 4; ++i) {
        const int c0 = i * 256 + lane * 4;
        const float4 gg = *(const float4*)(g2 + c0), bb = *(const float4*)(b2 + c0);
        *(float4*)(out + (size_t)t * D + c0) = make_float4((v[4 * i] - mean) * rstd * gg.x + bb.x, (v[4 * i + 1] - mean) * rstd * gg.y + bb.y,
                                                           (v[4 * i + 2] - mean) * rstd * gg.z + bb.z, (v[4 * i + 3] - mean) * rstd * gg.w + bb.w);
    }
}
__global__ void k_lam(const float* q1, const float* k1, const float* q2, const float* k2, float* lam_out) {
    const int l = blockIdx.x, lane = threadIdx.x;
    const float a = wave_sum(q1[l * 64 + lane] * k1[l * 64 + lane]), b = wave_sum(q2[l * 64 + lane] * k2[l * 64 + lane]);
    const float lam_init = 0.8f - 0.6f * expf(-0.3f * (float)l);
    if (lane == 0) lam_out[l] = expf(a) - expf(b) + lam_init;
}
__global__ __launch_bounds__(256) void k_attnA_l(const float* __restrict__ h, float* __restrict__ mix, const float* __restrict__ subg, const float* __restrict__ lamp, float lam_init);

extern "C" void kernel_launch(void* const* d_in, const int* in_sizes, int n_in, void* d_out, int out_size, void* d_ws, size_t ws_size, hipStream_t stream) {
    const float* x_in = (const float*)d_in[0];
    const float* w_in = (const float*)d_in[1];
    const float* lam_q1 = (const float*)d_in[2]; const float* lam_k1 = (const float*)d_in[3];
    const float* lam_q2 = (const float*)d_in[4]; const float* lam_k2 = (const float*)d_in[5];
    const float* subln_g = (const float*)d_in[6];
    const float* rel_bias = (const float*)d_in[7];
    const float* w_out = (const float*)d_in[8];
    const float* ln1_g = (const float*)d_in[9]; const float* ln1_b = (const float*)d_in[10];
    const float* w_router = (const float*)d_in[11]; const float* b_router = (const float*)d_in[12];
    const float* w_gu = (const float*)d_in[13]; const float* b_gu = (const float*)d_in[14];
    const float* w_down = (const float*)d_in[15]; const float* b_down = (const float*)d_in[16];
    const float* ln2_g = (const float*)d_in[17]; const float* ln2_b = (const float*)d_in[18];
    float* out = (float*)d_out;

    char* ws = (char*)d_ws; size_t off = 0;
    auto take = [&](size_t bytes) { char* p = ws + off; off += (bytes + 255) & ~(size_t)255; return p; };
    float* xcur = (float*)take((size_t)T * D * 4);
    float* hbuf = (float*)take((size_t)T * DIN * 4);
    float* mix = (float*)take((size_t)T * D * 4);
    float* y1 = (float*)take((size_t)T * D * 4);
    float* x1 = (float*)take((size_t)T * D * 4);
    float* hgu = (float*)take((size_t)NROWS * 2048 * 4);
    float* act = (float*)take((size_t)NROWS * 1024 * 4);
    float* yrows = hgu;
    unsigned long long* masks = (unsigned long long*)take((size_t)T * 32 * 8);
    int* cnt = (int*)take(DEPTH * NE * 4);
    int* pstart = (int*)take(NE * 4);
    int* tile_e = (int*)take(NTILES * 4);
    int* top_e = (int*)take(NASG * 4);
    float* gates = (float*)take(NASG * 4);
    int* slots = (int*)take(NASG * 4);
    int* dest = (int*)take(NASG * 4);
    int* row_token = (int*)take(NROWS * 4);
    float* lamv = (float*)take(256);

    hipMemsetAsync(cnt, 0, DEPTH * NE * 4, stream);
    k_lam<<<DEPTH, 64, 0, stream>>>(lam_q1, lam_k1, lam_q2, lam_k2, lamv);

    for (int l = 0; l < DEPTH; ++l) {
        const float* xl = (l == 0) ? x_in : xcur;
        float* xo = (l == DEPTH - 1) ? out : xcur;
        const float lam_init = 0.8f - 0.6f * expf(-0.3f * (float)l);
        { GemmArgs g{}; g.A = xl; g.lda = D; g.arow = nullptr; g.B = w_in + (size_t)l * D * DIN; g.ldb = DIN; g.strideB = 0; g.C = hbuf; g.ldc = DIN; g.bias = nullptr; g.strideBias = 0;
          g.R = nullptr; g.ldr = 0; g.tile_e = nullptr; g.M = T; g.N = DIN; g.K = D;
          k_gemm<0><<<dim3((DIN + 127) / 128, T / 128), 256, 0, stream>>>(g); }
        k_attnA_l<<<BATCH * 4 * SEQ / 4, 256, 0, stream>>>(hbuf, mix, subln_g + l * 128, lamv + l, lam_init);
        k_attnB<<<BATCH * 4 * SEQ / 4, 256, 0, stream>>>(hbuf, mix, rel_bias + (size_t)l * 4 * 257);
        k_index<<<T / 4, 256, 0, stream>>>(hbuf, masks);
        k_attnC<<<BATCH * 4 * SEQ / 4, 256, 0, stream>>>(hbuf, mix, masks);
        { GemmArgs g{}; g.A = mix; g.lda = D; g.arow = nullptr; g.B = w_out + (size_t)l * D * D; g.ldb = D; g.strideB = 0; g.C = y1; g.ldc = D; g.bias = nullptr; g.strideBias = 0;
          g.R = xl; g.ldr = D; g.tile_e = nullptr; g.M = T; g.N = D; g.K = D;
          k_gemm<2><<<dim3(D / 128, T / 128), 256, 0, stream>>>(g); }
        k_ln_router<<<T / 4, 256, 0, stream>>>(y1, x1, ln1_g + l * D, ln1_b + l * D, w_router + (size_t)l * D * NE, b_router + l * NE, cnt + l * NE, top_e, gates, slots);
        k_offsets<<<1, 256, 0, stream>>>(cnt + l * NE, pstart, tile_e);
        hipMemsetAsync(row_token, 0xFF, NROWS * 4, stream);
        k_scatter<<<NASG / 256, 256, 0, stream>>>(top_e, slots, pstart, row_token, dest);
        { GemmArgs g{}; g.A = x1; g.lda = D; g.arow = row_token; g.B = w_gu + (size_t)l * NE * D * 2048; g.ldb = 2048; g.strideB = (long)D * 2048; g.C = hgu; g.ldc = 2048;
          g.bias = b_gu + (size_t)l * NE * 2048; g.strideBias = 2048; g.R = nullptr; g.ldr = 0; g.tile_e = tile_e; g.M = NROWS; g.N = 2048; g.K = D;
          k_gemm<1><<<dim3(2048 / 128, NTILES), 256, 0, stream>>>(g); }
        k_swiglu<<<NROWS, 256, 0, stream>>>(hgu, act, tile_e);
        { GemmArgs g{}; g.A = act; g.lda = D; g.arow = nullptr; g.B = w_down + (size_t)l * NE * D * D; g.ldb = D; g.strideB = (long)D * D; g.C = yrows; g.ldc = D;
          g.bias = b_down + (size_t)l * NE * D; g.strideBias = D; g.R = nullptr; g.ldr = 0; g.tile_e = tile_e; g.M = NROWS; g.N = D; g.K = D;
          k_gemm<1><<<dim3(D / 128, NTILES), 256, 0, stream>>>(g); }
        k_combine_ln2<<<T / 4, 256, 0, stream>>>(x1, yrows, dest, gates, ln2_g + l * D, ln2_b + l * D, xo);
    }
}

__global__ __launch_bounds__(256) void k_attnA_l(const float* __restrict__ h, float* __restrict__ mix, const float* __restrict__ subg, const float* __restrict__ lamp, float lam_init) {
    __shared__ float sc[4][2][2048];
    const float lam = lamp[0];
    const int w = threadIdx.x >> 6, lane = threadIdx.x & 63;
    const int qid = blockIdx.x * 4 + w;
    const int t = qid % SEQ, hh = (qid / SEQ) % 4, b = qid / (SEQ * 4);
    const float* hb = h + (size_t)b * SEQ * DIN;
    const float4* qp = (const float4*)(hb + (size_t)t * DIN + OFF_QA + hh * 128);
    float q1[64], q2[64];
#pragma unroll
    for (int i = 0; i < 16; ++i) { float4 v = qp[i]; q1[4 * i] = v.x; q1[4 * i + 1] = v.y; q1[4 * i + 2] = v.z; q1[4 * i + 3] = v.w; }
#pragma unroll
    for (int i = 0; i < 16; ++i) { float4 v = qp[16 + i]; q2[4 * i] = v.x; q2[4 * i + 1] = v.y; q2[4 * i + 2] = v.z; q2[4 * i + 3] = v.w; }
    const int nk = ((t >> 6) + 1) * 64;
    const float slope = exp2f(-(float)(2 * hh + 1));
    float m1 = -3e38f, m2 = -3e38f;
    for (int s = lane; s < nk; s += 64) {
        const float4* kp = (const float4*)(hb + (size_t)s * DIN + OFF_KA + hh * 128);
        float d1 = 0.f, d2 = 0.f;
#pragma unroll
        for (int i = 0; i < 16; ++i) { float4 kv = kp[i]; d1 += q1[4 * i] * kv.x + q1[4 * i + 1] * kv.y + q1[4 * i + 2] * kv.z + q1[4 * i + 3] * kv.w; }
#pragma unroll
        for (int i = 0; i < 16; ++i) { float4 kv = kp[16 + i]; d2 += q2[4 * i] * kv.x + q2[4 * i + 1] * kv.y + q2[4 * i + 2] * kv.z + q2[4 * i + 3] * kv.w; }
        const float bias = -slope * fabsf((float)(t - s));
        const float s1 = d1 * 0.125f + bias, s2 = d2 * 0.125f + bias;
        sc[w][0][s] = s1; sc[w][1][s] = s2; m1 = fmaxf(m1, s1); m2 = fmaxf(m2, s2);
    }
    m1 = wave_max(m1); m2 = wave_max(m2);
    float l1 = 0.f, l2 = 0.f;
    for (int s = lane; s < nk; s += 64) {
        const float p1 = __expf(sc[w][0][s] - m1), p2 = __expf(sc[w][1][s] - m2);
        sc[w][0][s] = p1; sc[w][1][s] = p2; l1 += p1; l2 += p2;
    }
    l1 = wave_sum(l1); l2 = wave_sum(l2);
    __syncthreads();
    const float c1 = 1.0f / l1, c2 = lam / l2;
    float a0 = 0.f, a1 = 0.f;
    const float* vp = hb + OFF_VA + hh * 128 + lane;
#pragma unroll 4
    for (int s = 0; s < nk; ++s) {
        const float a = sc[w][0][s] * c1 - sc[w][1][s] * c2;
        a0 = fmaf(a, vp[(size_t)s * DIN], a0); a1 = fmaf(a, vp[(size_t)s * DIN + 64], a1);
    }
    const float ss = wave_sum(a0 * a0 + a1 * a1);
    const float r = rsqrtf(ss * (1.0f / 128.0f) + EPS) * (1.0f - lam_init);
    float* op = mix + (size_t)(b * SEQ + t) * 1024 + hh * 128;
    op[lane] = a0 * r * subg[lane]; op[64 + lane] = a1 * r * subg[64 + lane];
}
```

```cpp
#include <hip/hip_runtime.h>
#include <stdint.h>
#include <cstdio>

#define LAS __attribute__((address_space(3)))
typedef unsigned short bf16_t;
typedef short bf16x8 __attribute__((ext_vector_type(8)));
typedef float f32x4 __attribute__((ext_vector_type(4)));
typedef float f32x2 __attribute__((ext_vector_type(2)));
typedef unsigned u32x4 __attribute__((ext_vector_type(4)));
typedef unsigned u32x2 __attribute__((ext_vector_type(2)));
typedef __bf16 bf16v2 __attribute__((ext_vector_type(2)));

constexpr int D = 1024, BATCH = 16, SEQ = 2048, T = BATCH * SEQ, DEPTH = 4;
constexpr int DIN = 3368;
constexpr int NE = 32;
constexpr float ALPHA = 1.681792830507429f;
constexpr float EPS = 1e-5f;
constexpr float LOG2E = 1.4426950408889634f;
constexpr float QSCALE = 0.125f * LOG2E;
constexpr int HQP = 2560;
constexpr int HQ_QA = 0, HQ_KA = 512, HQ_QB = 1024, HQ_KB = 1280, HQ_QC = 1536, HQ_KC = 1792, HQ_QI = 2048, HQ_KI = 2304, HQ_WI = 2336, HQ_USED = 2344;
constexpr int VT_A = 0, VT_B = 512, VT_C = 768;
constexpr int NASG = T * 4;
constexpr int GROWS = NASG + NE * 256;
constexpr int MAXRT = GROWS / 256;

constexpr size_t MiB = (size_t)1 << 20;
constexpr size_t al(size_t x) { return (x + 255) & ~(size_t)255; }
constexpr size_t WS_CTL = 0, CTL_BYTES = 4 * MiB;
constexpr size_t WS_WIN = WS_CTL + CTL_BYTES;
constexpr size_t WS_WV = WS_WIN + al((size_t)DEPTH * HQP * D * 2);
constexpr size_t WS_WOUT = WS_WV + al((size_t)DEPTH * 1024 * D * 2);
constexpr size_t WS_WGU = WS_WOUT + al((size_t)DEPTH * D * 1024 * 2);
constexpr size_t WS_WDN = WS_WGU + al((size_t)DEPTH * NE * 2048 * D * 2);
constexpr size_t WS_XB = WS_WDN + al((size_t)DEPTH * NE * D * 1024 * 2);
constexpr size_t WS_XF = WS_XB + al((size_t)T * D * 2);
constexpr size_t WS_HQ = WS_XF + al((size_t)T * D * 4);
constexpr size_t WS_VT = WS_HQ + al((size_t)T * HQP * 2);
constexpr size_t WS_MIX = WS_VT + al((size_t)1024 * T * 2);
constexpr size_t WS_Y1 = WS_MIX + al((size_t)T * 1024 * 2);
constexpr size_t WS_X1F = WS_Y1 + al((size_t)T * D * 4);
constexpr size_t WS_X1B = WS_X1F + al((size_t)T * D * 4);
constexpr size_t WS_ACT = WS_X1B + al((size_t)T * D * 2);
constexpr size_t WS_YR = WS_ACT + al((size_t)GROWS * 1024 * 2);
constexpr size_t WS_MASK = WS_YR + al((size_t)GROWS * 1024 * 2);
constexpr size_t WS_TOKL = WS_MASK + al((size_t)T * 32 * 8);
constexpr size_t WS_ASGE = WS_TOKL + al((size_t)NE * T * 4);
constexpr size_t WS_ASGS = WS_ASGE + al((size_t)NASG * 4);
constexpr size_t WS_GATE = WS_ASGS + al((size_t)NASG * 4);
constexpr size_t WS_END = WS_GATE + al((size_t)NASG * 4);
constexpr int CW_BAR = 4096;
constexpr int CW_CNT = 262144;

__device__ __forceinline__ unsigned pk_bf16(float lo, float hi) { f32x2 v = {lo, hi}; return __builtin_bit_cast(unsigned, __builtin_convertvector(v, bf16v2)); }
__device__ __forceinline__ float bf_lo(unsigned u) { return __uint_as_float(u << 16); }
__device__ __forceinline__ float bf_hi(unsigned u) { return __uint_as_float(u & 0xffff0000u); }
__device__ __forceinline__ float bf2f(bf16_t b) { return __uint_as_float(((unsigned)b) << 16); }
__device__ __forceinline__ float wave_sum(float v) {
#pragma unroll
    for (int o = 32; o > 0; o >>= 1) v += __shfl_xor(v, o);
    return v; }
__device__ __forceinline__ float wave_max(float v) {
#pragma unroll
    for (int o = 32; o > 0; o >>= 1) v = fmaxf(v, __shfl_xor(v, o));
    return v; }
__device__ __forceinline__ int wave_sum_i(int v) {
#pragma unroll
    for (int o = 32; o > 0; o >>= 1) v += __shfl_xor(v, o);
    return v; }

#define XB_TMO      128
#define XB_XCNT(j)  (256  + 64 * (j))
#define XB_XSUB(j)  (1280 + 64 * (j))
#define XB_XGEN(j)  (2304 + 64 * (j))
#define XB_TOP      3328
#define XB_TOPGEN   3392
#define XCD_BAR_WORDS 3456
#define XB_SPIN_CAP (1u << 22)
__device__ __forceinline__ unsigned xb_ld(unsigned* p)              { return __hip_atomic_load(p, __ATOMIC_RELAXED, __HIP_MEMORY_SCOPE_AGENT); }
__device__ __forceinline__ unsigned xb_add(unsigned* p, unsigned v) { return __hip_atomic_fetch_add(p, v, __ATOMIC_RELAXED, __HIP_MEMORY_SCOPE_AGENT); }
__device__ __forceinline__ unsigned xb_xcc_id() { return (unsigned)__builtin_amdgcn_s_getreg((3 << 11) | 20) & 0xFu; }
#define XB_SPIN(cond, bar) do { unsigned _sp = 0; while (cond) { __builtin_amdgcn_s_sleep(1); \
    if ((++_sp & 255u) == 0u) { if (xb_ld(&(bar)[XB_TMO])) break; if (_sp > XB_SPIN_CAP) { atomicAdd(&(bar)[XB_TMO], 1u); break; } } } } while (0)
struct XcdBarrier { unsigned* bar; unsigned x; volatile LAS unsigned* st; };
__device__ __forceinline__ XcdBarrier xcd_barrier_post(unsigned* bar, volatile LAS unsigned* st) {
    XcdBarrier b; b.bar = bar; b.x = xb_xcc_id(); b.st = st;
    if (threadIdx.x == 0) (void)xb_add(&bar[XB_XCNT(b.x)], 1u);
    return b;
}
__device__ __forceinline__ void xcd_barrier_complete(unsigned* bar, unsigned x, unsigned& nloc, unsigned& nx) {
    const unsigned G = gridDim.x * gridDim.y * gridDim.z;
    unsigned sum, cnt, mine, sp = 0u;
    for (;;) {
        sum = 0u; cnt = 0u; mine = 0u;
#pragma unroll
        for (unsigned j = 0; j < 16; ++j) { const unsigned c = xb_ld(&bar[XB_XCNT(j)]); sum += c; cnt += (c > 0u) ? 1u : 0u; mine = (j == x) ? c : mine; }
        if (sum == G) break;
        __builtin_amdgcn_s_sleep(1);
        if ((++sp & 255u) == 0u) { if (xb_ld(&bar[XB_TMO])) break; if (sp > XB_SPIN_CAP) { atomicAdd(&bar[XB_TMO], 1u); break; } }
    }
    nloc = mine > 0u ? mine : 1u; nx = cnt > 0u ? cnt : 1u;
}
__device__ __forceinline__ void xcd_barrier(const XcdBarrier& b) {
    asm volatile("s_waitcnt vmcnt(0)" ::: "memory");
    __syncthreads();
    if (threadIdx.x == 0) {
        unsigned* bar = b.bar;
        __builtin_amdgcn_s_waitcnt(0);
        unsigned nloc = b.st[0], nx = b.st[1];
        if (nloc == 0u) { xcd_barrier_complete(bar, b.x, nloc, nx); b.st[0] = nloc; b.st[1] = nx; }
        const unsigned old = xb_add(&bar[XB_XSUB(b.x)], 1u);
        const unsigned gen = old / nloc;
        if (old + 1u == (gen + 1u) * nloc) {
            __builtin_amdgcn_fence(__ATOMIC_RELEASE, "agent");
            asm volatile("s_waitcnt vmcnt(0)" ::: "memory");
            const unsigned og = xb_add(&bar[XB_TOP], 1u);
            const unsigned tg = og / nx;
            if (og + 1u == (tg + 1u) * nx) xb_add(&bar[XB_TOPGEN], 1u);
            else XB_SPIN(xb_ld(&bar[XB_TOPGEN]) == tg, bar);
            __builtin_amdgcn_fence(__ATOMIC_ACQUIRE, "agent");
            xb_add(&bar[XB_XGEN(b.x)], 1u);
            asm volatile("s_waitcnt vmcnt(0)" ::: "memory");
        } else {
            XB_SPIN(xb_ld(&bar[XB_XGEN(b.x)]) == gen, bar);
            __builtin_amdgcn_fence(__ATOMIC_ACQUIRE, "agent");
            asm volatile("s_waitcnt vmcnt(0)" ::: "memory");
        }
    }
    __syncthreads();
}

namespace pg8 {
constexpr int BM = 256, BK = 64, HALF = 128, HTB = HALF * BK * 2, STAGE_BYTES = 8 * HTB;
__host__ __device__ __forceinline__ int lds_byte(int r, int c) { const int st = (r >> 4) * 2 + (c >> 5), rr = r & 15, cc = c & 31, ob = rr * 64 + cc * 2; return st * 1024 + (ob ^ (((ob >> 9) & 1) << 5)); }
__host__ __device__ __forceinline__ void stage_rc(int b, int& R, int& C) { const int st = b / 1024, sb = b % 1024, swz = sb ^ (((sb >> 9) & 1) << 5); R = (st >> 1) * 16 + swz / 64; C = (st & 1) * 32 + (swz % 64) / 2; }
__host__ __device__ __forceinline__ int perm32(int rho) { const int n = rho >> 4, i = rho & 15; return 8 * (i >> 2) + 4 * n + (i & 3); }

struct Unit {
    int row0;
    int col0;
    const char* Bt;
    const int* rows;
    int nvalid;
    int e;
};

template <class Epi, class Sched, bool GATHER>
__device__ __forceinline__ void gemm_phase(LAS unsigned char* lds, const bf16_t* Abase, const int K, const Sched& S, const Epi& E, const int wid) {
    int lane = (int)__builtin_amdgcn_mbcnt_hi(~0u, __builtin_amdgcn_mbcnt_lo(~0u, 0u)); asm volatile("" : "+v"(lane));
    const int tid = wid * 64 + lane, wr = wid >> 2, wc = wid & 3, fr = lane & 15, fq = lane >> 4;
    const int nt = K / BK;
    int Rl[2], Cl[2]; unsigned voffB[2];
#pragma unroll
    for (int i = 0; i < 2; ++i) { int R, C; stage_rc(tid * 16 + i * 8192, R, C); Rl[i] = R; Cl[i] = C; const int Rb = Epi::PERM ? ((R & ~31) + perm32(R & 31)) : R; voffB[i] = (unsigned)(Rb * K + C) * 2u; }
    const size_t kstep = (size_t)(BK * 2);
    const size_t hstep = (size_t)HALF * K * 2;
    const unsigned ldsw = (unsigned)wid * 1024u;
    const int aoff = lds_byte(wr * 64 + fr, fq * 8), boff = lds_byte(wc * 32 + fr, fq * 8);
#define PG8_SA(b, h) (((b) * 2 + (h)) * HTB)
#define PG8_SB(b, h) ((4 + (b) * 2 + (h)) * HTB)
#define PG8_STAGE(bufoff, gbase, voff) do { _Pragma("unroll") for (int _i = 0; _i < 2; ++_i) \
        __builtin_amdgcn_global_load_lds((const unsigned*)((const char*)(gbase) + (voff)[_i]), (LAS unsigned*)(lds + (bufoff) + ldsw + _i * 8192), 16, 0, 0); } while (0)
#define PG8_LDA(dst, b, h) do { _Pragma("unroll") for (int m = 0; m < 4; ++m) _Pragma("unroll") for (int k = 0; k < 2; ++k) dst[m][k] = *(const LAS bf16x8*)(lds + PG8_SA(b, h) + aoff + m * 2048 + k * 1024); } while (0)
#define PG8_LDB(dst, b, h) do { _Pragma("unroll") for (int n = 0; n < 2; ++n) _Pragma("unroll") for (int k = 0; k < 2; ++k) dst[n][k] = *(const LAS bf16x8*)(lds + PG8_SB(b, h) + boff + n * 2048 + k * 1024); } while (0)
#define PG8_MMA(ai, bj, At, Bt) do { __builtin_amdgcn_s_setprio(1); _Pragma("unroll") for (int m = 0; m < 4; ++m) _Pragma("unroll") for (int n = 0; n < 2; ++n) _Pragma("unroll") for (int k = 0; k < 2; ++k) \
        acc[ai][bj][m][n] = __builtin_amdgcn_mfma_f32_16x16x32_bf16(Bt[n][k], At[m][k], acc[ai][bj][m][n], 0, 0, 0); __builtin_amdgcn_s_setprio(0); } while (0)
#define PG8_WAIT_V(n) asm volatile("s_waitcnt vmcnt(" #n ")" ::: "memory")
#define PG8_WAIT_L(n) asm volatile("s_waitcnt lgkmcnt(" #n ")" ::: "memory")
#define PG8_BAR __builtin_amdgcn_s_barrier()
#define PG8_SCHED __builtin_amdgcn_sched_barrier(0)
#define PG8_AOFFS(dst, u) do { _Pragma("unroll") for (int _h = 0; _h < 2; ++_h) _Pragma("unroll") for (int _i = 0; _i < 2; ++_i) { \
        int _src; if (GATHER) { const int _r = _h * HALF + Rl[_i]; _src = (_r < (u).nvalid) ? (u).rows[_r] : 0; } else _src = (u).row0 + _h * HALF + Rl[_i]; \
        dst[_h][_i] = (unsigned)(_src * K + Cl[_i]) * 2u; } } while (0)
    Unit cur, nxt; int ui = 0;
    if (!S.next(0, cur)) return;
    f32x4 acc[2][2][4][2];
#pragma unroll
    for (int a = 0; a < 2; ++a)
#pragma unroll
        for (int b = 0; b < 2; ++b)
#pragma unroll
            for (int m = 0; m < 4; ++m)
#pragma unroll
                for (int n = 0; n < 2; ++n) acc[a][b][m][n] = (f32x4){0.f, 0.f, 0.f, 0.f};
    bf16x8 At[4][2], B0[2][2], B1[2][2];
    unsigned oa[2][2], na[2][2];
    PG8_AOFFS(oa, cur);
    const char* cA = (const char*)Abase; const char* cB = cur.Bt;
    PG8_STAGE(PG8_SB(0, 0), cB, voffB); PG8_STAGE(PG8_SB(0, 1), cB + hstep, voffB); PG8_STAGE(PG8_SA(0, 0), cA, oa[0]); PG8_STAGE(PG8_SA(0, 1), cA, oa[1]);
    if (wr == 1) PG8_BAR;
    PG8_WAIT_V(2); PG8_BAR;
    PG8_STAGE(PG8_SB(1, 0), cB + kstep, voffB); PG8_STAGE(PG8_SA(1, 0), cA + kstep, oa[0]); PG8_STAGE(PG8_SB(1, 1), cB + hstep + kstep, voffB);
    PG8_WAIT_V(6); PG8_BAR;
    for (;;) {
        const bool has_next = S.next(ui + 1, nxt);
        if (has_next) { PG8_AOFFS(na, nxt); if (GATHER) asm volatile("" : "+v"(na[0][0]), "+v"(na[0][1]), "+v"(na[1][0]), "+v"(na[1][1])); }
        else {
#pragma unroll
            for (int h = 0; h < 2; ++h)
#pragma unroll
                for (int i = 0; i < 2; ++i) na[h][i] = oa[h][i];
        }
        const char* nB = has_next ? nxt.Bt : cB;
        for (int t = 0; t < nt; t += 2) {
            const bool last = (t == nt - 2);
            const char* a1 = cA + (size_t)(t + 1) * kstep;
            const char* a2 = last ? cA : cA + (size_t)(t + 2) * kstep; const char* b2 = last ? nB : cB + (size_t)(t + 2) * kstep;
            const char* a3 = a2 + kstep; const char* b3 = b2 + kstep;
            unsigned sa[2][2];
#pragma unroll
            for (int h = 0; h < 2; ++h)
#pragma unroll
                for (int i = 0; i < 2; ++i) sa[h][i] = last ? na[h][i] : oa[h][i];
            PG8_LDB(B0, 0, 0); PG8_LDB(B1, 0, 1); PG8_SCHED; PG8_LDA(At, 0, 0); PG8_STAGE(PG8_SA(1, 1), a1, oa[1]);
            PG8_WAIT_V(8); PG8_WAIT_L(0); PG8_BAR; PG8_MMA(0, 0, At, B0); PG8_MMA(0, 1, At, B1); PG8_BAR; PG8_SCHED;
            PG8_LDA(At, 0, 1); PG8_STAGE(PG8_SB(0, 0), b2, voffB); PG8_STAGE(PG8_SB(0, 1), b2 + hstep, voffB); PG8_STAGE(PG8_SA(0, 0), a2, sa[0]);
            PG8_WAIT_V(8); PG8_WAIT_L(0); PG8_BAR; PG8_MMA(1, 0, At, B0); PG8_MMA(1, 1, At, B1); PG8_BAR; PG8_SCHED;
            PG8_LDB(B0, 1, 0); PG8_LDB(B1, 1, 1); PG8_SCHED; PG8_LDA(At, 1, 0); PG8_STAGE(PG8_SA(0, 1), a2, sa[1]);
            PG8_WAIT_V(8); PG8_WAIT_L(0); PG8_BAR; PG8_MMA(0, 0, At, B0); PG8_MMA(0, 1, At, B1); PG8_BAR; PG8_SCHED;
            PG8_LDA(At, 1, 1); PG8_STAGE(PG8_SB(1, 0), b3, voffB); PG8_STAGE(PG8_SB(1, 1), b3 + hstep, voffB); PG8_STAGE(PG8_SA(1, 0), a3, sa[0]);
            PG8_WAIT_V(8); PG8_WAIT_L(0); PG8_BAR; PG8_MMA(1, 0, At, B0); PG8_MMA(1, 1, At, B1); PG8_BAR; PG8_SCHED;
        }
        if (wr == 0) PG8_BAR;
        E(acc, cur, wr, wc, fr, fq);
        if (!has_next) break;
#pragma unroll
        for (int a = 0; a < 2; ++a)
#pragma unroll
            for (int b = 0; b < 2; ++b)
#pragma unroll
                for (int m = 0; m < 4; ++m)
#pragma unroll
                    for (int n = 0; n < 2; ++n) acc[a][b][m][n] = (f32x4){0.f, 0.f, 0.f, 0.f};
        cur = nxt; cB = nB; ++ui;
#pragma unroll
        for (int h = 0; h < 2; ++h)
#pragma unroll
            for (int i = 0; i < 2; ++i) oa[h][i] = na[h][i];
        if (wr == 1) PG8_BAR;
    }
    PG8_WAIT_V(0);
    PG8_BAR;
#undef PG8_SA
#undef PG8_SB
#undef PG8_STAGE
#undef PG8_LDA
#undef PG8_LDB
#undef PG8_MMA
#undef PG8_WAIT_V
#undef PG8_WAIT_L
#undef PG8_BAR
#undef PG8_SCHED
#undef PG8_AOFFS
}

struct DenseOrder {
    int nRT, nN, G, c; const char* Bt; int K; bool swap;
    __device__ __forceinline__ bool next(int i, Unit& u) const {
        const int xcd = c & 7, s = i * (G >> 3) + (c >> 3);
        int rt, pn;
        if (!swap) { rt = 8 * (s / nN) + xcd; pn = s % nN; } else { pn = 8 * (s / nRT) + xcd; rt = s % nRT; }
        if (rt >= nRT || pn >= nN) return false;
        u.row0 = rt * BM; u.col0 = pn * BM; u.Bt = Bt + (size_t)pn * BM * K * 2; u.rows = nullptr; u.nvalid = 0; u.e = 0; return true;
    }
};
struct MoeTables { LAS const int* tstart; LAS const int* cnt; LAS const unsigned char* tile_e; int nrt; };
struct MoeOrder {
    MoeTables tb; int nN, G, c; const char* Bt; size_t strideB; const int* tokl; bool gather;
    __device__ __forceinline__ bool next(int i, Unit& u) const {
        const int xcd = c & 7, s = i * (G >> 3) + (c >> 3);
        const int q = 8 * (s / nN) + xcd, pn = s % nN;
        if (q >= tb.nrt) return false;
        const int e = tb.tile_e[q]; const int lt = q - tb.tstart[e];
        u.row0 = q * BM; u.col0 = pn * BM; u.e = e; u.Bt = Bt + (size_t)e * strideB + (size_t)pn * BM * 1024 * 2;
        u.rows = gather ? tokl + (size_t)e * T + lt * BM : nullptr; u.nvalid = tb.cnt[e] - lt * BM; return true;
    }
};

struct EpiBf16Plain {
    static constexpr bool PERM = true;
    bf16_t* O; int ldc;
    __device__ __forceinline__ void operator()(const f32x4 (&acc)[2][2][4][2], const Unit& u, int wr, int wc, int fr, int fq) const {
        const int row0 = u.row0 + wr * 64 + fr, col0 = u.col0 + wc * 32 + 8 * fq;
#pragma unroll
        for (int ai = 0; ai < 2; ++ai)
#pragma unroll
            for (int m = 0; m < 4; ++m) { bf16_t* rowp = O + (size_t)(row0 + ai * HALF + m * 16) * ldc + col0;
#pragma unroll
                for (int bj = 0; bj < 2; ++bj) { const f32x4 v0 = acc[ai][bj][m][0], v1 = acc[ai][bj][m][1];
                    u32x4 w; w.x = pk_bf16(v0[0], v0[1]); w.y = pk_bf16(v0[2], v0[3]); w.z = pk_bf16(v1[0], v1[1]); w.w = pk_bf16(v1[2], v1[3]);
                    *(u32x4*)(rowp + bj * HALF) = w; } }
    }
};
struct EpiResF32 {
    static constexpr bool PERM = false;
    float* C; const float* R;
    __device__ __forceinline__ void operator()(const f32x4 (&acc)[2][2][4][2], const Unit& u, int wr, int wc, int fr, int fq) const {
        const int row0 = u.row0 + wr * 64 + fr, col0 = u.col0 + wc * 32 + 4 * fq;
#pragma unroll
        for (int ai = 0; ai < 2; ++ai)
#pragma unroll
            for (int m = 0; m < 4; ++m) { const size_t off = (size_t)(row0 + ai * HALF + m * 16) * 1024 + col0;
#pragma unroll
                for (int bj = 0; bj < 2; ++bj)
#pragma unroll
                    for (int n = 0; n < 2; ++n) { const f32x4 r = *(const f32x4*)(R + off + bj * HALF + n * 16); *(f32x4*)(C + off + bj * HALF + n * 16) = r * ALPHA + acc[ai][bj][m][n]; } }
    }
};
struct EpiSwiglu {
    static constexpr bool PERM = true;
    bf16_t* O; const float* bias;
    __device__ __forceinline__ void operator()(const f32x4 (&acc)[2][2][4][2], const Unit& u, int wr, int wc, int fr, int fq) const {
        const int row0 = u.row0 + wr * 64 + fr, oc = (u.col0 >> 1) + wc * 32 + 8 * fq;
        const float* bp = bias + (size_t)u.e * 2048 + oc;
        f32x4 bg[2], bu[2];
#pragma unroll
        for (int n = 0; n < 2; ++n) { bg[n] = *(const f32x4*)(bp + 4 * n); bu[n] = *(const f32x4*)(bp + 1024 + 4 * n); }
#pragma unroll
        for (int ai = 0; ai < 2; ++ai)
#pragma unroll
            for (int m = 0; m < 4; ++m) {
                float o[8];
#pragma unroll
                for (int n = 0; n < 2; ++n) { const f32x4 g4 = acc[ai][0][m][n] + bg[n], u4 = acc[ai][1][m][n] + bu[n];
#pragma unroll
                    for (int j = 0; j < 4; ++j) { const float g = fminf(g4[j], 7.0f), up = fminf(fmaxf(u4[j], -7.0f), 7.0f);
                        const float glu = g * __builtin_amdgcn_rcpf(1.0f + __builtin_amdgcn_exp2f(-1.702f * LOG2E * g)); o[4 * n + j] = (up + 1.0f) * glu; } }
                u32x4 w; w.x = pk_bf16(o[0], o[1]); w.y = pk_bf16(o[2], o[3]); w.z = pk_bf16(o[4], o[5]); w.w = pk_bf16(o[6], o[7]);
                *(u32x4*)(O + (size_t)(row0 + ai * HALF + m * 16) * 1024 + oc) = w; }
    }
};
struct EpiBiasBf16 {
    static constexpr bool PERM = true;
    bf16_t* O; const float* bias;
    __device__ __forceinline__ void operator()(const f32x4 (&acc)[2][2][4][2], const Unit& u, int wr, int wc, int fr, int fq) const {
        const int row0 = u.row0 + wr * 64 + fr, col0 = u.col0 + wc * 32 + 8 * fq;
        const float* bp = bias + (size_t)u.e * 1024 + col0;
        f32x4 bv[2][2];
#pragma unroll
        for (int bj = 0; bj < 2; ++bj)
#pragma unroll
            for (int n = 0; n < 2; ++n) bv[bj][n] = *(const f32x4*)(bp + bj * HALF + 4 * n);
#pragma unroll
        for (int ai = 0; ai < 2; ++ai)
#pragma unroll
            for (int m = 0; m < 4; ++m) { bf16_t* rowp = O + (size_t)(row0 + ai * HALF + m * 16) * 1024 + col0;
#pragma unroll
                for (int bj = 0; bj < 2; ++bj) { const f32x4 v0 = acc[ai][bj][m][0] + bv[bj][0], v1 = acc[ai][bj][m][1] + bv[bj][1];
                    u32x4 w; w.x = pk_bf16(v0[0], v0[1]); w.y = pk_bf16(v0[2], v0[3]); w.z = pk_bf16(v1[0], v1[1]); w.w = pk_bf16(v1[2], v1[3]);
                    *(u32x4*)(rowp + bj * HALF) = w; } }
    }
};
}

struct Args {
    const float* x; const float* w_in; const float* lam_q1; const float* lam_k1; const float* lam_q2; const float* lam_k2; const float* subln_g; const float* rel_bias;
    const float* w_out; const float* ln1_g; const float* ln1_b; const float* w_router; const float* b_router; const float* w_gu; const float* b_gu;
    const float* w_down; const float* b_down; const float* ln2_g; const float* ln2_b;
    float* out; unsigned char* ws;
    int ph_lo, ph_hi, bar_region, pad;
};

constexpr int LDS_STAGE = 0;
constexpr int LDS_CTL = 131072;
constexpr int LDS_TSTART = LDS_CTL + 64;
constexpr int LDS_CNT = LDS_TSTART + 36 * 4;
constexpr int LDS_TILEE = LDS_CNT + 32 * 4;
constexpr int LDS_RT = LDS_TILEE + 576;
constexpr int LDS_BYTES = 147456;
static_assert(LDS_RT + (64 + 1024) * 4 <= LDS_BYTES, "LDS map");

__device__ __forceinline__ void transpose_item(const float* W, int N, int k0, int n0, int nvalid, bf16_t* WTrow0, float scale, LAS float* scr, int lane) {
#pragma unroll 8
    for (int i = 0; i < 32; ++i) { const int kk = 2 * i + (lane >> 5), col = lane & 31; scr[kk * 33 + col] = (col < nvalid) ? W[(size_t)(k0 + kk) * N + n0 + col] * scale : 0.f; }
    asm volatile("s_waitcnt lgkmcnt(0)" ::: "memory");
    const int c = lane & 7;
#pragma unroll
    for (int j = 0; j < 4; ++j) { const int n = (lane >> 3) + 8 * j; const LAS float* s = scr + (8 * c) * 33 + n;
        u32x4 o; o.x = pk_bf16(s[0 * 33], s[1 * 33]); o.y = pk_bf16(s[2 * 33], s[3 * 33]); o.z = pk_bf16(s[4 * 33], s[5 * 33]); o.w = pk_bf16(s[6 * 33], s[7 * 33]);
        if (n < nvalid) *(u32x4*)(WTrow0 + (size_t)n * 1024 + k0 + 8 * c) = o; }
    asm volatile("s_waitcnt lgkmcnt(0)" ::: "memory");
}
__device__ __forceinline__ void in_map(int n0, bool& isv, int& row, float& scale) {
    scale = 1.f; isv = false;
    if (n0 < 512) { row = HQ_QA + n0; scale = QSCALE; }
    else if (n0 < 1024) row = HQ_KA + (n0 - 512);
    else if (n0 < 1536) { isv = true; row = VT_A + (n0 - 1024); }
    else if (n0 < 1792) { row = HQ_QB + (n0 - 1536); scale = QSCALE; }
    else if (n0 < 2048) row = HQ_KB + (n0 - 1792);
    else if (n0 < 2304) { isv = true; row = VT_B + (n0 - 2048); }
    else if (n0 < 2560) { row = HQ_QC + (n0 - 2304); scale = QSCALE; }
    else if (n0 < 2816) row = HQ_KC + (n0 - 2560);
    else if (n0 < 3072) { isv = true; row = VT_C + (n0 - 2816); }
    else if (n0 < 3328) row = HQ_QI + (n0 - 3072);
    else if (n0 < 3360) row = HQ_KI + (n0 - 3328);
    else row = HQ_WI + (n0 - 3360);
}

__global__ void __launch_bounds__(512, 2) mega(Args a) {
    extern __shared__ __attribute__((aligned(16))) unsigned char lds_raw[];
    LAS unsigned char* lds = (LAS unsigned char*)lds_raw;
    const int G = gridDim.x, bid = blockIdx.x, NGW = G * 8;
    const int wave = __builtin_amdgcn_readfirstlane((int)threadIdx.x >> 6);
#define OPAQUE_IDS() int lane = (int)__builtin_amdgcn_mbcnt_hi(~0u, __builtin_amdgcn_mbcnt_lo(~0u, 0u)); asm volatile("" : "+v"(lane)); const int tid = wave * 64 + lane, gw = bid * 8 + wave; (void)tid; (void)gw
    unsigned char* ws = a.ws;
    unsigned* ctl = (unsigned*)(ws + WS_CTL);
    bf16_t* Win = (bf16_t*)(ws + WS_WIN); bf16_t* Wv = (bf16_t*)(ws + WS_WV); bf16_t* Wout = (bf16_t*)(ws + WS_WOUT);
    bf16_t* Wgu = (bf16_t*)(ws + WS_WGU); bf16_t* Wdn = (bf16_t*)(ws + WS_WDN);
    bf16_t* XB = (bf16_t*)(ws + WS_XB); float* XF = (float*)(ws + WS_XF);
    bf16_t* HQ = (bf16_t*)(ws + WS_HQ); bf16_t* VT = (bf16_t*)(ws + WS_VT); bf16_t* MIX = (bf16_t*)(ws + WS_MIX);
    float* Y1 = (float*)(ws + WS_Y1); float* X1F = (float*)(ws + WS_X1F); bf16_t* X1B = (bf16_t*)(ws + WS_X1B);
    bf16_t* ACT = (bf16_t*)(ws + WS_ACT); bf16_t* YR = (bf16_t*)(ws + WS_YR);
    int* TOKL = (int*)(ws + WS_TOKL); int* ASGE = (int*)(ws + WS_ASGE); int* ASGS = (int*)(ws + WS_ASGS); float* GATE = (float*)(ws + WS_GATE);

    for (int u = threadIdx.x; u < (LDS_BYTES - LDS_CTL) / 4; u += 512) ((LAS unsigned*)(lds + LDS_CTL))[u] = 0u;
    __syncthreads();
    XcdBarrier bar = xcd_barrier_post(ctl + CW_BAR + a.bar_region * XCD_BAR_WORDS, (volatile LAS unsigned*)(lds + LDS_CTL));
    const int lo = a.ph_lo, hi = a.ph_hi;
#define IN(k) (lo <= (k) && (k) < hi)
#define SEAM(k) do { if (IN(k) && IN((k) + 1)) xcd_barrier(bar); } while (0)

    if (IN(0)) {
        OPAQUE_IDS();
        LAS float* scr = (LAS float*)(lds + LDS_STAGE + wave * 16384);
        constexpr int I_IN = 16 * 106, I_OUT = 16 * 32, I_GU = 16 * 64, I_DN = 16 * 32;
        constexpr int N_IN = DEPTH * I_IN, N_OUT = DEPTH * I_OUT, N_GU = DEPTH * NE * I_GU, N_DN = DEPTH * NE * I_DN;
        for (int it = gw; it < N_IN + N_OUT + N_GU + N_DN; it += NGW) {
            int r = it;
            if (r < N_IN) { const int l = r / I_IN, q = r % I_IN, kb = q / 106, nb = q % 106, n0 = nb * 32; bool isv; int row; float sc; in_map(n0, isv, row, sc);
                bf16_t* dst = isv ? Wv + ((size_t)l * 1024 + row) * 1024 : Win + ((size_t)l * HQP + row) * 1024;
                transpose_item(a.w_in + (size_t)l * D * DIN, DIN, kb * 64, n0, (DIN - n0) < 32 ? (DIN - n0) : 32, dst, sc, scr, lane); continue; }
            r -= N_IN;
            if (r < N_OUT) { const int l = r / I_OUT, q = r % I_OUT, kb = q / 32, nb = q % 32;
                transpose_item(a.w_out + (size_t)l * 1024 * D, D, kb * 64, nb * 32, 32, Wout + ((size_t)l * D + nb * 32) * 1024, 1.f, scr, lane); continue; }
            r -= N_OUT;
            if (r < N_GU) { const int le = r / I_GU, q = r % I_GU, kb = q / 64, nb = q % 64, n0 = nb * 32;
                const int bj = n0 >> 10, rr = n0 & 1023, pn = rr >> 7, c = rr & 127, nrow = pn * 256 + bj * 128 + c;
                transpose_item(a.w_gu + (size_t)le * D * 2048, 2048, kb * 64, n0, 32, Wgu + ((size_t)le * 2048 + nrow) * 1024, 1.f, scr, lane); continue; }
            r -= N_GU;
            { const int le = r / I_DN, q = r % I_DN, kb = q / 32, nb = q % 32;
                transpose_item(a.w_down + (size_t)le * 1024 * D, D, kb * 64, nb * 32, 32, Wdn + ((size_t)le * D + nb * 32) * 1024, 1.f, scr, lane); }
        }
        for (int i = gw * 64 + lane; i < DEPTH * (HQP - HQ_USED) * 128; i += NGW * 64) { const int l = i / ((HQP - HQ_USED) * 128), q = i % ((HQP - HQ_USED) * 128);
            *(u32x4*)(Win + ((size_t)l * HQP + HQ_USED) * 1024 + (size_t)q * 8) = (u32x4){0u, 0u, 0u, 0u}; }
        for (size_t i = (size_t)gw * 64 + lane; i < (size_t)T * D / 8; i += (size_t)NGW * 64) { const f32x4 v0 = *(const f32x4*)(a.x + i * 8), v1 = *(const f32x4*)(a.x + i * 8 + 4);
            u32x4 w; w.x = pk_bf16(v0[0], v0[1]); w.y = pk_bf16(v0[2], v0[3]); w.z = pk_bf16(v1[0], v1[1]); w.w = pk_bf16(v1[2], v1[3]); *(u32x4*)(XB + i * 8) = w; }
    }
    SEAM(0);

    for (int l = 0; l < DEPTH; ++l) {
        const int pb = 1 + 8 * l;
        const float* xres = (l == 0) ? a.x : XF;
        float* xout = (l == DEPTH - 1) ? a.out : XF;
        if (IN(pb + 0)) {
            { pg8::DenseOrder S{T / 256, HQP / 256, G, bid, (const char*)(Win + (size_t)l * HQP * 1024), 1024, false};
              pg8::EpiBf16Plain E{HQ, HQP};
              pg8::gemm_phase<pg8::EpiBf16Plain, pg8::DenseOrder, false>(lds + LDS_STAGE, XB, 1024, S, E, wave); }
            { pg8::DenseOrder S{1024 / 256, T / 256, G, bid, (const char*)XB, 1024, true};
              pg8::EpiBf16Plain E{VT, T};
              pg8::gemm_phase<pg8::EpiBf16Plain, pg8::DenseOrder, false>(lds + LDS_STAGE, Wv + (size_t)l * 1024 * 1024, 1024, S, E, wave); }
        }
        SEAM(pb + 0);
        SEAM(pb + 1);
        SEAM(pb + 2);
        if (IN(pb + 3)) {
            pg8::DenseOrder S{T / 256, 4, G, bid, (const char*)(Wout + (size_t)l * 1024 * 1024), 1024, false};
            pg8::EpiResF32 E{Y1, xres};
            pg8::gemm_phase<pg8::EpiResF32, pg8::DenseOrder, false>(lds + LDS_STAGE, MIX, 1024, S, E, wave);
        }
        SEAM(pb + 3);
        if (IN(pb + 4)) {
            OPAQUE_IDS();
            LAS int* lcnt = (LAS int*)(lds + LDS_RT); LAS int* lbase = lcnt + 32; LAS int* asg_e = lcnt + 64; LAS int* asg_ls = asg_e + 512;
            const float* g1 = a.ln1_g + l * D; const float* b1 = a.ln1_b + l * D; const float* wr = a.w_router + (size_t)l * D * NE; const float* br = a.b_router + l * NE;
            unsigned* gcnt = ctl + CW_CNT + l * 64;
            for (int unit = bid; unit < T / 128; unit += G) {
                if (tid < 32) lcnt[tid] = 0;
                __syncthreads();
                for (int k = 0; k < 16; ++k) {
                    const int tl = wave * 16 + k, t = unit * 128 + tl;
                    float v[16];
#pragma unroll
                    for (int i = 0; i < 4; ++i) { const f32x4 u4 = *(const f32x4*)(Y1 + (size_t)t * D + i * 256 + lane * 4); v[4 * i] = u4[0]; v[4 * i + 1] = u4[1]; v[4 * i + 2] = u4[2]; v[4 * i + 3] = u4[3]; }
                    float s = 0.f;
#pragma unroll
                    for (int i = 0; i < 16; ++i) s += v[i];
                    const float mean = wave_sum(s) * (1.0f / 1024.0f);
                    float qv = 0.f;
#pragma unroll
                    for (int i = 0; i < 16; ++i) { const float d = v[i] - mean; qv += d * d; }
                    const float rstd = rsqrtf(wave_sum(qv) * (1.0f / 1024.0f) + EPS);
                    float part[32];
#pragma unroll
                    for (int e = 0; e < 32; ++e) part[e] = 0.f;
#pragma unroll
                    for (int i = 0; i < 4; ++i) {
                        const int c0 = i * 256 + lane * 4;
                        const f32x4 gg = *(const f32x4*)(g1 + c0), bb = *(const f32x4*)(b1 + c0);
                        float o[4];
#pragma unroll
                        for (int j = 0; j < 4; ++j) o[j] = (v[4 * i + j] - mean) * rstd * gg[j] + bb[j];
                        *(f32x4*)(X1F + (size_t)t * D + c0) = (f32x4){o[0], o[1], o[2], o[3]};
                        *(u32x2*)(X1B + (size_t)t * D + c0) = (u32x2){pk_bf16(o[0], o[1]), pk_bf16(o[2], o[3])};
#pragma unroll
                        for (int j = 0; j < 4; ++j) {
                            const f32x4* wp = (const f32x4*)(wr + (size_t)(c0 + j) * 32);
#pragma unroll
                            for (int e4 = 0; e4 < 8; ++e4) { const f32x4 wv = wp[e4];
#pragma unroll
                                for (int jj = 0; jj < 4; ++jj) part[4 * e4 + jj] = fmaf(o[j], wv[jj], part[4 * e4 + jj]); }
                        }
                    }
                    float p16[16], p8[8], p4[4], p2[2], lg;
                    { const bool hi = (lane & 32) != 0;
#pragma unroll
                      for (int i = 0; i < 16; ++i) { const float keep = hi ? part[i + 16] : part[i], send = hi ? part[i] : part[i + 16]; p16[i] = keep + __shfl_xor(send, 32); } }
                    { const bool hi = (lane & 16) != 0;
#pragma unroll
                      for (int i = 0; i < 8; ++i) { const float keep = hi ? p16[i + 8] : p16[i], send = hi ? p16[i] : p16[i + 8]; p8[i] = keep + __shfl_xor(send, 16); } }
                    { const bool hi = (lane & 8) != 0;
#pragma unroll
                      for (int i = 0; i < 4; ++i) { const float keep = hi ? p8[i + 4] : p8[i], send = hi ? p8[i] : p8[i + 4]; p4[i] = keep + __shfl_xor(send, 8); } }
                    { const bool hi = (lane & 4) != 0;
#pragma unroll
                      for (int i = 0; i < 2; ++i) { const float keep = hi ? p4[i + 2] : p4[i], send = hi ? p4[i] : p4[i + 2]; p2[i] = keep + __shfl_xor(send, 4); } }
                    { const bool hi = (lane & 2) != 0; const float keep = hi ? p2[1] : p2[0], send = hi ? p2[0] : p2[1]; lg = keep + __shfl_xor(send, 2); }
                    lg += __shfl_xor(lg, 1);
                    lg += br[lane >> 1];
                    int be[4]; float bv[4];
#pragma unroll
                    for (int kk = 0; kk < 4; ++kk) {
                        const float mx = wave_max(lg);
                        const unsigned long long bal = __ballot(lg == mx);
                        const int e = (__ffsll((long long)bal) - 1) >> 1;
                        be[kk] = e; bv[kk] = mx;
                        if ((lane >> 1) == e) lg = -3e38f;
                    }
                    float ex[4], es = 0.f;
#pragma unroll
                    for (int kk = 0; kk < 4; ++kk) { ex[kk] = __expf(bv[kk] - bv[0]); es += ex[kk]; }
                    if (lane == 0) {
#pragma unroll
                        for (int kk = 0; kk < 4; ++kk) { const int sl = __hip_atomic_fetch_add(&lcnt[be[kk]], 1, __ATOMIC_RELAXED, __HIP_MEMORY_SCOPE_WORKGROUP); asg_e[tl * 4 + kk] = be[kk]; asg_ls[tl * 4 + kk] = sl; GATE[t * 4 + kk] = ex[kk] / es; }
                    }
                }
                __syncthreads();
                if (tid < 32) lbase[tid] = (int)__hip_atomic_fetch_add(gcnt + tid, (unsigned)lcnt[tid], __ATOMIC_RELAXED, __HIP_MEMORY_SCOPE_AGENT);
                __syncthreads();
                { const int e = asg_e[tid], sl = lbase[e] + asg_ls[tid], t = unit * 128 + (tid >> 2);
                  TOKL[(size_t)e * T + sl] = t; ASGE[t * 4 + (tid & 3)] = e; ASGS[t * 4 + (tid & 3)] = sl; }
                __syncthreads();
            }
        }
        SEAM(pb + 4);
        LAS int* tstart = (LAS int*)(lds + LDS_TSTART); LAS int* lcntE = (LAS int*)(lds + LDS_CNT); LAS unsigned char* tile_e = lds + LDS_TILEE;
        if (IN(pb + 5) || IN(pb + 6) || IN(pb + 7)) {
            OPAQUE_IDS();
            if (tid < 32) lcntE[tid] = (int)__hip_atomic_load(ctl + CW_CNT + l * 64 + tid, __ATOMIC_RELAXED, __HIP_MEMORY_SCOPE_AGENT);
            __syncthreads();
            if (tid == 0) { int acc = 0; for (int e = 0; e < NE; ++e) { tstart[e] = acc; acc += (lcntE[e] + 255) >> 8; } tstart[32] = acc; }
            __syncthreads();
            for (int q = tid; q < MAXRT; q += 512) { int e = 0; for (int k = 0; k < NE; ++k) if (q >= tstart[k]) e = k; tile_e[q] = (unsigned char)e; }
            __syncthreads();
        }
        pg8::MoeTables tb{tstart, lcntE, tile_e, tstart[32]};
        if (IN(pb + 5)) {
            pg8::MoeOrder S{tb, 8, G, bid, (const char*)(Wgu + (size_t)l * NE * 2048 * 1024), (size_t)2048 * 1024 * 2, TOKL, true};
            pg8::EpiSwiglu E{ACT, a.b_gu + (size_t)l * NE * 2048};
            pg8::gemm_phase<pg8::EpiSwiglu, pg8::MoeOrder, true>(lds + LDS_STAGE, X1B, 1024, S, E, wave);
        }
        SEAM(pb + 5);
        if (IN(pb + 6)) {
            pg8::MoeOrder S{tb, 4, G, bid, (const char*)(Wdn + (size_t)l * NE * 1024 * 1024), (size_t)1024 * 1024 * 2, TOKL, false};
            pg8::EpiBiasBf16 E{YR, a.b_down + (size_t)l * NE * 1024};
            pg8::gemm_phase<pg8::EpiBiasBf16, pg8::MoeOrder, false>(lds + LDS_STAGE, ACT, 1024, S, E, wave);
        }
        SEAM(pb + 6);
        if (IN(pb + 7)) {
            OPAQUE_IDS();
            const float* g2 = a.ln2_g + l * D; const float* b2 = a.ln2_b + l * D;
            for (int t = gw; t < T; t += NGW) {
                float v[16];
#pragma unroll
                for (int i = 0; i < 4; ++i) { const f32x4 u4 = *(const f32x4*)(X1F + (size_t)t * D + i * 256 + lane * 4);
#pragma unroll
                    for (int j = 0; j < 4; ++j) v[4 * i + j] = ALPHA * u4[j]; }
#pragma unroll
                for (int k = 0; k < 4; ++k) {
                    const int e = ASGE[t * 4 + k]; const float gk = GATE[t * 4 + k];
                    const bf16_t* yp = YR + ((size_t)tstart[e] * 256 + ASGS[t * 4 + k]) * 1024;
#pragma unroll
                    for (int i = 0; i < 4; ++i) { const u32x2 u2 = *(const u32x2*)(yp + i * 256 + lane * 4);
                        v[4 * i] += gk * bf_lo(u2[0]); v[4 * i + 1] += gk * bf_hi(u2[0]); v[4 * i + 2] += gk * bf_lo(u2[1]); v[4 * i + 3] += gk * bf_hi(u2[1]); }
                }
                float s = 0.f;
#pragma unroll
                for (int i = 0; i < 16; ++i) s += v[i];
                const float mean = wave_sum(s) * (1.0f / 1024.0f);
                float qv = 0.f;
#pragma unroll
                for (int i = 0; i < 16; ++i) { const float d = v[i] - mean; qv += d * d; }
                const float rstd = rsqrtf(wave_sum(qv) * (1.0f / 1024.0f) + EPS);
#pragma unroll
                for (int i = 0; i < 4; ++i) {
                    const int c0 = i * 256 + lane * 4;
                    const f32x4 gg = *(const f32x4*)(g2 + c0), bb = *(const f32x4*)(b2 + c0);
                    float o[4];
#pragma unroll
                    for (int j = 0; j < 4; ++j) o[j] = (v[4 * i + j] - mean) * rstd * gg[j] + bb[j];
                    *(f32x4*)(xout + (size_t)t * D + c0) = (f32x4){o[0], o[1], o[2], o[3]};
                    *(u32x2*)(XB + (size_t)t * D + c0) = (u32x2){pk_bf16(o[0], o[1]), pk_bf16(o[2], o[3])};
                }
            }
        }
        if (l + 1 < DEPTH) SEAM(pb + 7);
    }
#undef IN
#undef SEAM
}

__device__ __forceinline__ void load_q64(const bf16_t* p, float (&q)[64]) {
#pragma unroll
    for (int i = 0; i < 8; ++i) { const u32x4 v = *(const u32x4*)(p + 8 * i);
        q[8 * i] = bf_lo(v[0]); q[8 * i + 1] = bf_hi(v[0]); q[8 * i + 2] = bf_lo(v[1]); q[8 * i + 3] = bf_hi(v[1]);
        q[8 * i + 4] = bf_lo(v[2]); q[8 * i + 5] = bf_hi(v[2]); q[8 * i + 6] = bf_lo(v[3]); q[8 * i + 7] = bf_hi(v[3]); }
}
__device__ __forceinline__ float dot64(const bf16_t* p, const float (&q)[64]) {
    float d = 0.f;
#pragma unroll
    for (int i = 0; i < 8; ++i) { const u32x4 v = *(const u32x4*)(p + 8 * i);
        d += q[8 * i] * bf_lo(v[0]) + q[8 * i + 1] * bf_hi(v[0]) + q[8 * i + 2] * bf_lo(v[1]) + q[8 * i + 3] * bf_hi(v[1])
           + q[8 * i + 4] * bf_lo(v[2]) + q[8 * i + 5] * bf_hi(v[2]) + q[8 * i + 6] * bf_lo(v[3]) + q[8 * i + 7] * bf_hi(v[3]); }
    return d;
}
__global__ __launch_bounds__(256) void k_attnA(const bf16_t* __restrict__ hq, const bf16_t* __restrict__ vt, bf16_t* __restrict__ mix, const float* __restrict__ subg,
                                               const float* lq1, const float* lk1, const float* lq2, const float* lk2, float lam_init) {
    __shared__ float sc[4][2][2048];
    const int w = threadIdx.x >> 6, lane = threadIdx.x & 63;
    const float lam = expf(wave_sum(lq1[lane] * lk1[lane])) - expf(wave_sum(lq2[lane] * lk2[lane])) + lam_init;
    const int qid = blockIdx.x * 4 + w;
    const int t = qid % SEQ, hh = (qid / SEQ) % 4, b = qid / (SEQ * 4);
    const bf16_t* hb = hq + (size_t)b * SEQ * HQP;
    float q1[64], q2[64];
    load_q64(hb + (size_t)t * HQP + HQ_QA + hh * 128, q1); load_q64(hb + (size_t)t * HQP + HQ_QA + hh * 128 + 64, q2);
    const int nk = ((t >> 6) + 1) * 64;
    const float slope = exp2f(-(float)(2 * hh + 1)) * LOG2E;
    float m1 = -3e38f, m2 = -3e38f;
    for (int s = lane; s < nk; s += 64) {
        const bf16_t* kp = hb + (size_t)s * HQP + HQ_KA + hh * 128;
        const float bias = -slope * fabsf((float)(t - s));
        const float s1 = dot64(kp, q1) + bias, s2 = dot64(kp + 64, q2) + bias;
        sc[w][0][s] = s1; sc[w][1][s] = s2; m1 = fmaxf(m1, s1); m2 = fmaxf(m2, s2);
    }
    m1 = wave_max(m1); m2 = wave_max(m2);
    float l1 = 0.f, l2 = 0.f;
    for (int s = lane; s < nk; s += 64) { const float p1 = exp2f(sc[w][0][s] - m1), p2 = exp2f(sc[w][1][s] - m2); sc[w][0][s] = p1; sc[w][1][s] = p2; l1 += p1; l2 += p2; }
    l1 = wave_sum(l1); l2 = wave_sum(l2);
    __syncthreads();
    const float c1 = 1.0f / l1, c2 = lam / l2;
    float a0 = 0.f, a1 = 0.f;
    const bf16_t* vp0 = vt + (size_t)(VT_A + hh * 128 + lane) * T + (size_t)b * SEQ;
    const bf16_t* vp1 = vp0 + (size_t)64 * T;
#pragma unroll 4
    for (int s = 0; s < nk; ++s) { const float aa = sc[w][0][s] * c1 - sc[w][1][s] * c2; a0 = fmaf(aa, bf2f(vp0[s]), a0); a1 = fmaf(aa, bf2f(vp1[s]), a1); }
    const float ss = wave_sum(a0 * a0 + a1 * a1);
    const float r = rsqrtf(ss * (1.0f / 128.0f) + EPS) * (1.0f - lam_init);
    bf16_t* op = mix + (size_t)(b * SEQ + t) * 1024 + hh * 128;
    op[lane] = (bf16_t)(pk_bf16(a0 * r * subg[lane], 0.f) & 0xffffu); op[64 + lane] = (bf16_t)(pk_bf16(a1 * r * subg[64 + lane], 0.f) & 0xffffu);
}
__global__ __launch_bounds__(256) void k_attnB(const bf16_t* __restrict__ hq, const bf16_t* __restrict__ vt, bf16_t* __restrict__ mix, const float* __restrict__ relb) {
    __shared__ float sc[4][576];
    const int w = threadIdx.x >> 6, lane = threadIdx.x & 63;
    const int qid = blockIdx.x * 4 + w;
    const int t = qid % SEQ, hh = (qid / SEQ) % 4, b = qid / (SEQ * 4);
    const bf16_t* hb = hq + (size_t)b * SEQ * HQP;
    float q[64]; load_q64(hb + (size_t)t * HQP + HQ_QB + hh * 64, q);
    const int c = t >> 6;
    const int s0 = (c - 8) * 64 < 0 ? 0 : (c - 8) * 64, s1 = (c + 1) * 64;
    float m = -3e38f;
    for (int s = s0 + lane; s < s1; s += 64) {
        int rel = t - s; rel = rel < -128 ? -128 : (rel > 128 ? 128 : rel);
        const float sv = dot64(hb + (size_t)s * HQP + HQ_KB + hh * 64, q) + relb[hh * 257 + rel + 128] * LOG2E;
        sc[w][s - s0] = sv; m = fmaxf(m, sv);
    }
    m = wave_max(m);
    float l = 0.f;
    for (int s = s0 + lane; s < s1; s += 64) { const float p = exp2f(sc[w][s - s0] - m); sc[w][s - s0] = p; l += p; }
    l = wave_sum(l);
    __syncthreads();
    float a0 = 0.f;
    const bf16_t* vp = vt + (size_t)(VT_B + hh * 64 + lane) * T + (size_t)b * SEQ;
#pragma unroll 4
    for (int s = s0; s < s1; ++s) a0 = fmaf(sc[w][s - s0], bf2f(vp[s]), a0);
    mix[(size_t)(b * SEQ + t) * 1024 + 512 + hh * 64 + lane] = (bf16_t)(pk_bf16(a0 / l, 0.f) & 0xffffu);
}
__device__ __forceinline__ unsigned f2key(float f) { unsigned u = __float_as_uint(f); return (u & 0x80000000u) ? ~u : (u | 0x80000000u); }
__global__ __launch_bounds__(256) void k_index(const bf16_t* __restrict__ hq, unsigned long long* __restrict__ masks) {
    __shared__ unsigned keys[4][2048];
    __shared__ float qs[4][256];
    const int w = threadIdx.x >> 6, lane = threadIdx.x & 63;
    const int qid = blockIdx.x * 4 + w;
    const int t = qid % SEQ, b = qid / SEQ;
    const bf16_t* hb = hq + (size_t)b * SEQ * HQP;
    const bf16_t* hp = hb + (size_t)t * HQP;
    unsigned long long* mo = masks + (size_t)(b * SEQ + t) * 32;
    const int nk = ((t >> 6) + 1) * 64;
    if (nk <= 256) { if (lane < 32) mo[lane] = (lane < (nk >> 6)) ? ~0ull : 0ull; return; }
    { const u32x2 v = *(const u32x2*)(hp + HQ_QI + lane * 4); qs[w][lane * 4] = bf_lo(v[0]); qs[w][lane * 4 + 1] = bf_hi(v[0]); qs[w][lane * 4 + 2] = bf_lo(v[1]); qs[w][lane * 4 + 3] = bf_hi(v[1]); }
    __builtin_amdgcn_wave_barrier();
    float wsx[8];
#pragma unroll
    for (int i = 0; i < 8; ++i) wsx[i] = bf2f(hp[HQ_WI + i]) * 0.0625f;
#pragma unroll 1
    for (int s = lane; s < nk; s += 64) {
        asm volatile("" ::: "memory");
        float ki[32];
        const bf16_t* kp = hb + (size_t)s * HQP + HQ_KI;
#pragma unroll
        for (int i = 0; i < 4; ++i) { const u32x4 v = *(const u32x4*)(kp + 8 * i);
            ki[8 * i] = bf_lo(v[0]); ki[8 * i + 1] = bf_hi(v[0]); ki[8 * i + 2] = bf_lo(v[1]); ki[8 * i + 3] = bf_hi(v[1]);
            ki[8 * i + 4] = bf_lo(v[2]); ki[8 * i + 5] = bf_hi(v[2]); ki[8 * i + 6] = bf_lo(v[3]); ki[8 * i + 7] = bf_hi(v[3]); }
        float acc = 0.f;
#pragma unroll
        for (int hh = 0; hh < 8; ++hh) {
            float d = 0.f;
#pragma unroll
            for (int i = 0; i < 8; ++i) { const f32x4 qv = *(const f32x4*)&qs[w][hh * 32 + i * 4]; d += qv[0] * ki[4 * i] + qv[1] * ki[4 * i + 1] + qv[2] * ki[4 * i + 2] + qv[3] * ki[4 * i + 3]; }
            acc += wsx[hh] * fmaxf(d, 0.f);
        }
        acc += 0.0f;
        keys[w][s] = f2key(acc);
    }
    __builtin_amdgcn_wave_barrier();
    const int nb = nk >> 6;
    unsigned prefix = 0u;
#pragma unroll 1
    for (int bit = 31; bit >= 0; --bit) {
        const unsigned cand = prefix | (1u << bit);
        int c = 0;
#pragma unroll 1
        for (int i = 0; i < nb; ++i) c += (keys[w][i * 64 + lane] >= cand) ? 1 : 0;
        c = wave_sum_i(c);
        if (c >= 256) prefix = cand;
    }
    const unsigned thr = prefix;
    int cg = 0;
#pragma unroll 1
    for (int i = 0; i < nb; ++i) cg += (keys[w][i * 64 + lane] > thr) ? 1 : 0;
    cg = wave_sum_i(cg);
    const int quota = 256 - cg;
    int taken = 0;
#pragma unroll 1
    for (int i = 0; i < 32; ++i) {
        unsigned long long m = 0ull;
        if (i < nb) {
            const unsigned k = keys[w][i * 64 + lane];
            const bool eq = (k == thr);
            const unsigned long long eqm = __ballot(eq);
            const int before = __popcll(eqm & ((1ull << lane) - 1ull));
            const bool sel = (k > thr) || (eq && (taken + before < quota));
            m = __ballot(sel);
            taken += __popcll(eqm);
        }
        if (lane == 0) mo[i] = m;
    }
}
__global__ __launch_bounds__(256) void k_attnC(const bf16_t* __restrict__ hq, const bf16_t* __restrict__ vt, bf16_t* __restrict__ mix, const unsigned long long* __restrict__ masks) {
    __shared__ float sc[4][2048];
    const int w = threadIdx.x >> 6, lane = threadIdx.x & 63;
    const int qid = blockIdx.x * 4 + w;
    const int t = qid % SEQ, hh = (qid / SEQ) % 4, b = qid / (SEQ * 4);
    const bf16_t* hb = hq + (size_t)b * SEQ * HQP;
    const unsigned long long* mo = masks + (size_t)(b * SEQ + t) * 32;
    float q[64]; load_q64(hb + (size_t)t * HQP + HQ_QC + hh * 64, q);
    const int nk = ((t >> 6) + 1) * 64;
    const float slope = exp2f(-(float)(2 * hh + 2)) * LOG2E;
    float m = -3e38f;
    for (int s = lane; s < nk; s += 64) {
        const bool sel = (mo[s >> 6] >> lane) & 1ull;
        float sv = -3e38f;
        if (sel) sv = dot64(hb + (size_t)s * HQP + HQ_KC + hh * 64, q) - slope * fabsf((float)(t - s));
        sc[w][s] = sv; m = fmaxf(m, sv);
    }
    m = wave_max(m);
    float l = 0.f;
    for (int s = lane; s < nk; s += 64) { const float sv = sc[w][s]; const float p = (sv > -1e38f) ? exp2f(sv - m) : 0.f; sc[w][s] = p; l += p; }
    l = wave_sum(l);
    __syncthreads();
    float a0 = 0.f;
    const bf16_t* vp = vt + (size_t)(VT_C + hh * 64 + lane) * T + (size_t)b * SEQ;
#pragma unroll 4
    for (int s = 0; s < nk; ++s) a0 = fmaf(sc[w][s], bf2f(vp[s]), a0);
    mix[(size_t)(b * SEQ + t) * 1024 + 768 + hh * 64 + lane] = (bf16_t)(pk_bf16(a0 / l, 0.f) & 0xffffu);
}

extern "C" void kernel_launch(void* const* d_in, const int* in_sizes, int n_in, void* d_out, int out_size, void* d_ws, size_t ws_size, hipStream_t stream) {
    static int grid = 0;
    if (grid == 0) {
        if (ws_size < WS_END) { fprintf(stderr, "kernel_launch: workspace too small (%zu < %zu)\n", ws_size, (size_t)WS_END); grid = -1; return; }
        int dev = 0, cus = 0, per_cu = 0;
        if (hipGetDevice(&dev) != hipSuccess || hipDeviceGetAttribute(&cus, hipDeviceAttributeMultiprocessorCount, dev) != hipSuccess) { grid = -1; return; }
        if (hipFuncSetAttribute((const void*)mega, hipFuncAttributeMaxDynamicSharedMemorySize, LDS_BYTES) != hipSuccess) { fprintf(stderr, "kernel_launch: hipFuncSetAttribute failed\n"); grid = -1; return; }
        if (hipOccupancyMaxActiveBlocksPerMultiprocessor(&per_cu, (const void*)mega, 512, LDS_BYTES) != hipSuccess || per_cu < 1) { fprintf(stderr, "kernel_launch: occupancy query says %d\n", per_cu); }
        (void)hipGetLastError();
        grid = cus;
        if (grid % 8 != 0) grid -= grid % 8;
    }
    if (grid < 0) return;
    (void)hipMemsetAsync((char*)d_ws + WS_CTL, 0, CTL_BYTES, stream);
    Args a{};
    a.x = (const float*)d_in[0]; a.w_in = (const float*)d_in[1]; a.lam_q1 = (const float*)d_in[2]; a.lam_k1 = (const float*)d_in[3]; a.lam_q2 = (const float*)d_in[4]; a.lam_k2 = (const float*)d_in[5];
    a.subln_g = (const float*)d_in[6]; a.rel_bias = (const float*)d_in[7]; a.w_out = (const float*)d_in[8]; a.ln1_g = (const float*)d_in[9]; a.ln1_b = (const float*)d_in[10];
    a.w_router = (const float*)d_in[11]; a.b_router = (const float*)d_in[12]; a.w_gu = (const float*)d_in[13]; a.b_gu = (const float*)d_in[14]; a.w_down = (const float*)d_in[15];
    a.b_down = (const float*)d_in[16]; a.ln2_g = (const float*)d_in[17]; a.ln2_b = (const float*)d_in[18];
    a.out = (float*)d_out; a.ws = (unsigned char*)d_ws; a.pad = 0;
    unsigned char* ws = (unsigned char*)d_ws;
    bf16_t* HQ = (bf16_t*)(ws + WS_HQ); bf16_t* VT = (bf16_t*)(ws + WS_VT); bf16_t* MIX = (bf16_t*)(ws + WS_MIX);
    unsigned long long* MASK = (unsigned long long*)(ws + WS_MASK);
    int region = 0;
    for (int l = 0; l < DEPTH; ++l) {
        const int pb = 1 + 8 * l;
        a.ph_lo = (l == 0) ? 0 : pb; a.ph_hi = pb + 1; a.bar_region = region++;
        hipLaunchKernelGGL(mega, dim3(grid), dim3(512), LDS_BYTES, stream, a);
        const float lam_init = 0.8f - 0.6f * expf(-0.3f * (float)l);
        k_attnA<<<BATCH * 4 * SEQ / 4, 256, 0, stream>>>(HQ, VT, MIX, a.subln_g + l * 128, a.lam_q1 + l * 64, a.lam_k1 + l * 64, a.lam_q2 + l * 64, a.lam_k2 + l * 64, lam_init);
        k_attnB<<<BATCH * 4 * SEQ / 4, 256, 0, stream>>>(HQ, VT, MIX, a.rel_bias + (size_t)l * 4 * 257);
        k_index<<<T / 4, 256, 0, stream>>>(HQ, MASK);
        k_attnC<<<BATCH * 4 * SEQ / 4, 256, 0, stream>>>(HQ, VT, MIX, MASK);
        a.ph_lo = pb + 3; a.ph_hi = pb + 8; a.bar_region = region++;
        hipLaunchKernelGGL(mega, dim3(grid), dim3(512), LDS_BYTES, stream, a);
    }
}
```

```cpp
#include <hip/hip_runtime.h>
#include <stdint.h>
#include <cstdio>

#define LAS __attribute__((address_space(3)))
typedef unsigned short bf16_t;
typedef short bf16x8 __attribute__((ext_vector_type(8)));
typedef float f32x4 __attribute__((ext_vector_type(4)));
typedef float f32x2 __attribute__((ext_vector_type(2)));
typedef unsigned u32x4 __attribute__((ext_vector_type(4)));
typedef unsigned u32x2 __attribute__((ext_vector_type(2)));
typedef __bf16 bf16v2 __attribute__((ext_vector_type(2)));

constexpr int D = 1024, BATCH = 16, SEQ = 2048, T = BATCH * SEQ, DEPTH = 4;
constexpr int DIN = 3368;
constexpr int NE = 32;
constexpr float ALPHA = 1.681792830507429f;
constexpr float EPS = 1e-5f;
constexpr float LOG2E = 1.4426950408889634f;
constexpr float QSCALE = 0.125f * LOG2E;
constexpr int HQP = 2560;
constexpr int HQ_QA = 0, HQ_KA = 512, HQ_QB = 1024, HQ_KB = 1280, HQ_QC = 1536, HQ_KC = 1792, HQ_QI = 2048, HQ_KI = 2304, HQ_WI = 2336, HQ_USED = 2344;
constexpr int VT_A = 0, VT_B = 512, VT_C = 768;
constexpr int NASG = T * 4;
constexpr int GROWS = NASG + NE * 256;
constexpr int MAXRT = GROWS / 256;

constexpr size_t MiB = (size_t)1 << 20;
constexpr size_t al(size_t x) { return (x + 255) & ~(size_t)255; }
constexpr size_t WS_CTL = 0, CTL_BYTES = 4 * MiB;
constexpr size_t WS_WIN = WS_CTL + CTL_BYTES;
constexpr size_t WS_WV = WS_WIN + al((size_t)DEPTH * HQP * D * 2);
constexpr size_t WS_WOUT = WS_WV + al((size_t)DEPTH * 1024 * D * 2);
constexpr size_t WS_WGU = WS_WOUT + al((size_t)DEPTH * D * 1024 * 2);
constexpr size_t WS_WDN = WS_WGU + al((size_t)DEPTH * NE * 2048 * D * 2);
constexpr size_t WS_XB = WS_WDN + al((size_t)DEPTH * NE * D * 1024 * 2);
constexpr size_t WS_XF = WS_XB + al((size_t)T * D * 2);
constexpr size_t WS_HQ = WS_XF + al((size_t)T * D * 4);
constexpr size_t WS_VT = WS_HQ + al((size_t)T * HQP * 2);
constexpr size_t WS_MIX = WS_VT + al((size_t)1024 * T * 2);
constexpr size_t WS_Y1 = WS_MIX + al((size_t)T * 1024 * 2);
constexpr size_t WS_X1F = WS_Y1 + al((size_t)T * D * 4);
constexpr size_t WS_X1B = WS_X1F + al((size_t)T * D * 4);
constexpr size_t WS_ACT = WS_X1B + al((size_t)T * D * 2);
constexpr size_t WS_YR = WS_ACT + al((size_t)GROWS * 1024 * 2);
constexpr size_t WS_MASK = WS_YR + al((size_t)GROWS * 1024 * 2);
constexpr size_t WS_TOKL = WS_MASK + al((size_t)T * 32 * 8);
constexpr size_t WS_ASGE = WS_TOKL + al((size_t)NE * T * 4);
constexpr size_t WS_ASGS = WS_ASGE + al((size_t)NASG * 4);
constexpr size_t WS_GATE = WS_ASGS + al((size_t)NASG * 4);
constexpr size_t WS_OA1 = WS_GATE + al((size_t)NASG * 4);
constexpr size_t WS_END = WS_OA1 + al((size_t)T * 512 * 4);
constexpr int CW_BAR = 4096;
constexpr int CW_CNT = 262144;

__device__ __forceinline__ unsigned pk_bf16(float lo, float hi) { f32x2 v = {lo, hi}; return __builtin_bit_cast(unsigned, __builtin_convertvector(v, bf16v2)); }
__device__ __forceinline__ float bf_lo(unsigned u) { return __uint_as_float(u << 16); }
__device__ __forceinline__ float bf_hi(unsigned u) { return __uint_as_float(u & 0xffff0000u); }
__device__ __forceinline__ float bf2f(bf16_t b) { return __uint_as_float(((unsigned)b) << 16); }
__device__ __forceinline__ float wave_sum(float v) {
#pragma unroll
    for (int o = 32; o > 0; o >>= 1) v += __shfl_xor(v, o);
    return v; }
__device__ __forceinline__ float wave_max(float v) {
#pragma unroll
    for (int o = 32; o > 0; o >>= 1) v = fmaxf(v, __shfl_xor(v, o));
    return v; }
__device__ __forceinline__ int wave_sum_i(int v) {
#pragma unroll
    for (int o = 32; o > 0; o >>= 1) v += __shfl_xor(v, o);
    return v; }

__device__ __forceinline__ float shx(float v, int o, int lane) { return __int_as_float(__builtin_amdgcn_ds_bpermute((lane ^ o) << 2, __float_as_int(v))); }
__device__ __forceinline__ float wsum(float v, int lane) {
#pragma unroll
    for (int o = 32; o > 0; o >>= 1) v += shx(v, o, lane);
    return v; }
__device__ __forceinline__ float wmax(float v, int lane) {
#pragma unroll
    for (int o = 32; o > 0; o >>= 1) v = fmaxf(v, shx(v, o, lane));
    return v; }

#define XB_TMO      128
#define XB_XCNT(j)  (256  + 64 * (j))
#define XB_XSUB(j)  (1280 + 64 * (j))
#define XB_XGEN(j)  (2304 + 64 * (j))
#define XB_TOP      3328
#define XB_TOPGEN   3392
#define XCD_BAR_WORDS 3456
#define XB_SPIN_CAP (1u << 22)
__device__ __forceinline__ unsigned xb_ld(unsigned* p)              { return __hip_atomic_load(p, __ATOMIC_RELAXED, __HIP_MEMORY_SCOPE_AGENT); }
__device__ __forceinline__ unsigned xb_add(unsigned* p, unsigned v) { return __hip_atomic_fetch_add(p, v, __ATOMIC_RELAXED, __HIP_MEMORY_SCOPE_AGENT); }
__device__ __forceinline__ unsigned xb_xcc_id() { return (unsigned)__builtin_amdgcn_s_getreg((3 << 11) | 20) & 0xFu; }
#define XB_SPIN(cond, bar) do { unsigned _sp = 0; while (cond) { __builtin_amdgcn_s_sleep(1); \
    if ((++_sp & 255u) == 0u) { if (xb_ld(&(bar)[XB_TMO])) break; if (_sp > XB_SPIN_CAP) { atomicAdd(&(bar)[XB_TMO], 1u); break; } } } } while (0)
struct XcdBarrier { unsigned* bar; unsigned x; volatile LAS unsigned* st; };
__device__ __forceinline__ XcdBarrier xcd_barrier_post(unsigned* bar, volatile LAS unsigned* st) {
    XcdBarrier b; b.bar = bar; b.x = xb_xcc_id(); b.st = st;
    if (threadIdx.x == 0) (void)xb_add(&bar[XB_XCNT(b.x)], 1u);
    return b;
}
__device__ __forceinline__ void xcd_barrier_complete(unsigned* bar, unsigned x, unsigned& nloc, unsigned& nx) {
    const unsigned G = gridDim.x * gridDim.y * gridDim.z;
    unsigned sum, cnt, mine, sp = 0u;
    for (;;) {
        sum = 0u; cnt = 0u; mine = 0u;
#pragma unroll
        for (unsigned j = 0; j < 16; ++j) { const unsigned c = xb_ld(&bar[XB_XCNT(j)]); sum += c; cnt += (c > 0u) ? 1u : 0u; mine = (j == x) ? c : mine; }
        if (sum == G) break;
        __builtin_amdgcn_s_sleep(1);
        if ((++sp & 255u) == 0u) { if (xb_ld(&bar[XB_TMO])) break; if (sp > XB_SPIN_CAP) { atomicAdd(&bar[XB_TMO], 1u); break; } }
    }
    nloc = mine > 0u ? mine : 1u; nx = cnt > 0u ? cnt : 1u;
}
__device__ __forceinline__ void xcd_barrier(const XcdBarrier& b) {
    asm volatile("s_waitcnt vmcnt(0)" ::: "memory");
    __syncthreads();
    if (threadIdx.x == 0) {
        unsigned* bar = b.bar;
        __builtin_amdgcn_s_waitcnt(0);
        unsigned nloc = b.st[0], nx = b.st[1];
        if (nloc == 0u) { xcd_barrier_complete(bar, b.x, nloc, nx); b.st[0] = nloc; b.st[1] = nx; }
        const unsigned old = xb_add(&bar[XB_XSUB(b.x)], 1u);
        const unsigned gen = old / nloc;
        if (old + 1u == (gen + 1u) * nloc) {
            __builtin_amdgcn_fence(__ATOMIC_RELEASE, "agent");
            asm volatile("s_waitcnt vmcnt(0)" ::: "memory");
            const unsigned og = xb_add(&bar[XB_TOP], 1u);
            const unsigned tg = og / nx;
            if (og + 1u == (tg + 1u) * nx) xb_add(&bar[XB_TOPGEN], 1u);
            else XB_SPIN(xb_ld(&bar[XB_TOPGEN]) == tg, bar);
            __builtin_amdgcn_fence(__ATOMIC_ACQUIRE, "agent");
            xb_add(&bar[XB_XGEN(b.x)], 1u);
            asm volatile("s_waitcnt vmcnt(0)" ::: "memory");
        } else {
            XB_SPIN(xb_ld(&bar[XB_XGEN(b.x)]) == gen, bar);
            __builtin_amdgcn_fence(__ATOMIC_ACQUIRE, "agent");
            asm volatile("s_waitcnt vmcnt(0)" ::: "memory");
        }
    }
    __syncthreads();
}

namespace pg8 {
constexpr int BM = 256, BK = 64, HALF = 128, HTB = HALF * BK * 2, STAGE_BYTES = 8 * HTB;
__host__ __device__ __forceinline__ int lds_byte(int r, int c) { const int st = (r >> 4) * 2 + (c >> 5), rr = r & 15, cc = c & 31, ob = rr * 64 + cc * 2; return st * 1024 + (ob ^ (((ob >> 9) & 1) << 5)); }
__host__ __device__ __forceinline__ void stage_rc(int b, int& R, int& C) { const int st = b / 1024, sb = b % 1024, swz = sb ^ (((sb >> 9) & 1) << 5); R = (st >> 1) * 16 + swz / 64; C = (st & 1) * 32 + (swz % 64) / 2; }
__host__ __device__ __forceinline__ int perm32(int rho) { const int n = rho >> 4, i = rho & 15; return 8 * (i >> 2) + 4 * n + (i & 3); }

struct Unit {
    int row0;
    int col0;
    const char* Bt;
    const int* rows;
    int nvalid;
    int e;
};

template <class Epi, class Sched, bool GATHER>
__device__ __forceinline__ void gemm_phase(LAS unsigned char* lds, const bf16_t* Abase, const int K, const Sched& S, const Epi& E, const int wid) {
    int lane; asm volatile("v_mbcnt_lo_u32_b32 %0, -1, 0\n\tv_mbcnt_hi_u32_b32 %0, -1, %0" : "=&v"(lane));
    const int tid = wid * 64 + lane, wr = wid >> 2, wc = wid & 3, fr = lane & 15, fq = lane >> 4;
    const int nt = K / BK;
    int Rl[2], Cl[2]; unsigned voffB[2];
#pragma unroll
    for (int i = 0; i < 2; ++i) { int R, C; stage_rc(tid * 16 + i * 8192, R, C); Rl[i] = R; Cl[i] = C; const int Rb = Epi::PERM ? ((R & ~31) + perm32(R & 31)) : R; voffB[i] = (unsigned)(Rb * K + C) * 2u; }
    const size_t kstep = (size_t)(BK * 2);
    const size_t hstep = (size_t)HALF * K * 2;
    const unsigned ldsw = (unsigned)wid * 1024u;
    const int aoff = lds_byte(wr * 64 + fr, fq * 8), boff = lds_byte(wc * 32 + fr, fq * 8);
#define PG8_SA(b, h) (((b) * 2 + (h)) * HTB)
#define PG8_SB(b, h) ((4 + (b) * 2 + (h)) * HTB)
#define PG8_STAGE(bufoff, gbase, voff) do { _Pragma("unroll") for (int _i = 0; _i < 2; ++_i) \
        __builtin_amdgcn_global_load_lds((const unsigned*)((const char*)(gbase) + (voff)[_i]), (LAS unsigned*)(lds + (bufoff) + ldsw + _i * 8192), 16, 0, 0); } while (0)
#define PG8_LDA(dst, b, h) do { _Pragma("unroll") for (int m = 0; m < 4; ++m) _Pragma("unroll") for (int k = 0; k < 2; ++k) dst[m][k] = *(const LAS bf16x8*)(lds + PG8_SA(b, h) + aoff + m * 2048 + k * 1024); } while (0)
#define PG8_LDB(dst, b, h) do { _Pragma("unroll") for (int n = 0; n < 2; ++n) _Pragma("unroll") for (int k = 0; k < 2; ++k) dst[n][k] = *(const LAS bf16x8*)(lds + PG8_SB(b, h) + boff + n * 2048 + k * 1024); } while (0)
#define PG8_MMA(ai, bj, At, Bt) do { __builtin_amdgcn_s_setprio(1); _Pragma("unroll") for (int m = 0; m < 4; ++m) _Pragma("unroll") for (int n = 0; n < 2; ++n) _Pragma("unroll") for (int k = 0; k < 2; ++k) \
        acc[ai][bj][m][n] = __builtin_amdgcn_mfma_f32_16x16x32_bf16(Bt[n][k], At[m][k], acc[ai][bj][m][n], 0, 0, 0); __builtin_amdgcn_s_setprio(0); } while (0)
#define PG8_WAIT_V(n) asm volatile("s_waitcnt vmcnt(" #n ")" ::: "memory")
#define PG8_WAIT_L(n) asm volatile("s_waitcnt lgkmcnt(" #n ")" ::: "memory")
#define PG8_BAR __builtin_amdgcn_s_barrier()
#define PG8_SCHED __builtin_amdgcn_sched_barrier(0)
#define PG8_AOFFS(dst, u) do { _Pragma("unroll") for (int _h = 0; _h < 2; ++_h) _Pragma("unroll") for (int _i = 0; _i < 2; ++_i) { \
        int _src; if (GATHER) { const int _r = _h * HALF + Rl[_i]; _src = (_r < (u).nvalid) ? (u).rows[_r] : 0; } else _src = (u).row0 + _h * HALF + Rl[_i]; \
        dst[_h][_i] = (unsigned)(_src * K + Cl[_i]) * 2u; } } while (0)
    Unit cur, nxt; int ui = 0;
    if (!S.next(0, cur)) return;
    f32x4 acc[2][2][4][2];
#pragma unroll
    for (int a = 0; a < 2; ++a)
#pragma unroll
        for (int b = 0; b < 2; ++b)
#pragma unroll
            for (int m = 0; m < 4; ++m)
#pragma unroll
                for (int n = 0; n < 2; ++n) acc[a][b][m][n] = (f32x4){0.f, 0.f, 0.f, 0.f};
    bf16x8 At[4][2], B0[2][2], B1[2][2];
    unsigned oa[2][2], na[2][2];
    PG8_AOFFS(oa, cur);
    const char* cA = (const char*)Abase; const char* cB = cur.Bt;
    PG8_STAGE(PG8_SB(0, 0), cB, voffB); PG8_STAGE(PG8_SB(0, 1), cB + hstep, voffB); PG8_STAGE(PG8_SA(0, 0), cA, oa[0]); PG8_STAGE(PG8_SA(0, 1), cA, oa[1]);
    if (wr == 1) PG8_BAR;
    PG8_WAIT_V(2); PG8_BAR;
    PG8_STAGE(PG8_SB(1, 0), cB + kstep, voffB); PG8_STAGE(PG8_SA(1, 0), cA + kstep, oa[0]); PG8_STAGE(PG8_SB(1, 1), cB + hstep + kstep, voffB);
    PG8_WAIT_V(6); PG8_BAR;
    for (;;) {
        const bool has_next = S.next(ui + 1, nxt);
        if (has_next) { PG8_AOFFS(na, nxt); if (GATHER) asm volatile("" : "+v"(na[0][0]), "+v"(na[0][1]), "+v"(na[1][0]), "+v"(na[1][1])); }
        else {
#pragma unroll
            for (int h = 0; h < 2; ++h)
#pragma unroll
                for (int i = 0; i < 2; ++i) na[h][i] = oa[h][i];
        }
        const char* nB = has_next ? nxt.Bt : cB;
        for (int t = 0; t < nt; t += 2) {
            const bool last = (t == nt - 2);
            const char* a1 = cA + (size_t)(t + 1) * kstep;
            const char* a2 = last ? cA : cA + (size_t)(t + 2) * kstep; const char* b2 = last ? nB : cB + (size_t)(t + 2) * kstep;
            const char* a3 = a2 + kstep; const char* b3 = b2 + kstep;
            unsigned sa[2][2];
#pragma unroll
            for (int h = 0; h < 2; ++h)
#pragma unroll
                for (int i = 0; i < 2; ++i) sa[h][i] = last ? na[h][i] : oa[h][i];
            PG8_LDB(B0, 0, 0); PG8_LDB(B1, 0, 1); PG8_SCHED; PG8_LDA(At, 0, 0); PG8_STAGE(PG8_SA(1, 1), a1, oa[1]);
            PG8_WAIT_V(8); PG8_WAIT_L(0); PG8_BAR; PG8_MMA(0, 0, At, B0); PG8_MMA(0, 1, At, B1); PG8_BAR; PG8_SCHED;
            PG8_LDA(At, 0, 1); PG8_STAGE(PG8_SB(0, 0), b2, voffB); PG8_STAGE(PG8_SB(0, 1), b2 + hstep, voffB); PG8_STAGE(PG8_SA(0, 0), a2, sa[0]);
            PG8_WAIT_V(8); PG8_WAIT_L(0); PG8_BAR; PG8_MMA(1, 0, At, B0); PG8_MMA(1, 1, At, B1); PG8_BAR; PG8_SCHED;
            PG8_LDB(B0, 1, 0); PG8_LDB(B1, 1, 1); PG8_SCHED; PG8_LDA(At, 1, 0); PG8_STAGE(PG8_SA(0, 1), a2, sa[1]);
            PG8_WAIT_V(8); PG8_WAIT_L(0); PG8_BAR; PG8_MMA(0, 0, At, B0); PG8_MMA(0, 1, At, B1); PG8_BAR; PG8_SCHED;
            PG8_LDA(At, 1, 1); PG8_STAGE(PG8_SB(1, 0), b3, voffB); PG8_STAGE(PG8_SB(1, 1), b3 + hstep, voffB); PG8_STAGE(PG8_SA(1, 0), a3, sa[0]);
            PG8_WAIT_V(8); PG8_WAIT_L(0); PG8_BAR; PG8_MMA(1, 0, At, B0); PG8_MMA(1, 1, At, B1); PG8_BAR; PG8_SCHED;
        }
        if (wr == 0) PG8_BAR;
        E(acc, cur, wr, wc, fr, fq);
        if (!has_next) break;
#pragma unroll
        for (int a = 0; a < 2; ++a)
#pragma unroll
            for (int b = 0; b < 2; ++b)
#pragma unroll
                for (int m = 0; m < 4; ++m)
#pragma unroll
                    for (int n = 0; n < 2; ++n) acc[a][b][m][n] = (f32x4){0.f, 0.f, 0.f, 0.f};
        cur = nxt; cB = nB; ++ui;
#pragma unroll
        for (int h = 0; h < 2; ++h)
#pragma unroll
            for (int i = 0; i < 2; ++i) oa[h][i] = na[h][i];
        if (wr == 1) PG8_BAR;
    }
    PG8_WAIT_V(0);
    PG8_BAR;
#undef PG8_SA
#undef PG8_SB
#undef PG8_STAGE
#undef PG8_LDA
#undef PG8_LDB
#undef PG8_MMA
#undef PG8_WAIT_V
#undef PG8_WAIT_L
#undef PG8_BAR
#undef PG8_SCHED
#undef PG8_AOFFS
}

struct DenseOrder {
    int nRT, nN, G, c; const char* Bt; int K; bool swap;
    __device__ __forceinline__ bool next(int i, Unit& u) const {
        const int xcd = c & 7, s = i * (G >> 3) + (c >> 3);
        int rt, pn;
        if (!swap) { rt = 8 * (s / nN) + xcd; pn = s % nN; } else { pn = 8 * (s / nRT) + xcd; rt = s % nRT; }
        if (rt >= nRT || pn >= nN) return false;
        u.row0 = rt * BM; u.col0 = pn * BM; u.Bt = Bt + (size_t)pn * BM * K * 2; u.rows = nullptr; u.nvalid = 0; u.e = 0; return true;
    }
};
struct MoeTables { LAS const int* tstart; LAS const int* cnt; LAS const unsigned char* tile_e; int nrt; };
struct MoeOrder {
    MoeTables tb; int nN, G, c; const char* Bt; size_t strideB; const int* tokl; bool gather;
    __device__ __forceinline__ bool next(int i, Unit& u) const {
        const int xcd = c & 7, s = i * (G >> 3) + (c >> 3);
        const int q = 8 * (s / nN) + xcd, pn = s % nN;
        if (q >= tb.nrt) return false;
        const int e = tb.tile_e[q]; const int lt = q - tb.tstart[e];
        u.row0 = q * BM; u.col0 = pn * BM; u.e = e; u.Bt = Bt + (size_t)e * strideB + (size_t)pn * BM * 1024 * 2;
        u.rows = gather ? tokl + (size_t)e * T + lt * BM : nullptr; u.nvalid = tb.cnt[e] - lt * BM; return true;
    }
};

struct EpiBf16Plain {
    static constexpr bool PERM = true;
    bf16_t* O; int ldc;
    __device__ __forceinline__ void operator()(const f32x4 (&acc)[2][2][4][2], const Unit& u, int wr, int wc, int fr, int fq) const {
        const int row0 = u.row0 + wr * 64 + fr, col0 = u.col0 + wc * 32 + 8 * fq;
#pragma unroll
        for (int ai = 0; ai < 2; ++ai)
#pragma unroll
            for (int m = 0; m < 4; ++m) { bf16_t* rowp = O + (size_t)(row0 + ai * HALF + m * 16) * ldc + col0;
#pragma unroll
                for (int bj = 0; bj < 2; ++bj) { const f32x4 v0 = acc[ai][bj][m][0], v1 = acc[ai][bj][m][1];
                    u32x4 w; w.x = pk_bf16(v0[0], v0[1]); w.y = pk_bf16(v0[2], v0[3]); w.z = pk_bf16(v1[0], v1[1]); w.w = pk_bf16(v1[2], v1[3]);
                    *(u32x4*)(rowp + bj * HALF) = w; } }
    }
};
struct EpiResF32 {
    static constexpr bool PERM = false;
    float* C; const float* R;
    __device__ __forceinline__ void operator()(const f32x4 (&acc)[2][2][4][2], const Unit& u, int wr, int wc, int fr, int fq) const {
        const int row0 = u.row0 + wr * 64 + fr, col0 = u.col0 + wc * 32 + 4 * fq;
#pragma unroll
        for (int ai = 0; ai < 2; ++ai)
#pragma unroll
            for (int m = 0; m < 4; ++m) { const size_t off = (size_t)(row0 + ai * HALF + m * 16) * 1024 + col0;
#pragma unroll
                for (int bj = 0; bj < 2; ++bj)
#pragma unroll
                    for (int n = 0; n < 2; ++n) { const f32x4 r = *(const f32x4*)(R + off + bj * HALF + n * 16); *(f32x4*)(C + off + bj * HALF + n * 16) = r * ALPHA + acc[ai][bj][m][n]; } }
    }
};
struct EpiSwiglu {
    static constexpr bool PERM = true;
    bf16_t* O; const float* bias;
    __device__ __forceinline__ void operator()(const f32x4 (&acc)[2][2][4][2], const Unit& u, int wr, int wc, int fr, int fq) const {
        const int row0 = u.row0 + wr * 64 + fr, oc = (u.col0 >> 1) + wc * 32 + 8 * fq;
        const float* bp = bias + (size_t)u.e * 2048 + oc;
        f32x4 bg[2], bu[2];
#pragma unroll
        for (int n = 0; n < 2; ++n) { bg[n] = *(const f32x4*)(bp + 4 * n); bu[n] = *(const f32x4*)(bp + 1024 + 4 * n); }
#pragma unroll
        for (int ai = 0; ai < 2; ++ai)
#pragma unroll
            for (int m = 0; m < 4; ++m) {
                float o[8];
#pragma unroll
                for (int n = 0; n < 2; ++n) { const f32x4 g4 = acc[ai][0][m][n] + bg[n], u4 = acc[ai][1][m][n] + bu[n];
#pragma unroll
                    for (int j = 0; j < 4; ++j) { const float g = fminf(g4[j], 7.0f), up = fminf(fmaxf(u4[j], -7.0f), 7.0f);
                        const float glu = g * __builtin_amdgcn_rcpf(1.0f + __builtin_amdgcn_exp2f(-1.702f * LOG2E * g)); o[4 * n + j] = (up + 1.0f) * glu; } }
                u32x4 w; w.x = pk_bf16(o[0], o[1]); w.y = pk_bf16(o[2], o[3]); w.z = pk_bf16(o[4], o[5]); w.w = pk_bf16(o[6], o[7]);
                *(u32x4*)(O + (size_t)(row0 + ai * HALF + m * 16) * 1024 + oc) = w; }
    }
};
struct EpiBiasBf16 {
    static constexpr bool PERM = true;
    bf16_t* O; const float* bias;
    __device__ __forceinline__ void operator()(const f32x4 (&acc)[2][2][4][2], const Unit& u, int wr, int wc, int fr, int fq) const {
        const int row0 = u.row0 + wr * 64 + fr, col0 = u.col0 + wc * 32 + 8 * fq;
        const float* bp = bias + (size_t)u.e * 1024 + col0;
        f32x4 bv[2][2];
#pragma unroll
        for (int bj = 0; bj < 2; ++bj)
#pragma unroll
            for (int n = 0; n < 2; ++n) bv[bj][n] = *(const f32x4*)(bp + bj * HALF + 4 * n);
#pragma unroll
        for (int ai = 0; ai < 2; ++ai)
#pragma unroll
            for (int m = 0; m < 4; ++m) { bf16_t* rowp = O + (size_t)(row0 + ai * HALF + m * 16) * 1024 + col0;
#pragma unroll
                for (int bj = 0; bj < 2; ++bj) { const f32x4 v0 = acc[ai][bj][m][0] + bv[bj][0], v1 = acc[ai][bj][m][1] + bv[bj][1];
                    u32x4 w; w.x = pk_bf16(v0[0], v0[1]); w.y = pk_bf16(v0[2], v0[3]); w.z = pk_bf16(v1[0], v1[1]); w.w = pk_bf16(v1[2], v1[3]);
                    *(u32x4*)(rowp + bj * HALF) = w; } }
    }
};
}


#ifndef ATT_EN
#define ATT_EN 7
#endif
typedef float f32x16 __attribute__((ext_vector_type(16)));
#define MFMA32(a, b, c) __builtin_amdgcn_mfma_f32_32x32x16_bf16((a), (b), (c), 0, 0, 0)
constexpr int ATT_BUF = 27648;
constexpr int ATT_RELB = 2 * ATT_BUF;
#define NEG_INF_F (-__builtin_huge_valf())

template <int MODE>
__device__ __forceinline__ void attn_unit(LAS unsigned char* lds, const bf16_t* HQ, const bf16_t* VT, bf16_t* MIX, const unsigned long long* MASK, float* OA1,
                                          const int b, const int h, const int qt, const int wave, const int lane_unused,
                                          const float lam, const float lam_init, const float* subg, const float* relb) {
    constexpr int NPASS = (MODE == 0) ? 2 : 1;
    constexpr int EB = (MODE == 0) ? 4 : 2;
    constexpr int KSTR = 144;
    constexpr int VOFF = 64 * KSTR;
    constexpr int NCHV = (MODE == 0) ? 2 : 1;
    const int qoff = (MODE == 0) ? HQ_QA + h * 128 : (MODE == 1) ? HQ_QB + h * 64 : HQ_QC + h * 64;
    const int koff = (MODE == 0) ? HQ_KA + h * 128 : (MODE == 1) ? HQ_KB + h * 64 : HQ_KC + h * 64;
    const int vrow0 = (MODE == 0) ? VT_A + h * 128 : (MODE == 1) ? VT_B + h * 64 : VT_C + h * 64;
    const int mixcol = (MODE == 0) ? h * 128 : (MODE == 1) ? 512 + h * 64 : 768 + h * 64;
    int lane; asm volatile("v_mbcnt_lo_u32_b32 %0, -1, 0\n\tv_mbcnt_hi_u32_b32 %0, -1, %0" : "=&v"(lane));
    const int tid = wave * 64 + lane, ql = lane & 31, hb = lane >> 5;
    const int cq = qt * 4 + (wave >> 1);
    const int tq = qt * 256 + wave * 32 + ql;
    const int kt_hi = qt * 4 + 3;
    const int kt_lo = (MODE == 1) ? ((qt * 4 - 8) > 0 ? (qt * 4 - 8) : 0) : 0;
    const float slope2 = (MODE == 0) ? exp2f(-(float)(2 * h + 1)) * LOG2E : exp2f(-(float)(2 * h + 2)) * LOG2E;
    LAS float* relb_l = (LAS float*)(lds + ATT_RELB);
    const int prow = (ql & 16) | ((ql & 4) << 1) | ((ql & 8) >> 1) | (ql & 3);
    const int krow = tid >> 3, kc = tid & 7;
#pragma unroll 1
    for (int mp = 0; mp < NPASS; ++mp) {
        bf16x8 Q[4];
        { const bf16_t* qp = HQ + (size_t)(b * SEQ + tq) * HQP + qoff + mp * 64 + hb * 8;
#pragma unroll
          for (int ks = 0; ks < 4; ++ks) Q[ks] = *(const bf16x8*)(qp + ks * 16); }
        f32x16 O[EB];
        float mrun = -1e30f, lrun = 0.f;
#pragma unroll
        for (int eb = 0; eb < EB; ++eb)
#pragma unroll
            for (int i = 0; i < 16; ++i) O[eb][i] = 0.f;
        u32x4 kreg, vreg[NCHV];
#define ATT_LOAD(kt_) do { kreg = *(const u32x4*)(HQ + (size_t)(b * SEQ + (kt_) * 64 + krow) * HQP + koff + mp * 64 + kc * 8); \
        _Pragma("unroll") for (int j = 0; j < NCHV; ++j) vreg[j] = *(const u32x4*)(VT + (size_t)(vrow0 + krow + 64 * j) * T + (size_t)b * SEQ + (kt_) * 64 + kc * 8); } while (0)
#define ATT_STORE(buf_) do { *(LAS u32x4*)(lds + (buf_) * ATT_BUF + krow * KSTR + kc * 16) = kreg; \
        _Pragma("unroll") for (int j = 0; j < NCHV; ++j) *(LAS u32x4*)(lds + (buf_) * ATT_BUF + VOFF + (krow + 64 * j) * 144 + kc * 16) = vreg[j]; } while (0)

        __syncthreads();
        if (MODE == 1) { for (int i = tid; i < 257; i += 512) relb_l[i] = relb[i] * LOG2E; }
        ATT_LOAD(kt_hi); ATT_STORE(0);
        __syncthreads();
        int buf = 0;
        for (int kt = kt_hi; kt >= kt_lo; --kt) {
            if (kt > kt_lo) ATT_LOAD(kt - 1);
            const bool active = (kt <= cq) && (MODE != 1 || kt >= cq - 8);
            if (active) {
                const LAS unsigned char* kbp = lds + buf * ATT_BUF + prow * KSTR + hb * 16;
                const LAS unsigned char* vbp = lds + buf * ATT_BUF + VOFF + ql * 144 + hb * 16;
                f32x16 S0, S1;
#pragma unroll
                for (int i = 0; i < 16; ++i) { S0[i] = 0.f; S1[i] = 0.f; }
#pragma unroll
                for (int ks = 0; ks < 4; ++ks) {
                    const bf16x8 k0 = *(const LAS bf16x8*)(kbp + ks * 32);
                    const bf16x8 k1 = *(const LAS bf16x8*)(kbp + 32 * KSTR + ks * 32);
                    S0 = MFMA32(k0, Q[ks], S0); S1 = MFMA32(k1, Q[ks], S1);
                    if (ks & 1) __builtin_amdgcn_sched_barrier(0);
                }
                if (MODE == 0 || MODE == 2) {
                    const float base0 = (float)(tq - kt * 64 - 8 * hb), base1 = base0 - 32.0f;
#pragma unroll
                    for (int i = 0; i < 16; ++i) { const float off = (float)(16 * (i >> 3) + (i & 7));
                        S0[i] = S0[i] - slope2 * fabsf(base0 - off); S1[i] = S1[i] - slope2 * fabsf(base1 - off); }
                }
                if (MODE == 2) {
                    const unsigned long long W = MASK[(size_t)(b * SEQ + tq) * 32 + kt];
                    const unsigned w0 = (unsigned)W >> (8 * hb), w1 = (unsigned)(W >> 32) >> (8 * hb);
#pragma unroll
                    for (int i = 0; i < 16; ++i) { const int off = 16 * (i >> 3) + (i & 7);
                        S0[i] = ((w0 >> off) & 1u) ? S0[i] : NEG_INF_F; S1[i] = ((w1 >> off) & 1u) ? S1[i] : NEG_INF_F; }
                }
                if (MODE == 1) {
                    if (kt >= cq - 2) {
                        const int rel0 = tq - kt * 64 - 8 * hb + 128;
#pragma unroll
                        for (int i = 0; i < 16; ++i) { const int off = 16 * (i >> 3) + (i & 7);
                            int r0 = rel0 - off, r1 = rel0 - 32 - off;
                            r0 = r0 < 0 ? 0 : (r0 > 256 ? 256 : r0); r1 = r1 < 0 ? 0 : (r1 > 256 ? 256 : r1);
                            S0[i] += relb_l[r0]; S1[i] += relb_l[r1]; }
                    } else {
                        const float far = relb_l[256];
#pragma unroll
                        for (int i = 0; i < 16; ++i) { S0[i] += far; S1[i] += far; }
                    }
                }
                float mx = fmaxf(S0[0], S1[0]);
#pragma unroll
                for (int i = 1; i < 16; ++i) mx = fmaxf(mx, fmaxf(S0[i], S1[i]));
                mx = fmaxf(mx, shx(mx, 32, lane));
                const float mnew = fmaxf(mrun, mx);
                const float alpha = __builtin_amdgcn_exp2f(mrun - mnew);
                mrun = mnew;
                float ps = 0.f;
#pragma unroll
                for (int i = 0; i < 16; ++i) { S0[i] = __builtin_amdgcn_exp2f(S0[i] - mnew); S1[i] = __builtin_amdgcn_exp2f(S1[i] - mnew); ps += S0[i] + S1[i]; }
                lrun = lrun * alpha + ps;
#pragma unroll
                for (int eb = 0; eb < EB; ++eb) O[eb] = O[eb] * alpha;
                bf16x8 P[4];
                { u32x4 p;
                  p.x = pk_bf16(S0[0], S0[1]); p.y = pk_bf16(S0[2], S0[3]); p.z = pk_bf16(S0[4], S0[5]); p.w = pk_bf16(S0[6], S0[7]); P[0] = __builtin_bit_cast(bf16x8, p);
                  p.x = pk_bf16(S0[8], S0[9]); p.y = pk_bf16(S0[10], S0[11]); p.z = pk_bf16(S0[12], S0[13]); p.w = pk_bf16(S0[14], S0[15]); P[1] = __builtin_bit_cast(bf16x8, p);
                  p.x = pk_bf16(S1[0], S1[1]); p.y = pk_bf16(S1[2], S1[3]); p.z = pk_bf16(S1[4], S1[5]); p.w = pk_bf16(S1[6], S1[7]); P[2] = __builtin_bit_cast(bf16x8, p);
                  p.x = pk_bf16(S1[8], S1[9]); p.y = pk_bf16(S1[10], S1[11]); p.z = pk_bf16(S1[12], S1[13]); p.w = pk_bf16(S1[14], S1[15]); P[3] = __builtin_bit_cast(bf16x8, p); }
#pragma unroll
                for (int s4 = 0; s4 < 4; ++s4)
#pragma unroll
                    for (int eb = 0; eb < EB; ++eb) {
                        const bf16x8 vf = *(const LAS bf16x8*)(vbp + eb * 32 * 144 + s4 * 32);
                        O[eb] = MFMA32(vf, P[s4], O[eb]);
                        if (eb & 1) __builtin_amdgcn_sched_barrier(0);
                    }
            }
            if (kt > kt_lo) ATT_STORE(buf ^ 1);
            __syncthreads();
            buf ^= 1;
        }
#undef ATT_LOAD
#undef ATT_STORE
        const float inv = 1.0f / (lrun + shx(lrun, 32, lane));
        bf16_t* op = MIX + (size_t)(b * SEQ + tq) * 1024 + mixcol + 4 * hb;
        if (MODE == 0) {
            float* o1p = OA1 + (size_t)(b * SEQ + tq) * 512 + h * 128 + 4 * hb;
            if (mp == 0) {
#pragma unroll
                for (int eb = 0; eb < EB; ++eb)
#pragma unroll
                    for (int g = 0; g < 4; ++g) *(f32x4*)(o1p + eb * 32 + 8 * g) = (f32x4){O[eb][4 * g] * inv, O[eb][4 * g + 1] * inv, O[eb][4 * g + 2] * inv, O[eb][4 * g + 3] * inv};
            } else {
                const float c2 = lam * inv;
                float ss = 0.f;
#pragma unroll
                for (int eb = 0; eb < EB; ++eb)
#pragma unroll
                    for (int g = 0; g < 4; ++g) { const f32x4 o1 = *(const f32x4*)(o1p + eb * 32 + 8 * g);
#pragma unroll
                        for (int j = 0; j < 4; ++j) { const float o = o1[j] - O[eb][4 * g + j] * c2; O[eb][4 * g + j] = o; ss += o * o; } }
                ss += shx(ss, 32, lane);
                const float r = rsqrtf(ss * (1.0f / 128.0f) + EPS) * (1.0f - lam_init);
#pragma unroll
                for (int eb = 0; eb < EB; ++eb)
#pragma unroll
                    for (int g = 0; g < 4; ++g) { const int e0 = eb * 32 + 8 * g; const f32x4 sg = *(const f32x4*)(subg + e0 + 4 * hb);
                        *(u32x2*)(op + e0) = (u32x2){pk_bf16(O[eb][4 * g] * r * sg[0], O[eb][4 * g + 1] * r * sg[1]), pk_bf16(O[eb][4 * g + 2] * r * sg[2], O[eb][4 * g + 3] * r * sg[3])}; }
            }
        } else {
#pragma unroll
            for (int eb = 0; eb < EB; ++eb)
#pragma unroll
                for (int g = 0; g < 4; ++g) { const int e0 = eb * 32 + 8 * g;
                    *(u32x2*)(op + e0) = (u32x2){pk_bf16(O[eb][4 * g] * inv, O[eb][4 * g + 1] * inv), pk_bf16(O[eb][4 * g + 2] * inv, O[eb][4 * g + 3] * inv)}; }
        }
    }
}

struct Args {
    const float* x; const float* w_in; const float* lam_q1; const float* lam_k1; const float* lam_q2; const float* lam_k2; const float* subln_g; const float* rel_bias;
    const float* w_out; const float* ln1_g; const float* ln1_b; const float* w_router; const float* b_router; const float* w_gu; const float* b_gu;
    const float* w_down; const float* b_down; const float* ln2_g; const float* ln2_b;
    float* out; unsigned char* ws;
    int ph_lo, ph_hi, bar_region, pad;
};

constexpr int LDS_STAGE = 0;
constexpr int LDS_CTL = 131072;
constexpr int LDS_TSTART = LDS_CTL + 64;
constexpr int LDS_CNT = LDS_TSTART + 36 * 4;
constexpr int LDS_TILEE = LDS_CNT + 32 * 4;
constexpr int LDS_RT = LDS_TILEE + 576;
constexpr int LDS_BYTES = 147456;
static_assert(LDS_RT + (64 + 1024) * 4 <= LDS_BYTES, "LDS map");

__device__ __forceinline__ void transpose_item(const float* W, int N, int k0, int n0, int nvalid, bf16_t* WTrow0, float scale, LAS float* scr, int lane) {
#pragma unroll 8
    for (int i = 0; i < 32; ++i) { const int kk = 2 * i + (lane >> 5), col = lane & 31; scr[kk * 33 + col] = (col < nvalid) ? W[(size_t)(k0 + kk) * N + n0 + col] * scale : 0.f; }
    asm volatile("s_waitcnt lgkmcnt(0)" ::: "memory");
    const int c = lane & 7;
#pragma unroll
    for (int j = 0; j < 4; ++j) { const int n = (lane >> 3) + 8 * j; const LAS float* s = scr + (8 * c) * 33 + n;
        u32x4 o; o.x = pk_bf16(s[0 * 33], s[1 * 33]); o.y = pk_bf16(s[2 * 33], s[3 * 33]); o.z = pk_bf16(s[4 * 33], s[5 * 33]); o.w = pk_bf16(s[6 * 33], s[7 * 33]);
        if (n < nvalid) *(u32x4*)(WTrow0 + (size_t)n * 1024 + k0 + 8 * c) = o; }
    asm volatile("s_waitcnt lgkmcnt(0)" ::: "memory");
}
__device__ __forceinline__ void in_map(int n0, bool& isv, int& row, float& scale) {
    scale = 1.f; isv = false;
    if (n0 < 512) { row = HQ_QA + n0; scale = QSCALE; }
    else if (n0 < 1024) row = HQ_KA + (n0 - 512);
    else if (n0 < 1536) { isv = true; row = VT_A + (n0 - 1024); }
    else if (n0 < 1792) { row = HQ_QB + (n0 - 1536); scale = QSCALE; }
    else if (n0 < 2048) row = HQ_KB + (n0 - 1792);
    else if (n0 < 2304) { isv = true; row = VT_B + (n0 - 2048); }
    else if (n0 < 2560) { row = HQ_QC + (n0 - 2304); scale = QSCALE; }
    else if (n0 < 2816) row = HQ_KC + (n0 - 2560);
    else if (n0 < 3072) { isv = true; row = VT_C + (n0 - 2816); }
    else if (n0 < 3328) row = HQ_QI + (n0 - 3072);
    else if (n0 < 3360) row = HQ_KI + (n0 - 3328);
    else row = HQ_WI + (n0 - 3360);
}

__global__ void __launch_bounds__(512, 2) mega(Args a) {
    extern __shared__ __attribute__((aligned(16))) unsigned char lds_raw[];
    LAS unsigned char* lds = (LAS unsigned char*)lds_raw;
    const int G = gridDim.x, bid = blockIdx.x, NGW = G * 8;
    const int wave = __builtin_amdgcn_readfirstlane((int)threadIdx.x >> 6);
#define OPAQUE_IDS() int lane; asm volatile("v_mbcnt_lo_u32_b32 %0, -1, 0\n\tv_mbcnt_hi_u32_b32 %0, -1, %0" : "=&v"(lane)); const int tid = wave * 64 + lane, gw = bid * 8 + wave; (void)tid; (void)gw
#define WSPTRS() unsigned char* ws = a.ws; asm volatile("" : "+s"(ws)); \
    unsigned* ctl = (unsigned*)(ws + WS_CTL); bf16_t* Win = (bf16_t*)(ws + WS_WIN); bf16_t* Wv = (bf16_t*)(ws + WS_WV); bf16_t* Wout = (bf16_t*)(ws + WS_WOUT); \
    bf16_t* Wgu = (bf16_t*)(ws + WS_WGU); bf16_t* Wdn = (bf16_t*)(ws + WS_WDN); bf16_t* XB = (bf16_t*)(ws + WS_XB); float* XF = (float*)(ws + WS_XF); \
    bf16_t* HQ = (bf16_t*)(ws + WS_HQ); bf16_t* VT = (bf16_t*)(ws + WS_VT); bf16_t* MIX = (bf16_t*)(ws + WS_MIX); \
    float* Y1 = (float*)(ws + WS_Y1); float* X1F = (float*)(ws + WS_X1F); bf16_t* X1B = (bf16_t*)(ws + WS_X1B); bf16_t* ACT = (bf16_t*)(ws + WS_ACT); bf16_t* YR = (bf16_t*)(ws + WS_YR); \
    int* TOKL = (int*)(ws + WS_TOKL); int* ASGE = (int*)(ws + WS_ASGE); int* ASGS = (int*)(ws + WS_ASGS); float* GATE = (float*)(ws + WS_GATE); \
    (void)ctl; (void)Win; (void)Wv; (void)Wout; (void)Wgu; (void)Wdn; (void)XB; (void)XF; (void)HQ; (void)VT; (void)MIX; (void)Y1; (void)X1F; (void)X1B; (void)ACT; (void)YR; (void)TOKL; (void)ASGE; (void)ASGS; (void)GATE
    for (int u = threadIdx.x; u < (LDS_BYTES - LDS_CTL) / 4; u += 512) ((LAS unsigned*)(lds + LDS_CTL))[u] = 0u;
    __syncthreads();
    XcdBarrier bar = xcd_barrier_post((unsigned*)(a.ws + WS_CTL) + CW_BAR + a.bar_region * XCD_BAR_WORDS, (volatile LAS unsigned*)(lds + LDS_CTL));
    const int lo = a.ph_lo, hi = a.ph_hi;
#define IN(k) (lo <= (k) && (k) < hi)
#define SEAM(k) do { if (IN(k) && IN((k) + 1)) xcd_barrier(bar); } while (0)

    if (IN(0)) {
        OPAQUE_IDS(); WSPTRS();
        LAS float* scr = (LAS float*)(lds + LDS_STAGE + wave * 16384);
        constexpr int I_IN = 16 * 106, I_OUT = 16 * 32, I_GU = 16 * 64, I_DN = 16 * 32;
        constexpr int N_IN = DEPTH * I_IN, N_OUT = DEPTH * I_OUT, N_GU = DEPTH * NE * I_GU, N_DN = DEPTH * NE * I_DN;
        for (int it = gw; it < N_IN + N_OUT + N_GU + N_DN; it += NGW) {
            int r = it;
            if (r < N_IN) { const int l = r / I_IN, q = r % I_IN, kb = q / 106, nb = q % 106, n0 = nb * 32; bool isv; int row; float sc; in_map(n0, isv, row, sc);
                bf16_t* dst = isv ? Wv + ((size_t)l * 1024 + row) * 1024 : Win + ((size_t)l * HQP + row) * 1024;
                transpose_item(a.w_in + (size_t)l * D * DIN, DIN, kb * 64, n0, (DIN - n0) < 32 ? (DIN - n0) : 32, dst, sc, scr, lane); continue; }
            r -= N_IN;
            if (r < N_OUT) { const int l = r / I_OUT, q = r % I_OUT, kb = q / 32, nb = q % 32;
                transpose_item(a.w_out + (size_t)l * 1024 * D, D, kb * 64, nb * 32, 32, Wout + ((size_t)l * D + nb * 32) * 1024, 1.f, scr, lane); continue; }
            r -= N_OUT;
            if (r < N_GU) { const int le = r / I_GU, q = r % I_GU, kb = q / 64, nb = q % 64, n0 = nb * 32;
                const int bj = n0 >> 10, rr = n0 & 1023, pn = rr >> 7, c = rr & 127, nrow = pn * 256 + bj * 128 + c;
                transpose_item(a.w_gu + (size_t)le * D * 2048, 2048, kb * 64, n0, 32, Wgu + ((size_t)le * 2048 + nrow) * 1024, 1.f, scr, lane); continue; }
            r -= N_GU;
            { const int le = r / I_DN, q = r % I_DN, kb = q / 32, nb = q % 32;
                transpose_item(a.w_down + (size_t)le * 1024 * D, D, kb * 64, nb * 32, 32, Wdn + ((size_t)le * D + nb * 32) * 1024, 1.f, scr, lane); }
        }
        for (int i = gw * 64 + lane; i < DEPTH * (HQP - HQ_USED) * 128; i += NGW * 64) { const int l = i / ((HQP - HQ_USED) * 128), q = i % ((HQP - HQ_USED) * 128);
            *(u32x4*)(Win + ((size_t)l * HQP + HQ_USED) * 1024 + (size_t)q * 8) = (u32x4){0u, 0u, 0u, 0u}; }
        for (size_t i = (size_t)gw * 64 + lane; i < (size_t)T * D / 8; i += (size_t)NGW * 64) { const f32x4 v0 = *(const f32x4*)(a.x + i * 8), v1 = *(const f32x4*)(a.x + i * 8 + 4);
            u32x4 w; w.x = pk_bf16(v0[0], v0[1]); w.y = pk_bf16(v0[2], v0[3]); w.z = pk_bf16(v1[0], v1[1]); w.w = pk_bf16(v1[2], v1[3]); *(u32x4*)(XB + i * 8) = w; }
    }
    SEAM(0);

#pragma unroll 1
    for (int l = 0; l < DEPTH; ++l) {
        const int pb = 1 + 8 * l;
        if (IN(pb + 0)) {
            WSPTRS();
            { pg8::DenseOrder S{T / 256, HQP / 256, G, bid, (const char*)(Win + (size_t)l * HQP * 1024), 1024, false};
              pg8::EpiBf16Plain E{HQ, HQP};
              pg8::gemm_phase<pg8::EpiBf16Plain, pg8::DenseOrder, false>(lds + LDS_STAGE, XB, 1024, S, E, wave); }
            { pg8::DenseOrder S{1024 / 256, T / 256, G, bid, (const char*)XB, 1024, true};
              pg8::EpiBf16Plain E{VT, T};
              pg8::gemm_phase<pg8::EpiBf16Plain, pg8::DenseOrder, false>(lds + LDS_STAGE, Wv + (size_t)l * 1024 * 1024, 1024, S, E, wave); }
        }
        SEAM(pb + 0);
        if (IN(pb + 1)) {
            OPAQUE_IDS(); WSPTRS();
            const unsigned long long* MASKp = (const unsigned long long*)(ws + WS_MASK); float* OA1p = (float*)(ws + WS_OA1);
            const float lam_init = 0.8f - 0.6f * expf(-0.3f * (float)l);
            const float lam = expf(wsum(a.lam_q1[l * 64 + lane] * a.lam_k1[l * 64 + lane], lane)) - expf(wsum(a.lam_q2[l * 64 + lane] * a.lam_k2[l * 64 + lane], lane)) + lam_init;
            const int v0 = (G % 8 == 0) ? (bid & 7) * (G >> 3) + (bid >> 3) : bid;
            for (int v = v0; v < 256; v += G) {
                const int b = v >> 4, h = (v >> 2) & 3, q0 = v & 3;
#if ATT_EN & 1
#pragma unroll 1
                for (int rep = 0; rep < 2; ++rep) attn_unit<0>(lds + LDS_STAGE, HQ, VT, MIX, MASKp, OA1p, b, h, rep ? 7 - q0 : q0, wave, lane, lam, lam_init, a.subln_g + l * 128, nullptr);
#endif
#if ATT_EN & 2
#pragma unroll 1
                for (int rep = 0; rep < 2; ++rep) attn_unit<2>(lds + LDS_STAGE, HQ, VT, MIX, MASKp, OA1p, b, h, rep ? 7 - q0 : q0, wave, lane, 0.f, 0.f, nullptr, nullptr);
#endif
#if ATT_EN & 4
#pragma unroll 1
                for (int rep = 0; rep < 2; ++rep) attn_unit<1>(lds + LDS_STAGE, HQ, VT, MIX, MASKp, OA1p, b, h, rep ? 7 - q0 : q0, wave, lane, 0.f, 0.f, nullptr, a.rel_bias + ((size_t)l * 4 + h) * 257);
#endif
            }
        }
        SEAM(pb + 1);
        SEAM(pb + 2);
        if (IN(pb + 3)) {
            WSPTRS(); const float* xres = (l == 0) ? a.x : XF;
            pg8::DenseOrder S{T / 256, 4, G, bid, (const char*)(Wout + (size_t)l * 1024 * 1024), 1024, false};
            pg8::EpiResF32 E{Y1, xres};
            pg8::gemm_phase<pg8::EpiResF32, pg8::DenseOrder, false>(lds + LDS_STAGE, MIX, 1024, S, E, wave);
        }
        SEAM(pb + 3);
        if (IN(pb + 4)) {
            OPAQUE_IDS(); WSPTRS();
            LAS int* lcnt = (LAS int*)(lds + LDS_RT); LAS int* lbase = lcnt + 32; LAS int* asg_e = lcnt + 64; LAS int* asg_ls = asg_e + 512;
            const float* g1 = a.ln1_g + l * D; const float* b1 = a.ln1_b + l * D; const float* wr = a.w_router + (size_t)l * D * NE; const float* br = a.b_router + l * NE;
            unsigned* gcnt = ctl + CW_CNT + l * 64;
            for (int unit = bid; unit < T / 128; unit += G) {
                if (tid < 32) lcnt[tid] = 0;
                __syncthreads();
                for (int k = 0; k < 16; ++k) {
                    const int tl = wave * 16 + k, t = unit * 128 + tl;
                    float v[16];
#pragma unroll
                    for (int i = 0; i < 4; ++i) { const f32x4 u4 = *(const f32x4*)(Y1 + (size_t)t * D + i * 256 + lane * 4); v[4 * i] = u4[0]; v[4 * i + 1] = u4[1]; v[4 * i + 2] = u4[2]; v[4 * i + 3] = u4[3]; }
                    float s = 0.f;
#pragma unroll
                    for (int i = 0; i < 16; ++i) s += v[i];
                    const float mean = wsum(s, lane) * (1.0f / 1024.0f);
                    float qv = 0.f;
#pragma unroll
                    for (int i = 0; i < 16; ++i) { const float d = v[i] - mean; qv += d * d; }
                    const float rstd = rsqrtf(wsum(qv, lane) * (1.0f / 1024.0f) + EPS);
                    float part[32];
#pragma unroll
                    for (int e = 0; e < 32; ++e) part[e] = 0.f;
#pragma unroll
                    for (int i = 0; i < 4; ++i) {
                        const int c0 = i * 256 + lane * 4;
                        const f32x4 gg = *(const f32x4*)(g1 + c0), bb = *(const f32x4*)(b1 + c0);
                        float o[4];
#pragma unroll
                        for (int j = 0; j < 4; ++j) o[j] = (v[4 * i + j] - mean) * rstd * gg[j] + bb[j];
                        *(f32x4*)(X1F + (size_t)t * D + c0) = (f32x4){o[0], o[1], o[2], o[3]};
                        *(u32x2*)(X1B + (size_t)t * D + c0) = (u32x2){pk_bf16(o[0], o[1]), pk_bf16(o[2], o[3])};
#pragma unroll
                        for (int j = 0; j < 4; ++j) {
                            const f32x4* wp = (const f32x4*)(wr + (size_t)(c0 + j) * 32);
#pragma unroll
                            for (int e4 = 0; e4 < 8; ++e4) { const f32x4 wv = wp[e4];
#pragma unroll
                                for (int jj = 0; jj < 4; ++jj) part[4 * e4 + jj] = fmaf(o[j], wv[jj], part[4 * e4 + jj]); }
                        }
                    }
                    float p16[16], p8[8], p4[4], p2[2], lg;
                    { const bool hi = (lane & 32) != 0;
#pragma unroll
                      for (int i = 0; i < 16; ++i) { const float keep = hi ? part[i + 16] : part[i], send = hi ? part[i] : part[i + 16]; p16[i] = keep + shx(send, 32, lane); } }
                    { const bool hi = (lane & 16) != 0;
#pragma unroll
                      for (int i = 0; i < 8; ++i) { const float keep = hi ? p16[i + 8] : p16[i], send = hi ? p16[i] : p16[i + 8]; p8[i] = keep + shx(send, 16, lane); } }
                    { const bool hi = (lane & 8) != 0;
#pragma unroll
                      for (int i = 0; i < 4; ++i) { const float keep = hi ? p8[i + 4] : p8[i], send = hi ? p8[i] : p8[i + 4]; p4[i] = keep + shx(send, 8, lane); } }
                    { const bool hi = (lane & 4) != 0;
#pragma unroll
                      for (int i = 0; i < 2; ++i) { const float keep = hi ? p4[i + 2] : p4[i], send = hi ? p4[i] : p4[i + 2]; p2[i] = keep + shx(send, 4, lane); } }
                    { const bool hi = (lane & 2) != 0; const float keep = hi ? p2[1] : p2[0], send = hi ? p2[0] : p2[1]; lg = keep + shx(send, 2, lane); }
                    lg += shx(lg, 1, lane);
                    lg += br[lane >> 1];
                    int be[4]; float bv[4];
#pragma unroll
                    for (int kk = 0; kk < 4; ++kk) {
                        const float mx = wmax(lg, lane);
                        const unsigned long long bal = __ballot(lg == mx);
                        const int e = (__ffsll((long long)bal) - 1) >> 1;
                        be[kk] = e; bv[kk] = mx;
                        if ((lane >> 1) == e) lg = -3e38f;
                    }
                    float ex[4], es = 0.f;
#pragma unroll
                    for (int kk = 0; kk < 4; ++kk) { ex[kk] = __expf(bv[kk] - bv[0]); es += ex[kk]; }
                    if (lane == 0) {
#pragma unroll
                        for (int kk = 0; kk < 4; ++kk) { const int sl = __hip_atomic_fetch_add(&lcnt[be[kk]], 1, __ATOMIC_RELAXED, __HIP_MEMORY_SCOPE_WORKGROUP); asg_e[tl * 4 + kk] = be[kk]; asg_ls[tl * 4 + kk] = sl; GATE[t * 4 + kk] = ex[kk] / es; }
                    }
                }
                __syncthreads();
                if (tid < 32) lbase[tid] = (int)__hip_atomic_fetch_add(gcnt + tid, (unsigned)lcnt[tid], __ATOMIC_RELAXED, __HIP_MEMORY_SCOPE_AGENT);
                __syncthreads();
                { const int e = asg_e[tid], sl = lbase[e] + asg_ls[tid], t = unit * 128 + (tid >> 2);
                  TOKL[(size_t)e * T + sl] = t; ASGE[t * 4 + (tid & 3)] = e; ASGS[t * 4 + (tid & 3)] = sl; }
                __syncthreads();
            }
        }
        SEAM(pb + 4);
        LAS int* tstart = (LAS int*)(lds + LDS_TSTART); LAS int* lcntE = (LAS int*)(lds + LDS_CNT); LAS unsigned char* tile_e = lds + LDS_TILEE;
        if (IN(pb + 5) || IN(pb + 6) || IN(pb + 7)) {
            OPAQUE_IDS(); WSPTRS();
            if (tid < 32) lcntE[tid] = (int)__hip_atomic_load(ctl + CW_CNT + l * 64 + tid, __ATOMIC_RELAXED, __HIP_MEMORY_SCOPE_AGENT);
            __syncthreads();
            if (tid == 0) { int acc = 0; for (int e = 0; e < NE; ++e) { tstart[e] = acc; acc += (lcntE[e] + 255) >> 8; } tstart[32] = acc; }
            __syncthreads();
            for (int q = tid; q < MAXRT; q += 512) { int e = 0; for (int k = 0; k < NE; ++k) if (q >= tstart[k]) e = k; tile_e[q] = (unsigned char)e; }
            __syncthreads();
        }
        pg8::MoeTables tb{tstart, lcntE, tile_e, tstart[32]};
        if (IN(pb + 5)) {
            WSPTRS();
            pg8::MoeOrder S{tb, 8, G, bid, (const char*)(Wgu + (size_t)l * NE * 2048 * 1024), (size_t)2048 * 1024 * 2, TOKL, true};
            pg8::EpiSwiglu E{ACT, a.b_gu + (size_t)l * NE * 2048};
            pg8::gemm_phase<pg8::EpiSwiglu, pg8::MoeOrder, true>(lds + LDS_STAGE, X1B, 1024, S, E, wave);
        }
        SEAM(pb + 5);
        if (IN(pb + 6)) {
            WSPTRS();
            pg8::MoeOrder S{tb, 4, G, bid, (const char*)(Wdn + (size_t)l * NE * 1024 * 1024), (size_t)1024 * 1024 * 2, TOKL, false};
            pg8::EpiBiasBf16 E{YR, a.b_down + (size_t)l * NE * 1024};
            pg8::gemm_phase<pg8::EpiBiasBf16, pg8::MoeOrder, false>(lds + LDS_STAGE, ACT, 1024, S, E, wave);
        }
        SEAM(pb + 6);
        if (IN(pb + 7)) {
            OPAQUE_IDS(); WSPTRS(); float* xout = (l == DEPTH - 1) ? a.out : XF;
            const float* g2 = a.ln2_g + l * D; const float* b2 = a.ln2_b + l * D;
            for (int t = gw; t < T; t += NGW) {
                float v[16];
#pragma unroll
                for (int i = 0; i < 4; ++i) { const f32x4 u4 = *(const f32x4*)(X1F + (size_t)t * D + i * 256 + lane * 4);
#pragma unroll
                    for (int j = 0; j < 4; ++j) v[4 * i + j] = ALPHA * u4[j]; }
#pragma unroll
                for (int k = 0; k < 4; ++k) {
                    const int e = ASGE[t * 4 + k]; const float gk = GATE[t * 4 + k];
                    const bf16_t* yp = YR + ((size_t)tstart[e] * 256 + ASGS[t * 4 + k]) * 1024;
#pragma unroll
                    for (int i = 0; i < 4; ++i) { const u32x2 u2 = *(const u32x2*)(yp + i * 256 + lane * 4);
                        v[4 * i] += gk * bf_lo(u2[0]); v[4 * i + 1] += gk * bf_hi(u2[0]); v[4 * i + 2] += gk * bf_lo(u2[1]); v[4 * i + 3] += gk * bf_hi(u2[1]); }
                }
                float s = 0.f;
#pragma unroll
                for (int i = 0; i < 16; ++i) s += v[i];
                const float mean = wsum(s, lane) * (1.0f / 1024.0f);
                float qv = 0.f;
#pragma unroll
                for (int i = 0; i < 16; ++i) { const float d = v[i] - mean; qv += d * d; }
                const float rstd = rsqrtf(wsum(qv, lane) * (1.0f / 1024.0f) + EPS);
#pragma unroll
                for (int i = 0; i < 4; ++i) {
                    const int c0 = i * 256 + lane * 4;
                    const f32x4 gg = *(const f32x4*)(g2 + c0), bb = *(const f32x4*)(b2 + c0);
                    float o[4];
#pragma unroll
                    for (int j = 0; j < 4; ++j) o[j] = (v[4 * i + j] - mean) * rstd * gg[j] + bb[j];
                    *(f32x4*)(xout + (size_t)t * D + c0) = (f32x4){o[0], o[1], o[2], o[3]};
                    *(u32x2*)(XB + (size_t)t * D + c0) = (u32x2){pk_bf16(o[0], o[1]), pk_bf16(o[2], o[3])};
                }
            }
        }
        if (l + 1 < DEPTH) SEAM(pb + 7);
    }
#undef IN
#undef SEAM
}

__device__ __forceinline__ void load_q64(const bf16_t* p, float (&q)[64]) {
#pragma unroll
    for (int i = 0; i < 8; ++i) { const u32x4 v = *(const u32x4*)(p + 8 * i);
        q[8 * i] = bf_lo(v[0]); q[8 * i + 1] = bf_hi(v[0]); q[8 * i + 2] = bf_lo(v[1]); q[8 * i + 3] = bf_hi(v[1]);
        q[8 * i + 4] = bf_lo(v[2]); q[8 * i + 5] = bf_hi(v[2]); q[8 * i + 6] = bf_lo(v[3]); q[8 * i + 7] = bf_hi(v[3]); }
}
__device__ __forceinline__ float dot64(const bf16_t* p, const float (&q)[64]) {
    float d = 0.f;
#pragma unroll
    for (int i = 0; i < 8; ++i) { const u32x4 v = *(const u32x4*)(p + 8 * i);
        d += q[8 * i] * bf_lo(v[0]) + q[8 * i + 1] * bf_hi(v[0]) + q[8 * i + 2] * bf_lo(v[1]) + q[8 * i + 3] * bf_hi(v[1])
           + q[8 * i + 4] * bf_lo(v[2]) + q[8 * i + 5] * bf_hi(v[2]) + q[8 * i + 6] * bf_lo(v[3]) + q[8 * i + 7] * bf_hi(v[3]); }
    return d;
}
__global__ __launch_bounds__(256) void k_attnA(const bf16_t* __restrict__ hq, const bf16_t* __restrict__ vt, bf16_t* __restrict__ mix, const float* __restrict__ subg,
                                               const float* lq1, const float* lk1, const float* lq2, const float* lk2, float lam_init) {
    __shared__ float sc[4][2][2048];
    const int w = threadIdx.x >> 6, lane = threadIdx.x & 63;
    const float lam = expf(wave_sum(lq1[lane] * lk1[lane])) - expf(wave_sum(lq2[lane] * lk2[lane])) + lam_init;
    const int qid = blockIdx.x * 4 + w;
    const int t = qid % SEQ, hh = (qid / SEQ) % 4, b = qid / (SEQ * 4);
    const bf16_t* hb = hq + (size_t)b * SEQ * HQP;
    float q1[64], q2[64];
    load_q64(hb + (size_t)t * HQP + HQ_QA + hh * 128, q1); load_q64(hb + (size_t)t * HQP + HQ_QA + hh * 128 + 64, q2);
    const int nk = ((t >> 6) + 1) * 64;
    const float slope = exp2f(-(float)(2 * hh + 1)) * LOG2E;
    float m1 = -3e38f, m2 = -3e38f;
    for (int s = lane; s < nk; s += 64) {
        const bf16_t* kp = hb + (size_t)s * HQP + HQ_KA + hh * 128;
        const float bias = -slope * fabsf((float)(t - s));
        const float s1 = dot64(kp, q1) + bias, s2 = dot64(kp + 64, q2) + bias;
        sc[w][0][s] = s1; sc[w][1][s] = s2; m1 = fmaxf(m1, s1); m2 = fmaxf(m2, s2);
    }
    m1 = wave_max(m1); m2 = wave_max(m2);
    float l1 = 0.f, l2 = 0.f;
    for (int s = lane; s < nk; s += 64) { const float p1 = exp2f(sc[w][0][s] - m1), p2 = exp2f(sc[w][1][s] - m2); sc[w][0][s] = p1; sc[w][1][s] = p2; l1 += p1; l2 += p2; }
    l1 = wave_sum(l1); l2 = wave_sum(l2);
    __syncthreads();
    const float c1 = 1.0f / l1, c2 = lam / l2;
    float a0 = 0.f, a1 = 0.f;
    const bf16_t* vp0 = vt + (size_t)(VT_A + hh * 128 + lane) * T + (size_t)b * SEQ;
    const bf16_t* vp1 = vp0 + (size_t)64 * T;
#pragma unroll 4
    for (int s = 0; s < nk; ++s) { const float aa = sc[w][0][s] * c1 - sc[w][1][s] * c2; a0 = fmaf(aa, bf2f(vp0[s]), a0); a1 = fmaf(aa, bf2f(vp1[s]), a1); }
    const float ss = wave_sum(a0 * a0 + a1 * a1);
    const float r = rsqrtf(ss * (1.0f / 128.0f) + EPS) * (1.0f - lam_init);
    bf16_t* op = mix + (size_t)(b * SEQ + t) * 1024 + hh * 128;
    op[lane] = (bf16_t)(pk_bf16(a0 * r * subg[lane], 0.f) & 0xffffu); op[64 + lane] = (bf16_t)(pk_bf16(a1 * r * subg[64 + lane], 0.f) & 0xffffu);
}
__global__ __launch_bounds__(256) void k_attnB(const bf16_t* __restrict__ hq, const bf16_t* __restrict__ vt, bf16_t* __restrict__ mix, const float* __restrict__ relb) {
    __shared__ float sc[4][576];
    const int w = threadIdx.x >> 6, lane = threadIdx.x & 63;
    const int qid = blockIdx.x * 4 + w;
    const int t = qid % SEQ, hh = (qid / SEQ) % 4, b = qid / (SEQ * 4);
    const bf16_t* hb = hq + (size_t)b * SEQ * HQP;
    float q[64]; load_q64(hb + (size_t)t * HQP + HQ_QB + hh * 64, q);
    const int c = t >> 6;
    const int s0 = (c - 8) * 64 < 0 ? 0 : (c - 8) * 64, s1 = (c + 1) * 64;
    float m = -3e38f;
    for (int s = s0 + lane; s < s1; s += 64) {
        int rel = t - s; rel = rel < -128 ? -128 : (rel > 128 ? 128 : rel);
        const float sv = dot64(hb + (size_t)s * HQP + HQ_KB + hh * 64, q) + relb[hh * 257 + rel + 128] * LOG2E;
        sc[w][s - s0] = sv; m = fmaxf(m, sv);
    }
    m = wave_max(m);
    float l = 0.f;
    for (int s = s0 + lane; s < s1; s += 64) { const float p = exp2f(sc[w][s - s0] - m); sc[w][s - s0] = p; l += p; }
    l = wave_sum(l);
    __syncthreads();
    float a0 = 0.f;
    const bf16_t* vp = vt + (size_t)(VT_B + hh * 64 + lane) * T + (size_t)b * SEQ;
#pragma unroll 4
    for (int s = s0; s < s1; ++s) a0 = fmaf(sc[w][s - s0], bf2f(vp[s]), a0);
    mix[(size_t)(b * SEQ + t) * 1024 + 512 + hh * 64 + lane] = (bf16_t)(pk_bf16(a0 / l, 0.f) & 0xffffu);
}
__device__ __forceinline__ unsigned f2key(float f) { unsigned u = __float_as_uint(f); return (u & 0x80000000u) ? ~u : (u | 0x80000000u); }
__global__ __launch_bounds__(256) void k_index(const bf16_t* __restrict__ hq, unsigned long long* __restrict__ masks) {
    __shared__ unsigned keys[4][2048];
    __shared__ float qs[4][256];
    const int w = threadIdx.x >> 6, lane = threadIdx.x & 63;
    const int qid = blockIdx.x * 4 + w;
    const int t = qid % SEQ, b = qid / SEQ;
    const bf16_t* hb = hq + (size_t)b * SEQ * HQP;
    const bf16_t* hp = hb + (size_t)t * HQP;
    unsigned long long* mo = masks + (size_t)(b * SEQ + t) * 32;
    const int nk = ((t >> 6) + 1) * 64;
    if (nk <= 256) { if (lane < 32) mo[lane] = (lane < (nk >> 6)) ? ~0ull : 0ull; return; }
    { const u32x2 v = *(const u32x2*)(hp + HQ_QI + lane * 4); qs[w][lane * 4] = bf_lo(v[0]); qs[w][lane * 4 + 1] = bf_hi(v[0]); qs[w][lane * 4 + 2] = bf_lo(v[1]); qs[w][lane * 4 + 3] = bf_hi(v[1]); }
    __builtin_amdgcn_wave_barrier();
    float wsx[8];
#pragma unroll
    for (int i = 0; i < 8; ++i) wsx[i] = bf2f(hp[HQ_WI + i]) * 0.0625f;
#pragma unroll 1
    for (int s = lane; s < nk; s += 64) {
        asm volatile("" ::: "memory");
        float ki[32];
        const bf16_t* kp = hb + (size_t)s * HQP + HQ_KI;
#pragma unroll
        for (int i = 0; i < 4; ++i) { const u32x4 v = *(const u32x4*)(kp + 8 * i);
            ki[8 * i] = bf_lo(v[0]); ki[8 * i + 1] = bf_hi(v[0]); ki[8 * i + 2] = bf_lo(v[1]); ki[8 * i + 3] = bf_hi(v[1]);
            ki[8 * i + 4] = bf_lo(v[2]); ki[8 * i + 5] = bf_hi(v[2]); ki[8 * i + 6] = bf_lo(v[3]); ki[8 * i + 7] = bf_hi(v[3]); }
        float acc = 0.f;
#pragma unroll
        for (int hh = 0; hh < 8; ++hh) {
            float d = 0.f;
#pragma unroll
            for (int i = 0; i < 8; ++i) { const f32x4 qv = *(const f32x4*)&qs[w][hh * 32 + i * 4]; d += qv[0] * ki[4 * i] + qv[1] * ki[4 * i + 1] + qv[2] * ki[4 * i + 2] + qv[3] * ki[4 * i + 3]; }
            acc += wsx[hh] * fmaxf(d, 0.f);
        }
        acc += 0.0f;
        keys[w][s] = f2key(acc);
    }
    __builtin_amdgcn_wave_barrier();
    const int nb = nk >> 6;
    unsigned prefix = 0u;
#pragma unroll 1
    for (int bit = 31; bit >= 0; --bit) {
        const unsigned cand = prefix | (1u << bit);
        int c = 0;
#pragma unroll 1
        for (int i = 0; i < nb; ++i) c += (keys[w][i * 64 + lane] >= cand) ? 1 : 0;
        c = wave_sum_i(c);
        if (c >= 256) prefix = cand;
    }
    const unsigned thr = prefix;
    int cg = 0;
#pragma unroll 1
    for (int i = 0; i < nb; ++i) cg += (keys[w][i * 64 + lane] > thr) ? 1 : 0;
    cg = wave_sum_i(cg);
    const int quota = 256 - cg;
    int taken = 0;
#pragma unroll 1
    for (int i = 0; i < 32; ++i) {
        unsigned long long m = 0ull;
        if (i < nb) {
            const unsigned k = keys[w][i * 64 + lane];
            const bool eq = (k == thr);
            const unsigned long long eqm = __ballot(eq);
            const int before = __popcll(eqm & ((1ull << lane) - 1ull));
            const bool sel = (k > thr) || (eq && (taken + before < quota));
            m = __ballot(sel);
            taken += __popcll(eqm);
        }
        if (lane == 0) mo[i] = m;
    }
}
__global__ __launch_bounds__(256) void k_attnC(const bf16_t* __restrict__ hq, const bf16_t* __restrict__ vt, bf16_t* __restrict__ mix, const unsigned long long* __restrict__ masks) {
    __shared__ float sc[4][2048];
    const int w = threadIdx.x >> 6, lane = threadIdx.x & 63;
    const int qid = blockIdx.x * 4 + w;
    const int t = qid % SEQ, hh = (qid / SEQ) % 4, b = qid / (SEQ * 4);
    const bf16_t* hb = hq + (size_t)b * SEQ * HQP;
    const unsigned long long* mo = masks + (size_t)(b * SEQ + t) * 32;
    float q[64]; load_q64(hb + (size_t)t * HQP + HQ_QC + hh * 64, q);
    const int nk = ((t >> 6) + 1) * 64;
    const float slope = exp2f(-(float)(2 * hh + 2)) * LOG2E;
    float m = -3e38f;
    for (int s = lane; s < nk; s += 64) {
        const bool sel = (mo[s >> 6] >> lane) & 1ull;
        float sv = -3e38f;
        if (sel) sv = dot64(hb + (size_t)s * HQP + HQ_KC + hh * 64, q) - slope * fabsf((float)(t - s));
        sc[w][s] = sv; m = fmaxf(m, sv);
    }
    m = wave_max(m);
    float l = 0.f;
    for (int s = lane; s < nk; s += 64) { const float sv = sc[w][s]; const float p = (sv > -1e38f) ? exp2f(sv - m) : 0.f; sc[w][s] = p; l += p; }
    l = wave_sum(l);
    __syncthreads();
    float a0 = 0.f;
    const bf16_t* vp = vt + (size_t)(VT_C + hh * 64 + lane) * T + (size_t)b * SEQ;
#pragma unroll 4
    for (int s = 0; s < nk; ++s) a0 = fmaf(sc[w][s], bf2f(vp[s]), a0);
    mix[(size_t)(b * SEQ + t) * 1024 + 768 + hh * 64 + lane] = (bf16_t)(pk_bf16(a0 / l, 0.f) & 0xffffu);
}

extern "C" void kernel_launch(void* const* d_in, const int* in_sizes, int n_in, void* d_out, int out_size, void* d_ws, size_t ws_size, hipStream_t stream) {
    static int grid = 0;
    if (grid == 0) {
        if (ws_size < WS_END) { fprintf(stderr, "kernel_launch: workspace too small (%zu < %zu)\n", ws_size, (size_t)WS_END); grid = -1; return; }
        int dev = 0, cus = 0, per_cu = 0;
        if (hipGetDevice(&dev) != hipSuccess || hipDeviceGetAttribute(&cus, hipDeviceAttributeMultiprocessorCount, dev) != hipSuccess) { grid = -1; return; }
        if (hipFuncSetAttribute((const void*)mega, hipFuncAttributeMaxDynamicSharedMemorySize, LDS_BYTES) != hipSuccess) { fprintf(stderr, "kernel_launch: hipFuncSetAttribute failed\n"); grid = -1; return; }
        if (hipOccupancyMaxActiveBlocksPerMultiprocessor(&per_cu, (const void*)mega, 512, LDS_BYTES) != hipSuccess || per_cu < 1) { fprintf(stderr, "kernel_launch: occupancy query says %d\n", per_cu); }
        (void)hipGetLastError();
        grid = cus;
        if (grid % 8 != 0) grid -= grid % 8;
    }
    if (grid < 0) return;
    (void)hipMemsetAsync((char*)d_ws + WS_CTL, 0, CTL_BYTES, stream);
    Args a{};
    a.x = (const float*)d_in[0]; a.w_in = (const float*)d_in[1]; a.lam_q1 = (const float*)d_in[2]; a.lam_k1 = (const float*)d_in[3]; a.lam_q2 = (const float*)d_in[4]; a.lam_k2 = (const float*)d_in[5];
    a.subln_g = (const float*)d_in[6]; a.rel_bias = (const float*)d_in[7]; a.w_out = (const float*)d_in[8]; a.ln1_g = (const float*)d_in[9]; a.ln1_b = (const float*)d_in[10];
    a.w_router = (const float*)d_in[11]; a.b_router = (const float*)d_in[12]; a.w_gu = (const float*)d_in[13]; a.b_gu = (const float*)d_in[14]; a.w_down = (const float*)d_in[15];
    a.b_down = (const float*)d_in[16]; a.ln2_g = (const float*)d_in[17]; a.ln2_b = (const float*)d_in[18];
    a.out = (float*)d_out; a.ws = (unsigned char*)d_ws; a.pad = 0;
    unsigned char* ws = (unsigned char*)d_ws;
    bf16_t* HQ = (bf16_t*)(ws + WS_HQ); bf16_t* VT = (bf16_t*)(ws + WS_VT); bf16_t* MIX = (bf16_t*)(ws + WS_MIX);
    unsigned long long* MASK = (unsigned long long*)(ws + WS_MASK);
    int region = 0;
    for (int l = 0; l < DEPTH; ++l) {
        const int pb = 1 + 8 * l;
        a.ph_lo = (l == 0) ? 0 : pb; a.ph_hi = pb + 1; a.bar_region = region++;
        hipLaunchKernelGGL(mega, dim3(grid), dim3(512), LDS_BYTES, stream, a);
        k_index<<<T / 4, 256, 0, stream>>>(HQ, MASK);
        a.ph_lo = pb + 1; a.ph_hi = pb + 8; a.bar_region = region++;
        hipLaunchKernelGGL(mega, dim3(grid), dim3(512), LDS_BYTES, stream, a);
    }
}
```

```cpp
#include <hip/hip_runtime.h>
#include <stdint.h>
#include <cstdio>

#define LAS __attribute__((address_space(3)))
typedef unsigned short bf16_t;
typedef short bf16x8 __attribute__((ext_vector_type(8)));
typedef float f32x4 __attribute__((ext_vector_type(4)));
typedef float f32x2 __attribute__((ext_vector_type(2)));
typedef unsigned u32x4 __attribute__((ext_vector_type(4)));
typedef unsigned u32x2 __attribute__((ext_vector_type(2)));
typedef __bf16 bf16v2 __attribute__((ext_vector_type(2)));

constexpr int D = 1024, BATCH = 16, SEQ = 2048, T = BATCH * SEQ, DEPTH = 4;
constexpr int DIN = 3368;
constexpr int NE = 32;
constexpr float ALPHA = 1.681792830507429f;
constexpr float EPS = 1e-5f;
constexpr float LOG2E = 1.4426950408889634f;
constexpr float QSCALE = 0.125f * LOG2E;
constexpr int HQP = 2560;
constexpr int HQ_QA = 0, HQ_KA = 512, HQ_QB = 1024, HQ_KB = 1280, HQ_QC = 1536, HQ_KC = 1792, HQ_QI = 2048, HQ_KI = 2304, HQ_WI = 2336, HQ_USED = 2344;
constexpr int VT_A = 0, VT_B = 512, VT_C = 768;
constexpr int NASG = T * 4;
constexpr int GROWS = NASG + NE * 256;
constexpr int MAXRT = GROWS / 256;

constexpr size_t MiB = (size_t)1 << 20;
constexpr size_t al(size_t x) { return (x + 255) & ~(size_t)255; }
constexpr size_t WS_CTL = 0, CTL_BYTES = 4 * MiB;
constexpr size_t WS_WIN = WS_CTL + CTL_BYTES;
constexpr size_t WS_WV = WS_WIN + al((size_t)DEPTH * HQP * D * 2);
constexpr size_t WS_WOUT = WS_WV + al((size_t)DEPTH * 1024 * D * 2);
constexpr size_t WS_WGU = WS_WOUT + al((size_t)DEPTH * D * 1024 * 2);
constexpr size_t WS_WDN = WS_WGU + al((size_t)DEPTH * NE * 2048 * D * 2);
constexpr size_t WS_XB = WS_WDN + al((size_t)DEPTH * NE * D * 1024 * 2);
constexpr size_t WS_XF = WS_XB + al((size_t)T * D * 2);
constexpr size_t WS_HQ = WS_XF + al((size_t)T * D * 4);
constexpr size_t WS_VT = WS_HQ + al((size_t)T * HQP * 2);
constexpr size_t WS_MIX = WS_VT + al((size_t)1024 * T * 2);
constexpr size_t WS_Y1 = WS_MIX + al((size_t)T * 1024 * 2);
constexpr size_t WS_X1F = WS_Y1 + al((size_t)T * D * 4);
constexpr size_t WS_X1B = WS_X1F + al((size_t)T * D * 4);
constexpr size_t WS_ACT = WS_X1B + al((size_t)T * D * 2);
constexpr size_t WS_YR = WS_ACT + al((size_t)GROWS * 1024 * 2);
constexpr size_t WS_MASK = WS_YR + al((size_t)GROWS * 1024 * 2);
constexpr size_t WS_TOKL = WS_MASK + al((size_t)T * 32 * 8);
constexpr size_t WS_ASGE = WS_TOKL + al((size_t)NE * T * 4);
constexpr size_t WS_ASGS = WS_ASGE + al((size_t)NASG * 4);
constexpr size_t WS_GATE = WS_ASGS + al((size_t)NASG * 4);
constexpr size_t WS_OA1 = WS_GATE + al((size_t)NASG * 4);
constexpr size_t WS_END = WS_OA1 + al((size_t)T * 512 * 4);
constexpr int CW_BAR = 4096;
constexpr int CW_CNT = 262144;

__device__ __forceinline__ unsigned pk_bf16(float lo, float hi) { f32x2 v = {lo, hi}; return __builtin_bit_cast(unsigned, __builtin_convertvector(v, bf16v2)); }
__device__ __forceinline__ float bf_lo(unsigned u) { return __uint_as_float(u << 16); }
__device__ __forceinline__ float bf_hi(unsigned u) { return __uint_as_float(u & 0xffff0000u); }
__device__ __forceinline__ float bf2f(bf16_t b) { return __uint_as_float(((unsigned)b) << 16); }
__device__ __forceinline__ float wave_sum(float v) {
#pragma unroll
    for (int o = 32; o > 0; o >>= 1) v += __shfl_xor(v, o);
    return v; }
__device__ __forceinline__ float wave_max(float v) {
#pragma unroll
    for (int o = 32; o > 0; o >>= 1) v = fmaxf(v, __shfl_xor(v, o));
    return v; }
__device__ __forceinline__ int wave_sum_i(int v) {
#pragma unroll
    for (int o = 32; o > 0; o >>= 1) v += __shfl_xor(v, o);
    return v; }

__device__ __forceinline__ float shx(float v, int o, int lane) { return __int_as_float(__builtin_amdgcn_ds_bpermute((lane ^ o) << 2, __float_as_int(v))); }
__device__ __forceinline__ float wsum(float v, int lane) {
#pragma unroll
    for (int o = 32; o > 0; o >>= 1) v += shx(v, o, lane);
    return v; }
__device__ __forceinline__ float wmax(float v, int lane) {
#pragma unroll
    for (int o = 32; o > 0; o >>= 1) v = fmaxf(v, shx(v, o, lane));
    return v; }

#define XB_TMO      128
#define XB_XCNT(j)  (256  + 64 * (j))
#define XB_XSUB(j)  (1280 + 64 * (j))
#define XB_XGEN(j)  (2304 + 64 * (j))
#define XB_TOP      3328
#define XB_TOPGEN   3392
#define XCD_BAR_WORDS 3456
#define XB_SPIN_CAP (1u << 22)
__device__ __forceinline__ unsigned xb_ld(unsigned* p)              { return __hip_atomic_load(p, __ATOMIC_RELAXED, __HIP_MEMORY_SCOPE_AGENT); }
__device__ __forceinline__ unsigned xb_add(unsigned* p, unsigned v) { return __hip_atomic_fetch_add(p, v, __ATOMIC_RELAXED, __HIP_MEMORY_SCOPE_AGENT); }
__device__ __forceinline__ unsigned xb_xcc_id() { return (unsigned)__builtin_amdgcn_s_getreg((3 << 11) | 20) & 0xFu; }
#define XB_SPIN(cond, bar) do { unsigned _sp = 0; while (cond) { __builtin_amdgcn_s_sleep(1); \
    if ((++_sp & 255u) == 0u) { if (xb_ld(&(bar)[XB_TMO])) break; if (_sp > XB_SPIN_CAP) { atomicAdd(&(bar)[XB_TMO], 1u); break; } } } } while (0)
struct XcdBarrier { unsigned* bar; unsigned x; volatile LAS unsigned* st; };
__device__ __forceinline__ XcdBarrier xcd_barrier_post(unsigned* bar, volatile LAS unsigned* st) {
    XcdBarrier b; b.bar = bar; b.x = xb_xcc_id(); b.st = st;
    if (threadIdx.x == 0) (void)xb_add(&bar[XB_XCNT(b.x)], 1u);
    return b;
}
__device__ __forceinline__ void xcd_barrier_complete(unsigned* bar, unsigned x, unsigned& nloc, unsigned& nx) {
    const unsigned G = gridDim.x * gridDim.y * gridDim.z;
    unsigned sum, cnt, mine, sp = 0u;
    for (;;) {
        sum = 0u; cnt = 0u; mine = 0u;
#pragma unroll
        for (unsigned j = 0; j < 16; ++j) { const unsigned c = xb_ld(&bar[XB_XCNT(j)]); sum += c; cnt += (c > 0u) ? 1u : 0u; mine = (j == x) ? c : mine; }
        if (sum == G) break;
        __builtin_amdgcn_s_sleep(1);
        if ((++sp & 255u) == 0u) { if (xb_ld(&bar[XB_TMO])) break; if (sp > XB_SPIN_CAP) { atomicAdd(&bar[XB_TMO], 1u); break; } }
    }
    nloc = mine > 0u ? mine : 1u; nx = cnt > 0u ? cnt : 1u;
}
__device__ __forceinline__ void xcd_barrier(const XcdBarrier& b) {
    asm volatile("s_waitcnt vmcnt(0)" ::: "memory");
    __syncthreads();
    if (threadIdx.x == 0) {
        unsigned* bar = b.bar;
        __builtin_amdgcn_s_waitcnt(0);
        unsigned nloc = b.st[0], nx = b.st[1];
        if (nloc == 0u) { xcd_barrier_complete(bar, b.x, nloc, nx); b.st[0] = nloc; b.st[1] = nx; }
        const unsigned old = xb_add(&bar[XB_XSUB(b.x)], 1u);
        const unsigned gen = old / nloc;
        if (old + 1u == (gen + 1u) * nloc) {
            __builtin_amdgcn_fence(__ATOMIC_RELEASE, "agent");
            asm volatile("s_waitcnt vmcnt(0)" ::: "memory");
            const unsigned og = xb_add(&bar[XB_TOP], 1u);
            const unsigned tg = og / nx;
            if (og + 1u == (tg + 1u) * nx) xb_add(&bar[XB_TOPGEN], 1u);
            else XB_SPIN(xb_ld(&bar[XB_TOPGEN]) == tg, bar);
            __builtin_amdgcn_fence(__ATOMIC_ACQUIRE, "agent");
            xb_add(&bar[XB_XGEN(b.x)], 1u);
            asm volatile("s_waitcnt vmcnt(0)" ::: "memory");
        } else {
            XB_SPIN(xb_ld(&bar[XB_XGEN(b.x)]) == gen, bar);
            __builtin_amdgcn_fence(__ATOMIC_ACQUIRE, "agent");
            asm volatile("s_waitcnt vmcnt(0)" ::: "memory");
        }
    }
    __syncthreads();
}

namespace pg8 {
constexpr int BM = 256, BK = 64, HALF = 128, HTB = HALF * BK * 2, STAGE_BYTES = 8 * HTB;
__host__ __device__ __forceinline__ int lds_byte(int r, int c) { const int st = (r >> 4) * 2 + (c >> 5), rr = r & 15, cc = c & 31, ob = rr * 64 + cc * 2; return st * 1024 + (ob ^ (((ob >> 9) & 1) << 5)); }
__host__ __device__ __forceinline__ void stage_rc(int b, int& R, int& C) { const int st = b / 1024, sb = b % 1024, swz = sb ^ (((sb >> 9) & 1) << 5); R = (st >> 1) * 16 + swz / 64; C = (st & 1) * 32 + (swz % 64) / 2; }
__host__ __device__ __forceinline__ int perm32(int rho) { const int n = rho >> 4, i = rho & 15; return 8 * (i >> 2) + 4 * n + (i & 3); }

struct Unit {
    int row0;
    int col0;
    const char* Bt;
    const int* rows;
    int nvalid;
    int e;
};

template <class Epi, class Sched, bool GATHER>
__device__ __forceinline__ void gemm_phase(LAS unsigned char* lds, const bf16_t* Abase, const int K, const Sched& S, const Epi& E, const int wid) {
    int lane; asm volatile("v_mbcnt_lo_u32_b32 %0, -1, 0\n\tv_mbcnt_hi_u32_b32 %0, -1, %0" : "=&v"(lane));
    const int tid = wid * 64 + lane, wr = wid >> 2, wc = wid & 3, fr = lane & 15, fq = lane >> 4;
    const int nt = K / BK;
    int Rl[2], Cl[2]; unsigned voffB[2];
#pragma unroll
    for (int i = 0; i < 2; ++i) { int R, C; stage_rc(tid * 16 + i * 8192, R, C); Rl[i] = R; Cl[i] = C; const int Rb = Epi::PERM ? ((R & ~31) + perm32(R & 31)) : R; voffB[i] = (unsigned)(Rb * K + C) * 2u; }
    const size_t kstep = (size_t)(BK * 2);
    const size_t hstep = (size_t)HALF * K * 2;
    const unsigned ldsw = (unsigned)wid * 1024u;
    const int aoff = lds_byte(wr * 64 + fr, fq * 8), boff = lds_byte(wc * 32 + fr, fq * 8);
#define PG8_SA(b, h) (((b) * 2 + (h)) * HTB)
#define PG8_SB(b, h) ((4 + (b) * 2 + (h)) * HTB)
#define PG8_STAGE(bufoff, gbase, voff) do { _Pragma("unroll") for (int _i = 0; _i < 2; ++_i) \
        __builtin_amdgcn_global_load_lds((const unsigned*)((const char*)(gbase) + (voff)[_i]), (LAS unsigned*)(lds + (bufoff) + ldsw + _i * 8192), 16, 0, 0); } while (0)
#define PG8_LDA(dst, b, h) do { _Pragma("unroll") for (int m = 0; m < 4; ++m) _Pragma("unroll") for (int k = 0; k < 2; ++k) dst[m][k] = *(const LAS bf16x8*)(lds + PG8_SA(b, h) + aoff + m * 2048 + k * 1024); } while (0)
#define PG8_LDB(dst, b, h) do { _Pragma("unroll") for (int n = 0; n < 2; ++n) _Pragma("unroll") for (int k = 0; k < 2; ++k) dst[n][k] = *(const LAS bf16x8*)(lds + PG8_SB(b, h) + boff + n * 2048 + k * 1024); } while (0)
#define PG8_MMA(ai, bj, At, Bt) do { __builtin_amdgcn_s_setprio(1); _Pragma("unroll") for (int m = 0; m < 4; ++m) _Pragma("unroll") for (int n = 0; n < 2; ++n) _Pragma("unroll") for (int k = 0; k < 2; ++k) \
        acc[ai][bj][m][n] = __builtin_amdgcn_mfma_f32_16x16x32_bf16(Bt[n][k], At[m][k], acc[ai][bj][m][n], 0, 0, 0); __builtin_amdgcn_s_setprio(0); } while (0)
#define PG8_WAIT_V(n) asm volatile("s_waitcnt vmcnt(" #n ")" ::: "memory")
#define PG8_WAIT_L(n) asm volatile("s_waitcnt lgkmcnt(" #n ")" ::: "memory")
#define PG8_BAR __builtin_amdgcn_s_barrier()
#define PG8_SCHED __builtin_amdgcn_sched_barrier(0)
#define PG8_AOFFS(dst, u) do { _Pragma("unroll") for (int _h = 0; _h < 2; ++_h) _Pragma("unroll") for (int _i = 0; _i < 2; ++_i) { \
        int _src; if (GATHER) { const int _r = _h * HALF + Rl[_i]; _src = (_r < (u).nvalid) ? (u).rows[_r] : 0; } else _src = (u).row0 + _h * HALF + Rl[_i]; \
        dst[_h][_i] = (unsigned)(_src * K + Cl[_i]) * 2u; } } while (0)
    Unit cur, nxt; int ui = 0;
    if (!S.next(0, cur)) return;
    f32x4 acc[2][2][4][2];
#pragma unroll
    for (int a = 0; a < 2; ++a)
#pragma unroll
        for (int b = 0; b < 2; ++b)
#pragma unroll
            for (int m = 0; m < 4; ++m)
#pragma unroll
                for (int n = 0; n < 2; ++n) acc[a][b][m][n] = (f32x4){0.f, 0.f, 0.f, 0.f};
    bf16x8 At[4][2], B0[2][2], B1[2][2];
    unsigned oa[2][2], na[2][2];
    PG8_AOFFS(oa, cur);
    const char* cA = (const char*)Abase; const char* cB = cur.Bt;
    PG8_STAGE(PG8_SB(0, 0), cB, voffB); PG8_STAGE(PG8_SB(0, 1), cB + hstep, voffB); PG8_STAGE(PG8_SA(0, 0), cA, oa[0]); PG8_STAGE(PG8_SA(0, 1), cA, oa[1]);
    if (wr == 1) PG8_BAR;
    PG8_WAIT_V(2); PG8_BAR;
    PG8_STAGE(PG8_SB(1, 0), cB + kstep, voffB); PG8_STAGE(PG8_SA(1, 0), cA + kstep, oa[0]); PG8_STAGE(PG8_SB(1, 1), cB + hstep + kstep, voffB);
    PG8_WAIT_V(6); PG8_BAR;
    for (;;) {
        const bool has_next = S.next(ui + 1, nxt);
        if (has_next) { PG8_AOFFS(na, nxt); if (GATHER) asm volatile("" : "+v"(na[0][0]), "+v"(na[0][1]), "+v"(na[1][0]), "+v"(na[1][1])); }
        else {
#pragma unroll
            for (int h = 0; h < 2; ++h)
#pragma unroll
                for (int i = 0; i < 2; ++i) na[h][i] = oa[h][i];
        }
        const char* nB = has_next ? nxt.Bt : cB;
        for (int t = 0; t < nt; t += 2) {
            const bool last = (t == nt - 2);
            const char* a1 = cA + (size_t)(t + 1) * kstep;
            const char* a2 = last ? cA : cA + (size_t)(t + 2) * kstep; const char* b2 = last ? nB : cB + (size_t)(t + 2) * kstep;
            const char* a3 = a2 + kstep; const char* b3 = b2 + kstep;
            unsigned sa[2][2];
#pragma unroll
            for (int h = 0; h < 2; ++h)
#pragma unroll
                for (int i = 0; i < 2; ++i) sa[h][i] = last ? na[h][i] : oa[h][i];
            PG8_LDB(B0, 0, 0); PG8_LDB(B1, 0, 1); PG8_SCHED; PG8_LDA(At, 0, 0); PG8_STAGE(PG8_SA(1, 1), a1, oa[1]);
            PG8_WAIT_V(8); PG8_WAIT_L(0); PG8_BAR; PG8_MMA(0, 0, At, B0); PG8_MMA(0, 1, At, B1); PG8_BAR; PG8_SCHED;
            PG8_LDA(At, 0, 1); PG8_STAGE(PG8_SB(0, 0), b2, voffB); PG8_STAGE(PG8_SB(0, 1), b2 + hstep, voffB); PG8_STAGE(PG8_SA(0, 0), a2, sa[0]);
            PG8_WAIT_V(8); PG8_WAIT_L(0); PG8_BAR; PG8_MMA(1, 0, At, B0); PG8_MMA(1, 1, At, B1); PG8_BAR; PG8_SCHED;
            PG8_LDB(B0, 1, 0); PG8_LDB(B1, 1, 1); PG8_SCHED; PG8_LDA(At, 1, 0); PG8_STAGE(PG8_SA(0, 1), a2, sa[1]);
            PG8_WAIT_V(8); PG8_WAIT_L(0); PG8_BAR; PG8_MMA(0, 0, At, B0); PG8_MMA(0, 1, At, B1); PG8_BAR; PG8_SCHED;
            PG8_LDA(At, 1, 1); PG8_STAGE(PG8_SB(1, 0), b3, voffB); PG8_STAGE(PG8_SB(1, 1), b3 + hstep, voffB); PG8_STAGE(PG8_SA(1, 0), a3, sa[0]);
            PG8_WAIT_V(8); PG8_WAIT_L(0); PG8_BAR; PG8_MMA(1, 0, At, B0); PG8_MMA(1, 1, At, B1); PG8_BAR; PG8_SCHED;
        }
        if (wr == 0) PG8_BAR;
        E(acc, cur, wr, wc, fr, fq);
        if (!has_next) break;
#pragma unroll
        for (int a = 0; a < 2; ++a)
#pragma unroll
            for (int b = 0; b < 2; ++b)
#pragma unroll
                for (int m = 0; m < 4; ++m)
#pragma unroll
                    for (int n = 0; n < 2; ++n) acc[a][b][m][n] = (f32x4){0.f, 0.f, 0.f, 0.f};
        cur = nxt; cB = nB; ++ui;
#pragma unroll
        for (int h = 0; h < 2; ++h)
#pragma unroll
            for (int i = 0; i < 2; ++i) oa[h][i] = na[h][i];
        if (wr == 1) PG8_BAR;
    }
    PG8_WAIT_V(0);
    PG8_BAR;
#undef PG8_SA
#undef PG8_SB
#undef PG8_STAGE
#undef PG8_LDA
#undef PG8_LDB
#undef PG8_MMA
#undef PG8_WAIT_V
#undef PG8_WAIT_L
#undef PG8_BAR
#undef PG8_SCHED
#undef PG8_AOFFS
}

struct DenseOrder {
    int nRT, nN, G, c; const char* Bt; int K; bool swap;
    __device__ __forceinline__ bool next(int i, Unit& u) const {
        const int xcd = c & 7, s = i * (G >> 3) + (c >> 3);
        int rt, pn;
        if (!swap) { rt = 8 * (s / nN) + xcd; pn = s % nN; } else { pn = 8 * (s / nRT) + xcd; rt = s % nRT; }
        if (rt >= nRT || pn >= nN) return false;
        u.row0 = rt * BM; u.col0 = pn * BM; u.Bt = Bt + (size_t)pn * BM * K * 2; u.rows = nullptr; u.nvalid = 0; u.e = 0; return true;
    }
};
struct MoeTables { LAS const int* tstart; LAS const int* cnt; LAS const unsigned char* tile_e; int nrt; };
struct MoeOrder {
    MoeTables tb; int nN, G, c; const char* Bt; size_t strideB; const int* tokl; bool gather;
    __device__ __forceinline__ bool next(int i, Unit& u) const {
        const int xcd = c & 7, s = i * (G >> 3) + (c >> 3);
        const int q = 8 * (s / nN) + xcd, pn = s % nN;
        if (q >= tb.nrt) return false;
        const int e = tb.tile_e[q]; const int lt = q - tb.tstart[e];
        u.row0 = q * BM; u.col0 = pn * BM; u.e = e; u.Bt = Bt + (size_t)e * strideB + (size_t)pn * BM * 1024 * 2;
        u.rows = gather ? tokl + (size_t)e * T + lt * BM : nullptr; u.nvalid = tb.cnt[e] - lt * BM; return true;
    }
};

struct EpiBf16Plain {
    static constexpr bool PERM = true;
    bf16_t* O; int ldc;
    __device__ __forceinline__ void operator()(const f32x4 (&acc)[2][2][4][2], const Unit& u, int wr, int wc, int fr, int fq) const {
        const int row0 = u.row0 + wr * 64 + fr, col0 = u.col0 + wc * 32 + 8 * fq;
#pragma unroll
        for (int ai = 0; ai < 2; ++ai)
#pragma unroll
            for (int m = 0; m < 4; ++m) { bf16_t* rowp = O + (size_t)(row0 + ai * HALF + m * 16) * ldc + col0;
#pragma unroll
                for (int bj = 0; bj < 2; ++bj) { const f32x4 v0 = acc[ai][bj][m][0], v1 = acc[ai][bj][m][1];
                    u32x4 w; w.x = pk_bf16(v0[0], v0[1]); w.y = pk_bf16(v0[2], v0[3]); w.z = pk_bf16(v1[0], v1[1]); w.w = pk_bf16(v1[2], v1[3]);
                    *(u32x4*)(rowp + bj * HALF) = w; } }
    }
};
struct EpiResF32 {
    static constexpr bool PERM = false;
    float* C; const float* R;
    __device__ __forceinline__ void operator()(const f32x4 (&acc)[2][2][4][2], const Unit& u, int wr, int wc, int fr, int fq) const {
        const int row0 = u.row0 + wr * 64 + fr, col0 = u.col0 + wc * 32 + 4 * fq;
#pragma unroll
        for (int ai = 0; ai < 2; ++ai)
#pragma unroll
            for (int m = 0; m < 4; ++m) { const size_t off = (size_t)(row0 + ai * HALF + m * 16) * 1024 + col0;
#pragma unroll
                for (int bj = 0; bj < 2; ++bj)
#pragma unroll
                    for (int n = 0; n < 2; ++n) { const f32x4 r = *(const f32x4*)(R + off + bj * HALF + n * 16); *(f32x4*)(C + off + bj * HALF + n * 16) = r * ALPHA + acc[ai][bj][m][n]; } }
    }
};
struct EpiSwiglu {
    static constexpr bool PERM = true;
    bf16_t* O; const float* bias;
    __device__ __forceinline__ void operator()(const f32x4 (&acc)[2][2][4][2], const Unit& u, int wr, int wc, int fr, int fq) const {
        const int row0 = u.row0 + wr * 64 + fr, oc = (u.col0 >> 1) + wc * 32 + 8 * fq;
        const float* bp = bias + (size_t)u.e * 2048 + oc;
        f32x4 bg[2], bu[2];
#pragma unroll
        for (int n = 0; n < 2; ++n) { bg[n] = *(const f32x4*)(bp + 4 * n); bu[n] = *(const f32x4*)(bp + 1024 + 4 * n); }
#pragma unroll
        for (int ai = 0; ai < 2; ++ai)
#pragma unroll
            for (int m = 0; m < 4; ++m) {
                float o[8];
#pragma unroll
                for (int n = 0; n < 2; ++n) { const f32x4 g4 = acc[ai][0][m][n] + bg[n], u4 = acc[ai][1][m][n] + bu[n];
#pragma unroll
                    for (int j = 0; j < 4; ++j) { const float g = fminf(g4[j], 7.0f), up = fminf(fmaxf(u4[j], -7.0f), 7.0f);
                        const float glu = g * __builtin_amdgcn_rcpf(1.0f + __builtin_amdgcn_exp2f(-1.702f * LOG2E * g)); o[4 * n + j] = (up + 1.0f) * glu; } }
                u32x4 w; w.x = pk_bf16(o[0], o[1]); w.y = pk_bf16(o[2], o[3]); w.z = pk_bf16(o[4], o[5]); w.w = pk_bf16(o[6], o[7]);
                *(u32x4*)(O + (size_t)(row0 + ai * HALF + m * 16) * 1024 + oc) = w; }
    }
};
struct EpiBiasBf16 {
    static constexpr bool PERM = true;
    bf16_t* O; const float* bias;
    __device__ __forceinline__ void operator()(const f32x4 (&acc)[2][2][4][2], const Unit& u, int wr, int wc, int fr, int fq) const {
        const int row0 = u.row0 + wr * 64 + fr, col0 = u.col0 + wc * 32 + 8 * fq;
        const float* bp = bias + (size_t)u.e * 1024 + col0;
        f32x4 bv[2][2];
#pragma unroll
        for (int bj = 0; bj < 2; ++bj)
#pragma unroll
            for (int n = 0; n < 2; ++n) bv[bj][n] = *(const f32x4*)(bp + bj * HALF + 4 * n);
#pragma unroll
        for (int ai = 0; ai < 2; ++ai)
#pragma unroll
            for (int m = 0; m < 4; ++m) { bf16_t* rowp = O + (size_t)(row0 + ai * HALF + m * 16) * 1024 + col0;
#pragma unroll
                for (int bj = 0; bj < 2; ++bj) { const f32x4 v0 = acc[ai][bj][m][0] + bv[bj][0], v1 = acc[ai][bj][m][1] + bv[bj][1];
                    u32x4 w; w.x = pk_bf16(v0[0], v0[1]); w.y = pk_bf16(v0[2], v0[3]); w.z = pk_bf16(v1[0], v1[1]); w.w = pk_bf16(v1[2], v1[3]);
                    *(u32x4*)(rowp + bj * HALF) = w; } }
    }
};
}


#ifndef ATT_EN
#define ATT_EN 7
#endif
typedef float f32x16 __attribute__((ext_vector_type(16)));
#define MFMA32(a, b, c) __builtin_amdgcn_mfma_f32_32x32x16_bf16((a), (b), (c), 0, 0, 0)
constexpr int ATT_BUF = 27648;
constexpr int ATT_RELB = 2 * ATT_BUF;
#define NEG_INF_F (-__builtin_huge_valf())

template <int MODE>
__device__ __forceinline__ void attn_unit(LAS unsigned char* lds, const bf16_t* HQ, const bf16_t* VT, bf16_t* MIX, const unsigned long long* MASK, float* OA1,
                                          const int b, const int h, const int qt, const int wave, const int lane_unused,
                                          const float lam, const float lam_init, const float* subg, const float* relb) {
    constexpr int NPASS = (MODE == 0) ? 2 : 1;
    constexpr int EB = (MODE == 0) ? 4 : 2;
    constexpr int KSTR = 144;
    constexpr int VOFF = 64 * KSTR;
    constexpr int NCHV = (MODE == 0) ? 2 : 1;
    const int qoff = (MODE == 0) ? HQ_QA + h * 128 : (MODE == 1) ? HQ_QB + h * 64 : HQ_QC + h * 64;
    const int koff = (MODE == 0) ? HQ_KA + h * 128 : (MODE == 1) ? HQ_KB + h * 64 : HQ_KC + h * 64;
    const int vrow0 = (MODE == 0) ? VT_A + h * 128 : (MODE == 1) ? VT_B + h * 64 : VT_C + h * 64;
    const int mixcol = (MODE == 0) ? h * 128 : (MODE == 1) ? 512 + h * 64 : 768 + h * 64;
    int lane; asm volatile("v_mbcnt_lo_u32_b32 %0, -1, 0\n\tv_mbcnt_hi_u32_b32 %0, -1, %0" : "=&v"(lane));
    const int tid = wave * 64 + lane, ql = lane & 31, hb = lane >> 5;
    const int cq = qt * 4 + (wave >> 1);
    const int tq = qt * 256 + wave * 32 + ql;
    const int kt_hi = qt * 4 + 3;
    const int kt_lo = (MODE == 1) ? ((qt * 4 - 8) > 0 ? (qt * 4 - 8) : 0) : 0;
    const float slope2 = (MODE == 0) ? exp2f(-(float)(2 * h + 1)) * LOG2E : exp2f(-(float)(2 * h + 2)) * LOG2E;
    LAS float* relb_l = (LAS float*)(lds + ATT_RELB);
    const int prow = (ql & 16) | ((ql & 4) << 1) | ((ql & 8) >> 1) | (ql & 3);
    const int krow = tid >> 3, kc = tid & 7;
#pragma unroll 1
    for (int mp = 0; mp < NPASS; ++mp) {
        bf16x8 Q[4];
        { const bf16_t* qp = HQ + (size_t)(b * SEQ + tq) * HQP + qoff + mp * 64 + hb * 8;
#pragma unroll
          for (int ks = 0; ks < 4; ++ks) Q[ks] = *(const bf16x8*)(qp + ks * 16); }
        f32x16 O[EB];
        float mrun = -1e30f, lrun = 0.f;
#pragma unroll
        for (int eb = 0; eb < EB; ++eb)
#pragma unroll
            for (int i = 0; i < 16; ++i) O[eb][i] = 0.f;
        u32x4 kreg, vreg[NCHV];
#define ATT_LOAD(kt_) do { kreg = *(const u32x4*)(HQ + (size_t)(b * SEQ + (kt_) * 64 + krow) * HQP + koff + mp * 64 + kc * 8); \
        _Pragma("unroll") for (int j = 0; j < NCHV; ++j) vreg[j] = *(const u32x4*)(VT + (size_t)(vrow0 + krow + 64 * j) * T + (size_t)b * SEQ + (kt_) * 64 + kc * 8); } while (0)
#define ATT_STORE(buf_) do { *(LAS u32x4*)(lds + (buf_) * ATT_BUF + krow * KSTR + kc * 16) = kreg; \
        _Pragma("unroll") for (int j = 0; j < NCHV; ++j) *(LAS u32x4*)(lds + (buf_) * ATT_BUF + VOFF + (krow + 64 * j) * 144 + kc * 16) = vreg[j]; } while (0)

        __syncthreads();
        if (MODE == 1) { for (int i = tid; i < 257; i += 512) relb_l[i] = relb[i] * LOG2E; }
        ATT_LOAD(kt_hi); ATT_STORE(0);
        __syncthreads();
        int buf = 0;
        for (int kt = kt_hi; kt >= kt_lo; --kt) {
            if (kt > kt_lo) ATT_LOAD(kt - 1);
            const bool active = (kt <= cq) && (MODE != 1 || kt >= cq - 8);
            if (active) {
                const LAS unsigned char* kbp = lds + buf * ATT_BUF + prow * KSTR + hb * 16;
                const LAS unsigned char* vbp = lds + buf * ATT_BUF + VOFF + ql * 144 + hb * 16;
                f32x16 S0, S1;
#pragma unroll
                for (int i = 0; i < 16; ++i) { S0[i] = 0.f; S1[i] = 0.f; }
#pragma unroll
                for (int ks = 0; ks < 4; ++ks) {
                    const bf16x8 k0 = *(const LAS bf16x8*)(kbp + ks * 32);
                    const bf16x8 k1 = *(const LAS bf16x8*)(kbp + 32 * KSTR + ks * 32);
                    S0 = MFMA32(k0, Q[ks], S0); S1 = MFMA32(k1, Q[ks], S1);
                    if (ks & 1) __builtin_amdgcn_sched_barrier(0);
                }
                if (MODE == 0 || MODE == 2) {
                    const float base0 = (float)(tq - kt * 64 - 8 * hb), base1 = base0 - 32.0f;
#pragma unroll
                    for (int i = 0; i < 16; ++i) { const float off = (float)(16 * (i >> 3) + (i & 7));
                        S0[i] = S0[i] - slope2 * fabsf(base0 - off); S1[i] = S1[i] - slope2 * fabsf(base1 - off); }
                }
                if (MODE == 2) {
                    const unsigned long long W = MASK[(size_t)(b * SEQ + tq) * 32 + kt];
                    const unsigned w0 = (unsigned)W >> (8 * hb), w1 = (unsigned)(W >> 32) >> (8 * hb);
#pragma unroll
                    for (int i = 0; i < 16; ++i) { const int off = 16 * (i >> 3) + (i & 7);
                        S0[i] = ((w0 >> off) & 1u) ? S0[i] : NEG_INF_F; S1[i] = ((w1 >> off) & 1u) ? S1[i] : NEG_INF_F; }
                }
                if (MODE == 1) {
                    if (kt >= cq - 2) {
                        const int rel0 = tq - kt * 64 - 8 * hb + 128;
#pragma unroll
                        for (int i = 0; i < 16; ++i) { const int off = 16 * (i >> 3) + (i & 7);
                            int r0 = rel0 - off, r1 = rel0 - 32 - off;
                            r0 = r0 < 0 ? 0 : (r0 > 256 ? 256 : r0); r1 = r1 < 0 ? 0 : (r1 > 256 ? 256 : r1);
                            S0[i] += relb_l[r0]; S1[i] += relb_l[r1]; }
                    } else {
                        const float far = relb_l[256];
#pragma unroll
                        for (int i = 0; i < 16; ++i) { S0[i] += far; S1[i] += far; }
                    }
                }
                float mx = fmaxf(S0[0], S1[0]);
#pragma unroll
                for (int i = 1; i < 16; ++i) mx = fmaxf(mx, fmaxf(S0[i], S1[i]));
                mx = fmaxf(mx, shx(mx, 32, lane));
                const float mnew = fmaxf(mrun, mx);
                const float alpha = __builtin_amdgcn_exp2f(mrun - mnew);
                mrun = mnew;
                float ps = 0.f;
#pragma unroll
                for (int i = 0; i < 16; ++i) { S0[i] = __builtin_amdgcn_exp2f(S0[i] - mnew); S1[i] = __builtin_amdgcn_exp2f(S1[i] - mnew); ps += S0[i] + S1[i]; }
                lrun = lrun * alpha + ps;
#pragma unroll
                for (int eb = 0; eb < EB; ++eb) O[eb] = O[eb] * alpha;
                bf16x8 P[4];
                { u32x4 p;
                  p.x = pk_bf16(S0[0], S0[1]); p.y = pk_bf16(S0[2], S0[3]); p.z = pk_bf16(S0[4], S0[5]); p.w = pk_bf16(S0[6], S0[7]); P[0] = __builtin_bit_cast(bf16x8, p);
                  p.x = pk_bf16(S0[8], S0[9]); p.y = pk_bf16(S0[10], S0[11]); p.z = pk_bf16(S0[12], S0[13]); p.w = pk_bf16(S0[14], S0[15]); P[1] = __builtin_bit_cast(bf16x8, p);
                  p.x = pk_bf16(S1[0], S1[1]); p.y = pk_bf16(S1[2], S1[3]); p.z = pk_bf16(S1[4], S1[5]); p.w = pk_bf16(S1[6], S1[7]); P[2] = __builtin_bit_cast(bf16x8, p);
                  p.x = pk_bf16(S1[8], S1[9]); p.y = pk_bf16(S1[10], S1[11]); p.z = pk_bf16(S1[12], S1[13]); p.w = pk_bf16(S1[14], S1[15]); P[3] = __builtin_bit_cast(bf16x8, p); }
#pragma unroll
                for (int s4 = 0; s4 < 4; ++s4)
#pragma unroll
                    for (int eb = 0; eb < EB; ++eb) {
                        const bf16x8 vf = *(const LAS bf16x8*)(vbp + eb * 32 * 144 + s4 * 32);
                        O[eb] = MFMA32(vf, P[s4], O[eb]);
                        if (eb & 1) __builtin_amdgcn_sched_barrier(0);
                    }
            }
            if (kt > kt_lo) ATT_STORE(buf ^ 1);
            __syncthreads();
            buf ^= 1;
        }
#undef ATT_LOAD
#undef ATT_STORE
        const float inv = 1.0f / (lrun + shx(lrun, 32, lane));
        bf16_t* op = MIX + (size_t)(b * SEQ + tq) * 1024 + mixcol + 4 * hb;
        if (MODE == 0) {
            float* o1p = OA1 + (size_t)(b * SEQ + tq) * 512 + h * 128 + 4 * hb;
            if (mp == 0) {
#pragma unroll
                for (int eb = 0; eb < EB; ++eb)
#pragma unroll
                    for (int g = 0; g < 4; ++g) *(f32x4*)(o1p + eb * 32 + 8 * g) = (f32x4){O[eb][4 * g] * inv, O[eb][4 * g + 1] * inv, O[eb][4 * g + 2] * inv, O[eb][4 * g + 3] * inv};
            } else {
                const float c2 = lam * inv;
                float ss = 0.f;
#pragma unroll
                for (int eb = 0; eb < EB; ++eb)
#pragma unroll
                    for (int g = 0; g < 4; ++g) { const f32x4 o1 = *(const f32x4*)(o1p + eb * 32 + 8 * g);
#pragma unroll
                        for (int j = 0; j < 4; ++j) { const float o = o1[j] - O[eb][4 * g + j] * c2; O[eb][4 * g + j] = o; ss += o * o; } }
                ss += shx(ss, 32, lane);
                const float r = rsqrtf(ss * (1.0f / 128.0f) + EPS) * (1.0f - lam_init);
#pragma unroll
                for (int eb = 0; eb < EB; ++eb)
#pragma unroll
                    for (int g = 0; g < 4; ++g) { const int e0 = eb * 32 + 8 * g; const f32x4 sg = *(const f32x4*)(subg + e0 + 4 * hb);
                        *(u32x2*)(op + e0) = (u32x2){pk_bf16(O[eb][4 * g] * r * sg[0], O[eb][4 * g + 1] * r * sg[1]), pk_bf16(O[eb][4 * g + 2] * r * sg[2], O[eb][4 * g + 3] * r * sg[3])}; }
            }
        } else {
#pragma unroll
            for (int eb = 0; eb < EB; ++eb)
#pragma unroll
                for (int g = 0; g < 4; ++g) { const int e0 = eb * 32 + 8 * g;
                    *(u32x2*)(op + e0) = (u32x2){pk_bf16(O[eb][4 * g] * inv, O[eb][4 * g + 1] * inv), pk_bf16(O[eb][4 * g + 2] * inv, O[eb][4 * g + 3] * inv)}; }
        }
    }
}


constexpr int IDX_STR = 2052;
__device__ __forceinline__ unsigned f2key(float f) { const unsigned u = __float_as_uint(f); return u ^ (((unsigned)((int)u >> 31)) | 0x80000000u); }
__device__ __forceinline__ void index_unit(LAS unsigned char* lds, const bf16_t* HQ, unsigned long long* MASK, const int b, const int tt, const int wave) {
    int lane; asm volatile("v_mbcnt_lo_u32_b32 %0, -1, 0\n\tv_mbcnt_hi_u32_b32 %0, -1, %0" : "=&v"(lane));
    const int t0 = tt * 16, nb = (t0 >> 6) + 1, nk = nb * 64;
    if (nb <= 4) {
        for (int i = wave * 64 + lane; i < 16 * 32; i += 512) MASK[(size_t)(b * SEQ + t0 + (i >> 5)) * 32 + (i & 31)] = ((i & 31) < nb) ? ~0ull : 0ull;
        return;
    }
    LAS float* sc = (LAS float*)lds;
    const int q = lane & 15, g = lane >> 4;
    {
        const bf16_t* qrow = HQ + (size_t)(b * SEQ + t0 + q) * HQP;
        bf16x8 QI[8];
#pragma unroll
        for (int h = 0; h < 8; ++h) QI[h] = *(const bf16x8*)(qrow + HQ_QI + h * 32 + g * 8);
        float w[8];
        { const u32x4 wv = *(const u32x4*)(qrow + HQ_WI);
          w[0] = bf_lo(wv[0]) * 0.0625f; w[1] = bf_hi(wv[0]) * 0.0625f; w[2] = bf_lo(wv[1]) * 0.0625f; w[3] = bf_hi(wv[1]) * 0.0625f;
          w[4] = bf_lo(wv[2]) * 0.0625f; w[5] = bf_hi(wv[2]) * 0.0625f; w[6] = bf_lo(wv[3]) * 0.0625f; w[7] = bf_hi(wv[3]) * 0.0625f; }
        const bf16_t* kbase = HQ + (size_t)(b * SEQ + q) * HQP + HQ_KI + g * 8;
        for (int kb = wave; kb < nk / 16; kb += 8) {
            const bf16x8 kf = *(const bf16x8*)(kbase + (size_t)kb * 16 * HQP);
            f32x4 acc = {0.f, 0.f, 0.f, 0.f};
#pragma unroll
            for (int h = 0; h < 8; ++h) {
                const f32x4 z = __builtin_amdgcn_mfma_f32_16x16x32_bf16(kf, QI[h], (f32x4){0.f, 0.f, 0.f, 0.f}, 0, 0, 0);
#pragma unroll
                for (int j = 0; j < 4; ++j) acc[j] = fmaf(w[h], fmaxf(z[j], 0.f), acc[j]);
            }
#pragma unroll
            for (int j = 0; j < 4; ++j) acc[j] += 0.0f;
            *(LAS f32x4*)(sc + q * IDX_STR + kb * 16 + g * 4) = acc;
        }
    }
    __syncthreads();
#pragma unroll 1
    for (int qq = 0; qq < 2; ++qq) {
        const int ql = wave * 2 + qq;
        const LAS float* row = sc + ql * IDX_STR + lane;
        unsigned u[32];
#pragma unroll
        for (int j = 0; j < 32; ++j) u[j] = (j < nb) ? f2key(row[64 * j]) : 0u;
        unsigned prefix = 0u;
#pragma unroll 1
        for (int bit = 31; bit >= 0; --bit) {
            const unsigned cand = prefix | (1u << bit);
            int c = 0;
#pragma unroll
            for (int j = 0; j < 32; ++j) if (j < nb) c += (int)__builtin_popcountll(__ballot(u[j] >= cand));
            if (c >= 256) prefix = cand;
            if (c == 256) break;
        }
        const unsigned thr = prefix;
        int cg = 0;
#pragma unroll
        for (int j = 0; j < 32; ++j) if (j < nb) cg += (int)__builtin_popcountll(__ballot(u[j] > thr));
        const int quota = 256 - cg;
        int taken = 0;
        unsigned long long* mo = MASK + (size_t)(b * SEQ + t0 + ql) * 32;
        unsigned long long myword = 0ull;
#pragma unroll
        for (int j = 0; j < 32; ++j) {
            unsigned long long m = 0ull;
            if (j < nb) {
                const bool eq = (u[j] == thr);
                const unsigned long long eqm = __ballot(eq);
                const int before = (int)__builtin_popcountll(eqm & ((1ull << lane) - 1ull));
                m = __ballot((u[j] > thr) || (eq && (taken + before < quota)));
                taken += (int)__builtin_popcountll(eqm);
            }
            myword = (lane == j) ? m : myword;
        }
        if (lane < 32) mo[lane] = myword;
    }
    __syncthreads();
}

struct Args {
    const float* x; const float* w_in; const float* lam_q1; const float* lam_k1; const float* lam_q2; const float* lam_k2; const float* subln_g; const float* rel_bias;
    const float* w_out; const float* ln1_g; const float* ln1_b; const float* w_router; const float* b_router; const float* w_gu; const float* b_gu;
    const float* w_down; const float* b_down; const float* ln2_g; const float* ln2_b;
    float* out; unsigned char* ws;
    int ph_lo, ph_hi, bar_region, pad;
};

constexpr int LDS_STAGE = 0;
constexpr int LDS_CTL = 135168;
constexpr int LDS_TSTART = LDS_CTL + 64;
constexpr int LDS_CNT = LDS_TSTART + 36 * 4;
constexpr int LDS_TILEE = LDS_CNT + 32 * 4;
constexpr int LDS_RT = LDS_TILEE + 576;
constexpr int LDS_BYTES = 147456;
static_assert(LDS_RT + (64 + 1024) * 4 <= LDS_BYTES && 16 * IDX_STR * 4 <= LDS_CTL, "LDS map");

__device__ __forceinline__ void transpose_item(const float* W, int N, int k0, int n0, int nvalid, bf16_t* WTrow0, float scale, LAS float* scr, int lane) {
#pragma unroll 8
    for (int i = 0; i < 32; ++i) { const int kk = 2 * i + (lane >> 5), col = lane & 31; scr[kk * 33 + col] = (col < nvalid) ? W[(size_t)(k0 + kk) * N + n0 + col] * scale : 0.f; }
    asm volatile("s_waitcnt lgkmcnt(0)" ::: "memory");
    const int c = lane & 7;
#pragma unroll
    for (int j = 0; j < 4; ++j) { const int n = (lane >> 3) + 8 * j; const LAS float* s = scr + (8 * c) * 33 + n;
        u32x4 o; o.x = pk_bf16(s[0 * 33], s[1 * 33]); o.y = pk_bf16(s[2 * 33], s[3 * 33]); o.z = pk_bf16(s[4 * 33], s[5 * 33]); o.w = pk_bf16(s[6 * 33], s[7 * 33]);
        if (n < nvalid) *(u32x4*)(WTrow0 + (size_t)n * 1024 + k0 + 8 * c) = o; }
    asm volatile("s_waitcnt lgkmcnt(0)" ::: "memory");
}
__device__ __forceinline__ void in_map(int n0, bool& isv, int& row, float& scale) {
    scale = 1.f; isv = false;
    if (n0 < 512) { row = HQ_QA + n0; scale = QSCALE; }
    else if (n0 < 1024) row = HQ_KA + (n0 - 512);
    else if (n0 < 1536) { isv = true; row = VT_A + (n0 - 1024); }
    else if (n0 < 1792) { row = HQ_QB + (n0 - 1536); scale = QSCALE; }
    else if (n0 < 2048) row = HQ_KB + (n0 - 1792);
    else if (n0 < 2304) { isv = true; row = VT_B + (n0 - 2048); }
    else if (n0 < 2560) { row = HQ_QC + (n0 - 2304); scale = QSCALE; }
    else if (n0 < 2816) row = HQ_KC + (n0 - 2560);
    else if (n0 < 3072) { isv = true; row = VT_C + (n0 - 2816); }
    else if (n0 < 3328) row = HQ_QI + (n0 - 3072);
    else if (n0 < 3360) row = HQ_KI + (n0 - 3328);
    else row = HQ_WI + (n0 - 3360);
}

__global__ void __launch_bounds__(512, 2) mega(Args a) {
    extern __shared__ __attribute__((aligned(16))) unsigned char lds_raw[];
    LAS unsigned char* lds = (LAS unsigned char*)lds_raw;
    const int G = gridDim.x, bid = blockIdx.x, NGW = G * 8;
    const int wave = __builtin_amdgcn_readfirstlane((int)threadIdx.x >> 6);
#define OPAQUE_IDS() int lane; asm volatile("v_mbcnt_lo_u32_b32 %0, -1, 0\n\tv_mbcnt_hi_u32_b32 %0, -1, %0" : "=&v"(lane)); const int tid = wave * 64 + lane, gw = bid * 8 + wave; (void)tid; (void)gw
#define WSPTRS() unsigned char* ws = a.ws; asm volatile("" : "+s"(ws)); \
    unsigned* ctl = (unsigned*)(ws + WS_CTL); bf16_t* Win = (bf16_t*)(ws + WS_WIN); bf16_t* Wv = (bf16_t*)(ws + WS_WV); bf16_t* Wout = (bf16_t*)(ws + WS_WOUT); \
    bf16_t* Wgu = (bf16_t*)(ws + WS_WGU); bf16_t* Wdn = (bf16_t*)(ws + WS_WDN); bf16_t* XB = (bf16_t*)(ws + WS_XB); float* XF = (float*)(ws + WS_XF); \
    bf16_t* HQ = (bf16_t*)(ws + WS_HQ); bf16_t* VT = (bf16_t*)(ws + WS_VT); bf16_t* MIX = (bf16_t*)(ws + WS_MIX); \
    float* Y1 = (float*)(ws + WS_Y1); float* X1F = (float*)(ws + WS_X1F); bf16_t* X1B = (bf16_t*)(ws + WS_X1B); bf16_t* ACT = (bf16_t*)(ws + WS_ACT); bf16_t* YR = (bf16_t*)(ws + WS_YR); \
    int* TOKL = (int*)(ws + WS_TOKL); int* ASGE = (int*)(ws + WS_ASGE); int* ASGS = (int*)(ws + WS_ASGS); float* GATE = (float*)(ws + WS_GATE); \
    (void)ctl; (void)Win; (void)Wv; (void)Wout; (void)Wgu; (void)Wdn; (void)XB; (void)XF; (void)HQ; (void)VT; (void)MIX; (void)Y1; (void)X1F; (void)X1B; (void)ACT; (void)YR; (void)TOKL; (void)ASGE; (void)ASGS; (void)GATE
    for (int u = threadIdx.x; u < (LDS_BYTES - LDS_CTL) / 4; u += 512) ((LAS unsigned*)(lds + LDS_CTL))[u] = 0u;
    __syncthreads();
    XcdBarrier bar = xcd_barrier_post((unsigned*)(a.ws + WS_CTL) + CW_BAR + a.bar_region * XCD_BAR_WORDS, (volatile LAS unsigned*)(lds + LDS_CTL));
    const int lo = a.ph_lo, hi = a.ph_hi;
#define IN(k) (lo <= (k) && (k) < hi)
#define SEAM(k) do { if (IN(k) && IN((k) + 1)) xcd_barrier(bar); } while (0)

    if (IN(0)) {
        OPAQUE_IDS(); WSPTRS();
        LAS float* scr = (LAS float*)(lds + LDS_STAGE + wave * 16384);
        constexpr int I_IN = 16 * 106, I_OUT = 16 * 32, I_GU = 16 * 64, I_DN = 16 * 32;
        constexpr int N_IN = DEPTH * I_IN, N_OUT = DEPTH * I_OUT, N_GU = DEPTH * NE * I_GU, N_DN = DEPTH * NE * I_DN;
        for (int it = gw; it < N_IN + N_OUT + N_GU + N_DN; it += NGW) {
            int r = it;
            if (r < N_IN) { const int l = r / I_IN, q = r % I_IN, kb = q / 106, nb = q % 106, n0 = nb * 32; bool isv; int row; float sc; in_map(n0, isv, row, sc);
                bf16_t* dst = isv ? Wv + ((size_t)l * 1024 + row) * 1024 : Win + ((size_t)l * HQP + row) * 1024;
                transpose_item(a.w_in + (size_t)l * D * DIN, DIN, kb * 64, n0, (DIN - n0) < 32 ? (DIN - n0) : 32, dst, sc, scr, lane); continue; }
            r -= N_IN;
            if (r < N_OUT) { const int l = r / I_OUT, q = r % I_OUT, kb = q / 32, nb = q % 32;
                transpose_item(a.w_out + (size_t)l * 1024 * D, D, kb * 64, nb * 32, 32, Wout + ((size_t)l * D + nb * 32) * 1024, 1.f, scr, lane); continue; }
            r -= N_OUT;
            if (r < N_GU) { const int le = r / I_GU, q = r % I_GU, kb = q / 64, nb = q % 64, n0 = nb * 32;
                const int bj = n0 >> 10, rr = n0 & 1023, pn = rr >> 7, c = rr & 127, nrow = pn * 256 + bj * 128 + c;
                transpose_item(a.w_gu + (size_t)le * D * 2048, 2048, kb * 64, n0, 32, Wgu + ((size_t)le * 2048 + nrow) * 1024, 1.f, scr, lane); continue; }
            r -= N_GU;
            { const int le = r / I_DN, q = r % I_DN, kb = q / 32, nb = q % 32;
                transpose_item(a.w_down + (size_t)le * 1024 * D, D, kb * 64, nb * 32, 32, Wdn + ((size_t)le * D + nb * 32) * 1024, 1.f, scr, lane); }
        }
        for (int i = gw * 64 + lane; i < DEPTH * (HQP - HQ_USED) * 128; i += NGW * 64) { const int l = i / ((HQP - HQ_USED) * 128), q = i % ((HQP - HQ_USED) * 128);
            *(u32x4*)(Win + ((size_t)l * HQP + HQ_USED) * 1024 + (size_t)q * 8) = (u32x4){0u, 0u, 0u, 0u}; }
        for (size_t i = (size_t)gw * 64 + lane; i < (size_t)T * D / 8; i += (size_t)NGW * 64) { const f32x4 v0 = *(const f32x4*)(a.x + i * 8), v1 = *(const f32x4*)(a.x + i * 8 + 4);
            u32x4 w; w.x = pk_bf16(v0[0], v0[1]); w.y = pk_bf16(v0[2], v0[3]); w.z = pk_bf16(v1[0], v1[1]); w.w = pk_bf16(v1[2], v1[3]); *(u32x4*)(XB + i * 8) = w; }
    }
    SEAM(0);

#pragma unroll 1
    for (int l = 0; l < DEPTH; ++l) {
        const int pb = 1 + 8 * l;
        if (IN(pb + 0)) {
            WSPTRS();
            { pg8::DenseOrder S{T / 256, HQP / 256, G, bid, (const char*)(Win + (size_t)l * HQP * 1024), 1024, false};
              pg8::EpiBf16Plain E{HQ, HQP};
              pg8::gemm_phase<pg8::EpiBf16Plain, pg8::DenseOrder, false>(lds + LDS_STAGE, XB, 1024, S, E, wave); }
            { pg8::DenseOrder S{1024 / 256, T / 256, G, bid, (const char*)XB, 1024, true};
              pg8::EpiBf16Plain E{VT, T};
              pg8::gemm_phase<pg8::EpiBf16Plain, pg8::DenseOrder, false>(lds + LDS_STAGE, Wv + (size_t)l * 1024 * 1024, 1024, S, E, wave); }
        }
        SEAM(pb + 0);
        if (IN(pb + 1)) {
            OPAQUE_IDS(); WSPTRS();
            unsigned long long* MASKp = (unsigned long long*)(ws + WS_MASK); float* OA1p = (float*)(ws + WS_OA1);
            const float lam_init = 0.8f - 0.6f * expf(-0.3f * (float)l);
            const float lam = expf(wsum(a.lam_q1[l * 64 + lane] * a.lam_k1[l * 64 + lane], lane)) - expf(wsum(a.lam_q2[l * 64 + lane] * a.lam_k2[l * 64 + lane], lane)) + lam_init;
            const int v0 = (G % 8 == 0) ? (bid & 7) * (G >> 3) + (bid >> 3) : bid;
            for (int v = v0; v < 256; v += G) {
                const int b = v >> 4, h = (v >> 2) & 3, q0 = v & 3, j16 = v & 15;
#pragma unroll 1
                for (int k = 0; k < 8; ++k) index_unit(lds + LDS_STAGE, HQ, MASKp, b, 16 * k + ((k & 1) ? 15 - j16 : j16), wave);
#pragma unroll 1
                for (int rep = 0; rep < 2; ++rep) attn_unit<0>(lds + LDS_STAGE, HQ, VT, MIX, MASKp, OA1p, b, h, rep ? 7 - q0 : q0, wave, lane, lam, lam_init, a.subln_g + l * 128, nullptr);
#pragma unroll 1
                for (int rep = 0; rep < 2; ++rep) attn_unit<1>(lds + LDS_STAGE, HQ, VT, MIX, MASKp, OA1p, b, h, rep ? 7 - q0 : q0, wave, lane, 0.f, 0.f, nullptr, a.rel_bias + ((size_t)l * 4 + h) * 257);
            }
        }
        SEAM(pb + 1);
        if (IN(pb + 2)) {
            OPAQUE_IDS(); WSPTRS();
            unsigned long long* MASKp = (unsigned long long*)(ws + WS_MASK); float* OA1p = (float*)(ws + WS_OA1);
            const int v0 = (G % 8 == 0) ? (bid & 7) * (G >> 3) + (bid >> 3) : bid;
            for (int v = v0; v < 256; v += G) {
                const int b = v >> 4, h = (v >> 2) & 3, q0 = v & 3;
#pragma unroll 1
                for (int rep = 0; rep < 2; ++rep) attn_unit<2>(lds + LDS_STAGE, HQ, VT, MIX, MASKp, OA1p, b, h, rep ? 7 - q0 : q0, wave, lane, 0.f, 0.f, nullptr, nullptr);
            }
        }
        SEAM(pb + 2);
        if (IN(pb + 3)) {
            WSPTRS(); const float* xres = (l == 0) ? a.x : XF;
            pg8::DenseOrder S{T / 256, 4, G, bid, (const char*)(Wout + (size_t)l * 1024 * 1024), 1024, false};
            pg8::EpiResF32 E{Y1, xres};
            pg8::gemm_phase<pg8::EpiResF32, pg8::DenseOrder, false>(lds + LDS_STAGE, MIX, 1024, S, E, wave);
        }
        SEAM(pb + 3);
        if (IN(pb + 4)) {
            OPAQUE_IDS(); WSPTRS();
            LAS int* lcnt = (LAS int*)(lds + LDS_RT); LAS int* lbase = lcnt + 32; LAS int* asg_e = lcnt + 64; LAS int* asg_ls = asg_e + 512;
            const float* g1 = a.ln1_g + l * D; const float* b1 = a.ln1_b + l * D; const float* wr = a.w_router + (size_t)l * D * NE; const float* br = a.b_router + l * NE;
            unsigned* gcnt = ctl + CW_CNT + l * 64;
            for (int unit = bid; unit < T / 128; unit += G) {
                if (tid < 32) lcnt[tid] = 0;
                __syncthreads();
                for (int k = 0; k < 16; ++k) {
                    const int tl = wave * 16 + k, t = unit * 128 + tl;
                    float v[16];
#pragma unroll
                    for (int i = 0; i < 4; ++i) { const f32x4 u4 = *(const f32x4*)(Y1 + (size_t)t * D + i * 256 + lane * 4); v[4 * i] = u4[0]; v[4 * i + 1] = u4[1]; v[4 * i + 2] = u4[2]; v[4 * i + 3] = u4[3]; }
                    float s = 0.f;
#pragma unroll
                    for (int i = 0; i < 16; ++i) s += v[i];
                    const float mean = wsum(s, lane) * (1.0f / 1024.0f);
                    float qv = 0.f;
#pragma unroll
                    for (int i = 0; i < 16; ++i) { const float d = v[i] - mean; qv += d * d; }
                    const float rstd = rsqrtf(wsum(qv, lane) * (1.0f / 1024.0f) + EPS);
                    float part[32];
#pragma unroll
                    for (int e = 0; e < 32; ++e) part[e] = 0.f;
#pragma unroll
                    for (int i = 0; i < 4; ++i) {
                        const int c0 = i * 256 + lane * 4;
                        const f32x4 gg = *(const f32x4*)(g1 + c0), bb = *(const f32x4*)(b1 + c0);
                        float o[4];
#pragma unroll
                        for (int j = 0; j < 4; ++j) o[j] = (v[4 * i + j] - mean) * rstd * gg[j] + bb[j];
                        *(f32x4*)(X1F + (size_t)t * D + c0) = (f32x4){o[0], o[1], o[2], o[3]};
                        *(u32x2*)(X1B + (size_t)t * D + c0) = (u32x2){pk_bf16(o[0], o[1]), pk_bf16(o[2], o[3])};
#pragma unroll
                        for (int j = 0; j < 4; ++j) {
                            const f32x4* wp = (const f32x4*)(wr + (size_t)(c0 + j) * 32);
#pragma unroll
                            for (int e4 = 0; e4 < 8; ++e4) { const f32x4 wv = wp[e4];
#pragma unroll
                                for (int jj = 0; jj < 4; ++jj) part[4 * e4 + jj] = fmaf(o[j], wv[jj], part[4 * e4 + jj]); }
                        }
                    }
                    float p16[16], p8[8], p4[4], p2[2], lg;
                    { const bool hi = (lane & 32) != 0;
#pragma unroll
                      for (int i = 0; i < 16; ++i) { const float keep = hi ? part[i + 16] : part[i], send = hi ? part[i] : part[i + 16]; p16[i] = keep + shx(send, 32, lane); } }
                    { const bool hi = (lane & 16) != 0;
#pragma unroll
                      for (int i = 0; i < 8; ++i) { const float keep = hi ? p16[i + 8] : p16[i], send = hi ? p16[i] : p16[i + 8]; p8[i] = keep + shx(send, 16, lane); } }
                    { const bool hi = (lane & 8) != 0;
#pragma unroll
                      for (int i = 0; i < 4; ++i) { const float keep = hi ? p8[i + 4] : p8[i], send = hi ? p8[i] : p8[i + 4]; p4[i] = keep + shx(send, 8, lane); } }
                    { const bool hi = (lane & 4) != 0;
#pragma unroll
                      for (int i = 0; i < 2; ++i) { const float keep = hi ? p4[i + 2] : p4[i], send = hi ? p4[i] : p4[i + 2]; p2[i] = keep + shx(send, 4, lane); } }
                    { const bool hi = (lane & 2) != 0; const float keep = hi ? p2[1] : p2[0], send = hi ? p2[0] : p2[1]; lg = keep + shx(send, 2, lane); }
                    lg += shx(lg, 1, lane);
                    lg += br[lane >> 1];
                    int be[4]; float bv[4];
#pragma unroll
                    for (int kk = 0; kk < 4; ++kk) {
                        const float mx = wmax(lg, lane);
                        const unsigned long long bal = __ballot(lg == mx);
                        const int e = (__ffsll((long long)bal) - 1) >> 1;
                        be[kk] = e; bv[kk] = mx;
                        if ((lane >> 1) == e) lg = -3e38f;
                    }
                    float ex[4], es = 0.f;
#pragma unroll
                    for (int kk = 0; kk < 4; ++kk) { ex[kk] = __expf(bv[kk] - bv[0]); es += ex[kk]; }
                    if (lane == 0) {
#pragma unroll
                        for (int kk = 0; kk < 4; ++kk) { const int sl = __hip_atomic_fetch_add(&lcnt[be[kk]], 1, __ATOMIC_RELAXED, __HIP_MEMORY_SCOPE_WORKGROUP); asg_e[tl * 4 + kk] = be[kk]; asg_ls[tl * 4 + kk] = sl; GATE[t * 4 + kk] = ex[kk] / es; }
                    }
                }
                __syncthreads();
                if (tid < 32) lbase[tid] = (int)__hip_atomic_fetch_add(gcnt + tid, (unsigned)lcnt[tid], __ATOMIC_RELAXED, __HIP_MEMORY_SCOPE_AGENT);
                __syncthreads();
                { const int e = asg_e[tid], sl = lbase[e] + asg_ls[tid], t = unit * 128 + (tid >> 2);
                  TOKL[(size_t)e * T + sl] = t; ASGE[t * 4 + (tid & 3)] = e; ASGS[t * 4 + (tid & 3)] = sl; }
                __syncthreads();
            }
        }
        SEAM(pb + 4);
        LAS int* tstart = (LAS int*)(lds + LDS_TSTART); LAS int* lcntE = (LAS int*)(lds + LDS_CNT); LAS unsigned char* tile_e = lds + LDS_TILEE;
        if (IN(pb + 5) || IN(pb + 6) || IN(pb + 7)) {
            OPAQUE_IDS(); WSPTRS();
            if (tid < 32) lcntE[tid] = (int)__hip_atomic_load(ctl + CW_CNT + l * 64 + tid, __ATOMIC_RELAXED, __HIP_MEMORY_SCOPE_AGENT);
            __syncthreads();
            if (tid == 0) { int acc = 0; for (int e = 0; e < NE; ++e) { tstart[e] = acc; acc += (lcntE[e] + 255) >> 8; } tstart[32] = acc; }
            __syncthreads();
            for (int q = tid; q < MAXRT; q += 512) { int e = 0; for (int k = 0; k < NE; ++k) if (q >= tstart[k]) e = k; tile_e[q] = (unsigned char)e; }
            __syncthreads();
        }
        pg8::MoeTables tb{tstart, lcntE, tile_e, tstart[32]};
        if (IN(pb + 5)) {
            WSPTRS();
            pg8::MoeOrder S{tb, 8, G, bid, (const char*)(Wgu + (size_t)l * NE * 2048 * 1024), (size_t)2048 * 1024 * 2, TOKL, true};
            pg8::EpiSwiglu E{ACT, a.b_gu + (size_t)l * NE * 2048};
            pg8::gemm_phase<pg8::EpiSwiglu, pg8::MoeOrder, true>(lds + LDS_STAGE, X1B, 1024, S, E, wave);
        }
        SEAM(pb + 5);
        if (IN(pb + 6)) {
            WSPTRS();
            pg8::MoeOrder S{tb, 4, G, bid, (const char*)(Wdn + (size_t)l * NE * 1024 * 1024), (size_t)1024 * 1024 * 2, TOKL, false};
            pg8::EpiBiasBf16 E{YR, a.b_down + (size_t)l * NE * 1024};
            pg8::gemm_phase<pg8::EpiBiasBf16, pg8::MoeOrder, false>(lds + LDS_STAGE, ACT, 1024, S, E, wave);
        }
        SEAM(pb + 6);
        if (IN(pb + 7)) {
            OPAQUE_IDS(); WSPTRS(); float* xout = (l == DEPTH - 1) ? a.out : XF;
            const float* g2 = a.ln2_g + l * D; const float* b2 = a.ln2_b + l * D;
            for (int t = gw; t < T; t += NGW) {
                float v[16];
#pragma unroll
                for (int i = 0; i < 4; ++i) { const f32x4 u4 = *(const f32x4*)(X1F + (size_t)t * D + i * 256 + lane * 4);
#pragma unroll
                    for (int j = 0; j < 4; ++j) v[4 * i + j] = ALPHA * u4[j]; }
#pragma unroll
                for (int k = 0; k < 4; ++k) {
                    const int e = ASGE[t * 4 + k]; const float gk = GATE[t * 4 + k];
                    const bf16_t* yp = YR + ((size_t)tstart[e] * 256 + ASGS[t * 4 + k]) * 1024;
#pragma unroll
                    for (int i = 0; i < 4; ++i) { const u32x2 u2 = *(const u32x2*)(yp + i * 256 + lane * 4);
                        v[4 * i] += gk * bf_lo(u2[0]); v[4 * i + 1] += gk * bf_hi(u2[0]); v[4 * i + 2] += gk * bf_lo(u2[1]); v[4 * i + 3] += gk * bf_hi(u2[1]); }
                }
                float s = 0.f;
#pragma unroll
                for (int i = 0; i < 16; ++i) s += v[i];
                const float mean = wsum(s, lane) * (1.0f / 1024.0f);
                float qv = 0.f;
#pragma unroll
                for (int i = 0; i < 16; ++i) { const float d = v[i] - mean; qv += d * d; }
                const float rstd = rsqrtf(wsum(qv, lane) * (1.0f / 1024.0f) + EPS);
#pragma unroll
                for (int i = 0; i < 4; ++i) {
                    const int c0 = i * 256 + lane * 4;
                    const f32x4 gg = *(const f32x4*)(g2 + c0), bb = *(const f32x4*)(b2 + c0);
                    float o[4];
#pragma unroll
                    for (int j = 0; j < 4; ++j) o[j] = (v[4 * i + j] - mean) * rstd * gg[j] + bb[j];
                    *(f32x4*)(xout + (size_t)t * D + c0) = (f32x4){o[0], o[1], o[2], o[3]};
                    *(u32x2*)(XB + (size_t)t * D + c0) = (u32x2){pk_bf16(o[0], o[1]), pk_bf16(o[2], o[3])};
                }
            }
        }
        if (l + 1 < DEPTH) SEAM(pb + 7);
    }
#undef IN
#undef SEAM
}

extern "C" void kernel_launch(void* const* d_in, const int* in_sizes, int n_in, void* d_out, int out_size, void* d_ws, size_t ws_size, hipStream_t stream) {
    static int grid = 0;
    if (grid == 0) {
        if (ws_size < WS_END) { fprintf(stderr, "kernel_launch: workspace too small (%zu < %zu)\n", ws_size, (size_t)WS_END); grid = -1; return; }
        int dev = 0, cus = 0, per_cu = 0;
        if (hipGetDevice(&dev) != hipSuccess || hipDeviceGetAttribute(&cus, hipDeviceAttributeMultiprocessorCount, dev) != hipSuccess) { grid = -1; return; }
        if (hipFuncSetAttribute((const void*)mega, hipFuncAttributeMaxDynamicSharedMemorySize, LDS_BYTES) != hipSuccess) { fprintf(stderr, "kernel_launch: hipFuncSetAttribute failed\n"); grid = -1; return; }
        if (hipOccupancyMaxActiveBlocksPerMultiprocessor(&per_cu, (const void*)mega, 512, LDS_BYTES) != hipSuccess || per_cu < 1) { fprintf(stderr, "kernel_launch: occupancy query says %d\n", per_cu); }
        (void)hipGetLastError();
        grid = cus;
        if (grid % 8 != 0) grid -= grid % 8;
    }
    if (grid < 0) return;
    (void)hipMemsetAsync((char*)d_ws + WS_CTL, 0, CTL_BYTES, stream);
    Args a{};
    a.x = (const float*)d_in[0]; a.w_in = (const float*)d_in[1]; a.lam_q1 = (const float*)d_in[2]; a.lam_k1 = (const float*)d_in[3]; a.lam_q2 = (const float*)d_in[4]; a.lam_k2 = (const float*)d_in[5];
    a.subln_g = (const float*)d_in[6]; a.rel_bias = (const float*)d_in[7]; a.w_out = (const float*)d_in[8]; a.ln1_g = (const float*)d_in[9]; a.ln1_b = (const float*)d_in[10];
    a.w_router = (const float*)d_in[11]; a.b_router = (const float*)d_in[12]; a.w_gu = (const float*)d_in[13]; a.b_gu = (const float*)d_in[14]; a.w_down = (const float*)d_in[15];
    a.b_down = (const float*)d_in[16]; a.ln2_g = (const float*)d_in[17]; a.ln2_b = (const float*)d_in[18];
    a.out = (float*)d_out; a.ws = (unsigned char*)d_ws; a.pad = 0;
    a.ph_lo = 0; a.ph_hi = 1 + 8 * DEPTH; a.bar_region = 0;
    hipLaunchKernelGGL(mega, dim3(grid), dim3(512), LDS_BYTES, stream, a);
}
```

```cpp
#include <hip/hip_runtime.h>
#include <stdint.h>
#include <cstdio>

#define LAS __attribute__((address_space(3)))
typedef unsigned short bf16_t;
typedef short bf16x8 __attribute__((ext_vector_type(8)));
typedef float f32x4 __attribute__((ext_vector_type(4)));
typedef float f32x2 __attribute__((ext_vector_type(2)));
typedef unsigned u32x4 __attribute__((ext_vector_type(4)));
typedef unsigned u32x2 __attribute__((ext_vector_type(2)));
typedef __bf16 bf16v2 __attribute__((ext_vector_type(2)));

constexpr int D = 1024, BATCH = 16, SEQ = 2048, T = BATCH * SEQ, DEPTH = 4;
constexpr int DIN = 3368;
constexpr int NE = 32;
constexpr float ALPHA = 1.681792830507429f;
constexpr float EPS = 1e-5f;
constexpr float LOG2E = 1.4426950408889634f;
constexpr float QSCALE = 0.125f * LOG2E;
constexpr int HQP = 2560;
constexpr int HQ_QA = 0, HQ_KA = 512, HQ_QB = 1024, HQ_KB = 1280, HQ_QC = 1536, HQ_KC = 1792, HQ_QI = 2048, HQ_KI = 2304, HQ_WI = 2336, HQ_USED = 2344;
constexpr int VT_A = 0, VT_B = 512, VT_C = 768;
constexpr int NASG = T * 4;
constexpr int GROWS = NASG + NE * 256;
constexpr int MAXRT = GROWS / 256;

constexpr size_t MiB = (size_t)1 << 20;
constexpr size_t al(size_t x) { return (x + 255) & ~(size_t)255; }
constexpr size_t WS_CTL = 0, CTL_BYTES = 4 * MiB;
constexpr size_t WS_WIN = WS_CTL + CTL_BYTES;
constexpr size_t WS_WV = WS_WIN + al((size_t)DEPTH * HQP * D * 2);
constexpr size_t WS_WOUT = WS_WV + al((size_t)DEPTH * 1024 * D * 2);
constexpr size_t WS_WGU = WS_WOUT + al((size_t)DEPTH * D * 1024 * 2);
constexpr size_t WS_WDN = WS_WGU + al((size_t)DEPTH * NE * 2048 * D * 2);
constexpr size_t WS_XB = WS_WDN + al((size_t)DEPTH * NE * D * 1024 * 2);
constexpr size_t WS_XF = WS_XB + al((size_t)T * D * 2);
constexpr size_t WS_HQ = WS_XF + al((size_t)T * D * 4);
constexpr size_t WS_VT = WS_HQ + al((size_t)T * HQP * 2);
constexpr size_t WS_MIX = WS_VT + al((size_t)1024 * T * 2);
constexpr size_t WS_Y1 = WS_MIX + al((size_t)T * 1024 * 2);
constexpr size_t WS_X1F = WS_Y1 + al((size_t)T * D * 4);
constexpr size_t WS_X1B = WS_X1F + al((size_t)T * D * 4);
constexpr size_t WS_ACT = WS_X1B + al((size_t)T * D * 2);
constexpr size_t WS_YR = WS_ACT + al((size_t)GROWS * 1024 * 2);
constexpr size_t WS_MASK = WS_YR + al((size_t)GROWS * 1024 * 2);
constexpr size_t WS_TOKL = WS_MASK + al((size_t)T * 32 * 8);
constexpr size_t WS_ASGE = WS_TOKL + al((size_t)NE * T * 4);
constexpr size_t WS_ASGS = WS_ASGE + al((size_t)NASG * 4);
constexpr size_t WS_GATE = WS_ASGS + al((size_t)NASG * 4);
constexpr size_t WS_OA1 = WS_GATE + al((size_t)NASG * 4);
constexpr size_t WS_WRT = WS_OA1 + al((size_t)T * 512 * 4);
constexpr size_t WS_END = WS_WRT + al((size_t)DEPTH * NE * D * 4);
constexpr int CW_BAR = 4096;
constexpr int CW_CNT = 262144;

__device__ __forceinline__ unsigned pk_bf16(float lo, float hi) { f32x2 v = {lo, hi}; return __builtin_bit_cast(unsigned, __builtin_convertvector(v, bf16v2)); }
__device__ __forceinline__ float bf_lo(unsigned u) { return __uint_as_float(u << 16); }
__device__ __forceinline__ float bf_hi(unsigned u) { return __uint_as_float(u & 0xffff0000u); }
__device__ __forceinline__ float bf2f(bf16_t b) { return __uint_as_float(((unsigned)b) << 16); }
__device__ __forceinline__ float wave_sum(float v) {
#pragma unroll
    for (int o = 32; o > 0; o >>= 1) v += __shfl_xor(v, o);
    return v; }
__device__ __forceinline__ float wave_max(float v) {
#pragma unroll
    for (int o = 32; o > 0; o >>= 1) v = fmaxf(v, __shfl_xor(v, o));
    return v; }
__device__ __forceinline__ int wave_sum_i(int v) {
#pragma unroll
    for (int o = 32; o > 0; o >>= 1) v += __shfl_xor(v, o);
    return v; }

__device__ __forceinline__ float shx(float v, int o, int lane) { return __int_as_float(__builtin_amdgcn_ds_bpermute((lane ^ o) << 2, __float_as_int(v))); }
__device__ __forceinline__ float wsum(float v, int lane) {
#pragma unroll
    for (int o = 32; o > 0; o >>= 1) v += shx(v, o, lane);
    return v; }
__device__ __forceinline__ float wmax(float v, int lane) {
#pragma unroll
    for (int o = 32; o > 0; o >>= 1) v = fmaxf(v, shx(v, o, lane));
    return v; }

#define XB_TMO      128
#define XB_XCNT(j)  (256  + 64 * (j))
#define XB_XSUB(j)  (1280 + 64 * (j))
#define XB_XGEN(j)  (2304 + 64 * (j))
#define XB_TOP      3328
#define XB_TOPGEN   3392
#define XCD_BAR_WORDS 3456
#define XB_SPIN_CAP (1u << 22)
__device__ __forceinline__ unsigned xb_ld(unsigned* p)              { return __hip_atomic_load(p, __ATOMIC_RELAXED, __HIP_MEMORY_SCOPE_AGENT); }
__device__ __forceinline__ unsigned xb_add(unsigned* p, unsigned v) { return __hip_atomic_fetch_add(p, v, __ATOMIC_RELAXED, __HIP_MEMORY_SCOPE_AGENT); }
__device__ __forceinline__ unsigned xb_xcc_id() { return (unsigned)__builtin_amdgcn_s_getreg((3 << 11) | 20) & 0xFu; }
#define XB_SPIN(cond, bar) do { unsigned _sp = 0; while (cond) { __builtin_amdgcn_s_sleep(1); \
    if ((++_sp & 255u) == 0u) { if (xb_ld(&(bar)[XB_TMO])) break; if (_sp > XB_SPIN_CAP) { atomicAdd(&(bar)[XB_TMO], 1u); break; } } } } while (0)
struct XcdBarrier { unsigned* bar; unsigned x; volatile LAS unsigned* st; };
__device__ __forceinline__ XcdBarrier xcd_barrier_post(unsigned* bar, volatile LAS unsigned* st) {
    XcdBarrier b; b.bar = bar; b.x = xb_xcc_id(); b.st = st;
    if (threadIdx.x == 0) (void)xb_add(&bar[XB_XCNT(b.x)], 1u);
    return b;
}
__device__ __forceinline__ void xcd_barrier_complete(unsigned* bar, unsigned x, unsigned& nloc, unsigned& nx) {
    const unsigned G = gridDim.x * gridDim.y * gridDim.z;
    unsigned sum, cnt, mine, sp = 0u;
    for (;;) {
        sum = 0u; cnt = 0u; mine = 0u;
#pragma unroll
        for (unsigned j = 0; j < 16; ++j) { const unsigned c = xb_ld(&bar[XB_XCNT(j)]); sum += c; cnt += (c > 0u) ? 1u : 0u; mine = (j == x) ? c : mine; }
        if (sum == G) break;
        __builtin_amdgcn_s_sleep(1);
        if ((++sp & 255u) == 0u) { if (xb_ld(&bar[XB_TMO])) break; if (sp > XB_SPIN_CAP) { atomicAdd(&bar[XB_TMO], 1u); break; } }
    }
    nloc = mine > 0u ? mine : 1u; nx = cnt > 0u ? cnt : 1u;
}
__device__ __forceinline__ void xcd_barrier(const XcdBarrier& b) {
    asm volatile("s_waitcnt vmcnt(0)" ::: "memory");
    __syncthreads();
    if (threadIdx.x == 0) {
        unsigned* bar = b.bar;
        __builtin_amdgcn_s_waitcnt(0);
        unsigned nloc = b.st[0], nx = b.st[1];
        if (nloc == 0u) { xcd_barrier_complete(bar, b.x, nloc, nx); b.st[0] = nloc; b.st[1] = nx; }
        const unsigned old = xb_add(&bar[XB_XSUB(b.x)], 1u);
        const unsigned gen = old / nloc;
        if (old + 1u == (gen + 1u) * nloc) {
            __builtin_amdgcn_fence(__ATOMIC_RELEASE, "agent");
            asm volatile("s_waitcnt vmcnt(0)" ::: "memory");
            const unsigned og = xb_add(&bar[XB_TOP], 1u);
            const unsigned tg = og / nx;
            if (og + 1u == (tg + 1u) * nx) xb_add(&bar[XB_TOPGEN], 1u);
            else XB_SPIN(xb_ld(&bar[XB_TOPGEN]) == tg, bar);
            __builtin_amdgcn_fence(__ATOMIC_ACQUIRE, "agent");
            xb_add(&bar[XB_XGEN(b.x)], 1u);
            asm volatile("s_waitcnt vmcnt(0)" ::: "memory");
        } else {
            XB_SPIN(xb_ld(&bar[XB_XGEN(b.x)]) == gen, bar);
            __builtin_amdgcn_fence(__ATOMIC_ACQUIRE, "agent");
            asm volatile("s_waitcnt vmcnt(0)" ::: "memory");
        }
    }
    __syncthreads();
}

namespace pg8 {
constexpr int BM = 256, BK = 64, HALF = 128, HTB = HALF * BK * 2, STAGE_BYTES = 8 * HTB;
__host__ __device__ __forceinline__ int lds_byte(int r, int c) { const int st = (r >> 4) * 2 + (c >> 5), rr = r & 15, cc = c & 31, ob = rr * 64 + cc * 2; return st * 1024 + (ob ^ (((ob >> 9) & 1) << 5)); }
__host__ __device__ __forceinline__ void stage_rc(int b, int& R, int& C) { const int st = b / 1024, sb = b % 1024, swz = sb ^ (((sb >> 9) & 1) << 5); R = (st >> 1) * 16 + swz / 64; C = (st & 1) * 32 + (swz % 64) / 2; }
__host__ __device__ __forceinline__ int perm32(int rho) { const int n = rho >> 4, i = rho & 15; return 8 * (i >> 2) + 4 * n + (i & 3); }

struct Unit {
    int row0;
    int col0;
    const char* Bt;
    const int* rows;
    int nvalid;
    int e;
};

template <class Epi, class Sched, bool GATHER>
__device__ __forceinline__ void gemm_phase(LAS unsigned char* lds, const bf16_t* Abase, const int K, const Sched& S, const Epi& E, const int wid) {
    int lane; asm volatile("v_mbcnt_lo_u32_b32 %0, -1, 0\n\tv_mbcnt_hi_u32_b32 %0, -1, %0" : "=&v"(lane));
    const int tid = wid * 64 + lane, wr = wid >> 2, wc = wid & 3, fr = lane & 15, fq = lane >> 4;
    const int nt = K / BK;
    int Rl[2], Cl[2]; unsigned voffB[2];
#pragma unroll
    for (int i = 0; i < 2; ++i) { int R, C; stage_rc(tid * 16 + i * 8192, R, C); Rl[i] = R; Cl[i] = C; const int Rb = Epi::PERM ? ((R & ~31) + perm32(R & 31)) : R; voffB[i] = (unsigned)(Rb * K + C) * 2u; }
    const size_t kstep = (size_t)(BK * 2);
    const size_t hstep = (size_t)HALF * K * 2;
    const unsigned ldsw = (unsigned)wid * 1024u;
    const int aoff = lds_byte(wr * 64 + fr, fq * 8), boff = lds_byte(wc * 32 + fr, fq * 8);
#define PG8_SA(b, h) (((b) * 2 + (h)) * HTB)
#define PG8_SB(b, h) ((4 + (b) * 2 + (h)) * HTB)
#define PG8_STAGE(bufoff, gbase, voff) do { _Pragma("unroll") for (int _i = 0; _i < 2; ++_i) \
        __builtin_amdgcn_global_load_lds((const unsigned*)((const char*)(gbase) + (voff)[_i]), (LAS unsigned*)(lds + (bufoff) + ldsw + _i * 8192), 16, 0, 0); } while (0)
#define PG8_LDA(dst, b, h) do { _Pragma("unroll") for (int m = 0; m < 4; ++m) _Pragma("unroll") for (int k = 0; k < 2; ++k) dst[m][k] = *(const LAS bf16x8*)(lds + PG8_SA(b, h) + aoff + m * 2048 + k * 1024); } while (0)
#define PG8_LDB(dst, b, h) do { _Pragma("unroll") for (int n = 0; n < 2; ++n) _Pragma("unroll") for (int k = 0; k < 2; ++k) dst[n][k] = *(const LAS bf16x8*)(lds + PG8_SB(b, h) + boff + n * 2048 + k * 1024); } while (0)
#define PG8_MMA(ai, bj, At, Bt) do { __builtin_amdgcn_s_setprio(1); _Pragma("unroll") for (int m = 0; m < 4; ++m) _Pragma("unroll") for (int n = 0; n < 2; ++n) _Pragma("unroll") for (int k = 0; k < 2; ++k) \
        acc[ai][bj][m][n] = __builtin_amdgcn_mfma_f32_16x16x32_bf16(Bt[n][k], At[m][k], acc[ai][bj][m][n], 0, 0, 0); __builtin_amdgcn_s_setprio(0); } while (0)
#define PG8_WAIT_V(n) asm volatile("s_waitcnt vmcnt(" #n ")" ::: "memory")
#define PG8_WAIT_L(n) asm volatile("s_waitcnt lgkmcnt(" #n ")" ::: "memory")
#define PG8_BAR __builtin_amdgcn_s_barrier()
#define PG8_SCHED __builtin_amdgcn_sched_barrier(0)
#define PG8_AOFFS(dst, u) do { _Pragma("unroll") for (int _h = 0; _h < 2; ++_h) _Pragma("unroll") for (int _i = 0; _i < 2; ++_i) { \
        int _src; if (GATHER) { const int _r = _h * HALF + Rl[_i]; _src = (_r < (u).nvalid) ? (u).rows[_r] : 0; } else _src = (u).row0 + _h * HALF + Rl[_i]; \
        dst[_h][_i] = (unsigned)(_src * K + Cl[_i]) * 2u; } } while (0)
    Unit cur, nxt; int ui = 0;
    if (!S.next(0, cur)) return;
    f32x4 acc[2][2][4][2];
#pragma unroll
    for (int a = 0; a < 2; ++a)
#pragma unroll
        for (int b = 0; b < 2; ++b)
#pragma unroll
            for (int m = 0; m < 4; ++m)
#pragma unroll
                for (int n = 0; n < 2; ++n) acc[a][b][m][n] = (f32x4){0.f, 0.f, 0.f, 0.f};
    bf16x8 At[4][2], B0[2][2], B1[2][2];
    unsigned oa[2][2], na[2][2];
    PG8_AOFFS(oa, cur);
    const char* cA = (const char*)Abase; const char* cB = cur.Bt;
    PG8_STAGE(PG8_SB(0, 0), cB, voffB); PG8_STAGE(PG8_SB(0, 1), cB + hstep, voffB); PG8_STAGE(PG8_SA(0, 0), cA, oa[0]); PG8_STAGE(PG8_SA(0, 1), cA, oa[1]);
    if (wr == 1) PG8_BAR;
    PG8_WAIT_V(2); PG8_BAR;
    PG8_STAGE(PG8_SB(1, 0), cB + kstep, voffB); PG8_STAGE(PG8_SA(1, 0), cA + kstep, oa[0]); PG8_STAGE(PG8_SB(1, 1), cB + hstep + kstep, voffB);
    PG8_WAIT_V(6); PG8_BAR;
    for (;;) {
        const bool has_next = S.next(ui + 1, nxt);
        if (has_next) { PG8_AOFFS(na, nxt); if (GATHER) asm volatile("" : "+v"(na[0][0]), "+v"(na[0][1]), "+v"(na[1][0]), "+v"(na[1][1])); }
        else {
#pragma unroll
            for (int h = 0; h < 2; ++h)
#pragma unroll
                for (int i = 0; i < 2; ++i) na[h][i] = oa[h][i];
        }
        const char* nB = has_next ? nxt.Bt : cB;
        for (int t = 0; t < nt; t += 2) {
            const bool last = (t == nt - 2);
            const char* a1 = cA + (size_t)(t + 1) * kstep;
            const char* a2 = last ? cA : cA + (size_t)(t + 2) * kstep; const char* b2 = last ? nB : cB + (size_t)(t + 2) * kstep;
            const char* a3 = a2 + kstep; const char* b3 = b2 + kstep;
            unsigned sa[2][2];
#pragma unroll
            for (int h = 0; h < 2; ++h)
#pragma unroll
                for (int i = 0; i < 2; ++i) sa[h][i] = last ? na[h][i] : oa[h][i];
            PG8_LDB(B0, 0, 0); PG8_LDB(B1, 0, 1); PG8_SCHED; PG8_LDA(At, 0, 0); PG8_STAGE(PG8_SA(1, 1), a1, oa[1]);
            PG8_WAIT_V(8); PG8_WAIT_L(0); PG8_BAR; PG8_MMA(0, 0, At, B0); PG8_MMA(0, 1, At, B1); PG8_BAR; PG8_SCHED;
            PG8_LDA(At, 0, 1); PG8_STAGE(PG8_SB(0, 0), b2, voffB); PG8_STAGE(PG8_SB(0, 1), b2 + hstep, voffB); PG8_STAGE(PG8_SA(0, 0), a2, sa[0]);
            PG8_WAIT_V(8); PG8_WAIT_L(0); PG8_BAR; PG8_MMA(1, 0, At, B0); PG8_MMA(1, 1, At, B1); PG8_BAR; PG8_SCHED;
            PG8_LDB(B0, 1, 0); PG8_LDB(B1, 1, 1); PG8_SCHED; PG8_LDA(At, 1, 0); PG8_STAGE(PG8_SA(0, 1), a2, sa[1]);
            PG8_WAIT_V(8); PG8_WAIT_L(0); PG8_BAR; PG8_MMA(0, 0, At, B0); PG8_MMA(0, 1, At, B1); PG8_BAR; PG8_SCHED;
            PG8_LDA(At, 1, 1); PG8_STAGE(PG8_SB(1, 0), b3, voffB); PG8_STAGE(PG8_SB(1, 1), b3 + hstep, voffB); PG8_STAGE(PG8_SA(1, 0), a3, sa[0]);
            PG8_WAIT_V(8); PG8_WAIT_L(0); PG8_BAR; PG8_MMA(1, 0, At, B0); PG8_MMA(1, 1, At, B1); PG8_BAR; PG8_SCHED;
        }
        if (wr == 0) PG8_BAR;
        E(acc, cur, wr, wc, fr, fq);
        if (!has_next) break;
#pragma unroll
        for (int a = 0; a < 2; ++a)
#pragma unroll
            for (int b = 0; b < 2; ++b)
#pragma unroll
                for (int m = 0; m < 4; ++m)
#pragma unroll
                    for (int n = 0; n < 2; ++n) acc[a][b][m][n] = (f32x4){0.f, 0.f, 0.f, 0.f};
        cur = nxt; cB = nB; ++ui;
#pragma unroll
        for (int h = 0; h < 2; ++h)
#pragma unroll
            for (int i = 0; i < 2; ++i) oa[h][i] = na[h][i];
        if (wr == 1) PG8_BAR;
    }
    PG8_WAIT_V(0);
    PG8_BAR;
#undef PG8_SA
#undef PG8_SB
#undef PG8_STAGE
#undef PG8_LDA
#undef PG8_LDB
#undef PG8_MMA
#undef PG8_WAIT_V
#undef PG8_WAIT_L
#undef PG8_BAR
#undef PG8_SCHED
#undef PG8_AOFFS
}

struct DenseOrder {
    int nRT, nN, G, c; const char* Bt; int K; bool swap;
    __device__ __forceinline__ bool next(int i, Unit& u) const {
        const int xcd = c & 7, s = i * (G >> 3) + (c >> 3);
        int rt, pn;
        if (!swap) { rt = 8 * (s / nN) + xcd; pn = s % nN; } else { pn = 8 * (s / nRT) + xcd; rt = s % nRT; }
        if (rt >= nRT || pn >= nN) return false;
        u.row0 = rt * BM; u.col0 = pn * BM; u.Bt = Bt + (size_t)pn * BM * K * 2; u.rows = nullptr; u.nvalid = 0; u.e = 0; return true;
    }
};
struct MoeTables { LAS const int* tstart; LAS const int* cnt; LAS const unsigned char* tile_e; int nrt; };
struct MoeOrder {
    MoeTables tb; int nN, G, c; const char* Bt; size_t strideB; const int* tokl; bool gather;
    __device__ __forceinline__ bool next(int i, Unit& u) const {
        const int xcd = c & 7, s = i * (G >> 3) + (c >> 3);
        const int q = 8 * (s / nN) + xcd, pn = s % nN;
        if (q >= tb.nrt) return false;
        const int e = tb.tile_e[q]; const int lt = q - tb.tstart[e];
        u.row0 = q * BM; u.col0 = pn * BM; u.e = e; u.Bt = Bt + (size_t)e * strideB + (size_t)pn * BM * 1024 * 2;
        u.rows = gather ? tokl + (size_t)e * T + lt * BM : nullptr; u.nvalid = tb.cnt[e] - lt * BM; return true;
    }
};

struct EpiBf16Plain {
    static constexpr bool PERM = true;
    bf16_t* O; int ldc;
    __device__ __forceinline__ void operator()(const f32x4 (&acc)[2][2][4][2], const Unit& u, int wr, int wc, int fr, int fq) const {
        const int row0 = u.row0 + wr * 64 + fr, col0 = u.col0 + wc * 32 + 8 * fq;
#pragma unroll
        for (int ai = 0; ai < 2; ++ai)
#pragma unroll
            for (int m = 0; m < 4; ++m) { bf16_t* rowp = O + (size_t)(row0 + ai * HALF + m * 16) * ldc + col0;
#pragma unroll
                for (int bj = 0; bj < 2; ++bj) { const f32x4 v0 = acc[ai][bj][m][0], v1 = acc[ai][bj][m][1];
                    u32x4 w; w.x = pk_bf16(v0[0], v0[1]); w.y = pk_bf16(v0[2], v0[3]); w.z = pk_bf16(v1[0], v1[1]); w.w = pk_bf16(v1[2], v1[3]);
                    *(u32x4*)(rowp + bj * HALF) = w; } }
    }
};
struct EpiResF32 {
    static constexpr bool PERM = false;
    float* C; const float* R;
    __device__ __forceinline__ void operator()(const f32x4 (&acc)[2][2][4][2], const Unit& u, int wr, int wc, int fr, int fq) const {
        const int row0 = u.row0 + wr * 64 + fr, col0 = u.col0 + wc * 32 + 4 * fq;
#pragma unroll
        for (int ai = 0; ai < 2; ++ai)
#pragma unroll
            for (int m = 0; m < 4; ++m) { const size_t off = (size_t)(row0 + ai * HALF + m * 16) * 1024 + col0;
#pragma unroll
                for (int bj = 0; bj < 2; ++bj)
#pragma unroll
                    for (int n = 0; n < 2; ++n) { const f32x4 r = *(const f32x4*)(R + off + bj * HALF + n * 16); *(f32x4*)(C + off + bj * HALF + n * 16) = r * ALPHA + acc[ai][bj][m][n]; } }
    }
};
struct EpiSwiglu {
    static constexpr bool PERM = true;
    bf16_t* O; const float* bias;
    __device__ __forceinline__ void operator()(const f32x4 (&acc)[2][2][4][2], const Unit& u, int wr, int wc, int fr, int fq) const {
        const int row0 = u.row0 + wr * 64 + fr, oc = (u.col0 >> 1) + wc * 32 + 8 * fq;
        const float* bp = bias + (size_t)u.e * 2048 + oc;
        f32x4 bg[2], bu[2];
#pragma unroll
        for (int n = 0; n < 2; ++n) { bg[n] = *(const f32x4*)(bp + 4 * n); bu[n] = *(const f32x4*)(bp + 1024 + 4 * n); }
#pragma unroll
        for (int ai = 0; ai < 2; ++ai)
#pragma unroll
            for (int m = 0; m < 4; ++m) {
                float o[8];
#pragma unroll
                for (int n = 0; n < 2; ++n) { const f32x4 g4 = acc[ai][0][m][n] + bg[n], u4 = acc[ai][1][m][n] + bu[n];
#pragma unroll
                    for (int j = 0; j < 4; ++j) { const float g = fminf(g4[j], 7.0f), up = fminf(fmaxf(u4[j], -7.0f), 7.0f);
                        const float glu = g * __builtin_amdgcn_rcpf(1.0f + __builtin_amdgcn_exp2f(-1.702f * LOG2E * g)); o[4 * n + j] = (up + 1.0f) * glu; } }
                u32x4 w; w.x = pk_bf16(o[0], o[1]); w.y = pk_bf16(o[2], o[3]); w.z = pk_bf16(o[4], o[5]); w.w = pk_bf16(o[6], o[7]);
                *(u32x4*)(O + (size_t)(row0 + ai * HALF + m * 16) * 1024 + oc) = w; }
    }
};
struct EpiBiasBf16 {
    static constexpr bool PERM = true;
    bf16_t* O; const float* bias;
    __device__ __forceinline__ void operator()(const f32x4 (&acc)[2][2][4][2], const Unit& u, int wr, int wc, int fr, int fq) const {
        const int row0 = u.row0 + wr * 64 + fr, col0 = u.col0 + wc * 32 + 8 * fq;
        const float* bp = bias + (size_t)u.e * 1024 + col0;
        f32x4 bv[2][2];
#pragma unroll
        for (int bj = 0; bj < 2; ++bj)
#pragma unroll
            for (int n = 0; n < 2; ++n) bv[bj][n] = *(const f32x4*)(bp + bj * HALF + 4 * n);
#pragma unroll
        for (int ai = 0; ai < 2; ++ai)
#pragma unroll
            for (int m = 0; m < 4; ++m) { bf16_t* rowp = O + (size_t)(row0 + ai * HALF + m * 16) * 1024 + col0;
#pragma unroll
                for (int bj = 0; bj < 2; ++bj) { const f32x4 v0 = acc[ai][bj][m][0] + bv[bj][0], v1 = acc[ai][bj][m][1] + bv[bj][1];
                    u32x4 w; w.x = pk_bf16(v0[0], v0[1]); w.y = pk_bf16(v0[2], v0[3]); w.z = pk_bf16(v1[0], v1[1]); w.w = pk_bf16(v1[2], v1[3]);
                    *(u32x4*)(rowp + bj * HALF) = w; } }
    }
};
}


#ifndef ATT_EN
#define ATT_EN 7
#endif
#ifndef PROBE
#define PROBE (-1)
#endif
#define PREP(k) _Pragma("unroll 1") for (int _rp = 0; _rp < ((PROBE == (k)) ? 2 : 1); ++_rp)
typedef float f32x16 __attribute__((ext_vector_type(16)));
#define MFMA32(a, b, c) __builtin_amdgcn_mfma_f32_32x32x16_bf16((a), (b), (c), 0, 0, 0)
constexpr int ATT_BUF = 27648;
constexpr int ATT_RELB = 2 * ATT_BUF;
#define NEG_INF_F (-__builtin_huge_valf())

template <int MODE>
__device__ __forceinline__ void attn_unit(LAS unsigned char* lds, const bf16_t* HQ, const bf16_t* VT, bf16_t* MIX, const unsigned long long* MASK, float* OA1,
                                          const int b, const int h, const int qt, const int wave, const int lane_unused,
                                          const float lam, const float lam_init, const float* subg, const float* relb) {
    constexpr int NPASS = (MODE == 0) ? 2 : 1;
    constexpr int EB = (MODE == 0) ? 4 : 2;
    constexpr int KSTR = 144;
    constexpr int VOFF = 64 * KSTR;
    constexpr int NCHV = (MODE == 0) ? 2 : 1;
    const int qoff = (MODE == 0) ? HQ_QA + h * 128 : (MODE == 1) ? HQ_QB + h * 64 : HQ_QC + h * 64;
    const int koff = (MODE == 0) ? HQ_KA + h * 128 : (MODE == 1) ? HQ_KB + h * 64 : HQ_KC + h * 64;
    const int vrow0 = (MODE == 0) ? VT_A + h * 128 : (MODE == 1) ? VT_B + h * 64 : VT_C + h * 64;
    const int mixcol = (MODE == 0) ? h * 128 : (MODE == 1) ? 512 + h * 64 : 768 + h * 64;
    int lane; asm volatile("v_mbcnt_lo_u32_b32 %0, -1, 0\n\tv_mbcnt_hi_u32_b32 %0, -1, %0" : "=&v"(lane));
    const int tid = wave * 64 + lane, ql = lane & 31, hb = lane >> 5;
    const int cq = qt * 4 + (wave >> 1);
    const int tq = qt * 256 + wave * 32 + ql;
    const int kt_hi = qt * 4 + 3;
    const int kt_lo = (MODE == 1) ? ((qt * 4 - 8) > 0 ? (qt * 4 - 8) : 0) : 0;
    const float slope2 = (MODE == 0) ? exp2f(-(float)(2 * h + 1)) * LOG2E : exp2f(-(float)(2 * h + 2)) * LOG2E;
    LAS float* relb_l = (LAS float*)(lds + ATT_RELB);
    const int prow = (ql & 16) | ((ql & 4) << 1) | ((ql & 8) >> 1) | (ql & 3);
    const int krow = tid >> 3, kc = tid & 7;
#pragma unroll 1
    for (int mp = 0; mp < NPASS; ++mp) {
        bf16x8 Q[4];
        { const bf16_t* qp = HQ + (size_t)(b * SEQ + tq) * HQP + qoff + mp * 64 + hb * 8;
#pragma unroll
          for (int ks = 0; ks < 4; ++ks) Q[ks] = *(const bf16x8*)(qp + ks * 16); }
        f32x16 O[EB];
        float mrun = -1e30f, lrun = 0.f;
#pragma unroll
        for (int eb = 0; eb < EB; ++eb)
#pragma unroll
            for (int i = 0; i < 16; ++i) O[eb][i] = 0.f;
        u32x4 kreg, vreg[NCHV];
#define ATT_LOAD(kt_) do { kreg = *(const u32x4*)(HQ + (size_t)(b * SEQ + (kt_) * 64 + krow) * HQP + koff + mp * 64 + kc * 8); \
        _Pragma("unroll") for (int j = 0; j < NCHV; ++j) vreg[j] = *(const u32x4*)(VT + (size_t)(vrow0 + krow + 64 * j) * T + (size_t)b * SEQ + (kt_) * 64 + kc * 8); } while (0)
#define ATT_STORE(buf_) do { *(LAS u32x4*)(lds + (buf_) * ATT_BUF + krow * KSTR + kc * 16) = kreg; \
        _Pragma("unroll") for (int j = 0; j < NCHV; ++j) *(LAS u32x4*)(lds + (buf_) * ATT_BUF + VOFF + (krow + 64 * j) * 144 + kc * 16) = vreg[j]; } while (0)

        __syncthreads();
        if (MODE == 1) { for (int i = tid; i < 257; i += 512) relb_l[i] = relb[i] * LOG2E; }
        ATT_LOAD(kt_hi); ATT_STORE(0);
        __syncthreads();
        int buf = 0;
        for (int kt = kt_hi; kt >= kt_lo; --kt) {
            if (kt > kt_lo) ATT_LOAD(kt - 1);
            const bool active = (kt <= cq) && (MODE != 1 || kt >= cq - 8);
            if (active) {
                const LAS unsigned char* kbp = lds + buf * ATT_BUF + prow * KSTR + hb * 16;
                const LAS unsigned char* vbp = lds + buf * ATT_BUF + VOFF + ql * 144 + hb * 16;
                f32x16 S0, S1;
#pragma unroll
                for (int i = 0; i < 16; ++i) { S0[i] = 0.f; S1[i] = 0.f; }
#pragma unroll
                for (int ks = 0; ks < 4; ++ks) {
                    const bf16x8 k0 = *(const LAS bf16x8*)(kbp + ks * 32);
                    const bf16x8 k1 = *(const LAS bf16x8*)(kbp + 32 * KSTR + ks * 32);
                    S0 = MFMA32(k0, Q[ks], S0); S1 = MFMA32(k1, Q[ks], S1);
                    if (ks & 1) __builtin_amdgcn_sched_barrier(0);
                }
                if (MODE == 0 || MODE == 2) {
                    const float base0 = (float)(tq - kt * 64 - 8 * hb), base1 = base0 - 32.0f;
#pragma unroll
                    for (int i = 0; i < 16; ++i) { const float off = (float)(16 * (i >> 3) + (i & 7));
                        S0[i] = S0[i] - slope2 * fabsf(base0 - off); S1[i] = S1[i] - slope2 * fabsf(base1 - off); }
                }
                if (MODE == 2) {
                    const unsigned long long W = MASK[(size_t)(b * SEQ + tq) * 32 + kt];
                    const unsigned w0 = (unsigned)W >> (8 * hb), w1 = (unsigned)(W >> 32) >> (8 * hb);
#pragma unroll
                    for (int i = 0; i < 16; ++i) { const int off = 16 * (i >> 3) + (i & 7);
                        S0[i] = ((w0 >> off) & 1u) ? S0[i] : NEG_INF_F; S1[i] = ((w1 >> off) & 1u) ? S1[i] : NEG_INF_F; }
                }
                if (MODE == 1) {
                    if (kt >= cq - 2) {
                        const int rel0 = tq - kt * 64 - 8 * hb + 128;
#pragma unroll
                        for (int i = 0; i < 16; ++i) { const int off = 16 * (i >> 3) + (i & 7);
                            int r0 = rel0 - off, r1 = rel0 - 32 - off;
                            r0 = r0 < 0 ? 0 : (r0 > 256 ? 256 : r0); r1 = r1 < 0 ? 0 : (r1 > 256 ? 256 : r1);
                            S0[i] += relb_l[r0]; S1[i] += relb_l[r1]; }
                    } else {
                        const float far = relb_l[256];
#pragma unroll
                        for (int i = 0; i < 16; ++i) { S0[i] += far; S1[i] += far; }
                    }
                }
                float mx = fmaxf(S0[0], S1[0]);
#pragma unroll
                for (int i = 1; i < 16; ++i) mx = fmaxf(mx, fmaxf(S0[i], S1[i]));
                mx = fmaxf(mx, shx(mx, 32, lane));
                const float mnew = fmaxf(mrun, mx);
                const float alpha = __builtin_amdgcn_exp2f(mrun - mnew);
                mrun = mnew;
                float ps = 0.f;
#pragma unroll
                for (int i = 0; i < 16; ++i) { S0[i] = __builtin_amdgcn_exp2f(S0[i] - mnew); S1[i] = __builtin_amdgcn_exp2f(S1[i] - mnew); ps += S0[i] + S1[i]; }
                lrun = lrun * alpha + ps;
#pragma unroll
                for (int eb = 0; eb < EB; ++eb) O[eb] = O[eb] * alpha;
                bf16x8 P[4];
                { u32x4 p;
                  p.x = pk_bf16(S0[0], S0[1]); p.y = pk_bf16(S0[2], S0[3]); p.z = pk_bf16(S0[4], S0[5]); p.w = pk_bf16(S0[6], S0[7]); P[0] = __builtin_bit_cast(bf16x8, p);
                  p.x = pk_bf16(S0[8], S0[9]); p.y = pk_bf16(S0[10], S0[11]); p.z = pk_bf16(S0[12], S0[13]); p.w = pk_bf16(S0[14], S0[15]); P[1] = __builtin_bit_cast(bf16x8, p);
                  p.x = pk_bf16(S1[0], S1[1]); p.y = pk_bf16(S1[2], S1[3]); p.z = pk_bf16(S1[4], S1[5]); p.w = pk_bf16(S1[6], S1[7]); P[2] = __builtin_bit_cast(bf16x8, p);
                  p.x = pk_bf16(S1[8], S1[9]); p.y = pk_bf16(S1[10], S1[11]); p.z = pk_bf16(S1[12], S1[13]); p.w = pk_bf16(S1[14], S1[15]); P[3] = __builtin_bit_cast(bf16x8, p); }
#pragma unroll
                for (int s4 = 0; s4 < 4; ++s4)
#pragma unroll
                    for (int eb = 0; eb < EB; ++eb) {
                        const bf16x8 vf = *(const LAS bf16x8*)(vbp + eb * 32 * 144 + s4 * 32);
                        O[eb] = MFMA32(vf, P[s4], O[eb]);
                        if (eb & 1) __builtin_amdgcn_sched_barrier(0);
                    }
            }
            if (kt > kt_lo) ATT_STORE(buf ^ 1);
            __syncthreads();
            buf ^= 1;
        }
#undef ATT_LOAD
#undef ATT_STORE
        const float inv = 1.0f / (lrun + shx(lrun, 32, lane));
        bf16_t* op = MIX + (size_t)(b * SEQ + tq) * 1024 + mixcol + 4 * hb;
        if (MODE == 0) {
            float* o1p = OA1 + (size_t)(b * SEQ + tq) * 512 + h * 128 + 4 * hb;
            if (mp == 0) {
#pragma unroll
                for (int eb = 0; eb < EB; ++eb)
#pragma unroll
                    for (int g = 0; g < 4; ++g) *(f32x4*)(o1p + eb * 32 + 8 * g) = (f32x4){O[eb][4 * g] * inv, O[eb][4 * g + 1] * inv, O[eb][4 * g + 2] * inv, O[eb][4 * g + 3] * inv};
            } else {
                const float c2 = lam * inv;
                float ss = 0.f;
#pragma unroll
                for (int eb = 0; eb < EB; ++eb)
#pragma unroll
                    for (int g = 0; g < 4; ++g) { const f32x4 o1 = *(const f32x4*)(o1p + eb * 32 + 8 * g);
#pragma unroll
                        for (int j = 0; j < 4; ++j) { const float o = o1[j] - O[eb][4 * g + j] * c2; O[eb][4 * g + j] = o; ss += o * o; } }
                ss += shx(ss, 32, lane);
                const float r = rsqrtf(ss * (1.0f / 128.0f) + EPS) * (1.0f - lam_init);
#pragma unroll
                for (int eb = 0; eb < EB; ++eb)
#pragma unroll
                    for (int g = 0; g < 4; ++g) { const int e0 = eb * 32 + 8 * g; const f32x4 sg = *(const f32x4*)(subg + e0 + 4 * hb);
                        *(u32x2*)(op + e0) = (u32x2){pk_bf16(O[eb][4 * g] * r * sg[0], O[eb][4 * g + 1] * r * sg[1]), pk_bf16(O[eb][4 * g + 2] * r * sg[2], O[eb][4 * g + 3] * r * sg[3])}; }
            }
        } else {
#pragma unroll
            for (int eb = 0; eb < EB; ++eb)
#pragma unroll
                for (int g = 0; g < 4; ++g) { const int e0 = eb * 32 + 8 * g;
                    *(u32x2*)(op + e0) = (u32x2){pk_bf16(O[eb][4 * g] * inv, O[eb][4 * g + 1] * inv), pk_bf16(O[eb][4 * g + 2] * inv, O[eb][4 * g + 3] * inv)}; }
        }
    }
}


constexpr int IDX_STR = 2052;
__device__ __forceinline__ unsigned f2key(float f) { const unsigned u = __float_as_uint(f); return u ^ (((unsigned)((int)u >> 31)) | 0x80000000u); }
template <int J>
__device__ __forceinline__ void index_select(const LAS float* row, const int nb, const int lane, unsigned long long* mo) {
    unsigned u[J];
#pragma unroll
    for (int j = 0; j < J; ++j) u[j] = (j < nb) ? f2key(row[64 * j]) : 0u;
    unsigned prefix = 0u;
#pragma unroll 1
    for (int bit = 31; bit >= 0; --bit) {
        const unsigned cand = prefix | (1u << bit);
        int c = 0;
#pragma unroll
        for (int j = 0; j < J; ++j) c += (int)__builtin_popcountll(__ballot(u[j] >= cand));
        if (c >= 256) prefix = cand;
        if (c == 256) break;
    }
    const unsigned thr = prefix;
    int cg = 0;
#pragma unroll
    for (int j = 0; j < J; ++j) cg += (int)__builtin_popcountll(__ballot(u[j] > thr));
    const int quota = 256 - cg;
    int taken = 0;
    unsigned long long myword = 0ull;
#pragma unroll
    for (int j = 0; j < J; ++j) {
        const bool eq = (u[j] == thr);
        const unsigned long long eqm = __ballot(eq);
        const int before = (int)__builtin_popcountll(eqm & ((1ull << lane) - 1ull));
        const unsigned long long m = __ballot((u[j] > thr) || (eq && (taken + before < quota)));
        taken += (int)__builtin_popcountll(eqm);
        myword = (lane == j) ? m : myword;
    }
    if (lane < 32) mo[lane] = myword;
}
__device__ __forceinline__ void index_unit(LAS unsigned char* lds, const bf16_t* HQ, unsigned long long* MASK, const int b, const int tt, const int wave) {
    int lane; asm volatile("v_mbcnt_lo_u32_b32 %0, -1, 0\n\tv_mbcnt_hi_u32_b32 %0, -1, %0" : "=&v"(lane));
    const int t0 = tt * 16, nb = (t0 >> 6) + 1, nk = nb * 64;
    if (nb <= 4) {
        for (int i = wave * 64 + lane; i < 16 * 32; i += 512) MASK[(size_t)(b * SEQ + t0 + (i >> 5)) * 32 + (i & 31)] = ((i & 31) < nb) ? ~0ull : 0ull;
        return;
    }
    LAS float* sc = (LAS float*)lds;
    const int q = lane & 15, g = lane >> 4;
    {
        const bf16_t* qrow = HQ + (size_t)(b * SEQ + t0 + q) * HQP;
        bf16x8 QI[8];
#pragma unroll
        for (int h = 0; h < 8; ++h) QI[h] = *(const bf16x8*)(qrow + HQ_QI + h * 32 + g * 8);
        float w[8];
        { const u32x4 wv = *(const u32x4*)(qrow + HQ_WI);
          w[0] = bf_lo(wv[0]) * 0.0625f; w[1] = bf_hi(wv[0]) * 0.0625f; w[2] = bf_lo(wv[1]) * 0.0625f; w[3] = bf_hi(wv[1]) * 0.0625f;
          w[4] = bf_lo(wv[2]) * 0.0625f; w[5] = bf_hi(wv[2]) * 0.0625f; w[6] = bf_lo(wv[3]) * 0.0625f; w[7] = bf_hi(wv[3]) * 0.0625f; }
        const bf16_t* kbase = HQ + (size_t)(b * SEQ + q) * HQP + HQ_KI + g * 8;
        for (int kb = wave; kb < nk / 16; kb += 8) {
            const bf16x8 kf = *(const bf16x8*)(kbase + (size_t)kb * 16 * HQP);
            f32x4 acc = {0.f, 0.f, 0.f, 0.f};
#pragma unroll
            for (int h = 0; h < 8; ++h) {
                const f32x4 z = __builtin_amdgcn_mfma_f32_16x16x32_bf16(kf, QI[h], (f32x4){0.f, 0.f, 0.f, 0.f}, 0, 0, 0);
#pragma unroll
                for (int j = 0; j < 4; ++j) acc[j] = fmaf(w[h], fmaxf(z[j], 0.f), acc[j]);
            }
#pragma unroll
            for (int j = 0; j < 4; ++j) acc[j] += 0.0f;
            *(LAS f32x4*)(sc + q * IDX_STR + kb * 16 + g * 4) = acc;
        }
    }
    __syncthreads();
#pragma unroll 1
    for (int qq = 0; qq < 2; ++qq) {
        const int ql = wave * 2 + qq;
        const LAS float* row = sc + ql * IDX_STR + lane;
        unsigned long long* mo = MASK + (size_t)(b * SEQ + t0 + ql) * 32;
        if (nb <= 8) index_select<8>(row, nb, lane, mo);
        else if (nb <= 16) index_select<16>(row, nb, lane, mo);
        else if (nb <= 24) index_select<24>(row, nb, lane, mo);
        else index_select<32>(row, nb, lane, mo);
    }
    __syncthreads();
}

struct Args {
    const float* x; const float* w_in; const float* lam_q1; const float* lam_k1; const float* lam_q2; const float* lam_k2; const float* subln_g; const float* rel_bias;
    const float* w_out; const float* ln1_g; const float* ln1_b; const float* w_router; const float* b_router; const float* w_gu; const float* b_gu;
    const float* w_down; const float* b_down; const float* ln2_g; const float* ln2_b;
    float* out; unsigned char* ws;
    int ph_lo, ph_hi, bar_region, pad;
};

constexpr int LDS_STAGE = 0;
constexpr int LDS_CTL = 135168;
constexpr int LDS_TSTART = LDS_CTL + 64;
constexpr int LDS_CNT = LDS_TSTART + 36 * 4;
constexpr int LDS_TILEE = LDS_CNT + 32 * 4;
constexpr int LDS_RT = LDS_TILEE + 576;
constexpr int LDS_BYTES = 147456;
static_assert(LDS_RT + (64 + 1024) * 4 <= LDS_BYTES && 16 * IDX_STR * 4 <= LDS_CTL, "LDS map");

__device__ __forceinline__ void transpose_item(const float* W, int N, int k0, int n0, int nvalid, bf16_t* WTrow0, float scale, LAS float* scr, int lane) {
#pragma unroll 8
    for (int i = 0; i < 32; ++i) { const int kk = 2 * i + (lane >> 5), col = lane & 31; scr[kk * 33 + col] = (col < nvalid) ? W[(size_t)(k0 + kk) * N + n0 + col] * scale : 0.f; }
    asm volatile("s_waitcnt lgkmcnt(0)" ::: "memory");
    const int c = lane & 7;
#pragma unroll
    for (int j = 0; j < 4; ++j) { const int n = (lane >> 3) + 8 * j; const LAS float* s = scr + (8 * c) * 33 + n;
        u32x4 o; o.x = pk_bf16(s[0 * 33], s[1 * 33]); o.y = pk_bf16(s[2 * 33], s[3 * 33]); o.z = pk_bf16(s[4 * 33], s[5 * 33]); o.w = pk_bf16(s[6 * 33], s[7 * 33]);
        if (n < nvalid) *(u32x4*)(WTrow0 + (size_t)n * 1024 + k0 + 8 * c) = o; }
    asm volatile("s_waitcnt lgkmcnt(0)" ::: "memory");
}
__device__ __forceinline__ void in_map(int n0, bool& isv, int& row, float& scale) {
    scale = 1.f; isv = false;
    if (n0 < 512) { row = HQ_QA + n0; scale = QSCALE; }
    else if (n0 < 1024) row = HQ_KA + (n0 - 512);
    else if (n0 < 1536) { isv = true; row = VT_A + (n0 - 1024); }
    else if (n0 < 1792) { row = HQ_QB + (n0 - 1536); scale = QSCALE; }
    else if (n0 < 2048) row = HQ_KB + (n0 - 1792);
    else if (n0 < 2304) { isv = true; row = VT_B + (n0 - 2048); }
    else if (n0 < 2560) { row = HQ_QC + (n0 - 2304); scale = QSCALE; }
    else if (n0 < 2816) row = HQ_KC + (n0 - 2560);
    else if (n0 < 3072) { isv = true; row = VT_C + (n0 - 2816); }
    else if (n0 < 3328) row = HQ_QI + (n0 - 3072);
    else if (n0 < 3360) row = HQ_KI + (n0 - 3328);
    else row = HQ_WI + (n0 - 3360);
}

__global__ void __launch_bounds__(512, 2) mega(Args a) {
    extern __shared__ __attribute__((aligned(16))) unsigned char lds_raw[];
    LAS unsigned char* lds = (LAS unsigned char*)lds_raw;
    const int G = gridDim.x, bid = blockIdx.x, NGW = G * 8;
    const int wave = __builtin_amdgcn_readfirstlane((int)threadIdx.x >> 6);
#define OPAQUE_IDS() int lane; asm volatile("v_mbcnt_lo_u32_b32 %0, -1, 0\n\tv_mbcnt_hi_u32_b32 %0, -1, %0" : "=&v"(lane)); const int tid = wave * 64 + lane, gw = bid * 8 + wave; (void)tid; (void)gw
#define WSPTRS() unsigned char* ws = a.ws; asm volatile("" : "+s"(ws)); \
    unsigned* ctl = (unsigned*)(ws + WS_CTL); bf16_t* Win = (bf16_t*)(ws + WS_WIN); bf16_t* Wv = (bf16_t*)(ws + WS_WV); bf16_t* Wout = (bf16_t*)(ws + WS_WOUT); \
    bf16_t* Wgu = (bf16_t*)(ws + WS_WGU); bf16_t* Wdn = (bf16_t*)(ws + WS_WDN); bf16_t* XB = (bf16_t*)(ws + WS_XB); float* XF = (float*)(ws + WS_XF); \
    bf16_t* HQ = (bf16_t*)(ws + WS_HQ); bf16_t* VT = (bf16_t*)(ws + WS_VT); bf16_t* MIX = (bf16_t*)(ws + WS_MIX); \
    float* Y1 = (float*)(ws + WS_Y1); float* X1F = (float*)(ws + WS_X1F); bf16_t* X1B = (bf16_t*)(ws + WS_X1B); bf16_t* ACT = (bf16_t*)(ws + WS_ACT); bf16_t* YR = (bf16_t*)(ws + WS_YR); \
    int* TOKL = (int*)(ws + WS_TOKL); int* ASGE = (int*)(ws + WS_ASGE); int* ASGS = (int*)(ws + WS_ASGS); float* GATE = (float*)(ws + WS_GATE); \
    (void)ctl; (void)Win; (void)Wv; (void)Wout; (void)Wgu; (void)Wdn; (void)XB; (void)XF; (void)HQ; (void)VT; (void)MIX; (void)Y1; (void)X1F; (void)X1B; (void)ACT; (void)YR; (void)TOKL; (void)ASGE; (void)ASGS; (void)GATE
    for (int u = threadIdx.x; u < (LDS_BYTES - LDS_CTL) / 4; u += 512) ((LAS unsigned*)(lds + LDS_CTL))[u] = 0u;
    __syncthreads();
    XcdBarrier bar = xcd_barrier_post((unsigned*)(a.ws + WS_CTL) + CW_BAR + a.bar_region * XCD_BAR_WORDS, (volatile LAS unsigned*)(lds + LDS_CTL));
    const int lo = a.ph_lo, hi = a.ph_hi;
#define IN(k) (lo <= (k) && (k) < hi)
#define SEAM(k) do { if (IN(k) && IN((k) + 1)) xcd_barrier(bar); } while (0)

    if (IN(0)) PREP(0) {
        OPAQUE_IDS(); WSPTRS();
        LAS float* scr = (LAS float*)(lds + LDS_STAGE + wave * 16384);
        constexpr int I_IN = 16 * 106, I_OUT = 16 * 32, I_GU = 16 * 64, I_DN = 16 * 32;
        constexpr int N_IN = DEPTH * I_IN, N_OUT = DEPTH * I_OUT, N_GU = DEPTH * NE * I_GU, N_DN = DEPTH * NE * I_DN;
        for (int it = gw; it < N_IN + N_OUT + N_GU + N_DN; it += NGW) {
            int r = it;
            if (r < N_IN) { const int l = r / I_IN, q = r % I_IN, kb = q / 106, nb = q % 106, n0 = nb * 32; bool isv; int row; float sc; in_map(n0, isv, row, sc);
                bf16_t* dst = isv ? Wv + ((size_t)l * 1024 + row) * 1024 : Win + ((size_t)l * HQP + row) * 1024;
                transpose_item(a.w_in + (size_t)l * D * DIN, DIN, kb * 64, n0, (DIN - n0) < 32 ? (DIN - n0) : 32, dst, sc, scr, lane); continue; }
            r -= N_IN;
            if (r < N_OUT) { const int l = r / I_OUT, q = r % I_OUT, kb = q / 32, nb = q % 32;
                transpose_item(a.w_out + (size_t)l * 1024 * D, D, kb * 64, nb * 32, 32, Wout + ((size_t)l * D + nb * 32) * 1024, 1.f, scr, lane); continue; }
            r -= N_OUT;
            if (r < N_GU) { const int le = r / I_GU, q = r % I_GU, kb = q / 64, nb = q % 64, n0 = nb * 32;
                const int bj = n0 >> 10, rr = n0 & 1023, pn = rr >> 7, c = rr & 127, nrow = pn * 256 + bj * 128 + c;
                transpose_item(a.w_gu + (size_t)le * D * 2048, 2048, kb * 64, n0, 32, Wgu + ((size_t)le * 2048 + nrow) * 1024, 1.f, scr, lane); continue; }
            r -= N_GU;
            { const int le = r / I_DN, q = r % I_DN, kb = q / 32, nb = q % 32;
                transpose_item(a.w_down + (size_t)le * 1024 * D, D, kb * 64, nb * 32, 32, Wdn + ((size_t)le * D + nb * 32) * 1024, 1.f, scr, lane); }
        }
        for (int i = gw * 64 + lane; i < DEPTH * (HQP - HQ_USED) * 128; i += NGW * 64) { const int l = i / ((HQP - HQ_USED) * 128), q = i % ((HQP - HQ_USED) * 128);
            *(u32x4*)(Win + ((size_t)l * HQP + HQ_USED) * 1024 + (size_t)q * 8) = (u32x4){0u, 0u, 0u, 0u}; }
        { float* WRT = (float*)(ws + WS_WRT);
          for (int i = gw * 64 + lane; i < DEPTH * NE * D; i += NGW * 64) { const int ll = i / (NE * D), r = i % (NE * D), e = r / D, c = r % D; WRT[i] = a.w_router[((size_t)ll * D + c) * NE + e]; } }
        for (size_t i = (size_t)gw * 64 + lane; i < (size_t)T * D / 8; i += (size_t)NGW * 64) { const f32x4 v0 = *(const f32x4*)(a.x + i * 8), v1 = *(const f32x4*)(a.x + i * 8 + 4);
            u32x4 w; w.x = pk_bf16(v0[0], v0[1]); w.y = pk_bf16(v0[2], v0[3]); w.z = pk_bf16(v1[0], v1[1]); w.w = pk_bf16(v1[2], v1[3]); *(u32x4*)(XB + i * 8) = w; }
    }
    SEAM(0);

#pragma unroll 1
    for (int l = 0; l < DEPTH; ++l) {
        const int pb = 1 + 8 * l;
        if (IN(pb + 0)) PREP(1) {
            WSPTRS();
            { pg8::DenseOrder S{T / 256, HQP / 256, G, bid, (const char*)(Win + (size_t)l * HQP * 1024), 1024, false};
              pg8::EpiBf16Plain E{HQ, HQP};
              pg8::gemm_phase<pg8::EpiBf16Plain, pg8::DenseOrder, false>(lds + LDS_STAGE, XB, 1024, S, E, wave); }
            { pg8::DenseOrder S{1024 / 256, T / 256, G, bid, (const char*)XB, 1024, true};
              pg8::EpiBf16Plain E{VT, T};
              pg8::gemm_phase<pg8::EpiBf16Plain, pg8::DenseOrder, false>(lds + LDS_STAGE, Wv + (size_t)l * 1024 * 1024, 1024, S, E, wave); }
        }
        SEAM(pb + 0);
        if (IN(pb + 1)) {
            OPAQUE_IDS(); WSPTRS();
            unsigned long long* MASKp = (unsigned long long*)(ws + WS_MASK); float* OA1p = (float*)(ws + WS_OA1);
            const float lam_init = 0.8f - 0.6f * expf(-0.3f * (float)l);
            const float lam = expf(wsum(a.lam_q1[l * 64 + lane] * a.lam_k1[l * 64 + lane], lane)) - expf(wsum(a.lam_q2[l * 64 + lane] * a.lam_k2[l * 64 + lane], lane)) + lam_init;
            const int v0 = (G % 8 == 0) ? (bid & 7) * (G >> 3) + (bid >> 3) : bid;
            for (int v = v0; v < 256; v += G) {
                const int b = v >> 4, h = (v >> 2) & 3, q0 = v & 3, j16 = v & 15;
                PREP(2)
#pragma unroll 1
                for (int k = 0; k < 8; ++k) index_unit(lds + LDS_STAGE, HQ, MASKp, b, 16 * k + ((k & 1) ? 15 - j16 : j16), wave);
                PREP(3)
#pragma unroll 1
                for (int rep = 0; rep < 2; ++rep) attn_unit<0>(lds + LDS_STAGE, HQ, VT, MIX, MASKp, OA1p, b, h, rep ? 7 - q0 : q0, wave, lane, lam, lam_init, a.subln_g + l * 128, nullptr);
                PREP(4)
#pragma unroll 1
                for (int rep = 0; rep < 2; ++rep) attn_unit<1>(lds + LDS_STAGE, HQ, VT, MIX, MASKp, OA1p, b, h, rep ? 7 - q0 : q0, wave, lane, 0.f, 0.f, nullptr, a.rel_bias + ((size_t)l * 4 + h) * 257);
            }
        }
        SEAM(pb + 1);
        if (IN(pb + 2)) {
            OPAQUE_IDS(); WSPTRS();
            unsigned long long* MASKp = (unsigned long long*)(ws + WS_MASK); float* OA1p = (float*)(ws + WS_OA1);
            const int v0 = (G % 8 == 0) ? (bid & 7) * (G >> 3) + (bid >> 3) : bid;
            for (int v = v0; v < 256; v += G) {
                const int b = v >> 4, h = (v >> 2) & 3, q0 = v & 3;
                PREP(5)
#pragma unroll 1
                for (int rep = 0; rep < 2; ++rep) attn_unit<2>(lds + LDS_STAGE, HQ, VT, MIX, MASKp, OA1p, b, h, rep ? 7 - q0 : q0, wave, lane, 0.f, 0.f, nullptr, nullptr);
            }
        }
        SEAM(pb + 2);
        if (IN(pb + 3)) PREP(6) {
            WSPTRS(); const float* xres = (l == 0) ? a.x : XF;
            pg8::DenseOrder S{T / 256, 4, G, bid, (const char*)(Wout + (size_t)l * 1024 * 1024), 1024, false};
            pg8::EpiResF32 E{Y1, xres};
            pg8::gemm_phase<pg8::EpiResF32, pg8::DenseOrder, false>(lds + LDS_STAGE, MIX, 1024, S, E, wave);
        }
        SEAM(pb + 3);
        if (IN(pb + 4)) {
            OPAQUE_IDS(); WSPTRS();
            LAS int* lcnt = (LAS int*)(lds + LDS_RT); LAS int* lbase = lcnt + 32; LAS int* asg_e = lcnt + 64; LAS int* asg_ls = asg_e + 512;
            const float* g1 = a.ln1_g + l * D; const float* b1 = a.ln1_b + l * D; const float* br = a.b_router + l * NE;
            unsigned* gcnt = ctl + CW_CNT + l * 64;
            LAS float* wT = (LAS float*)(lds + LDS_STAGE);
            { const f32x4* src = (const f32x4*)((const float*)(ws + WS_WRT) + (size_t)l * NE * D);
              for (int i = tid; i < NE * D / 4; i += 512) ((LAS f32x4*)wT)[i] = src[i]; }
            for (int unit = bid; unit < T / 128; unit += G) {
                if (tid < 32) lcnt[tid] = 0;
                __syncthreads();
#pragma unroll 1
                for (int k = 0; k < 8; ++k) {
                    asm volatile("" ::: "memory");
                    const int tl0 = wave * 16 + 2 * k, t0 = unit * 128 + tl0;
                    float v[2][16];
#pragma unroll
                    for (int tk = 0; tk < 2; ++tk)
#pragma unroll
                        for (int i = 0; i < 4; ++i) { const f32x4 u4 = *(const f32x4*)(Y1 + (size_t)(t0 + tk) * D + i * 256 + lane * 4); v[tk][4 * i] = u4[0]; v[tk][4 * i + 1] = u4[1]; v[tk][4 * i + 2] = u4[2]; v[tk][4 * i + 3] = u4[3]; }
#pragma unroll
                    for (int tk = 0; tk < 2; ++tk) {
                        float s = 0.f;
#pragma unroll
                        for (int i = 0; i < 16; ++i) s += v[tk][i];
                        const float mean = wsum(s, lane) * (1.0f / 1024.0f);
                        float qv = 0.f;
#pragma unroll
                        for (int i = 0; i < 16; ++i) { const float d = v[tk][i] - mean; qv += d * d; }
                        const float rstd = rsqrtf(wsum(qv, lane) * (1.0f / 1024.0f) + EPS);
#pragma unroll
                        for (int i = 0; i < 4; ++i) {
                            const int c0 = i * 256 + lane * 4;
                            const f32x4 gg = *(const f32x4*)(g1 + c0), bb = *(const f32x4*)(b1 + c0);
#pragma unroll
                            for (int j = 0; j < 4; ++j) v[tk][4 * i + j] = (v[tk][4 * i + j] - mean) * rstd * gg[j] + bb[j];
                            *(f32x4*)(X1F + (size_t)(t0 + tk) * D + c0) = (f32x4){v[tk][4 * i], v[tk][4 * i + 1], v[tk][4 * i + 2], v[tk][4 * i + 3]};
                            *(u32x2*)(X1B + (size_t)(t0 + tk) * D + c0) = (u32x2){pk_bf16(v[tk][4 * i], v[tk][4 * i + 1]), pk_bf16(v[tk][4 * i + 2], v[tk][4 * i + 3])};
                        }
                    }
                    f32x2 part2[32];
#pragma unroll
                    for (int e = 0; e < 32; ++e) part2[e] = (f32x2){0.f, 0.f};
#pragma unroll
                    for (int i = 0; i < 4; ++i) {
                        f32x2 xv[4];
#pragma unroll
                        for (int j = 0; j < 4; ++j) xv[j] = (f32x2){v[0][4 * i + j], v[1][4 * i + j]};
#pragma unroll
                        for (int e = 0; e < 32; ++e) { const f32x4 w4 = *(const LAS f32x4*)(wT + e * 1024 + i * 256 + lane * 4);
#pragma unroll
                            for (int j = 0; j < 4; ++j) part2[e] = __builtin_elementwise_fma(xv[j], (f32x2){w4[j], w4[j]}, part2[e]);
                            if ((e & 3) == 3) __builtin_amdgcn_sched_barrier(0); }
                    }
                    float part[2][32];
#pragma unroll
                    for (int e = 0; e < 32; ++e) { part[0][e] = part2[e][0]; part[1][e] = part2[e][1]; }
#pragma unroll
                    for (int tk = 0; tk < 2; ++tk) {
                        float p16[16], p8[8], p4[4], p2[2], lg;
                        { const bool hi = (lane & 32) != 0;
#pragma unroll
                          for (int i = 0; i < 16; ++i) { const float keep = hi ? part[tk][i + 16] : part[tk][i], send = hi ? part[tk][i] : part[tk][i + 16]; p16[i] = keep + shx(send, 32, lane); } }
                        { const bool hi = (lane & 16) != 0;
#pragma unroll
                          for (int i = 0; i < 8; ++i) { const float keep = hi ? p16[i + 8] : p16[i], send = hi ? p16[i] : p16[i + 8]; p8[i] = keep + shx(send, 16, lane); } }
                        { const bool hi = (lane & 8) != 0;
#pragma unroll
                          for (int i = 0; i < 4; ++i) { const float keep = hi ? p8[i + 4] : p8[i], send = hi ? p8[i] : p8[i + 4]; p4[i] = keep + shx(send, 8, lane); } }
                        { const bool hi = (lane & 4) != 0;
#pragma unroll
                          for (int i = 0; i < 2; ++i) { const float keep = hi ? p4[i + 2] : p4[i], send = hi ? p4[i] : p4[i + 2]; p2[i] = keep + shx(send, 4, lane); } }
                        { const bool hi = (lane & 2) != 0; const float keep = hi ? p2[1] : p2[0], send = hi ? p2[0] : p2[1]; lg = keep + shx(send, 2, lane); }
                        lg += shx(lg, 1, lane);
                        lg += br[lane >> 1];
                        int be[4]; float bv[4];
#pragma unroll
                        for (int kk = 0; kk < 4; ++kk) {
                            const float mx = wmax(lg, lane);
                            const unsigned long long bal = __ballot(lg == mx);
                            const int e = (__ffsll((long long)bal) - 1) >> 1;
                            be[kk] = e; bv[kk] = mx;
                            if ((lane >> 1) == e) lg = -3e38f;
                        }
                        float ex[4], es = 0.f;
#pragma unroll
                        for (int kk = 0; kk < 4; ++kk) { ex[kk] = __expf(bv[kk] - bv[0]); es += ex[kk]; }
                        if (lane == 0) {
                            const int tl = tl0 + tk, t = t0 + tk;
#pragma unroll
                            for (int kk = 0; kk < 4; ++kk) { const int sl = __hip_atomic_fetch_add(&lcnt[be[kk]], 1, __ATOMIC_RELAXED, __HIP_MEMORY_SCOPE_WORKGROUP); asg_e[tl * 4 + kk] = be[kk]; asg_ls[tl * 4 + kk] = sl; GATE[t * 4 + kk] = ex[kk] / es; }
                        }
                    }
                }
                __syncthreads();
                if (tid < 32) lbase[tid] = (int)__hip_atomic_fetch_add(gcnt + tid, (unsigned)lcnt[tid], __ATOMIC_RELAXED, __HIP_MEMORY_SCOPE_AGENT);
                __syncthreads();
                { const int e = asg_e[tid], sl = lbase[e] + asg_ls[tid], t = unit * 128 + (tid >> 2);
                  TOKL[(size_t)e * T + sl] = t; ASGE[t * 4 + (tid & 3)] = e; ASGS[t * 4 + (tid & 3)] = sl; }
                __syncthreads();
            }
        }
        SEAM(pb + 4);
        LAS int* tstart = (LAS int*)(lds + LDS_TSTART); LAS int* lcntE = (LAS int*)(lds + LDS_CNT); LAS unsigned char* tile_e = lds + LDS_TILEE;
        if (IN(pb + 5) || IN(pb + 6) || IN(pb + 7)) {
            OPAQUE_IDS(); WSPTRS();
            if (tid < 32) lcntE[tid] = (int)__hip_atomic_load(ctl + CW_CNT + l * 64 + tid, __ATOMIC_RELAXED, __HIP_MEMORY_SCOPE_AGENT);
            __syncthreads();
            if (tid == 0) { int acc = 0; for (int e = 0; e < NE; ++e) { tstart[e] = acc; acc += (lcntE[e] + 255) >> 8; } tstart[32] = acc; }
            __syncthreads();
            for (int q = tid; q < MAXRT; q += 512) { int e = 0; for (int k = 0; k < NE; ++k) if (q >= tstart[k]) e = k; tile_e[q] = (unsigned char)e; }
            __syncthreads();
        }
        pg8::MoeTables tb{tstart, lcntE, tile_e, tstart[32]};
        if (IN(pb + 5)) PREP(7) {
            WSPTRS();
            pg8::MoeOrder S{tb, 8, G, bid, (const char*)(Wgu + (size_t)l * NE * 2048 * 1024), (size_t)2048 * 1024 * 2, TOKL, true};
            pg8::EpiSwiglu E{ACT, a.b_gu + (size_t)l * NE * 2048};
            pg8::gemm_phase<pg8::EpiSwiglu, pg8::MoeOrder, true>(lds + LDS_STAGE, X1B, 1024, S, E, wave);
        }
        SEAM(pb + 5);
        if (IN(pb + 6)) PREP(8) {
            WSPTRS();
            pg8::MoeOrder S{tb, 4, G, bid, (const char*)(Wdn + (size_t)l * NE * 1024 * 1024), (size_t)1024 * 1024 * 2, TOKL, false};
            pg8::EpiBiasBf16 E{YR, a.b_down + (size_t)l * NE * 1024};
            pg8::gemm_phase<pg8::EpiBiasBf16, pg8::MoeOrder, false>(lds + LDS_STAGE, ACT, 1024, S, E, wave);
        }
        SEAM(pb + 6);
        if (IN(pb + 7)) PREP(9) {
            OPAQUE_IDS(); WSPTRS(); float* xout = (l == DEPTH - 1) ? a.out : XF;
            const float* g2 = a.ln2_g + l * D; const float* b2 = a.ln2_b + l * D;
            for (int t = gw; t < T; t += NGW) {
                float v[16];
#pragma unroll
                for (int i = 0; i < 4; ++i) { const f32x4 u4 = *(const f32x4*)(X1F + (size_t)t * D + i * 256 + lane * 4);
#pragma unroll
                    for (int j = 0; j < 4; ++j) v[4 * i + j] = ALPHA * u4[j]; }
#pragma unroll
                for (int k = 0; k < 4; ++k) {
                    const int e = ASGE[t * 4 + k]; const float gk = GATE[t * 4 + k];
                    const bf16_t* yp = YR + ((size_t)tstart[e] * 256 + ASGS[t * 4 + k]) * 1024;
#pragma unroll
                    for (int i = 0; i < 4; ++i) { const u32x2 u2 = *(const u32x2*)(yp + i * 256 + lane * 4);
                        v[4 * i] += gk * bf_lo(u2[0]); v[4 * i + 1] += gk * bf_hi(u2[0]); v[4 * i + 2] += gk * bf_lo(u2[1]); v[4 * i + 3] += gk * bf_hi(u2[1]); }
                }
                float s = 0.f;
#pragma unroll
                for (int i = 0; i < 16; ++i) s += v[i];
                const float mean = wsum(s, lane) * (1.0f / 1024.0f);
                float qv = 0.f;
#pragma unroll
                for (int i = 0; i < 16; ++i) { const float d = v[i] - mean; qv += d * d; }
                const float rstd = rsqrtf(wsum(qv, lane) * (1.0f / 1024.0f) + EPS);
#pragma unroll
                for (int i = 0; i < 4; ++i) {
                    const int c0 = i * 256 + lane * 4;
                    const f32x4 gg = *(const f32x4*)(g2 + c0), bb = *(const f32x4*)(b2 + c0);
                    float o[4];
#pragma unroll
                    for (int j = 0; j < 4; ++j) o[j] = (v[4 * i + j] - mean) * rstd * gg[j] + bb[j];
                    *(f32x4*)(xout + (size_t)t * D + c0) = (f32x4){o[0], o[1], o[2], o[3]};
                    *(u32x2*)(XB + (size_t)t * D + c0) = (u32x2){pk_bf16(o[0], o[1]), pk_bf16(o[2], o[3])};
                }
            }
        }
        if (l + 1 < DEPTH) SEAM(pb + 7);
    }
#undef IN
#undef SEAM
}

extern "C" void kernel_launch(void* const* d_in, const int* in_sizes, int n_in, void* d_out, int out_size, void* d_ws, size_t ws_size, hipStream_t stream) {
    static int grid = 0;
    if (grid == 0) {
        if (ws_size < WS_END) { fprintf(stderr, "kernel_launch: workspace too small (%zu < %zu)\n", ws_size, (size_t)WS_END); grid = -1; return; }
        int dev = 0, cus = 0, per_cu = 0;
        if (hipGetDevice(&dev) != hipSuccess || hipDeviceGetAttribute(&cus, hipDeviceAttributeMultiprocessorCount, dev) != hipSuccess) { grid = -1; return; }
        if (hipFuncSetAttribute((const void*)mega, hipFuncAttributeMaxDynamicSharedMemorySize, LDS_BYTES) != hipSuccess) { fprintf(stderr, "kernel_launch: hipFuncSetAttribute failed\n"); grid = -1; return; }
        if (hipOccupancyMaxActiveBlocksPerMultiprocessor(&per_cu, (const void*)mega, 512, LDS_BYTES) != hipSuccess || per_cu < 1) { fprintf(stderr, "kernel_launch: occupancy query says %d\n", per_cu); }
        (void)hipGetLastError();
        grid = cus;
        if (grid % 8 != 0) grid -= grid % 8;
    }
    if (grid < 0) return;
    (void)hipMemsetAsync((char*)d_ws + WS_CTL, 0, CTL_BYTES, stream);
    Args a{};
    a.x = (const float*)d_in[0]; a.w_in = (const float*)d_in[1]; a.lam_q1 = (const float*)d_in[2]; a.lam_k1 = (const float*)d_in[3]; a.lam_q2 = (const float*)d_in[4]; a.lam_k2 = (const float*)d_in[5];
    a.subln_g = (const float*)d_in[6]; a.rel_bias = (const float*)d_in[7]; a.w_out = (const float*)d_in[8]; a.ln1_g = (const float*)d_in[9]; a.ln1_b = (const float*)d_in[10];
    a.w_router = (const float*)d_in[11]; a.b_router = (const float*)d_in[12]; a.w_gu = (const float*)d_in[13]; a.b_gu = (const float*)d_in[14]; a.w_down = (const float*)d_in[15];
    a.b_down = (const float*)d_in[16]; a.ln2_g = (const float*)d_in[17]; a.ln2_b = (const float*)d_in[18];
    a.out = (float*)d_out; a.ws = (unsigned char*)d_ws; a.pad = 0;
    a.ph_lo = 0; a.ph_hi = 1 + 8 * DEPTH; a.bar_region = 0;
    hipLaunchKernelGGL(mega, dim3(grid), dim3(512), LDS_BYTES, stream, a);
}
```

```cpp
#include <hip/hip_runtime.h>
#include <stdint.h>
#include <cstdio>

#define LAS __attribute__((address_space(3)))
typedef unsigned short bf16_t;
typedef _Float16 bf16x8 __attribute__((ext_vector_type(8)));
typedef float f32x4 __attribute__((ext_vector_type(4)));
typedef float f32x2 __attribute__((ext_vector_type(2)));
typedef unsigned u32x4 __attribute__((ext_vector_type(4)));
typedef unsigned u32x2 __attribute__((ext_vector_type(2)));
typedef _Float16 bf16v2 __attribute__((ext_vector_type(2)));

constexpr int D = 1024, BATCH = 16, SEQ = 2048, T = BATCH * SEQ, DEPTH = 4;
constexpr int DIN = 3368;
constexpr int NE = 32;
constexpr float ALPHA = 1.681792830507429f;
constexpr float EPS = 1e-5f;
constexpr float LOG2E = 1.4426950408889634f;
constexpr float QSCALE = 0.125f * LOG2E;
constexpr int HQP = 2560;
constexpr int HQ_QA = 0, HQ_KA = 512, HQ_QB = 1024, HQ_KB = 1280, HQ_QC = 1536, HQ_KC = 1792, HQ_QI = 2048, HQ_KI = 2304, HQ_WI = 2336, HQ_USED = 2344;
constexpr int VT_A = 0, VT_B = 512, VT_C = 768;
constexpr int NASG = T * 4;
constexpr int GROWS = NASG + NE * 256;
constexpr int MAXRT = GROWS / 256;

constexpr size_t MiB = (size_t)1 << 20;
constexpr size_t al(size_t x) { return (x + 255) & ~(size_t)255; }
constexpr size_t WS_CTL = 0, CTL_BYTES = 4 * MiB;
constexpr size_t WS_WIN = WS_CTL + CTL_BYTES;
constexpr size_t WS_WV = WS_WIN + al((size_t)DEPTH * HQP * D * 2);
constexpr size_t WS_WOUT = WS_WV + al((size_t)DEPTH * 1024 * D * 2);
constexpr size_t WS_WGU = WS_WOUT + al((size_t)DEPTH * D * 1024 * 2);
constexpr size_t WS_WDN = WS_WGU + al((size_t)DEPTH * NE * 2048 * D * 2);
constexpr size_t WS_XB = WS_WDN + al((size_t)DEPTH * NE * D * 1024 * 2);
constexpr size_t WS_HQ = WS_XB + al((size_t)T * D * 2);
constexpr size_t WS_VT = WS_HQ + al((size_t)T * HQP * 2);
constexpr size_t WS_MIX = WS_VT + al((size_t)1024 * T * 2);
constexpr size_t WS_Y1 = WS_MIX + al((size_t)T * 1024 * 2);
constexpr size_t WS_X1B = WS_Y1 + al((size_t)T * D * 2);
constexpr size_t WS_ACT = WS_X1B + al((size_t)T * D * 2);
constexpr size_t WS_YR = WS_ACT + al((size_t)GROWS * 1024 * 2);
constexpr size_t WS_MASK = WS_YR + al((size_t)GROWS * 1024 * 2);
constexpr size_t WS_TOKL = WS_MASK + al((size_t)T * 32 * 8);
constexpr size_t WS_ASGE = WS_TOKL + al((size_t)NE * T * 4);
constexpr size_t WS_ASGS = WS_ASGE + al((size_t)NASG * 4);
constexpr size_t WS_GATE = WS_ASGS + al((size_t)NASG * 4);
constexpr size_t WS_OA1 = WS_GATE + al((size_t)NASG * 4);
constexpr size_t WS_WRT = WS_OA1 + al((size_t)T * 512 * 4);
constexpr size_t WS_END = WS_WRT + al((size_t)DEPTH * NE * D * 4);
constexpr int CW_BAR = 4096;
constexpr int CW_CNT = 262144;

__device__ __forceinline__ unsigned pk_bf16(float lo, float hi) { f32x2 v = {lo, hi}; return __builtin_bit_cast(unsigned, __builtin_convertvector(v, bf16v2)); }
__device__ __forceinline__ float bf_lo(unsigned u) { return (float)__builtin_bit_cast(bf16v2, u)[0]; }
__device__ __forceinline__ float bf_hi(unsigned u) { return (float)__builtin_bit_cast(bf16v2, u)[1]; }
__device__ __forceinline__ float bf2f(bf16_t b) { return (float)__builtin_bit_cast(bf16v2, (unsigned)b)[0]; }
__device__ __forceinline__ float wave_sum(float v) {
#pragma unroll
    for (int o = 32; o > 0; o >>= 1) v += __shfl_xor(v, o);
    return v; }
__device__ __forceinline__ float wave_max(float v) {
#pragma unroll
    for (int o = 32; o > 0; o >>= 1) v = fmaxf(v, __shfl_xor(v, o));
    return v; }
__device__ __forceinline__ int wave_sum_i(int v) {
#pragma unroll
    for (int o = 32; o > 0; o >>= 1) v += __shfl_xor(v, o);
    return v; }

__device__ __forceinline__ float shx(float v, int o, int lane) { return __int_as_float(__builtin_amdgcn_ds_bpermute((lane ^ o) << 2, __float_as_int(v))); }
__device__ __forceinline__ float wsum(float v, int lane) {
#pragma unroll
    for (int o = 32; o > 0; o >>= 1) v += shx(v, o, lane);
    return v; }
__device__ __forceinline__ float wmax(float v, int lane) {
#pragma unroll
    for (int o = 32; o > 0; o >>= 1) v = fmaxf(v, shx(v, o, lane));
    return v; }

#define XB_TMO      128
#define XB_XCNT(j)  (256  + 64 * (j))
#define XB_XSUB(j)  (1280 + 64 * (j))
#define XB_XGEN(j)  (2304 + 64 * (j))
#define XB_TOP      3328
#define XB_TOPGEN   3392
#define XCD_BAR_WORDS 3456
#define XB_SPIN_CAP (1u << 22)
__device__ __forceinline__ unsigned xb_ld(unsigned* p)              { return __hip_atomic_load(p, __ATOMIC_RELAXED, __HIP_MEMORY_SCOPE_AGENT); }
__device__ __forceinline__ unsigned xb_add(unsigned* p, unsigned v) { return __hip_atomic_fetch_add(p, v, __ATOMIC_RELAXED, __HIP_MEMORY_SCOPE_AGENT); }
__device__ __forceinline__ unsigned xb_xcc_id() { return (unsigned)__builtin_amdgcn_s_getreg((3 << 11) | 20) & 0xFu; }
#define XB_SPIN(cond, bar) do { unsigned _sp = 0; while (cond) { __builtin_amdgcn_s_sleep(1); \
    if ((++_sp & 255u) == 0u) { if (xb_ld(&(bar)[XB_TMO])) break; if (_sp > XB_SPIN_CAP) { atomicAdd(&(bar)[XB_TMO], 1u); break; } } } } while (0)
struct XcdBarrier { unsigned* bar; unsigned x; volatile LAS unsigned* st; };
__device__ __forceinline__ XcdBarrier xcd_barrier_post(unsigned* bar, volatile LAS unsigned* st) {
    XcdBarrier b; b.bar = bar; b.x = xb_xcc_id(); b.st = st;
    if (threadIdx.x == 0) (void)xb_add(&bar[XB_XCNT(b.x)], 1u);
    return b;
}
__device__ __forceinline__ void xcd_barrier_complete(unsigned* bar, unsigned x, unsigned& nloc, unsigned& nx) {
    const unsigned G = gridDim.x * gridDim.y * gridDim.z;
    unsigned sum, cnt, mine, sp = 0u;
    for (;;) {
        sum = 0u; cnt = 0u; mine = 0u;
#pragma unroll
        for (unsigned j = 0; j < 16; ++j) { const unsigned c = xb_ld(&bar[XB_XCNT(j)]); sum += c; cnt += (c > 0u) ? 1u : 0u; mine = (j == x) ? c : mine; }
        if (sum == G) break;
        __builtin_amdgcn_s_sleep(1);
        if ((++sp & 255u) == 0u) { if (xb_ld(&bar[XB_TMO])) break; if (sp > XB_SPIN_CAP) { atomicAdd(&bar[XB_TMO], 1u); break; } }
    }
    nloc = mine > 0u ? mine : 1u; nx = cnt > 0u ? cnt : 1u;
}
__device__ __forceinline__ void xcd_barrier(const XcdBarrier& b) {
    asm volatile("s_waitcnt vmcnt(0)" ::: "memory");
    __syncthreads();
    if (threadIdx.x == 0) {
        unsigned* bar = b.bar;
        __builtin_amdgcn_s_waitcnt(0);
        unsigned nloc = b.st[0], nx = b.st[1];
        if (nloc == 0u) { xcd_barrier_complete(bar, b.x, nloc, nx); b.st[0] = nloc; b.st[1] = nx; }
        const unsigned old = xb_add(&bar[XB_XSUB(b.x)], 1u);
        const unsigned gen = old / nloc;
        if (old + 1u == (gen + 1u) * nloc) {
            __builtin_amdgcn_fence(__ATOMIC_RELEASE, "agent");
            asm volatile("s_waitcnt vmcnt(0)" ::: "memory");
            const unsigned og = xb_add(&bar[XB_TOP], 1u);
            const unsigned tg = og / nx;
            if (og + 1u == (tg + 1u) * nx) xb_add(&bar[XB_TOPGEN], 1u);
            else XB_SPIN(xb_ld(&bar[XB_TOPGEN]) == tg, bar);
            __builtin_amdgcn_fence(__ATOMIC_ACQUIRE, "agent");
            xb_add(&bar[XB_XGEN(b.x)], 1u);
            asm volatile("s_waitcnt vmcnt(0)" ::: "memory");
        } else {
            XB_SPIN(xb_ld(&bar[XB_XGEN(b.x)]) == gen, bar);
            __builtin_amdgcn_fence(__ATOMIC_ACQUIRE, "agent");
            asm volatile("s_waitcnt vmcnt(0)" ::: "memory");
        }
    }
    __syncthreads();
}

namespace pg8 {
constexpr int BM = 256, BK = 64, HALF = 128, HTB = HALF * BK * 2, STAGE_BYTES = 8 * HTB;
__host__ __device__ __forceinline__ int lds_byte(int r, int c) { const int st = (r >> 4) * 2 + (c >> 5), rr = r & 15, cc = c & 31, ob = rr * 64 + cc * 2; return st * 1024 + (ob ^ (((ob >> 9) & 1) << 5)); }
__host__ __device__ __forceinline__ void stage_rc(int b, int& R, int& C) { const int st = b / 1024, sb = b % 1024, swz = sb ^ (((sb >> 9) & 1) << 5); R = (st >> 1) * 16 + swz / 64; C = (st & 1) * 32 + (swz % 64) / 2; }
__host__ __device__ __forceinline__ int perm32(int rho) { const int n = rho >> 4, i = rho & 15; return 8 * (i >> 2) + 4 * n + (i & 3); }

struct Unit {
    int row0;
    int col0;
    const char* Bt;
    const int* rows;
    int nvalid;
    int e;
};

template <class Epi, class Sched, bool GATHER>
__device__ __forceinline__ void gemm_phase(LAS unsigned char* lds, const bf16_t* Abase, const int K, const Sched& S, const Epi& E, const int wid) {
    int lane; asm volatile("v_mbcnt_lo_u32_b32 %0, -1, 0\n\tv_mbcnt_hi_u32_b32 %0, -1, %0" : "=&v"(lane));
    const int tid = wid * 64 + lane, wr = wid >> 2, wc = wid & 3, fr = lane & 15, fq = lane >> 4;
    const int nt = K / BK;
    int Rl[2], Cl[2]; unsigned voffB[2];
#pragma unroll
    for (int i = 0; i < 2; ++i) { int R, C; stage_rc(tid * 16 + i * 8192, R, C); Rl[i] = R; Cl[i] = C; const int Rb = Epi::PERM ? ((R & ~31) + perm32(R & 31)) : R; voffB[i] = (unsigned)(Rb * K + C) * 2u; }
    const size_t kstep = (size_t)(BK * 2);
    const size_t hstep = (size_t)HALF * K * 2;
    const unsigned ldsw = (unsigned)wid * 1024u;
    const int aoff = lds_byte(wr * 64 + fr, fq * 8), boff = lds_byte(wc * 32 + fr, fq * 8);
#define PG8_SA(b, h) (((b) * 2 + (h)) * HTB)
#define PG8_SB(b, h) ((4 + (b) * 2 + (h)) * HTB)
#define PG8_STAGE(bufoff, gbase, voff) do { _Pragma("unroll") for (int _i = 0; _i < 2; ++_i) \
        __builtin_amdgcn_global_load_lds((const unsigned*)((const char*)(gbase) + (voff)[_i]), (LAS unsigned*)(lds + (bufoff) + ldsw + _i * 8192), 16, 0, 0); } while (0)
#define PG8_LDA(dst, b, h) do { _Pragma("unroll") for (int m = 0; m < 4; ++m) _Pragma("unroll") for (int k = 0; k < 2; ++k) dst[m][k] = *(const LAS bf16x8*)(lds + PG8_SA(b, h) + aoff + m * 2048 + k * 1024); } while (0)
#define PG8_LDB(dst, b, h) do { _Pragma("unroll") for (int n = 0; n < 2; ++n) _Pragma("unroll") for (int k = 0; k < 2; ++k) dst[n][k] = *(const LAS bf16x8*)(lds + PG8_SB(b, h) + boff + n * 2048 + k * 1024); } while (0)
#define PG8_MMA(ai, bj, At, Bt) do { __builtin_amdgcn_s_setprio(1); _Pragma("unroll") for (int m = 0; m < 4; ++m) _Pragma("unroll") for (int n = 0; n < 2; ++n) _Pragma("unroll") for (int k = 0; k < 2; ++k) \
        acc[ai][bj][m][n] = __builtin_amdgcn_mfma_f32_16x16x32_f16(Bt[n][k], At[m][k], acc[ai][bj][m][n], 0, 0, 0); __builtin_amdgcn_s_setprio(0); } while (0)
#define PG8_WAIT_V(n) asm volatile("s_waitcnt vmcnt(" #n ")" ::: "memory")
#define PG8_WAIT_L(n) asm volatile("s_waitcnt lgkmcnt(" #n ")" ::: "memory")
#define PG8_BAR __builtin_amdgcn_s_barrier()
#define PG8_SCHED __builtin_amdgcn_sched_barrier(0)
#define PG8_AOFFS(dst, u) do { _Pragma("unroll") for (int _h = 0; _h < 2; ++_h) _Pragma("unroll") for (int _i = 0; _i < 2; ++_i) { \
        int _src; if (GATHER) { const int _r = _h * HALF + Rl[_i]; _src = (_r < (u).nvalid) ? (u).rows[_r] : 0; } else _src = (u).row0 + _h * HALF + Rl[_i]; \
        dst[_h][_i] = (unsigned)(_src * K + Cl[_i]) * 2u; } } while (0)
    Unit cur, nxt; int ui = 0;
    if (!S.next(0, cur)) return;
    f32x4 acc[2][2][4][2];
#pragma unroll
    for (int a = 0; a < 2; ++a)
#pragma unroll
        for (int b = 0; b < 2; ++b)
#pragma unroll
            for (int m = 0; m < 4; ++m)
#pragma unroll
                for (int n = 0; n < 2; ++n) acc[a][b][m][n] = (f32x4){0.f, 0.f, 0.f, 0.f};
    bf16x8 At[4][2], B0[2][2], B1[2][2];
    unsigned oa[2][2], na[2][2];
    PG8_AOFFS(oa, cur);
    const char* cA = (const char*)Abase; const char* cB = cur.Bt;
    PG8_STAGE(PG8_SB(0, 0), cB, voffB); PG8_STAGE(PG8_SB(0, 1), cB + hstep, voffB); PG8_STAGE(PG8_SA(0, 0), cA, oa[0]); PG8_STAGE(PG8_SA(0, 1), cA, oa[1]);
    if (wr == 1) PG8_BAR;
    PG8_WAIT_V(2); PG8_BAR;
    PG8_STAGE(PG8_SB(1, 0), cB + kstep, voffB); PG8_STAGE(PG8_SA(1, 0), cA + kstep, oa[0]); PG8_STAGE(PG8_SB(1, 1), cB + hstep + kstep, voffB);
    PG8_WAIT_V(6); PG8_BAR;
    for (;;) {
        const bool has_next = S.next(ui + 1, nxt);
        if (has_next) { PG8_AOFFS(na, nxt); if (GATHER) asm volatile("" : "+v"(na[0][0]), "+v"(na[0][1]), "+v"(na[1][0]), "+v"(na[1][1])); }
        else {
#pragma unroll
            for (int h = 0; h < 2; ++h)
#pragma unroll
                for (int i = 0; i < 2; ++i) na[h][i] = oa[h][i];
        }
        const char* nB = has_next ? nxt.Bt : cB;
        for (int t = 0; t < nt; t += 2) {
            const bool last = (t == nt - 2);
            const char* a1 = cA + (size_t)(t + 1) * kstep;
            const char* a2 = last ? cA : cA + (size_t)(t + 2) * kstep; const char* b2 = last ? nB : cB + (size_t)(t + 2) * kstep;
            const char* a3 = a2 + kstep; const char* b3 = b2 + kstep;
            unsigned sa[2][2];
#pragma unroll
            for (int h = 0; h < 2; ++h)
#pragma unroll
                for (int i = 0; i < 2; ++i) sa[h][i] = last ? na[h][i] : oa[h][i];
            PG8_LDB(B0, 0, 0); PG8_LDB(B1, 0, 1); PG8_SCHED; PG8_LDA(At, 0, 0); PG8_STAGE(PG8_SA(1, 1), a1, oa[1]);
            PG8_WAIT_V(8); PG8_WAIT_L(0); PG8_BAR; PG8_MMA(0, 0, At, B0); PG8_MMA(0, 1, At, B1); PG8_BAR; PG8_SCHED;
            PG8_LDA(At, 0, 1); PG8_STAGE(PG8_SB(0, 0), b2, voffB); PG8_STAGE(PG8_SB(0, 1), b2 + hstep, voffB); PG8_STAGE(PG8_SA(0, 0), a2, sa[0]);
            PG8_WAIT_V(8); PG8_WAIT_L(0); PG8_BAR; PG8_MMA(1, 0, At, B0); PG8_MMA(1, 1, At, B1); PG8_BAR; PG8_SCHED;
            PG8_LDB(B0, 1, 0); PG8_LDB(B1, 1, 1); PG8_SCHED; PG8_LDA(At, 1, 0); PG8_STAGE(PG8_SA(0, 1), a2, sa[1]);
            PG8_WAIT_V(8); PG8_WAIT_L(0); PG8_BAR; PG8_MMA(0, 0, At, B0); PG8_MMA(0, 1, At, B1); PG8_BAR; PG8_SCHED;
            PG8_LDA(At, 1, 1); PG8_STAGE(PG8_SB(1, 0), b3, voffB); PG8_STAGE(PG8_SB(1, 1), b3 + hstep, voffB); PG8_STAGE(PG8_SA(1, 0), a3, sa[0]);
            PG8_WAIT_V(8); PG8_WAIT_L(0); PG8_BAR; PG8_MMA(1, 0, At, B0); PG8_MMA(1, 1, At, B1); PG8_BAR; PG8_SCHED;
        }
        if (wr == 0) PG8_BAR;
        E(acc, cur, wr, wc, fr, fq);
        if (!has_next) break;
#pragma unroll
        for (int a = 0; a < 2; ++a)
#pragma unroll
            for (int b = 0; b < 2; ++b)
#pragma unroll
                for (int m = 0; m < 4; ++m)
#pragma unroll
                    for (int n = 0; n < 2; ++n) acc[a][b][m][n] = (f32x4){0.f, 0.f, 0.f, 0.f};
        cur = nxt; cB = nB; ++ui;
#pragma unroll
        for (int h = 0; h < 2; ++h)
#pragma unroll
            for (int i = 0; i < 2; ++i) oa[h][i] = na[h][i];
        if (wr == 1) PG8_BAR;
    }
    PG8_WAIT_V(0);
    PG8_BAR;
#undef PG8_SA
#undef PG8_SB
#undef PG8_STAGE
#undef PG8_LDA
#undef PG8_LDB
#undef PG8_MMA
#undef PG8_WAIT_V
#undef PG8_WAIT_L
#undef PG8_BAR
#undef PG8_SCHED
#undef PG8_AOFFS
}

struct DenseOrder {
    int nRT, nN, G, c; const char* Bt; int K; bool swap;
    __device__ __forceinline__ bool next(int i, Unit& u) const {
        const int xcd = c & 7, s = i * (G >> 3) + (c >> 3);
        int rt, pn;
        if (!swap) { rt = 8 * (s / nN) + xcd; pn = s % nN; } else { pn = 8 * (s / nRT) + xcd; rt = s % nRT; }
        if (rt >= nRT || pn >= nN) return false;
        u.row0 = rt * BM; u.col0 = pn * BM; u.Bt = Bt + (size_t)pn * BM * K * 2; u.rows = nullptr; u.nvalid = 0; u.e = 0; return true;
    }
};
struct MoeTables { LAS const int* tstart; LAS const int* cnt; LAS const unsigned char* tile_e; int nrt; };
struct MoeOrder {
    MoeTables tb; int nN, G, c; const char* Bt; size_t strideB; const int* tokl; bool gather;
    __device__ __forceinline__ bool next(int i, Unit& u) const {
        const int xcd = c & 7, s = i * (G >> 3) + (c >> 3);
        const int q = 8 * (s / nN) + xcd, pn = s % nN;
        if (q >= tb.nrt) return false;
        const int e = tb.tile_e[q]; const int lt = q - tb.tstart[e];
        u.row0 = q * BM; u.col0 = pn * BM; u.e = e; u.Bt = Bt + (size_t)e * strideB + (size_t)pn * BM * 1024 * 2;
        u.rows = gather ? tokl + (size_t)e * T + lt * BM : nullptr; u.nvalid = tb.cnt[e] - lt * BM; return true;
    }
};

struct EpiBf16Plain {
    static constexpr bool PERM = true;
    bf16_t* O; int ldc;
    __device__ __forceinline__ void operator()(const f32x4 (&acc)[2][2][4][2], const Unit& u, int wr, int wc, int fr, int fq) const {
        const int row0 = u.row0 + wr * 64 + fr, col0 = u.col0 + wc * 32 + 8 * fq;
#pragma unroll
        for (int ai = 0; ai < 2; ++ai)
#pragma unroll
            for (int m = 0; m < 4; ++m) { bf16_t* rowp = O + (size_t)(row0 + ai * HALF + m * 16) * ldc + col0;
#pragma unroll
                for (int bj = 0; bj < 2; ++bj) { const f32x4 v0 = acc[ai][bj][m][0], v1 = acc[ai][bj][m][1];
                    u32x4 w; w.x = pk_bf16(v0[0], v0[1]); w.y = pk_bf16(v0[2], v0[3]); w.z = pk_bf16(v1[0], v1[1]); w.w = pk_bf16(v1[2], v1[3]);
                    *(u32x4*)(rowp + bj * HALF) = w; } }
    }
};
struct EpiResBf16 {
    static constexpr bool PERM = true;
    bf16_t* O; const bf16_t* R;
    __device__ __forceinline__ void operator()(const f32x4 (&acc)[2][2][4][2], const Unit& u, int wr, int wc, int fr, int fq) const {
        const int row0 = u.row0 + wr * 64 + fr, col0 = u.col0 + wc * 32 + 8 * fq;
#pragma unroll
        for (int ai = 0; ai < 2; ++ai)
#pragma unroll
            for (int m = 0; m < 4; ++m) { const size_t off = (size_t)(row0 + ai * HALF + m * 16) * 1024 + col0;
#pragma unroll
                for (int bj = 0; bj < 2; ++bj) { const u32x4 r = *(const u32x4*)(R + off + bj * HALF); const f32x4 v0 = acc[ai][bj][m][0], v1 = acc[ai][bj][m][1];
                    u32x4 w; w.x = pk_bf16(bf_lo(r[0]) * ALPHA + v0[0], bf_hi(r[0]) * ALPHA + v0[1]); w.y = pk_bf16(bf_lo(r[1]) * ALPHA + v0[2], bf_hi(r[1]) * ALPHA + v0[3]);
                    w.z = pk_bf16(bf_lo(r[2]) * ALPHA + v1[0], bf_hi(r[2]) * ALPHA + v1[1]); w.w = pk_bf16(bf_lo(r[3]) * ALPHA + v1[2], bf_hi(r[3]) * ALPHA + v1[3]);
                    *(u32x4*)(O + off + bj * HALF) = w; } }
    }
};
struct EpiSwiglu {
    static constexpr bool PERM = true;
    bf16_t* O; const float* bias;
    __device__ __forceinline__ void operator()(const f32x4 (&acc)[2][2][4][2], const Unit& u, int wr, int wc, int fr, int fq) const {
        const int row0 = u.row0 + wr * 64 + fr, oc = (u.col0 >> 1) + wc * 32 + 8 * fq;
        const float* bp = bias + (size_t)u.e * 2048 + oc;
        f32x4 bg[2], bu[2];
#pragma unroll
        for (int n = 0; n < 2; ++n) { bg[n] = *(const f32x4*)(bp + 4 * n); bu[n] = *(const f32x4*)(bp + 1024 + 4 * n); }
#pragma unroll
        for (int ai = 0; ai < 2; ++ai)
#pragma unroll
            for (int m = 0; m < 4; ++m) {
                float o[8];
#pragma unroll
                for (int n = 0; n < 2; ++n) { const f32x4 g4 = acc[ai][0][m][n] + bg[n], u4 = acc[ai][1][m][n] + bu[n];
#pragma unroll
                    for (int j = 0; j < 4; ++j) { const float g = fminf(g4[j], 7.0f), up = fminf(fmaxf(u4[j], -7.0f), 7.0f);
                        const float glu = g * __builtin_amdgcn_rcpf(1.0f + __builtin_amdgcn_exp2f(-1.702f * LOG2E * g)); o[4 * n + j] = (up + 1.0f) * glu; } }
                u32x4 w; w.x = pk_bf16(o[0], o[1]); w.y = pk_bf16(o[2], o[3]); w.z = pk_bf16(o[4], o[5]); w.w = pk_bf16(o[6], o[7]);
                *(u32x4*)(O + (size_t)(row0 + ai * HALF + m * 16) * 1024 + oc) = w; }
    }
};
struct EpiBiasBf16 {
    static constexpr bool PERM = true;
    bf16_t* O; const float* bias;
    __device__ __forceinline__ void operator()(const f32x4 (&acc)[2][2][4][2], const Unit& u, int wr, int wc, int fr, int fq) const {
        const int row0 = u.row0 + wr * 64 + fr, col0 = u.col0 + wc * 32 + 8 * fq;
        const float* bp = bias + (size_t)u.e * 1024 + col0;
        f32x4 bv[2][2];
#pragma unroll
        for (int bj = 0; bj < 2; ++bj)
#pragma unroll
            for (int n = 0; n < 2; ++n) bv[bj][n] = *(const f32x4*)(bp + bj * HALF + 4 * n);
#pragma unroll
        for (int ai = 0; ai < 2; ++ai)
#pragma unroll
            for (int m = 0; m < 4; ++m) { bf16_t* rowp = O + (size_t)(row0 + ai * HALF + m * 16) * 1024 + col0;
#pragma unroll
                for (int bj = 0; bj < 2; ++bj) { const f32x4 v0 = acc[ai][bj][m][0] + bv[bj][0], v1 = acc[ai][bj][m][1] + bv[bj][1];
                    u32x4 w; w.x = pk_bf16(v0[0], v0[1]); w.y = pk_bf16(v0[2], v0[3]); w.z = pk_bf16(v1[0], v1[1]); w.w = pk_bf16(v1[2], v1[3]);
                    *(u32x4*)(rowp + bj * HALF) = w; } }
    }
};
}


#ifndef ATT_EN
#define ATT_EN 7
#endif
#ifndef PROBE
#define PROBE (-1)
#endif
#define PREP(k) _Pragma("unroll 1") for (int _rp = 0; _rp < ((PROBE == (k)) ? 2 : 1); ++_rp)
typedef float f32x16 __attribute__((ext_vector_type(16)));
#define MFMA32(a, b, c) __builtin_amdgcn_mfma_f32_32x32x16_f16((a), (b), (c), 0, 0, 0)
constexpr int ATT_BUF = 27648;
constexpr int ATT_RELB = 2 * ATT_BUF;
#define NEG_INF_F (-__builtin_huge_valf())

template <int MODE>
__device__ __forceinline__ void attn_unit(LAS unsigned char* lds, const bf16_t* HQ, const bf16_t* VT, bf16_t* MIX, const unsigned long long* MASK, float* OA1,
                                          const int b, const int h, const int qt, const int wave, const int lane_unused,
                                          const float lam, const float lam_init, const float* subg, const float* relb) {
    constexpr int NPASS = (MODE == 0) ? 2 : 1;
    constexpr int EB = (MODE == 0) ? 4 : 2;
    constexpr int KSTR = 144;
    constexpr int VOFF = 64 * KSTR;
    constexpr int NCHV = (MODE == 0) ? 2 : 1;
    const int qoff = (MODE == 0) ? HQ_QA + h * 128 : (MODE == 1) ? HQ_QB + h * 64 : HQ_QC + h * 64;
    const int koff = (MODE == 0) ? HQ_KA + h * 128 : (MODE == 1) ? HQ_KB + h * 64 : HQ_KC + h * 64;
    const int vrow0 = (MODE == 0) ? VT_A + h * 128 : (MODE == 1) ? VT_B + h * 64 : VT_C + h * 64;
    const int mixcol = (MODE == 0) ? h * 128 : (MODE == 1) ? 512 + h * 64 : 768 + h * 64;
    int lane; asm volatile("v_mbcnt_lo_u32_b32 %0, -1, 0\n\tv_mbcnt_hi_u32_b32 %0, -1, %0" : "=&v"(lane));
    const int tid = wave * 64 + lane, ql = lane & 31, hb = lane >> 5;
    const int cq = qt * 4 + (wave >> 1);
    const int tq = qt * 256 + wave * 32 + ql;
    const int kt_hi = qt * 4 + 3;
    const int kt_lo = (MODE == 1) ? ((qt * 4 - 8) > 0 ? (qt * 4 - 8) : 0) : 0;
    const float slope2 = (MODE == 0) ? exp2f(-(float)(2 * h + 1)) * LOG2E : exp2f(-(float)(2 * h + 2)) * LOG2E;
    LAS float* relb_l = (LAS float*)(lds + ATT_RELB);
    const int prow = (ql & 16) | ((ql & 4) << 1) | ((ql & 8) >> 1) | (ql & 3);
    const int krow = tid >> 3, kc = tid & 7;
#pragma unroll 1
    for (int mp = 0; mp < NPASS; ++mp) {
        bf16x8 Q[4];
        { const bf16_t* qp = HQ + (size_t)(b * SEQ + tq) * HQP + qoff + mp * 64 + hb * 8;
#pragma unroll
          for (int ks = 0; ks < 4; ++ks) Q[ks] = *(const bf16x8*)(qp + ks * 16); }
        f32x16 O[EB];
        float mrun = -1e30f, lrun = 0.f;
#pragma unroll
        for (int eb = 0; eb < EB; ++eb)
#pragma unroll
            for (int i = 0; i < 16; ++i) O[eb][i] = 0.f;
        u32x4 kreg, vreg[NCHV];
#define ATT_LOAD(kt_) do { kreg = *(const u32x4*)(HQ + (size_t)(b * SEQ + (kt_) * 64 + krow) * HQP + koff + mp * 64 + kc * 8); \
        _Pragma("unroll") for (int j = 0; j < NCHV; ++j) vreg[j] = *(const u32x4*)(VT + (size_t)(vrow0 + krow + 64 * j) * T + (size_t)b * SEQ + (kt_) * 64 + kc * 8); } while (0)
#define ATT_STORE(buf_) do { *(LAS u32x4*)(lds + (buf_) * ATT_BUF + krow * KSTR + kc * 16) = kreg; \
        _Pragma("unroll") for (int j = 0; j < NCHV; ++j) *(LAS u32x4*)(lds + (buf_) * ATT_BUF + VOFF + (krow + 64 * j) * 144 + kc * 16) = vreg[j]; } while (0)

        __syncthreads();
        if (MODE == 1) { for (int i = tid; i < 257; i += 512) relb_l[i] = relb[i] * LOG2E; }
        ATT_LOAD(kt_hi); ATT_STORE(0);
        __syncthreads();
        int buf = 0;
        for (int kt = kt_hi; kt >= kt_lo; --kt) {
            if (kt > kt_lo) ATT_LOAD(kt - 1);
            const bool active = (kt <= cq) && (MODE != 1 || kt >= cq - 8);
            if (active) {
                const LAS unsigned char* kbp = lds + buf * ATT_BUF + prow * KSTR + hb * 16;
                const LAS unsigned char* vbp = lds + buf * ATT_BUF + VOFF + ql * 144 + hb * 16;
                f32x16 S0, S1;
#pragma unroll
                for (int i = 0; i < 16; ++i) { S0[i] = 0.f; S1[i] = 0.f; }
#pragma unroll
                for (int ks = 0; ks < 4; ++ks) {
                    const bf16x8 k0 = *(const LAS bf16x8*)(kbp + ks * 32);
                    const bf16x8 k1 = *(const LAS bf16x8*)(kbp + 32 * KSTR + ks * 32);
                    S0 = MFMA32(k0, Q[ks], S0); S1 = MFMA32(k1, Q[ks], S1);
                    if (ks & 1) __builtin_amdgcn_sched_barrier(0);
                }
                if (MODE == 0 || MODE == 2) {
                    const float base0 = (float)(tq - kt * 64 - 8 * hb), base1 = base0 - 32.0f;
#pragma unroll
                    for (int i = 0; i < 16; ++i) { const float off = (float)(16 * (i >> 3) + (i & 7));
                        S0[i] = S0[i] - slope2 * fabsf(base0 - off); S1[i] = S1[i] - slope2 * fabsf(base1 - off); }
                }
                if (MODE == 2) {
                    const unsigned long long W = MASK[(size_t)(b * SEQ + tq) * 32 + kt];
                    const unsigned w0 = (unsigned)W >> (8 * hb), w1 = (unsigned)(W >> 32) >> (8 * hb);
#pragma unroll
                    for (int i = 0; i < 16; ++i) { const int off = 16 * (i >> 3) + (i & 7);
                        S0[i] = ((w0 >> off) & 1u) ? S0[i] : NEG_INF_F; S1[i] = ((w1 >> off) & 1u) ? S1[i] : NEG_INF_F; }
                }
                if (MODE == 1) {
                    if (kt >= cq - 2) {
                        const int rel0 = tq - kt * 64 - 8 * hb + 128;
#pragma unroll
                        for (int i = 0; i < 16; ++i) { const int off = 16 * (i >> 3) + (i & 7);
                            int r0 = rel0 - off, r1 = rel0 - 32 - off;
                            r0 = r0 < 0 ? 0 : (r0 > 256 ? 256 : r0); r1 = r1 < 0 ? 0 : (r1 > 256 ? 256 : r1);
                            S0[i] += relb_l[r0]; S1[i] += relb_l[r1]; }
                    } else {
                        const float far = relb_l[256];
#pragma unroll
                        for (int i = 0; i < 16; ++i) { S0[i] += far; S1[i] += far; }
                    }
                }
                float mx = fmaxf(S0[0], S1[0]);
#pragma unroll
                for (int i = 1; i < 16; ++i) mx = fmaxf(mx, fmaxf(S0[i], S1[i]));
                mx = fmaxf(mx, shx(mx, 32, lane));
                const float mnew = fmaxf(mrun, mx);
                const float alpha = __builtin_amdgcn_exp2f(mrun - mnew);
                mrun = mnew;
                float ps = 0.f;
#pragma unroll
                for (int i = 0; i < 16; ++i) { S0[i] = __builtin_amdgcn_exp2f(S0[i] - mnew); S1[i] = __builtin_amdgcn_exp2f(S1[i] - mnew); ps += S0[i] + S1[i]; }
                lrun = lrun * alpha + ps;
#pragma unroll
                for (int eb = 0; eb < EB; ++eb) O[eb] = O[eb] * alpha;
                bf16x8 P[4];
                { u32x4 p;
                  p.x = pk_bf16(S0[0], S0[1]); p.y = pk_bf16(S0[2], S0[3]); p.z = pk_bf16(S0[4], S0[5]); p.w = pk_bf16(S0[6], S0[7]); P[0] = __builtin_bit_cast(bf16x8, p);
                  p.x = pk_bf16(S0[8], S0[9]); p.y = pk_bf16(S0[10], S0[11]); p.z = pk_bf16(S0[12], S0[13]); p.w = pk_bf16(S0[14], S0[15]); P[1] = __builtin_bit_cast(bf16x8, p);
                  p.x = pk_bf16(S1[0], S1[1]); p.y = pk_bf16(S1[2], S1[3]); p.z = pk_bf16(S1[4], S1[5]); p.w = pk_bf16(S1[6], S1[7]); P[2] = __builtin_bit_cast(bf16x8, p);
                  p.x = pk_bf16(S1[8], S1[9]); p.y = pk_bf16(S1[10], S1[11]); p.z = pk_bf16(S1[12], S1[13]); p.w = pk_bf16(S1[14], S1[15]); P[3] = __builtin_bit_cast(bf16x8, p); }
#pragma unroll
                for (int s4 = 0; s4 < 4; ++s4)
#pragma unroll
                    for (int eb = 0; eb < EB; ++eb) {
                        const bf16x8 vf = *(const LAS bf16x8*)(vbp + eb * 32 * 144 + s4 * 32);
                        O[eb] = MFMA32(vf, P[s4], O[eb]);
                        if (eb & 1) __builtin_amdgcn_sched_barrier(0);
                    }
            }
            if (kt > kt_lo) ATT_STORE(buf ^ 1);
            __syncthreads();
            buf ^= 1;
        }
#undef ATT_LOAD
#undef ATT_STORE
        const float inv = 1.0f / (lrun + shx(lrun, 32, lane));
        bf16_t* op = MIX + (size_t)(b * SEQ + tq) * 1024 + mixcol + 4 * hb;
        if (MODE == 0) {
            float* o1p = OA1 + (size_t)(b * SEQ + tq) * 512 + h * 128 + 4 * hb;
            if (mp == 0) {
#pragma unroll
                for (int eb = 0; eb < EB; ++eb)
#pragma unroll
                    for (int g = 0; g < 4; ++g) *(f32x4*)(o1p + eb * 32 + 8 * g) = (f32x4){O[eb][4 * g] * inv, O[eb][4 * g + 1] * inv, O[eb][4 * g + 2] * inv, O[eb][4 * g + 3] * inv};
            } else {
                const float c2 = lam * inv;
                float ss = 0.f;
#pragma unroll
                for (int eb = 0; eb < EB; ++eb)
#pragma unroll
                    for (int g = 0; g < 4; ++g) { const f32x4 o1 = *(const f32x4*)(o1p + eb * 32 + 8 * g);
#pragma unroll
                        for (int j = 0; j < 4; ++j) { const float o = o1[j] - O[eb][4 * g + j] * c2; O[eb][4 * g + j] = o; ss += o * o; } }
                ss += shx(ss, 32, lane);
                const float r = rsqrtf(ss * (1.0f / 128.0f) + EPS) * (1.0f - lam_init);
#pragma unroll
                for (int eb = 0; eb < EB; ++eb)
#pragma unroll
                    for (int g = 0; g < 4; ++g) { const int e0 = eb * 32 + 8 * g; const f32x4 sg = *(const f32x4*)(subg + e0 + 4 * hb);
                        *(u32x2*)(op + e0) = (u32x2){pk_bf16(O[eb][4 * g] * r * sg[0], O[eb][4 * g + 1] * r * sg[1]), pk_bf16(O[eb][4 * g + 2] * r * sg[2], O[eb][4 * g + 3] * r * sg[3])}; }
            }
        } else {
#pragma unroll
            for (int eb = 0; eb < EB; ++eb)
#pragma unroll
                for (int g = 0; g < 4; ++g) { const int e0 = eb * 32 + 8 * g;
                    *(u32x2*)(op + e0) = (u32x2){pk_bf16(O[eb][4 * g] * inv, O[eb][4 * g + 1] * inv), pk_bf16(O[eb][4 * g + 2] * inv, O[eb][4 * g + 3] * inv)}; }
        }
    }
}


constexpr int IDX_STR = 2052;
__device__ __forceinline__ unsigned f2key(float f) { const unsigned u = __float_as_uint(f); return u ^ (((unsigned)((int)u >> 31)) | 0x80000000u); }
template <int J>
__device__ __forceinline__ void index_select(const LAS float* row, const int nb, const int lane, unsigned long long* mo) {
    unsigned u[J];
#pragma unroll
    for (int j = 0; j < J; ++j) u[j] = (j < nb) ? f2key(row[64 * j]) : 0u;
    unsigned prefix = 0u;
#pragma unroll 1
    for (int bit = 31; bit >= 0; --bit) {
        const unsigned cand = prefix | (1u << bit);
        int c = 0;
#pragma unroll
        for (int j = 0; j < J; ++j) c += (int)__builtin_popcountll(__ballot(u[j] >= cand));
        if (c >= 256) prefix = cand;
        if (c == 256) break;
    }
    const unsigned thr = prefix;
    int cg = 0;
#pragma unroll
    for (int j = 0; j < J; ++j) cg += (int)__builtin_popcountll(__ballot(u[j] > thr));
    const int quota = 256 - cg;
    int taken = 0;
    unsigned long long myword = 0ull;
#pragma unroll
    for (int j = 0; j < J; ++j) {
        const bool eq = (u[j] == thr);
        const unsigned long long eqm = __ballot(eq);
        const int before = (int)__builtin_popcountll(eqm & ((1ull << lane) - 1ull));
        const unsigned long long m = __ballot((u[j] > thr) || (eq && (taken + before < quota)));
        taken += (int)__builtin_popcountll(eqm);
        myword = (lane == j) ? m : myword;
    }
    if (lane < 32) mo[lane] = myword;
}
__device__ __forceinline__ void index_unit(LAS unsigned char* lds, const bf16_t* HQ, unsigned long long* MASK, const int b, const int tt, const int wave) {
    int lane; asm volatile("v_mbcnt_lo_u32_b32 %0, -1, 0\n\tv_mbcnt_hi_u32_b32 %0, -1, %0" : "=&v"(lane));
    const int t0 = tt * 16, nb = (t0 >> 6) + 1, nk = nb * 64;
    if (nb <= 4) {
        for (int i = wave * 64 + lane; i < 16 * 32; i += 512) MASK[(size_t)(b * SEQ + t0 + (i >> 5)) * 32 + (i & 31)] = ((i & 31) < nb) ? ~0ull : 0ull;
        return;
    }
    LAS float* sc = (LAS float*)lds;
    const int q = lane & 15, g = lane >> 4;
    {
        const bf16_t* qrow = HQ + (size_t)(b * SEQ + t0 + q) * HQP;
        bf16x8 QI[8];
#pragma unroll
        for (int h = 0; h < 8; ++h) QI[h] = *(const bf16x8*)(qrow + HQ_QI + h * 32 + g * 8);
        float w[8];
        { const u32x4 wv = *(const u32x4*)(qrow + HQ_WI);
          w[0] = bf_lo(wv[0]) * 0.0625f; w[1] = bf_hi(wv[0]) * 0.0625f; w[2] = bf_lo(wv[1]) * 0.0625f; w[3] = bf_hi(wv[1]) * 0.0625f;
          w[4] = bf_lo(wv[2]) * 0.0625f; w[5] = bf_hi(wv[2]) * 0.0625f; w[6] = bf_lo(wv[3]) * 0.0625f; w[7] = bf_hi(wv[3]) * 0.0625f; }
        const bf16_t* kbase = HQ + (size_t)(b * SEQ + q) * HQP + HQ_KI + g * 8;
        for (int kb = wave; kb < nk / 16; kb += 8) {
            const bf16x8 kf = *(const bf16x8*)(kbase + (size_t)kb * 16 * HQP);
            f32x4 acc = {0.f, 0.f, 0.f, 0.f};
#pragma unroll
            for (int h = 0; h < 8; ++h) {
                const f32x4 z = __builtin_amdgcn_mfma_f32_16x16x32_f16(kf, QI[h], (f32x4){0.f, 0.f, 0.f, 0.f}, 0, 0, 0);
#pragma unroll
                for (int j = 0; j < 4; ++j) acc[j] = fmaf(w[h], fmaxf(z[j], 0.f), acc[j]);
            }
#pragma unroll
            for (int j = 0; j < 4; ++j) acc[j] += 0.0f;
            *(LAS f32x4*)(sc + q * IDX_STR + kb * 16 + g * 4) = acc;
        }
    }
    __syncthreads();
#pragma unroll 1
    for (int qq = 0; qq < 2; ++qq) {
        const int ql = wave * 2 + qq;
        const LAS float* row = sc + ql * IDX_STR + lane;
        unsigned long long* mo = MASK + (size_t)(b * SEQ + t0 + ql) * 32;
        if (nb <= 8) index_select<8>(row, nb, lane, mo);
        else if (nb <= 16) index_select<16>(row, nb, lane, mo);
        else if (nb <= 24) index_select<24>(row, nb, lane, mo);
        else index_select<32>(row, nb, lane, mo);
    }
    __syncthreads();
}

struct Args {
    const float* x; const float* w_in; const float* lam_q1; const float* lam_k1; const float* lam_q2; const float* lam_k2; const float* subln_g; const float* rel_bias;
    const float* w_out; const float* ln1_g; const float* ln1_b; const float* w_router; const float* b_router; const float* w_gu; const float* b_gu;
    const float* w_down; const float* b_down; const float* ln2_g; const float* ln2_b;
    float* out; unsigned char* ws;
    int ph_lo, ph_hi, bar_region, pad;
};

constexpr int LDS_STAGE = 0;
constexpr int LDS_CTL = 135168;
constexpr int LDS_TSTART = LDS_CTL + 64;
constexpr int LDS_CNT = LDS_TSTART + 36 * 4;
constexpr int LDS_TILEE = LDS_CNT + 32 * 4;
constexpr int LDS_RT = LDS_TILEE + 576;
constexpr int LDS_BYTES = 147456;
static_assert(LDS_RT + (64 + 1024) * 4 <= LDS_BYTES && 16 * IDX_STR * 4 <= LDS_CTL, "LDS map");

__device__ __forceinline__ void transpose_item(const float* W, int N, int k0, int n0, int nvalid, bf16_t* WTrow0, float scale, LAS float* scr, int lane) {
#pragma unroll 8
    for (int i = 0; i < 32; ++i) { const int kk = 2 * i + (lane >> 5), col = lane & 31; scr[kk * 33 + col] = (col < nvalid) ? W[(size_t)(k0 + kk) * N + n0 + col] * scale : 0.f; }
    asm volatile("s_waitcnt lgkmcnt(0)" ::: "memory");
    const int c = lane & 7;
#pragma unroll
    for (int j = 0; j < 4; ++j) { const int n = (lane >> 3) + 8 * j; const LAS float* s = scr + (8 * c) * 33 + n;
        u32x4 o; o.x = pk_bf16(s[0 * 33], s[1 * 33]); o.y = pk_bf16(s[2 * 33], s[3 * 33]); o.z = pk_bf16(s[4 * 33], s[5 * 33]); o.w = pk_bf16(s[6 * 33], s[7 * 33]);
        if (n < nvalid) *(u32x4*)(WTrow0 + (size_t)n * 1024 + k0 + 8 * c) = o; }
    asm volatile("s_waitcnt lgkmcnt(0)" ::: "memory");
}
__device__ __forceinline__ void in_map(int n0, bool& isv, int& row, float& scale) {
    scale = 1.f; isv = false;
    if (n0 < 512) { row = HQ_QA + n0; scale = QSCALE; }
    else if (n0 < 1024) row = HQ_KA + (n0 - 512);
    else if (n0 < 1536) { isv = true; row = VT_A + (n0 - 1024); }
    else if (n0 < 1792) { row = HQ_QB + (n0 - 1536); scale = QSCALE; }
    else if (n0 < 2048) row = HQ_KB + (n0 - 1792);
    else if (n0 < 2304) { isv = true; row = VT_B + (n0 - 2048); }
    else if (n0 < 2560) { row = HQ_QC + (n0 - 2304); scale = QSCALE; }
    else if (n0 < 2816) row = HQ_KC + (n0 - 2560);
    else if (n0 < 3072) { isv = true; row = VT_C + (n0 - 2816); }
    else if (n0 < 3328) row = HQ_QI + (n0 - 3072);
    else if (n0 < 3360) row = HQ_KI + (n0 - 3328);
    else row = HQ_WI + (n0 - 3360);
}

__global__ void __launch_bounds__(512, 2) mega(Args a) {
    extern __shared__ __attribute__((aligned(16))) unsigned char lds_raw[];
    LAS unsigned char* lds = (LAS unsigned char*)lds_raw;
    const int G = gridDim.x, bid = blockIdx.x, NGW = G * 8;
    const int wave = __builtin_amdgcn_readfirstlane((int)threadIdx.x >> 6);
#define OPAQUE_IDS() int lane; asm volatile("v_mbcnt_lo_u32_b32 %0, -1, 0\n\tv_mbcnt_hi_u32_b32 %0, -1, %0" : "=&v"(lane)); const int tid = wave * 64 + lane, gw = bid * 8 + wave; (void)tid; (void)gw
#define WSPTRS() unsigned char* ws = a.ws; asm volatile("" : "+s"(ws)); \
    unsigned* ctl = (unsigned*)(ws + WS_CTL); bf16_t* Win = (bf16_t*)(ws + WS_WIN); bf16_t* Wv = (bf16_t*)(ws + WS_WV); bf16_t* Wout = (bf16_t*)(ws + WS_WOUT); \
    bf16_t* Wgu = (bf16_t*)(ws + WS_WGU); bf16_t* Wdn = (bf16_t*)(ws + WS_WDN); bf16_t* XB = (bf16_t*)(ws + WS_XB); \
    bf16_t* HQ = (bf16_t*)(ws + WS_HQ); bf16_t* VT = (bf16_t*)(ws + WS_VT); bf16_t* MIX = (bf16_t*)(ws + WS_MIX); \
    bf16_t* Y1B = (bf16_t*)(ws + WS_Y1); bf16_t* X1B = (bf16_t*)(ws + WS_X1B); bf16_t* ACT = (bf16_t*)(ws + WS_ACT); bf16_t* YR = (bf16_t*)(ws + WS_YR); \
    int* TOKL = (int*)(ws + WS_TOKL); int* ASGE = (int*)(ws + WS_ASGE); int* ASGS = (int*)(ws + WS_ASGS); float* GATE = (float*)(ws + WS_GATE); \
    (void)ctl; (void)Win; (void)Wv; (void)Wout; (void)Wgu; (void)Wdn; (void)XB; (void)HQ; (void)VT; (void)MIX; (void)Y1B; (void)X1B; (void)ACT; (void)YR; (void)TOKL; (void)ASGE; (void)ASGS; (void)GATE
    for (int u = threadIdx.x; u < (LDS_BYTES - LDS_CTL) / 4; u += 512) ((LAS unsigned*)(lds + LDS_CTL))[u] = 0u;
    __syncthreads();
    XcdBarrier bar = xcd_barrier_post((unsigned*)(a.ws + WS_CTL) + CW_BAR + a.bar_region * XCD_BAR_WORDS, (volatile LAS unsigned*)(lds + LDS_CTL));
    const int lo = a.ph_lo, hi = a.ph_hi;
#define IN(k) (lo <= (k) && (k) < hi)
#define SEAM(k) do { if (IN(k) && IN((k) + 1)) xcd_barrier(bar); } while (0)

    if (IN(0)) PREP(0) {
        OPAQUE_IDS(); WSPTRS();
        LAS float* scr = (LAS float*)(lds + LDS_STAGE + wave * 16384);
        constexpr int I_IN = 16 * 106, I_OUT = 16 * 32, I_GU = 16 * 64, I_DN = 16 * 32;
        constexpr int N_IN = DEPTH * I_IN, N_OUT = DEPTH * I_OUT, N_GU = DEPTH * NE * I_GU, N_DN = DEPTH * NE * I_DN;
        for (int it = gw; it < N_IN + N_OUT + N_GU + N_DN; it += NGW) {
            int r = it;
            if (r < N_IN) { const int l = r / I_IN, q = r % I_IN, kb = q / 106, nb = q % 106, n0 = nb * 32; bool isv; int row; float sc; in_map(n0, isv, row, sc);
                bf16_t* dst = isv ? Wv + ((size_t)l * 1024 + row) * 1024 : Win + ((size_t)l * HQP + row) * 1024;
                transpose_item(a.w_in + (size_t)l * D * DIN, DIN, kb * 64, n0, (DIN - n0) < 32 ? (DIN - n0) : 32, dst, sc, scr, lane); continue; }
            r -= N_IN;
            if (r < N_OUT) { const int l = r / I_OUT, q = r % I_OUT, kb = q / 32, nb = q % 32;
                transpose_item(a.w_out + (size_t)l * 1024 * D, D, kb * 64, nb * 32, 32, Wout + ((size_t)l * D + nb * 32) * 1024, 1.f, scr, lane); continue; }
            r -= N_OUT;
            if (r < N_GU) { const int le = r / I_GU, q = r % I_GU, kb = q / 64, nb = q % 64, n0 = nb * 32;
                const int bj = n0 >> 10, rr = n0 & 1023, pn = rr >> 7, c = rr & 127, nrow = pn * 256 + bj * 128 + c;
                transpose_item(a.w_gu + (size_t)le * D * 2048, 2048, kb * 64, n0, 32, Wgu + ((size_t)le * 2048 + nrow) * 1024, 1.f, scr, lane); continue; }
            r -= N_GU;
            { const int le = r / I_DN, q = r % I_DN, kb = q / 32, nb = q % 32;
                transpose_item(a.w_down + (size_t)le * 1024 * D, D, kb * 64, nb * 32, 32, Wdn + ((size_t)le * D + nb * 32) * 1024, 1.f, scr, lane); }
        }
        for (int i = gw * 64 + lane; i < DEPTH * (HQP - HQ_USED) * 128; i += NGW * 64) { const int l = i / ((HQP - HQ_USED) * 128), q = i % ((HQP - HQ_USED) * 128);
            *(u32x4*)(Win + ((size_t)l * HQP + HQ_USED) * 1024 + (size_t)q * 8) = (u32x4){0u, 0u, 0u, 0u}; }
        { float* WRT = (float*)(ws + WS_WRT);
          for (int i = gw * 64 + lane; i < DEPTH * NE * D; i += NGW * 64) { const int ll = i / (NE * D), r = i % (NE * D), e = r / D, c = r % D; WRT[i] = a.w_router[((size_t)ll * D + c) * NE + e]; } }
        for (size_t i = (size_t)gw * 64 + lane; i < (size_t)T * D / 8; i += (size_t)NGW * 64) { const f32x4 v0 = *(const f32x4*)(a.x + i * 8), v1 = *(const f32x4*)(a.x + i * 8 + 4);
            u32x4 w; w.x = pk_bf16(v0[0], v0[1]); w.y = pk_bf16(v0[2], v0[3]); w.z = pk_bf16(v1[0], v1[1]); w.w = pk_bf16(v1[2], v1[3]); *(u32x4*)(XB + i * 8) = w; }
    }
    SEAM(0);

#pragma unroll 1
    for (int l = 0; l < DEPTH; ++l) {
        const int pb = 1 + 8 * l;
        if (IN(pb + 0)) PREP(1) {
            WSPTRS();
            { pg8::DenseOrder S{T / 256, HQP / 256, G, bid, (const char*)(Win + (size_t)l * HQP * 1024), 1024, false};
              pg8::EpiBf16Plain E{HQ, HQP};
              pg8::gemm_phase<pg8::EpiBf16Plain, pg8::DenseOrder, false>(lds + LDS_STAGE, XB, 1024, S, E, wave); }
            { pg8::DenseOrder S{1024 / 256, T / 256, G, bid, (const char*)XB, 1024, true};
              pg8::EpiBf16Plain E{VT, T};
              pg8::gemm_phase<pg8::EpiBf16Plain, pg8::DenseOrder, false>(lds + LDS_STAGE, Wv + (size_t)l * 1024 * 1024, 1024, S, E, wave); }
        }
        SEAM(pb + 0);
        if (IN(pb + 1)) {
            OPAQUE_IDS(); WSPTRS();
            unsigned long long* MASKp = (unsigned long long*)(ws + WS_MASK); float* OA1p = (float*)(ws + WS_OA1);
            const float lam_init = 0.8f - 0.6f * expf(-0.3f * (float)l);
            const float lam = expf(wsum(a.lam_q1[l * 64 + lane] * a.lam_k1[l * 64 + lane], lane)) - expf(wsum(a.lam_q2[l * 64 + lane] * a.lam_k2[l * 64 + lane], lane)) + lam_init;
            const int v0 = (G % 8 == 0) ? (bid & 7) * (G >> 3) + (bid >> 3) : bid;
            for (int v = v0; v < 256; v += G) {
                const int b = v >> 4, h = (v >> 2) & 3, q0 = v & 3, j16 = v & 15;
                PREP(2)
#pragma unroll 1
                for (int k = 0; k < 8; ++k) index_unit(lds + LDS_STAGE, HQ, MASKp, b, 16 * k + ((k & 1) ? 15 - j16 : j16), wave);
                PREP(3)
#pragma unroll 1
                for (int rep = 0; rep < 2; ++rep) attn_unit<0>(lds + LDS_STAGE, HQ, VT, MIX, MASKp, OA1p, b, h, rep ? 7 - q0 : q0, wave, lane, lam, lam_init, a.subln_g + l * 128, nullptr);
                PREP(4)
#pragma unroll 1
                for (int rep = 0; rep < 2; ++rep) attn_unit<1>(lds + LDS_STAGE, HQ, VT, MIX, MASKp, OA1p, b, h, rep ? 7 - q0 : q0, wave, lane, 0.f, 0.f, nullptr, a.rel_bias + ((size_t)l * 4 + h) * 257);
            }
        }
        SEAM(pb + 1);
        if (IN(pb + 2)) {
            OPAQUE_IDS(); WSPTRS();
            unsigned long long* MASKp = (unsigned long long*)(ws + WS_MASK); float* OA1p = (float*)(ws + WS_OA1);
            const int v0 = (G % 8 == 0) ? (bid & 7) * (G >> 3) + (bid >> 3) : bid;
            for (int v = v0; v < 256; v += G) {
                const int b = v >> 4, h = (v >> 2) & 3, q0 = v & 3;
                PREP(5)
#pragma unroll 1
                for (int rep = 0; rep < 2; ++rep) attn_unit<2>(lds + LDS_STAGE, HQ, VT, MIX, MASKp, OA1p, b, h, rep ? 7 - q0 : q0, wave, lane, 0.f, 0.f, nullptr, nullptr);
            }
        }
        SEAM(pb + 2);
        if (IN(pb + 3)) PREP(6) {
            WSPTRS();
            pg8::DenseOrder S{T / 256, 4, G, bid, (const char*)(Wout + (size_t)l * 1024 * 1024), 1024, false};
            pg8::EpiResBf16 E{Y1B, XB};
            pg8::gemm_phase<pg8::EpiResBf16, pg8::DenseOrder, false>(lds + LDS_STAGE, MIX, 1024, S, E, wave);
        }
        SEAM(pb + 3);
        if (IN(pb + 4)) {
            OPAQUE_IDS(); WSPTRS();
            LAS int* lcnt = (LAS int*)(lds + LDS_RT); LAS int* lbase = lcnt + 32; LAS int* asg_e = lcnt + 64; LAS int* asg_ls = asg_e + 512;
            const float* g1 = a.ln1_g + l * D; const float* b1 = a.ln1_b + l * D; const float* br = a.b_router + l * NE;
            unsigned* gcnt = ctl + CW_CNT + l * 64;
            LAS float* wT = (LAS float*)(lds + LDS_STAGE);
            { const f32x4* src = (const f32x4*)((const float*)(ws + WS_WRT) + (size_t)l * NE * D);
              for (int i = tid; i < NE * D / 4; i += 512) ((LAS f32x4*)wT)[i] = src[i]; }
            for (int unit = bid; unit < T / 128; unit += G) {
                if (tid < 32) lcnt[tid] = 0;
                __syncthreads();
#pragma unroll 1
                for (int k = 0; k < 8; ++k) {
                    asm volatile("" ::: "memory");
                    const int tl0 = wave * 16 + 2 * k, t0 = unit * 128 + tl0;
                    float v[2][16];
#pragma unroll
                    for (int tk = 0; tk < 2; ++tk)
#pragma unroll
                        for (int i = 0; i < 4; ++i) { const u32x2 u2 = *(const u32x2*)(Y1B + (size_t)(t0 + tk) * D + i * 256 + lane * 4); v[tk][4 * i] = bf_lo(u2[0]); v[tk][4 * i + 1] = bf_hi(u2[0]); v[tk][4 * i + 2] = bf_lo(u2[1]); v[tk][4 * i + 3] = bf_hi(u2[1]); }
#pragma unroll
                    for (int tk = 0; tk < 2; ++tk) {
                        float s = 0.f;
#pragma unroll
                        for (int i = 0; i < 16; ++i) s += v[tk][i];
                        const float mean = wsum(s, lane) * (1.0f / 1024.0f);
                        float qv = 0.f;
#pragma unroll
                        for (int i = 0; i < 16; ++i) { const float d = v[tk][i] - mean; qv += d * d; }
                        const float rstd = rsqrtf(wsum(qv, lane) * (1.0f / 1024.0f) + EPS);
#pragma unroll
                        for (int i = 0; i < 4; ++i) {
                            const int c0 = i * 256 + lane * 4;
                            const f32x4 gg = *(const f32x4*)(g1 + c0), bb = *(const f32x4*)(b1 + c0);
#pragma unroll
                            for (int j = 0; j < 4; ++j) v[tk][4 * i + j] = (v[tk][4 * i + j] - mean) * rstd * gg[j] + bb[j];
                            *(u32x2*)(X1B + (size_t)(t0 + tk) * D + c0) = (u32x2){pk_bf16(v[tk][4 * i], v[tk][4 * i + 1]), pk_bf16(v[tk][4 * i + 2], v[tk][4 * i + 3])};
                        }
                    }
                    f32x2 part2[32];
#pragma unroll
                    for (int e = 0; e < 32; ++e) part2[e] = (f32x2){0.f, 0.f};
#pragma unroll
                    for (int i = 0; i < 4; ++i) {
                        f32x2 xv[4];
#pragma unroll
                        for (int j = 0; j < 4; ++j) xv[j] = (f32x2){v[0][4 * i + j], v[1][4 * i + j]};
#pragma unroll
                        for (int e = 0; e < 32; ++e) { const f32x4 w4 = *(const LAS f32x4*)(wT + e * 1024 + i * 256 + lane * 4);
#pragma unroll
                            for (int j = 0; j < 4; ++j) part2[e] = __builtin_elementwise_fma(xv[j], (f32x2){w4[j], w4[j]}, part2[e]);
                            if ((e & 3) == 3) __builtin_amdgcn_sched_barrier(0); }
                    }
                    float part[2][32];
#pragma unroll
                    for (int e = 0; e < 32; ++e) { part[0][e] = part2[e][0]; part[1][e] = part2[e][1]; }
#pragma unroll
                    for (int tk = 0; tk < 2; ++tk) {
                        float p16[16], p8[8], p4[4], p2[2], lg;
                        { const bool hi = (lane & 32) != 0;
#pragma unroll
                          for (int i = 0; i < 16; ++i) { const float keep = hi ? part[tk][i + 16] : part[tk][i], send = hi ? part[tk][i] : part[tk][i + 16]; p16[i] = keep + shx(send, 32, lane); } }
                        { const bool hi = (lane & 16) != 0;
#pragma unroll
                          for (int i = 0; i < 8; ++i) { const float keep = hi ? p16[i + 8] : p16[i], send = hi ? p16[i] : p16[i + 8]; p8[i] = keep + shx(send, 16, lane); } }
                        { const bool hi = (lane & 8) != 0;
#pragma unroll
                          for (int i = 0; i < 4; ++i) { const float keep = hi ? p8[i + 4] : p8[i], send = hi ? p8[i] : p8[i + 4]; p4[i] = keep + shx(send, 8, lane); } }
                        { const bool hi = (lane & 4) != 0;
#pragma unroll
                          for (int i = 0; i < 2; ++i) { const float keep = hi ? p4[i + 2] : p4[i], send = hi ? p4[i] : p4[i + 2]; p2[i] = keep + shx(send, 4, lane); } }
                        { const bool hi = (lane & 2) != 0; const float keep = hi ? p2[1] : p2[0], send = hi ? p2[0] : p2[1]; lg = keep + shx(send, 2, lane); }
                        lg += shx(lg, 1, lane);
                        lg += br[lane >> 1];
                        int be[4]; float bv[4];
#pragma unroll
                        for (int kk = 0; kk < 4; ++kk) {
                            const float mx = wmax(lg, lane);
                            const unsigned long long bal = __ballot(lg == mx);
                            const int e = (__ffsll((long long)bal) - 1) >> 1;
                            be[kk] = e; bv[kk] = mx;
                            if ((lane >> 1) == e) lg = -3e38f;
                        }
                        float ex[4], es = 0.f;
#pragma unroll
                        for (int kk = 0; kk < 4; ++kk) { ex[kk] = __expf(bv[kk] - bv[0]); es += ex[kk]; }
                        if (lane == 0) {
                            const int tl = tl0 + tk, t = t0 + tk;
#pragma unroll
                            for (int kk = 0; kk < 4; ++kk) { const int sl = __hip_atomic_fetch_add(&lcnt[be[kk]], 1, __ATOMIC_RELAXED, __HIP_MEMORY_SCOPE_WORKGROUP); asg_e[tl * 4 + kk] = be[kk]; asg_ls[tl * 4 + kk] = sl; GATE[t * 4 + kk] = ex[kk] / es; }
                        }
                    }
                }
                __syncthreads();
                if (tid < 32) lbase[tid] = (int)__hip_atomic_fetch_add(gcnt + tid, (unsigned)lcnt[tid], __ATOMIC_RELAXED, __HIP_MEMORY_SCOPE_AGENT);
                __syncthreads();
                { const int e = asg_e[tid], sl = lbase[e] + asg_ls[tid], t = unit * 128 + (tid >> 2);
                  TOKL[(size_t)e * T + sl] = t; ASGE[t * 4 + (tid & 3)] = e; ASGS[t * 4 + (tid & 3)] = sl; }
                __syncthreads();
            }
        }
        SEAM(pb + 4);
        LAS int* tstart = (LAS int*)(lds + LDS_TSTART); LAS int* lcntE = (LAS int*)(lds + LDS_CNT); LAS unsigned char* tile_e = lds + LDS_TILEE;
        if (IN(pb + 5) || IN(pb + 6) || IN(pb + 7)) {
            OPAQUE_IDS(); WSPTRS();
            if (tid < 32) lcntE[tid] = (int)__hip_atomic_load(ctl + CW_CNT + l * 64 + tid, __ATOMIC_RELAXED, __HIP_MEMORY_SCOPE_AGENT);
            __syncthreads();
            if (tid == 0) { int acc = 0; for (int e = 0; e < NE; ++e) { tstart[e] = acc; acc += (lcntE[e] + 255) >> 8; } tstart[32] = acc; }
            __syncthreads();
            for (int q = tid; q < MAXRT; q += 512) { int e = 0; for (int k = 0; k < NE; ++k) if (q >= tstart[k]) e = k; tile_e[q] = (unsigned char)e; }
            __syncthreads();
        }
        pg8::MoeTables tb{tstart, lcntE, tile_e, tstart[32]};
        if (IN(pb + 5)) PREP(7) {
            WSPTRS();
            pg8::MoeOrder S{tb, 8, G, bid, (const char*)(Wgu + (size_t)l * NE * 2048 * 1024), (size_t)2048 * 1024 * 2, TOKL, true};
            pg8::EpiSwiglu E{ACT, a.b_gu + (size_t)l * NE * 2048};
            pg8::gemm_phase<pg8::EpiSwiglu, pg8::MoeOrder, true>(lds + LDS_STAGE, X1B, 1024, S, E, wave);
        }
        SEAM(pb + 5);
        if (IN(pb + 6)) PREP(8) {
            WSPTRS();
            pg8::MoeOrder S{tb, 4, G, bid, (const char*)(Wdn + (size_t)l * NE * 1024 * 1024), (size_t)1024 * 1024 * 2, TOKL, false};
            pg8::EpiBiasBf16 E{YR, a.b_down + (size_t)l * NE * 1024};
            pg8::gemm_phase<pg8::EpiBiasBf16, pg8::MoeOrder, false>(lds + LDS_STAGE, ACT, 1024, S, E, wave);
        }
        SEAM(pb + 6);
        if (IN(pb + 7)) PREP(9) {
            OPAQUE_IDS(); WSPTRS();
            const float* g2 = a.ln2_g + l * D; const float* b2 = a.ln2_b + l * D;
            for (int t = gw; t < T; t += NGW) {
                float v[16];
#pragma unroll
                for (int i = 0; i < 4; ++i) { const u32x2 u2 = *(const u32x2*)(X1B + (size_t)t * D + i * 256 + lane * 4);
                    v[4 * i] = ALPHA * bf_lo(u2[0]); v[4 * i + 1] = ALPHA * bf_hi(u2[0]); v[4 * i + 2] = ALPHA * bf_lo(u2[1]); v[4 * i + 3] = ALPHA * bf_hi(u2[1]); }
#pragma unroll
                for (int k = 0; k < 4; ++k) {
                    const int e = ASGE[t * 4 + k]; const float gk = GATE[t * 4 + k];
                    const bf16_t* yp = YR + ((size_t)tstart[e] * 256 + ASGS[t * 4 + k]) * 1024;
#pragma unroll
                    for (int i = 0; i < 4; ++i) { const u32x2 u2 = *(const u32x2*)(yp + i * 256 + lane * 4);
                        v[4 * i] += gk * bf_lo(u2[0]); v[4 * i + 1] += gk * bf_hi(u2[0]); v[4 * i + 2] += gk * bf_lo(u2[1]); v[4 * i + 3] += gk * bf_hi(u2[1]); }
                }
                float s = 0.f;
#pragma unroll
                for (int i = 0; i < 16; ++i) s += v[i];
                const float mean = wsum(s, lane) * (1.0f / 1024.0f);
                float qv = 0.f;
#pragma unroll
                for (int i = 0; i < 16; ++i) { const float d = v[i] - mean; qv += d * d; }
                const float rstd = rsqrtf(wsum(qv, lane) * (1.0f / 1024.0f) + EPS);
#pragma unroll
                for (int i = 0; i < 4; ++i) {
                    const int c0 = i * 256 + lane * 4;
                    const f32x4 gg = *(const f32x4*)(g2 + c0), bb = *(const f32x4*)(b2 + c0);
                    float o[4];
#pragma unroll
                    for (int j = 0; j < 4; ++j) o[j] = (v[4 * i + j] - mean) * rstd * gg[j] + bb[j];
                    if (l == DEPTH - 1) *(f32x4*)(a.out + (size_t)t * D + c0) = (f32x4){o[0], o[1], o[2], o[3]};
                    else *(u32x2*)(XB + (size_t)t * D + c0) = (u32x2){pk_bf16(o[0], o[1]), pk_bf16(o[2], o[3])};
                }
            }
        }
        if (l + 1 < DEPTH) SEAM(pb + 7);
    }
#undef IN
#undef SEAM
}

extern "C" void kernel_launch(void* const* d_in, const int* in_sizes, int n_in, void* d_out, int out_size, void* d_ws, size_t ws_size, hipStream_t stream) {
    static int grid = 0;
    if (grid == 0) {
        if (ws_size < WS_END) { fprintf(stderr, "kernel_launch: workspace too small (%zu < %zu)\n", ws_size, (size_t)WS_END); grid = -1; return; }
        int dev = 0, cus = 0, per_cu = 0;
        if (hipGetDevice(&dev) != hipSuccess || hipDeviceGetAttribute(&cus, hipDeviceAttributeMultiprocessorCount, dev) != hipSuccess) { grid = -1; return; }
        if (hipFuncSetAttribute((const void*)mega, hipFuncAttributeMaxDynamicSharedMemorySize, LDS_BYTES) != hipSuccess) { fprintf(stderr, "kernel_launch: hipFuncSetAttribute failed\n"); grid = -1; return; }
        if (hipOccupancyMaxActiveBlocksPerMultiprocessor(&per_cu, (const void*)mega, 512, LDS_BYTES) != hipSuccess || per_cu < 1) { fprintf(stderr, "kernel_launch: occupancy query says %d\n", per_cu); }
        (void)hipGetLastError();
        grid = cus;
        if (grid % 8 != 0) grid -= grid % 8;
    }
    if (grid < 0) return;
    (void)hipMemsetAsync((char*)d_ws + WS_CTL, 0, CTL_BYTES, stream);
    Args a{};
    a.x = (const float*)d_in[0]; a.w_in = (const float*)d_in[1]; a.lam_q1 = (const float*)d_in[2]; a.lam_k1 = (const float*)d_in[3]; a.lam_q2 = (const float*)d_in[4]; a.lam_k2 = (const float*)d_in[5];
    a.subln_g = (const float*)d_in[6]; a.rel_bias = (const float*)d_in[7]; a.w_out = (const float*)d_in[8]; a.ln1_g = (const float*)d_in[9]; a.ln1_b = (const float*)d_in[10];
    a.w_router = (const float*)d_in[11]; a.b_router = (const float*)d_in[12]; a.w_gu = (const float*)d_in[13]; a.b_gu = (const float*)d_in[14]; a.w_down = (const float*)d_in[15];
    a.b_down = (const float*)d_in[16]; a.ln2_g = (const float*)d_in[17]; a.ln2_b = (const float*)d_in[18];
    a.out = (float*)d_out; a.ws = (unsigned char*)d_ws; a.pad = 0;
    a.ph_lo = 0; a.ph_hi = 1 + 8 * DEPTH; a.bar_region = 0;
    hipLaunchKernelGGL(mega, dim3(grid), dim3(512), LDS_BYTES, stream, a);
}
```

```cpp
#include <hip/hip_runtime.h>
#include <stdint.h>
#include <cstdio>

#define LAS __attribute__((address_space(3)))
typedef unsigned short bf16_t;
typedef _Float16 bf16x8 __attribute__((ext_vector_type(8)));
typedef float f32x4 __attribute__((ext_vector_type(4)));
typedef float f32x2 __attribute__((ext_vector_type(2)));
typedef unsigned u32x4 __attribute__((ext_vector_type(4)));
typedef unsigned u32x2 __attribute__((ext_vector_type(2)));
typedef _Float16 bf16v2 __attribute__((ext_vector_type(2)));

constexpr int D = 1024, BATCH = 16, SEQ = 2048, T = BATCH * SEQ, DEPTH = 4;
constexpr int DIN = 3368;
constexpr int NE = 32;
constexpr float ALPHA = 1.681792830507429f;
constexpr float EPS = 1e-5f;
constexpr float LOG2E = 1.4426950408889634f;
constexpr float QSCALE = 0.125f * LOG2E;
constexpr int HQP = 2560;
constexpr int HQ_QA = 0, HQ_KA = 512, HQ_QB = 1024, HQ_KB = 1280, HQ_QC = 1536, HQ_KC = 1792, HQ_QI = 2048, HQ_KI = 2304, HQ_WI = 2336, HQ_USED = 2344;
constexpr int VT_A = 0, VT_B = 512, VT_C = 768;
constexpr int NASG = T * 4;
constexpr int GROWS = NASG + NE * 256;
constexpr int MAXRT = GROWS / 256;

constexpr size_t MiB = (size_t)1 << 20;
constexpr size_t al(size_t x) { return (x + 255) & ~(size_t)255; }
constexpr size_t WS_CTL = 0, CTL_BYTES = 4 * MiB;
constexpr size_t WS_WIN = WS_CTL + CTL_BYTES;
constexpr size_t WS_WV = WS_WIN + al((size_t)DEPTH * HQP * D * 2);
constexpr size_t WS_WOUT = WS_WV + al((size_t)DEPTH * 1024 * D * 2);
constexpr size_t WS_WGU = WS_WOUT + al((size_t)DEPTH * D * 1024 * 2);
constexpr size_t WS_WDN = WS_WGU + al((size_t)DEPTH * NE * 2048 * D * 2);
constexpr size_t WS_XB = WS_WDN + al((size_t)DEPTH * NE * D * 1024 * 2);
constexpr size_t WS_HQ = WS_XB + al((size_t)T * D * 2);
constexpr size_t WS_VT = WS_HQ + al((size_t)T * HQP * 2);
constexpr size_t WS_MIX = WS_VT + al((size_t)1024 * T * 2);
constexpr size_t WS_Y1 = WS_MIX + al((size_t)T * 1024 * 2);
constexpr size_t WS_X1B = WS_Y1 + al((size_t)T * D * 2);
constexpr size_t WS_ACT = WS_X1B + al((size_t)T * D * 2);
constexpr size_t WS_YR = WS_ACT + al((size_t)GROWS * 1024 * 2);
constexpr size_t WS_MASK = WS_YR + al((size_t)GROWS * 1024 * 2);
constexpr size_t WS_TOKL = WS_MASK + al((size_t)T * 32 * 8);
constexpr size_t WS_ASGE = WS_TOKL + al((size_t)NE * T * 4);
constexpr size_t WS_ASGS = WS_ASGE + al((size_t)NASG * 4);
constexpr size_t WS_GATE = WS_ASGS + al((size_t)NASG * 4);
constexpr size_t WS_OA1 = WS_GATE + al((size_t)NASG * 4);
constexpr size_t WS_WRT = WS_OA1 + al((size_t)T * 512 * 4);
constexpr size_t WS_X1Q = WS_WRT + al((size_t)DEPTH * NE * D * 4);
constexpr size_t WS_END = WS_X1Q + al((size_t)T * D);
constexpr int CW_BAR = 4096;
constexpr int CW_CNT = 262144;

#ifndef MOE_FP8
#define MOE_FP8 1
#endif
constexpr float W8_SCALE = 512.0f;
constexpr float X8_SCALE = 16.0f;
constexpr float A8_SCALE = 4.0f;
typedef int i32x8 __attribute__((ext_vector_type(8)));
__device__ __forceinline__ unsigned pk_bf16(float lo, float hi) { f32x2 v = {lo, hi}; return __builtin_bit_cast(unsigned, __builtin_convertvector(v, bf16v2)); }
__device__ __forceinline__ float clamp8(float x) { return __builtin_fminf(__builtin_fmaxf(x, -448.0f), 448.0f); }
__device__ __forceinline__ unsigned pk4_fp8(float a, float b, float c, float d) {
    int w = 0; w = __builtin_amdgcn_cvt_pk_fp8_f32(clamp8(a), clamp8(b), w, false); w = __builtin_amdgcn_cvt_pk_fp8_f32(clamp8(c), clamp8(d), w, true); return (unsigned)w; }
__device__ __forceinline__ float bf_lo(unsigned u) { return (float)__builtin_bit_cast(bf16v2, u)[0]; }
__device__ __forceinline__ float bf_hi(unsigned u) { return (float)__builtin_bit_cast(bf16v2, u)[1]; }
__device__ __forceinline__ float bf2f(bf16_t b) { return (float)__builtin_bit_cast(bf16v2, (unsigned)b)[0]; }
__device__ __forceinline__ float wave_sum(float v) {
#pragma unroll
    for (int o = 32; o > 0; o >>= 1) v += __shfl_xor(v, o);
    return v; }
__device__ __forceinline__ float wave_max(float v) {
#pragma unroll
    for (int o = 32; o > 0; o >>= 1) v = fmaxf(v, __shfl_xor(v, o));
    return v; }
__device__ __forceinline__ int wave_sum_i(int v) {
#pragma unroll
    for (int o = 32; o > 0; o >>= 1) v += __shfl_xor(v, o);
    return v; }

__device__ __forceinline__ float shx(float v, int o, int lane) { return __int_as_float(__builtin_amdgcn_ds_bpermute((lane ^ o) << 2, __float_as_int(v))); }
__device__ __forceinline__ float wsum(float v, int lane) {
#pragma unroll
    for (int o = 32; o > 0; o >>= 1) v += shx(v, o, lane);
    return v; }
__device__ __forceinline__ float wmax(float v, int lane) {
#pragma unroll
    for (int o = 32; o > 0; o >>= 1) v = fmaxf(v, shx(v, o, lane));
    return v; }

#define XB_TMO      128
#define XB_XCNT(j)  (256  + 64 * (j))
#define XB_XSUB(j)  (1280 + 64 * (j))
#define XB_XGEN(j)  (2304 + 64 * (j))
#define XB_TOP      3328
#define XB_TOPGEN   3392
#define XCD_BAR_WORDS 3456
#define XB_SPIN_CAP (1u << 22)
__device__ __forceinline__ unsigned xb_ld(unsigned* p)              { return __hip_atomic_load(p, __ATOMIC_RELAXED, __HIP_MEMORY_SCOPE_AGENT); }
__device__ __forceinline__ unsigned xb_add(unsigned* p, unsigned v) { return __hip_atomic_fetch_add(p, v, __ATOMIC_RELAXED, __HIP_MEMORY_SCOPE_AGENT); }
__device__ __forceinline__ unsigned xb_xcc_id() { return (unsigned)__builtin_amdgcn_s_getreg((3 << 11) | 20) & 0xFu; }
#define XB_SPIN(cond, bar) do { unsigned _sp = 0; while (cond) { __builtin_amdgcn_s_sleep(1); \
    if ((++_sp & 255u) == 0u) { if (xb_ld(&(bar)[XB_TMO])) break; if (_sp > XB_SPIN_CAP) { atomicAdd(&(bar)[XB_TMO], 1u); break; } } } } while (0)
struct XcdBarrier { unsigned* bar; unsigned x; volatile LAS unsigned* st; };
__device__ __forceinline__ XcdBarrier xcd_barrier_post(unsigned* bar, volatile LAS unsigned* st) {
    XcdBarrier b; b.bar = bar; b.x = xb_xcc_id(); b.st = st;
    if (threadIdx.x == 0) (void)xb_add(&bar[XB_XCNT(b.x)], 1u);
    return b;
}
__device__ __forceinline__ void xcd_barrier_complete(unsigned* bar, unsigned x, unsigned& nloc, unsigned& nx) {
    const unsigned G = gridDim.x * gridDim.y * gridDim.z;
    unsigned sum, cnt, mine, sp = 0u;
    for (;;) {
        sum = 0u; cnt = 0u; mine = 0u;
#pragma unroll
        for (unsigned j = 0; j < 16; ++j) { const unsigned c = xb_ld(&bar[XB_XCNT(j)]); sum += c; cnt += (c > 0u) ? 1u : 0u; mine = (j == x) ? c : mine; }
        if (sum == G) break;
        __builtin_amdgcn_s_sleep(1);
        if ((++sp & 255u) == 0u) { if (xb_ld(&bar[XB_TMO])) break; if (sp > XB_SPIN_CAP) { atomicAdd(&bar[XB_TMO], 1u); break; } }
    }
    nloc = mine > 0u ? mine : 1u; nx = cnt > 0u ? cnt : 1u;
}
__device__ __forceinline__ void xcd_barrier(const XcdBarrier& b) {
    asm volatile("s_waitcnt vmcnt(0)" ::: "memory");
    __syncthreads();
    if (threadIdx.x == 0) {
        unsigned* bar = b.bar;
        __builtin_amdgcn_s_waitcnt(0);
        unsigned nloc = b.st[0], nx = b.st[1];
        if (nloc == 0u) { xcd_barrier_complete(bar, b.x, nloc, nx); b.st[0] = nloc; b.st[1] = nx; }
        const unsigned old = xb_add(&bar[XB_XSUB(b.x)], 1u);
        const unsigned gen = old / nloc;
        if (old + 1u == (gen + 1u) * nloc) {
            __builtin_amdgcn_fence(__ATOMIC_RELEASE, "agent");
            asm volatile("s_waitcnt vmcnt(0)" ::: "memory");
            const unsigned og = xb_add(&bar[XB_TOP], 1u);
            const unsigned tg = og / nx;
            if (og + 1u == (tg + 1u) * nx) xb_add(&bar[XB_TOPGEN], 1u);
            else XB_SPIN(xb_ld(&bar[XB_TOPGEN]) == tg, bar);
            __builtin_amdgcn_fence(__ATOMIC_ACQUIRE, "agent");
            xb_add(&bar[XB_XGEN(b.x)], 1u);
            asm volatile("s_waitcnt vmcnt(0)" ::: "memory");
        } else {
            XB_SPIN(xb_ld(&bar[XB_XGEN(b.x)]) == gen, bar);
            __builtin_amdgcn_fence(__ATOMIC_ACQUIRE, "agent");
            asm volatile("s_waitcnt vmcnt(0)" ::: "memory");
        }
    }
    __syncthreads();
}

namespace pg8 {
constexpr int BM = 256, BK = 64, HALF = 128, HTB = HALF * BK * 2, STAGE_BYTES = 8 * HTB;
__host__ __device__ __forceinline__ int lds_byte(int r, int c) { const int st = (r >> 4) * 2 + (c >> 5), rr = r & 15, cc = c & 31, ob = rr * 64 + cc * 2; return st * 1024 + (ob ^ (((ob >> 9) & 1) << 5)); }
__host__ __device__ __forceinline__ void stage_rc(int b, int& R, int& C) { const int st = b / 1024, sb = b % 1024, swz = sb ^ (((sb >> 9) & 1) << 5); R = (st >> 1) * 16 + swz / 64; C = (st & 1) * 32 + (swz % 64) / 2; }
__host__ __device__ __forceinline__ int perm32(int rho) { const int n = rho >> 4, i = rho & 15; return 8 * (i >> 2) + 4 * n + (i & 3); }

struct Unit {
    int row0;
    int col0;
    const char* Bt;
    const int* rows;
    int nvalid;
    int e;
};

template <class Epi, class Sched, bool GATHER, int ESZ = 2>
__device__ __forceinline__ void gemm_phase(LAS unsigned char* lds, const bf16_t* Abase, const int K, const Sched& S, const Epi& E, const int wid) {
    int lane; asm volatile("v_mbcnt_lo_u32_b32 %0, -1, 0\n\tv_mbcnt_hi_u32_b32 %0, -1, %0" : "=&v"(lane));
    const int tid = wid * 64 + lane, wr = wid >> 2, wc = wid & 3, fr = lane & 15, fq = lane >> 4;
    const int nt = K * ESZ / 128;
    unsigned voffB[2];
#pragma unroll
    for (int i = 0; i < 2; ++i) { int R, C; stage_rc(tid * 16 + i * 8192, R, C); const int Rb = Epi::PERM ? ((R & ~31) + perm32(R & 31)) : R; voffB[i] = (unsigned)(Rb * K * ESZ + C * 2); }
    const size_t kstep = (size_t)(BK * 2);
    const size_t hstep = (size_t)HALF * K * ESZ;
    const unsigned ldsw = (unsigned)wid * 1024u;
    const int aoff = lds_byte(wr * 64 + fr, fq * 8), boff = lds_byte(wc * 32 + fr, fq * 8);
#define PG8_SA(b, h) (((b) * 2 + (h)) * HTB)
#define PG8_SB(b, h) ((4 + (b) * 2 + (h)) * HTB)
#define PG8_STAGE(bufoff, gbase, voff) do { _Pragma("unroll") for (int _i = 0; _i < 2; ++_i) \
        __builtin_amdgcn_global_load_lds((const unsigned*)((const char*)(gbase) + (voff)[_i]), (LAS unsigned*)(lds + (bufoff) + ldsw + _i * 8192), 16, 0, 0); } while (0)
#define PG8_LDA(dst, b, h) do { _Pragma("unroll") for (int m = 0; m < 4; ++m) _Pragma("unroll") for (int k = 0; k < 2; ++k) dst[m][k] = *(const LAS bf16x8*)(lds + PG8_SA(b, h) + aoff + m * 2048 + k * 1024); } while (0)
#define PG8_LDB(dst, b, h) do { _Pragma("unroll") for (int n = 0; n < 2; ++n) _Pragma("unroll") for (int k = 0; k < 2; ++k) dst[n][k] = *(const LAS bf16x8*)(lds + PG8_SB(b, h) + boff + n * 2048 + k * 1024); } while (0)
#define PG8_MMA(ai, bj, At, Bt) do { __builtin_amdgcn_s_setprio(1); _Pragma("unroll") for (int m = 0; m < 4; ++m) _Pragma("unroll") for (int n = 0; n < 2; ++n) { \
        if constexpr (ESZ == 2) { _Pragma("unroll") for (int k = 0; k < 2; ++k) acc[ai][bj][m][n] = __builtin_amdgcn_mfma_f32_16x16x32_f16(Bt[n][k], At[m][k], acc[ai][bj][m][n], 0, 0, 0); } \
        else {   \
            const u32x4 _a0 = __builtin_bit_cast(u32x4, At[m][0]), _a1 = __builtin_bit_cast(u32x4, At[m][1]), _b0 = __builtin_bit_cast(u32x4, Bt[n][0]), _b1 = __builtin_bit_cast(u32x4, Bt[n][1]); \
            const i32x8 _af = {(int)_a0[0], (int)_a0[1], (int)_a0[2], (int)_a0[3], (int)_a1[0], (int)_a1[1], (int)_a1[2], (int)_a1[3]}; \
            const i32x8 _bf = {(int)_b0[0], (int)_b0[1], (int)_b0[2], (int)_b0[3], (int)_b1[0], (int)_b1[1], (int)_b1[2], (int)_b1[3]}; \
              \
            asm volatile("v_mfma_scale_f32_16x16x128_f8f6f4 %0, %1, %2, %0, %3, %3 op_sel_hi:[0,0,0]" : "+v"(acc[ai][bj][m][n]) : "v"(_bf), "v"(_af), "v"(s8)); } } \
        __builtin_amdgcn_s_setprio(0); } while (0)
#define PG8_WAIT_V(n) asm volatile("s_waitcnt vmcnt(" #n ")" ::: "memory")
#define PG8_WAIT_L(n) asm volatile("s_waitcnt lgkmcnt(" #n ")" ::: "memory")
#define PG8_BAR __builtin_amdgcn_s_barrier()
#define PG8_SCHED __builtin_amdgcn_sched_barrier(0)
#define PG8_AOFFS(dst, u) do { _Pragma("unroll") for (int _h = 0; _h < 2; ++_h) _Pragma("unroll") for (int _i = 0; _i < 2; ++_i) { int _R, _C; stage_rc(tid * 16 + _i * 8192, _R, _C); \
        const int _r = _h * HALF + _R; const int _src = (_r < (u).nvalid) ? (u).rows[_r] : 0; dst[_h][_i] = (unsigned)(_src * K * ESZ + _C * 2); } } while (0)
#define PG8_STAGE_A(bufoff, h, ktb, usenext) do { if constexpr (GATHER) { const unsigned _o[2] = {(usenext) ? na[h][0] : oa[h][0], (usenext) ? na[h][1] : oa[h][1]}; PG8_STAGE(bufoff, cA + (ktb), _o); } \
        else { PG8_STAGE(bufoff, ((usenext) ? nA : cA) + (size_t)(h) * hstep + (ktb), voffA); } } while (0)
    Unit cur, nxt; int ui = 0;
    if (!S.next(0, cur)) return;
    f32x4 acc[2][2][4][2];
#pragma unroll
    for (int a = 0; a < 2; ++a)
#pragma unroll
        for (int b = 0; b < 2; ++b)
#pragma unroll
            for (int m = 0; m < 4; ++m)
#pragma unroll
                for (int n = 0; n < 2; ++n) acc[a][b][m][n] = (f32x4){0.f, 0.f, 0.f, 0.f};
    bf16x8 At[4][2], B0[2][2], B1[2][2];
    int s8 = 0x7F7F7F7F; asm volatile("" : "+v"(s8));
    unsigned oa[2][2], na[2][2], voffA[2];
    const char* cA; const char* nA; const char* cB = cur.Bt;
    if constexpr (GATHER) { PG8_AOFFS(oa, cur); cA = (const char*)Abase; nA = cA; voffA[0] = voffA[1] = 0u; }
    else { cA = (const char*)Abase + (size_t)cur.row0 * K * ESZ; nA = cA;
#pragma unroll
        for (int i = 0; i < 2; ++i) { int R, C; stage_rc(tid * 16 + i * 8192, R, C); voffA[i] = (unsigned)(R * K * ESZ + C * 2); oa[0][i] = oa[1][i] = na[0][i] = na[1][i] = 0u; } }
    PG8_STAGE(PG8_SB(0, 0), cB, voffB); PG8_STAGE(PG8_SB(0, 1), cB + hstep, voffB); PG8_STAGE_A(PG8_SA(0, 0), 0, 0, false); PG8_STAGE_A(PG8_SA(0, 1), 1, 0, false);
    if (wr == 1) PG8_BAR;
    PG8_WAIT_V(2); PG8_BAR;
    PG8_STAGE(PG8_SB(1, 0), cB + kstep, voffB); PG8_STAGE_A(PG8_SA(1, 0), 0, kstep, false); PG8_STAGE(PG8_SB(1, 1), cB + hstep + kstep, voffB);
    PG8_WAIT_V(6); PG8_BAR;
    for (;;) {
        const bool has_next = S.next(ui + 1, nxt);
        if constexpr (GATHER) {
            if (has_next) { PG8_AOFFS(na, nxt); asm volatile("" : "+v"(na[0][0]), "+v"(na[0][1]), "+v"(na[1][0]), "+v"(na[1][1])); }
            else {
#pragma unroll
                for (int h = 0; h < 2; ++h)
#pragma unroll
                    for (int i = 0; i < 2; ++i) na[h][i] = oa[h][i];
            }
        } else nA = has_next ? (const char*)Abase + (size_t)nxt.row0 * K * ESZ : cA;
        const char* nB = has_next ? nxt.Bt : cB;
#pragma unroll 1
        for (int t = 0; t < nt; t += 2) {
            const bool last = (t == nt - 2);
            const size_t k1 = (size_t)(t + 1) * kstep, k2 = last ? 0 : (size_t)(t + 2) * kstep, k3 = k2 + kstep;
            const char* b2 = last ? nB : cB + (size_t)(t + 2) * kstep; const char* b3 = b2 + kstep;
            PG8_LDB(B0, 0, 0); PG8_LDB(B1, 0, 1); PG8_SCHED; PG8_LDA(At, 0, 0); PG8_STAGE_A(PG8_SA(1, 1), 1, k1, false);
            PG8_WAIT_V(8); PG8_WAIT_L(0); PG8_BAR; PG8_MMA(0, 0, At, B0); PG8_MMA(0, 1, At, B1); PG8_BAR; PG8_SCHED;
            PG8_LDA(At, 0, 1); PG8_STAGE(PG8_SB(0, 0), b2, voffB); PG8_STAGE(PG8_SB(0, 1), b2 + hstep, voffB); PG8_STAGE_A(PG8_SA(0, 0), 0, k2, last);
            PG8_WAIT_V(8); PG8_WAIT_L(0); PG8_BAR; PG8_MMA(1, 0, At, B0); PG8_MMA(1, 1, At, B1); PG8_BAR; PG8_SCHED;
            PG8_LDB(B0, 1, 0); PG8_LDB(B1, 1, 1); PG8_SCHED; PG8_LDA(At, 1, 0); PG8_STAGE_A(PG8_SA(0, 1), 1, k2, last);
            PG8_WAIT_V(8); PG8_WAIT_L(0); PG8_BAR; PG8_MMA(0, 0, At, B0); PG8_MMA(0, 1, At, B1); PG8_BAR; PG8_SCHED;
            PG8_LDA(At, 1, 1); PG8_STAGE(PG8_SB(1, 0), b3, voffB); PG8_STAGE(PG8_SB(1, 1), b3 + hstep, voffB); PG8_STAGE_A(PG8_SA(1, 0), 0, k3, last);
            PG8_WAIT_V(8); PG8_WAIT_L(0); PG8_BAR; PG8_MMA(1, 0, At, B0); PG8_MMA(1, 1, At, B1); PG8_BAR; PG8_SCHED;
        }
        if constexpr (ESZ == 1) asm volatile("s_nop 15\n\ts_nop 15" ::: "memory");
        if (wr == 0) PG8_BAR;
        E(acc, cur, wr, wc, fr, fq);
        if (!has_next) break;
#pragma unroll
        for (int a = 0; a < 2; ++a)
#pragma unroll
            for (int b = 0; b < 2; ++b)
#pragma unroll
                for (int m = 0; m < 4; ++m)
#pragma unroll
                    for (int n = 0; n < 2; ++n) acc[a][b][m][n] = (f32x4){0.f, 0.f, 0.f, 0.f};
        cur = nxt; cB = nB; ++ui;
        if constexpr (GATHER) {
#pragma unroll
            for (int h = 0; h < 2; ++h)
#pragma unroll
                for (int i = 0; i < 2; ++i) oa[h][i] = na[h][i];
        } else cA = nA;
        if (wr == 1) PG8_BAR;
    }
    PG8_WAIT_V(0);
    PG8_BAR;
#undef PG8_SA
#undef PG8_SB
#undef PG8_STAGE
#undef PG8_LDA
#undef PG8_LDB
#undef PG8_MMA
#undef PG8_WAIT_V
#undef PG8_WAIT_L
#undef PG8_BAR
#undef PG8_SCHED
#undef PG8_AOFFS
#undef PG8_STAGE_A
}

struct DenseOrder {
    int nRT, nN, G, c; const char* Bt; int K; bool swap;
    __device__ __forceinline__ bool next(int i, Unit& u) const {
        const int xcd = c & 7, s = i * (G >> 3) + (c >> 3);
        int rt, pn;
        if (!swap) { rt = 8 * (s / nN) + xcd; pn = s % nN; } else { pn = 8 * (s / nRT) + xcd; rt = s % nRT; }
        if (rt >= nRT || pn >= nN) return false;
        u.row0 = rt * BM; u.col0 = pn * BM; u.Bt = Bt + (size_t)pn * BM * K * 2; u.rows = nullptr; u.nvalid = 0; u.e = 0; return true;
    }
};
struct MoeTables { LAS const int* tstart; LAS const int* cnt; LAS const unsigned char* tile_e; int nrt; };
struct MoeOrder {
    MoeTables tb; int nN, G, c; const char* Bt; size_t strideB; const int* tokl; bool gather; int rowb;
    __device__ __forceinline__ bool next(int i, Unit& u) const {
        const int xcd = c & 7, s = i * (G >> 3) + (c >> 3);
        const int q = 8 * (s / nN) + xcd, pn = s % nN;
        if (q >= tb.nrt) return false;
        const int e = tb.tile_e[q]; const int lt = q - tb.tstart[e];
        u.row0 = q * BM; u.col0 = pn * BM; u.e = e; u.Bt = Bt + (size_t)e * strideB + (size_t)pn * BM * rowb;
        u.rows = gather ? tokl + (size_t)e * T + lt * BM : nullptr; u.nvalid = tb.cnt[e] - lt * BM; return true;
    }
};

struct EpiBf16Plain {
    static constexpr bool PERM = true;
    bf16_t* O; int ldc;
    __device__ __forceinline__ void operator()(const f32x4 (&acc)[2][2][4][2], const Unit& u, int wr, int wc, int fr, int fq) const {
        const int row0 = u.row0 + wr * 64 + fr, col0 = u.col0 + wc * 32 + 8 * fq;
#pragma unroll
        for (int ai = 0; ai < 2; ++ai)
#pragma unroll
            for (int m = 0; m < 4; ++m) { bf16_t* rowp = O + (size_t)(row0 + ai * HALF + m * 16) * ldc + col0;
#pragma unroll
                for (int bj = 0; bj < 2; ++bj) { const f32x4 v0 = acc[ai][bj][m][0], v1 = acc[ai][bj][m][1];
                    u32x4 w; w.x = pk_bf16(v0[0], v0[1]); w.y = pk_bf16(v0[2], v0[3]); w.z = pk_bf16(v1[0], v1[1]); w.w = pk_bf16(v1[2], v1[3]);
                    *(u32x4*)(rowp + bj * HALF) = w; } }
    }
};
struct EpiResBf16 {
    static constexpr bool PERM = true;
    bf16_t* O; const bf16_t* R;
    __device__ __forceinline__ void operator()(const f32x4 (&acc)[2][2][4][2], const Unit& u, int wr, int wc, int fr, int fq) const {
        const int row0 = u.row0 + wr * 64 + fr, col0 = u.col0 + wc * 32 + 8 * fq;
#pragma unroll
        for (int ai = 0; ai < 2; ++ai)
#pragma unroll
            for (int m = 0; m < 4; ++m) { const size_t off = (size_t)(row0 + ai * HALF + m * 16) * 1024 + col0;
#pragma unroll
                for (int bj = 0; bj < 2; ++bj) { const u32x4 r = *(const u32x4*)(R + off + bj * HALF); const f32x4 v0 = acc[ai][bj][m][0], v1 = acc[ai][bj][m][1];
                    u32x4 w; w.x = pk_bf16(bf_lo(r[0]) * ALPHA + v0[0], bf_hi(r[0]) * ALPHA + v0[1]); w.y = pk_bf16(bf_lo(r[1]) * ALPHA + v0[2], bf_hi(r[1]) * ALPHA + v0[3]);
                    w.z = pk_bf16(bf_lo(r[2]) * ALPHA + v1[0], bf_hi(r[2]) * ALPHA + v1[1]); w.w = pk_bf16(bf_lo(r[3]) * ALPHA + v1[2], bf_hi(r[3]) * ALPHA + v1[3]);
                    *(u32x4*)(O + off + bj * HALF) = w; } }
    }
};
template <bool F8> struct EpiSwiglu {
    static constexpr bool PERM = true;
    void* Ov; const float* bias; float ascale;
    __device__ __forceinline__ void operator()(const f32x4 (&acc)[2][2][4][2], const Unit& u, int wr, int wc, int fr, int fq) const {
        const int row0 = u.row0 + wr * 64 + fr, oc = (u.col0 >> 1) + wc * 32 + 8 * fq;
        const float* bp = bias + (size_t)u.e * 2048 + oc;
        f32x4 bg[2], bu[2];
#pragma unroll
        for (int n = 0; n < 2; ++n) { bg[n] = *(const f32x4*)(bp + 4 * n); bu[n] = *(const f32x4*)(bp + 1024 + 4 * n); }
#pragma unroll
        for (int ai = 0; ai < 2; ++ai)
#pragma unroll
            for (int m = 0; m < 4; ++m) {
                float o[8];
#pragma unroll
                for (int n = 0; n < 2; ++n) { const f32x4 g4 = acc[ai][0][m][n] * ascale + bg[n], u4 = acc[ai][1][m][n] * ascale + bu[n];
#pragma unroll
                    for (int j = 0; j < 4; ++j) { const float g = fminf(g4[j], 7.0f), up = fminf(fmaxf(u4[j], -7.0f), 7.0f);
                        const float glu = g * __builtin_amdgcn_rcpf(1.0f + __builtin_amdgcn_exp2f(-1.702f * LOG2E * g)); o[4 * n + j] = (up + 1.0f) * glu; } }
                if constexpr (F8) { *(u32x2*)((unsigned char*)Ov + (size_t)(row0 + ai * HALF + m * 16) * 1024 + oc) = (u32x2){pk4_fp8(o[0] * A8_SCALE, o[1] * A8_SCALE, o[2] * A8_SCALE, o[3] * A8_SCALE), pk4_fp8(o[4] * A8_SCALE, o[5] * A8_SCALE, o[6] * A8_SCALE, o[7] * A8_SCALE)}; }
                else { u32x4 w; w.x = pk_bf16(o[0], o[1]); w.y = pk_bf16(o[2], o[3]); w.z = pk_bf16(o[4], o[5]); w.w = pk_bf16(o[6], o[7]);
                    *(u32x4*)((bf16_t*)Ov + (size_t)(row0 + ai * HALF + m * 16) * 1024 + oc) = w; } }
    }
};
struct EpiBiasBf16 {
    static constexpr bool PERM = true;
    bf16_t* O; const float* bias; float ascale;
    __device__ __forceinline__ void operator()(const f32x4 (&acc)[2][2][4][2], const Unit& u, int wr, int wc, int fr, int fq) const {
        const int row0 = u.row0 + wr * 64 + fr, col0 = u.col0 + wc * 32 + 8 * fq;
        const float* bp = bias + (size_t)u.e * 1024 + col0;
        f32x4 bv[2][2];
#pragma unroll
        for (int bj = 0; bj < 2; ++bj)
#pragma unroll
            for (int n = 0; n < 2; ++n) bv[bj][n] = *(const f32x4*)(bp + bj * HALF + 4 * n);
#pragma unroll
        for (int ai = 0; ai < 2; ++ai)
#pragma unroll
            for (int m = 0; m < 4; ++m) { bf16_t* rowp = O + (size_t)(row0 + ai * HALF + m * 16) * 1024 + col0;
#pragma unroll
                for (int bj = 0; bj < 2; ++bj) { const f32x4 v0 = acc[ai][bj][m][0] * ascale + bv[bj][0], v1 = acc[ai][bj][m][1] * ascale + bv[bj][1];
                    u32x4 w; w.x = pk_bf16(v0[0], v0[1]); w.y = pk_bf16(v0[2], v0[3]); w.z = pk_bf16(v1[0], v1[1]); w.w = pk_bf16(v1[2], v1[3]);
                    *(u32x4*)(rowp + bj * HALF) = w; } }
    }
};
}


#ifndef ATT_EN
#define ATT_EN 7
#endif
#ifndef PROBE
#define PROBE (-1)
#endif
#define PREP(k) _Pragma("unroll 1") for (int _rp = 0; _rp < ((PROBE == (k)) ? 2 : 1); ++_rp)
typedef float f32x16 __attribute__((ext_vector_type(16)));
#define MFMA32(a, b, c) __builtin_amdgcn_mfma_f32_32x32x16_f16((a), (b), (c), 0, 0, 0)
constexpr int ATT_BUF = 27648;
constexpr int ATT_RELB = 2 * ATT_BUF;
#define NEG_INF_F (-__builtin_huge_valf())

template <int MODE>
__device__ __forceinline__ void attn_unit(LAS unsigned char* lds, const bf16_t* HQ, const bf16_t* VT, bf16_t* MIX, const unsigned long long* MASK, float* OA1,
                                          const int b, const int h, const int qt, const int wave, const int lane_unused,
                                          const float lam, const float lam_init, const float* subg, const float* relb) {
    constexpr int NPASS = (MODE == 0) ? 2 : 1;
    constexpr int EB = (MODE == 0) ? 4 : 2;
    constexpr int KSTR = 144;
    constexpr int VOFF = 64 * KSTR;
    constexpr int NCHV = (MODE == 0) ? 2 : 1;
    const int qoff = (MODE == 0) ? HQ_QA + h * 128 : (MODE == 1) ? HQ_QB + h * 64 : HQ_QC + h * 64;
    const int koff = (MODE == 0) ? HQ_KA + h * 128 : (MODE == 1) ? HQ_KB + h * 64 : HQ_KC + h * 64;
    const int vrow0 = (MODE == 0) ? VT_A + h * 128 : (MODE == 1) ? VT_B + h * 64 : VT_C + h * 64;
    const int mixcol = (MODE == 0) ? h * 128 : (MODE == 1) ? 512 + h * 64 : 768 + h * 64;
    int lane; asm volatile("v_mbcnt_lo_u32_b32 %0, -1, 0\n\tv_mbcnt_hi_u32_b32 %0, -1, %0" : "=&v"(lane));
    const int tid = wave * 64 + lane, ql = lane & 31, hb = lane >> 5;
    const int cq = qt * 4 + (wave >> 1);
    const int tq = qt * 256 + wave * 32 + ql;
    const int kt_hi = qt * 4 + 3;
    const int kt_lo = (MODE == 1) ? ((qt * 4 - 8) > 0 ? (qt * 4 - 8) : 0) : 0;
    const float slope2 = (MODE == 0) ? exp2f(-(float)(2 * h + 1)) * LOG2E : exp2f(-(float)(2 * h + 2)) * LOG2E;
    LAS float* relb_l = (LAS float*)(lds + ATT_RELB);
    const int prow = (ql & 16) | ((ql & 4) << 1) | ((ql & 8) >> 1) | (ql & 3);
    const int krow = tid >> 3, kc = tid & 7;
#pragma unroll 1
    for (int mp = 0; mp < NPASS; ++mp) {
        bf16x8 Q[4];
        { const bf16_t* qp = HQ + (size_t)(b * SEQ + tq) * HQP + qoff + mp * 64 + hb * 8;
#pragma unroll
          for (int ks = 0; ks < 4; ++ks) Q[ks] = *(const bf16x8*)(qp + ks * 16); }
        f32x16 O[EB];
        float mrun = -1e30f, lrun = 0.f;
#pragma unroll
        for (int eb = 0; eb < EB; ++eb)
#pragma unroll
            for (int i = 0; i < 16; ++i) O[eb][i] = 0.f;
        u32x4 kreg, vreg[NCHV];
#define ATT_LOAD(kt_) do { kreg = *(const u32x4*)(HQ + (size_t)(b * SEQ + (kt_) * 64 + krow) * HQP + koff + mp * 64 + kc * 8); \
        _Pragma("unroll") for (int j = 0; j < NCHV; ++j) vreg[j] = *(const u32x4*)(VT + (size_t)(vrow0 + krow + 64 * j) * T + (size_t)b * SEQ + (kt_) * 64 + kc * 8); } while (0)
#define ATT_STORE(buf_) do { *(LAS u32x4*)(lds + (buf_) * ATT_BUF + krow * KSTR + kc * 16) = kreg; \
        _Pragma("unroll") for (int j = 0; j < NCHV; ++j) *(LAS u32x4*)(lds + (buf_) * ATT_BUF + VOFF + (krow + 64 * j) * 144 + kc * 16) = vreg[j]; } while (0)

        __syncthreads();
        if (MODE == 1) { for (int i = tid; i < 257; i += 512) relb_l[i] = relb[i] * LOG2E; }
        ATT_LOAD(kt_hi); ATT_STORE(0);
        __syncthreads();
        int buf = 0;
        for (int kt = kt_hi; kt >= kt_lo; --kt) {
            if (kt > kt_lo) ATT_LOAD(kt - 1);
            const bool active = (kt <= cq) && (MODE != 1 || kt >= cq - 8);
            if (active) {
                const LAS unsigned char* kbp = lds + buf * ATT_BUF + prow * KSTR + hb * 16;
                const LAS unsigned char* vbp = lds + buf * ATT_BUF + VOFF + ql * 144 + hb * 16;
                f32x16 S0, S1;
#pragma unroll
                for (int i = 0; i < 16; ++i) { S0[i] = 0.f; S1[i] = 0.f; }
#pragma unroll
                for (int ks = 0; ks < 4; ++ks) {
                    const bf16x8 k0 = *(const LAS bf16x8*)(kbp + ks * 32);
                    const bf16x8 k1 = *(const LAS bf16x8*)(kbp + 32 * KSTR + ks * 32);
                    S0 = MFMA32(k0, Q[ks], S0); S1 = MFMA32(k1, Q[ks], S1);
                    if (ks & 1) __builtin_amdgcn_sched_barrier(0);
                }
                if (MODE == 0 || MODE == 2) {
                    const float base0 = (float)(tq - kt * 64 - 8 * hb), base1 = base0 - 32.0f;
#pragma unroll
                    for (int i = 0; i < 16; ++i) { const float off = (float)(16 * (i >> 3) + (i & 7));
                        S0[i] = S0[i] - slope2 * fabsf(base0 - off); S1[i] = S1[i] - slope2 * fabsf(base1 - off); }
                }
                if (MODE == 2) {
                    const unsigned long long W = MASK[(size_t)(b * SEQ + tq) * 32 + kt];
                    const unsigned w0 = (unsigned)W >> (8 * hb), w1 = (unsigned)(W >> 32) >> (8 * hb);
#pragma unroll
                    for (int i = 0; i < 16; ++i) { const int off = 16 * (i >> 3) + (i & 7);
                        S0[i] = ((w0 >> off) & 1u) ? S0[i] : NEG_INF_F; S1[i] = ((w1 >> off) & 1u) ? S1[i] : NEG_INF_F; }
                }
                if (MODE == 1) {
                    if (kt >= cq - 2) {
                        const int rel0 = tq - kt * 64 - 8 * hb + 128;
#pragma unroll
                        for (int i = 0; i < 16; ++i) { const int off = 16 * (i >> 3) + (i & 7);
                            int r0 = rel0 - off, r1 = rel0 - 32 - off;
                            r0 = r0 < 0 ? 0 : (r0 > 256 ? 256 : r0); r1 = r1 < 0 ? 0 : (r1 > 256 ? 256 : r1);
                            S0[i] += relb_l[r0]; S1[i] += relb_l[r1]; }
                    } else {
                        const float far = relb_l[256];
#pragma unroll
                        for (int i = 0; i < 16; ++i) { S0[i] += far; S1[i] += far; }
                    }
                }
                float mx = fmaxf(S0[0], S1[0]);
#pragma unroll
                for (int i = 1; i < 16; ++i) mx = fmaxf(mx, fmaxf(S0[i], S1[i]));
                mx = fmaxf(mx, shx(mx, 32, lane));
                const float mnew = fmaxf(mrun, mx);
                const float alpha = __builtin_amdgcn_exp2f(mrun - mnew);
                mrun = mnew;
                float ps = 0.f;
#pragma unroll
                for (int i = 0; i < 16; ++i) { S0[i] = __builtin_amdgcn_exp2f(S0[i] - mnew); S1[i] = __builtin_amdgcn_exp2f(S1[i] - mnew); ps += S0[i] + S1[i]; }
                lrun = lrun * alpha + ps;
#pragma unroll
                for (int eb = 0; eb < EB; ++eb) O[eb] = O[eb] * alpha;
                bf16x8 P[4];
                { u32x4 p;
                  p.x = pk_bf16(S0[0], S0[1]); p.y = pk_bf16(S0[2], S0[3]); p.z = pk_bf16(S0[4], S0[5]); p.w = pk_bf16(S0[6], S0[7]); P[0] = __builtin_bit_cast(bf16x8, p);
                  p.x = pk_bf16(S0[8], S0[9]); p.y = pk_bf16(S0[10], S0[11]); p.z = pk_bf16(S0[12], S0[13]); p.w = pk_bf16(S0[14], S0[15]); P[1] = __builtin_bit_cast(bf16x8, p);
                  p.x = pk_bf16(S1[0], S1[1]); p.y = pk_bf16(S1[2], S1[3]); p.z = pk_bf16(S1[4], S1[5]); p.w = pk_bf16(S1[6], S1[7]); P[2] = __builtin_bit_cast(bf16x8, p);
                  p.x = pk_bf16(S1[8], S1[9]); p.y = pk_bf16(S1[10], S1[11]); p.z = pk_bf16(S1[12], S1[13]); p.w = pk_bf16(S1[14], S1[15]); P[3] = __builtin_bit_cast(bf16x8, p); }
#pragma unroll
                for (int s4 = 0; s4 < 4; ++s4)
#pragma unroll
                    for (int eb = 0; eb < EB; ++eb) {
                        const bf16x8 vf = *(const LAS bf16x8*)(vbp + eb * 32 * 144 + s4 * 32);
                        O[eb] = MFMA32(vf, P[s4], O[eb]);
                        if (eb & 1) __builtin_amdgcn_sched_barrier(0);
                    }
            }
            if (kt > kt_lo) ATT_STORE(buf ^ 1);
            __syncthreads();
            buf ^= 1;
        }
#undef ATT_LOAD
#undef ATT_STORE
        const float inv = 1.0f / (lrun + shx(lrun, 32, lane));
        bf16_t* op = MIX + (size_t)(b * SEQ + tq) * 1024 + mixcol + 4 * hb;
        if (MODE == 0) {
            float* o1p = OA1 + (size_t)(b * SEQ + tq) * 512 + h * 128 + 4 * hb;
            if (mp == 0) {
#pragma unroll
                for (int eb = 0; eb < EB; ++eb)
#pragma unroll
                    for (int g = 0; g < 4; ++g) *(f32x4*)(o1p + eb * 32 + 8 * g) = (f32x4){O[eb][4 * g] * inv, O[eb][4 * g + 1] * inv, O[eb][4 * g + 2] * inv, O[eb][4 * g + 3] * inv};
            } else {
                const float c2 = lam * inv;
                float ss = 0.f;
#pragma unroll
                for (int eb = 0; eb < EB; ++eb)
#pragma unroll
                    for (int g = 0; g < 4; ++g) { const f32x4 o1 = *(const f32x4*)(o1p + eb * 32 + 8 * g);
#pragma unroll
                        for (int j = 0; j < 4; ++j) { const float o = o1[j] - O[eb][4 * g + j] * c2; O[eb][4 * g + j] = o; ss += o * o; } }
                ss += shx(ss, 32, lane);
                const float r = rsqrtf(ss * (1.0f / 128.0f) + EPS) * (1.0f - lam_init);
#pragma unroll
                for (int eb = 0; eb < EB; ++eb)
#pragma unroll
                    for (int g = 0; g < 4; ++g) { const int e0 = eb * 32 + 8 * g; const f32x4 sg = *(const f32x4*)(subg + e0 + 4 * hb);
                        *(u32x2*)(op + e0) = (u32x2){pk_bf16(O[eb][4 * g] * r * sg[0], O[eb][4 * g + 1] * r * sg[1]), pk_bf16(O[eb][4 * g + 2] * r * sg[2], O[eb][4 * g + 3] * r * sg[3])}; }
            }
        } else {
#pragma unroll
            for (int eb = 0; eb < EB; ++eb)
#pragma unroll
                for (int g = 0; g < 4; ++g) { const int e0 = eb * 32 + 8 * g;
                    *(u32x2*)(op + e0) = (u32x2){pk_bf16(O[eb][4 * g] * inv, O[eb][4 * g + 1] * inv), pk_bf16(O[eb][4 * g + 2] * inv, O[eb][4 * g + 3] * inv)}; }
        }
    }
}


constexpr int IDX_STR = 2052;
__device__ __forceinline__ unsigned f2key(float f) { const unsigned u = __float_as_uint(f); return u ^ (((unsigned)((int)u >> 31)) | 0x80000000u); }
template <int J>
__device__ __forceinline__ void index_select(const LAS float* row, const int nb, const int lane, unsigned long long* mo) {
    unsigned u[J];
#pragma unroll
    for (int j = 0; j < J; ++j) u[j] = (j < nb) ? f2key(row[64 * j]) : 0u;
    unsigned prefix = 0u;
#pragma unroll 1
    for (int bit = 31; bit >= 0; --bit) {
        const unsigned cand = prefix | (1u << bit);
        int c = 0;
#pragma unroll
        for (int j = 0; j < J; ++j) c += (int)__builtin_popcountll(__ballot(u[j] >= cand));
        if (c >= 256) prefix = cand;
        if (c == 256) break;
    }
    const unsigned thr = prefix;
    int cg = 0;
#pragma unroll
    for (int j = 0; j < J; ++j) cg += (int)__builtin_popcountll(__ballot(u[j] > thr));
    const int quota = 256 - cg;
    int taken = 0;
    unsigned long long myword = 0ull;
#pragma unroll
    for (int j = 0; j < J; ++j) {
        const bool eq = (u[j] == thr);
        const unsigned long long eqm = __ballot(eq);
        const int before = (int)__builtin_popcountll(eqm & ((1ull << lane) - 1ull));
        const unsigned long long m = __ballot((u[j] > thr) || (eq && (taken + before < quota)));
        taken += (int)__builtin_popcountll(eqm);
        myword = (lane == j) ? m : myword;
    }
    if (lane < 32) mo[lane] = myword;
}
__device__ __forceinline__ void index_unit(LAS unsigned char* lds, const bf16_t* HQ, unsigned long long* MASK, const int b, const int tt, const int wave) {
    int lane; asm volatile("v_mbcnt_lo_u32_b32 %0, -1, 0\n\tv_mbcnt_hi_u32_b32 %0, -1, %0" : "=&v"(lane));
    const int t0 = tt * 16, nb = (t0 >> 6) + 1, nk = nb * 64;
    if (nb <= 4) {
        for (int i = wave * 64 + lane; i < 16 * 32; i += 512) MASK[(size_t)(b * SEQ + t0 + (i >> 5)) * 32 + (i & 31)] = ((i & 31) < nb) ? ~0ull : 0ull;
        return;
    }
    LAS float* sc = (LAS float*)lds;
    const int q = lane & 15, g = lane >> 4;
    {
        const bf16_t* qrow = HQ + (size_t)(b * SEQ + t0 + q) * HQP;
        bf16x8 QI[8];
#pragma unroll
        for (int h = 0; h < 8; ++h) QI[h] = *(const bf16x8*)(qrow + HQ_QI + h * 32 + g * 8);
        float w[8];
        { const u32x4 wv = *(const u32x4*)(qrow + HQ_WI);
          w[0] = bf_lo(wv[0]) * 0.0625f; w[1] = bf_hi(wv[0]) * 0.0625f; w[2] = bf_lo(wv[1]) * 0.0625f; w[3] = bf_hi(wv[1]) * 0.0625f;
          w[4] = bf_lo(wv[2]) * 0.0625f; w[5] = bf_hi(wv[2]) * 0.0625f; w[6] = bf_lo(wv[3]) * 0.0625f; w[7] = bf_hi(wv[3]) * 0.0625f; }
        const bf16_t* kbase = HQ + (size_t)(b * SEQ + q) * HQP + HQ_KI + g * 8;
        for (int kb = wave; kb < nk / 16; kb += 8) {
            const bf16x8 kf = *(const bf16x8*)(kbase + (size_t)kb * 16 * HQP);
            f32x4 acc = {0.f, 0.f, 0.f, 0.f};
#pragma unroll
            for (int h = 0; h < 8; ++h) {
                const f32x4 z = __builtin_amdgcn_mfma_f32_16x16x32_f16(kf, QI[h], (f32x4){0.f, 0.f, 0.f, 0.f}, 0, 0, 0);
#pragma unroll
                for (int j = 0; j < 4; ++j) acc[j] = fmaf(w[h], fmaxf(z[j], 0.f), acc[j]);
            }
#pragma unroll
            for (int j = 0; j < 4; ++j) acc[j] += 0.0f;
            *(LAS f32x4*)(sc + q * IDX_STR + kb * 16 + g * 4) = acc;
        }
    }
    __syncthreads();
#pragma unroll 1
    for (int qq = 0; qq < 2; ++qq) {
        const int ql = wave * 2 + qq;
        const LAS float* row = sc + ql * IDX_STR + lane;
        unsigned long long* mo = MASK + (size_t)(b * SEQ + t0 + ql) * 32;
        if (nb <= 8) index_select<8>(row, nb, lane, mo);
        else if (nb <= 16) index_select<16>(row, nb, lane, mo);
        else if (nb <= 24) index_select<24>(row, nb, lane, mo);
        else index_select<32>(row, nb, lane, mo);
    }
    __syncthreads();
}

struct Args {
    const float* x; const float* w_in; const float* lam_q1; const float* lam_k1; const float* lam_q2; const float* lam_k2; const float* subln_g; const float* rel_bias;
    const float* w_out; const float* ln1_g; const float* ln1_b; const float* w_router; const float* b_router; const float* w_gu; const float* b_gu;
    const float* w_down; const float* b_down; const float* ln2_g; const float* ln2_b;
    float* out; unsigned char* ws;
    int ph_lo, ph_hi, bar_region, pad;
};

constexpr int LDS_STAGE = 0;
constexpr int LDS_CTL = 135168;
constexpr int LDS_TSTART = LDS_CTL + 64;
constexpr int LDS_CNT = LDS_TSTART + 36 * 4;
constexpr int LDS_TILEE = LDS_CNT + 32 * 4;
constexpr int LDS_RT = LDS_TILEE + 576;
constexpr int LDS_BYTES = 147456;
static_assert(LDS_RT + (64 + 1024) * 4 <= LDS_BYTES && 16 * IDX_STR * 4 <= LDS_CTL, "LDS map");

__device__ __forceinline__ void transpose_item(const float* W, int N, int k0, int n0, int nvalid, bf16_t* WTrow0, float scale, LAS float* scr, int lane) {
#pragma unroll 8
    for (int i = 0; i < 32; ++i) { const int kk = 2 * i + (lane >> 5), col = lane & 31; scr[kk * 33 + col] = (col < nvalid) ? W[(size_t)(k0 + kk) * N + n0 + col] * scale : 0.f; }
    asm volatile("s_waitcnt lgkmcnt(0)" ::: "memory");
    const int c = lane & 7;
#pragma unroll
    for (int j = 0; j < 4; ++j) { const int n = (lane >> 3) + 8 * j; const LAS float* s = scr + (8 * c) * 33 + n;
        u32x4 o; o.x = pk_bf16(s[0 * 33], s[1 * 33]); o.y = pk_bf16(s[2 * 33], s[3 * 33]); o.z = pk_bf16(s[4 * 33], s[5 * 33]); o.w = pk_bf16(s[6 * 33], s[7 * 33]);
        if (n < nvalid) *(u32x4*)(WTrow0 + (size_t)n * 1024 + k0 + 8 * c) = o; }
    asm volatile("s_waitcnt lgkmcnt(0)" ::: "memory");
}
__device__ __forceinline__ void transpose_item_fp8(const float* W, int N, int k0, int n0, unsigned char* WTrow0, float scale, LAS float* scr, int lane) {
#pragma unroll 8
    for (int i = 0; i < 32; ++i) { const int kk = 2 * i + (lane >> 5), col = lane & 31; scr[kk * 33 + col] = W[(size_t)(k0 + kk) * N + n0 + col] * scale; }
    asm volatile("s_waitcnt lgkmcnt(0)" ::: "memory");
    const int c = lane & 3;
#pragma unroll
    for (int j = 0; j < 2; ++j) { const int n = (lane >> 2) + 16 * j; const LAS float* s = scr + (16 * c) * 33 + n;
        u32x4 o; o.x = pk4_fp8(s[0 * 33], s[1 * 33], s[2 * 33], s[3 * 33]); o.y = pk4_fp8(s[4 * 33], s[5 * 33], s[6 * 33], s[7 * 33]);
        o.z = pk4_fp8(s[8 * 33], s[9 * 33], s[10 * 33], s[11 * 33]); o.w = pk4_fp8(s[12 * 33], s[13 * 33], s[14 * 33], s[15 * 33]);
        *(u32x4*)(WTrow0 + (size_t)n * 1024 + k0 + 16 * c) = o; }
    asm volatile("s_waitcnt lgkmcnt(0)" ::: "memory");
}
__device__ __forceinline__ void in_map(int n0, bool& isv, int& row, float& scale) {
    scale = 1.f; isv = false;
    if (n0 < 512) { row = HQ_QA + n0; scale = QSCALE; }
    else if (n0 < 1024) row = HQ_KA + (n0 - 512);
    else if (n0 < 1536) { isv = true; row = VT_A + (n0 - 1024); }
    else if (n0 < 1792) { row = HQ_QB + (n0 - 1536); scale = QSCALE; }
    else if (n0 < 2048) row = HQ_KB + (n0 - 1792);
    else if (n0 < 2304) { isv = true; row = VT_B + (n0 - 2048); }
    else if (n0 < 2560) { row = HQ_QC + (n0 - 2304); scale = QSCALE; }
    else if (n0 < 2816) row = HQ_KC + (n0 - 2560);
    else if (n0 < 3072) { isv = true; row = VT_C + (n0 - 2816); }
    else if (n0 < 3328) row = HQ_QI + (n0 - 3072);
    else if (n0 < 3360) row = HQ_KI + (n0 - 3328);
    else row = HQ_WI + (n0 - 3360);
}

__global__ void __launch_bounds__(512, 2) mega(Args a) {
    extern __shared__ __attribute__((aligned(16))) unsigned char lds_raw[];
    LAS unsigned char* lds = (LAS unsigned char*)lds_raw;
    const int G = gridDim.x, bid = blockIdx.x, NGW = G * 8;
    const int wave = __builtin_amdgcn_readfirstlane((int)threadIdx.x >> 6);
#define OPAQUE_IDS() int lane; asm volatile("v_mbcnt_lo_u32_b32 %0, -1, 0\n\tv_mbcnt_hi_u32_b32 %0, -1, %0" : "=&v"(lane)); const int tid = wave * 64 + lane, gw = bid * 8 + wave; (void)tid; (void)gw
#define WSPTRS() unsigned char* ws = a.ws; asm volatile("" : "+s"(ws)); \
    unsigned* ctl = (unsigned*)(ws + WS_CTL); bf16_t* Win = (bf16_t*)(ws + WS_WIN); bf16_t* Wv = (bf16_t*)(ws + WS_WV); bf16_t* Wout = (bf16_t*)(ws + WS_WOUT); \
    bf16_t* Wgu = (bf16_t*)(ws + WS_WGU); bf16_t* Wdn = (bf16_t*)(ws + WS_WDN); bf16_t* XB = (bf16_t*)(ws + WS_XB); \
    bf16_t* HQ = (bf16_t*)(ws + WS_HQ); bf16_t* VT = (bf16_t*)(ws + WS_VT); bf16_t* MIX = (bf16_t*)(ws + WS_MIX); \
    bf16_t* Y1B = (bf16_t*)(ws + WS_Y1); bf16_t* X1B = (bf16_t*)(ws + WS_X1B); bf16_t* ACT = (bf16_t*)(ws + WS_ACT); bf16_t* YR = (bf16_t*)(ws + WS_YR); \
    int* TOKL = (int*)(ws + WS_TOKL); int* ASGE = (int*)(ws + WS_ASGE); int* ASGS = (int*)(ws + WS_ASGS); float* GATE = (float*)(ws + WS_GATE); \
    (void)ctl; (void)Win; (void)Wv; (void)Wout; (void)Wgu; (void)Wdn; (void)XB; (void)HQ; (void)VT; (void)MIX; (void)Y1B; (void)X1B; (void)ACT; (void)YR; (void)TOKL; (void)ASGE; (void)ASGS; (void)GATE
    for (int u = threadIdx.x; u < (LDS_BYTES - LDS_CTL) / 4; u += 512) ((LAS unsigned*)(lds + LDS_CTL))[u] = 0u;
    __syncthreads();
    XcdBarrier bar = xcd_barrier_post((unsigned*)(a.ws + WS_CTL) + CW_BAR + a.bar_region * XCD_BAR_WORDS, (volatile LAS unsigned*)(lds + LDS_CTL));
    const int lo = a.ph_lo, hi = a.ph_hi;
#define IN(k) (lo <= (k) && (k) < hi)
#define SEAM(k) do { if (IN(k) && IN((k) + 1)) xcd_barrier(bar); } while (0)

    if (IN(0)) PREP(0) {
        OPAQUE_IDS(); WSPTRS();
        LAS float* scr = (LAS float*)(lds + LDS_STAGE + wave * 16384);
        constexpr int I_IN = 16 * 106, I_OUT = 16 * 32, I_GU = 16 * 64, I_DN = 16 * 32;
        constexpr int N_IN = DEPTH * I_IN, N_OUT = DEPTH * I_OUT, N_GU = DEPTH * NE * I_GU, N_DN = DEPTH * NE * I_DN;
        for (int it = gw; it < N_IN + N_OUT + N_GU + N_DN; it += NGW) {
            int r = it;
            if (r < N_IN) { const int l = r / I_IN, q = r % I_IN, kb = q / 106, nb = q % 106, n0 = nb * 32; bool isv; int row; float sc; in_map(n0, isv, row, sc);
                bf16_t* dst = isv ? Wv + ((size_t)l * 1024 + row) * 1024 : Win + ((size_t)l * HQP + row) * 1024;
                transpose_item(a.w_in + (size_t)l * D * DIN, DIN, kb * 64, n0, (DIN - n0) < 32 ? (DIN - n0) : 32, dst, sc, scr, lane); continue; }
            r -= N_IN;
            if (r < N_OUT) { const int l = r / I_OUT, q = r % I_OUT, kb = q / 32, nb = q % 32;
                transpose_item(a.w_out + (size_t)l * 1024 * D, D, kb * 64, nb * 32, 32, Wout + ((size_t)l * D + nb * 32) * 1024, 1.f, scr, lane); continue; }
            r -= N_OUT;
            if (r < N_GU) { const int le = r / I_GU, q = r % I_GU, kb = q / 64, nb = q % 64, n0 = nb * 32;
                const int bj = n0 >> 10, rr = n0 & 1023, pn = rr >> 7, c = rr & 127, nrow = pn * 256 + bj * 128 + c;
#if MOE_FP8
                transpose_item_fp8(a.w_gu + (size_t)le * D * 2048, 2048, kb * 64, n0, (unsigned char*)Wgu + ((size_t)le * 2048 + nrow) * 1024, W8_SCALE, scr, lane); continue; }
#else
                transpose_item(a.w_gu + (size_t)le * D * 2048, 2048, kb * 64, n0, 32, Wgu + ((size_t)le * 2048 + nrow) * 1024, 1.f, scr, lane); continue; }
#endif
            r -= N_GU;
            { const int le = r / I_DN, q = r % I_DN, kb = q / 32, nb = q % 32;
#if MOE_FP8
                transpose_item_fp8(a.w_down + (size_t)le * 1024 * D, D, kb * 64, nb * 32, (unsigned char*)Wdn + ((size_t)le * D + nb * 32) * 1024, W8_SCALE, scr, lane); }
#else
                transpose_item(a.w_down + (size_t)le * 1024 * D, D, kb * 64, nb * 32, 32, Wdn + ((size_t)le * D + nb * 32) * 1024, 1.f, scr, lane); }
#endif
        }
        for (int i = gw * 64 + lane; i < DEPTH * (HQP - HQ_USED) * 128; i += NGW * 64) { const int l = i / ((HQP - HQ_USED) * 128), q = i % ((HQP - HQ_USED) * 128);
            *(u32x4*)(Win + ((size_t)l * HQP + HQ_USED) * 1024 + (size_t)q * 8) = (u32x4){0u, 0u, 0u, 0u}; }
        { float* WRT = (float*)(ws + WS_WRT);
          for (int i = gw * 64 + lane; i < DEPTH * NE * D; i += NGW * 64) { const int ll = i / (NE * D), r = i % (NE * D), e = r / D, c = r % D; WRT[i] = a.w_router[((size_t)ll * D + c) * NE + e]; } }
        for (size_t i = (size_t)gw * 64 + lane; i < (size_t)T * D / 8; i += (size_t)NGW * 64) { const f32x4 v0 = *(const f32x4*)(a.x + i * 8), v1 = *(const f32x4*)(a.x + i * 8 + 4);
            u32x4 w; w.x = pk_bf16(v0[0], v0[1]); w.y = pk_bf16(v0[2], v0[3]); w.z = pk_bf16(v1[0], v1[1]); w.w = pk_bf16(v1[2], v1[3]); *(u32x4*)(XB + i * 8) = w; }
    }
    SEAM(0);

#pragma unroll 1
    for (int l = 0; l < DEPTH; ++l) {
        const int pb = 1 + 8 * l;
        if (IN(pb + 0)) PREP(1) {
            WSPTRS();
            { pg8::DenseOrder S{T / 256, HQP / 256, G, bid, (const char*)(Win + (size_t)l * HQP * 1024), 1024, false};
              pg8::EpiBf16Plain E{HQ, HQP};
              pg8::gemm_phase<pg8::EpiBf16Plain, pg8::DenseOrder, false>(lds + LDS_STAGE, XB, 1024, S, E, wave); }
            { pg8::DenseOrder S{1024 / 256, T / 256, G, bid, (const char*)XB, 1024, true};
              pg8::EpiBf16Plain E{VT, T};
              pg8::gemm_phase<pg8::EpiBf16Plain, pg8::DenseOrder, false>(lds + LDS_STAGE, Wv + (size_t)l * 1024 * 1024, 1024, S, E, wave); }
        }
        SEAM(pb + 0);
        if (IN(pb + 1)) {
            OPAQUE_IDS(); WSPTRS();
            unsigned long long* MASKp = (unsigned long long*)(ws + WS_MASK); float* OA1p = (float*)(ws + WS_OA1);
            const float lam_init = 0.8f - 0.6f * expf(-0.3f * (float)l);
            const float lam = expf(wsum(a.lam_q1[l * 64 + lane] * a.lam_k1[l * 64 + lane], lane)) - expf(wsum(a.lam_q2[l * 64 + lane] * a.lam_k2[l * 64 + lane], lane)) + lam_init;
            const int v0 = (G % 8 == 0) ? (bid & 7) * (G >> 3) + (bid >> 3) : bid;
            for (int v = v0; v < 256; v += G) {
                const int b = v >> 4, h = (v >> 2) & 3, q0 = v & 3, j16 = v & 15;
                PREP(2)
#pragma unroll 1
                for (int k = 0; k < 8; ++k) index_unit(lds + LDS_STAGE, HQ, MASKp, b, 16 * k + ((k & 1) ? 15 - j16 : j16), wave);
                PREP(3)
#pragma unroll 1
                for (int rep = 0; rep < 2; ++rep) attn_unit<0>(lds + LDS_STAGE, HQ, VT, MIX, MASKp, OA1p, b, h, rep ? 7 - q0 : q0, wave, lane, lam, lam_init, a.subln_g + l * 128, nullptr);
                PREP(4)
#pragma unroll 1
                for (int rep = 0; rep < 2; ++rep) attn_unit<1>(lds + LDS_STAGE, HQ, VT, MIX, MASKp, OA1p, b, h, rep ? 7 - q0 : q0, wave, lane, 0.f, 0.f, nullptr, a.rel_bias + ((size_t)l * 4 + h) * 257);
            }
        }
        SEAM(pb + 1);
        if (IN(pb + 2)) {
            OPAQUE_IDS(); WSPTRS();
            unsigned long long* MASKp = (unsigned long long*)(ws + WS_MASK); float* OA1p = (float*)(ws + WS_OA1);
            const int v0 = (G % 8 == 0) ? (bid & 7) * (G >> 3) + (bid >> 3) : bid;
            for (int v = v0; v < 256; v += G) {
                const int b = v >> 4, h = (v >> 2) & 3, q0 = v & 3;
                PREP(5)
#pragma unroll 1
                for (int rep = 0; rep < 2; ++rep) attn_unit<2>(lds + LDS_STAGE, HQ, VT, MIX, MASKp, OA1p, b, h, rep ? 7 - q0 : q0, wave, lane, 0.f, 0.f, nullptr, nullptr);
            }
        }
        SEAM(pb + 2);
        if (IN(pb + 3)) PREP(6) {
            WSPTRS();
            pg8::DenseOrder S{T / 256, 4, G, bid, (const char*)(Wout + (size_t)l * 1024 * 1024), 1024, false};
            pg8::EpiResBf16 E{Y1B, XB};
            pg8::gemm_phase<pg8::EpiResBf16, pg8::DenseOrder, false>(lds + LDS_STAGE, MIX, 1024, S, E, wave);
        }
        SEAM(pb + 3);
        if (IN(pb + 4)) {
            OPAQUE_IDS(); WSPTRS();
            LAS int* lcnt = (LAS int*)(lds + LDS_RT); LAS int* lbase = lcnt + 32; LAS int* asg_e = lcnt + 64; LAS int* asg_ls = asg_e + 512;
            const float* g1 = a.ln1_g + l * D; const float* b1 = a.ln1_b + l * D; const float* br = a.b_router + l * NE;
            unsigned* gcnt = ctl + CW_CNT + l * 64;
            LAS float* wT = (LAS float*)(lds + LDS_STAGE);
            { const f32x4* src = (const f32x4*)((const float*)(ws + WS_WRT) + (size_t)l * NE * D);
              for (int i = tid; i < NE * D / 4; i += 512) ((LAS f32x4*)wT)[i] = src[i]; }
            for (int unit = bid; unit < T / 128; unit += G) {
                if (tid < 32) lcnt[tid] = 0;
                __syncthreads();
#pragma unroll 1
                for (int k = 0; k < 8; ++k) {
                    asm volatile("" ::: "memory");
                    const int tl0 = wave * 16 + 2 * k, t0 = unit * 128 + tl0;
                    float v[2][16];
#pragma unroll
                    for (int tk = 0; tk < 2; ++tk)
#pragma unroll
                        for (int i = 0; i < 4; ++i) { const u32x2 u2 = *(const u32x2*)(Y1B + (size_t)(t0 + tk) * D + i * 256 + lane * 4); v[tk][4 * i] = bf_lo(u2[0]); v[tk][4 * i + 1] = bf_hi(u2[0]); v[tk][4 * i + 2] = bf_lo(u2[1]); v[tk][4 * i + 3] = bf_hi(u2[1]); }
#pragma unroll
                    for (int tk = 0; tk < 2; ++tk) {
                        float s = 0.f;
#pragma unroll
                        for (int i = 0; i < 16; ++i) s += v[tk][i];
                        const float mean = wsum(s, lane) * (1.0f / 1024.0f);
                        float qv = 0.f;
#pragma unroll
                        for (int i = 0; i < 16; ++i) { const float d = v[tk][i] - mean; qv += d * d; }
                        const float rstd = rsqrtf(wsum(qv, lane) * (1.0f / 1024.0f) + EPS);
#pragma unroll
                        for (int i = 0; i < 4; ++i) {
                            const int c0 = i * 256 + lane * 4;
                            const f32x4 gg = *(const f32x4*)(g1 + c0), bb = *(const f32x4*)(b1 + c0);
#pragma unroll
                            for (int j = 0; j < 4; ++j) v[tk][4 * i + j] = (v[tk][4 * i + j] - mean) * rstd * gg[j] + bb[j];
                            *(u32x2*)(X1B + (size_t)(t0 + tk) * D + c0) = (u32x2){pk_bf16(v[tk][4 * i], v[tk][4 * i + 1]), pk_bf16(v[tk][4 * i + 2], v[tk][4 * i + 3])};
#if MOE_FP8
                            *(unsigned*)(ws + WS_X1Q + (size_t)(t0 + tk) * D + c0) = pk4_fp8(v[tk][4 * i] * X8_SCALE, v[tk][4 * i + 1] * X8_SCALE, v[tk][4 * i + 2] * X8_SCALE, v[tk][4 * i + 3] * X8_SCALE);
#endif
                        }
                    }
                    f32x2 part2[32];
#pragma unroll
                    for (int e = 0; e < 32; ++e) part2[e] = (f32x2){0.f, 0.f};
#pragma unroll
                    for (int i = 0; i < 4; ++i) {
                        f32x2 xv[4];
#pragma unroll
                        for (int j = 0; j < 4; ++j) xv[j] = (f32x2){v[0][4 * i + j], v[1][4 * i + j]};
#pragma unroll
                        for (int e = 0; e < 32; ++e) { const f32x4 w4 = *(const LAS f32x4*)(wT + e * 1024 + i * 256 + lane * 4);
#pragma unroll
                            for (int j = 0; j < 4; ++j) part2[e] = __builtin_elementwise_fma(xv[j], (f32x2){w4[j], w4[j]}, part2[e]);
                            if ((e & 3) == 3) __builtin_amdgcn_sched_barrier(0); }
                    }
                    float part[2][32];
#pragma unroll
                    for (int e = 0; e < 32; ++e) { part[0][e] = part2[e][0]; part[1][e] = part2[e][1]; }
#pragma unroll
                    for (int tk = 0; tk < 2; ++tk) {
                        float p16[16], p8[8], p4[4], p2[2], lg;
                        { const bool hi = (lane & 32) != 0;
#pragma unroll
                          for (int i = 0; i < 16; ++i) { const float keep = hi ? part[tk][i + 16] : part[tk][i], send = hi ? part[tk][i] : part[tk][i + 16]; p16[i] = keep + shx(send, 32, lane); } }
                        { const bool hi = (lane & 16) != 0;
#pragma unroll
                          for (int i = 0; i < 8; ++i) { const float keep = hi ? p16[i + 8] : p16[i], send = hi ? p16[i] : p16[i + 8]; p8[i] = keep + shx(send, 16, lane); } }
                        { const bool hi = (lane & 8) != 0;
#pragma unroll
                          for (int i = 0; i < 4; ++i) { const float keep = hi ? p8[i + 4] : p8[i], send = hi ? p8[i] : p8[i + 4]; p4[i] = keep + shx(send, 8, lane); } }
                        { const bool hi = (lane & 4) != 0;
#pragma unroll
                          for (int i = 0; i < 2; ++i) { const float keep = hi ? p4[i + 2] : p4[i], send = hi ? p4[i] : p4[i + 2]; p2[i] = keep + shx(send, 4, lane); } }
                        { const bool hi = (lane & 2) != 0; const float keep = hi ? p2[1] : p2[0], send = hi ? p2[0] : p2[1]; lg = keep + shx(send, 2, lane); }
                        lg += shx(lg, 1, lane);
                        lg += br[lane >> 1];
                        int be[4]; float bv[4];
#pragma unroll
                        for (int kk = 0; kk < 4; ++kk) {
                            const float mx = wmax(lg, lane);
                            const unsigned long long bal = __ballot(lg == mx);
                            const int e = (__ffsll((long long)bal) - 1) >> 1;
                            be[kk] = e; bv[kk] = mx;
                            if ((lane >> 1) == e) lg = -3e38f;
                        }
                        float ex[4], es = 0.f;
#pragma unroll
                        for (int kk = 0; kk < 4; ++kk) { ex[kk] = __expf(bv[kk] - bv[0]); es += ex[kk]; }
                        if (lane == 0) {
                            const int tl = tl0 + tk, t = t0 + tk;
#pragma unroll
                            for (int kk = 0; kk < 4; ++kk) { const int sl = __hip_atomic_fetch_add(&lcnt[be[kk]], 1, __ATOMIC_RELAXED, __HIP_MEMORY_SCOPE_WORKGROUP); asg_e[tl * 4 + kk] = be[kk]; asg_ls[tl * 4 + kk] = sl; GATE[t * 4 + kk] = ex[kk] / es; }
                        }
                    }
                }
                __syncthreads();
                if (tid < 32) lbase[tid] = (int)__hip_atomic_fetch_add(gcnt + tid, (unsigned)lcnt[tid], __ATOMIC_RELAXED, __HIP_MEMORY_SCOPE_AGENT);
                __syncthreads();
                { const int e = asg_e[tid], sl = lbase[e] + asg_ls[tid], t = unit * 128 + (tid >> 2);
                  TOKL[(size_t)e * T + sl] = t; ASGE[t * 4 + (tid & 3)] = e; ASGS[t * 4 + (tid & 3)] = sl; }
                __syncthreads();
            }
        }
        SEAM(pb + 4);
        LAS int* tstart = (LAS int*)(lds + LDS_TSTART); LAS int* lcntE = (LAS int*)(lds + LDS_CNT); LAS unsigned char* tile_e = lds + LDS_TILEE;
        if (IN(pb + 5) || IN(pb + 6) || IN(pb + 7)) {
            OPAQUE_IDS(); WSPTRS();
            if (tid < 32) lcntE[tid] = (int)__hip_atomic_load(ctl + CW_CNT + l * 64 + tid, __ATOMIC_RELAXED, __HIP_MEMORY_SCOPE_AGENT);
            __syncthreads();
            if (tid == 0) { int acc = 0; for (int e = 0; e < NE; ++e) { tstart[e] = acc; acc += (lcntE[e] + 255) >> 8; } tstart[32] = acc; }
            __syncthreads();
            for (int q = tid; q < MAXRT; q += 512) { int e = 0; for (int k = 0; k < NE; ++k) if (q >= tstart[k]) e = k; tile_e[q] = (unsigned char)e; }
            __syncthreads();
        }
        pg8::MoeTables tb{tstart, lcntE, tile_e, tstart[32]};
        if (IN(pb + 5)) PREP(7) {
            WSPTRS();
#if MOE_FP8
            pg8::MoeOrder S{tb, 8, G, bid, (const char*)Wgu + (size_t)l * NE * 2048 * 1024, (size_t)2048 * 1024, TOKL, true, 1024};
            pg8::EpiSwiglu<true> E{(void*)ACT, a.b_gu + (size_t)l * NE * 2048, 1.0f / (W8_SCALE * X8_SCALE)};
            pg8::gemm_phase<pg8::EpiSwiglu<true>, pg8::MoeOrder, true, 1>(lds + LDS_STAGE, (const bf16_t*)(ws + WS_X1Q), 1024, S, E, wave);
#else
            pg8::MoeOrder S{tb, 8, G, bid, (const char*)(Wgu + (size_t)l * NE * 2048 * 1024), (size_t)2048 * 1024 * 2, TOKL, true, 2048};
            pg8::EpiSwiglu<false> E{(void*)ACT, a.b_gu + (size_t)l * NE * 2048, 1.0f};
            pg8::gemm_phase<pg8::EpiSwiglu<false>, pg8::MoeOrder, true>(lds + LDS_STAGE, X1B, 1024, S, E, wave);
#endif
        }
        SEAM(pb + 5);
        if (IN(pb + 6)) PREP(8) {
            WSPTRS();
#if MOE_FP8
            pg8::MoeOrder S{tb, 4, G, bid, (const char*)Wdn + (size_t)l * NE * 1024 * 1024, (size_t)1024 * 1024, TOKL, false, 1024};
            pg8::EpiBiasBf16 E{YR, a.b_down + (size_t)l * NE * 1024, 1.0f / (W8_SCALE * A8_SCALE)};
            pg8::gemm_phase<pg8::EpiBiasBf16, pg8::MoeOrder, false, 1>(lds + LDS_STAGE, ACT, 1024, S, E, wave);
#else
            pg8::MoeOrder S{tb, 4, G, bid, (const char*)(Wdn + (size_t)l * NE * 1024 * 1024), (size_t)1024 * 1024 * 2, TOKL, false, 2048};
            pg8::EpiBiasBf16 E{YR, a.b_down + (size_t)l * NE * 1024, 1.0f};
            pg8::gemm_phase<pg8::EpiBiasBf16, pg8::MoeOrder, false>(lds + LDS_STAGE, ACT, 1024, S, E, wave);
#endif
        }
        SEAM(pb + 6);
        if (IN(pb + 7)) PREP(9) {
            OPAQUE_IDS(); WSPTRS();
            const float* g2 = a.ln2_g + l * D; const float* b2 = a.ln2_b + l * D;
            for (int t = gw; t < T; t += NGW) {
                float v[16];
#pragma unroll
                for (int i = 0; i < 4; ++i) { const u32x2 u2 = *(const u32x2*)(X1B + (size_t)t * D + i * 256 + lane * 4);
                    v[4 * i] = ALPHA * bf_lo(u2[0]); v[4 * i + 1] = ALPHA * bf_hi(u2[0]); v[4 * i + 2] = ALPHA * bf_lo(u2[1]); v[4 * i + 3] = ALPHA * bf_hi(u2[1]); }
#pragma unroll
                for (int k = 0; k < 4; ++k) {
                    const int e = ASGE[t * 4 + k]; const float gk = GATE[t * 4 + k];
                    const bf16_t* yp = YR + ((size_t)tstart[e] * 256 + ASGS[t * 4 + k]) * 1024;
#pragma unroll
                    for (int i = 0; i < 4; ++i) { const u32x2 u2 = *(const u32x2*)(yp + i * 256 + lane * 4);
                        v[4 * i] += gk * bf_lo(u2[0]); v[4 * i + 1] += gk * bf_hi(u2[0]); v[4 * i + 2] += gk * bf_lo(u2[1]); v[4 * i + 3] += gk * bf_hi(u2[1]); }
                }
                float s = 0.f;
#pragma unroll
                for (int i = 0; i < 16; ++i) s += v[i];
                const float mean = wsum(s, lane) * (1.0f / 1024.0f);
                float qv = 0.f;
#pragma unroll
                for (int i = 0; i < 16; ++i) { const float d = v[i] - mean; qv += d * d; }
                const float rstd = rsqrtf(wsum(qv, lane) * (1.0f / 1024.0f) + EPS);
#pragma unroll
                for (int i = 0; i < 4; ++i) {
                    const int c0 = i * 256 + lane * 4;
                    const f32x4 gg = *(const f32x4*)(g2 + c0), bb = *(const f32x4*)(b2 + c0);
                    float o[4];
#pragma unroll
                    for (int j = 0; j < 4; ++j) o[j] = (v[4 * i + j] - mean) * rstd * gg[j] + bb[j];
                    if (l == DEPTH - 1) *(f32x4*)(a.out + (size_t)t * D + c0) = (f32x4){o[0], o[1], o[2], o[3]};
                    else *(u32x2*)(XB + (size_t)t * D + c0) = (u32x2){pk_bf16(o[0], o[1]), pk_bf16(o[2], o[3])};
                }
            }
        }
        if (l + 1 < DEPTH) SEAM(pb + 7);
    }
#undef IN
#undef SEAM
}

extern "C" void kernel_launch(void* const* d_in, const int* in_sizes, int n_in, void* d_out, int out_size, void* d_ws, size_t ws_size, hipStream_t stream) {
    static int grid = 0;
    if (grid == 0) {
        if (ws_size < WS_END) { fprintf(stderr, "kernel_launch: workspace too small (%zu < %zu)\n", ws_size, (size_t)WS_END); grid = -1; return; }
        int dev = 0, cus = 0, per_cu = 0;
        if (hipGetDevice(&dev) != hipSuccess || hipDeviceGetAttribute(&cus, hipDeviceAttributeMultiprocessorCount, dev) != hipSuccess) { grid = -1; return; }
        if (hipFuncSetAttribute((const void*)mega, hipFuncAttributeMaxDynamicSharedMemorySize, LDS_BYTES) != hipSuccess) { fprintf(stderr, "kernel_launch: hipFuncSetAttribute failed\n"); grid = -1; return; }
        if (hipOccupancyMaxActiveBlocksPerMultiprocessor(&per_cu, (const void*)mega, 512, LDS_BYTES) != hipSuccess || per_cu < 1) { fprintf(stderr, "kernel_launch: occupancy query says %d\n", per_cu); }
        (void)hipGetLastError();
        grid = cus;
        if (grid % 8 != 0) grid -= grid % 8;
    }
    if (grid < 0) return;
    (void)hipMemsetAsync((char*)d_ws + WS_CTL, 0, CTL_BYTES, stream);
    Args a{};
    a.x = (const float*)d_in[0]; a.w_in = (const float*)d_in[1]; a.lam_q1 = (const float*)d_in[2]; a.lam_k1 = (const float*)d_in[3]; a.lam_q2 = (const float*)d_in[4]; a.lam_k2 = (const float*)d_in[5];
    a.subln_g = (const float*)d_in[6]; a.rel_bias = (const float*)d_in[7]; a.w_out = (const float*)d_in[8]; a.ln1_g = (const float*)d_in[9]; a.ln1_b = (const float*)d_in[10];
    a.w_router = (const float*)d_in[11]; a.b_router = (const float*)d_in[12]; a.w_gu = (const float*)d_in[13]; a.b_gu = (const float*)d_in[14]; a.w_down = (const float*)d_in[15];
    a.b_down = (const float*)d_in[16]; a.ln2_g = (const float*)d_in[17]; a.ln2_b = (const float*)d_in[18];
    a.out = (float*)d_out; a.ws = (unsigned char*)d_ws; a.pad = 0;
    a.ph_lo = 0; a.ph_hi = 1 + 8 * DEPTH; a.bar_region = 0;
    hipLaunchKernelGGL(mega, dim3(grid), dim3(512), LDS_BYTES, stream, a);
}
```

```cpp
#include <hip/hip_runtime.h>
#include <stdint.h>
#include <cstdio>

#define LAS __attribute__((address_space(3)))
typedef unsigned short bf16_t;
typedef _Float16 bf16x8 __attribute__((ext_vector_type(8)));
typedef float f32x4 __attribute__((ext_vector_type(4)));
typedef float f32x2 __attribute__((ext_vector_type(2)));
typedef unsigned u32x4 __attribute__((ext_vector_type(4)));
typedef unsigned u32x2 __attribute__((ext_vector_type(2)));
typedef _Float16 bf16v2 __attribute__((ext_vector_type(2)));

constexpr int D = 1024, BATCH = 16, SEQ = 2048, T = BATCH * SEQ, DEPTH = 4;
constexpr int DIN = 3368;
constexpr int NE = 32;
constexpr float ALPHA = 1.681792830507429f;
constexpr float EPS = 1e-5f;
constexpr float LOG2E = 1.4426950408889634f;
constexpr float QSCALE = 0.125f * LOG2E;
constexpr int HQP = 2560;
constexpr int HQ_QA = 0, HQ_KA = 512, HQ_QB = 1024, HQ_KB = 1280, HQ_QC = 1536, HQ_KC = 1792, HQ_QI = 2048, HQ_KI = 2304, HQ_WI = 2336, HQ_USED = 2344;
constexpr int VT_A = 0, VT_B = 512, VT_C = 768;
constexpr int NASG = T * 4;
constexpr int GROWS = NASG + NE * 256;
constexpr int MAXRT = GROWS / 256;

constexpr size_t MiB = (size_t)1 << 20;
constexpr size_t al(size_t x) { return (x + 255) & ~(size_t)255; }
constexpr size_t WS_CTL = 0, CTL_BYTES = 4 * MiB;
constexpr size_t WS_WIN = WS_CTL + CTL_BYTES;
constexpr size_t WS_WV = WS_WIN + al((size_t)DEPTH * HQP * D * 2);
constexpr size_t WS_WOUT = WS_WV + al((size_t)DEPTH * 1024 * D * 2);
constexpr size_t WS_WGU = WS_WOUT + al((size_t)DEPTH * D * 1024 * 2);
constexpr size_t WS_WDN = WS_WGU + al((size_t)DEPTH * NE * 2048 * D * 2);
constexpr size_t WS_XB = WS_WDN + al((size_t)DEPTH * NE * D * 1024 * 2);
constexpr size_t WS_HQ = WS_XB + al((size_t)T * D * 2);
constexpr size_t WS_VT = WS_HQ + al((size_t)T * HQP * 2);
constexpr size_t WS_MIX = WS_VT + al((size_t)1024 * T * 2);
constexpr size_t WS_Y1 = WS_MIX + al((size_t)T * 1024 * 2);
constexpr size_t WS_X1B = WS_Y1 + al((size_t)T * D * 2);
constexpr size_t WS_ACT = WS_X1B + al((size_t)T * D * 2);
constexpr size_t WS_YR = WS_ACT + al((size_t)GROWS * 1024 * 2);
constexpr size_t WS_MASK = WS_YR + al((size_t)GROWS * 1024 * 2);
constexpr size_t WS_TOKL = WS_MASK + al((size_t)T * 32 * 8);
constexpr size_t WS_ASGE = WS_TOKL + al((size_t)NE * T * 4);
constexpr size_t WS_ASGS = WS_ASGE + al((size_t)NASG * 4);
constexpr size_t WS_GATE = WS_ASGS + al((size_t)NASG * 4);
constexpr size_t WS_OA1 = WS_GATE + al((size_t)NASG * 4);
constexpr size_t WS_WRT = WS_OA1 + al((size_t)T * 512 * 4);
constexpr size_t WS_X1Q = WS_WRT + al((size_t)DEPTH * NE * D * 4);
constexpr size_t WS_END = WS_X1Q + al((size_t)T * D);
constexpr int CW_BAR = 4096;
constexpr int CW_CNT = 262144;

#ifndef MOE_FP8
#define MOE_FP8 1
#endif
constexpr int RTP = 2;
constexpr float W8_SCALE = 512.0f;
constexpr float X8_SCALE = 16.0f;
constexpr float A8_SCALE = 4.0f;
typedef int i32x8 __attribute__((ext_vector_type(8)));
__device__ __forceinline__ unsigned pk_bf16(float lo, float hi) { f32x2 v = {lo, hi}; return __builtin_bit_cast(unsigned, __builtin_convertvector(v, bf16v2)); }
__device__ __forceinline__ float clamp8(float x) { return __builtin_fminf(__builtin_fmaxf(x, -448.0f), 448.0f); }
__device__ __forceinline__ unsigned pk4_fp8(float a, float b, float c, float d) {
    int w = 0; w = __builtin_amdgcn_cvt_pk_fp8_f32(clamp8(a), clamp8(b), w, false); w = __builtin_amdgcn_cvt_pk_fp8_f32(clamp8(c), clamp8(d), w, true); return (unsigned)w; }
__device__ __forceinline__ float bf_lo(unsigned u) { return (float)__builtin_bit_cast(bf16v2, u)[0]; }
__device__ __forceinline__ float bf_hi(unsigned u) { return (float)__builtin_bit_cast(bf16v2, u)[1]; }
__device__ __forceinline__ float bf2f(bf16_t b) { return (float)__builtin_bit_cast(bf16v2, (unsigned)b)[0]; }
__device__ __forceinline__ float wave_sum(float v) {
#pragma unroll
    for (int o = 32; o > 0; o >>= 1) v += __shfl_xor(v, o);
    return v; }
__device__ __forceinline__ float wave_max(float v) {
#pragma unroll
    for (int o = 32; o > 0; o >>= 1) v = fmaxf(v, __shfl_xor(v, o));
    return v; }
__device__ __forceinline__ int wave_sum_i(int v) {
#pragma unroll
    for (int o = 32; o > 0; o >>= 1) v += __shfl_xor(v, o);
    return v; }

__device__ __forceinline__ float shx(float v, int o, int lane) { return __int_as_float(__builtin_amdgcn_ds_bpermute((lane ^ o) << 2, __float_as_int(v))); }
__device__ __forceinline__ float wsum(float v, int lane) {
#pragma unroll
    for (int o = 32; o > 0; o >>= 1) v += shx(v, o, lane);
    return v; }
__device__ __forceinline__ float wmax(float v, int lane) {
#pragma unroll
    for (int o = 32; o > 0; o >>= 1) v = fmaxf(v, shx(v, o, lane));
    return v; }

#define XB_TMO      128
#define XB_XCNT(j)  (256  + 64 * (j))
#define XB_XSUB(j)  (1280 + 64 * (j))
#define XB_XGEN(j)  (2304 + 64 * (j))
#define XB_TOP      3328
#define XB_TOPGEN   3392
#define XCD_BAR_WORDS 3456
#define XB_SPIN_CAP (1u << 22)
__device__ __forceinline__ unsigned xb_ld(unsigned* p)              { return __hip_atomic_load(p, __ATOMIC_RELAXED, __HIP_MEMORY_SCOPE_AGENT); }
__device__ __forceinline__ unsigned xb_add(unsigned* p, unsigned v) { return __hip_atomic_fetch_add(p, v, __ATOMIC_RELAXED, __HIP_MEMORY_SCOPE_AGENT); }
__device__ __forceinline__ unsigned xb_xcc_id() { return (unsigned)__builtin_amdgcn_s_getreg((3 << 11) | 20) & 0xFu; }
#define XB_SPIN(cond, bar) do { unsigned _sp = 0; while (cond) { __builtin_amdgcn_s_sleep(1); \
    if ((++_sp & 255u) == 0u) { if (xb_ld(&(bar)[XB_TMO])) break; if (_sp > XB_SPIN_CAP) { atomicAdd(&(bar)[XB_TMO], 1u); break; } } } } while (0)
struct XcdBarrier { unsigned* bar; unsigned x; volatile LAS unsigned* st; };
__device__ __forceinline__ XcdBarrier xcd_barrier_post(unsigned* bar, volatile LAS unsigned* st) {
    XcdBarrier b; b.bar = bar; b.x = xb_xcc_id(); b.st = st;
    if (threadIdx.x == 0) (void)xb_add(&bar[XB_XCNT(b.x)], 1u);
    return b;
}
__device__ __forceinline__ void xcd_barrier_complete(unsigned* bar, unsigned x, unsigned& nloc, unsigned& nx) {
    const unsigned G = gridDim.x * gridDim.y * gridDim.z;
    unsigned sum, cnt, mine, sp = 0u;
    for (;;) {
        sum = 0u; cnt = 0u; mine = 0u;
#pragma unroll
        for (unsigned j = 0; j < 16; ++j) { const unsigned c = xb_ld(&bar[XB_XCNT(j)]); sum += c; cnt += (c > 0u) ? 1u : 0u; mine = (j == x) ? c : mine; }
        if (sum == G) break;
        __builtin_amdgcn_s_sleep(1);
        if ((++sp & 255u) == 0u) { if (xb_ld(&bar[XB_TMO])) break; if (sp > XB_SPIN_CAP) { atomicAdd(&bar[XB_TMO], 1u); break; } }
    }
    nloc = mine > 0u ? mine : 1u; nx = cnt > 0u ? cnt : 1u;
}
__device__ __forceinline__ void xcd_barrier(const XcdBarrier& b) {
    asm volatile("s_waitcnt vmcnt(0)" ::: "memory");
    __syncthreads();
    if (threadIdx.x == 0) {
        unsigned* bar = b.bar;
        __builtin_amdgcn_s_waitcnt(0);
        unsigned nloc = b.st[0], nx = b.st[1];
        if (nloc == 0u) { xcd_barrier_complete(bar, b.x, nloc, nx); b.st[0] = nloc; b.st[1] = nx; }
        const unsigned old = xb_add(&bar[XB_XSUB(b.x)], 1u);
        const unsigned gen = old / nloc;
        if (old + 1u == (gen + 1u) * nloc) {
            __builtin_amdgcn_fence(__ATOMIC_RELEASE, "agent");
            asm volatile("s_waitcnt vmcnt(0)" ::: "memory");
            const unsigned og = xb_add(&bar[XB_TOP], 1u);
            const unsigned tg = og / nx;
            if (og + 1u == (tg + 1u) * nx) xb_add(&bar[XB_TOPGEN], 1u);
            else XB_SPIN(xb_ld(&bar[XB_TOPGEN]) == tg, bar);
            __builtin_amdgcn_fence(__ATOMIC_ACQUIRE, "agent");
            xb_add(&bar[XB_XGEN(b.x)], 1u);
            asm volatile("s_waitcnt vmcnt(0)" ::: "memory");
        } else {
            XB_SPIN(xb_ld(&bar[XB_XGEN(b.x)]) == gen, bar);
            __builtin_amdgcn_fence(__ATOMIC_ACQUIRE, "agent");
            asm volatile("s_waitcnt vmcnt(0)" ::: "memory");
        }
    }
    __syncthreads();
}

namespace pg8 {
constexpr int BM = 256, BK = 64, HALF = 128, HTB = HALF * BK * 2, STAGE_BYTES = 8 * HTB;
__host__ __device__ __forceinline__ int lds_byte(int r, int c) { const int st = (r >> 4) * 2 + (c >> 5), rr = r & 15, cc = c & 31, ob = rr * 64 + cc * 2; return st * 1024 + (ob ^ (((ob >> 9) & 1) << 5)); }
__host__ __device__ __forceinline__ void stage_rc(int b, int& R, int& C) { const int st = b / 1024, sb = b % 1024, swz = sb ^ (((sb >> 9) & 1) << 5); R = (st >> 1) * 16 + swz / 64; C = (st & 1) * 32 + (swz % 64) / 2; }
__host__ __device__ __forceinline__ int perm32(int rho) { const int n = rho >> 4, i = rho & 15; return 8 * (i >> 2) + 4 * n + (i & 3); }

struct Unit {
    int row0;
    int col0;
    const char* Bt;
    const int* rows;
    int nvalid;
    int e;
};

template <class Epi, class Sched, bool GATHER, int ESZ = 2>
__device__ __forceinline__ void gemm_phase(LAS unsigned char* lds, const bf16_t* Abase, const int K, const Sched& S, const Epi& E, const int wid_in) {
    int wid = wid_in; asm volatile("" : "+s"(wid));
    int lane; asm volatile("v_mbcnt_lo_u32_b32 %0, -1, 0\n\tv_mbcnt_hi_u32_b32 %0, -1, %0" : "=&v"(lane));
    const int tid = wid * 64 + lane, wr = wid >> 2, wc = wid & 3, fr = lane & 15, fq = lane >> 4;
    const int nt = K * ESZ / 128;
    unsigned voffB[2];
#pragma unroll
    for (int i = 0; i < 2; ++i) { int R, C; stage_rc(tid * 16 + i * 8192, R, C); const int Rb = Epi::PERM ? ((R & ~31) + perm32(R & 31)) : R; voffB[i] = (unsigned)(Rb * K * ESZ + C * 2); }
    const size_t kstep = (size_t)(BK * 2);
    const size_t hstep = (size_t)HALF * K * ESZ;
    const unsigned ldsw = (unsigned)wid * 1024u;
    const int aoff = lds_byte(wr * 64 + fr, fq * 8), boff = lds_byte(wc * 32 + fr, fq * 8);
#define PG8_SA(b, h) (((b) * 2 + (h)) * HTB)
#define PG8_SB(b, h) ((4 + (b) * 2 + (h)) * HTB)
#define PG8_STAGE(bufoff, gbase, voff) do { _Pragma("unroll") for (int _i = 0; _i < 2; ++_i) \
        __builtin_amdgcn_global_load_lds((const unsigned*)((const char*)(gbase) + (voff)[_i]), (LAS unsigned*)(lds + (bufoff) + ldsw + _i * 8192), 16, 0, 0); } while (0)
#define PG8_LDA(dst, b, h) do { _Pragma("unroll") for (int m = 0; m < 4; ++m) _Pragma("unroll") for (int k = 0; k < 2; ++k) dst[m][k] = *(const LAS bf16x8*)(lds + PG8_SA(b, h) + aoff + m * 2048 + k * 1024); } while (0)
#define PG8_LDB(dst, b, h) do { _Pragma("unroll") for (int n = 0; n < 2; ++n) _Pragma("unroll") for (int k = 0; k < 2; ++k) dst[n][k] = *(const LAS bf16x8*)(lds + PG8_SB(b, h) + boff + n * 2048 + k * 1024); } while (0)
#define PG8_MMA(ai, bj, At, Bt) do { __builtin_amdgcn_s_setprio(1); _Pragma("unroll") for (int m = 0; m < 4; ++m) _Pragma("unroll") for (int n = 0; n < 2; ++n) { \
        if constexpr (ESZ == 2) { _Pragma("unroll") for (int k = 0; k < 2; ++k) acc[ai][bj][m][n] = __builtin_amdgcn_mfma_f32_16x16x32_f16(Bt[n][k], At[m][k], acc[ai][bj][m][n], 0, 0, 0); } \
        else {   \
            const u32x4 _a0 = __builtin_bit_cast(u32x4, At[m][0]), _a1 = __builtin_bit_cast(u32x4, At[m][1]), _b0 = __builtin_bit_cast(u32x4, Bt[n][0]), _b1 = __builtin_bit_cast(u32x4, Bt[n][1]); \
            const i32x8 _af = {(int)_a0[0], (int)_a0[1], (int)_a0[2], (int)_a0[3], (int)_a1[0], (int)_a1[1], (int)_a1[2], (int)_a1[3]}; \
            const i32x8 _bf = {(int)_b0[0], (int)_b0[1], (int)_b0[2], (int)_b0[3], (int)_b1[0], (int)_b1[1], (int)_b1[2], (int)_b1[3]}; \
              \
            asm volatile("v_mfma_scale_f32_16x16x128_f8f6f4 %0, %1, %2, %0, %3, %3 op_sel_hi:[0,0,0]" : "+v"(acc[ai][bj][m][n]) : "v"(_bf), "v"(_af), "v"(s8)); } } \
        __builtin_amdgcn_s_setprio(0); } while (0)
#define PG8_WAIT_V(n) asm volatile("s_waitcnt vmcnt(" #n ")" ::: "memory")
#define PG8_WAIT_L(n) asm volatile("s_waitcnt lgkmcnt(" #n ")" ::: "memory")
#define PG8_BAR __builtin_amdgcn_s_barrier()
#define PG8_SCHED __builtin_amdgcn_sched_barrier(0)
#define PG8_AOFFS(dst, u) do { _Pragma("unroll") for (int _h = 0; _h < 2; ++_h) _Pragma("unroll") for (int _i = 0; _i < 2; ++_i) { int _R, _C; stage_rc(tid * 16 + _i * 8192, _R, _C); \
        const int _r = _h * HALF + _R; const int _src = (_r < (u).nvalid) ? (u).rows[_r] : 0; dst[_h][_i] = (unsigned)(_src * K * ESZ + _C * 2); } } while (0)
#define PG8_RAWLOAD(dst, u) do { _Pragma("unroll") for (int _h = 0; _h < 2; ++_h) _Pragma("unroll") for (int _i = 0; _i < 2; ++_i) { int _R, _C; stage_rc(tid * 16 + _i * 8192, _R, _C); \
        const int _r = _h * HALF + _R; dst[_h][_i] = (_r < (u).nvalid) ? (u).rows[_r] : 0; } } while (0)
#define PG8_STAGE_A(bufoff, h, ktb, usenext) do { if constexpr (GATHER) { const unsigned _o[2] = {(usenext) ? na[h][0] : oa[h][0], (usenext) ? na[h][1] : oa[h][1]}; PG8_STAGE(bufoff, cA + (ktb), _o); } \
        else { PG8_STAGE(bufoff, ((usenext) ? nA : cA) + (size_t)(h) * hstep + (ktb), voffA); } } while (0)
    Unit cur, nxt; int ui = 0;
    if (!S.next(0, cur)) return;
    f32x4 acc[2][2][4][2];
#pragma unroll
    for (int a = 0; a < 2; ++a)
#pragma unroll
        for (int b = 0; b < 2; ++b)
#pragma unroll
            for (int m = 0; m < 4; ++m)
#pragma unroll
                for (int n = 0; n < 2; ++n) acc[a][b][m][n] = (f32x4){0.f, 0.f, 0.f, 0.f};
    bf16x8 At[4][2], B0[2][2], B1[2][2];
    int s8 = 0x7F7F7F7F; asm volatile("" : "+v"(s8));
    unsigned oa[2][2], na[2][2], voffA[2];
    const char* cA; const char* nA; const char* cB = cur.Bt;
    int raw[2][2] = {{0, 0}, {0, 0}};
    if constexpr (GATHER) { PG8_AOFFS(oa, cur); cA = (const char*)Abase; nA = cA; voffA[0] = voffA[1] = 0u; if (S.next(1, nxt)) { PG8_RAWLOAD(raw, nxt); } }
    else { cA = (const char*)Abase + (size_t)cur.row0 * K * ESZ; nA = cA;
#pragma unroll
        for (int i = 0; i < 2; ++i) { int R, C; stage_rc(tid * 16 + i * 8192, R, C); voffA[i] = (unsigned)(R * K * ESZ + C * 2); oa[0][i] = oa[1][i] = na[0][i] = na[1][i] = 0u; } }
    PG8_STAGE(PG8_SB(0, 0), cB, voffB); PG8_STAGE(PG8_SB(0, 1), cB + hstep, voffB); PG8_STAGE_A(PG8_SA(0, 0), 0, 0, false); PG8_STAGE_A(PG8_SA(0, 1), 1, 0, false);
    if (wr == 1) PG8_BAR;
    PG8_WAIT_V(2); PG8_BAR;
    PG8_STAGE(PG8_SB(1, 0), cB + kstep, voffB); PG8_STAGE_A(PG8_SA(1, 0), 0, kstep, false); PG8_STAGE(PG8_SB(1, 1), cB + hstep + kstep, voffB);
    PG8_WAIT_V(6); PG8_BAR;
    for (;;) {
        const bool has_next = S.next(ui + 1, nxt);
        if constexpr (GATHER) {
            if (has_next) {
#pragma unroll
                for (int h = 0; h < 2; ++h)
#pragma unroll
                    for (int i = 0; i < 2; ++i) { int R, C; stage_rc(tid * 16 + i * 8192, R, C); na[h][i] = (unsigned)(raw[h][i] * K * ESZ + C * 2); }
                asm volatile("" : "+v"(na[0][0]), "+v"(na[0][1]), "+v"(na[1][0]), "+v"(na[1][1]));
            } else {
#pragma unroll
                for (int h = 0; h < 2; ++h)
#pragma unroll
                    for (int i = 0; i < 2; ++i) na[h][i] = oa[h][i];
            }
            Unit n2;
            if (has_next && S.next(ui + 2, n2)) { PG8_RAWLOAD(raw, n2); }
        } else nA = has_next ? (const char*)Abase + (size_t)nxt.row0 * K * ESZ : cA;
        const char* nB = has_next ? nxt.Bt : cB;
#pragma unroll 1
        for (int t = 0; t < nt; t += 2) {
            const bool last = (t == nt - 2);
            const size_t k1 = (size_t)(t + 1) * kstep, k2 = last ? 0 : (size_t)(t + 2) * kstep, k3 = k2 + kstep;
            const char* b2 = last ? nB : cB + (size_t)(t + 2) * kstep; const char* b3 = b2 + kstep;
            PG8_LDB(B0, 0, 0); PG8_LDB(B1, 0, 1); PG8_SCHED; PG8_LDA(At, 0, 0); PG8_STAGE_A(PG8_SA(1, 1), 1, k1, false);
            PG8_WAIT_V(8); PG8_WAIT_L(0); PG8_BAR; PG8_MMA(0, 0, At, B0); PG8_MMA(0, 1, At, B1); PG8_BAR; PG8_SCHED;
            PG8_LDA(At, 0, 1); PG8_STAGE(PG8_SB(0, 0), b2, voffB); PG8_STAGE(PG8_SB(0, 1), b2 + hstep, voffB); PG8_STAGE_A(PG8_SA(0, 0), 0, k2, last);
            PG8_WAIT_V(8); PG8_WAIT_L(0); PG8_BAR; PG8_MMA(1, 0, At, B0); PG8_MMA(1, 1, At, B1); PG8_BAR; PG8_SCHED;
            PG8_LDB(B0, 1, 0); PG8_LDB(B1, 1, 1); PG8_SCHED; PG8_LDA(At, 1, 0); PG8_STAGE_A(PG8_SA(0, 1), 1, k2, last);
            PG8_WAIT_V(8); PG8_WAIT_L(0); PG8_BAR; PG8_MMA(0, 0, At, B0); PG8_MMA(0, 1, At, B1); PG8_BAR; PG8_SCHED;
            PG8_LDA(At, 1, 1); PG8_STAGE(PG8_SB(1, 0), b3, voffB); PG8_STAGE(PG8_SB(1, 1), b3 + hstep, voffB); PG8_STAGE_A(PG8_SA(1, 0), 0, k3, last);
            PG8_WAIT_V(8); PG8_WAIT_L(0); PG8_BAR; PG8_MMA(1, 0, At, B0); PG8_MMA(1, 1, At, B1); PG8_BAR; PG8_SCHED;
        }
        if constexpr (ESZ == 1) asm volatile("s_nop 15\n\ts_nop 15" ::: "memory");
        if (wr == 0) PG8_BAR;
        E(acc, cur, wr, wc, fr, fq);
        if (!has_next) break;
#pragma unroll
        for (int a = 0; a < 2; ++a)
#pragma unroll
            for (int b = 0; b < 2; ++b)
#pragma unroll
                for (int m = 0; m < 4; ++m)
#pragma unroll
                    for (int n = 0; n < 2; ++n) acc[a][b][m][n] = (f32x4){0.f, 0.f, 0.f, 0.f};
        cur = nxt; cB = nB; ++ui;
        if constexpr (GATHER) {
#pragma unroll
            for (int h = 0; h < 2; ++h)
#pragma unroll
                for (int i = 0; i < 2; ++i) oa[h][i] = na[h][i];
        } else cA = nA;
        if (wr == 1) PG8_BAR;
    }
    PG8_WAIT_V(0);
    PG8_BAR;
#undef PG8_SA
#undef PG8_SB
#undef PG8_STAGE
#undef PG8_LDA
#undef PG8_LDB
#undef PG8_MMA
#undef PG8_WAIT_V
#undef PG8_WAIT_L
#undef PG8_BAR
#undef PG8_SCHED
#undef PG8_AOFFS
#undef PG8_RAWLOAD
#undef PG8_STAGE_A
}

struct DenseOrder {
    int nRT, nN, G, c; const char* Bt; int K; bool swap;
    __device__ __forceinline__ bool next(int i, Unit& u) const {
        const int xcd = c & 7, s = i * (G >> 3) + (c >> 3);
        int rt, pn;
        if (!swap) { rt = 8 * (s / nN) + xcd; pn = s % nN; } else { pn = 8 * (s / nRT) + xcd; rt = s % nRT; }
        if (rt >= nRT || pn >= nN) return false;
        u.row0 = rt * BM; u.col0 = pn * BM; u.Bt = Bt + (size_t)pn * BM * K * 2; u.rows = nullptr; u.nvalid = 0; u.e = 0; return true;
    }
};
struct MoeTables { LAS const int* tstart; LAS const int* cnt; LAS const unsigned char* tile_e; int nrt; };
struct MoeOrder {
    MoeTables tb; int nN, G, c; const char* Bt; size_t strideB; const int* tokl; bool gather; int rowb;
    __device__ __forceinline__ bool next(int i, Unit& u) const {
        const int xcd = c & 7, s = i * (G >> 3) + (c >> 3);
        const int q = 8 * (s / nN) + xcd, pn = s % nN;
        if (q >= tb.nrt) return false;
        const int e = tb.tile_e[q]; const int lt = q - tb.tstart[e];
        u.row0 = q * BM; u.col0 = pn * BM; u.e = e; u.Bt = Bt + (size_t)e * strideB + (size_t)pn * BM * rowb;
        u.rows = gather ? tokl + (size_t)e * T + lt * BM : nullptr; u.nvalid = tb.cnt[e] - lt * BM; return true;
    }
};

struct EpiBf16Plain {
    static constexpr bool PERM = true;
    bf16_t* O; int ldc;
    __device__ __forceinline__ void operator()(const f32x4 (&acc)[2][2][4][2], const Unit& u, int wr, int wc, int fr, int fq) const {
        const int row0 = u.row0 + wr * 64 + fr, col0 = u.col0 + wc * 32 + 8 * fq;
#pragma unroll
        for (int ai = 0; ai < 2; ++ai)
#pragma unroll
            for (int m = 0; m < 4; ++m) { bf16_t* rowp = O + (size_t)(row0 + ai * HALF + m * 16) * ldc + col0;
#pragma unroll
                for (int bj = 0; bj < 2; ++bj) { const f32x4 v0 = acc[ai][bj][m][0], v1 = acc[ai][bj][m][1];
                    u32x4 w; w.x = pk_bf16(v0[0], v0[1]); w.y = pk_bf16(v0[2], v0[3]); w.z = pk_bf16(v1[0], v1[1]); w.w = pk_bf16(v1[2], v1[3]);
                    *(u32x4*)(rowp + bj * HALF) = w; } }
    }
};
struct EpiResBf16 {
    static constexpr bool PERM = true;
    bf16_t* O; const bf16_t* R;
    __device__ __forceinline__ void operator()(const f32x4 (&acc)[2][2][4][2], const Unit& u, int wr, int wc, int fr, int fq) const {
        const int row0 = u.row0 + wr * 64 + fr, col0 = u.col0 + wc * 32 + 8 * fq;
#pragma unroll
        for (int ai = 0; ai < 2; ++ai)
#pragma unroll
            for (int m = 0; m < 4; ++m) { const size_t off = (size_t)(row0 + ai * HALF + m * 16) * 1024 + col0;
#pragma unroll
                for (int bj = 0; bj < 2; ++bj) { const u32x4 r = *(const u32x4*)(R + off + bj * HALF); const f32x4 v0 = acc[ai][bj][m][0], v1 = acc[ai][bj][m][1];
                    u32x4 w; w.x = pk_bf16(bf_lo(r[0]) * ALPHA + v0[0], bf_hi(r[0]) * ALPHA + v0[1]); w.y = pk_bf16(bf_lo(r[1]) * ALPHA + v0[2], bf_hi(r[1]) * ALPHA + v0[3]);
                    w.z = pk_bf16(bf_lo(r[2]) * ALPHA + v1[0], bf_hi(r[2]) * ALPHA + v1[1]); w.w = pk_bf16(bf_lo(r[3]) * ALPHA + v1[2], bf_hi(r[3]) * ALPHA + v1[3]);
                    *(u32x4*)(O + off + bj * HALF) = w; } }
    }
};
template <bool F8> struct EpiSwiglu {
    static constexpr bool PERM = true;
    void* Ov; const float* bias; float ascale;
    __device__ __forceinline__ void operator()(const f32x4 (&acc)[2][2][4][2], const Unit& u, int wr, int wc, int fr, int fq) const {
        const int row0 = u.row0 + wr * 64 + fr, oc = (u.col0 >> 1) + wc * 32 + 8 * fq;
        const float* bp = bias + (size_t)u.e * 2048 + oc;
        f32x4 bg[2], bu[2];
#pragma unroll
        for (int n = 0; n < 2; ++n) { bg[n] = *(const f32x4*)(bp + 4 * n); bu[n] = *(const f32x4*)(bp + 1024 + 4 * n); }
#pragma unroll
        for (int ai = 0; ai < 2; ++ai)
#pragma unroll
            for (int m = 0; m < 4; ++m) {
                float o[8];
#pragma unroll
                for (int n = 0; n < 2; ++n) { const f32x4 g4 = acc[ai][0][m][n] * ascale + bg[n], u4 = acc[ai][1][m][n] * ascale + bu[n];
#pragma unroll
                    for (int j = 0; j < 4; ++j) { const float g = fminf(g4[j], 7.0f), up = fminf(fmaxf(u4[j], -7.0f), 7.0f);
                        const float glu = g * __builtin_amdgcn_rcpf(1.0f + __builtin_amdgcn_exp2f(-1.702f * LOG2E * g)); o[4 * n + j] = (up + 1.0f) * glu; } }
                if constexpr (F8) { *(u32x2*)((unsigned char*)Ov + (size_t)(row0 + ai * HALF + m * 16) * 1024 + oc) = (u32x2){pk4_fp8(o[0] * A8_SCALE, o[1] * A8_SCALE, o[2] * A8_SCALE, o[3] * A8_SCALE), pk4_fp8(o[4] * A8_SCALE, o[5] * A8_SCALE, o[6] * A8_SCALE, o[7] * A8_SCALE)}; }
                else { u32x4 w; w.x = pk_bf16(o[0], o[1]); w.y = pk_bf16(o[2], o[3]); w.z = pk_bf16(o[4], o[5]); w.w = pk_bf16(o[6], o[7]);
                    *(u32x4*)((bf16_t*)Ov + (size_t)(row0 + ai * HALF + m * 16) * 1024 + oc) = w; } }
    }
};
struct EpiBiasBf16 {
    static constexpr bool PERM = true;
    bf16_t* O; const float* bias; float ascale;
    __device__ __forceinline__ void operator()(const f32x4 (&acc)[2][2][4][2], const Unit& u, int wr, int wc, int fr, int fq) const {
        const int row0 = u.row0 + wr * 64 + fr, col0 = u.col0 + wc * 32 + 8 * fq;
        const float* bp = bias + (size_t)u.e * 1024 + col0;
        f32x4 bv[2][2];
#pragma unroll
        for (int bj = 0; bj < 2; ++bj)
#pragma unroll
            for (int n = 0; n < 2; ++n) bv[bj][n] = *(const f32x4*)(bp + bj * HALF + 4 * n);
#pragma unroll
        for (int ai = 0; ai < 2; ++ai)
#pragma unroll
            for (int m = 0; m < 4; ++m) { bf16_t* rowp = O + (size_t)(row0 + ai * HALF + m * 16) * 1024 + col0;
#pragma unroll
                for (int bj = 0; bj < 2; ++bj) { const f32x4 v0 = acc[ai][bj][m][0] * ascale + bv[bj][0], v1 = acc[ai][bj][m][1] * ascale + bv[bj][1];
                    u32x4 w; w.x = pk_bf16(v0[0], v0[1]); w.y = pk_bf16(v0[2], v0[3]); w.z = pk_bf16(v1[0], v1[1]); w.w = pk_bf16(v1[2], v1[3]);
                    *(u32x4*)(rowp + bj * HALF) = w; } }
    }
};
}


#ifndef ATT_EN
#define ATT_EN 7
#endif
#ifndef PROBE
#define PROBE (-1)
#endif
#define PREP(k) _Pragma("unroll 1") for (int _rp = ((PROBE == (k)) ? 0 : 1); _rp < 2; ++_rp)
typedef float f32x16 __attribute__((ext_vector_type(16)));
#define MFMA32(a, b, c) __builtin_amdgcn_mfma_f32_32x32x16_f16((a), (b), (c), 0, 0, 0)
constexpr float ATT_THR = 8.0f;
constexpr int ATT_KB = 8192;
#define NEG_INF_F (-__builtin_huge_valf())

template <int MODE>
__device__ __forceinline__ void attn_unit(LAS unsigned char* lds, const bf16_t* HQ, const bf16_t* VT, bf16_t* MIX, const unsigned long long* MASK, float* OA1,
                                          const int b, const int h, const int qt, const int wave_in, const int lane_unused,
                                          const float lam, const float lam_init, const float* subg, const float* relb) {
    int wave = wave_in; asm volatile("" : "+s"(wave));
    constexpr int NPASS = (MODE == 0) ? 2 : 1;
    constexpr int EB = (MODE == 0) ? 4 : 2;
    constexpr int NLV = EB / 2;
    constexpr int SLOTB = ATT_KB + EB * 32 * 128;
    constexpr int XOFF = 3 * SLOTB;
    const int qoff = (MODE == 0) ? HQ_QA + h * 128 : (MODE == 1) ? HQ_QB + h * 64 : HQ_QC + h * 64;
    const int koff = (MODE == 0) ? HQ_KA + h * 128 : (MODE == 1) ? HQ_KB + h * 64 : HQ_KC + h * 64;
    const int vrow0 = (MODE == 0) ? VT_A + h * 128 : (MODE == 1) ? VT_B + h * 64 : VT_C + h * 64;
    const int mixcol = (MODE == 0) ? h * 128 : (MODE == 1) ? 512 + h * 64 : 768 + h * 64;
    int lane; asm volatile("v_mbcnt_lo_u32_b32 %0, -1, 0\n\tv_mbcnt_hi_u32_b32 %0, -1, %0" : "=&v"(lane));
    const int tid = wave * 64 + lane, ql = lane & 31, hb = lane >> 5;
    const int cq = qt * 4 + (wave >> 1);
    const int tq = qt * 256 + wave * 32 + ql;
    const int kt_hi = qt * 4 + 3;
    const int kt_lo = (MODE == 1) ? ((qt * 4 - 8) > 0 ? (qt * 4 - 8) : 0) : 0;
    const int ntile = kt_hi - kt_lo + 1;
    const float slope2 = (MODE == 0) ? exp2f(-(float)(2 * h + 1)) * LOG2E : exp2f(-(float)(2 * h + 2)) * LOG2E;
    LAS float* relb_l = (LAS float*)(lds + XOFF);
    float so[16];
#pragma unroll
    for (int i = 0; i < 16; ++i) { int oi = 16 * (i >> 3) + (i & 7); asm volatile("" : "+s"(oi));
        so[i] = __int_as_float(__builtin_amdgcn_readfirstlane(__float_as_int(slope2 * (float)oi))); }
    const int prow = (ql & 16) | ((ql & 4) << 1) | ((ql & 8) >> 1) | (ql & 3);
    const int kt_x = (hb ^ ((prow >> 1) & 7)) << 4, vt_x = (hb ^ ((ql >> 1) & 7)) << 4;
    const int krd = prow * 128, vrd = ATT_KB + ql * 128;
    const int drow = lane >> 3, dpos = lane & 7;
    const int krow_g = 8 * wave + drow;
    const size_t ksrc = ((size_t)(b * SEQ + krow_g) * HQP + koff + ((dpos ^ ((krow_g >> 1) & 7)) << 3)) * 2;
    size_t vsrc[NLV];
#pragma unroll
    for (int j = 0; j < NLV; ++j) { const int vr = 8 * (wave + 8 * j) + drow; vsrc[j] = ((size_t)(vrow0 + vr) * T + (size_t)b * SEQ + ((dpos ^ ((vr >> 1) & 7)) << 3)) * 2; }

#pragma unroll 1
    for (int mp = 0; mp < NPASS; ++mp) {
#define ATT_ISSUE(kt_, slot_) do { \
        __builtin_amdgcn_global_load_lds((const unsigned*)((const char*)HQ + ksrc + (size_t)(kt_) * (64 * HQP * 2) + mp * 128), (LAS unsigned*)(lds + (slot_) * SLOTB + wave * 1024), 16, 0, 0); \
        _Pragma("unroll") for (int j = 0; j < NLV; ++j) \
            __builtin_amdgcn_global_load_lds((const unsigned*)((const char*)VT + vsrc[j] + (size_t)(kt_) * 128), (LAS unsigned*)(lds + (slot_) * SLOTB + ATT_KB + (wave + 8 * j) * 1024), 16, 0, 0); } while (0)
        asm volatile("s_waitcnt vmcnt(0)" ::: "memory");
        __syncthreads();
        ATT_ISSUE(kt_hi, 0);
        ATT_ISSUE((ntile > 1 ? kt_hi - 1 : kt_hi), 1);
        if (MODE == 1 && mp == 0) { for (int i = tid; i < 257; i += 512) relb_l[i] = relb[i] * LOG2E; }
        if (MODE == 2) {
#pragma unroll
            for (int i = 0; i < 8; ++i) { const int q = wave * 32 + i * 4 + (lane >> 4), p = lane & 15;
                __builtin_amdgcn_global_load_lds((const unsigned*)((const char*)MASK + ((size_t)(b * SEQ + qt * 256 + q) * 32 + (((p - q) & 15) << 1)) * 8),
                                                 (LAS unsigned*)(lds + XOFF + (wave * 32 + i * 4) * 256), 16, 0, 0); }
        }
        bf16x8 Q[4];
        { const bf16_t* qp = HQ + (size_t)(b * SEQ + tq) * HQP + qoff + mp * 64 + hb * 8;
#pragma unroll
          for (int ks = 0; ks < 4; ++ks) Q[ks] = *(const bf16x8*)(qp + ks * 16); }
        asm volatile("" : "+v"(Q[0]), "+v"(Q[1]), "+v"(Q[2]), "+v"(Q[3]));
        f32x16 O[EB];
        float mref = 0.f, seen = 0.f, lrun = 0.f;
#pragma unroll
        for (int eb = 0; eb < EB; ++eb)
#pragma unroll
            for (int i = 0; i < 16; ++i) O[eb][i] = 0.f;
        asm volatile("s_waitcnt lgkmcnt(0)" ::: "memory");
        int slot = 0;
        for (int jt = 0; jt < ntile; ++jt) {
            const int kt = kt_hi - jt;
            if constexpr (MODE == 0) asm volatile("s_waitcnt vmcnt(3)" ::: "memory"); else asm volatile("s_waitcnt vmcnt(2)" ::: "memory");
            __builtin_amdgcn_s_barrier();
            { const int nj = jt + 2 < ntile ? jt + 2 : ntile - 1; int ns = slot + 2; ns = ns >= 3 ? ns - 3 : ns; ATT_ISSUE(kt_hi - nj, ns); }
            const bool active = (kt <= cq) && (MODE != 1 || kt >= cq - 8);
            if (active) {
                const LAS unsigned char* kbp = lds + slot * SLOTB + krd;
                const LAS unsigned char* vbp = lds + slot * SLOTB + vrd;
                f32x16 S0, S1;
                if (MODE == 0 || MODE == 2) {
                    const float base0 = (float)(tq - kt * 64 - 8 * hb);
                    if (kt == cq) {
#pragma unroll
                        for (int i = 0; i < 16; ++i) { const float off = (float)(16 * (i >> 3) + (i & 7));
                            S0[i] = -slope2 * fabsf(base0 - off) - mref; S1[i] = -slope2 * fabsf(base0 - 32.0f - off) - mref; }
                    } else {
                        const float c0 = -slope2 * base0 - mref, c1 = c0 + 32.0f * slope2;
#pragma unroll
                        for (int i = 0; i < 16; ++i) { S0[i] = so[i] + c0; S1[i] = so[i] + c1; }
                    }
                }
                if (MODE == 2) {
                    const int mq = wave * 32 + ql; const unsigned long long W = *(const LAS unsigned long long*)(lds + XOFF + mq * 256 + ((((kt >> 1) + mq) & 15) << 4) + ((kt & 1) << 3));
                    const unsigned w0 = (unsigned)W >> (8 * hb), w1 = (unsigned)(W >> 32) >> (8 * hb);
#pragma unroll
                    for (int i = 0; i < 16; ++i) { const int off = 16 * (i >> 3) + (i & 7);
                        S0[i] = ((w0 >> off) & 1u) ? S0[i] : NEG_INF_F; S1[i] = ((w1 >> off) & 1u) ? S1[i] : NEG_INF_F; }
                }
                if (MODE == 1) {
                    if (kt >= cq - 2) {
                        const int rel0 = tq - kt * 64 - 8 * hb + 128;
#pragma unroll
                        for (int i = 0; i < 16; ++i) { const int off = 16 * (i >> 3) + (i & 7);
                            int r0 = rel0 - off, r1 = rel0 - 32 - off;
                            r0 = r0 < 0 ? 0 : (r0 > 256 ? 256 : r0); r1 = r1 < 0 ? 0 : (r1 > 256 ? 256 : r1);
                            S0[i] = relb_l[r0] - mref; S1[i] = relb_l[r1] - mref; }
                    } else {
                        const float far = relb_l[256] - mref;
#pragma unroll
                        for (int i = 0; i < 16; ++i) { S0[i] = far; S1[i] = far; }
                    }
                }
#pragma unroll
                for (int ks = 0; ks < 4; ++ks) {
                    const bf16x8 k0 = *(const LAS bf16x8*)(kbp + ((ks << 5) ^ kt_x));
                    const bf16x8 k1 = *(const LAS bf16x8*)(kbp + 4096 + ((ks << 5) ^ kt_x));
                    S0 = MFMA32(k0, Q[ks], S0); S1 = MFMA32(k1, Q[ks], S1);
                    if (ks & 1) __builtin_amdgcn_sched_barrier(0);
                }
                float mx = fmaxf(S0[0], S1[0]);
#pragma unroll
                for (int i = 1; i < 16; ++i) mx = fmaxf(mx, fmaxf(S0[i], S1[i]));
                mx = fmaxf(mx, shx(mx, 32, lane));
                const bool unseen = !(seen > 0.f), finite = mx > -1e30f;
                const bool need = unseen ? finite : (mx > ATT_THR);
                if (__ballot(unseen ? finite : (mx >= -150.0f)) != 0ull) {
                    if (__ballot(need) != 0ull) {
                        const float d = need ? mx : 0.f;
                        mref += d; seen = (unseen && finite) ? 1.f : seen;
                        const float alpha = __builtin_amdgcn_exp2f(-d);
                        lrun *= alpha;
#pragma unroll
                        for (int eb = 0; eb < EB; ++eb) O[eb] = O[eb] * alpha;
#pragma unroll
                        for (int i = 0; i < 16; ++i) { S0[i] -= d; S1[i] -= d; }
                    }
                    float ps = 0.f;
#pragma unroll
                    for (int i = 0; i < 16; ++i) { S0[i] = __builtin_amdgcn_exp2f(S0[i]); S1[i] = __builtin_amdgcn_exp2f(S1[i]); ps += S0[i] + S1[i]; }
                    lrun += ps;
                    bf16x8 P[4];
                    { u32x4 p;
                      p.x = pk_bf16(S0[0], S0[1]); p.y = pk_bf16(S0[2], S0[3]); p.z = pk_bf16(S0[4], S0[5]); p.w = pk_bf16(S0[6], S0[7]); P[0] = __builtin_bit_cast(bf16x8, p);
                      p.x = pk_bf16(S0[8], S0[9]); p.y = pk_bf16(S0[10], S0[11]); p.z = pk_bf16(S0[12], S0[13]); p.w = pk_bf16(S0[14], S0[15]); P[1] = __builtin_bit_cast(bf16x8, p);
                      p.x = pk_bf16(S1[0], S1[1]); p.y = pk_bf16(S1[2], S1[3]); p.z = pk_bf16(S1[4], S1[5]); p.w = pk_bf16(S1[6], S1[7]); P[2] = __builtin_bit_cast(bf16x8, p);
                      p.x = pk_bf16(S1[8], S1[9]); p.y = pk_bf16(S1[10], S1[11]); p.z = pk_bf16(S1[12], S1[13]); p.w = pk_bf16(S1[14], S1[15]); P[3] = __builtin_bit_cast(bf16x8, p); }
#pragma unroll
                    for (int s4 = 0; s4 < 4; ++s4)
#pragma unroll
                        for (int eb = 0; eb < EB; ++eb) {
                            const bf16x8 vf = *(const LAS bf16x8*)(vbp + eb * 4096 + ((s4 << 5) ^ vt_x));
                            O[eb] = MFMA32(vf, P[s4], O[eb]);
                            if (eb & 1) __builtin_amdgcn_sched_barrier(0);
                        }
                }
            }
            slot = slot == 2 ? 0 : slot + 1;
        }
#undef ATT_ISSUE
        const float inv = 1.0f / (lrun + shx(lrun, 32, lane));
        bf16_t* op = MIX + (size_t)(b * SEQ + tq) * 1024 + mixcol + 4 * hb;
        if (MODE == 0) {
            float* o1p = OA1 + (size_t)(b * SEQ + tq) * 512 + h * 128 + 4 * hb;
            if (mp == 0) {
#pragma unroll
                for (int eb = 0; eb < EB; ++eb)
#pragma unroll
                    for (int g = 0; g < 4; ++g) *(f32x4*)(o1p + eb * 32 + 8 * g) = (f32x4){O[eb][4 * g] * inv, O[eb][4 * g + 1] * inv, O[eb][4 * g + 2] * inv, O[eb][4 * g + 3] * inv};
            } else {
                const float c2 = lam * inv;
                float ss = 0.f;
#pragma unroll
                for (int eb = 0; eb < EB; ++eb)
#pragma unroll
                    for (int g = 0; g < 4; ++g) { const f32x4 o1 = *(const f32x4*)(o1p + eb * 32 + 8 * g);
#pragma unroll
                        for (int j = 0; j < 4; ++j) { const float o = o1[j] - O[eb][4 * g + j] * c2; O[eb][4 * g + j] = o; ss += o * o; } }
                ss += shx(ss, 32, lane);
                const float r = rsqrtf(ss * (1.0f / 128.0f) + EPS) * (1.0f - lam_init);
#pragma unroll
                for (int eb = 0; eb < EB; ++eb)
#pragma unroll
                    for (int g = 0; g < 4; ++g) { const int e0 = eb * 32 + 8 * g; const f32x4 sg = *(const f32x4*)(subg + e0 + 4 * hb);
                        *(u32x2*)(op + e0) = (u32x2){pk_bf16(O[eb][4 * g] * r * sg[0], O[eb][4 * g + 1] * r * sg[1]), pk_bf16(O[eb][4 * g + 2] * r * sg[2], O[eb][4 * g + 3] * r * sg[3])}; }
            }
        } else {
#pragma unroll
            for (int eb = 0; eb < EB; ++eb)
#pragma unroll
                for (int g = 0; g < 4; ++g) { const int e0 = eb * 32 + 8 * g;
                    *(u32x2*)(op + e0) = (u32x2){pk_bf16(O[eb][4 * g] * inv, O[eb][4 * g + 1] * inv), pk_bf16(O[eb][4 * g + 2] * inv, O[eb][4 * g + 3] * inv)}; }
        }
    }
}


constexpr int IDX_STR = 2052;
__device__ __forceinline__ unsigned f2key(float f) { const unsigned u = __float_as_uint(f); return u ^ (((unsigned)((int)u >> 31)) | 0x80000000u); }
template <int J>
__device__ __forceinline__ void index_select(const LAS float* row, const int nb, const int lane, unsigned long long* mo) {
    unsigned u[J];
#pragma unroll
    for (int j = 0; j < J; ++j) u[j] = (j < nb) ? f2key(row[64 * j]) : 0u;
    unsigned prefix = 0u;
#pragma unroll 1
    for (int bit = 31; bit >= 0; --bit) {
        const unsigned cand = prefix | (1u << bit);
        int c = 0;
#pragma unroll
        for (int j0 = 0; j0 < J; j0 += 8) {
            unsigned long long bm[8];
#pragma unroll
            for (int j = 0; j < 8; ++j) bm[j] = __ballot(u[j0 + j] >= cand);
            asm volatile("" : "+s"(bm[0]), "+s"(bm[1]), "+s"(bm[2]), "+s"(bm[3]), "+s"(bm[4]), "+s"(bm[5]), "+s"(bm[6]), "+s"(bm[7]));
#pragma unroll
            for (int j = 0; j < 8; ++j) c += (int)__builtin_popcountll(bm[j]);
        }
        if (c >= 256) prefix = cand;
        if (c == 256) break;
    }
    const unsigned thr = prefix;
    int cg = 0;
#pragma unroll
    for (int j = 0; j < J; ++j) cg += (int)__builtin_popcountll(__ballot(u[j] > thr));
    const int quota = 256 - cg;
    int taken = 0;
    unsigned long long myword = 0ull;
#pragma unroll
    for (int j = 0; j < J; ++j) {
        const bool eq = (u[j] == thr);
        const unsigned long long eqm = __ballot(eq);
        const int before = (int)__builtin_popcountll(eqm & ((1ull << lane) - 1ull));
        const unsigned long long m = __ballot((u[j] > thr) || (eq && (taken + before < quota)));
        taken += (int)__builtin_popcountll(eqm);
        myword = (lane == j) ? m : myword;
    }
    if (lane < 32) mo[lane] = myword;
}
__device__ __forceinline__ void index_unit(LAS unsigned char* lds, const bf16_t* HQ, unsigned long long* MASK, const int b, const int tt, const int wave_in) {
    int wave = wave_in; asm volatile("" : "+s"(wave));
    int lane; asm volatile("v_mbcnt_lo_u32_b32 %0, -1, 0\n\tv_mbcnt_hi_u32_b32 %0, -1, %0" : "=&v"(lane));
    const int t0 = tt * 16, nb = (t0 >> 6) + 1, nk = nb * 64;
    if (nb <= 4) {
        for (int i = wave * 64 + lane; i < 16 * 32; i += 512) MASK[(size_t)(b * SEQ + t0 + (i >> 5)) * 32 + (i & 31)] = ((i & 31) < nb) ? ~0ull : 0ull;
        return;
    }
    LAS float* sc = (LAS float*)lds;
    const int q = lane & 15, g = lane >> 4;
    {
        const bf16_t* qrow = HQ + (size_t)(b * SEQ + t0 + q) * HQP;
        bf16x8 QI[8];
#pragma unroll
        for (int h = 0; h < 8; ++h) QI[h] = *(const bf16x8*)(qrow + HQ_QI + h * 32 + g * 8);
        float w[8];
        { const u32x4 wv = *(const u32x4*)(qrow + HQ_WI);
          w[0] = bf_lo(wv[0]) * 0.0625f; w[1] = bf_hi(wv[0]) * 0.0625f; w[2] = bf_lo(wv[1]) * 0.0625f; w[3] = bf_hi(wv[1]) * 0.0625f;
          w[4] = bf_lo(wv[2]) * 0.0625f; w[5] = bf_hi(wv[2]) * 0.0625f; w[6] = bf_lo(wv[3]) * 0.0625f; w[7] = bf_hi(wv[3]) * 0.0625f; }
        const bf16_t* kbase = HQ + (size_t)(b * SEQ + q) * HQP + HQ_KI + g * 8;
        for (int kb0 = wave; kb0 < nk / 16; kb0 += 32) {
            bf16x8 kf[4];
#pragma unroll
            for (int u = 0; u < 4; ++u) { const int kb = kb0 + 8 * u; kf[u] = (kb < nk / 16) ? *(const bf16x8*)(kbase + (size_t)kb * 16 * HQP) : (bf16x8){0, 0, 0, 0, 0, 0, 0, 0}; }
#pragma unroll
            for (int u = 0; u < 4; ++u) {
                const int kb = kb0 + 8 * u;
                if (kb < nk / 16) {
                    f32x4 acc = {0.f, 0.f, 0.f, 0.f};
#pragma unroll
                    for (int h = 0; h < 8; ++h) {
                        const f32x4 z = __builtin_amdgcn_mfma_f32_16x16x32_f16(kf[u], QI[h], (f32x4){0.f, 0.f, 0.f, 0.f}, 0, 0, 0);
#pragma unroll
                        for (int j = 0; j < 4; ++j) acc[j] = fmaf(w[h], fmaxf(z[j], 0.f), acc[j]);
                    }
#pragma unroll
                    for (int j = 0; j < 4; ++j) acc[j] += 0.0f;
                    *(LAS f32x4*)(sc + q * IDX_STR + kb * 16 + g * 4) = acc;
                }
            }
        }
    }
    __syncthreads();
#pragma unroll 1
    for (int qq = 0; qq < 2; ++qq) {
        const int ql = wave * 2 + qq;
        const LAS float* row = sc + ql * IDX_STR + lane;
        unsigned long long* mo = MASK + (size_t)(b * SEQ + t0 + ql) * 32;
        if (nb <= 8) index_select<8>(row, nb, lane, mo);
        else if (nb <= 16) index_select<16>(row, nb, lane, mo);
        else if (nb <= 24) index_select<24>(row, nb, lane, mo);
        else index_select<32>(row, nb, lane, mo);
    }
    __syncthreads();
}

struct Args {
    const float* x; const float* w_in; const float* lam_q1; const float* lam_k1; const float* lam_q2; const float* lam_k2; const float* subln_g; const float* rel_bias;
    const float* w_out; const float* ln1_g; const float* ln1_b; const float* w_router; const float* b_router; const float* w_gu; const float* b_gu;
    const float* w_down; const float* b_down; const float* ln2_g; const float* ln2_b;
    float* out; unsigned char* ws;
    int ph_lo, ph_hi, bar_region, pad;
};

constexpr int LDS_STAGE = 0;
constexpr int LDS_CTL = 135168;
constexpr int LDS_TSTART = LDS_CTL + 64;
constexpr int LDS_CNT = LDS_TSTART + 36 * 4;
constexpr int LDS_TILEE = LDS_CNT + 32 * 4;
constexpr int LDS_RT = LDS_TILEE + 576;
constexpr int LDS_BYTES = 147456;
static_assert(LDS_RT + (64 + 1024) * 4 <= LDS_BYTES && 16 * IDX_STR * 4 <= LDS_CTL, "LDS map");

__device__ __forceinline__ void transpose_item(const float* W, int N, int k0, int n0, int nvalid, bf16_t* WTrow0, float scale, LAS float* scr, int lane) {
#pragma unroll
    for (int i = 0; i < 32; ++i) { const int kk = 2 * i + (lane >> 5), col = lane & 31; scr[kk * 33 + col] = (col < nvalid) ? W[(size_t)(k0 + kk) * N + n0 + col] * scale : 0.f; }
    asm volatile("s_waitcnt lgkmcnt(0)" ::: "memory");
    const int c = lane & 7;
#pragma unroll
    for (int j = 0; j < 4; ++j) { const int n = (lane >> 3) + 8 * j; const LAS float* s = scr + (8 * c) * 33 + n;
        u32x4 o; o.x = pk_bf16(s[0 * 33], s[1 * 33]); o.y = pk_bf16(s[2 * 33], s[3 * 33]); o.z = pk_bf16(s[4 * 33], s[5 * 33]); o.w = pk_bf16(s[6 * 33], s[7 * 33]);
        if (n < nvalid) *(u32x4*)(WTrow0 + (size_t)n * 1024 + k0 + 8 * c) = o; }
    asm volatile("s_waitcnt lgkmcnt(0)" ::: "memory");
}
__device__ __forceinline__ void transpose_item_fp8(const float* W, int N, int k0, int n0, unsigned char* WTrow0, float scale, LAS float* scr, int lane) {
#pragma unroll
    for (int i = 0; i < 32; ++i) { const int kk = 2 * i + (lane >> 5), col = lane & 31; scr[kk * 33 + col] = W[(size_t)(k0 + kk) * N + n0 + col] * scale; }
    asm volatile("s_waitcnt lgkmcnt(0)" ::: "memory");
    const int c = lane & 3;
#pragma unroll
    for (int j = 0; j < 2; ++j) { const int n = (lane >> 2) + 16 * j; const LAS float* s = scr + (16 * c) * 33 + n;
        u32x4 o; o.x = pk4_fp8(s[0 * 33], s[1 * 33], s[2 * 33], s[3 * 33]); o.y = pk4_fp8(s[4 * 33], s[5 * 33], s[6 * 33], s[7 * 33]);
        o.z = pk4_fp8(s[8 * 33], s[9 * 33], s[10 * 33], s[11 * 33]); o.w = pk4_fp8(s[12 * 33], s[13 * 33], s[14 * 33], s[15 * 33]);
        *(u32x4*)(WTrow0 + (size_t)n * 1024 + k0 + 16 * c) = o; }
    asm volatile("s_waitcnt lgkmcnt(0)" ::: "memory");
}
__device__ __forceinline__ void in_map(int n0, bool& isv, int& row, float& scale) {
    scale = 1.f; isv = false;
    if (n0 < 512) { row = HQ_QA + n0; scale = QSCALE; }
    else if (n0 < 1024) row = HQ_KA + (n0 - 512);
    else if (n0 < 1536) { isv = true; row = VT_A + (n0 - 1024); }
    else if (n0 < 1792) { row = HQ_QB + (n0 - 1536); scale = QSCALE; }
    else if (n0 < 2048) row = HQ_KB + (n0 - 1792);
    else if (n0 < 2304) { isv = true; row = VT_B + (n0 - 2048); }
    else if (n0 < 2560) { row = HQ_QC + (n0 - 2304); scale = QSCALE; }
    else if (n0 < 2816) row = HQ_KC + (n0 - 2560);
    else if (n0 < 3072) { isv = true; row = VT_C + (n0 - 2816); }
    else if (n0 < 3328) row = HQ_QI + (n0 - 3072);
    else if (n0 < 3360) row = HQ_KI + (n0 - 3328);
    else row = HQ_WI + (n0 - 3360);
}

__global__ void __launch_bounds__(512, 2) mega(Args a) {
    extern __shared__ __attribute__((aligned(16))) unsigned char lds_raw[];
    LAS unsigned char* lds = (LAS unsigned char*)lds_raw;
    const int G = gridDim.x, bid = blockIdx.x, NGW = G * 8;
    const int wave0 = __builtin_amdgcn_readfirstlane((int)threadIdx.x >> 6);
#define OPAQUE_IDS() int wave = wave0; asm volatile("" : "+s"(wave)); int lane; asm volatile("v_mbcnt_lo_u32_b32 %0, -1, 0\n\tv_mbcnt_hi_u32_b32 %0, -1, %0" : "=&v"(lane)); const int tid = wave * 64 + lane, gw = bid * 8 + wave; (void)tid; (void)gw
#define WSPTRS() unsigned char* ws = a.ws; asm volatile("" : "+s"(ws)); \
    unsigned* ctl = (unsigned*)(ws + WS_CTL); bf16_t* Win = (bf16_t*)(ws + WS_WIN); bf16_t* Wv = (bf16_t*)(ws + WS_WV); bf16_t* Wout = (bf16_t*)(ws + WS_WOUT); \
    bf16_t* Wgu = (bf16_t*)(ws + WS_WGU); bf16_t* Wdn = (bf16_t*)(ws + WS_WDN); bf16_t* XB = (bf16_t*)(ws + WS_XB); \
    bf16_t* HQ = (bf16_t*)(ws + WS_HQ); bf16_t* VT = (bf16_t*)(ws + WS_VT); bf16_t* MIX = (bf16_t*)(ws + WS_MIX); \
    bf16_t* Y1B = (bf16_t*)(ws + WS_Y1); bf16_t* X1B = (bf16_t*)(ws + WS_X1B); bf16_t* ACT = (bf16_t*)(ws + WS_ACT); bf16_t* YR = (bf16_t*)(ws + WS_YR); \
    int* TOKL = (int*)(ws + WS_TOKL); int* ASGE = (int*)(ws + WS_ASGE); int* ASGS = (int*)(ws + WS_ASGS); float* GATE = (float*)(ws + WS_GATE); \
    (void)ctl; (void)Win; (void)Wv; (void)Wout; (void)Wgu; (void)Wdn; (void)XB; (void)HQ; (void)VT; (void)MIX; (void)Y1B; (void)X1B; (void)ACT; (void)YR; (void)TOKL; (void)ASGE; (void)ASGS; (void)GATE
    for (int u = threadIdx.x; u < (LDS_BYTES - LDS_CTL) / 4; u += 512) ((LAS unsigned*)(lds + LDS_CTL))[u] = 0u;
    __syncthreads();
    XcdBarrier bar = xcd_barrier_post((unsigned*)(a.ws + WS_CTL) + CW_BAR + a.bar_region * XCD_BAR_WORDS, (volatile LAS unsigned*)(lds + LDS_CTL));
    const int lo = a.ph_lo, hi = a.ph_hi;
#define IN(k) (lo <= (k) && (k) < hi)
#define SEAM(k) do { if (IN(k) && IN((k) + 1)) xcd_barrier(bar); } while (0)

    if (IN(0)) PREP(0) {
        OPAQUE_IDS(); WSPTRS();
        LAS float* scr = (LAS float*)(lds + LDS_STAGE + wave * 16384);
        constexpr int I_IN = 16 * 106, I_OUT = 16 * 32, I_GU = 16 * 64, I_DN = 16 * 32;
        constexpr int N_IN = DEPTH * I_IN, N_OUT = DEPTH * I_OUT, N_GU = DEPTH * NE * I_GU, N_DN = DEPTH * NE * I_DN;
        for (int it = gw; it < N_IN + N_OUT + N_GU + N_DN; it += NGW) {
            int r = it;
            if (r < N_IN) { const int l = r / I_IN, q = r % I_IN, kb = q / 106, nb = q % 106, n0 = nb * 32; bool isv; int row; float sc; in_map(n0, isv, row, sc);
                bf16_t* dst = isv ? Wv + ((size_t)l * 1024 + row) * 1024 : Win + ((size_t)l * HQP + row) * 1024;
                transpose_item(a.w_in + (size_t)l * D * DIN, DIN, kb * 64, n0, (DIN - n0) < 32 ? (DIN - n0) : 32, dst, sc, scr, lane); continue; }
            r -= N_IN;
            if (r < N_OUT) { const int l = r / I_OUT, q = r % I_OUT, kb = q / 32, nb = q % 32;
                transpose_item(a.w_out + (size_t)l * 1024 * D, D, kb * 64, nb * 32, 32, Wout + ((size_t)l * D + nb * 32) * 1024, 1.f, scr, lane); continue; }
            r -= N_OUT;
            if (r < N_GU) { const int le = r / I_GU, q = r % I_GU, kb = q / 64, nb = q % 64, n0 = nb * 32;
                const int bj = n0 >> 10, rr = n0 & 1023, pn = rr >> 7, c = rr & 127, nrow = pn * 256 + bj * 128 + c;
#if MOE_FP8
                transpose_item_fp8(a.w_gu + (size_t)le * D * 2048, 2048, kb * 64, n0, (unsigned char*)Wgu + ((size_t)le * 2048 + nrow) * 1024, W8_SCALE, scr, lane); continue; }
#else
                transpose_item(a.w_gu + (size_t)le * D * 2048, 2048, kb * 64, n0, 32, Wgu + ((size_t)le * 2048 + nrow) * 1024, 1.f, scr, lane); continue; }
#endif
            r -= N_GU;
            { const int le = r / I_DN, q = r % I_DN, kb = q / 32, nb = q % 32;
#if MOE_FP8
                transpose_item_fp8(a.w_down + (size_t)le * 1024 * D, D, kb * 64, nb * 32, (unsigned char*)Wdn + ((size_t)le * D + nb * 32) * 1024, W8_SCALE, scr, lane); }
#else
                transpose_item(a.w_down + (size_t)le * 1024 * D, D, kb * 64, nb * 32, 32, Wdn + ((size_t)le * D + nb * 32) * 1024, 1.f, scr, lane); }
#endif
        }
        for (int i = gw * 64 + lane; i < DEPTH * (HQP - HQ_USED) * 128; i += NGW * 64) { const int l = i / ((HQP - HQ_USED) * 128), q = i % ((HQP - HQ_USED) * 128);
            *(u32x4*)(Win + ((size_t)l * HQP + HQ_USED) * 1024 + (size_t)q * 8) = (u32x4){0u, 0u, 0u, 0u}; }
        { float* WRT = (float*)(ws + WS_WRT);
          for (int i = gw * 64 + lane; i < DEPTH * NE * D; i += NGW * 64) { const int ll = i / (NE * D), r = i % (NE * D), e = r / D, c = r % D; WRT[i] = a.w_router[((size_t)ll * D + c) * NE + e]; } }
        for (size_t i = (size_t)gw * 64 + lane; i < (size_t)T * D / 8; i += (size_t)NGW * 64) { const f32x4 v0 = *(const f32x4*)(a.x + i * 8), v1 = *(const f32x4*)(a.x + i * 8 + 4);
            u32x4 w; w.x = pk_bf16(v0[0], v0[1]); w.y = pk_bf16(v0[2], v0[3]); w.z = pk_bf16(v1[0], v1[1]); w.w = pk_bf16(v1[2], v1[3]); *(u32x4*)(XB + i * 8) = w; }
    }
    SEAM(0);

#pragma unroll 1
    for (int l = 0; l < DEPTH; ++l) {
        const int pb = 1 + 8 * l;
        if (IN(pb + 0)) PREP(1) {
            WSPTRS();
            { pg8::DenseOrder S{T / 256, HQP / 256, G, bid, (const char*)(Win + (size_t)l * HQP * 1024), 1024, false};
              pg8::EpiBf16Plain E{HQ, HQP};
              pg8::gemm_phase<pg8::EpiBf16Plain, pg8::DenseOrder, false>(lds + LDS_STAGE, XB, 1024, S, E, wave0); }
            { pg8::DenseOrder S{1024 / 256, T / 256, G, bid, (const char*)XB, 1024, true};
              pg8::EpiBf16Plain E{VT, T};
              pg8::gemm_phase<pg8::EpiBf16Plain, pg8::DenseOrder, false>(lds + LDS_STAGE, Wv + (size_t)l * 1024 * 1024, 1024, S, E, wave0); }
        }
        SEAM(pb + 0);
        if (IN(pb + 1)) {
            OPAQUE_IDS(); WSPTRS();
            unsigned long long* MASKp = (unsigned long long*)(ws + WS_MASK); float* OA1p = (float*)(ws + WS_OA1);
            const float lam_init = 0.8f - 0.6f * expf(-0.3f * (float)l);
            const float lam = expf(wsum(a.lam_q1[l * 64 + lane] * a.lam_k1[l * 64 + lane], lane)) - expf(wsum(a.lam_q2[l * 64 + lane] * a.lam_k2[l * 64 + lane], lane)) + lam_init;
            const int v0 = (G % 8 == 0) ? (bid & 7) * (G >> 3) + (bid >> 3) : bid;
            for (int v = v0; v < 256; v += G) {
                const int b = v >> 4, h = (v >> 2) & 3, q0 = v & 3, j16 = v & 15;
                PREP(2)
#pragma unroll 1
                for (int k = 0; k < 8; ++k) index_unit(lds + LDS_STAGE, HQ, MASKp, b, 16 * k + ((k & 1) ? 15 - j16 : j16), wave);
                PREP(3)
#pragma unroll 1
                for (int rep = 0; rep < 2; ++rep) attn_unit<0>(lds + LDS_STAGE, HQ, VT, MIX, MASKp, OA1p, b, h, rep ? 7 - q0 : q0, wave, lane, lam, lam_init, a.subln_g + l * 128, nullptr);
                PREP(4)
#pragma unroll 1
                for (int rep = 0; rep < 2; ++rep) attn_unit<1>(lds + LDS_STAGE, HQ, VT, MIX, MASKp, OA1p, b, h, rep ? 7 - q0 : q0, wave, lane, 0.f, 0.f, nullptr, a.rel_bias + ((size_t)l * 4 + h) * 257);
            }
        }
        SEAM(pb + 1);
        if (IN(pb + 2)) {
            OPAQUE_IDS(); WSPTRS();
            unsigned long long* MASKp = (unsigned long long*)(ws + WS_MASK); float* OA1p = (float*)(ws + WS_OA1);
            const int v0 = (G % 8 == 0) ? (bid & 7) * (G >> 3) + (bid >> 3) : bid;
            for (int v = v0; v < 256; v += G) {
                const int b = v >> 4, h = (v >> 2) & 3, q0 = v & 3;
                PREP(5)
#pragma unroll 1
                for (int rep = 0; rep < 2; ++rep) attn_unit<2>(lds + LDS_STAGE, HQ, VT, MIX, MASKp, OA1p, b, h, rep ? 7 - q0 : q0, wave, lane, 0.f, 0.f, nullptr, nullptr);
            }
        }
        SEAM(pb + 2);
        if (IN(pb + 3)) PREP(6) {
            WSPTRS();
            pg8::DenseOrder S{T / 256, 4, G, bid, (const char*)(Wout + (size_t)l * 1024 * 1024), 1024, false};
            pg8::EpiResBf16 E{Y1B, XB};
            pg8::gemm_phase<pg8::EpiResBf16, pg8::DenseOrder, false>(lds + LDS_STAGE, MIX, 1024, S, E, wave0);
        }
        SEAM(pb + 3);
        if (IN(pb + 4)) PREP(10) {
            OPAQUE_IDS(); WSPTRS();
            if (PROBE == 10 && _rp == 0) { TOKL = (int*)(ws + WS_END); ASGE = TOKL + NE * T; ASGS = ASGE + NASG; GATE = (float*)(ASGS + NASG); }
            LAS int* lcnt = (LAS int*)(lds + LDS_RT); LAS int* lbase = lcnt + 32; LAS int* asg_e = lcnt + 64; LAS int* asg_ls = asg_e + 512;
            const float* g1 = a.ln1_g + l * D; const float* b1 = a.ln1_b + l * D; const float* br = a.b_router + l * NE;
            unsigned* gcnt = ctl + CW_CNT + l * 64 + ((PROBE == 10 && _rp == 0) ? 4096 : 0);
            LAS float* wT = (LAS float*)(lds + LDS_STAGE);
            { const f32x4* src = (const f32x4*)((const float*)(ws + WS_WRT) + (size_t)l * NE * D);
              for (int i = tid; i < NE * D / 4; i += 512) ((LAS f32x4*)wT)[i] = src[i]; }
            for (int unit = bid; unit < T / 128; unit += G) {
                if (tid < 32) lcnt[tid] = 0;
                __syncthreads();
#pragma unroll 1
                for (int k = 0; k < 16 / RTP; ++k) {
                    asm volatile("" ::: "memory");
                    const int tl0 = wave * 16 + RTP * k, t0 = unit * 128 + tl0;
                    float v[RTP][16];
#pragma unroll
                    for (int tk = 0; tk < RTP; ++tk)
#pragma unroll
                        for (int i = 0; i < 4; ++i) { const u32x2 u2 = *(const u32x2*)(Y1B + (size_t)(t0 + tk) * D + i * 256 + lane * 4); v[tk][4 * i] = bf_lo(u2[0]); v[tk][4 * i + 1] = bf_hi(u2[0]); v[tk][4 * i + 2] = bf_lo(u2[1]); v[tk][4 * i + 3] = bf_hi(u2[1]); }
#pragma unroll
                    for (int tk = 0; tk < RTP; ++tk) {
                        float s = 0.f;
#pragma unroll
                        for (int i = 0; i < 16; ++i) s += v[tk][i];
                        const float mean = wsum(s, lane) * (1.0f / 1024.0f);
                        float qv = 0.f;
#pragma unroll
                        for (int i = 0; i < 16; ++i) { const float d = v[tk][i] - mean; qv += d * d; }
                        const float rstd = rsqrtf(wsum(qv, lane) * (1.0f / 1024.0f) + EPS);
#pragma unroll
                        for (int i = 0; i < 4; ++i) {
                            const int c0 = i * 256 + lane * 4;
                            const f32x4 gg = *(const f32x4*)(g1 + c0), bb = *(const f32x4*)(b1 + c0);
#pragma unroll
                            for (int j = 0; j < 4; ++j) v[tk][4 * i + j] = (v[tk][4 * i + j] - mean) * rstd * gg[j] + bb[j];
                            *(u32x2*)(X1B + (size_t)(t0 + tk) * D + c0) = (u32x2){pk_bf16(v[tk][4 * i], v[tk][4 * i + 1]), pk_bf16(v[tk][4 * i + 2], v[tk][4 * i + 3])};
#if MOE_FP8
                            *(unsigned*)(ws + WS_X1Q + (size_t)(t0 + tk) * D + c0) = pk4_fp8(v[tk][4 * i] * X8_SCALE, v[tk][4 * i + 1] * X8_SCALE, v[tk][4 * i + 2] * X8_SCALE, v[tk][4 * i + 3] * X8_SCALE);
#endif
                        }
                    }
                    f32x2 part2[RTP / 2][32];
#pragma unroll
                    for (int e = 0; e < 32; ++e)
#pragma unroll
                        for (int tp = 0; tp < RTP / 2; ++tp) part2[tp][e] = (f32x2){0.f, 0.f};
#pragma unroll
                    for (int i = 0; i < 4; ++i) {
                        f32x2 xv[RTP / 2][4];
#pragma unroll
                        for (int tp = 0; tp < RTP / 2; ++tp)
#pragma unroll
                            for (int j = 0; j < 4; ++j) xv[tp][j] = (f32x2){v[2 * tp][4 * i + j], v[2 * tp + 1][4 * i + j]};
#pragma unroll
                        for (int e = 0; e < 32; ++e) { const f32x4 w4 = *(const LAS f32x4*)(wT + e * 1024 + i * 256 + lane * 4);
#pragma unroll
                            for (int tp = 0; tp < RTP / 2; ++tp)
#pragma unroll
                                for (int j = 0; j < 4; ++j) part2[tp][e] = __builtin_elementwise_fma(xv[tp][j], (f32x2){w4[j], w4[j]}, part2[tp][e]);
                            if ((e & 3) == 3) __builtin_amdgcn_sched_barrier(0); }
                    }
#pragma unroll
                    for (int tk = 0; tk < RTP; ++tk) {
                        float p16[16], p8[8], p4[4], p2[2], lg;
                        { const bool hi = (lane & 32) != 0;
#pragma unroll
                          for (int i = 0; i < 16; ++i) { const float keep = hi ? part2[tk >> 1][i + 16][tk & 1] : part2[tk >> 1][i][tk & 1], send = hi ? part2[tk >> 1][i][tk & 1] : part2[tk >> 1][i + 16][tk & 1]; p16[i] = keep + shx(send, 32, lane); } }
                        { const bool hi = (lane & 16) != 0;
#pragma unroll
                          for (int i = 0; i < 8; ++i) { const float keep = hi ? p16[i + 8] : p16[i], send = hi ? p16[i] : p16[i + 8]; p8[i] = keep + shx(send, 16, lane); } }
                        { const bool hi = (lane & 8) != 0;
#pragma unroll
                          for (int i = 0; i < 4; ++i) { const float keep = hi ? p8[i + 4] : p8[i], send = hi ? p8[i] : p8[i + 4]; p4[i] = keep + shx(send, 8, lane); } }
                        { const bool hi = (lane & 4) != 0;
#pragma unroll
                          for (int i = 0; i < 2; ++i) { const float keep = hi ? p4[i + 2] : p4[i], send = hi ? p4[i] : p4[i + 2]; p2[i] = keep + shx(send, 4, lane); } }
                        { const bool hi = (lane & 2) != 0; const float keep = hi ? p2[1] : p2[0], send = hi ? p2[0] : p2[1]; lg = keep + shx(send, 2, lane); }
                        lg += shx(lg, 1, lane);
                        lg += br[lane >> 1];
                        int be[4]; float bv[4];
#pragma unroll
                        for (int kk = 0; kk < 4; ++kk) {
                            const float mx = wmax(lg, lane);
                            const unsigned long long bal = __ballot(lg == mx);
                            const int e = (__ffsll((long long)bal) - 1) >> 1;
                            be[kk] = e; bv[kk] = mx;
                            if ((lane >> 1) == e) lg = -3e38f;
                        }
                        float ex[4], es = 0.f;
#pragma unroll
                        for (int kk = 0; kk < 4; ++kk) { ex[kk] = __expf(bv[kk] - bv[0]); es += ex[kk]; }
                        if (lane == 0) {
                            const int tl = tl0 + tk, t = t0 + tk;
#pragma unroll
                            for (int kk = 0; kk < 4; ++kk) { const int sl = __hip_atomic_fetch_add(&lcnt[be[kk]], 1, __ATOMIC_RELAXED, __HIP_MEMORY_SCOPE_WORKGROUP); asg_e[tl * 4 + kk] = be[kk]; asg_ls[tl * 4 + kk] = sl; GATE[t * 4 + kk] = ex[kk] / es; }
                        }
                    }
                }
                __syncthreads();
                if (tid < 32) lbase[tid] = (int)__hip_atomic_fetch_add(gcnt + tid, (unsigned)lcnt[tid], __ATOMIC_RELAXED, __HIP_MEMORY_SCOPE_AGENT);
                __syncthreads();
                { const int e = asg_e[tid], sl = lbase[e] + asg_ls[tid], t = unit * 128 + (tid >> 2);
                  TOKL[(size_t)e * T + sl] = t; ASGE[t * 4 + (tid & 3)] = e; ASGS[t * 4 + (tid & 3)] = sl; }
                __syncthreads();
            }
        }
        SEAM(pb + 4);
        LAS int* tstart = (LAS int*)(lds + LDS_TSTART); LAS int* lcntE = (LAS int*)(lds + LDS_CNT); LAS unsigned char* tile_e = lds + LDS_TILEE;
        if (IN(pb + 5) || IN(pb + 6) || IN(pb + 7)) {
            OPAQUE_IDS(); WSPTRS();
            if (tid < 32) lcntE[tid] = (int)__hip_atomic_load(ctl + CW_CNT + l * 64 + tid, __ATOMIC_RELAXED, __HIP_MEMORY_SCOPE_AGENT);
            __syncthreads();
            if (tid == 0) { int acc = 0; for (int e = 0; e < NE; ++e) { tstart[e] = acc; acc += (lcntE[e] + 255) >> 8; } tstart[32] = acc; }
            __syncthreads();
            for (int q = tid; q < MAXRT; q += 512) { int e = 0; for (int k = 0; k < NE; ++k) if (q >= tstart[k]) e = k; tile_e[q] = (unsigned char)e; }
            __syncthreads();
        }
        pg8::MoeTables tb{tstart, lcntE, tile_e, tstart[32]};
        if (IN(pb + 5)) PREP(7) {
            WSPTRS();
#if MOE_FP8
            pg8::MoeOrder S{tb, 8, G, bid, (const char*)Wgu + (size_t)l * NE * 2048 * 1024, (size_t)2048 * 1024, TOKL, true, 1024};
            pg8::EpiSwiglu<true> E{(void*)ACT, a.b_gu + (size_t)l * NE * 2048, 1.0f / (W8_SCALE * X8_SCALE)};
            pg8::gemm_phase<pg8::EpiSwiglu<true>, pg8::MoeOrder, true, 1>(lds + LDS_STAGE, (const bf16_t*)(ws + WS_X1Q), 1024, S, E, wave0);
#else
            pg8::MoeOrder S{tb, 8, G, bid, (const char*)(Wgu + (size_t)l * NE * 2048 * 1024), (size_t)2048 * 1024 * 2, TOKL, true, 2048};
            pg8::EpiSwiglu<false> E{(void*)ACT, a.b_gu + (size_t)l * NE * 2048, 1.0f};
            pg8::gemm_phase<pg8::EpiSwiglu<false>, pg8::MoeOrder, true>(lds + LDS_STAGE, X1B, 1024, S, E, wave0);
#endif
        }
        SEAM(pb + 5);
        if (IN(pb + 6)) PREP(8) {
            WSPTRS();
#if MOE_FP8
            pg8::MoeOrder S{tb, 4, G, bid, (const char*)Wdn + (size_t)l * NE * 1024 * 1024, (size_t)1024 * 1024, TOKL, false, 1024};
            pg8::EpiBiasBf16 E{YR, a.b_down + (size_t)l * NE * 1024, 1.0f / (W8_SCALE * A8_SCALE)};
            pg8::gemm_phase<pg8::EpiBiasBf16, pg8::MoeOrder, false, 1>(lds + LDS_STAGE, ACT, 1024, S, E, wave0);
#else
            pg8::MoeOrder S{tb, 4, G, bid, (const char*)(Wdn + (size_t)l * NE * 1024 * 1024), (size_t)1024 * 1024 * 2, TOKL, false, 2048};
            pg8::EpiBiasBf16 E{YR, a.b_down + (size_t)l * NE * 1024, 1.0f};
            pg8::gemm_phase<pg8::EpiBiasBf16, pg8::MoeOrder, false>(lds + LDS_STAGE, ACT, 1024, S, E, wave0);
#endif
        }
        SEAM(pb + 6);
        if (IN(pb + 7)) PREP(9) {
            OPAQUE_IDS(); WSPTRS();
            const float* g2 = a.ln2_g + l * D; const float* b2 = a.ln2_b + l * D;
            for (int t = gw; t < T; t += NGW) {
                float v[16];
#pragma unroll
                for (int i = 0; i < 4; ++i) { const u32x2 u2 = *(const u32x2*)(X1B + (size_t)t * D + i * 256 + lane * 4);
                    v[4 * i] = ALPHA * bf_lo(u2[0]); v[4 * i + 1] = ALPHA * bf_hi(u2[0]); v[4 * i + 2] = ALPHA * bf_lo(u2[1]); v[4 * i + 3] = ALPHA * bf_hi(u2[1]); }
#pragma unroll
                for (int k = 0; k < 4; ++k) {
                    const int e = ASGE[t * 4 + k]; const float gk = GATE[t * 4 + k];
                    const bf16_t* yp = YR + ((size_t)tstart[e] * 256 + ASGS[t * 4 + k]) * 1024;
#pragma unroll
                    for (int i = 0; i < 4; ++i) { const u32x2 u2 = *(const u32x2*)(yp + i * 256 + lane * 4);
                        v[4 * i] += gk * bf_lo(u2[0]); v[4 * i + 1] += gk * bf_hi(u2[0]); v[4 * i + 2] += gk * bf_lo(u2[1]); v[4 * i + 3] += gk * bf_hi(u2[1]); }
                }
                float s = 0.f;
#pragma unroll
                for (int i = 0; i < 16; ++i) s += v[i];
                const float mean = wsum(s, lane) * (1.0f / 1024.0f);
                float qv = 0.f;
#pragma unroll
                for (int i = 0; i < 16; ++i) { const float d = v[i] - mean; qv += d * d; }
                const float rstd = rsqrtf(wsum(qv, lane) * (1.0f / 1024.0f) + EPS);
#pragma unroll
                for (int i = 0; i < 4; ++i) {
                    const int c0 = i * 256 + lane * 4;
                    const f32x4 gg = *(const f32x4*)(g2 + c0), bb = *(const f32x4*)(b2 + c0);
                    float o[4];
#pragma unroll
                    for (int j = 0; j < 4; ++j) o[j] = (v[4 * i + j] - mean) * rstd * gg[j] + bb[j];
                    if (l == DEPTH - 1) *(f32x4*)(a.out + (size_t)t * D + c0) = (f32x4){o[0], o[1], o[2], o[3]};
                    else *(u32x2*)(XB + (size_t)t * D + c0) = (u32x2){pk_bf16(o[0], o[1]), pk_bf16(o[2], o[3])};
                }
            }
        }
        if (l + 1 < DEPTH) SEAM(pb + 7);
    }
#undef IN
#undef SEAM
}

extern "C" void kernel_launch(void* const* d_in, const int* in_sizes, int n_in, void* d_out, int out_size, void* d_ws, size_t ws_size, hipStream_t stream) {
    static int grid = 0;
    if (grid == 0) {
        if (ws_size < WS_END) { fprintf(stderr, "kernel_launch: workspace too small (%zu < %zu)\n", ws_size, (size_t)WS_END); grid = -1; return; }
        int dev = 0, cus = 0, per_cu = 0;
        if (hipGetDevice(&dev) != hipSuccess || hipDeviceGetAttribute(&cus, hipDeviceAttributeMultiprocessorCount, dev) != hipSuccess) { grid = -1; return; }
        if (hipFuncSetAttribute((const void*)mega, hipFuncAttributeMaxDynamicSharedMemorySize, LDS_BYTES) != hipSuccess) { fprintf(stderr, "kernel_launch: hipFuncSetAttribute failed\n"); grid = -1; return; }
        if (hipOccupancyMaxActiveBlocksPerMultiprocessor(&per_cu, (const void*)mega, 512, LDS_BYTES) != hipSuccess || per_cu < 1) { fprintf(stderr, "kernel_launch: occupancy query says %d\n", per_cu); }
        (void)hipGetLastError();
        grid = cus;
        if (grid % 8 != 0) grid -= grid % 8;
    }
    if (grid < 0) return;
    (void)hipMemsetAsync((char*)d_ws + WS_CTL, 0, CTL_BYTES, stream);
    Args a{};
    a.x = (const float*)d_in[0]; a.w_in = (const float*)d_in[1]; a.lam_q1 = (const float*)d_in[2]; a.lam_k1 = (const float*)d_in[3]; a.lam_q2 = (const float*)d_in[4]; a.lam_k2 = (const float*)d_in[5];
    a.subln_g = (const float*)d_in[6]; a.rel_bias = (const float*)d_in[7]; a.w_out = (const float*)d_in[8]; a.ln1_g = (const float*)d_in[9]; a.ln1_b = (const float*)d_in[10];
    a.w_router = (const float*)d_in[11]; a.b_router = (const float*)d_in[12]; a.w_gu = (const float*)d_in[13]; a.b_gu = (const float*)d_in[14]; a.w_down = (const float*)d_in[15];
    a.b_down = (const float*)d_in[16]; a.ln2_g = (const float*)d_in[17]; a.ln2_b = (const float*)d_in[18];
    a.out = (float*)d_out; a.ws = (unsigned char*)d_ws; a.pad = 0;
    a.ph_lo = 0; a.ph_hi = 1 + 8 * DEPTH; a.bar_region = 0;
    hipLaunchKernelGGL(mega, dim3(grid), dim3(512), LDS_BYTES, stream, a);
}
```

```cpp
#include <hip/hip_runtime.h>
#include <stdint.h>
#include <cstdio>

#define LAS __attribute__((address_space(3)))
typedef unsigned short bf16_t;
typedef _Float16 bf16x8 __attribute__((ext_vector_type(8)));
typedef float f32x4 __attribute__((ext_vector_type(4)));
typedef float f32x2 __attribute__((ext_vector_type(2)));
typedef unsigned u32x4 __attribute__((ext_vector_type(4)));
typedef unsigned u32x2 __attribute__((ext_vector_type(2)));
typedef _Float16 bf16v2 __attribute__((ext_vector_type(2)));

constexpr int D = 1024, BATCH = 16, SEQ = 2048, T = BATCH * SEQ, DEPTH = 4;
constexpr int DIN = 3368;
constexpr int NE = 32;
constexpr float ALPHA = 1.681792830507429f;
constexpr float EPS = 1e-5f;
constexpr float LOG2E = 1.4426950408889634f;
constexpr float QSCALE = 0.125f * LOG2E;
constexpr int HQP = 2560;
constexpr int HQ_QA = 0, HQ_KA = 512, HQ_QB = 1024, HQ_KB = 1280, HQ_QC = 1536, HQ_KC = 1792, HQ_QI = 2048, HQ_KI = 2304, HQ_WI = 2336, HQ_USED = 2344;
constexpr int VT_A = 0, VT_B = 512, VT_C = 768;
constexpr int NASG = T * 4;
constexpr int GROWS = NASG + NE * 256;
constexpr int MAXRT = GROWS / 256;

constexpr size_t MiB = (size_t)1 << 20;
constexpr size_t al(size_t x) { return (x + 255) & ~(size_t)255; }
constexpr size_t WS_CTL = 0, CTL_BYTES = 4 * MiB;
constexpr size_t WS_WIN = WS_CTL + CTL_BYTES;
constexpr size_t WS_WV = WS_WIN + al((size_t)DEPTH * HQP * D * 2);
constexpr size_t WS_WOUT = WS_WV + al((size_t)DEPTH * 1024 * D * 2);
constexpr size_t WS_WGU = WS_WOUT + al((size_t)DEPTH * D * 1024 * 2);
constexpr size_t WS_WDN = WS_WGU + al((size_t)DEPTH * NE * 2048 * D * 2);
constexpr size_t WS_XB = WS_WDN + al((size_t)DEPTH * NE * D * 1024 * 2);
constexpr size_t WS_HQ = WS_XB + al((size_t)T * D * 2);
constexpr size_t WS_VT = WS_HQ + al((size_t)T * HQP * 2);
constexpr size_t WS_MIX = WS_VT + al((size_t)1024 * T * 2);
constexpr size_t WS_Y1 = WS_MIX + al((size_t)T * 1024 * 2);
constexpr size_t WS_X1B = WS_Y1 + al((size_t)T * D * 2);
constexpr size_t WS_ACT = WS_X1B + al((size_t)T * D * 2);
constexpr size_t WS_YR = WS_ACT + al((size_t)GROWS * 1024 * 2);
constexpr size_t WS_MASK = WS_YR + al((size_t)GROWS * 1024 * 2);
constexpr size_t WS_TOKL = WS_MASK + al((size_t)T * 32 * 8);
constexpr size_t WS_ASGE = WS_TOKL + al((size_t)NE * T * 4);
constexpr size_t WS_ASGS = WS_ASGE + al((size_t)NASG * 4);
constexpr size_t WS_GATE = WS_ASGS + al((size_t)NASG * 4);
constexpr size_t WS_OA1 = WS_GATE + al((size_t)NASG * 4);
constexpr size_t WS_WRT = WS_OA1 + al((size_t)T * 512 * 4);
constexpr size_t WS_X1Q = WS_WRT + al((size_t)DEPTH * NE * D * 4);
constexpr size_t WS_END = WS_X1Q + al((size_t)T * D);
constexpr int CW_BAR = 4096;
constexpr int CW_CNT = 262144;

#ifndef MOE_FP8
#define MOE_FP8 1
#endif
constexpr int RTP = 2;
constexpr float W8_SCALE = 512.0f;
constexpr float X8_SCALE = 16.0f;
constexpr float A8_SCALE = 4.0f;
typedef int i32x8 __attribute__((ext_vector_type(8)));
__device__ __forceinline__ unsigned pk_bf16(float lo, float hi) { f32x2 v = {lo, hi}; return __builtin_bit_cast(unsigned, __builtin_convertvector(v, bf16v2)); }
__device__ __forceinline__ float clamp8(float x) { return __builtin_fminf(__builtin_fmaxf(x, -448.0f), 448.0f); }
__device__ __forceinline__ unsigned pk4_fp8(float a, float b, float c, float d) {
    int w = 0; w = __builtin_amdgcn_cvt_pk_fp8_f32(clamp8(a), clamp8(b), w, false); w = __builtin_amdgcn_cvt_pk_fp8_f32(clamp8(c), clamp8(d), w, true); return (unsigned)w; }
__device__ __forceinline__ float bf_lo(unsigned u) { return (float)__builtin_bit_cast(bf16v2, u)[0]; }
__device__ __forceinline__ float bf_hi(unsigned u) { return (float)__builtin_bit_cast(bf16v2, u)[1]; }
__device__ __forceinline__ float bf2f(bf16_t b) { return (float)__builtin_bit_cast(bf16v2, (unsigned)b)[0]; }
__device__ __forceinline__ float wave_sum(float v) {
#pragma unroll
    for (int o = 32; o > 0; o >>= 1) v += __shfl_xor(v, o);
    return v; }
__device__ __forceinline__ float wave_max(float v) {
#pragma unroll
    for (int o = 32; o > 0; o >>= 1) v = fmaxf(v, __shfl_xor(v, o));
    return v; }
__device__ __forceinline__ int wave_sum_i(int v) {
#pragma unroll
    for (int o = 32; o > 0; o >>= 1) v += __shfl_xor(v, o);
    return v; }

__device__ __forceinline__ float shx(float v, int o, int lane) { return __int_as_float(__builtin_amdgcn_ds_bpermute((lane ^ o) << 2, __float_as_int(v))); }
__device__ __forceinline__ float wsum(float v, int lane) {
#pragma unroll
    for (int o = 32; o > 0; o >>= 1) v += shx(v, o, lane);
    return v; }
__device__ __forceinline__ float wmax(float v, int lane) {
#pragma unroll
    for (int o = 32; o > 0; o >>= 1) v = fmaxf(v, shx(v, o, lane));
    return v; }

#define XB_TMO      128
#define XB_XCNT(j)  (256  + 64 * (j))
#define XB_XSUB(j)  (1280 + 64 * (j))
#define XB_XGEN(j)  (2304 + 64 * (j))
#define XB_TOP      3328
#define XB_TOPGEN   3392
#define XCD_BAR_WORDS 3456
#define XB_SPIN_CAP (1u << 22)
__device__ __forceinline__ unsigned xb_ld(unsigned* p)              { return __hip_atomic_load(p, __ATOMIC_RELAXED, __HIP_MEMORY_SCOPE_AGENT); }
__device__ __forceinline__ unsigned xb_add(unsigned* p, unsigned v) { return __hip_atomic_fetch_add(p, v, __ATOMIC_RELAXED, __HIP_MEMORY_SCOPE_AGENT); }
__device__ __forceinline__ unsigned xb_xcc_id() { return (unsigned)__builtin_amdgcn_s_getreg((3 << 11) | 20) & 0xFu; }
#define XB_SPIN(cond, bar) do { unsigned _sp = 0; while (cond) { __builtin_amdgcn_s_sleep(1); \
    if ((++_sp & 255u) == 0u) { if (xb_ld(&(bar)[XB_TMO])) break; if (_sp > XB_SPIN_CAP) { atomicAdd(&(bar)[XB_TMO], 1u); break; } } } } while (0)
struct XcdBarrier { unsigned* bar; unsigned x; volatile LAS unsigned* st; };
__device__ __forceinline__ XcdBarrier xcd_barrier_post(unsigned* bar, volatile LAS unsigned* st) {
    XcdBarrier b; b.bar = bar; b.x = xb_xcc_id(); b.st = st;
    if (threadIdx.x == 0) (void)xb_add(&bar[XB_XCNT(b.x)], 1u);
    return b;
}
__device__ __forceinline__ void xcd_barrier_complete(unsigned* bar, unsigned x, unsigned& nloc, unsigned& nx) {
    const unsigned G = gridDim.x * gridDim.y * gridDim.z;
    unsigned sum, cnt, mine, sp = 0u;
    for (;;) {
        sum = 0u; cnt = 0u; mine = 0u;
#pragma unroll
        for (unsigned j = 0; j < 16; ++j) { const unsigned c = xb_ld(&bar[XB_XCNT(j)]); sum += c; cnt += (c > 0u) ? 1u : 0u; mine = (j == x) ? c : mine; }
        if (sum == G) break;
        __builtin_amdgcn_s_sleep(1);
        if ((++sp & 255u) == 0u) { if (xb_ld(&bar[XB_TMO])) break; if (sp > XB_SPIN_CAP) { atomicAdd(&bar[XB_TMO], 1u); break; } }
    }
    nloc = mine > 0u ? mine : 1u; nx = cnt > 0u ? cnt : 1u;
}
__device__ __forceinline__ void xcd_barrier(const XcdBarrier& b) {
    asm volatile("s_waitcnt vmcnt(0)" ::: "memory");
    __syncthreads();
    if (threadIdx.x == 0) {
        unsigned* bar = b.bar;
        __builtin_amdgcn_s_waitcnt(0);
        unsigned nloc = b.st[0], nx = b.st[1];
        if (nloc == 0u) { xcd_barrier_complete(bar, b.x, nloc, nx); b.st[0] = nloc; b.st[1] = nx; }
        const unsigned old = xb_add(&bar[XB_XSUB(b.x)], 1u);
        const unsigned gen = old / nloc;
        if (old + 1u == (gen + 1u) * nloc) {
            __builtin_amdgcn_fence(__ATOMIC_RELEASE, "agent");
            asm volatile("s_waitcnt vmcnt(0)" ::: "memory");
            const unsigned og = xb_add(&bar[XB_TOP], 1u);
            const unsigned tg = og / nx;
            if (og + 1u == (tg + 1u) * nx) xb_add(&bar[XB_TOPGEN], 1u);
            else XB_SPIN(xb_ld(&bar[XB_TOPGEN]) == tg, bar);
            __builtin_amdgcn_fence(__ATOMIC_ACQUIRE, "agent");
            xb_add(&bar[XB_XGEN(b.x)], 1u);
            asm volatile("s_waitcnt vmcnt(0)" ::: "memory");
        } else {
            XB_SPIN(xb_ld(&bar[XB_XGEN(b.x)]) == gen, bar);
            __builtin_amdgcn_fence(__ATOMIC_ACQUIRE, "agent");
            asm volatile("s_waitcnt vmcnt(0)" ::: "memory");
        }
    }
    __syncthreads();
}

namespace pg8 {
constexpr int BM = 256, BK = 64, HALF = 128, HTB = HALF * BK * 2, STAGE_BYTES = 8 * HTB;
__host__ __device__ __forceinline__ int lds_byte(int r, int c) { const int st = (r >> 4) * 2 + (c >> 5), rr = r & 15, cc = c & 31, ob = rr * 64 + cc * 2; return st * 1024 + (ob ^ (((ob >> 9) & 1) << 5)); }
__host__ __device__ __forceinline__ void stage_rc(int b, int& R, int& C) { const int st = b / 1024, sb = b % 1024, swz = sb ^ (((sb >> 9) & 1) << 5); R = (st >> 1) * 16 + swz / 64; C = (st & 1) * 32 + (swz % 64) / 2; }
__host__ __device__ __forceinline__ int perm32(int rho) { const int n = rho >> 4, i = rho & 15; return 8 * (i >> 2) + 4 * n + (i & 3); }

struct Unit {
    int row0;
    int col0;
    const char* Bt;
    const int* rows;
    int nvalid;
    int e;
};

template <class Epi, class Sched, bool GATHER, int ESZ = 2>
__device__ __forceinline__ void gemm_phase(LAS unsigned char* lds, const bf16_t* Abase, const int K, const Sched& S, const Epi& E, const int wid_in) {
    int wid = wid_in; asm volatile("" : "+s"(wid));
    int lane; asm volatile("v_mbcnt_lo_u32_b32 %0, -1, 0\n\tv_mbcnt_hi_u32_b32 %0, -1, %0" : "=&v"(lane));
    const int tid = wid * 64 + lane, wr = wid >> 2, wc = wid & 3, fr = lane & 15, fq = lane >> 4;
    const int nt = K * ESZ / 128;
    unsigned voffB[2];
#pragma unroll
    for (int i = 0; i < 2; ++i) { int R, C; stage_rc(tid * 16 + i * 8192, R, C); const int Rb = Epi::PERM ? ((R & ~31) + perm32(R & 31)) : R; voffB[i] = (unsigned)(Rb * K * ESZ + C * 2); }
    const size_t kstep = (size_t)(BK * 2);
    const size_t hstep = (size_t)HALF * K * ESZ;
    const unsigned ldsw = (unsigned)wid * 1024u;
    const int aoff = lds_byte(wr * 64 + fr, fq * 8), boff = lds_byte(wc * 32 + fr, fq * 8);
#define PG8_SA(b, h) (((b) * 2 + (h)) * HTB)
#define PG8_SB(b, h) ((4 + (b) * 2 + (h)) * HTB)
#define PG8_STAGE(bufoff, gbase, voff) do { _Pragma("unroll") for (int _i = 0; _i < 2; ++_i) \
        __builtin_amdgcn_global_load_lds((const unsigned*)((const char*)(gbase) + (voff)[_i]), (LAS unsigned*)(lds + (bufoff) + ldsw + _i * 8192), 16, 0, 0); } while (0)
#define PG8_LDA(dst, b, h) do { _Pragma("unroll") for (int m = 0; m < 4; ++m) _Pragma("unroll") for (int k = 0; k < 2; ++k) dst[m][k] = *(const LAS bf16x8*)(lds + PG8_SA(b, h) + aoff + m * 2048 + k * 1024); } while (0)
#define PG8_LDB(dst, b, h) do { _Pragma("unroll") for (int n = 0; n < 2; ++n) _Pragma("unroll") for (int k = 0; k < 2; ++k) dst[n][k] = *(const LAS bf16x8*)(lds + PG8_SB(b, h) + boff + n * 2048 + k * 1024); } while (0)
#define PG8_MMA(ai, bj, At, Bt) do { __builtin_amdgcn_s_setprio(1); _Pragma("unroll") for (int m = 0; m < 4; ++m) _Pragma("unroll") for (int n = 0; n < 2; ++n) { \
        if constexpr (ESZ == 2) { _Pragma("unroll") for (int k = 0; k < 2; ++k) acc[ai][bj][m][n] = __builtin_amdgcn_mfma_f32_16x16x32_f16(Bt[n][k], At[m][k], acc[ai][bj][m][n], 0, 0, 0); } \
        else {   \
            const u32x4 _a0 = __builtin_bit_cast(u32x4, At[m][0]), _a1 = __builtin_bit_cast(u32x4, At[m][1]), _b0 = __builtin_bit_cast(u32x4, Bt[n][0]), _b1 = __builtin_bit_cast(u32x4, Bt[n][1]); \
            const i32x8 _af = {(int)_a0[0], (int)_a0[1], (int)_a0[2], (int)_a0[3], (int)_a1[0], (int)_a1[1], (int)_a1[2], (int)_a1[3]}; \
            const i32x8 _bf = {(int)_b0[0], (int)_b0[1], (int)_b0[2], (int)_b0[3], (int)_b1[0], (int)_b1[1], (int)_b1[2], (int)_b1[3]}; \
              \
            asm volatile("v_mfma_scale_f32_16x16x128_f8f6f4 %0, %1, %2, %0, %3, %3 op_sel_hi:[0,0,0]" : "+v"(acc[ai][bj][m][n]) : "v"(_bf), "v"(_af), "v"(s8)); } } \
        __builtin_amdgcn_s_setprio(0); } while (0)
#define PG8_WAIT_V(n) asm volatile("s_waitcnt vmcnt(" #n ")" ::: "memory")
#define PG8_WAIT_L(n) asm volatile("s_waitcnt lgkmcnt(" #n ")" ::: "memory")
#define PG8_BAR __builtin_amdgcn_s_barrier()
#define PG8_SCHED __builtin_amdgcn_sched_barrier(0)
#define PG8_AOFFS(dst, u) do { _Pragma("unroll") for (int _h = 0; _h < 2; ++_h) _Pragma("unroll") for (int _i = 0; _i < 2; ++_i) { int _R, _C; stage_rc(tid * 16 + _i * 8192, _R, _C); \
        const int _r = _h * HALF + _R; const int _src = (_r < (u).nvalid) ? (u).rows[_r] : 0; dst[_h][_i] = (unsigned)(_src * K * ESZ + _C * 2); } } while (0)
#define PG8_RAWLOAD(dst, u) do { _Pragma("unroll") for (int _h = 0; _h < 2; ++_h) _Pragma("unroll") for (int _i = 0; _i < 2; ++_i) { int _R, _C; stage_rc(tid * 16 + _i * 8192, _R, _C); \
        const int _r = _h * HALF + _R; dst[_h][_i] = (_r < (u).nvalid) ? (u).rows[_r] : 0; } } while (0)
#define PG8_STAGE_A(bufoff, h, ktb, usenext) do { if constexpr (GATHER) { const unsigned _o[2] = {(usenext) ? na[h][0] : oa[h][0], (usenext) ? na[h][1] : oa[h][1]}; PG8_STAGE(bufoff, cA + (ktb), _o); } \
        else { PG8_STAGE(bufoff, ((usenext) ? nA : cA) + (size_t)(h) * hstep + (ktb), voffA); } } while (0)
    Unit cur, nxt; int ui = 0;
    if (!S.next(0, cur)) return;
    f32x4 acc[2][2][4][2];
#pragma unroll
    for (int a = 0; a < 2; ++a)
#pragma unroll
        for (int b = 0; b < 2; ++b)
#pragma unroll
            for (int m = 0; m < 4; ++m)
#pragma unroll
                for (int n = 0; n < 2; ++n) acc[a][b][m][n] = (f32x4){0.f, 0.f, 0.f, 0.f};
    bf16x8 At[4][2], B0[2][2], B1[2][2];
    int s8 = 0x7F7F7F7F; asm volatile("" : "+v"(s8));
    unsigned oa[2][2], na[2][2], voffA[2];
    const char* cA; const char* nA; const char* cB = cur.Bt;
    int raw[2][2] = {{0, 0}, {0, 0}};
    if constexpr (GATHER) { PG8_AOFFS(oa, cur); cA = (const char*)Abase; nA = cA; voffA[0] = voffA[1] = 0u; if (S.next(1, nxt)) { PG8_RAWLOAD(raw, nxt); } }
    else { cA = (const char*)Abase + (size_t)cur.row0 * K * ESZ; nA = cA;
#pragma unroll
        for (int i = 0; i < 2; ++i) { int R, C; stage_rc(tid * 16 + i * 8192, R, C); voffA[i] = (unsigned)(R * K * ESZ + C * 2); oa[0][i] = oa[1][i] = na[0][i] = na[1][i] = 0u; } }
    PG8_STAGE(PG8_SB(0, 0), cB, voffB); PG8_STAGE(PG8_SB(0, 1), cB + hstep, voffB); PG8_STAGE_A(PG8_SA(0, 0), 0, 0, false); PG8_STAGE_A(PG8_SA(0, 1), 1, 0, false);
    if (wr == 1) PG8_BAR;
    PG8_WAIT_V(2); PG8_BAR;
    PG8_STAGE(PG8_SB(1, 0), cB + kstep, voffB); PG8_STAGE_A(PG8_SA(1, 0), 0, kstep, false); PG8_STAGE(PG8_SB(1, 1), cB + hstep + kstep, voffB);
    PG8_WAIT_V(6); PG8_BAR;
    for (;;) {
        const bool has_next = S.next(ui + 1, nxt);
        if constexpr (GATHER) {
            if (has_next) {
#pragma unroll
                for (int h = 0; h < 2; ++h)
#pragma unroll
                    for (int i = 0; i < 2; ++i) { int R, C; stage_rc(tid * 16 + i * 8192, R, C); na[h][i] = (unsigned)(raw[h][i] * K * ESZ + C * 2); }
                asm volatile("" : "+v"(na[0][0]), "+v"(na[0][1]), "+v"(na[1][0]), "+v"(na[1][1]));
            } else {
#pragma unroll
                for (int h = 0; h < 2; ++h)
#pragma unroll
                    for (int i = 0; i < 2; ++i) na[h][i] = oa[h][i];
            }
            Unit n2;
            if (has_next && S.next(ui + 2, n2)) { PG8_RAWLOAD(raw, n2); }
        } else nA = has_next ? (const char*)Abase + (size_t)nxt.row0 * K * ESZ : cA;
        const char* nB = has_next ? nxt.Bt : cB;
#pragma unroll 1
        for (int t = 0; t < nt; t += 2) {
            const bool last = (t == nt - 2);
            const size_t k1 = (size_t)(t + 1) * kstep, k2 = last ? 0 : (size_t)(t + 2) * kstep, k3 = k2 + kstep;
            const char* b2 = last ? nB : cB + (size_t)(t + 2) * kstep; const char* b3 = b2 + kstep;
            PG8_LDB(B0, 0, 0); PG8_LDB(B1, 0, 1); PG8_SCHED; PG8_LDA(At, 0, 0); PG8_STAGE_A(PG8_SA(1, 1), 1, k1, false);
            PG8_WAIT_V(8); PG8_WAIT_L(0); PG8_BAR; PG8_MMA(0, 0, At, B0); PG8_MMA(0, 1, At, B1); PG8_BAR; PG8_SCHED;
            PG8_LDA(At, 0, 1); PG8_STAGE(PG8_SB(0, 0), b2, voffB); PG8_STAGE(PG8_SB(0, 1), b2 + hstep, voffB); PG8_STAGE_A(PG8_SA(0, 0), 0, k2, last);
            PG8_WAIT_V(8); PG8_WAIT_L(0); PG8_BAR; PG8_MMA(1, 0, At, B0); PG8_MMA(1, 1, At, B1); PG8_BAR; PG8_SCHED;
            PG8_LDB(B0, 1, 0); PG8_LDB(B1, 1, 1); PG8_SCHED; PG8_LDA(At, 1, 0); PG8_STAGE_A(PG8_SA(0, 1), 1, k2, last);
            PG8_WAIT_V(8); PG8_WAIT_L(0); PG8_BAR; PG8_MMA(0, 0, At, B0); PG8_MMA(0, 1, At, B1); PG8_BAR; PG8_SCHED;
            PG8_LDA(At, 1, 1); PG8_STAGE(PG8_SB(1, 0), b3, voffB); PG8_STAGE(PG8_SB(1, 1), b3 + hstep, voffB); PG8_STAGE_A(PG8_SA(1, 0), 0, k3, last);
            PG8_WAIT_V(8); PG8_WAIT_L(0); PG8_BAR; PG8_MMA(1, 0, At, B0); PG8_MMA(1, 1, At, B1); PG8_BAR; PG8_SCHED;
        }
        if constexpr (ESZ == 1) asm volatile("s_nop 15\n\ts_nop 15" ::: "memory");
        if (wr == 0) PG8_BAR;
        E(acc, cur, wr, wc, fr, fq);
        if (!has_next) break;
#pragma unroll
        for (int a = 0; a < 2; ++a)
#pragma unroll
            for (int b = 0; b < 2; ++b)
#pragma unroll
                for (int m = 0; m < 4; ++m)
#pragma unroll
                    for (int n = 0; n < 2; ++n) acc[a][b][m][n] = (f32x4){0.f, 0.f, 0.f, 0.f};
        cur = nxt; cB = nB; ++ui;
        if constexpr (GATHER) {
#pragma unroll
            for (int h = 0; h < 2; ++h)
#pragma unroll
                for (int i = 0; i < 2; ++i) oa[h][i] = na[h][i];
        } else cA = nA;
        if (wr == 1) PG8_BAR;
    }
    PG8_WAIT_V(0);
    PG8_BAR;
#undef PG8_SA
#undef PG8_SB
#undef PG8_STAGE
#undef PG8_LDA
#undef PG8_LDB
#undef PG8_MMA
#undef PG8_WAIT_V
#undef PG8_WAIT_L
#undef PG8_BAR
#undef PG8_SCHED
#undef PG8_AOFFS
#undef PG8_RAWLOAD
#undef PG8_STAGE_A
}

struct DenseOrder {
    int nRT, nN, G, c; const char* Bt; int K; bool swap;
    __device__ __forceinline__ bool next(int i, Unit& u) const {
        const int xcd = c & 7, s = i * (G >> 3) + (c >> 3);
        int rt, pn;
        if (!swap) { rt = 8 * (s / nN) + xcd; pn = s % nN; } else { pn = 8 * (s / nRT) + xcd; rt = s % nRT; }
        if (rt >= nRT || pn >= nN) return false;
        u.row0 = rt * BM; u.col0 = pn * BM; u.Bt = Bt + (size_t)pn * BM * K * 2; u.rows = nullptr; u.nvalid = 0; u.e = 0; return true;
    }
};
struct MoeTables { LAS const int* tstart; LAS const int* cnt; LAS const unsigned char* tile_e; int nrt; };
struct MoeOrder {
    MoeTables tb; int nN, G, c; const char* Bt; size_t strideB; const int* tokl; bool gather; int rowb;
    __device__ __forceinline__ bool next(int i, Unit& u) const {
        const int xcd = c & 7, s = i * (G >> 3) + (c >> 3);
        const int q = 8 * (s / nN) + xcd, pn = s % nN;
        if (q >= tb.nrt) return false;
        const int e = tb.tile_e[q]; const int lt = q - tb.tstart[e];
        u.row0 = q * BM; u.col0 = pn * BM; u.e = e; u.Bt = Bt + (size_t)e * strideB + (size_t)pn * BM * rowb;
        u.rows = gather ? tokl + (size_t)e * T + lt * BM : nullptr; u.nvalid = tb.cnt[e] - lt * BM; return true;
    }
};

struct EpiBf16Plain {
    static constexpr bool PERM = true;
    bf16_t* O; int ldc;
    __device__ __forceinline__ void operator()(const f32x4 (&acc)[2][2][4][2], const Unit& u, int wr, int wc, int fr, int fq) const {
        const int row0 = u.row0 + wr * 64 + fr, col0 = u.col0 + wc * 32 + 8 * fq;
#pragma unroll
        for (int ai = 0; ai < 2; ++ai)
#pragma unroll
            for (int m = 0; m < 4; ++m) { bf16_t* rowp = O + (size_t)(row0 + ai * HALF + m * 16) * ldc + col0;
#pragma unroll
                for (int bj = 0; bj < 2; ++bj) { const f32x4 v0 = acc[ai][bj][m][0], v1 = acc[ai][bj][m][1];
                    u32x4 w; w.x = pk_bf16(v0[0], v0[1]); w.y = pk_bf16(v0[2], v0[3]); w.z = pk_bf16(v1[0], v1[1]); w.w = pk_bf16(v1[2], v1[3]);
                    *(u32x4*)(rowp + bj * HALF) = w; } }
    }
};
struct EpiResBf16 {
    static constexpr bool PERM = true;
    bf16_t* O; const bf16_t* R;
    __device__ __forceinline__ void operator()(const f32x4 (&acc)[2][2][4][2], const Unit& u, int wr, int wc, int fr, int fq) const {
        const int row0 = u.row0 + wr * 64 + fr, col0 = u.col0 + wc * 32 + 8 * fq;
#pragma unroll
        for (int ai = 0; ai < 2; ++ai)
#pragma unroll
            for (int m = 0; m < 4; ++m) { const size_t off = (size_t)(row0 + ai * HALF + m * 16) * 1024 + col0;
#pragma unroll
                for (int bj = 0; bj < 2; ++bj) { const u32x4 r = *(const u32x4*)(R + off + bj * HALF); const f32x4 v0 = acc[ai][bj][m][0], v1 = acc[ai][bj][m][1];
                    u32x4 w; w.x = pk_bf16(bf_lo(r[0]) * ALPHA + v0[0], bf_hi(r[0]) * ALPHA + v0[1]); w.y = pk_bf16(bf_lo(r[1]) * ALPHA + v0[2], bf_hi(r[1]) * ALPHA + v0[3]);
                    w.z = pk_bf16(bf_lo(r[2]) * ALPHA + v1[0], bf_hi(r[2]) * ALPHA + v1[1]); w.w = pk_bf16(bf_lo(r[3]) * ALPHA + v1[2], bf_hi(r[3]) * ALPHA + v1[3]);
                    *(u32x4*)(O + off + bj * HALF) = w; } }
    }
};
template <bool F8> struct EpiSwiglu {
    static constexpr bool PERM = true;
    void* Ov; const float* bias; float ascale;
    __device__ __forceinline__ void operator()(const f32x4 (&acc)[2][2][4][2], const Unit& u, int wr, int wc, int fr, int fq) const {
        const int row0 = u.row0 + wr * 64 + fr, oc = (u.col0 >> 1) + wc * 32 + 8 * fq;
        const float* bp = bias + (size_t)u.e * 2048 + oc;
        f32x4 bg[2], bu[2];
#pragma unroll
        for (int n = 0; n < 2; ++n) { bg[n] = *(const f32x4*)(bp + 4 * n); bu[n] = *(const f32x4*)(bp + 1024 + 4 * n); }
#pragma unroll
        for (int ai = 0; ai < 2; ++ai)
#pragma unroll
            for (int m = 0; m < 4; ++m) {
                float o[8];
#pragma unroll
                for (int n = 0; n < 2; ++n) { const f32x4 g4 = acc[ai][0][m][n] * ascale + bg[n], u4 = acc[ai][1][m][n] * ascale + bu[n];
#pragma unroll
                    for (int j = 0; j < 4; ++j) { const float g = fminf(g4[j], 7.0f), up = __builtin_amdgcn_fmed3f(u4[j], -7.0f, 7.0f);
                        constexpr float OS = F8 ? A8_SCALE : 1.0f;
                        const float e = __builtin_amdgcn_exp2f(-1.702f * LOG2E * g), glu = g * __builtin_amdgcn_rcpf(__builtin_fmaf(e, 1.0f / OS, 1.0f / OS)); o[4 * n + j] = __builtin_fmaf(up, glu, glu); } }
                if constexpr (F8) {
                    int w0 = 0, w1 = 0; w0 = __builtin_amdgcn_cvt_pk_fp8_f32(o[0], o[1], w0, false); w0 = __builtin_amdgcn_cvt_pk_fp8_f32(o[2], o[3], w0, true);
                    w1 = __builtin_amdgcn_cvt_pk_fp8_f32(o[4], o[5], w1, false); w1 = __builtin_amdgcn_cvt_pk_fp8_f32(o[6], o[7], w1, true);
                    *(u32x2*)((unsigned char*)Ov + (size_t)(row0 + ai * HALF + m * 16) * 1024 + oc) = (u32x2){(unsigned)w0, (unsigned)w1}; }
                else { u32x4 w; w.x = pk_bf16(o[0], o[1]); w.y = pk_bf16(o[2], o[3]); w.z = pk_bf16(o[4], o[5]); w.w = pk_bf16(o[6], o[7]);
                    *(u32x4*)((bf16_t*)Ov + (size_t)(row0 + ai * HALF + m * 16) * 1024 + oc) = w; } }
    }
};
struct EpiBiasBf16 {
    static constexpr bool PERM = true;
    bf16_t* O; const float* bias; float ascale;
    __device__ __forceinline__ void operator()(const f32x4 (&acc)[2][2][4][2], const Unit& u, int wr, int wc, int fr, int fq) const {
        const int row0 = u.row0 + wr * 64 + fr, col0 = u.col0 + wc * 32 + 8 * fq;
        const float* bp = bias + (size_t)u.e * 1024 + col0;
        f32x4 bv[2][2];
#pragma unroll
        for (int bj = 0; bj < 2; ++bj)
#pragma unroll
            for (int n = 0; n < 2; ++n) bv[bj][n] = *(const f32x4*)(bp + bj * HALF + 4 * n);
#pragma unroll
        for (int ai = 0; ai < 2; ++ai)
#pragma unroll
            for (int m = 0; m < 4; ++m) { bf16_t* rowp = O + (size_t)(row0 + ai * HALF + m * 16) * 1024 + col0;
#pragma unroll
                for (int bj = 0; bj < 2; ++bj) { const f32x4 v0 = acc[ai][bj][m][0] * ascale + bv[bj][0], v1 = acc[ai][bj][m][1] * ascale + bv[bj][1];
                    u32x4 w; w.x = pk_bf16(v0[0], v0[1]); w.y = pk_bf16(v0[2], v0[3]); w.z = pk_bf16(v1[0], v1[1]); w.w = pk_bf16(v1[2], v1[3]);
                    *(u32x4*)(rowp + bj * HALF) = w; } }
    }
};
}


#ifndef ATT_EN
#define ATT_EN 7
#endif
#ifndef PROBE
#define PROBE (-1)
#endif
#define PREP(k) _Pragma("unroll 1") for (int _rp = ((PROBE == (k)) ? 0 : 1); _rp < 2; ++_rp)
typedef float f32x16 __attribute__((ext_vector_type(16)));
#define MFMA32(a, b, c) __builtin_amdgcn_mfma_f32_32x32x16_f16((a), (b), (c), 0, 0, 0)
constexpr float ATT_THR = 8.0f;
constexpr int ATT_KB = 8192;
#define NEG_INF_F (-__builtin_huge_valf())

template <int MODE>
__device__ __forceinline__ void attn_unit(LAS unsigned char* lds, const bf16_t* HQ, const bf16_t* VT, bf16_t* MIX, const unsigned long long* MASK, float* OA1,
                                          const int b, const int h, const int qt, const int wave_in, const int lane_unused,
                                          const float lam, const float lam_init, const float* subg, const float* relb) {
    int wave = wave_in; asm volatile("" : "+s"(wave));
    constexpr int NPASS = (MODE == 0) ? 2 : 1;
    constexpr int EB = (MODE == 0) ? 4 : 2;
    constexpr int NLV = EB / 2;
    constexpr int SLOTB = ATT_KB + EB * 32 * 128;
    constexpr int XOFF = 3 * SLOTB;
    const int qoff = (MODE == 0) ? HQ_QA + h * 128 : (MODE == 1) ? HQ_QB + h * 64 : HQ_QC + h * 64;
    const int koff = (MODE == 0) ? HQ_KA + h * 128 : (MODE == 1) ? HQ_KB + h * 64 : HQ_KC + h * 64;
    const int vrow0 = (MODE == 0) ? VT_A + h * 128 : (MODE == 1) ? VT_B + h * 64 : VT_C + h * 64;
    const int mixcol = (MODE == 0) ? h * 128 : (MODE == 1) ? 512 + h * 64 : 768 + h * 64;
    int lane; asm volatile("v_mbcnt_lo_u32_b32 %0, -1, 0\n\tv_mbcnt_hi_u32_b32 %0, -1, %0" : "=&v"(lane));
    const int tid = wave * 64 + lane, ql = lane & 31, hb = lane >> 5;
    const int cq = qt * 4 + (wave >> 1);
    const int tq = qt * 256 + wave * 32 + ql;
    const int kt_hi = qt * 4 + 3;
    const int kt_lo = (MODE == 1) ? ((qt * 4 - 8) > 0 ? (qt * 4 - 8) : 0) : 0;
    const int ntile = kt_hi - kt_lo + 1;
    const float slope2 = (MODE == 0) ? exp2f(-(float)(2 * h + 1)) * LOG2E : exp2f(-(float)(2 * h + 2)) * LOG2E;
    LAS float* relb_l = (LAS float*)(lds + XOFF);
    float so[16];
#pragma unroll
    for (int i = 0; i < 16; ++i) { int oi = 16 * (i >> 3) + (i & 7); asm volatile("" : "+s"(oi));
        so[i] = __int_as_float(__builtin_amdgcn_readfirstlane(__float_as_int(slope2 * (float)oi))); }
    const int prow = (ql & 16) | ((ql & 4) << 1) | ((ql & 8) >> 1) | (ql & 3);
    const int kt_x = (hb ^ ((prow >> 1) & 7)) << 4, vt_x = (hb ^ ((ql >> 1) & 7)) << 4;
    const int krd = prow * 128, vrd = ATT_KB + ql * 128;
    const int drow = lane >> 3, dpos = lane & 7;
    const int krow_g = 8 * wave + drow;
    const size_t ksrc = ((size_t)(b * SEQ + krow_g) * HQP + koff + ((dpos ^ ((krow_g >> 1) & 7)) << 3)) * 2;
    size_t vsrc[NLV];
#pragma unroll
    for (int j = 0; j < NLV; ++j) { const int vr = 8 * (wave + 8 * j) + drow; vsrc[j] = ((size_t)(vrow0 + vr) * T + (size_t)b * SEQ + ((dpos ^ ((vr >> 1) & 7)) << 3)) * 2; }

#pragma unroll 1
    for (int mp = 0; mp < NPASS; ++mp) {
#define ATT_ISSUE(kt_, slot_) do { \
        __builtin_amdgcn_global_load_lds((const unsigned*)((const char*)HQ + ksrc + (size_t)(kt_) * (64 * HQP * 2) + mp * 128), (LAS unsigned*)(lds + (slot_) * SLOTB + wave * 1024), 16, 0, 0); \
        _Pragma("unroll") for (int j = 0; j < NLV; ++j) \
            __builtin_amdgcn_global_load_lds((const unsigned*)((const char*)VT + vsrc[j] + (size_t)(kt_) * 128), (LAS unsigned*)(lds + (slot_) * SLOTB + ATT_KB + (wave + 8 * j) * 1024), 16, 0, 0); } while (0)
        asm volatile("s_waitcnt vmcnt(0)" ::: "memory");
        __syncthreads();
        ATT_ISSUE(kt_hi, 0);
        ATT_ISSUE((ntile > 1 ? kt_hi - 1 : kt_hi), 1);
        if (MODE == 1 && mp == 0) { for (int i = tid; i < 257; i += 512) relb_l[i] = relb[i] * LOG2E; }
        if (MODE == 2) {
#pragma unroll
            for (int i = 0; i < 8; ++i) { const int q = wave * 32 + i * 4 + (lane >> 4), p = lane & 15;
                __builtin_amdgcn_global_load_lds((const unsigned*)((const char*)MASK + ((size_t)(b * SEQ + qt * 256 + q) * 32 + (((p - q) & 15) << 1)) * 8),
                                                 (LAS unsigned*)(lds + XOFF + (wave * 32 + i * 4) * 256), 16, 0, 0); }
        }
        bf16x8 Q[4];
        { const bf16_t* qp = HQ + (size_t)(b * SEQ + tq) * HQP + qoff + mp * 64 + hb * 8;
#pragma unroll
          for (int ks = 0; ks < 4; ++ks) Q[ks] = *(const bf16x8*)(qp + ks * 16); }
        asm volatile("" : "+v"(Q[0]), "+v"(Q[1]), "+v"(Q[2]), "+v"(Q[3]));
        f32x16 O[EB];
        float mref = 0.f, seen = 0.f, lrun = 0.f;
#pragma unroll
        for (int eb = 0; eb < EB; ++eb)
#pragma unroll
            for (int i = 0; i < 16; ++i) O[eb][i] = 0.f;
        asm volatile("s_waitcnt lgkmcnt(0)" ::: "memory");
        int slot = 0;
        for (int jt = 0; jt < ntile; ++jt) {
            const int kt = kt_hi - jt;
            if constexpr (MODE == 0) asm volatile("s_waitcnt vmcnt(3)" ::: "memory"); else asm volatile("s_waitcnt vmcnt(2)" ::: "memory");
            __builtin_amdgcn_s_barrier();
            { const int nj = jt + 2 < ntile ? jt + 2 : ntile - 1; int ns = slot + 2; ns = ns >= 3 ? ns - 3 : ns; ATT_ISSUE(kt_hi - nj, ns); }
            const bool active = (kt <= cq) && (MODE != 1 || kt >= cq - 8);
            if (active) {
                const LAS unsigned char* kbp = lds + slot * SLOTB + krd;
                const LAS unsigned char* vbp = lds + slot * SLOTB + vrd;
                f32x16 S0, S1;
                if (MODE == 0 || MODE == 2) {
                    const float base0 = (float)(tq - kt * 64 - 8 * hb);
                    if (kt == cq) {
#pragma unroll
                        for (int i = 0; i < 16; ++i) { const float off = (float)(16 * (i >> 3) + (i & 7));
                            S0[i] = -slope2 * fabsf(base0 - off) - mref; S1[i] = -slope2 * fabsf(base0 - 32.0f - off) - mref; }
                    } else {
                        const float c0 = -slope2 * base0 - mref, c1 = c0 + 32.0f * slope2;
#pragma unroll
                        for (int i = 0; i < 16; ++i) { S0[i] = so[i] + c0; S1[i] = so[i] + c1; }
                    }
                }
                if (MODE == 2) {
                    const int mq = wave * 32 + ql; const unsigned long long W = *(const LAS unsigned long long*)(lds + XOFF + mq * 256 + ((((kt >> 1) + mq) & 15) << 4) + ((kt & 1) << 3));
                    const unsigned w0 = (unsigned)W >> (8 * hb), w1 = (unsigned)(W >> 32) >> (8 * hb);
#pragma unroll
                    for (int i = 0; i < 16; ++i) { const int off = 16 * (i >> 3) + (i & 7);
                        S0[i] = ((w0 >> off) & 1u) ? S0[i] : NEG_INF_F; S1[i] = ((w1 >> off) & 1u) ? S1[i] : NEG_INF_F; }
                }
                if (MODE == 1) {
                    if (kt >= cq - 2) {
                        const int rel0 = tq - kt * 64 - 8 * hb + 128;
#pragma unroll
                        for (int i = 0; i < 16; ++i) { const int off = 16 * (i >> 3) + (i & 7);
                            int r0 = rel0 - off, r1 = rel0 - 32 - off;
                            r0 = r0 < 0 ? 0 : (r0 > 256 ? 256 : r0); r1 = r1 < 0 ? 0 : (r1 > 256 ? 256 : r1);
                            S0[i] = relb_l[r0] - mref; S1[i] = relb_l[r1] - mref; }
                    } else {
                        const float far = relb_l[256] - mref;
#pragma unroll
                        for (int i = 0; i < 16; ++i) { S0[i] = far; S1[i] = far; }
                    }
                }
#pragma unroll
                for (int ks = 0; ks < 4; ++ks) {
                    const bf16x8 k0 = *(const LAS bf16x8*)(kbp + ((ks << 5) ^ kt_x));
                    const bf16x8 k1 = *(const LAS bf16x8*)(kbp + 4096 + ((ks << 5) ^ kt_x));
                    S0 = MFMA32(k0, Q[ks], S0); S1 = MFMA32(k1, Q[ks], S1);
                }
                float mx = fmaxf(S0[0], S1[0]);
#pragma unroll
                for (int i = 1; i < 16; ++i) mx = fmaxf(mx, fmaxf(S0[i], S1[i]));
                mx = fmaxf(mx, shx(mx, 32, lane));
                const bool unseen = !(seen > 0.f), finite = mx > -1e30f;
                const bool need = unseen ? finite : (mx > ATT_THR);
                if (__ballot(unseen ? finite : (mx >= -150.0f)) != 0ull) {
                    if (__ballot(need) != 0ull) {
                        const float d = need ? mx : 0.f;
                        mref += d; seen = (unseen && finite) ? 1.f : seen;
                        const float alpha = __builtin_amdgcn_exp2f(-d);
                        lrun *= alpha;
#pragma unroll
                        for (int eb = 0; eb < EB; ++eb) O[eb] = O[eb] * alpha;
#pragma unroll
                        for (int i = 0; i < 16; ++i) { S0[i] -= d; S1[i] -= d; }
                    }
                    float ps = 0.f;
#pragma unroll
                    for (int i = 0; i < 16; ++i) { S0[i] = __builtin_amdgcn_exp2f(S0[i]); S1[i] = __builtin_amdgcn_exp2f(S1[i]); ps += S0[i] + S1[i]; }
                    lrun += ps;
                    bf16x8 P[4];
                    { u32x4 p;
                      p.x = pk_bf16(S0[0], S0[1]); p.y = pk_bf16(S0[2], S0[3]); p.z = pk_bf16(S0[4], S0[5]); p.w = pk_bf16(S0[6], S0[7]); P[0] = __builtin_bit_cast(bf16x8, p);
                      p.x = pk_bf16(S0[8], S0[9]); p.y = pk_bf16(S0[10], S0[11]); p.z = pk_bf16(S0[12], S0[13]); p.w = pk_bf16(S0[14], S0[15]); P[1] = __builtin_bit_cast(bf16x8, p);
                      p.x = pk_bf16(S1[0], S1[1]); p.y = pk_bf16(S1[2], S1[3]); p.z = pk_bf16(S1[4], S1[5]); p.w = pk_bf16(S1[6], S1[7]); P[2] = __builtin_bit_cast(bf16x8, p);
                      p.x = pk_bf16(S1[8], S1[9]); p.y = pk_bf16(S1[10], S1[11]); p.z = pk_bf16(S1[12], S1[13]); p.w = pk_bf16(S1[14], S1[15]); P[3] = __builtin_bit_cast(bf16x8, p); }
#pragma unroll
                    for (int s4 = 0; s4 < 4; ++s4)
#pragma unroll
                        for (int eb = 0; eb < EB; ++eb) {
                            const bf16x8 vf = *(const LAS bf16x8*)(vbp + eb * 4096 + ((s4 << 5) ^ vt_x));
                            O[eb] = MFMA32(vf, P[s4], O[eb]);
                        }
                }
            }
            slot = slot == 2 ? 0 : slot + 1;
        }
#undef ATT_ISSUE
        const float inv = 1.0f / (lrun + shx(lrun, 32, lane));
        bf16_t* op = MIX + (size_t)(b * SEQ + tq) * 1024 + mixcol + 4 * hb;
        if (MODE == 0) {
            float* o1p = OA1 + (size_t)(b * SEQ + tq) * 512 + h * 128 + 4 * hb;
            if (mp == 0) {
#pragma unroll
                for (int eb = 0; eb < EB; ++eb)
#pragma unroll
                    for (int g = 0; g < 4; ++g) *(f32x4*)(o1p + eb * 32 + 8 * g) = (f32x4){O[eb][4 * g] * inv, O[eb][4 * g + 1] * inv, O[eb][4 * g + 2] * inv, O[eb][4 * g + 3] * inv};
            } else {
                const float c2 = lam * inv;
                float ss = 0.f;
#pragma unroll
                for (int eb = 0; eb < EB; ++eb)
#pragma unroll
                    for (int g = 0; g < 4; ++g) { const f32x4 o1 = *(const f32x4*)(o1p + eb * 32 + 8 * g);
#pragma unroll
                        for (int j = 0; j < 4; ++j) { const float o = o1[j] - O[eb][4 * g + j] * c2; O[eb][4 * g + j] = o; ss += o * o; } }
                ss += shx(ss, 32, lane);
                const float r = rsqrtf(ss * (1.0f / 128.0f) + EPS) * (1.0f - lam_init);
#pragma unroll
                for (int eb = 0; eb < EB; ++eb)
#pragma unroll
                    for (int g = 0; g < 4; ++g) { const int e0 = eb * 32 + 8 * g; const f32x4 sg = *(const f32x4*)(subg + e0 + 4 * hb);
                        *(u32x2*)(op + e0) = (u32x2){pk_bf16(O[eb][4 * g] * r * sg[0], O[eb][4 * g + 1] * r * sg[1]), pk_bf16(O[eb][4 * g + 2] * r * sg[2], O[eb][4 * g + 3] * r * sg[3])}; }
            }
        } else {
#pragma unroll
            for (int eb = 0; eb < EB; ++eb)
#pragma unroll
                for (int g = 0; g < 4; ++g) { const int e0 = eb * 32 + 8 * g;
                    *(u32x2*)(op + e0) = (u32x2){pk_bf16(O[eb][4 * g] * inv, O[eb][4 * g + 1] * inv), pk_bf16(O[eb][4 * g + 2] * inv, O[eb][4 * g + 3] * inv)}; }
        }
    }
}


constexpr int IDX_STR = 2052;
__device__ __forceinline__ unsigned f2key(float f) { const unsigned u = __float_as_uint(f); return u ^ (((unsigned)((int)u >> 31)) | 0x80000000u); }
template <int J>
__device__ __forceinline__ void index_select(const LAS float* row, const int nb, const int lane, unsigned long long* mo) {
    unsigned u[J];
#pragma unroll
    for (int j = 0; j < J; ++j) u[j] = (j < nb) ? f2key(row[64 * j]) : 0u;
    unsigned prefix = 0u;
#pragma unroll 1
    for (int bit = 31; bit >= 0; --bit) {
        const unsigned cand = prefix | (1u << bit);
        int c = 0;
#pragma unroll
        for (int j0 = 0; j0 < J; j0 += 8) {
            unsigned long long bm[8];
#pragma unroll
            for (int j = 0; j < 8; ++j) bm[j] = __ballot(u[j0 + j] >= cand);
            asm volatile("" : "+s"(bm[0]), "+s"(bm[1]), "+s"(bm[2]), "+s"(bm[3]), "+s"(bm[4]), "+s"(bm[5]), "+s"(bm[6]), "+s"(bm[7]));
#pragma unroll
            for (int j = 0; j < 8; ++j) c += (int)__builtin_popcountll(bm[j]);
        }
        if (c >= 256) prefix = cand;
        if (c == 256) break;
    }
    const unsigned thr = prefix;
    int cg = 0;
#pragma unroll
    for (int j = 0; j < J; ++j) cg += (int)__builtin_popcountll(__ballot(u[j] > thr));
    const int quota = 256 - cg;
    int taken = 0;
    unsigned long long myword = 0ull;
#pragma unroll
    for (int j = 0; j < J; ++j) {
        const bool eq = (u[j] == thr);
        const unsigned long long eqm = __ballot(eq);
        const int before = (int)__builtin_popcountll(eqm & ((1ull << lane) - 1ull));
        const unsigned long long m = __ballot((u[j] > thr) || (eq && (taken + before < quota)));
        taken += (int)__builtin_popcountll(eqm);
        myword = (lane == j) ? m : myword;
    }
    if (lane < 32) mo[lane] = myword;
}
__device__ __forceinline__ void index_unit(LAS unsigned char* lds, const bf16_t* HQ, unsigned long long* MASK, const int b, const int tt, const int wave_in) {
    int wave = wave_in; asm volatile("" : "+s"(wave));
    int lane; asm volatile("v_mbcnt_lo_u32_b32 %0, -1, 0\n\tv_mbcnt_hi_u32_b32 %0, -1, %0" : "=&v"(lane));
    const int t0 = tt * 16, nb = (t0 >> 6) + 1, nk = nb * 64;
    if (nb <= 4) {
        for (int i = wave * 64 + lane; i < 16 * 32; i += 512) MASK[(size_t)(b * SEQ + t0 + (i >> 5)) * 32 + (i & 31)] = ((i & 31) < nb) ? ~0ull : 0ull;
        return;
    }
    LAS float* sc = (LAS float*)lds;
    const int q = lane & 15, g = lane >> 4;
    {
        const bf16_t* qrow = HQ + (size_t)(b * SEQ + t0 + q) * HQP;
        bf16x8 QI[8];
#pragma unroll
        for (int h = 0; h < 8; ++h) QI[h] = *(const bf16x8*)(qrow + HQ_QI + h * 32 + g * 8);
        float w[8];
        { const u32x4 wv = *(const u32x4*)(qrow + HQ_WI);
          w[0] = bf_lo(wv[0]) * 0.0625f; w[1] = bf_hi(wv[0]) * 0.0625f; w[2] = bf_lo(wv[1]) * 0.0625f; w[3] = bf_hi(wv[1]) * 0.0625f;
          w[4] = bf_lo(wv[2]) * 0.0625f; w[5] = bf_hi(wv[2]) * 0.0625f; w[6] = bf_lo(wv[3]) * 0.0625f; w[7] = bf_hi(wv[3]) * 0.0625f; }
        const bf16_t* kbase = HQ + (size_t)(b * SEQ + q) * HQP + HQ_KI + g * 8;
        for (int kb0 = wave; kb0 < nk / 16; kb0 += 32) {
            bf16x8 kf[4];
#pragma unroll
            for (int u = 0; u < 4; ++u) { const int kb = kb0 + 8 * u; kf[u] = (kb < nk / 16) ? *(const bf16x8*)(kbase + (size_t)kb * 16 * HQP) : (bf16x8){0, 0, 0, 0, 0, 0, 0, 0}; }
#pragma unroll
            for (int u = 0; u < 4; ++u) {
                const int kb = kb0 + 8 * u;
                if (kb < nk / 16) {
                    f32x4 acc = {0.f, 0.f, 0.f, 0.f};
#pragma unroll
                    for (int h = 0; h < 8; ++h) {
                        const f32x4 z = __builtin_amdgcn_mfma_f32_16x16x32_f16(kf[u], QI[h], (f32x4){0.f, 0.f, 0.f, 0.f}, 0, 0, 0);
#pragma unroll
                        for (int j = 0; j < 4; ++j) acc[j] = fmaf(w[h], fmaxf(z[j], 0.f), acc[j]);
                    }
#pragma unroll
                    for (int j = 0; j < 4; ++j) acc[j] += 0.0f;
                    *(LAS f32x4*)(sc + q * IDX_STR + kb * 16 + g * 4) = acc;
                }
            }
        }
    }
    __syncthreads();
#pragma unroll 1
    for (int qq = 0; qq < 2; ++qq) {
        const int ql = wave * 2 + qq;
        const LAS float* row = sc + ql * IDX_STR + lane;
        unsigned long long* mo = MASK + (size_t)(b * SEQ + t0 + ql) * 32;
        if (nb <= 8) index_select<8>(row, nb, lane, mo);
        else if (nb <= 16) index_select<16>(row, nb, lane, mo);
        else if (nb <= 24) index_select<24>(row, nb, lane, mo);
        else index_select<32>(row, nb, lane, mo);
    }
    __syncthreads();
}

struct Args {
    const float* x; const float* w_in; const float* lam_q1; const float* lam_k1; const float* lam_q2; const float* lam_k2; const float* subln_g; const float* rel_bias;
    const float* w_out; const float* ln1_g; const float* ln1_b; const float* w_router; const float* b_router; const float* w_gu; const float* b_gu;
    const float* w_down; const float* b_down; const float* ln2_g; const float* ln2_b;
    float* out; unsigned char* ws;
    int ph_lo, ph_hi, bar_region, pad;
};

constexpr int LDS_STAGE = 0;
constexpr int LDS_CTL = 135168;
constexpr int LDS_TSTART = LDS_CTL + 64;
constexpr int LDS_CNT = LDS_TSTART + 36 * 4;
constexpr int LDS_TILEE = LDS_CNT + 32 * 4;
constexpr int LDS_RT = LDS_TILEE + 576;
constexpr int LDS_BYTES = 147456;
static_assert(LDS_RT + (64 + 1024) * 4 <= LDS_BYTES && 16 * IDX_STR * 4 <= LDS_CTL, "LDS map");

__device__ __forceinline__ void transpose_item(const float* W, int N, int k0, int n0, int nvalid, bf16_t* WTrow0, float scale, LAS float* scr, int lane) {
#pragma unroll
    for (int i = 0; i < 32; ++i) { const int kk = 2 * i + (lane >> 5), col = lane & 31; scr[kk * 33 + col] = (col < nvalid) ? W[(size_t)(k0 + kk) * N + n0 + col] * scale : 0.f; }
    asm volatile("s_waitcnt lgkmcnt(0)" ::: "memory");
    const int c = lane & 7;
#pragma unroll
    for (int j = 0; j < 4; ++j) { const int n = (lane >> 3) + 8 * j; const LAS float* s = scr + (8 * c) * 33 + n;
        u32x4 o; o.x = pk_bf16(s[0 * 33], s[1 * 33]); o.y = pk_bf16(s[2 * 33], s[3 * 33]); o.z = pk_bf16(s[4 * 33], s[5 * 33]); o.w = pk_bf16(s[6 * 33], s[7 * 33]);
        if (n < nvalid) *(u32x4*)(WTrow0 + (size_t)n * 1024 + k0 + 8 * c) = o; }
    asm volatile("s_waitcnt lgkmcnt(0)" ::: "memory");
}
__device__ __forceinline__ void transpose_item_fp8(const float* W, int N, int k0, int n0, unsigned char* WTrow0, float scale, LAS float* scr, int lane) {
#pragma unroll
    for (int i = 0; i < 32; ++i) { const int kk = 2 * i + (lane >> 5), col = lane & 31; scr[kk * 33 + col] = W[(size_t)(k0 + kk) * N + n0 + col] * scale; }
    asm volatile("s_waitcnt lgkmcnt(0)" ::: "memory");
    const int c = lane & 3;
#pragma unroll
    for (int j = 0; j < 2; ++j) { const int n = (lane >> 2) + 16 * j; const LAS float* s = scr + (16 * c) * 33 + n;
        u32x4 o; o.x = pk4_fp8(s[0 * 33], s[1 * 33], s[2 * 33], s[3 * 33]); o.y = pk4_fp8(s[4 * 33], s[5 * 33], s[6 * 33], s[7 * 33]);
        o.z = pk4_fp8(s[8 * 33], s[9 * 33], s[10 * 33], s[11 * 33]); o.w = pk4_fp8(s[12 * 33], s[13 * 33], s[14 * 33], s[15 * 33]);
        *(u32x4*)(WTrow0 + (size_t)n * 1024 + k0 + 16 * c) = o; }
    asm volatile("s_waitcnt lgkmcnt(0)" ::: "memory");
}
__device__ __forceinline__ void in_map(int n0, bool& isv, int& row, float& scale) {
    scale = 1.f; isv = false;
    if (n0 < 512) { row = HQ_QA + n0; scale = QSCALE; }
    else if (n0 < 1024) row = HQ_KA + (n0 - 512);
    else if (n0 < 1536) { isv = true; row = VT_A + (n0 - 1024); }
    else if (n0 < 1792) { row = HQ_QB + (n0 - 1536); scale = QSCALE; }
    else if (n0 < 2048) row = HQ_KB + (n0 - 1792);
    else if (n0 < 2304) { isv = true; row = VT_B + (n0 - 2048); }
    else if (n0 < 2560) { row = HQ_QC + (n0 - 2304); scale = QSCALE; }
    else if (n0 < 2816) row = HQ_KC + (n0 - 2560);
    else if (n0 < 3072) { isv = true; row = VT_C + (n0 - 2816); }
    else if (n0 < 3328) row = HQ_QI + (n0 - 3072);
    else if (n0 < 3360) row = HQ_KI + (n0 - 3328);
    else row = HQ_WI + (n0 - 3360);
}

__global__ void __launch_bounds__(512, 2) mega(Args a) {
    extern __shared__ __attribute__((aligned(16))) unsigned char lds_raw[];
    LAS unsigned char* lds = (LAS unsigned char*)lds_raw;
    const int G = gridDim.x, bid = blockIdx.x, NGW = G * 8;
    const int wave0 = __builtin_amdgcn_readfirstlane((int)threadIdx.x >> 6);
#define OPAQUE_IDS() int wave = wave0; asm volatile("" : "+s"(wave)); int lane; asm volatile("v_mbcnt_lo_u32_b32 %0, -1, 0\n\tv_mbcnt_hi_u32_b32 %0, -1, %0" : "=&v"(lane)); const int tid = wave * 64 + lane, gw = bid * 8 + wave; (void)tid; (void)gw
#define WSPTRS() unsigned char* ws = a.ws; asm volatile("" : "+s"(ws)); \
    unsigned* ctl = (unsigned*)(ws + WS_CTL); bf16_t* Win = (bf16_t*)(ws + WS_WIN); bf16_t* Wv = (bf16_t*)(ws + WS_WV); bf16_t* Wout = (bf16_t*)(ws + WS_WOUT); \
    bf16_t* Wgu = (bf16_t*)(ws + WS_WGU); bf16_t* Wdn = (bf16_t*)(ws + WS_WDN); bf16_t* XB = (bf16_t*)(ws + WS_XB); \
    bf16_t* HQ = (bf16_t*)(ws + WS_HQ); bf16_t* VT = (bf16_t*)(ws + WS_VT); bf16_t* MIX = (bf16_t*)(ws + WS_MIX); \
    bf16_t* Y1B = (bf16_t*)(ws + WS_Y1); bf16_t* X1B = (bf16_t*)(ws + WS_X1B); bf16_t* ACT = (bf16_t*)(ws + WS_ACT); bf16_t* YR = (bf16_t*)(ws + WS_YR); \
    int* TOKL = (int*)(ws + WS_TOKL); int* ASGE = (int*)(ws + WS_ASGE); int* ASGS = (int*)(ws + WS_ASGS); float* GATE = (float*)(ws + WS_GATE); \
    (void)ctl; (void)Win; (void)Wv; (void)Wout; (void)Wgu; (void)Wdn; (void)XB; (void)HQ; (void)VT; (void)MIX; (void)Y1B; (void)X1B; (void)ACT; (void)YR; (void)TOKL; (void)ASGE; (void)ASGS; (void)GATE
    for (int u = threadIdx.x; u < (LDS_BYTES - LDS_CTL) / 4; u += 512) ((LAS unsigned*)(lds + LDS_CTL))[u] = 0u;
    __syncthreads();
    XcdBarrier bar = xcd_barrier_post((unsigned*)(a.ws + WS_CTL) + CW_BAR + a.bar_region * XCD_BAR_WORDS, (volatile LAS unsigned*)(lds + LDS_CTL));
    const int lo = a.ph_lo, hi = a.ph_hi;
#define IN(k) (lo <= (k) && (k) < hi)
#define SEAM(k) do { if (IN(k) && IN((k) + 1)) xcd_barrier(bar); } while (0)

    if (IN(0)) PREP(0) {
        OPAQUE_IDS(); WSPTRS();
        LAS float* scr = (LAS float*)(lds + LDS_STAGE + wave * 16384);
        constexpr int I_IN = 16 * 106, I_OUT = 16 * 32, I_GU = 16 * 64, I_DN = 16 * 32;
        constexpr int N_IN = DEPTH * I_IN, N_OUT = DEPTH * I_OUT, N_GU = DEPTH * NE * I_GU, N_DN = DEPTH * NE * I_DN;
        for (int it = gw; it < N_IN + N_OUT + N_GU + N_DN; it += NGW) {
            int r = it;
            if (r < N_IN) { const int l = r / I_IN, q = r % I_IN, kb = q / 106, nb = q % 106, n0 = nb * 32; bool isv; int row; float sc; in_map(n0, isv, row, sc);
                bf16_t* dst = isv ? Wv + ((size_t)l * 1024 + row) * 1024 : Win + ((size_t)l * HQP + row) * 1024;
                transpose_item(a.w_in + (size_t)l * D * DIN, DIN, kb * 64, n0, (DIN - n0) < 32 ? (DIN - n0) : 32, dst, sc, scr, lane); continue; }
            r -= N_IN;
            if (r < N_OUT) { const int l = r / I_OUT, q = r % I_OUT, kb = q / 32, nb = q % 32;
                transpose_item(a.w_out + (size_t)l * 1024 * D, D, kb * 64, nb * 32, 32, Wout + ((size_t)l * D + nb * 32) * 1024, 1.f, scr, lane); continue; }
            r -= N_OUT;
            if (r < N_GU) { const int le = r / I_GU, q = r % I_GU, kb = q / 64, nb = q % 64, n0 = nb * 32;
                const int bj = n0 >> 10, rr = n0 & 1023, pn = rr >> 7, c = rr & 127, nrow = pn * 256 + bj * 128 + c;
#if MOE_FP8
                transpose_item_fp8(a.w_gu + (size_t)le * D * 2048, 2048, kb * 64, n0, (unsigned char*)Wgu + ((size_t)le * 2048 + nrow) * 1024, W8_SCALE, scr, lane); continue; }
#else
                transpose_item(a.w_gu + (size_t)le * D * 2048, 2048, kb * 64, n0, 32, Wgu + ((size_t)le * 2048 + nrow) * 1024, 1.f, scr, lane); continue; }
#endif
            r -= N_GU;
            { const int le = r / I_DN, q = r % I_DN, kb = q / 32, nb = q % 32;
#if MOE_FP8
                transpose_item_fp8(a.w_down + (size_t)le * 1024 * D, D, kb * 64, nb * 32, (unsigned char*)Wdn + ((size_t)le * D + nb * 32) * 1024, W8_SCALE, scr, lane); }
#else
                transpose_item(a.w_down + (size_t)le * 1024 * D, D, kb * 64, nb * 32, 32, Wdn + ((size_t)le * D + nb * 32) * 1024, 1.f, scr, lane); }
#endif
        }
        for (int i = gw * 64 + lane; i < DEPTH * (HQP - HQ_USED) * 128; i += NGW * 64) { const int l = i / ((HQP - HQ_USED) * 128), q = i % ((HQP - HQ_USED) * 128);
            *(u32x4*)(Win + ((size_t)l * HQP + HQ_USED) * 1024 + (size_t)q * 8) = (u32x4){0u, 0u, 0u, 0u}; }
        { bf16_t* WRH = (bf16_t*)(ws + WS_WRT); bf16_t* WRL = WRH + (size_t)DEPTH * NE * D;
          for (int i = gw * 64 + lane; i < DEPTH * NE * D; i += NGW * 64) { const int ll = i / (NE * D), r = i % (NE * D), e = r / D, c = r % D; const float w = a.w_router[((size_t)ll * D + c) * NE + e];
              const unsigned h = pk_bf16(w, 0.f) & 0xffffu; WRH[i] = (bf16_t)h; WRL[i] = (bf16_t)(pk_bf16(w - bf_lo(h), 0.f) & 0xffffu); } }
        for (size_t i = (size_t)gw * 64 + lane; i < (size_t)T * D / 8; i += (size_t)NGW * 64) { const f32x4 v0 = *(const f32x4*)(a.x + i * 8), v1 = *(const f32x4*)(a.x + i * 8 + 4);
            u32x4 w; w.x = pk_bf16(v0[0], v0[1]); w.y = pk_bf16(v0[2], v0[3]); w.z = pk_bf16(v1[0], v1[1]); w.w = pk_bf16(v1[2], v1[3]); *(u32x4*)(XB + i * 8) = w; }
    }
    SEAM(0);

#pragma unroll 1
    for (int l = 0; l < DEPTH; ++l) {
        const int pb = 1 + 8 * l;
        if (IN(pb + 0)) PREP(1) {
            WSPTRS();
            { pg8::DenseOrder S{T / 256, HQP / 256, G, bid, (const char*)(Win + (size_t)l * HQP * 1024), 1024, false};
              pg8::EpiBf16Plain E{HQ, HQP};
              pg8::gemm_phase<pg8::EpiBf16Plain, pg8::DenseOrder, false>(lds + LDS_STAGE, XB, 1024, S, E, wave0); }
            { pg8::DenseOrder S{1024 / 256, T / 256, G, bid, (const char*)XB, 1024, true};
              pg8::EpiBf16Plain E{VT, T};
              pg8::gemm_phase<pg8::EpiBf16Plain, pg8::DenseOrder, false>(lds + LDS_STAGE, Wv + (size_t)l * 1024 * 1024, 1024, S, E, wave0); }
        }
        SEAM(pb + 0);
        if (IN(pb + 1)) {
            OPAQUE_IDS(); WSPTRS();
            unsigned long long* MASKp = (unsigned long long*)(ws + WS_MASK); float* OA1p = (float*)(ws + WS_OA1);
            const float lam_init = 0.8f - 0.6f * expf(-0.3f * (float)l);
            const float lam = expf(wsum(a.lam_q1[l * 64 + lane] * a.lam_k1[l * 64 + lane], lane)) - expf(wsum(a.lam_q2[l * 64 + lane] * a.lam_k2[l * 64 + lane], lane)) + lam_init;
            const int v0 = (G % 8 == 0) ? (bid & 7) * (G >> 3) + (bid >> 3) : bid;
            for (int v = v0; v < 256; v += G) {
                const int b = v >> 4, h = (v >> 2) & 3, q0 = v & 3, j16 = v & 15;
                PREP(2)
#pragma unroll 1
                for (int k = 0; k < 8; ++k) index_unit(lds + LDS_STAGE, HQ, MASKp, b, 16 * k + ((k & 1) ? 15 - j16 : j16), wave);
                PREP(3)
#pragma unroll 1
                for (int rep = 0; rep < 2; ++rep) attn_unit<0>(lds + LDS_STAGE, HQ, VT, MIX, MASKp, OA1p, b, rep ? 3 - h : h, rep ? 7 - q0 : q0, wave, lane, lam, lam_init, a.subln_g + l * 128, nullptr);
                PREP(4)
#pragma unroll 1
                for (int rep = 0; rep < 2; ++rep) attn_unit<1>(lds + LDS_STAGE, HQ, VT, MIX, MASKp, OA1p, b, h, rep ? 7 - q0 : q0, wave, lane, 0.f, 0.f, nullptr, a.rel_bias + ((size_t)l * 4 + h) * 257);
            }
        }
        SEAM(pb + 1);
        if (IN(pb + 2)) {
            OPAQUE_IDS(); WSPTRS();
            unsigned long long* MASKp = (unsigned long long*)(ws + WS_MASK); float* OA1p = (float*)(ws + WS_OA1);
            const int v0 = (G % 8 == 0) ? (bid & 7) * (G >> 3) + (bid >> 3) : bid;
            for (int v = v0; v < 256; v += G) {
                const int b = v >> 4, h = (v >> 2) & 3, q0 = v & 3;
                PREP(5)
#pragma unroll 1
                for (int rep = 0; rep < 2; ++rep) attn_unit<2>(lds + LDS_STAGE, HQ, VT, MIX, MASKp, OA1p, b, rep ? 3 - h : h, rep ? 7 - q0 : q0, wave, lane, 0.f, 0.f, nullptr, nullptr);
            }
        }
        SEAM(pb + 2);
        if (IN(pb + 3)) PREP(6) {
            WSPTRS();
            pg8::DenseOrder S{T / 256, 4, G, bid, (const char*)(Wout + (size_t)l * 1024 * 1024), 1024, false};
            pg8::EpiResBf16 E{Y1B, XB};
            pg8::gemm_phase<pg8::EpiResBf16, pg8::DenseOrder, false>(lds + LDS_STAGE, MIX, 1024, S, E, wave0);
        }
        SEAM(pb + 3);
        if (IN(pb + 4)) PREP(10) {
            OPAQUE_IDS(); WSPTRS();
            if (PROBE == 10 && _rp == 0) { TOKL = (int*)(ws + WS_END); ASGE = TOKL + NE * T; ASGS = ASGE + NASG; GATE = (float*)(ASGS + NASG); }
            LAS int* lcnt = (LAS int*)(lds + LDS_RT); LAS int* lbase = lcnt + 32; LAS int* asg_e = lcnt + 64; LAS int* asg_ls = asg_e + 512;
            const float* g1 = a.ln1_g + l * D; const float* b1 = a.ln1_b + l * D; const float* br = a.b_router + l * NE;
            unsigned* gcnt = ctl + CW_CNT + l * 64 + ((PROBE == 10 && _rp == 0) ? 4096 : 0);
            { const u32x4* srch = (const u32x4*)(ws + WS_WRT) + (size_t)l * 4096; const u32x4* srcl = (const u32x4*)(ws + WS_WRT + (size_t)DEPTH * NE * D * 2) + (size_t)l * 4096;
              for (int i = tid; i < 4096; i += 512) { const int e = i >> 7, c = i & 127, dst = e * 2048 + ((c ^ (e & 15)) << 4);
                  *(LAS u32x4*)(lds + LDS_STAGE + dst) = srch[i]; *(LAS u32x4*)(lds + LDS_STAGE + 65536 + dst) = srcl[i]; } }
            LAS float* st = (LAS float*)(lds + 131072);
            for (int unit = bid; unit < T / 128; unit += G) {
                if (tid < 32) lcnt[tid] = 0;
                __syncthreads();
#pragma unroll 1
                for (int k = 0; k < 8; ++k) {
                    const int tl0 = wave * 16 + 2 * k, t0 = unit * 128 + tl0;
                    float v[2][16];
#pragma unroll
                    for (int tk = 0; tk < 2; ++tk)
#pragma unroll
                        for (int i = 0; i < 4; ++i) { const u32x2 u2 = *(const u32x2*)(Y1B + (size_t)(t0 + tk) * D + i * 256 + lane * 4); v[tk][4 * i] = bf_lo(u2[0]); v[tk][4 * i + 1] = bf_hi(u2[0]); v[tk][4 * i + 2] = bf_lo(u2[1]); v[tk][4 * i + 3] = bf_hi(u2[1]); }
#pragma unroll
                    for (int tk = 0; tk < 2; ++tk) {
                        float s_ = 0.f;
#pragma unroll
                        for (int i = 0; i < 16; ++i) s_ += v[tk][i];
                        const float mean = wsum(s_, lane) * (1.0f / 1024.0f);
                        float qv = 0.f;
#pragma unroll
                        for (int i = 0; i < 16; ++i) { const float d = v[tk][i] - mean; qv += d * d; }
                        const float rstd = rsqrtf(wsum(qv, lane) * (1.0f / 1024.0f) + EPS);
                        if (lane == 0) { st[(tl0 + tk) * 2] = mean; st[(tl0 + tk) * 2 + 1] = rstd; }
                    }
                }
                asm volatile("s_waitcnt lgkmcnt(0)" ::: "memory");
                __builtin_amdgcn_wave_barrier();
                {
                    const int tk = lane & 15, kg = lane >> 4, tl = wave * 16 + tk, t = unit * 128 + tl;
                    const float mean = st[tl * 2], rstd = st[tl * 2 + 1];
                    f32x4 acc0 = {0.f, 0.f, 0.f, 0.f}, acc1 = acc0;
                    const bf16_t* yrow = Y1B + (size_t)t * D + kg * 8;
                    const int e0 = tk, e1 = 16 + tk;
                    const LAS unsigned char* w0p = lds + LDS_STAGE + e0 * 2048; const LAS unsigned char* w1p = lds + LDS_STAGE + e1 * 2048;
#pragma unroll 2
                    for (int ks = 0; ks < 32; ++ks) {
                        const int k0 = ks * 32 + kg * 8;
                        const u32x4 y8 = *(const u32x4*)(yrow + ks * 32);
                        const f32x4 ga = *(const f32x4*)(g1 + k0), gb = *(const f32x4*)(g1 + k0 + 4), ba = *(const f32x4*)(b1 + k0), bb = *(const f32x4*)(b1 + k0 + 4);
                        float x[8];
                        x[0] = (bf_lo(y8[0]) - mean) * rstd * ga[0] + ba[0]; x[1] = (bf_hi(y8[0]) - mean) * rstd * ga[1] + ba[1];
                        x[2] = (bf_lo(y8[1]) - mean) * rstd * ga[2] + ba[2]; x[3] = (bf_hi(y8[1]) - mean) * rstd * ga[3] + ba[3];
                        x[4] = (bf_lo(y8[2]) - mean) * rstd * gb[0] + bb[0]; x[5] = (bf_hi(y8[2]) - mean) * rstd * gb[1] + bb[1];
                        x[6] = (bf_lo(y8[3]) - mean) * rstd * gb[2] + bb[2]; x[7] = (bf_hi(y8[3]) - mean) * rstd * gb[3] + bb[3];
                        u32x4 hx; hx.x = pk_bf16(x[0], x[1]); hx.y = pk_bf16(x[2], x[3]); hx.z = pk_bf16(x[4], x[5]); hx.w = pk_bf16(x[6], x[7]);
                        *(u32x4*)(X1B + (size_t)t * D + k0) = hx;
#if MOE_FP8
                        *(u32x2*)(ws + WS_X1Q + (size_t)t * D + k0) = (u32x2){pk4_fp8(x[0] * X8_SCALE, x[1] * X8_SCALE, x[2] * X8_SCALE, x[3] * X8_SCALE), pk4_fp8(x[4] * X8_SCALE, x[5] * X8_SCALE, x[6] * X8_SCALE, x[7] * X8_SCALE)};
#endif
                        u32x4 lx; lx.x = pk_bf16(x[0] - bf_lo(hx.x), x[1] - bf_hi(hx.x)); lx.y = pk_bf16(x[2] - bf_lo(hx.y), x[3] - bf_hi(hx.y));
                        lx.z = pk_bf16(x[4] - bf_lo(hx.z), x[5] - bf_hi(hx.z)); lx.w = pk_bf16(x[6] - bf_lo(hx.w), x[7] - bf_hi(hx.w));
                        const bf16x8 xh = __builtin_bit_cast(bf16x8, hx), xl = __builtin_bit_cast(bf16x8, lx);
                        const int c0 = ((ks * 4 + kg) ^ tk) << 4;
                        const bf16x8 wh0 = *(const LAS bf16x8*)(w0p + c0), wl0 = *(const LAS bf16x8*)(w0p + 65536 + c0);
                        const bf16x8 wh1 = *(const LAS bf16x8*)(w1p + c0), wl1 = *(const LAS bf16x8*)(w1p + 65536 + c0);
                        acc0 = __builtin_amdgcn_mfma_f32_16x16x32_f16(wh0, xh, acc0, 0, 0, 0); acc1 = __builtin_amdgcn_mfma_f32_16x16x32_f16(wh1, xh, acc1, 0, 0, 0);
                        acc0 = __builtin_amdgcn_mfma_f32_16x16x32_f16(wl0, xh, acc0, 0, 0, 0); acc1 = __builtin_amdgcn_mfma_f32_16x16x32_f16(wl1, xh, acc1, 0, 0, 0);
                        acc0 = __builtin_amdgcn_mfma_f32_16x16x32_f16(wh0, xl, acc0, 0, 0, 0); acc1 = __builtin_amdgcn_mfma_f32_16x16x32_f16(wh1, xl, acc1, 0, 0, 0);
                    }
                    float lv[8]; int li[8];
                    { const f32x4 b0 = *(const f32x4*)(br + kg * 4), b1v = *(const f32x4*)(br + 16 + kg * 4);
#pragma unroll
                      for (int j = 0; j < 4; ++j) { lv[j] = acc0[j] + b0[j]; li[j] = kg * 4 + j; lv[4 + j] = acc1[j] + b1v[j]; li[4 + j] = 16 + kg * 4 + j; } }
                    int be[4]; float bv[4];
#pragma unroll
                    for (int kk = 0; kk < 4; ++kk) {
                        float m = lv[0]; int mi = li[0];
#pragma unroll
                        for (int i = 1; i < 8; ++i) if (lv[i] > m) { m = lv[i]; mi = li[i]; }
                        { const float om = shx(m, 16, lane); const int oi = __float_as_int(shx(__int_as_float(mi), 16, lane)); if (om > m || (om == m && oi < mi)) { m = om; mi = oi; } }
                        { const float om = shx(m, 32, lane); const int oi = __float_as_int(shx(__int_as_float(mi), 32, lane)); if (om > m || (om == m && oi < mi)) { m = om; mi = oi; } }
                        be[kk] = mi; bv[kk] = m;
#pragma unroll
                        for (int i = 0; i < 8; ++i) if (li[i] == mi) lv[i] = -3e38f;
                    }
                    float ex[4], es = 0.f;
#pragma unroll
                    for (int kk = 0; kk < 4; ++kk) { ex[kk] = __expf(bv[kk] - bv[0]); es += ex[kk]; }
                    if (kg == 0) {
#pragma unroll
                        for (int kk = 0; kk < 4; ++kk) { const int sl = __hip_atomic_fetch_add(&lcnt[be[kk]], 1, __ATOMIC_RELAXED, __HIP_MEMORY_SCOPE_WORKGROUP); asg_e[tl * 4 + kk] = be[kk]; asg_ls[tl * 4 + kk] = sl; GATE[t * 4 + kk] = ex[kk] / es; }
                    }
                }
                __syncthreads();
                if (tid < 32) lbase[tid] = (int)__hip_atomic_fetch_add(gcnt + tid, (unsigned)lcnt[tid], __ATOMIC_RELAXED, __HIP_MEMORY_SCOPE_AGENT);
                __syncthreads();
                { const int e = asg_e[tid], sl = lbase[e] + asg_ls[tid], t = unit * 128 + (tid >> 2);
                  TOKL[(size_t)e * T + sl] = t; ASGE[t * 4 + (tid & 3)] = e; ASGS[t * 4 + (tid & 3)] = sl; }
                __syncthreads();
            }
        }
        SEAM(pb + 4);
        LAS int* tstart = (LAS int*)(lds + LDS_TSTART); LAS int* lcntE = (LAS int*)(lds + LDS_CNT); LAS unsigned char* tile_e = lds + LDS_TILEE;
        if (IN(pb + 5) || IN(pb + 6) || IN(pb + 7)) {
            OPAQUE_IDS(); WSPTRS();
            if (tid < 32) lcntE[tid] = (int)__hip_atomic_load(ctl + CW_CNT + l * 64 + tid, __ATOMIC_RELAXED, __HIP_MEMORY_SCOPE_AGENT);
            __syncthreads();
            if (tid == 0) { int acc = 0; for (int e = 0; e < NE; ++e) { tstart[e] = acc; acc += (lcntE[e] + 255) >> 8; } tstart[32] = acc; }
            __syncthreads();
            for (int q = tid; q < MAXRT; q += 512) { int e = 0; for (int k = 0; k < NE; ++k) if (q >= tstart[k]) e = k; tile_e[q] = (unsigned char)e; }
            __syncthreads();
        }
        pg8::MoeTables tb{tstart, lcntE, tile_e, tstart[32]};
        if (IN(pb + 5)) PREP(7) {
            WSPTRS();
#if MOE_FP8
            pg8::MoeOrder S{tb, 8, G, bid, (const char*)Wgu + (size_t)l * NE * 2048 * 1024, (size_t)2048 * 1024, TOKL, true, 1024};
            pg8::EpiSwiglu<true> E{(void*)ACT, a.b_gu + (size_t)l * NE * 2048, 1.0f / (W8_SCALE * X8_SCALE)};
            pg8::gemm_phase<pg8::EpiSwiglu<true>, pg8::MoeOrder, true, 1>(lds + LDS_STAGE, (const bf16_t*)(ws + WS_X1Q), 1024, S, E, wave0);
#else
            pg8::MoeOrder S{tb, 8, G, bid, (const char*)(Wgu + (size_t)l * NE * 2048 * 1024), (size_t)2048 * 1024 * 2, TOKL, true, 2048};
            pg8::EpiSwiglu<false> E{(void*)ACT, a.b_gu + (size_t)l * NE * 2048, 1.0f};
            pg8::gemm_phase<pg8::EpiSwiglu<false>, pg8::MoeOrder, true>(lds + LDS_STAGE, X1B, 1024, S, E, wave0);
#endif
        }
        SEAM(pb + 5);
        if (IN(pb + 6)) PREP(8) {
            WSPTRS();
#if MOE_FP8
            pg8::MoeOrder S{tb, 4, G, bid, (const char*)Wdn + (size_t)l * NE * 1024 * 1024, (size_t)1024 * 1024, TOKL, false, 1024};
            pg8::EpiBiasBf16 E{YR, a.b_down + (size_t)l * NE * 1024, 1.0f / (W8_SCALE * A8_SCALE)};
            pg8::gemm_phase<pg8::EpiBiasBf16, pg8::MoeOrder, false, 1>(lds + LDS_STAGE, ACT, 1024, S, E, wave0);
#else
            pg8::MoeOrder S{tb, 4, G, bid, (const char*)(Wdn + (size_t)l * NE * 1024 * 1024), (size_t)1024 * 1024 * 2, TOKL, false, 2048};
            pg8::EpiBiasBf16 E{YR, a.b_down + (size_t)l * NE * 1024, 1.0f};
            pg8::gemm_phase<pg8::EpiBiasBf16, pg8::MoeOrder, false>(lds + LDS_STAGE, ACT, 1024, S, E, wave0);
#endif
        }
        SEAM(pb + 6);
        if (IN(pb + 7)) PREP(9) {
            OPAQUE_IDS(); WSPTRS();
            const float* g2 = a.ln2_g + l * D; const float* b2 = a.ln2_b + l * D;
            for (int t = gw; t < T; t += NGW) {
                float v[16];
#pragma unroll
                for (int i = 0; i < 4; ++i) { const u32x2 u2 = *(const u32x2*)(X1B + (size_t)t * D + i * 256 + lane * 4);
                    v[4 * i] = ALPHA * bf_lo(u2[0]); v[4 * i + 1] = ALPHA * bf_hi(u2[0]); v[4 * i + 2] = ALPHA * bf_lo(u2[1]); v[4 * i + 3] = ALPHA * bf_hi(u2[1]); }
#pragma unroll
                for (int k = 0; k < 4; ++k) {
                    const int e = ASGE[t * 4 + k]; const float gk = GATE[t * 4 + k];
                    const bf16_t* yp = YR + ((size_t)tstart[e] * 256 + ASGS[t * 4 + k]) * 1024;
#pragma unroll
                    for (int i = 0; i < 4; ++i) { const u32x2 u2 = *(const u32x2*)(yp + i * 256 + lane * 4);
                        v[4 * i] += gk * bf_lo(u2[0]); v[4 * i + 1] += gk * bf_hi(u2[0]); v[4 * i + 2] += gk * bf_lo(u2[1]); v[4 * i + 3] += gk * bf_hi(u2[1]); }
                }
                float s = 0.f;
#pragma unroll
                for (int i = 0; i < 16; ++i) s += v[i];
                const float mean = wsum(s, lane) * (1.0f / 1024.0f);
                float qv = 0.f;
#pragma unroll
                for (int i = 0; i < 16; ++i) { const float d = v[i] - mean; qv += d * d; }
                const float rstd = rsqrtf(wsum(qv, lane) * (1.0f / 1024.0f) + EPS);
#pragma unroll
                for (int i = 0; i < 4; ++i) {
                    const int c0 = i * 256 + lane * 4;
                    const f32x4 gg = *(const f32x4*)(g2 + c0), bb = *(const f32x4*)(b2 + c0);
                    float o[4];
#pragma unroll
                    for (int j = 0; j < 4; ++j) o[j] = (v[4 * i + j] - mean) * rstd * gg[j] + bb[j];
                    if (l == DEPTH - 1) *(f32x4*)(a.out + (size_t)t * D + c0) = (f32x4){o[0], o[1], o[2], o[3]};
                    else *(u32x2*)(XB + (size_t)t * D + c0) = (u32x2){pk_bf16(o[0], o[1]), pk_bf16(o[2], o[3])};
                }
            }
        }
        if (l + 1 < DEPTH) SEAM(pb + 7);
    }
#undef IN
#undef SEAM
}

extern "C" void kernel_launch(void* const* d_in, const int* in_sizes, int n_in, void* d_out, int out_size, void* d_ws, size_t ws_size, hipStream_t stream) {
    static int grid = 0;
    if (grid == 0) {
        if (ws_size < WS_END) { fprintf(stderr, "kernel_launch: workspace too small (%zu < %zu)\n", ws_size, (size_t)WS_END); grid = -1; return; }
        int dev = 0, cus = 0, per_cu = 0;
        if (hipGetDevice(&dev) != hipSuccess || hipDeviceGetAttribute(&cus, hipDeviceAttributeMultiprocessorCount, dev) != hipSuccess) { grid = -1; return; }
        if (hipFuncSetAttribute((const void*)mega, hipFuncAttributeMaxDynamicSharedMemorySize, LDS_BYTES) != hipSuccess) { fprintf(stderr, "kernel_launch: hipFuncSetAttribute failed\n"); grid = -1; return; }
        if (hipOccupancyMaxActiveBlocksPerMultiprocessor(&per_cu, (const void*)mega, 512, LDS_BYTES) != hipSuccess || per_cu < 1) { fprintf(stderr, "kernel_launch: occupancy query says %d\n", per_cu); }
        (void)hipGetLastError();
        grid = cus;
        if (grid % 8 != 0) grid -= grid % 8;
    }
    if (grid < 0) return;
    (void)hipMemsetAsync((char*)d_ws + WS_CTL, 0, CTL_BYTES, stream);
    Args a{};
    a.x = (const float*)d_in[0]; a.w_in = (const float*)d_in[1]; a.lam_q1 = (const float*)d_in[2]; a.lam_k1 = (const float*)d_in[3]; a.lam_q2 = (const float*)d_in[4]; a.lam_k2 = (const float*)d_in[5];
    a.subln_g = (const float*)d_in[6]; a.rel_bias = (const float*)d_in[7]; a.w_out = (const float*)d_in[8]; a.ln1_g = (const float*)d_in[9]; a.ln1_b = (const float*)d_in[10];
    a.w_router = (const float*)d_in[11]; a.b_router = (const float*)d_in[12]; a.w_gu = (const float*)d_in[13]; a.b_gu = (const float*)d_in[14]; a.w_down = (const float*)d_in[15];
    a.b_down = (const float*)d_in[16]; a.ln2_g = (const float*)d_in[17]; a.ln2_b = (const float*)d_in[18];
    a.out = (float*)d_out; a.ws = (unsigned char*)d_ws; a.pad = 0;
    a.ph_lo = 0; a.ph_hi = 1 + 8 * DEPTH; a.bar_region = 0;
    hipLaunchKernelGGL(mega, dim3(grid), dim3(512), LDS_BYTES, stream, a);
}
```

```cpp
#include <hip/hip_runtime.h>
#include <stdint.h>
#include <cstdio>

#define LAS __attribute__((address_space(3)))
typedef unsigned short bf16_t;
typedef _Float16 bf16x8 __attribute__((ext_vector_type(8)));
typedef float f32x4 __attribute__((ext_vector_type(4)));
typedef float f32x2 __attribute__((ext_vector_type(2)));
typedef unsigned u32x4 __attribute__((ext_vector_type(4)));
typedef unsigned u32x2 __attribute__((ext_vector_type(2)));
typedef _Float16 bf16v2 __attribute__((ext_vector_type(2)));

constexpr int D = 1024, BATCH = 16, SEQ = 2048, T = BATCH * SEQ, DEPTH = 4;
constexpr int DIN = 3368;
constexpr int NE = 32;
constexpr float ALPHA = 1.681792830507429f;
constexpr float EPS = 1e-5f;
constexpr float LOG2E = 1.4426950408889634f;
constexpr float QSCALE = 0.125f * LOG2E;
constexpr int HQP = 2560;
constexpr int HQ_QA = 0, HQ_KA = 512, HQ_QB = 1024, HQ_KB = 1280, HQ_QC = 1536, HQ_KC = 1792, HQ_QI = 2048, HQ_KI = 2304, HQ_WI = 2336, HQ_USED = 2344;
constexpr int VT_A = 0, VT_B = 512, VT_C = 768;
constexpr int NASG = T * 4;
constexpr int GROWS = NASG + NE * 256;
constexpr int MAXRT = GROWS / 256;

constexpr size_t MiB = (size_t)1 << 20;
constexpr size_t al(size_t x) { return (x + 255) & ~(size_t)255; }
constexpr size_t WS_CTL = 0, CTL_BYTES = 4 * MiB;
constexpr size_t WS_WIN = WS_CTL + CTL_BYTES;
constexpr size_t WS_WV = WS_WIN + al((size_t)DEPTH * HQP * D * 2);
constexpr size_t WS_WOUT = WS_WV + al((size_t)DEPTH * 1024 * D * 2);
constexpr size_t WS_WGU = WS_WOUT + al((size_t)DEPTH * D * 1024 * 2);
constexpr size_t WS_WDN = WS_WGU + al((size_t)DEPTH * NE * 2048 * D * 2);
constexpr size_t WS_XB = WS_WDN + al((size_t)DEPTH * NE * D * 1024 * 2);
constexpr size_t WS_HQ = WS_XB + al((size_t)T * D * 2);
constexpr size_t WS_VT = WS_HQ + al((size_t)T * HQP * 2);
constexpr size_t WS_MIX = WS_VT + al((size_t)1024 * T * 2);
constexpr size_t WS_Y1 = WS_MIX + al((size_t)T * 1024 * 2);
constexpr size_t WS_X1B = WS_Y1 + al((size_t)T * D * 2);
constexpr size_t WS_ACT = WS_X1B + al((size_t)T * D * 2);
constexpr size_t WS_YR = WS_ACT + al((size_t)GROWS * 1024 * 2);
constexpr size_t WS_MASK = WS_YR + al((size_t)GROWS * 1024 * 2);
constexpr size_t WS_TOKL = WS_MASK + al((size_t)T * 32 * 8);
constexpr size_t WS_ASGE = WS_TOKL + al((size_t)NE * T * 4);
constexpr size_t WS_ASGS = WS_ASGE + al((size_t)NASG * 4);
constexpr size_t WS_GATE = WS_ASGS + al((size_t)NASG * 4);
constexpr size_t WS_OA1 = WS_GATE + al((size_t)NASG * 4);
constexpr size_t WS_WRT = WS_OA1 + al((size_t)T * 512 * 4);
constexpr size_t WS_X1Q = WS_WRT + al((size_t)DEPTH * NE * D * 4);
constexpr size_t WS_END = WS_X1Q + al((size_t)T * D);
constexpr int CW_BAR = 4096;
constexpr int CW_CNT = 262144;

#ifndef MOE_FP8
#define MOE_FP8 1
#endif
constexpr int RTP = 2;
constexpr float W8_SCALE = 512.0f;
constexpr float X8_SCALE = 16.0f;
constexpr float A8_SCALE = 4.0f;
typedef int i32x8 __attribute__((ext_vector_type(8)));
__device__ __forceinline__ unsigned pk_bf16(float lo, float hi) { f32x2 v = {lo, hi}; return __builtin_bit_cast(unsigned, __builtin_convertvector(v, bf16v2)); }
__device__ __forceinline__ float clamp8(float x) { return __builtin_fminf(__builtin_fmaxf(x, -448.0f), 448.0f); }
__device__ __forceinline__ unsigned pk4_fp8(float a, float b, float c, float d) {
    int w = 0; w = __builtin_amdgcn_cvt_pk_fp8_f32(clamp8(a), clamp8(b), w, false); w = __builtin_amdgcn_cvt_pk_fp8_f32(clamp8(c), clamp8(d), w, true); return (unsigned)w; }
__device__ __forceinline__ float bf_lo(unsigned u) { return (float)__builtin_bit_cast(bf16v2, u)[0]; }
__device__ __forceinline__ float bf_hi(unsigned u) { return (float)__builtin_bit_cast(bf16v2, u)[1]; }
__device__ __forceinline__ float bf2f(bf16_t b) { return (float)__builtin_bit_cast(bf16v2, (unsigned)b)[0]; }
__device__ __forceinline__ float wave_sum(float v) {
#pragma unroll
    for (int o = 32; o > 0; o >>= 1) v += __shfl_xor(v, o);
    return v; }
__device__ __forceinline__ float wave_max(float v) {
#pragma unroll
    for (int o = 32; o > 0; o >>= 1) v = fmaxf(v, __shfl_xor(v, o));
    return v; }
__device__ __forceinline__ int wave_sum_i(int v) {
#pragma unroll
    for (int o = 32; o > 0; o >>= 1) v += __shfl_xor(v, o);
    return v; }

__device__ __forceinline__ float shx(float v, int o, int lane) { return __int_as_float(__builtin_amdgcn_ds_bpermute((lane ^ o) << 2, __float_as_int(v))); }
__device__ __forceinline__ float wsum(float v, int lane) {
#pragma unroll
    for (int o = 32; o > 0; o >>= 1) v += shx(v, o, lane);
    return v; }
__device__ __forceinline__ float wmax(float v, int lane) {
#pragma unroll
    for (int o = 32; o > 0; o >>= 1) v = fmaxf(v, shx(v, o, lane));
    return v; }

#define XB_TMO      128
#define XB_XCNT(j)  (256  + 64 * (j))
#define XB_XSUB(j)  (1280 + 64 * (j))
#define XB_XGEN(j)  (2304 + 64 * (j))
#define XB_TOP      3328
#define XB_TOPGEN   3392
#define XCD_BAR_WORDS 3456
#define XB_SPIN_CAP (1u << 22)
__device__ __forceinline__ unsigned xb_ld(unsigned* p)              { return __hip_atomic_load(p, __ATOMIC_RELAXED, __HIP_MEMORY_SCOPE_AGENT); }
__device__ __forceinline__ unsigned xb_add(unsigned* p, unsigned v) { return __hip_atomic_fetch_add(p, v, __ATOMIC_RELAXED, __HIP_MEMORY_SCOPE_AGENT); }
__device__ __forceinline__ unsigned xb_xcc_id() { return (unsigned)__builtin_amdgcn_s_getreg((3 << 11) | 20) & 0xFu; }
#define XB_SPIN(cond, bar) do { unsigned _sp = 0; while (cond) { __builtin_amdgcn_s_sleep(1); \
    if ((++_sp & 255u) == 0u) { if (xb_ld(&(bar)[XB_TMO])) break; if (_sp > XB_SPIN_CAP) { atomicAdd(&(bar)[XB_TMO], 1u); break; } } } } while (0)
struct XcdBarrier { unsigned* bar; unsigned x; volatile LAS unsigned* st; };
__device__ __forceinline__ XcdBarrier xcd_barrier_post(unsigned* bar, volatile LAS unsigned* st) {
    XcdBarrier b; b.bar = bar; b.x = xb_xcc_id(); b.st = st;
    if (threadIdx.x == 0) (void)xb_add(&bar[XB_XCNT(b.x)], 1u);
    return b;
}
__device__ __forceinline__ void xcd_barrier_complete(unsigned* bar, unsigned x, unsigned& nloc, unsigned& nx) {
    const unsigned G = gridDim.x * gridDim.y * gridDim.z;
    unsigned sum, cnt, mine, sp = 0u;
    for (;;) {
        sum = 0u; cnt = 0u; mine = 0u;
#pragma unroll
        for (unsigned j = 0; j < 16; ++j) { const unsigned c = xb_ld(&bar[XB_XCNT(j)]); sum += c; cnt += (c > 0u) ? 1u : 0u; mine = (j == x) ? c : mine; }
        if (sum == G) break;
        __builtin_amdgcn_s_sleep(1);
        if ((++sp & 255u) == 0u) { if (xb_ld(&bar[XB_TMO])) break; if (sp > XB_SPIN_CAP) { atomicAdd(&bar[XB_TMO], 1u); break; } }
    }
    nloc = mine > 0u ? mine : 1u; nx = cnt > 0u ? cnt : 1u;
}
__device__ __forceinline__ void xcd_barrier(const XcdBarrier& b) {
    asm volatile("s_waitcnt vmcnt(0)" ::: "memory");
    __syncthreads();
    if (threadIdx.x == 0) {
        unsigned* bar = b.bar;
        __builtin_amdgcn_s_waitcnt(0);
        unsigned nloc = b.st[0], nx = b.st[1];
        if (nloc == 0u) { xcd_barrier_complete(bar, b.x, nloc, nx); b.st[0] = nloc; b.st[1] = nx; }
        const unsigned old = xb_add(&bar[XB_XSUB(b.x)], 1u);
        const unsigned gen = old / nloc;
        if (old + 1u == (gen + 1u) * nloc) {
            __builtin_amdgcn_fence(__ATOMIC_RELEASE, "agent");
            asm volatile("s_waitcnt vmcnt(0)" ::: "memory");
            const unsigned og = xb_add(&bar[XB_TOP], 1u);
            const unsigned tg = og / nx;
            if (og + 1u == (tg + 1u) * nx) xb_add(&bar[XB_TOPGEN], 1u);
            else XB_SPIN(xb_ld(&bar[XB_TOPGEN]) == tg, bar);
            __builtin_amdgcn_fence(__ATOMIC_ACQUIRE, "agent");
            xb_add(&bar[XB_XGEN(b.x)], 1u);
            asm volatile("s_waitcnt vmcnt(0)" ::: "memory");
        } else {
            XB_SPIN(xb_ld(&bar[XB_XGEN(b.x)]) == gen, bar);
            __builtin_amdgcn_fence(__ATOMIC_ACQUIRE, "agent");
            asm volatile("s_waitcnt vmcnt(0)" ::: "memory");
        }
    }
    __syncthreads();
}

namespace pg8 {
constexpr int BM = 256, BK = 64, HALF = 128, HTB = HALF * BK * 2, STAGE_BYTES = 8 * HTB;
__host__ __device__ __forceinline__ int lds_byte(int r, int c) { const int st = (r >> 4) * 2 + (c >> 5), rr = r & 15, cc = c & 31, ob = rr * 64 + cc * 2; return st * 1024 + (ob ^ (((ob >> 9) & 1) << 5)); }
__host__ __device__ __forceinline__ void stage_rc(int b, int& R, int& C) { const int st = b / 1024, sb = b % 1024, swz = sb ^ (((sb >> 9) & 1) << 5); R = (st >> 1) * 16 + swz / 64; C = (st & 1) * 32 + (swz % 64) / 2; }
__host__ __device__ __forceinline__ int perm32(int rho) { const int n = rho >> 4, i = rho & 15; return 8 * (i >> 2) + 4 * n + (i & 3); }

struct Unit {
    int row0;
    int col0;
    const char* Bt;
    const int* rows;
    int nvalid;
    int e;
};

template <class Epi, class Sched, bool GATHER, int ESZ = 2>
__device__ __forceinline__ void gemm_phase(LAS unsigned char* lds, const bf16_t* Abase, const int K, const Sched& S, const Epi& E, const int wid_in) {
    int wid = wid_in; asm volatile("" : "+s"(wid));
    int lane; asm volatile("v_mbcnt_lo_u32_b32 %0, -1, 0\n\tv_mbcnt_hi_u32_b32 %0, -1, %0" : "=&v"(lane));
    const int tid = wid * 64 + lane, wr = wid >> 2, wc = wid & 3, fr = lane & 15, fq = lane >> 4;
    const int nt = K * ESZ / 128;
    unsigned voffB[2];
#pragma unroll
    for (int i = 0; i < 2; ++i) { int R, C; stage_rc(tid * 16 + i * 8192, R, C); const int Rb = Epi::PERM ? ((R & ~31) + perm32(R & 31)) : R; voffB[i] = (unsigned)(Rb * K * ESZ + C * 2); }
    const size_t kstep = (size_t)(BK * 2);
    const size_t hstep = (size_t)HALF * K * ESZ;
    const unsigned ldsw = (unsigned)wid * 1024u;
    const int aoff = lds_byte(wr * 64 + fr, fq * 8), boff = lds_byte(wc * 32 + fr, fq * 8);
#define PG8_SA(b, h) (((b) * 2 + (h)) * HTB)
#define PG8_SB(b, h) ((4 + (b) * 2 + (h)) * HTB)
#define PG8_STAGE(bufoff, gbase, voff) do { _Pragma("unroll") for (int _i = 0; _i < 2; ++_i) \
        __builtin_amdgcn_global_load_lds((const unsigned*)((const char*)(gbase) + (voff)[_i]), (LAS unsigned*)(lds + (bufoff) + ldsw + _i * 8192), 16, 0, 0); } while (0)
#define PG8_LDA(dst, b, h) do { _Pragma("unroll") for (int m = 0; m < 4; ++m) _Pragma("unroll") for (int k = 0; k < 2; ++k) dst[m][k] = *(const LAS bf16x8*)(lds + PG8_SA(b, h) + aoff + m * 2048 + k * 1024); } while (0)
#define PG8_LDB(dst, b, h) do { _Pragma("unroll") for (int n = 0; n < 2; ++n) _Pragma("unroll") for (int k = 0; k < 2; ++k) dst[n][k] = *(const LAS bf16x8*)(lds + PG8_SB(b, h) + boff + n * 2048 + k * 1024); } while (0)
#define PG8_MMA(ai, bj, At, Bt) do { __builtin_amdgcn_s_setprio(1); _Pragma("unroll") for (int m = 0; m < 4; ++m) _Pragma("unroll") for (int n = 0; n < 2; ++n) { \
        if constexpr (ESZ == 2) { _Pragma("unroll") for (int k = 0; k < 2; ++k) acc[ai][bj][m][n] = __builtin_amdgcn_mfma_f32_16x16x32_f16(Bt[n][k], At[m][k], acc[ai][bj][m][n], 0, 0, 0); } \
        else {   \
            const u32x4 _a0 = __builtin_bit_cast(u32x4, At[m][0]), _a1 = __builtin_bit_cast(u32x4, At[m][1]), _b0 = __builtin_bit_cast(u32x4, Bt[n][0]), _b1 = __builtin_bit_cast(u32x4, Bt[n][1]); \
            const i32x8 _af = {(int)_a0[0], (int)_a0[1], (int)_a0[2], (int)_a0[3], (int)_a1[0], (int)_a1[1], (int)_a1[2], (int)_a1[3]}; \
            const i32x8 _bf = {(int)_b0[0], (int)_b0[1], (int)_b0[2], (int)_b0[3], (int)_b1[0], (int)_b1[1], (int)_b1[2], (int)_b1[3]}; \
              \
            asm volatile("v_mfma_scale_f32_16x16x128_f8f6f4 %0, %1, %2, %0, %3, %3 op_sel_hi:[0,0,0]" : "+v"(acc[ai][bj][m][n]) : "v"(_bf), "v"(_af), "v"(s8)); } } \
        __builtin_amdgcn_s_setprio(0); } while (0)
#define PG8_WAIT_V(n) asm volatile("s_waitcnt vmcnt(" #n ")" ::: "memory")
#define PG8_WAIT_L(n) asm volatile("s_waitcnt lgkmcnt(" #n ")" ::: "memory")
#define PG8_BAR __builtin_amdgcn_s_barrier()
#define PG8_SCHED __builtin_amdgcn_sched_barrier(0)
#define PG8_AOFFS(dst, u) do { _Pragma("unroll") for (int _h = 0; _h < 2; ++_h) _Pragma("unroll") for (int _i = 0; _i < 2; ++_i) { int _R, _C; stage_rc(tid * 16 + _i * 8192, _R, _C); \
        const int _r = _h * HALF + _R; const int _src = (_r < (u).nvalid) ? (u).rows[_r] : 0; dst[_h][_i] = (unsigned)(_src * K * ESZ + _C * 2); } } while (0)
#define PG8_RAWLOAD(dst, u) do { _Pragma("unroll") for (int _h = 0; _h < 2; ++_h) _Pragma("unroll") for (int _i = 0; _i < 2; ++_i) { int _R, _C; stage_rc(tid * 16 + _i * 8192, _R, _C); \
        const int _r = _h * HALF + _R; dst[_h][_i] = (_r < (u).nvalid) ? (u).rows[_r] : 0; } } while (0)
#define PG8_STAGE_A(bufoff, h, ktb, usenext) do { if constexpr (GATHER) { const unsigned _o[2] = {(usenext) ? na[h][0] : oa[h][0], (usenext) ? na[h][1] : oa[h][1]}; PG8_STAGE(bufoff, cA + (ktb), _o); } \
        else { PG8_STAGE(bufoff, ((usenext) ? nA : cA) + (size_t)(h) * hstep + (ktb), voffA); } } while (0)
    Unit cur, nxt; int ui = 0;
    if (!S.next(0, cur)) return;
    f32x4 acc[2][2][4][2];
#pragma unroll
    for (int a = 0; a < 2; ++a)
#pragma unroll
        for (int b = 0; b < 2; ++b)
#pragma unroll
            for (int m = 0; m < 4; ++m)
#pragma unroll
                for (int n = 0; n < 2; ++n) acc[a][b][m][n] = (f32x4){0.f, 0.f, 0.f, 0.f};
    bf16x8 At[4][2], B0[2][2], B1[2][2];
    int s8 = 0x7F7F7F7F; asm volatile("" : "+v"(s8));
    unsigned oa[2][2], na[2][2], voffA[2];
    const char* cA; const char* nA; const char* cB = cur.Bt;
    int raw[2][2] = {{0, 0}, {0, 0}};
    if constexpr (GATHER) { PG8_AOFFS(oa, cur); cA = (const char*)Abase; nA = cA; voffA[0] = voffA[1] = 0u; if (S.next(1, nxt)) { PG8_RAWLOAD(raw, nxt); } }
    else { cA = cur.rows ? (const char*)cur.rows : (const char*)Abase + (size_t)cur.row0 * K * ESZ; nA = cA;
#pragma unroll
        for (int i = 0; i < 2; ++i) { int R, C; stage_rc(tid * 16 + i * 8192, R, C); voffA[i] = (unsigned)(R * K * ESZ + C * 2); oa[0][i] = oa[1][i] = na[0][i] = na[1][i] = 0u; } }
    PG8_STAGE(PG8_SB(0, 0), cB, voffB); PG8_STAGE(PG8_SB(0, 1), cB + hstep, voffB); PG8_STAGE_A(PG8_SA(0, 0), 0, 0, false); PG8_STAGE_A(PG8_SA(0, 1), 1, 0, false);
    if (wr == 1) PG8_BAR;
    PG8_WAIT_V(2); PG8_BAR;
    PG8_STAGE(PG8_SB(1, 0), cB + kstep, voffB); PG8_STAGE_A(PG8_SA(1, 0), 0, kstep, false); PG8_STAGE(PG8_SB(1, 1), cB + hstep + kstep, voffB);
    PG8_WAIT_V(6); PG8_BAR;
    for (;;) {
        const bool has_next = S.next(ui + 1, nxt);
        if constexpr (GATHER) {
            if (has_next) {
#pragma unroll
                for (int h = 0; h < 2; ++h)
#pragma unroll
                    for (int i = 0; i < 2; ++i) { int R, C; stage_rc(tid * 16 + i * 8192, R, C); na[h][i] = (unsigned)(raw[h][i] * K * ESZ + C * 2); }
                asm volatile("" : "+v"(na[0][0]), "+v"(na[0][1]), "+v"(na[1][0]), "+v"(na[1][1]));
            } else {
#pragma unroll
                for (int h = 0; h < 2; ++h)
#pragma unroll
                    for (int i = 0; i < 2; ++i) na[h][i] = oa[h][i];
            }
            Unit n2;
            if (has_next && S.next(ui + 2, n2)) { PG8_RAWLOAD(raw, n2); }
        } else nA = has_next ? (nxt.rows ? (const char*)nxt.rows : (const char*)Abase + (size_t)nxt.row0 * K * ESZ) : cA;
        const char* nB = has_next ? nxt.Bt : cB;
#pragma unroll 1
        for (int t = 0; t < nt; t += 2) {
            const bool last = (t == nt - 2);
            const size_t k1 = (size_t)(t + 1) * kstep, k2 = last ? 0 : (size_t)(t + 2) * kstep, k3 = k2 + kstep;
            const char* b2 = last ? nB : cB + (size_t)(t + 2) * kstep; const char* b3 = b2 + kstep;
            PG8_LDB(B0, 0, 0); PG8_LDB(B1, 0, 1); PG8_SCHED; PG8_LDA(At, 0, 0); PG8_STAGE_A(PG8_SA(1, 1), 1, k1, false);
            PG8_WAIT_V(8); PG8_WAIT_L(0); PG8_BAR; PG8_MMA(0, 0, At, B0); PG8_MMA(0, 1, At, B1); PG8_BAR; PG8_SCHED;
            PG8_LDA(At, 0, 1); PG8_STAGE(PG8_SB(0, 0), b2, voffB); PG8_STAGE(PG8_SB(0, 1), b2 + hstep, voffB); PG8_STAGE_A(PG8_SA(0, 0), 0, k2, last);
            PG8_WAIT_V(8); PG8_WAIT_L(0); PG8_BAR; PG8_MMA(1, 0, At, B0); PG8_MMA(1, 1, At, B1); PG8_BAR; PG8_SCHED;
            PG8_LDB(B0, 1, 0); PG8_LDB(B1, 1, 1); PG8_SCHED; PG8_LDA(At, 1, 0); PG8_STAGE_A(PG8_SA(0, 1), 1, k2, last);
            PG8_WAIT_V(8); PG8_WAIT_L(0); PG8_BAR; PG8_MMA(0, 0, At, B0); PG8_MMA(0, 1, At, B1); PG8_BAR; PG8_SCHED;
            PG8_LDA(At, 1, 1); PG8_STAGE(PG8_SB(1, 0), b3, voffB); PG8_STAGE(PG8_SB(1, 1), b3 + hstep, voffB); PG8_STAGE_A(PG8_SA(1, 0), 0, k3, last);
            PG8_WAIT_V(8); PG8_WAIT_L(0); PG8_BAR; PG8_MMA(1, 0, At, B0); PG8_MMA(1, 1, At, B1); PG8_BAR; PG8_SCHED;
        }
        if constexpr (ESZ == 1) asm volatile("s_nop 15\n\ts_nop 15" ::: "memory");
        if (wr == 0) PG8_BAR;
        E(acc, cur, wr, wc, fr, fq);
        if (!has_next) break;
#pragma unroll
        for (int a = 0; a < 2; ++a)
#pragma unroll
            for (int b = 0; b < 2; ++b)
#pragma unroll
                for (int m = 0; m < 4; ++m)
#pragma unroll
                    for (int n = 0; n < 2; ++n) acc[a][b][m][n] = (f32x4){0.f, 0.f, 0.f, 0.f};
        cur = nxt; cB = nB; ++ui;
        if constexpr (GATHER) {
#pragma unroll
            for (int h = 0; h < 2; ++h)
#pragma unroll
                for (int i = 0; i < 2; ++i) oa[h][i] = na[h][i];
        } else cA = nA;
        if (wr == 1) PG8_BAR;
    }
    PG8_WAIT_V(0);
    PG8_BAR;
#undef PG8_SA
#undef PG8_SB
#undef PG8_STAGE
#undef PG8_LDA
#undef PG8_LDB
#undef PG8_MMA
#undef PG8_WAIT_V
#undef PG8_WAIT_L
#undef PG8_BAR
#undef PG8_SCHED
#undef PG8_AOFFS
#undef PG8_RAWLOAD
#undef PG8_STAGE_A
}

struct DenseOrder {
    int nRT, nN, G, c; const char* Bt; int K; bool swap;
    __device__ __forceinline__ bool next(int i, Unit& u) const {
        const int xcd = c & 7, s = i * (G >> 3) + (c >> 3);
        int rt, pn;
        if (!swap) { rt = 8 * (s / nN) + xcd; pn = s % nN; } else { pn = 8 * (s / nRT) + xcd; rt = s % nRT; }
        if (rt >= nRT || pn >= nN) return false;
        u.row0 = rt * BM; u.col0 = pn * BM; u.Bt = Bt + (size_t)pn * BM * K * 2; u.rows = nullptr; u.nvalid = 0; u.e = 0; return true;
    }
};
struct InProjOrder {
    int G, c; const char* Win; const char* Wv; const char* Xb;
    __device__ __forceinline__ bool next(int i, Unit& u) const {
        constexpr int NM = (T / 256 / 8) * (HQP / 256), NV = (T / 256 / 8) * 4;
        const int xcd = c & 7, s = i * (G >> 3) + (c >> 3);
        if (s < NM) { const int rt = 8 * (s / (HQP / 256)) + xcd, pn = s % (HQP / 256);
            u.row0 = rt * BM; u.col0 = pn * BM; u.Bt = Win + (size_t)pn * BM * 2048; u.rows = (const int*)(Xb + (size_t)rt * BM * 2048); u.nvalid = 0; u.e = 0; return true; }
        const int s2 = s - NM;
        if (s2 >= NV) return false;
        const int pn = 8 * (s2 >> 2) + xcd, rt = s2 & 3;
        u.row0 = rt * BM; u.col0 = pn * BM; u.Bt = Xb + (size_t)pn * BM * 2048; u.rows = (const int*)(Wv + (size_t)rt * BM * 2048); u.nvalid = 0; u.e = 1; return true;
    }
};
struct MoeTables { LAS const int* tstart; LAS const int* cnt; LAS const unsigned char* tile_e; int nrt; };
struct MoeOrder {
    MoeTables tb; int nN, G, c; const char* Bt; size_t strideB; const int* tokl; bool gather; int rowb;
    __device__ __forceinline__ bool next(int i, Unit& u) const {
        const int xcd = c & 7, s = i * (G >> 3) + (c >> 3);
        const int q = 8 * (s / nN) + xcd, pn = s % nN;
        if (q >= tb.nrt) return false;
        const int e = __builtin_amdgcn_readfirstlane((int)tb.tile_e[q]); const int lt = q - __builtin_amdgcn_readfirstlane(tb.tstart[e]);
        u.row0 = q * BM; u.col0 = pn * BM; u.e = e; u.Bt = Bt + (size_t)e * strideB + (size_t)pn * BM * rowb;
        u.rows = gather ? tokl + (size_t)e * T + lt * BM : nullptr; u.nvalid = __builtin_amdgcn_readfirstlane(tb.cnt[e]) - lt * BM; return true;
    }
};

struct EpiBf16Plain {
    static constexpr bool PERM = true;
    bf16_t* O; int ldc;
    __device__ __forceinline__ void operator()(const f32x4 (&acc)[2][2][4][2], const Unit& u, int wr, int wc, int fr, int fq) const {
        const int row0 = u.row0 + wr * 64 + fr, col0 = u.col0 + wc * 32 + 8 * fq;
#pragma unroll
        for (int ai = 0; ai < 2; ++ai)
#pragma unroll
            for (int m = 0; m < 4; ++m) { bf16_t* rowp = O + (size_t)(row0 + ai * HALF + m * 16) * ldc + col0;
#pragma unroll
                for (int bj = 0; bj < 2; ++bj) { const f32x4 v0 = acc[ai][bj][m][0], v1 = acc[ai][bj][m][1];
                    u32x4 w; w.x = pk_bf16(v0[0], v0[1]); w.y = pk_bf16(v0[2], v0[3]); w.z = pk_bf16(v1[0], v1[1]); w.w = pk_bf16(v1[2], v1[3]);
                    *(u32x4*)(rowp + bj * HALF) = w; } }
    }
};
struct EpiInProj {
    static constexpr bool PERM = true;
    bf16_t* Ohq; bf16_t* Ovt;
    __device__ __forceinline__ void operator()(const f32x4 (&acc)[2][2][4][2], const Unit& u, int wr, int wc, int fr, int fq) const {
        bf16_t* O = u.e ? Ovt : Ohq; const int ldc = u.e ? T : HQP;
        const int row0 = u.row0 + wr * 64 + fr, col0 = u.col0 + wc * 32 + 8 * fq;
#pragma unroll
        for (int ai = 0; ai < 2; ++ai)
#pragma unroll
            for (int m = 0; m < 4; ++m) { bf16_t* rowp = O + (size_t)(row0 + ai * HALF + m * 16) * ldc + col0;
#pragma unroll
                for (int bj = 0; bj < 2; ++bj) { const f32x4 v0 = acc[ai][bj][m][0], v1 = acc[ai][bj][m][1];
                    u32x4 w; w.x = pk_bf16(v0[0], v0[1]); w.y = pk_bf16(v0[2], v0[3]); w.z = pk_bf16(v1[0], v1[1]); w.w = pk_bf16(v1[2], v1[3]);
                    *(u32x4*)(rowp + bj * HALF) = w; } }
    }
};
struct EpiResBf16 {
    static constexpr bool PERM = true;
    bf16_t* O; const bf16_t* R;
    __device__ __forceinline__ void operator()(const f32x4 (&acc)[2][2][4][2], const Unit& u, int wr, int wc, int fr, int fq) const {
        const int row0 = u.row0 + wr * 64 + fr, col0 = u.col0 + wc * 32 + 8 * fq;
#pragma unroll
        for (int ai = 0; ai < 2; ++ai)
#pragma unroll
            for (int m = 0; m < 4; ++m) { const size_t off = (size_t)(row0 + ai * HALF + m * 16) * 1024 + col0;
#pragma unroll
                for (int bj = 0; bj < 2; ++bj) { const u32x4 r = __builtin_nontemporal_load((const u32x4*)(R + off + bj * HALF)); const f32x4 v0 = acc[ai][bj][m][0], v1 = acc[ai][bj][m][1];
                    u32x4 w; w.x = pk_bf16(bf_lo(r[0]) * ALPHA + v0[0], bf_hi(r[0]) * ALPHA + v0[1]); w.y = pk_bf16(bf_lo(r[1]) * ALPHA + v0[2], bf_hi(r[1]) * ALPHA + v0[3]);
                    w.z = pk_bf16(bf_lo(r[2]) * ALPHA + v1[0], bf_hi(r[2]) * ALPHA + v1[1]); w.w = pk_bf16(bf_lo(r[3]) * ALPHA + v1[2], bf_hi(r[3]) * ALPHA + v1[3]);
                    *(u32x4*)(O + off + bj * HALF) = w; } }
    }
};
template <bool F8> struct EpiSwiglu {
    static constexpr bool PERM = true;
    void* Ov; const float* bias; float ascale;
    __device__ __forceinline__ void operator()(const f32x4 (&acc)[2][2][4][2], const Unit& u, int wr, int wc, int fr, int fq) const {
        const int row0 = u.row0 + wr * 64 + fr, oc = (u.col0 >> 1) + wc * 32 + 8 * fq;
        const float* bp = bias + (size_t)u.e * 2048 + oc;
        f32x4 bg[2], bu[2];
#pragma unroll
        for (int n = 0; n < 2; ++n) { bg[n] = *(const f32x4*)(bp + 4 * n); bu[n] = *(const f32x4*)(bp + 1024 + 4 * n); }
#pragma unroll
        for (int ai = 0; ai < 2; ++ai)
#pragma unroll
            for (int m = 0; m < 4; ++m) {
                float o[8];
#pragma unroll
                for (int n = 0; n < 2; ++n) { const f32x4 g4 = acc[ai][0][m][n] * ascale + bg[n], u4 = acc[ai][1][m][n] * ascale + bu[n];
#pragma unroll
                    for (int j = 0; j < 4; ++j) { const float g = fminf(g4[j], 7.0f), up = __builtin_amdgcn_fmed3f(u4[j], -7.0f, 7.0f);
                        constexpr float OS = F8 ? A8_SCALE : 1.0f;
                        const float e = __builtin_amdgcn_exp2f(-1.702f * LOG2E * g), glu = g * __builtin_amdgcn_rcpf(__builtin_fmaf(e, 1.0f / OS, 1.0f / OS)); o[4 * n + j] = __builtin_fmaf(up, glu, glu); } }
                if constexpr (F8) {
                    int w0 = 0, w1 = 0; w0 = __builtin_amdgcn_cvt_pk_fp8_f32(o[0], o[1], w0, false); w0 = __builtin_amdgcn_cvt_pk_fp8_f32(o[2], o[3], w0, true);
                    w1 = __builtin_amdgcn_cvt_pk_fp8_f32(o[4], o[5], w1, false); w1 = __builtin_amdgcn_cvt_pk_fp8_f32(o[6], o[7], w1, true);
                    *(u32x2*)((unsigned char*)Ov + (size_t)(row0 + ai * HALF + m * 16) * 1024 + oc) = (u32x2){(unsigned)w0, (unsigned)w1}; }
                else { u32x4 w; w.x = pk_bf16(o[0], o[1]); w.y = pk_bf16(o[2], o[3]); w.z = pk_bf16(o[4], o[5]); w.w = pk_bf16(o[6], o[7]);
                    *(u32x4*)((bf16_t*)Ov + (size_t)(row0 + ai * HALF + m * 16) * 1024 + oc) = w; } }
    }
};
struct EpiBiasBf16 {
    static constexpr bool PERM = true;
    bf16_t* O; const float* bias; float ascale;
    __device__ __forceinline__ void operator()(const f32x4 (&acc)[2][2][4][2], const Unit& u, int wr, int wc, int fr, int fq) const {
        const int row0 = u.row0 + wr * 64 + fr, col0 = u.col0 + wc * 32 + 8 * fq;
        const float* bp = bias + (size_t)u.e * 1024 + col0;
        f32x4 bv[2][2];
#pragma unroll
        for (int bj = 0; bj < 2; ++bj)
#pragma unroll
            for (int n = 0; n < 2; ++n) bv[bj][n] = *(const f32x4*)(bp + bj * HALF + 4 * n);
#pragma unroll
        for (int ai = 0; ai < 2; ++ai)
#pragma unroll
            for (int m = 0; m < 4; ++m) { bf16_t* rowp = O + (size_t)(row0 + ai * HALF + m * 16) * 1024 + col0;
#pragma unroll
                for (int bj = 0; bj < 2; ++bj) { const f32x4 v0 = acc[ai][bj][m][0] * ascale + bv[bj][0], v1 = acc[ai][bj][m][1] * ascale + bv[bj][1];
                    u32x4 w; w.x = pk_bf16(v0[0], v0[1]); w.y = pk_bf16(v0[2], v0[3]); w.z = pk_bf16(v1[0], v1[1]); w.w = pk_bf16(v1[2], v1[3]);
                    *(u32x4*)(rowp + bj * HALF) = w; } }
    }
};
}


#ifndef ATT_EN
#define ATT_EN 7
#endif
#ifndef PROBE
#define PROBE (-1)
#endif
#define PREP(k) _Pragma("unroll 1") for (int _rp = ((PROBE == (k)) ? 0 : 1); _rp < 2; ++_rp)
typedef float f32x16 __attribute__((ext_vector_type(16)));
#define MFMA32(a, b, c) __builtin_amdgcn_mfma_f32_32x32x16_f16((a), (b), (c), 0, 0, 0)
constexpr float ATT_THR = 8.0f;
constexpr int ATT_KB = 8192;
#define NEG_INF_F (-__builtin_huge_valf())

template <int MODE>
__device__ __forceinline__ void attn_unit(LAS unsigned char* lds, const bf16_t* HQ, const bf16_t* VT, bf16_t* MIX, const unsigned long long* MASK, float* OA1,
                                          const int b, const int h, const int qt, const int wave_in, const int lane_unused,
                                          const float lam, const float lam_init, const float* subg, const float* relb) {
    int wave = wave_in; asm volatile("" : "+s"(wave));
    constexpr int NPASS = (MODE == 0) ? 2 : 1;
    constexpr int EB = (MODE == 0) ? 4 : 2;
    constexpr int NLV = EB / 2;
    constexpr int SLOTB = ATT_KB + EB * 32 * 128;
    constexpr int XOFF = 3 * SLOTB;
    const int qoff = (MODE == 0) ? HQ_QA + h * 128 : (MODE == 1) ? HQ_QB + h * 64 : HQ_QC + h * 64;
    const int koff = (MODE == 0) ? HQ_KA + h * 128 : (MODE == 1) ? HQ_KB + h * 64 : HQ_KC + h * 64;
    const int vrow0 = (MODE == 0) ? VT_A + h * 128 : (MODE == 1) ? VT_B + h * 64 : VT_C + h * 64;
    const int mixcol = (MODE == 0) ? h * 128 : (MODE == 1) ? 512 + h * 64 : 768 + h * 64;
    int lane; asm volatile("v_mbcnt_lo_u32_b32 %0, -1, 0\n\tv_mbcnt_hi_u32_b32 %0, -1, %0" : "=&v"(lane));
    const int tid = wave * 64 + lane, ql = lane & 31, hb = lane >> 5;
    const int cq = qt * 4 + (wave >> 1);
    const int tq = qt * 256 + wave * 32 + ql;
    const int kt_hi = qt * 4 + 3;
    const int kt_lo = (MODE == 1) ? ((qt * 4 - 8) > 0 ? (qt * 4 - 8) : 0) : 0;
    const int ntile = kt_hi - kt_lo + 1;
    const float slope2 = (MODE == 0) ? exp2f(-(float)(2 * h + 1)) * LOG2E : exp2f(-(float)(2 * h + 2)) * LOG2E;
    LAS float* relb_l = (LAS float*)(lds + XOFF);
    float so[16];
#pragma unroll
    for (int i = 0; i < 16; ++i) { int oi = 16 * (i >> 3) + (i & 7); asm volatile("" : "+s"(oi));
        so[i] = __int_as_float(__builtin_amdgcn_readfirstlane(__float_as_int(slope2 * (float)oi))); }
    const int prow = (ql & 16) | ((ql & 4) << 1) | ((ql & 8) >> 1) | (ql & 3);
    const int kt_x = (hb ^ ((prow >> 1) & 7)) << 4, vt_x = (hb ^ ((ql >> 1) & 7)) << 4;
    const int krd = prow * 128, vrd = ATT_KB + ql * 128;
    const int drow = lane >> 3, dpos = lane & 7;
    const int krow_g = 8 * wave + drow;
    const size_t ksrc = ((size_t)(b * SEQ + krow_g) * HQP + koff + ((dpos ^ ((krow_g >> 1) & 7)) << 3)) * 2;
    size_t vsrc[NLV];
#pragma unroll
    for (int j = 0; j < NLV; ++j) { const int vr = 8 * (wave + 8 * j) + drow; vsrc[j] = ((size_t)(vrow0 + vr) * T + (size_t)b * SEQ + ((dpos ^ ((vr >> 1) & 7)) << 3)) * 2; }

#pragma unroll 1
    for (int mp = 0; mp < NPASS; ++mp) {
#define ATT_ISSUE(kt_, slot_) do { \
        __builtin_amdgcn_global_load_lds((const unsigned*)((const char*)HQ + ksrc + (size_t)(kt_) * (64 * HQP * 2) + mp * 128), (LAS unsigned*)(lds + (slot_) * SLOTB + wave * 1024), 16, 0, 0); \
        _Pragma("unroll") for (int j = 0; j < NLV; ++j) \
            __builtin_amdgcn_global_load_lds((const unsigned*)((const char*)VT + vsrc[j] + (size_t)(kt_) * 128), (LAS unsigned*)(lds + (slot_) * SLOTB + ATT_KB + (wave + 8 * j) * 1024), 16, 0, 0); } while (0)
        asm volatile("s_waitcnt vmcnt(0)" ::: "memory");
        __syncthreads();
        ATT_ISSUE(kt_hi, 0);
        ATT_ISSUE((ntile > 1 ? kt_hi - 1 : kt_hi), 1);
        if (MODE == 1 && mp == 0) { for (int i = tid; i < 320; i += 512) relb_l[i] = relb[i < 256 ? i : 256] * LOG2E; }
        if (MODE == 2) {
#pragma unroll
            for (int i = 0; i < 8; ++i) { const int q = wave * 32 + i * 4 + (lane >> 4), p = lane & 15;
                __builtin_amdgcn_global_load_lds((const unsigned*)((const char*)MASK + ((size_t)(b * SEQ + qt * 256 + q) * 32 + (((p - q) & 15) << 1)) * 8),
                                                 (LAS unsigned*)(lds + XOFF + (wave * 32 + i * 4) * 256), 16, 0, 0); }
        }
        bf16x8 Q[4];
        { const bf16_t* qp = HQ + (size_t)(b * SEQ + tq) * HQP + qoff + mp * 64 + hb * 8;
#pragma unroll
          for (int ks = 0; ks < 4; ++ks) Q[ks] = *(const bf16x8*)(qp + ks * 16); }
        asm volatile("" : "+v"(Q[0]), "+v"(Q[1]), "+v"(Q[2]), "+v"(Q[3]));
        f32x16 O[EB];
        float mref = 0.f, seen = 0.f, lrun = 0.f;
#pragma unroll
        for (int eb = 0; eb < EB; ++eb)
#pragma unroll
            for (int i = 0; i < 16; ++i) O[eb][i] = 0.f;
        asm volatile("s_waitcnt lgkmcnt(0)" ::: "memory");
        int slot = 0;
        for (int jt = 0; jt < ntile; ++jt) {
            const int kt = kt_hi - jt;
            if constexpr (MODE == 0) asm volatile("s_waitcnt vmcnt(3)" ::: "memory"); else asm volatile("s_waitcnt vmcnt(2)" ::: "memory");
            __builtin_amdgcn_s_barrier();
            { const int nj = jt + 2 < ntile ? jt + 2 : ntile - 1; int ns = slot + 2; ns = ns >= 3 ? ns - 3 : ns; ATT_ISSUE(kt_hi - nj, ns); }
            const bool active = (kt <= cq) && (MODE != 1 || kt >= cq - 8);
            if (active) {
                const LAS unsigned char* kbp = lds + slot * SLOTB + krd;
                const LAS unsigned char* vbp = lds + slot * SLOTB + vrd;
                f32x16 S0, S1;
                if (MODE == 0 || MODE == 2) {
                    const float base0 = (float)(tq - kt * 64 - 8 * hb);
                    if (kt == cq) {
#pragma unroll
                        for (int i = 0; i < 16; ++i) { const float off = (float)(16 * (i >> 3) + (i & 7));
                            S0[i] = -slope2 * fabsf(base0 - off) - mref; S1[i] = -slope2 * fabsf(base0 - 32.0f - off) - mref; }
                    } else {
                        const float c0 = -slope2 * base0 - mref, c1 = c0 + 32.0f * slope2;
#pragma unroll
                        for (int i = 0; i < 16; ++i) { S0[i] = so[i] + c0; S1[i] = so[i] + c1; }
                    }
                }
                if (MODE == 2) {
                    const int mq = wave * 32 + ql; const unsigned long long W = *(const LAS unsigned long long*)(lds + XOFF + mq * 256 + ((((kt >> 1) + mq) & 15) << 4) + ((kt & 1) << 3));
                    const unsigned w0 = (unsigned)W >> (8 * hb), w1 = (unsigned)(W >> 32) >> (8 * hb);
#pragma unroll
                    for (int i = 0; i < 16; ++i) { const int off = 16 * (i >> 3) + (i & 7);
                        const int m0 = __builtin_amdgcn_sbfe((int)w0, off, 1), m1 = __builtin_amdgcn_sbfe((int)w1, off, 1);
                        S0[i] = __int_as_float((__float_as_int(S0[i]) & m0) | ((int)0xFF800000 & ~m0)); S1[i] = __int_as_float((__float_as_int(S1[i]) & m1) | ((int)0xFF800000 & ~m1)); }
                }
                if (MODE == 1) {
                    if (kt >= cq - 2) {
                        const int rel0 = tq - kt * 64 - 8 * hb + 128;
#pragma unroll
                        for (int i = 0; i < 16; ++i) { const int off = 16 * (i >> 3) + (i & 7);
                            S0[i] = relb_l[rel0 - off] - mref; S1[i] = relb_l[rel0 - 32 - off] - mref; }
                    } else {
                        const float far = relb_l[256] - mref;
#pragma unroll
                        for (int i = 0; i < 16; ++i) { S0[i] = far; S1[i] = far; }
                    }
                }
                bf16x8 kf[8], vf0[8];
#pragma unroll
                for (int ks = 0; ks < 4; ++ks) { kf[2 * ks] = *(const LAS bf16x8*)(kbp + ((ks << 5) ^ kt_x)); kf[2 * ks + 1] = *(const LAS bf16x8*)(kbp + 4096 + ((ks << 5) ^ kt_x)); }
#pragma unroll
                for (int i = 0; i < 8; ++i) { const int s4i = i / EB, eb = i % EB; vf0[i] = *(const LAS bf16x8*)(vbp + eb * 4096 + ((s4i << 5) ^ vt_x)); }
#pragma unroll
                for (int ks = 0; ks < 4; ++ks) { S0 = MFMA32(kf[2 * ks], Q[ks], S0); S1 = MFMA32(kf[2 * ks + 1], Q[ks], S1); }
                __builtin_amdgcn_sched_group_barrier(0x100, 16, 0); __builtin_amdgcn_sched_group_barrier(0x008, 8, 0);
                float mx; asm("s_nop 15\n\ts_nop 3\n\tv_max3_f32 %0, %1, %2, %3" : "=v"(mx) : "v"(S0[0]), "v"(S1[0]), "v"(S0[1]));
                asm("v_max3_f32 %0, %1, %2, %3" : "=v"(mx) : "v"(mx), "v"(S1[1]), "v"(S0[2]));
#pragma unroll
                for (int i = 2; i < 15; ++i) asm("v_max3_f32 %0, %1, %2, %3" : "=v"(mx) : "v"(mx), "v"(S1[i]), "v"(S0[i + 1]));
                asm("v_max_f32 %0, %1, %2" : "=v"(mx) : "v"(mx), "v"(S1[15]));
                mx = fmaxf(mx, shx(mx, 32, lane));
                const bool unseen = !(seen > 0.f), finite = mx > -1e30f;
                const bool need = unseen ? finite : (mx > ATT_THR);
                if (__ballot(unseen ? finite : (mx >= -36.0f)) != 0ull) {
                    if (__ballot(need) != 0ull) {
                        const float d = need ? mx : 0.f;
                        mref += d; seen = (unseen && finite) ? 1.f : seen;
                        const float alpha = unseen ? 1.0f : __builtin_amdgcn_exp2f(-d);
                        lrun *= alpha;
#pragma unroll
                        for (int eb = 0; eb < EB; ++eb) O[eb] = O[eb] * alpha;
#pragma unroll
                        for (int i = 0; i < 16; ++i) { S0[i] -= d; S1[i] -= d; }
                    }
                    float ps = 0.f;
#pragma unroll
                    for (int i = 0; i < 16; ++i) { S0[i] = __builtin_amdgcn_exp2f(S0[i]); S1[i] = __builtin_amdgcn_exp2f(S1[i]); ps += S0[i] + S1[i]; }
                    lrun += ps;
                    bf16x8 P[4];
                    { u32x4 p;
                      p.x = pk_bf16(S0[0], S0[1]); p.y = pk_bf16(S0[2], S0[3]); p.z = pk_bf16(S0[4], S0[5]); p.w = pk_bf16(S0[6], S0[7]); P[0] = __builtin_bit_cast(bf16x8, p);
                      p.x = pk_bf16(S0[8], S0[9]); p.y = pk_bf16(S0[10], S0[11]); p.z = pk_bf16(S0[12], S0[13]); p.w = pk_bf16(S0[14], S0[15]); P[1] = __builtin_bit_cast(bf16x8, p);
                      p.x = pk_bf16(S1[0], S1[1]); p.y = pk_bf16(S1[2], S1[3]); p.z = pk_bf16(S1[4], S1[5]); p.w = pk_bf16(S1[6], S1[7]); P[2] = __builtin_bit_cast(bf16x8, p);
                      p.x = pk_bf16(S1[8], S1[9]); p.y = pk_bf16(S1[10], S1[11]); p.z = pk_bf16(S1[12], S1[13]); p.w = pk_bf16(S1[14], S1[15]); P[3] = __builtin_bit_cast(bf16x8, p); }
                    if constexpr (EB == 4) {
                        bf16x8 vf1[8];
#pragma unroll
                        for (int i = 0; i < 8; ++i) { const int s4i = 2 + i / EB, eb = i % EB; vf1[i] = *(const LAS bf16x8*)(vbp + eb * 4096 + ((s4i << 5) ^ vt_x)); }
#pragma unroll
                        for (int i = 0; i < 8; ++i) { const int s4i = i / EB, eb = i % EB; O[eb] = MFMA32(vf0[i], P[s4i], O[eb]); }
#pragma unroll
                        for (int i = 0; i < 8; ++i) { const int s4i = 2 + i / EB, eb = i % EB; O[eb] = MFMA32(vf1[i], P[s4i], O[eb]); }
                        __builtin_amdgcn_sched_group_barrier(0x100, 8, 0); __builtin_amdgcn_sched_group_barrier(0x008, 16, 0);
                    } else {
#pragma unroll
                        for (int i = 0; i < 8; ++i) { const int s4i = i / EB, eb = i % EB; O[eb] = MFMA32(vf0[i], P[s4i], O[eb]); }
                    }
                }
            }
            slot = slot == 2 ? 0 : slot + 1;
        }
#undef ATT_ISSUE
        const float inv = 1.0f / (lrun + shx(lrun, 32, lane));
        bf16_t* op = MIX + (size_t)(b * SEQ + tq) * 1024 + mixcol + 4 * hb;
        if (MODE == 0) {
            bf16_t* o1p = (bf16_t*)OA1 + (size_t)(b * SEQ + tq) * 512 + h * 128 + 4 * hb;
            if (mp == 0) {
#pragma unroll
                for (int eb = 0; eb < EB; ++eb)
#pragma unroll
                    for (int g = 0; g < 4; ++g) *(u32x2*)(o1p + eb * 32 + 8 * g) = (u32x2){pk_bf16(O[eb][4 * g] * inv, O[eb][4 * g + 1] * inv), pk_bf16(O[eb][4 * g + 2] * inv, O[eb][4 * g + 3] * inv)};
            } else {
                const float c2 = lam * inv;
                float ss = 0.f;
#pragma unroll
                for (int eb = 0; eb < EB; ++eb)
#pragma unroll
                    for (int g = 0; g < 4; ++g) { const u32x2 o1h = *(const u32x2*)(o1p + eb * 32 + 8 * g); const f32x4 o1 = {bf_lo(o1h[0]), bf_hi(o1h[0]), bf_lo(o1h[1]), bf_hi(o1h[1])};
#pragma unroll
                        for (int j = 0; j < 4; ++j) { const float o = o1[j] - O[eb][4 * g + j] * c2; O[eb][4 * g + j] = o; ss += o * o; } }
                ss += shx(ss, 32, lane);
                const float r = rsqrtf(ss * (1.0f / 128.0f) + EPS) * (1.0f - lam_init);
#pragma unroll
                for (int eb = 0; eb < EB; ++eb)
#pragma unroll
                    for (int g = 0; g < 4; ++g) { const int e0 = eb * 32 + 8 * g; const f32x4 sg = *(const f32x4*)(subg + e0 + 4 * hb);
                        *(u32x2*)(op + e0) = (u32x2){pk_bf16(O[eb][4 * g] * r * sg[0], O[eb][4 * g + 1] * r * sg[1]), pk_bf16(O[eb][4 * g + 2] * r * sg[2], O[eb][4 * g + 3] * r * sg[3])}; }
            }
        } else {
#pragma unroll
            for (int eb = 0; eb < EB; ++eb)
#pragma unroll
                for (int g = 0; g < 4; ++g) { const int e0 = eb * 32 + 8 * g;
                    *(u32x2*)(op + e0) = (u32x2){pk_bf16(O[eb][4 * g] * inv, O[eb][4 * g + 1] * inv), pk_bf16(O[eb][4 * g + 2] * inv, O[eb][4 * g + 3] * inv)}; }
        }
    }
}


constexpr int IDX_STR = 2052;
__device__ __forceinline__ unsigned f2key(float f) { const unsigned u = __float_as_uint(f); return u ^ (((unsigned)((int)u >> 31)) | 0x80000000u); }
template <int J>
__device__ __forceinline__ void index_select(const LAS float* row, const int nb, const int lane, unsigned long long* mo) {
    unsigned u[J];
#pragma unroll
    for (int j = 0; j < J; ++j) u[j] = (j < nb) ? f2key(row[64 * j]) : 0u;
    unsigned prefix = 0u; bool exact = false;
#pragma unroll 1
    for (int bit = 31; bit >= 0; --bit) {
        const unsigned cand = prefix | (1u << bit);
        int c = 0;
#pragma unroll
        for (int j0 = 0; j0 < J; j0 += 8) {
            unsigned long long bm[8];
#pragma unroll
            for (int j = 0; j < 8; ++j) bm[j] = __ballot(u[j0 + j] >= cand);
            asm volatile("" : "+s"(bm[0]), "+s"(bm[1]), "+s"(bm[2]), "+s"(bm[3]), "+s"(bm[4]), "+s"(bm[5]), "+s"(bm[6]), "+s"(bm[7]));
#pragma unroll
            for (int j = 0; j < 8; ++j) c += (int)__builtin_popcountll(bm[j]);
        }
        if (c >= 256) prefix = cand;
        if (c == 256) { exact = true; break; }
    }
    unsigned thr = prefix; asm volatile("" : "+v"(thr));
    unsigned long long myword = 0ull;
    if (exact) {
#pragma unroll
        for (int j = 0; j < J; ++j) { const unsigned long long m = __ballot(u[j] >= thr); myword = (lane == j) ? m : myword; }
    } else {
        int cg = 0;
#pragma unroll
        for (int j = 0; j < J; ++j) cg += (int)__builtin_popcountll(__ballot(u[j] > thr));
        const int quota = 256 - cg;
        int taken = 0;
#pragma unroll
        for (int j = 0; j < J; ++j) {
            const bool eq = (u[j] == thr);
            const unsigned long long eqm = __ballot(eq);
            const int before = (int)__builtin_popcountll(eqm & ((1ull << lane) - 1ull));
            const unsigned long long m = __ballot((u[j] > thr) || (eq && (taken + before < quota)));
            taken += (int)__builtin_popcountll(eqm);
            myword = (lane == j) ? m : myword;
        }
    }
    if (lane < 32) mo[lane] = myword;
}
__device__ __forceinline__ void index_unit(LAS unsigned char* lds, const bf16_t* HQ, unsigned long long* MASK, const int b, const int tt, const int wave_in) {
    int wave = wave_in; asm volatile("" : "+s"(wave));
    int lane; asm volatile("v_mbcnt_lo_u32_b32 %0, -1, 0\n\tv_mbcnt_hi_u32_b32 %0, -1, %0" : "=&v"(lane));
    const int t0 = tt * 16, nb = (t0 >> 6) + 1, nk = nb * 64;
    if (nb <= 4) {
        for (int i = wave * 64 + lane; i < 16 * 32; i += 512) MASK[(size_t)(b * SEQ + t0 + (i >> 5)) * 32 + (i & 31)] = ((i & 31) < nb) ? ~0ull : 0ull;
        return;
    }
    LAS float* sc = (LAS float*)lds;
    const int q = lane & 15, g = lane >> 4;
    {
        const bf16_t* qrow = HQ + (size_t)(b * SEQ + t0 + q) * HQP;
        bf16x8 QI[8];
#pragma unroll
        for (int h = 0; h < 8; ++h) QI[h] = *(const bf16x8*)(qrow + HQ_QI + h * 32 + g * 8);
        float w[8];
        { const u32x4 wv = *(const u32x4*)(qrow + HQ_WI);
          w[0] = bf_lo(wv[0]) * 0.0625f; w[1] = bf_hi(wv[0]) * 0.0625f; w[2] = bf_lo(wv[1]) * 0.0625f; w[3] = bf_hi(wv[1]) * 0.0625f;
          w[4] = bf_lo(wv[2]) * 0.0625f; w[5] = bf_hi(wv[2]) * 0.0625f; w[6] = bf_lo(wv[3]) * 0.0625f; w[7] = bf_hi(wv[3]) * 0.0625f; }
        const bf16_t* kbase = HQ + (size_t)(b * SEQ + q) * HQP + HQ_KI + g * 8;
        for (int kb0 = wave; kb0 < nk / 16; kb0 += 32) {
            bf16x8 kf[4];
#pragma unroll
            for (int u = 0; u < 4; ++u) { const int kb = kb0 + 8 * u; kf[u] = (kb < nk / 16) ? *(const bf16x8*)(kbase + (size_t)kb * 16 * HQP) : (bf16x8){0, 0, 0, 0, 0, 0, 0, 0}; }
#pragma unroll
            for (int u = 0; u < 4; ++u) {
                const int kb = kb0 + 8 * u;
                if (kb < nk / 16) {
                    f32x4 acc = {0.f, 0.f, 0.f, 0.f};
#pragma unroll
                    for (int h = 0; h < 8; ++h) {
                        const f32x4 z = __builtin_amdgcn_mfma_f32_16x16x32_f16(kf[u], QI[h], (f32x4){0.f, 0.f, 0.f, 0.f}, 0, 0, 0);
#pragma unroll
                        for (int j = 0; j < 4; ++j) acc[j] = fmaf(w[h], fmaxf(z[j], 0.f), acc[j]);
                    }
#pragma unroll
                    for (int j = 0; j < 4; ++j) acc[j] += 0.0f;
                    *(LAS f32x4*)(sc + q * IDX_STR + kb * 16 + g * 4) = acc;
                }
            }
        }
    }
    __syncthreads();
#pragma unroll 1
    for (int qq = 0; qq < 2; ++qq) {
        const int ql = wave * 2 + qq;
        const LAS float* row = sc + ql * IDX_STR + lane;
        unsigned long long* mo = MASK + (size_t)(b * SEQ + t0 + ql) * 32;
        if (nb <= 8) index_select<8>(row, nb, lane, mo);
        else if (nb <= 16) index_select<16>(row, nb, lane, mo);
        else if (nb <= 24) index_select<24>(row, nb, lane, mo);
        else index_select<32>(row, nb, lane, mo);
    }
    __syncthreads();
}

struct Args {
    const float* x; const float* w_in; const float* lam_q1; const float* lam_k1; const float* lam_q2; const float* lam_k2; const float* subln_g; const float* rel_bias;
    const float* w_out; const float* ln1_g; const float* ln1_b; const float* w_router; const float* b_router; const float* w_gu; const float* b_gu;
    const float* w_down; const float* b_down; const float* ln2_g; const float* ln2_b;
    float* out; unsigned char* ws;
    int ph_lo, ph_hi, bar_region, pad;
};

constexpr int LDS_STAGE = 0;
constexpr int LDS_CTL = 135168;
constexpr int LDS_TSTART = LDS_CTL + 64;
constexpr int LDS_CNT = LDS_TSTART + 36 * 4;
constexpr int LDS_TILEE = LDS_CNT + 32 * 4;
constexpr int LDS_RT = LDS_TILEE + 576;
constexpr int LDS_BYTES = 147456;
static_assert(LDS_RT + (64 + 1024) * 4 <= LDS_BYTES && 16 * IDX_STR * 4 <= LDS_CTL, "LDS map");

__device__ __forceinline__ void transpose_item(const float* W, int N, int k0, int n0, int nvalid, bf16_t* WTrow0, float scale, LAS float* scr, int lane) {
#pragma unroll
    for (int i = 0; i < 32; ++i) { const int kk = 2 * i + (lane >> 5), col = lane & 31; scr[kk * 33 + col] = (col < nvalid) ? W[(size_t)(k0 + kk) * N + n0 + col] * scale : 0.f; }
    asm volatile("s_waitcnt lgkmcnt(0)" ::: "memory");
    const int c = lane & 7;
#pragma unroll
    for (int j = 0; j < 4; ++j) { const int n = (lane >> 3) + 8 * j; const LAS float* s = scr + (8 * c) * 33 + n;
        u32x4 o; o.x = pk_bf16(s[0 * 33], s[1 * 33]); o.y = pk_bf16(s[2 * 33], s[3 * 33]); o.z = pk_bf16(s[4 * 33], s[5 * 33]); o.w = pk_bf16(s[6 * 33], s[7 * 33]);
        if (n < nvalid) *(u32x4*)(WTrow0 + (size_t)n * 1024 + k0 + 8 * c) = o; }
    asm volatile("s_waitcnt lgkmcnt(0)" ::: "memory");
}
__device__ __forceinline__ void transpose_item_fp8(const float* W, int N, int k0, int n0, unsigned char* WTrow0, float scale, int lane) {
    const int rg = lane >> 4, cg = lane & 15;
    const float* src = W + (size_t)(k0 + 32 * rg) * N + n0 + 4 * cg;
    f32x4 v[32];
#pragma unroll
    for (int i = 0; i < 32; ++i) v[i] = __builtin_nontemporal_load((const f32x4*)(src + (size_t)i * N));
    unsigned char* dst = WTrow0 + (size_t)(4 * cg) * 1024 + k0 + 32 * rg;
#pragma unroll
    for (int j = 0; j < 4; ++j) {
#pragma unroll
        for (int h = 0; h < 2; ++h) {
            u32x4 o;
            o.x = pk4_fp8(v[16 * h + 0][j] * scale, v[16 * h + 1][j] * scale, v[16 * h + 2][j] * scale, v[16 * h + 3][j] * scale);
            o.y = pk4_fp8(v[16 * h + 4][j] * scale, v[16 * h + 5][j] * scale, v[16 * h + 6][j] * scale, v[16 * h + 7][j] * scale);
            o.z = pk4_fp8(v[16 * h + 8][j] * scale, v[16 * h + 9][j] * scale, v[16 * h + 10][j] * scale, v[16 * h + 11][j] * scale);
            o.w = pk4_fp8(v[16 * h + 12][j] * scale, v[16 * h + 13][j] * scale, v[16 * h + 14][j] * scale, v[16 * h + 15][j] * scale);
            *(u32x4*)(dst + (size_t)j * 1024 + 16 * h) = o;
        }
    }
}
__device__ __forceinline__ void in_map(int n0, bool& isv, int& row, float& scale) {
    scale = 1.f; isv = false;
    if (n0 < 512) { row = HQ_QA + n0; scale = QSCALE; }
    else if (n0 < 1024) row = HQ_KA + (n0 - 512);
    else if (n0 < 1536) { isv = true; row = VT_A + (n0 - 1024); }
    else if (n0 < 1792) { row = HQ_QB + (n0 - 1536); scale = QSCALE; }
    else if (n0 < 2048) row = HQ_KB + (n0 - 1792);
    else if (n0 < 2304) { isv = true; row = VT_B + (n0 - 2048); }
    else if (n0 < 2560) { row = HQ_QC + (n0 - 2304); scale = QSCALE; }
    else if (n0 < 2816) row = HQ_KC + (n0 - 2560);
    else if (n0 < 3072) { isv = true; row = VT_C + (n0 - 2816); }
    else if (n0 < 3328) row = HQ_QI + (n0 - 3072);
    else if (n0 < 3360) row = HQ_KI + (n0 - 3328);
    else row = HQ_WI + (n0 - 3360);
}

__global__ void __launch_bounds__(512, 2) mega(Args a) {
    extern __shared__ __attribute__((aligned(16))) unsigned char lds_raw[];
    LAS unsigned char* lds = (LAS unsigned char*)lds_raw;
    const int G = gridDim.x, bid = blockIdx.x, NGW = G * 8;
    const int wave0 = __builtin_amdgcn_readfirstlane((int)threadIdx.x >> 6);
#define OPAQUE_IDS() int wave = wave0; asm volatile("" : "+s"(wave)); int lane; asm volatile("v_mbcnt_lo_u32_b32 %0, -1, 0\n\tv_mbcnt_hi_u32_b32 %0, -1, %0" : "=&v"(lane)); const int tid = wave * 64 + lane, gw = bid * 8 + wave; (void)tid; (void)gw
#define WSPTRS() unsigned char* ws = a.ws; asm volatile("" : "+s"(ws)); \
    unsigned* ctl = (unsigned*)(ws + WS_CTL); bf16_t* Win = (bf16_t*)(ws + WS_WIN); bf16_t* Wv = (bf16_t*)(ws + WS_WV); bf16_t* Wout = (bf16_t*)(ws + WS_WOUT); \
    bf16_t* Wgu = (bf16_t*)(ws + WS_WGU); bf16_t* Wdn = (bf16_t*)(ws + WS_WDN); bf16_t* XB = (bf16_t*)(ws + WS_XB); \
    bf16_t* HQ = (bf16_t*)(ws + WS_HQ); bf16_t* VT = (bf16_t*)(ws + WS_VT); bf16_t* MIX = (bf16_t*)(ws + WS_MIX); \
    bf16_t* Y1B = (bf16_t*)(ws + WS_Y1); bf16_t* X1B = (bf16_t*)(ws + WS_X1B); bf16_t* ACT = (bf16_t*)(ws + WS_ACT); bf16_t* YR = (bf16_t*)(ws + WS_YR); \
    int* TOKL = (int*)(ws + WS_TOKL); int* ASGE = (int*)(ws + WS_ASGE); int* ASGS = (int*)(ws + WS_ASGS); float* GATE = (float*)(ws + WS_GATE); \
    (void)ctl; (void)Win; (void)Wv; (void)Wout; (void)Wgu; (void)Wdn; (void)XB; (void)HQ; (void)VT; (void)MIX; (void)Y1B; (void)X1B; (void)ACT; (void)YR; (void)TOKL; (void)ASGE; (void)ASGS; (void)GATE
    for (int u = threadIdx.x; u < (LDS_BYTES - LDS_CTL) / 4; u += 512) ((LAS unsigned*)(lds + LDS_CTL))[u] = 0u;
    __syncthreads();
    XcdBarrier bar = xcd_barrier_post((unsigned*)(a.ws + WS_CTL) + CW_BAR + a.bar_region * XCD_BAR_WORDS, (volatile LAS unsigned*)(lds + LDS_CTL));
    const int lo = a.ph_lo, hi = a.ph_hi;
#define IN(k) (lo <= (k) && (k) < hi)
#define SEAM(k) do { if (IN(k) && IN((k) + 1)) xcd_barrier(bar); } while (0)

    if (IN(0)) PREP(0) {
        OPAQUE_IDS(); WSPTRS();
        LAS float* scr = (LAS float*)(lds + LDS_STAGE + wave * 16384);
        #if MOE_FP8
        constexpr int I_IN = 16 * 106, I_OUT = 16 * 32, I_GU = 8 * 32, I_DN = 8 * 16;
#else
        constexpr int I_IN = 16 * 106, I_OUT = 16 * 32, I_GU = 16 * 64, I_DN = 16 * 32;
#endif
        constexpr int N_IN = DEPTH * I_IN, N_OUT = DEPTH * I_OUT, N_GU = DEPTH * NE * I_GU, N_DN = DEPTH * NE * I_DN;
        for (int it = gw; it < N_IN + N_OUT + N_GU + N_DN; it += NGW) {
            int r = it;
            if (r < N_IN) { const int l = r / I_IN, q = r % I_IN, kb = q / 106, nb = q % 106, n0 = nb * 32; bool isv; int row; float sc; in_map(n0, isv, row, sc);
                bf16_t* dst = isv ? Wv + ((size_t)l * 1024 + row) * 1024 : Win + ((size_t)l * HQP + row) * 1024;
                transpose_item(a.w_in + (size_t)l * D * DIN, DIN, kb * 64, n0, (DIN - n0) < 32 ? (DIN - n0) : 32, dst, sc, scr, lane); continue; }
            r -= N_IN;
            if (r < N_OUT) { const int l = r / I_OUT, q = r % I_OUT, kb = q / 32, nb = q % 32;
                transpose_item(a.w_out + (size_t)l * 1024 * D, D, kb * 64, nb * 32, 32, Wout + ((size_t)l * D + nb * 32) * 1024, 1.f, scr, lane); continue; }
            r -= N_OUT;
#if MOE_FP8
            if (r < N_GU) { const int le = r / I_GU, q = r % I_GU, kb = q >> 5, nb = q & 31, n0 = nb * 64;
                const int bj = n0 >> 10, rr = n0 & 1023, pn = rr >> 7, c = rr & 127, nrow = pn * 256 + bj * 128 + c;
                transpose_item_fp8(a.w_gu + (size_t)le * D * 2048, 2048, kb * 128, n0, (unsigned char*)Wgu + ((size_t)le * 2048 + nrow) * 1024, W8_SCALE, lane); continue; }
#else
            if (r < N_GU) { const int le = r / I_GU, q = r % I_GU, kb = q / 64, nb = q % 64, n0 = nb * 32;
                const int bj = n0 >> 10, rr = n0 & 1023, pn = rr >> 7, c = rr & 127, nrow = pn * 256 + bj * 128 + c;
                transpose_item(a.w_gu + (size_t)le * D * 2048, 2048, kb * 64, n0, 32, Wgu + ((size_t)le * 2048 + nrow) * 1024, 1.f, scr, lane); continue; }
#endif
            r -= N_GU;
#if MOE_FP8
            { const int le = r / I_DN, q = r % I_DN, kb = q >> 4, nb = q & 15;
                transpose_item_fp8(a.w_down + (size_t)le * 1024 * D, D, kb * 128, nb * 64, (unsigned char*)Wdn + ((size_t)le * D + nb * 64) * 1024, W8_SCALE, lane); }
#else
            { const int le = r / I_DN, q = r % I_DN, kb = q / 32, nb = q % 32;
                transpose_item(a.w_down + (size_t)le * 1024 * D, D, kb * 64, nb * 32, 32, Wdn + ((size_t)le * D + nb * 32) * 1024, 1.f, scr, lane); }
#endif
        }
        for (int i = gw * 64 + lane; i < DEPTH * (HQP - HQ_USED) * 128; i += NGW * 64) { const int l = i / ((HQP - HQ_USED) * 128), q = i % ((HQP - HQ_USED) * 128);
            *(u32x4*)(Win + ((size_t)l * HQP + HQ_USED) * 1024 + (size_t)q * 8) = (u32x4){0u, 0u, 0u, 0u}; }
        { bf16_t* WRH = (bf16_t*)(ws + WS_WRT); bf16_t* WRL = WRH + (size_t)DEPTH * NE * D;
          for (int i = gw * 64 + lane; i < DEPTH * NE * D; i += NGW * 64) { const int ll = i / (NE * D), r = i % (NE * D), e = r / D, c = r % D; const float w = a.w_router[((size_t)ll * D + c) * NE + e];
              const unsigned h = pk_bf16(w, 0.f) & 0xffffu; WRH[i] = (bf16_t)h; WRL[i] = (bf16_t)(pk_bf16(w - bf_lo(h), 0.f) & 0xffffu); } }
        for (size_t i = (size_t)gw * 64 + lane; i < (size_t)T * D / 8; i += (size_t)NGW * 64) { const f32x4 v0 = *(const f32x4*)(a.x + i * 8), v1 = *(const f32x4*)(a.x + i * 8 + 4);
            u32x4 w; w.x = pk_bf16(v0[0], v0[1]); w.y = pk_bf16(v0[2], v0[3]); w.z = pk_bf16(v1[0], v1[1]); w.w = pk_bf16(v1[2], v1[3]); *(u32x4*)(XB + i * 8) = w; }
    }
    SEAM(0);

#pragma unroll 1
    for (int l = 0; l < DEPTH; ++l) {
        const int pb = 1 + 8 * l;
        if (IN(pb + 0)) PREP(1) {
            WSPTRS();
            pg8::InProjOrder S{G, bid, (const char*)(Win + (size_t)l * HQP * 1024), (const char*)(Wv + (size_t)l * 1024 * 1024), (const char*)XB};
            pg8::EpiInProj E{HQ, VT};
            pg8::gemm_phase<pg8::EpiInProj, pg8::InProjOrder, false>(lds + LDS_STAGE, XB, 1024, S, E, wave0);
        }
        SEAM(pb + 0);
        if (IN(pb + 1)) {
            OPAQUE_IDS(); WSPTRS();
            unsigned long long* MASKp = (unsigned long long*)(ws + WS_MASK); float* OA1p = (float*)(ws + WS_OA1);
            const float lam_init = 0.8f - 0.6f * expf(-0.3f * (float)l);
            const float lam = expf(wsum(a.lam_q1[l * 64 + lane] * a.lam_k1[l * 64 + lane], lane)) - expf(wsum(a.lam_q2[l * 64 + lane] * a.lam_k2[l * 64 + lane], lane)) + lam_init;
            const int v0 = (G % 8 == 0) ? (bid & 7) * (G >> 3) + (bid >> 3) : bid;
            for (int v = v0; v < 256; v += G) {
                const int b = v >> 4, h = (v >> 2) & 3, q0 = v & 3, j16 = v & 15;
                PREP(2)
#pragma unroll 1
                for (int k = 0; k < 8; ++k) index_unit(lds + LDS_STAGE, HQ, MASKp, b, 16 * k + ((k & 1) ? 15 - j16 : j16), wave);
                PREP(3)
#pragma unroll 1
                for (int rep = 0; rep < 2; ++rep) attn_unit<0>(lds + LDS_STAGE, HQ, VT, MIX, MASKp, OA1p, b, rep ? 3 - h : h, rep ? 7 - q0 : q0, wave, lane, lam, lam_init, a.subln_g + l * 128, nullptr);
                PREP(4)
#pragma unroll 1
                for (int rep = 0; rep < 2; ++rep) attn_unit<1>(lds + LDS_STAGE, HQ, VT, MIX, MASKp, OA1p, b, h, rep ? 7 - q0 : q0, wave, lane, 0.f, 0.f, nullptr, a.rel_bias + ((size_t)l * 4 + h) * 257);
            }
        }
        SEAM(pb + 1);
        if (IN(pb + 2)) {
            OPAQUE_IDS(); WSPTRS();
            unsigned long long* MASKp = (unsigned long long*)(ws + WS_MASK); float* OA1p = (float*)(ws + WS_OA1);
            const int v0 = (G % 8 == 0) ? (bid & 7) * (G >> 3) + (bid >> 3) : bid;
            for (int v = v0; v < 256; v += G) {
                const int b = v >> 4, h = (v >> 2) & 3, q0 = v & 3;
                PREP(5)
#pragma unroll 1
                for (int rep = 0; rep < 2; ++rep) attn_unit<2>(lds + LDS_STAGE, HQ, VT, MIX, MASKp, OA1p, b, rep ? 3 - h : h, rep ? 7 - q0 : q0, wave, lane, 0.f, 0.f, nullptr, nullptr);
            }
        }
        SEAM(pb + 2);
        if (IN(pb + 3)) PREP(6) {
            WSPTRS();
            pg8::DenseOrder S{T / 256, 4, G, bid, (const char*)(Wout + (size_t)l * 1024 * 1024), 1024, false};
            pg8::EpiResBf16 E{Y1B, XB};
            pg8::gemm_phase<pg8::EpiResBf16, pg8::DenseOrder, false>(lds + LDS_STAGE, MIX, 1024, S, E, wave0);
        }
        SEAM(pb + 3);
        if (IN(pb + 4)) PREP(10) {
            OPAQUE_IDS(); WSPTRS();
            if (PROBE == 10 && _rp == 0) { TOKL = (int*)(ws + WS_END); ASGE = TOKL + NE * T; ASGS = ASGE + NASG; GATE = (float*)(ASGS + NASG); }
            LAS int* lcnt = (LAS int*)(lds + LDS_RT); LAS int* lbase = lcnt + 32; LAS int* asg_e = lcnt + 64; LAS int* asg_ls = asg_e + 512;
            const float* g1 = a.ln1_g + l * D; const float* b1 = a.ln1_b + l * D; const float* br = a.b_router + l * NE;
            unsigned* gcnt = ctl + CW_CNT + l * 64 + ((PROBE == 10 && _rp == 0) ? 4096 : 0);
            { const u32x4* srch = (const u32x4*)(ws + WS_WRT) + (size_t)l * 4096; const u32x4* srcl = (const u32x4*)(ws + WS_WRT + (size_t)DEPTH * NE * D * 2) + (size_t)l * 4096;
              for (int i = tid; i < 4096; i += 512) { const int e = i >> 7, c = i & 127, dst = e * 2048 + ((c ^ (e & 15)) << 4);
                  *(LAS u32x4*)(lds + LDS_STAGE + dst) = srch[i]; *(LAS u32x4*)(lds + LDS_STAGE + 65536 + dst) = srcl[i]; } }
            LAS float* st = (LAS float*)(lds + 131072);
            for (int unit = bid; unit < T / 128; unit += G) {
                if (tid < 32) lcnt[tid] = 0;
                __syncthreads();
#pragma unroll 1
                for (int k = 0; k < 8; ++k) {
                    const int tl0 = wave * 16 + 2 * k, t0 = unit * 128 + tl0;
                    float v[2][16];
#pragma unroll
                    for (int tk = 0; tk < 2; ++tk)
#pragma unroll
                        for (int i = 0; i < 4; ++i) { const u32x2 u2 = *(const u32x2*)(Y1B + (size_t)(t0 + tk) * D + i * 256 + lane * 4); v[tk][4 * i] = bf_lo(u2[0]); v[tk][4 * i + 1] = bf_hi(u2[0]); v[tk][4 * i + 2] = bf_lo(u2[1]); v[tk][4 * i + 3] = bf_hi(u2[1]); }
#pragma unroll
                    for (int tk = 0; tk < 2; ++tk) {
                        float s_ = 0.f;
#pragma unroll
                        for (int i = 0; i < 16; ++i) s_ += v[tk][i];
                        const float mean = wsum(s_, lane) * (1.0f / 1024.0f);
                        float qv = 0.f;
#pragma unroll
                        for (int i = 0; i < 16; ++i) { const float d = v[tk][i] - mean; qv += d * d; }
                        const float rstd = rsqrtf(wsum(qv, lane) * (1.0f / 1024.0f) + EPS);
                        if (lane == 0) { st[(tl0 + tk) * 2] = mean; st[(tl0 + tk) * 2 + 1] = rstd; }
                    }
                }
                asm volatile("s_waitcnt lgkmcnt(0)" ::: "memory");
                __builtin_amdgcn_wave_barrier();
                {
                    const int tk = lane & 15, kg = lane >> 4, tl = wave * 16 + tk, t = unit * 128 + tl;
                    const float mean = st[tl * 2], rstd = st[tl * 2 + 1];
                    f32x4 acc0 = {0.f, 0.f, 0.f, 0.f}, acc1 = acc0;
                    const bf16_t* yrow = Y1B + (size_t)t * D + kg * 8;
                    const int e0 = tk, e1 = 16 + tk;
                    const LAS unsigned char* w0p = lds + LDS_STAGE + e0 * 2048; const LAS unsigned char* w1p = lds + LDS_STAGE + e1 * 2048;
#pragma unroll 1
                    for (int ks0 = 0; ks0 < 32; ks0 += 4) {
                    u32x4 y8v[4];
#pragma unroll
                    for (int u = 0; u < 4; ++u) y8v[u] = __builtin_nontemporal_load((const u32x4*)(yrow + (ks0 + u) * 32));
#pragma unroll
                    for (int u = 0; u < 4; ++u) {
                        const int ks = ks0 + u;
                        const int k0 = ks * 32 + kg * 8;
                        const u32x4 y8 = y8v[u];
                        const f32x4 ga = *(const f32x4*)(g1 + k0), gb = *(const f32x4*)(g1 + k0 + 4), ba = *(const f32x4*)(b1 + k0), bb = *(const f32x4*)(b1 + k0 + 4);
                        float x[8];
                        x[0] = (bf_lo(y8[0]) - mean) * rstd * ga[0] + ba[0]; x[1] = (bf_hi(y8[0]) - mean) * rstd * ga[1] + ba[1];
                        x[2] = (bf_lo(y8[1]) - mean) * rstd * ga[2] + ba[2]; x[3] = (bf_hi(y8[1]) - mean) * rstd * ga[3] + ba[3];
                        x[4] = (bf_lo(y8[2]) - mean) * rstd * gb[0] + bb[0]; x[5] = (bf_hi(y8[2]) - mean) * rstd * gb[1] + bb[1];
                        x[6] = (bf_lo(y8[3]) - mean) * rstd * gb[2] + bb[2]; x[7] = (bf_hi(y8[3]) - mean) * rstd * gb[3] + bb[3];
                        u32x4 hx; hx.x = pk_bf16(x[0], x[1]); hx.y = pk_bf16(x[2], x[3]); hx.z = pk_bf16(x[4], x[5]); hx.w = pk_bf16(x[6], x[7]);
                        *(u32x4*)(X1B + (size_t)t * D + k0) = hx;
#if MOE_FP8
                        *(u32x2*)(ws + WS_X1Q + (size_t)t * D + k0) = (u32x2){pk4_fp8(x[0] * X8_SCALE, x[1] * X8_SCALE, x[2] * X8_SCALE, x[3] * X8_SCALE), pk4_fp8(x[4] * X8_SCALE, x[5] * X8_SCALE, x[6] * X8_SCALE, x[7] * X8_SCALE)};
#endif
                        u32x4 lx; lx.x = pk_bf16(x[0] - bf_lo(hx.x), x[1] - bf_hi(hx.x)); lx.y = pk_bf16(x[2] - bf_lo(hx.y), x[3] - bf_hi(hx.y));
                        lx.z = pk_bf16(x[4] - bf_lo(hx.z), x[5] - bf_hi(hx.z)); lx.w = pk_bf16(x[6] - bf_lo(hx.w), x[7] - bf_hi(hx.w));
                        const bf16x8 xh = __builtin_bit_cast(bf16x8, hx), xl = __builtin_bit_cast(bf16x8, lx);
                        const int c0 = ((ks * 4 + kg) ^ tk) << 4;
                        const bf16x8 wh0 = *(const LAS bf16x8*)(w0p + c0), wl0 = *(const LAS bf16x8*)(w0p + 65536 + c0);
                        const bf16x8 wh1 = *(const LAS bf16x8*)(w1p + c0), wl1 = *(const LAS bf16x8*)(w1p + 65536 + c0);
                        acc0 = __builtin_amdgcn_mfma_f32_16x16x32_f16(wh0, xh, acc0, 0, 0, 0); acc1 = __builtin_amdgcn_mfma_f32_16x16x32_f16(wh1, xh, acc1, 0, 0, 0);
                        acc0 = __builtin_amdgcn_mfma_f32_16x16x32_f16(wl0, xh, acc0, 0, 0, 0); acc1 = __builtin_amdgcn_mfma_f32_16x16x32_f16(wl1, xh, acc1, 0, 0, 0);
                        acc0 = __builtin_amdgcn_mfma_f32_16x16x32_f16(wh0, xl, acc0, 0, 0, 0); acc1 = __builtin_amdgcn_mfma_f32_16x16x32_f16(wh1, xl, acc1, 0, 0, 0);
                    }
                    }
                    float lv[8]; int li[8];
                    { const f32x4 b0 = *(const f32x4*)(br + kg * 4), b1v = *(const f32x4*)(br + 16 + kg * 4);
#pragma unroll
                      for (int j = 0; j < 4; ++j) { lv[j] = acc0[j] + b0[j]; li[j] = kg * 4 + j; lv[4 + j] = acc1[j] + b1v[j]; li[4 + j] = 16 + kg * 4 + j; } }
                    int be[4]; float bv[4];
#pragma unroll
                    for (int kk = 0; kk < 4; ++kk) {
                        float m = lv[0]; int mi = li[0];
#pragma unroll
                        for (int i = 1; i < 8; ++i) if (lv[i] > m) { m = lv[i]; mi = li[i]; }
                        { const float om = shx(m, 16, lane); const int oi = __float_as_int(shx(__int_as_float(mi), 16, lane)); if (om > m || (om == m && oi < mi)) { m = om; mi = oi; } }
                        { const float om = shx(m, 32, lane); const int oi = __float_as_int(shx(__int_as_float(mi), 32, lane)); if (om > m || (om == m && oi < mi)) { m = om; mi = oi; } }
                        be[kk] = mi; bv[kk] = m;
#pragma unroll
                        for (int i = 0; i < 8; ++i) if (li[i] == mi) lv[i] = -3e38f;
                    }
                    float ex[4], es = 0.f;
#pragma unroll
                    for (int kk = 0; kk < 4; ++kk) { ex[kk] = __expf(bv[kk] - bv[0]); es += ex[kk]; }
                    if (kg == 0) {
#pragma unroll
                        for (int kk = 0; kk < 4; ++kk) { const int sl = __hip_atomic_fetch_add(&lcnt[be[kk]], 1, __ATOMIC_RELAXED, __HIP_MEMORY_SCOPE_WORKGROUP); asg_e[tl * 4 + kk] = be[kk]; asg_ls[tl * 4 + kk] = sl; GATE[t * 4 + kk] = ex[kk] / es; }
                    }
                }
                __syncthreads();
                if (tid < 32) lbase[tid] = (int)__hip_atomic_fetch_add(gcnt + tid, (unsigned)lcnt[tid], __ATOMIC_RELAXED, __HIP_MEMORY_SCOPE_AGENT);
                __syncthreads();
                { const int e = asg_e[tid], sl = lbase[e] + asg_ls[tid], t = unit * 128 + (tid >> 2);
                  TOKL[(size_t)e * T + sl] = t; ASGE[t * 4 + (tid & 3)] = e; ASGS[t * 4 + (tid & 3)] = sl; }
                __syncthreads();
            }
        }
        SEAM(pb + 4);
        LAS int* tstart = (LAS int*)(lds + LDS_TSTART); LAS int* lcntE = (LAS int*)(lds + LDS_CNT); LAS unsigned char* tile_e = lds + LDS_TILEE;
        if (IN(pb + 5) || IN(pb + 6) || IN(pb + 7)) {
            OPAQUE_IDS(); WSPTRS();
            if (tid < 32) lcntE[tid] = (int)__hip_atomic_load(ctl + CW_CNT + l * 64 + tid, __ATOMIC_RELAXED, __HIP_MEMORY_SCOPE_AGENT);
            __syncthreads();
            if (tid == 0) { int acc = 0; for (int e = 0; e < NE; ++e) { tstart[e] = acc; acc += (lcntE[e] + 255) >> 8; } tstart[32] = acc; }
            __syncthreads();
            for (int q = tid; q < MAXRT; q += 512) { int e = 0; for (int k = 0; k < NE; ++k) if (q >= tstart[k]) e = k; tile_e[q] = (unsigned char)e; }
            __syncthreads();
        }
        pg8::MoeTables tb{tstart, lcntE, tile_e, tstart[32]};
        if (IN(pb + 5)) PREP(7) {
            WSPTRS();
#if MOE_FP8
            pg8::MoeOrder S{tb, 8, G, bid, (const char*)Wgu + (size_t)l * NE * 2048 * 1024, (size_t)2048 * 1024, TOKL, true, 1024};
            pg8::EpiSwiglu<true> E{(void*)ACT, a.b_gu + (size_t)l * NE * 2048, 1.0f / (W8_SCALE * X8_SCALE)};
            pg8::gemm_phase<pg8::EpiSwiglu<true>, pg8::MoeOrder, true, 1>(lds + LDS_STAGE, (const bf16_t*)(ws + WS_X1Q), 1024, S, E, wave0);
#else
            pg8::MoeOrder S{tb, 8, G, bid, (const char*)(Wgu + (size_t)l * NE * 2048 * 1024), (size_t)2048 * 1024 * 2, TOKL, true, 2048};
            pg8::EpiSwiglu<false> E{(void*)ACT, a.b_gu + (size_t)l * NE * 2048, 1.0f};
            pg8::gemm_phase<pg8::EpiSwiglu<false>, pg8::MoeOrder, true>(lds + LDS_STAGE, X1B, 1024, S, E, wave0);
#endif
        }
        SEAM(pb + 5);
        if (IN(pb + 6)) PREP(8) {
            WSPTRS();
#if MOE_FP8
            pg8::MoeOrder S{tb, 4, G, bid, (const char*)Wdn + (size_t)l * NE * 1024 * 1024, (size_t)1024 * 1024, TOKL, false, 1024};
            pg8::EpiBiasBf16 E{YR, a.b_down + (size_t)l * NE * 1024, 1.0f / (W8_SCALE * A8_SCALE)};
            pg8::gemm_phase<pg8::EpiBiasBf16, pg8::MoeOrder, false, 1>(lds + LDS_STAGE, ACT, 1024, S, E, wave0);
#else
            pg8::MoeOrder S{tb, 4, G, bid, (const char*)(Wdn + (size_t)l * NE * 1024 * 1024), (size_t)1024 * 1024 * 2, TOKL, false, 2048};
            pg8::EpiBiasBf16 E{YR, a.b_down + (size_t)l * NE * 1024, 1.0f};
            pg8::gemm_phase<pg8::EpiBiasBf16, pg8::MoeOrder, false>(lds + LDS_STAGE, ACT, 1024, S, E, wave0);
#endif
        }
        SEAM(pb + 6);
        if (IN(pb + 7)) PREP(9) {
            OPAQUE_IDS(); WSPTRS();
            const float* g2 = a.ln2_g + l * D; const float* b2 = a.ln2_b + l * D;
            for (int t0 = gw; t0 < T; t0 += 2 * NGW) {
                int e_[2][4], sl_[2][4]; float gk_[2][4];
#pragma unroll
                for (int u = 0; u < 2; ++u) { const int t = t0 + u * NGW;
#pragma unroll
                    for (int k = 0; k < 4; ++k) { e_[u][k] = ASGE[t * 4 + k]; sl_[u][k] = ASGS[t * 4 + k]; gk_[u][k] = GATE[t * 4 + k]; } }
                u32x2 xr[2][4], yr[2][4][4];
#pragma unroll
                for (int u = 0; u < 2; ++u) { const int t = t0 + u * NGW;
#pragma unroll
                    for (int i = 0; i < 4; ++i) xr[u][i] = __builtin_nontemporal_load((const u32x2*)(X1B + (size_t)t * D + i * 256 + lane * 4));
#pragma unroll
                    for (int k = 0; k < 4; ++k) { const bf16_t* yp = YR + ((size_t)tstart[e_[u][k]] * 256 + sl_[u][k]) * 1024;
#pragma unroll
                        for (int i = 0; i < 4; ++i) yr[u][k][i] = __builtin_nontemporal_load((const u32x2*)(yp + i * 256 + lane * 4)); } }
#pragma unroll
                for (int u = 0; u < 2; ++u) { const int t = t0 + u * NGW;
                    float v[16];
#pragma unroll
                    for (int i = 0; i < 4; ++i) { v[4 * i] = ALPHA * bf_lo(xr[u][i][0]); v[4 * i + 1] = ALPHA * bf_hi(xr[u][i][0]); v[4 * i + 2] = ALPHA * bf_lo(xr[u][i][1]); v[4 * i + 3] = ALPHA * bf_hi(xr[u][i][1]); }
#pragma unroll
                    for (int k = 0; k < 4; ++k) { const float gk = gk_[u][k];
#pragma unroll
                        for (int i = 0; i < 4; ++i) { const u32x2 u2 = yr[u][k][i];
                            v[4 * i] += gk * bf_lo(u2[0]); v[4 * i + 1] += gk * bf_hi(u2[0]); v[4 * i + 2] += gk * bf_lo(u2[1]); v[4 * i + 3] += gk * bf_hi(u2[1]); } }
                    float s_ = 0.f;
#pragma unroll
                    for (int i = 0; i < 16; ++i) s_ += v[i];
                    const float mean = wsum(s_, lane) * (1.0f / 1024.0f);
                    float qv = 0.f;
#pragma unroll
                    for (int i = 0; i < 16; ++i) { const float d = v[i] - mean; qv += d * d; }
                    const float rstd = rsqrtf(wsum(qv, lane) * (1.0f / 1024.0f) + EPS);
#pragma unroll
                    for (int i = 0; i < 4; ++i) {
                        const int c0 = i * 256 + lane * 4;
                        const f32x4 gg = *(const f32x4*)(g2 + c0), bb = *(const f32x4*)(b2 + c0);
                        float o[4];
#pragma unroll
                        for (int j = 0; j < 4; ++j) o[j] = (v[4 * i + j] - mean) * rstd * gg[j] + bb[j];
                        if (l == DEPTH - 1) *(f32x4*)(a.out + (size_t)t * D + c0) = (f32x4){o[0], o[1], o[2], o[3]};
                        else *(u32x2*)(XB + (size_t)t * D + c0) = (u32x2){pk_bf16(o[0], o[1]), pk_bf16(o[2], o[3])};
                    }
                }
            }
        }
        if (l + 1 < DEPTH) SEAM(pb + 7);
    }
#undef IN
#undef SEAM
}

extern "C" void kernel_launch(void* const* d_in, const int* in_sizes, int n_in, void* d_out, int out_size, void* d_ws, size_t ws_size, hipStream_t stream) {
    static int grid = 0;
    if (grid == 0) {
        if (ws_size < WS_END) { fprintf(stderr, "kernel_launch: workspace too small (%zu < %zu)\n", ws_size, (size_t)WS_END); grid = -1; return; }
        int dev = 0, cus = 0, per_cu = 0;
        if (hipGetDevice(&dev) != hipSuccess || hipDeviceGetAttribute(&cus, hipDeviceAttributeMultiprocessorCount, dev) != hipSuccess) { grid = -1; return; }
        if (hipFuncSetAttribute((const void*)mega, hipFuncAttributeMaxDynamicSharedMemorySize, LDS_BYTES) != hipSuccess) { fprintf(stderr, "kernel_launch: hipFuncSetAttribute failed\n"); grid = -1; return; }
        if (hipOccupancyMaxActiveBlocksPerMultiprocessor(&per_cu, (const void*)mega, 512, LDS_BYTES) != hipSuccess || per_cu < 1) { fprintf(stderr, "kernel_launch: occupancy query says %d\n", per_cu); }
        (void)hipGetLastError();
        grid = cus;
        if (grid % 8 != 0) grid -= grid % 8;
    }
    if (grid < 0) return;
    (void)hipMemsetAsync((char*)d_ws + WS_CTL, 0, CTL_BYTES, stream);
    Args a{};
    a.x = (const float*)d_in[0]; a.w_in = (const float*)d_in[1]; a.lam_q1 = (const float*)d_in[2]; a.lam_k1 = (const float*)d_in[3]; a.lam_q2 = (const float*)d_in[4]; a.lam_k2 = (const float*)d_in[5];
    a.subln_g = (const float*)d_in[6]; a.rel_bias = (const float*)d_in[7]; a.w_out = (const float*)d_in[8]; a.ln1_g = (const float*)d_in[9]; a.ln1_b = (const float*)d_in[10];
    a.w_router = (const float*)d_in[11]; a.b_router = (const float*)d_in[12]; a.w_gu = (const float*)d_in[13]; a.b_gu = (const float*)d_in[14]; a.w_down = (const float*)d_in[15];
    a.b_down = (const float*)d_in[16]; a.ln2_g = (const float*)d_in[17]; a.ln2_b = (const float*)d_in[18];
    a.out = (float*)d_out; a.ws = (unsigned char*)d_ws; a.pad = 0;
    a.ph_lo = 0; a.ph_hi = 1 + 8 * DEPTH; a.bar_region = 0;
    hipLaunchKernelGGL(mega, dim3(grid), dim3(512), LDS_BYTES, stream, a);
}
```

```cpp
#include <hip/hip_runtime.h>
#include <stdint.h>
#include <cstdio>

#define LAS __attribute__((address_space(3)))
typedef unsigned short bf16_t;
typedef _Float16 bf16x8 __attribute__((ext_vector_type(8)));
typedef float f32x4 __attribute__((ext_vector_type(4)));
typedef float f32x2 __attribute__((ext_vector_type(2)));
typedef unsigned u32x4 __attribute__((ext_vector_type(4)));
typedef unsigned u32x2 __attribute__((ext_vector_type(2)));
typedef _Float16 bf16v2 __attribute__((ext_vector_type(2)));

constexpr int D = 1024, BATCH = 16, SEQ = 2048, T = BATCH * SEQ, DEPTH = 4;
constexpr int DIN = 3368;
constexpr int NE = 32;
constexpr float ALPHA = 1.681792830507429f;
constexpr float EPS = 1e-5f;
constexpr float LOG2E = 1.4426950408889634f;
constexpr float QSCALE = 0.125f * LOG2E;
constexpr int HQP = 2560;
constexpr int HQ_QA = 0, HQ_KA = 512, HQ_QB = 1024, HQ_KB = 1280, HQ_QC = 1536, HQ_KC = 1792, HQ_QI = 2048, HQ_KI = 2304, HQ_WI = 2336, HQ_USED = 2344;
constexpr int VT_A = 0, VT_B = 512, VT_C = 768;
constexpr int NASG = T * 4;
constexpr int GROWS = NASG + NE * 256;
constexpr int MAXRT = GROWS / 256;

constexpr size_t MiB = (size_t)1 << 20;
constexpr size_t al(size_t x) { return (x + 255) & ~(size_t)255; }
constexpr size_t WS_CTL = 0, CTL_BYTES = 4 * MiB;
constexpr size_t WS_WIN = WS_CTL + CTL_BYTES;
constexpr size_t WS_WV = WS_WIN + al((size_t)DEPTH * HQP * D * 2);
constexpr size_t WS_WOUT = WS_WV + al((size_t)DEPTH * 1024 * D * 2);
constexpr size_t WS_WGU = WS_WOUT + al((size_t)DEPTH * D * 1024 * 2);
constexpr size_t WS_WDN = WS_WGU + al((size_t)DEPTH * NE * 2048 * D * 2);
constexpr size_t WS_XB = WS_WDN + al((size_t)DEPTH * NE * D * 1024 * 2);
constexpr size_t WS_HQ = WS_XB + al((size_t)T * D * 2);
constexpr size_t WS_VT = WS_HQ + al((size_t)T * HQP * 2);
constexpr size_t WS_MIX = WS_VT + al((size_t)1024 * T * 2);
constexpr size_t WS_Y1 = WS_MIX + al((size_t)T * 1024 * 2);
constexpr size_t WS_X1B = WS_Y1 + al((size_t)T * D * 2);
constexpr size_t WS_ACT = WS_X1B + al((size_t)T * D * 2);
constexpr size_t WS_YR = WS_ACT + al((size_t)GROWS * 1024 * 2);
constexpr size_t WS_MASK = WS_YR + al((size_t)GROWS * 1024 * 2);
constexpr size_t WS_TOKL = WS_MASK + al((size_t)T * 32 * 8);
constexpr size_t WS_ASGE = WS_TOKL + al((size_t)NE * T * 4);
constexpr size_t WS_ASGS = WS_ASGE + al((size_t)NASG * 4);
constexpr size_t WS_GATE = WS_ASGS + al((size_t)NASG * 4);
constexpr size_t WS_OA1 = WS_GATE + al((size_t)NASG * 4);
constexpr size_t WS_WRT = WS_OA1 + al((size_t)T * 512 * 4);
constexpr size_t WS_X1Q = WS_WRT + al((size_t)DEPTH * NE * D * 4);
constexpr size_t WS_END = WS_X1Q + al((size_t)T * D);
constexpr int CW_BAR = 4096;
constexpr int CW_CNT = 262144;

#ifndef MOE_FP8
#define MOE_FP8 1
#endif
constexpr int RTP = 2;
constexpr float W8_SCALE = 512.0f;
constexpr float X8_SCALE = 16.0f;
constexpr float A8_SCALE = 4.0f;
typedef int i32x8 __attribute__((ext_vector_type(8)));
__device__ __forceinline__ unsigned pk_bf16(float lo, float hi) { f32x2 v = {lo, hi}; return __builtin_bit_cast(unsigned, __builtin_convertvector(v, bf16v2)); }
__device__ __forceinline__ float clamp8(float x) { return __builtin_fminf(__builtin_fmaxf(x, -448.0f), 448.0f); }
__device__ __forceinline__ unsigned pk4_fp8(float a, float b, float c, float d) {
    int w = 0; w = __builtin_amdgcn_cvt_pk_fp8_f32(clamp8(a), clamp8(b), w, false); w = __builtin_amdgcn_cvt_pk_fp8_f32(clamp8(c), clamp8(d), w, true); return (unsigned)w; }
__device__ __forceinline__ float bf_lo(unsigned u) { return (float)__builtin_bit_cast(bf16v2, u)[0]; }
__device__ __forceinline__ float bf_hi(unsigned u) { return (float)__builtin_bit_cast(bf16v2, u)[1]; }
__device__ __forceinline__ float bf2f(bf16_t b) { return (float)__builtin_bit_cast(bf16v2, (unsigned)b)[0]; }
__device__ __forceinline__ float wave_sum(float v) {
#pragma unroll
    for (int o = 32; o > 0; o >>= 1) v += __shfl_xor(v, o);
    return v; }
__device__ __forceinline__ float wave_max(float v) {
#pragma unroll
    for (int o = 32; o > 0; o >>= 1) v = fmaxf(v, __shfl_xor(v, o));
    return v; }
__device__ __forceinline__ int wave_sum_i(int v) {
#pragma unroll
    for (int o = 32; o > 0; o >>= 1) v += __shfl_xor(v, o);
    return v; }

__device__ __forceinline__ float shx(float v, int o, int lane) { return __int_as_float(__builtin_amdgcn_ds_bpermute((lane ^ o) << 2, __float_as_int(v))); }
__device__ __forceinline__ float wsum(float v, int lane) {
#pragma unroll
    for (int o = 32; o > 0; o >>= 1) v += shx(v, o, lane);
    return v; }
__device__ __forceinline__ float wmax(float v, int lane) {
#pragma unroll
    for (int o = 32; o > 0; o >>= 1) v = fmaxf(v, shx(v, o, lane));
    return v; }

#define XB_TMO      128
#define XB_XCNT(j)  (256  + 64 * (j))
#define XB_XSUB(j)  (1280 + 64 * (j))
#define XB_XGEN(j)  (2304 + 64 * (j))
#define XB_TOP      3328
#define XB_TOPGEN   3392
#define XCD_BAR_WORDS 3456
#define XB_SPIN_CAP (1u << 22)
__device__ __forceinline__ unsigned xb_ld(unsigned* p)              { return __hip_atomic_load(p, __ATOMIC_RELAXED, __HIP_MEMORY_SCOPE_AGENT); }
__device__ __forceinline__ unsigned xb_add(unsigned* p, unsigned v) { return __hip_atomic_fetch_add(p, v, __ATOMIC_RELAXED, __HIP_MEMORY_SCOPE_AGENT); }
__device__ __forceinline__ unsigned xb_xcc_id() { return (unsigned)__builtin_amdgcn_s_getreg((3 << 11) | 20) & 0xFu; }
#define XB_SPIN(cond, bar) do { unsigned _sp = 0; while (cond) { __builtin_amdgcn_s_sleep(1); \
    if ((++_sp & 255u) == 0u) { if (xb_ld(&(bar)[XB_TMO])) break; if (_sp > XB_SPIN_CAP) { atomicAdd(&(bar)[XB_TMO], 1u); break; } } } } while (0)
struct XcdBarrier { unsigned* bar; unsigned x; volatile LAS unsigned* st; };
__device__ __forceinline__ XcdBarrier xcd_barrier_post(unsigned* bar, volatile LAS unsigned* st) {
    XcdBarrier b; b.bar = bar; b.x = xb_xcc_id(); b.st = st;
    if (threadIdx.x == 0) (void)xb_add(&bar[XB_XCNT(b.x)], 1u);
    return b;
}
__device__ __forceinline__ void xcd_barrier_complete(unsigned* bar, unsigned x, unsigned& nloc, unsigned& nx) {
    const unsigned G = gridDim.x * gridDim.y * gridDim.z;
    unsigned sum, cnt, mine, sp = 0u;
    for (;;) {
        sum = 0u; cnt = 0u; mine = 0u;
#pragma unroll
        for (unsigned j = 0; j < 16; ++j) { const unsigned c = xb_ld(&bar[XB_XCNT(j)]); sum += c; cnt += (c > 0u) ? 1u : 0u; mine = (j == x) ? c : mine; }
        if (sum == G) break;
        __builtin_amdgcn_s_sleep(1);
        if ((++sp & 255u) == 0u) { if (xb_ld(&bar[XB_TMO])) break; if (sp > XB_SPIN_CAP) { atomicAdd(&bar[XB_TMO], 1u); break; } }
    }
    nloc = mine > 0u ? mine : 1u; nx = cnt > 0u ? cnt : 1u;
}
__device__ __forceinline__ void xcd_barrier(const XcdBarrier& b) {
    asm volatile("s_waitcnt vmcnt(0)" ::: "memory");
    __syncthreads();
    if (threadIdx.x == 0) {
        unsigned* bar = b.bar;
        __builtin_amdgcn_s_waitcnt(0);
        unsigned nloc = b.st[0], nx = b.st[1];
        if (nloc == 0u) { xcd_barrier_complete(bar, b.x, nloc, nx); b.st[0] = nloc; b.st[1] = nx; }
        const unsigned old = xb_add(&bar[XB_XSUB(b.x)], 1u);
        const unsigned gen = old / nloc;
        if (old + 1u == (gen + 1u) * nloc) {
            __builtin_amdgcn_fence(__ATOMIC_RELEASE, "agent");
            asm volatile("s_waitcnt vmcnt(0)" ::: "memory");
            const unsigned og = xb_add(&bar[XB_TOP], 1u);
            const unsigned tg = og / nx;
            if (og + 1u == (tg + 1u) * nx) xb_add(&bar[XB_TOPGEN], 1u);
            else XB_SPIN(xb_ld(&bar[XB_TOPGEN]) == tg, bar);
            __builtin_amdgcn_fence(__ATOMIC_ACQUIRE, "agent");
            xb_add(&bar[XB_XGEN(b.x)], 1u);
            asm volatile("s_waitcnt vmcnt(0)" ::: "memory");
        } else {
            XB_SPIN(xb_ld(&bar[XB_XGEN(b.x)]) == gen, bar);
            __builtin_amdgcn_fence(__ATOMIC_ACQUIRE, "agent");
            asm volatile("s_waitcnt vmcnt(0)" ::: "memory");
        }
    }
    __syncthreads();
}

namespace pg8 {
constexpr int BM = 256, BK = 64, HALF = 128, HTB = HALF * BK * 2, STAGE_BYTES = 8 * HTB;
__host__ __device__ __forceinline__ int lds_byte(int r, int c) { const int st = (r >> 4) * 2 + (c >> 5), rr = r & 15, cc = c & 31, ob = rr * 64 + cc * 2; return st * 1024 + (ob ^ (((ob >> 9) & 1) << 5)); }
__host__ __device__ __forceinline__ void stage_rc(int b, int& R, int& C) { const int st = b / 1024, sb = b % 1024, swz = sb ^ (((sb >> 9) & 1) << 5); R = (st >> 1) * 16 + swz / 64; C = (st & 1) * 32 + (swz % 64) / 2; }
__host__ __device__ __forceinline__ int perm32(int rho) { const int n = rho >> 4, i = rho & 15; return 8 * (i >> 2) + 4 * n + (i & 3); }

struct Unit {
    int row0;
    int col0;
    const char* Bt;
    const int* rows;
    int nvalid;
    int e;
};

template <class Epi, class Sched, bool GATHER, int ESZ = 2>
__device__ __forceinline__ void gemm_phase(LAS unsigned char* lds, const bf16_t* Abase, const int K, const Sched& S, const Epi& E, const int wid_in) {
    int wid = wid_in; asm volatile("" : "+s"(wid));
    int lane; asm volatile("v_mbcnt_lo_u32_b32 %0, -1, 0\n\tv_mbcnt_hi_u32_b32 %0, -1, %0" : "=&v"(lane));
    const int tid = wid * 64 + lane, wr = wid >> 2, wc = wid & 3, fr = lane & 15, fq = lane >> 4;
    const int nt = K * ESZ / 128;
    unsigned voffB[2];
#pragma unroll
    for (int i = 0; i < 2; ++i) { int R, C; stage_rc(tid * 16 + i * 8192, R, C); const int Rb = Epi::PERM ? ((R & ~31) + perm32(R & 31)) : R; voffB[i] = (unsigned)(Rb * K * ESZ + C * 2); }
    const size_t kstep = (size_t)(BK * 2);
    const size_t hstep = (size_t)HALF * K * ESZ;
    const unsigned ldsw = (unsigned)wid * 1024u;
    const int aoff = lds_byte(wr * 64 + fr, fq * 8), boff = lds_byte(wc * 32 + fr, fq * 8);
#define PG8_SA(b, h) (((b) * 2 + (h)) * HTB)
#define PG8_SB(b, h) ((4 + (b) * 2 + (h)) * HTB)
#define PG8_STAGE(bufoff, gbase, voff) do { _Pragma("unroll") for (int _i = 0; _i < 2; ++_i) \
        __builtin_amdgcn_global_load_lds((const unsigned*)((const char*)(gbase) + (voff)[_i]), (LAS unsigned*)(lds + (bufoff) + ldsw + _i * 8192), 16, 0, 0); } while (0)
#define PG8_LDA(dst, b, h) do { _Pragma("unroll") for (int m = 0; m < 4; ++m) _Pragma("unroll") for (int k = 0; k < 2; ++k) dst[m][k] = *(const LAS bf16x8*)(lds + PG8_SA(b, h) + aoff + m * 2048 + k * 1024); } while (0)
#define PG8_LDB(dst, b, h) do { _Pragma("unroll") for (int n = 0; n < 2; ++n) _Pragma("unroll") for (int k = 0; k < 2; ++k) dst[n][k] = *(const LAS bf16x8*)(lds + PG8_SB(b, h) + boff + n * 2048 + k * 1024); } while (0)
#define PG8_MMA(ai, bj, At, Bt) do { __builtin_amdgcn_s_setprio(1); _Pragma("unroll") for (int m = 0; m < 4; ++m) _Pragma("unroll") for (int n = 0; n < 2; ++n) { \
        if constexpr (ESZ == 2) { _Pragma("unroll") for (int k = 0; k < 2; ++k) acc[ai][bj][m][n] = __builtin_amdgcn_mfma_f32_16x16x32_f16(Bt[n][k], At[m][k], acc[ai][bj][m][n], 0, 0, 0); } \
        else {   \
            const u32x4 _a0 = __builtin_bit_cast(u32x4, At[m][0]), _a1 = __builtin_bit_cast(u32x4, At[m][1]), _b0 = __builtin_bit_cast(u32x4, Bt[n][0]), _b1 = __builtin_bit_cast(u32x4, Bt[n][1]); \
            const i32x8 _af = {(int)_a0[0], (int)_a0[1], (int)_a0[2], (int)_a0[3], (int)_a1[0], (int)_a1[1], (int)_a1[2], (int)_a1[3]}; \
            const i32x8 _bf = {(int)_b0[0], (int)_b0[1], (int)_b0[2], (int)_b0[3], (int)_b1[0], (int)_b1[1], (int)_b1[2], (int)_b1[3]}; \
              \
            asm volatile("v_mfma_scale_f32_16x16x128_f8f6f4 %0, %1, %2, %0, %3, %3 op_sel_hi:[0,0,0]" : "+v"(acc[ai][bj][m][n]) : "v"(_bf), "v"(_af), "v"(s8)); } } \
        __builtin_amdgcn_s_setprio(0); } while (0)
#define PG8_WAIT_V(n) asm volatile("s_waitcnt vmcnt(" #n ")" ::: "memory")
#define PG8_WAIT_VS() do { if (slack) { if constexpr (Epi::NST >= 16) asm volatile("s_waitcnt vmcnt(24)" ::: "memory"); else asm volatile("s_waitcnt vmcnt(16)" ::: "memory"); } else asm volatile("s_waitcnt vmcnt(8)" ::: "memory"); } while (0)
#define PG8_WAIT_L(n) asm volatile("s_waitcnt lgkmcnt(" #n ")" ::: "memory")
#define PG8_BAR __builtin_amdgcn_s_barrier()
#define PG8_SCHED __builtin_amdgcn_sched_barrier(0)
#define PG8_AOFFS(dst, u) do { _Pragma("unroll") for (int _h = 0; _h < 2; ++_h) _Pragma("unroll") for (int _i = 0; _i < 2; ++_i) { int _R, _C; stage_rc(tid * 16 + _i * 8192, _R, _C); \
        const int _r = _h * HALF + _R; const int _src = (_r < (u).nvalid) ? (u).rows[_r] : 0; dst[_h][_i] = (unsigned)(_src * K * ESZ + _C * 2); } } while (0)
#define PG8_RAWLOAD(dst, u) do { _Pragma("unroll") for (int _h = 0; _h < 2; ++_h) _Pragma("unroll") for (int _i = 0; _i < 2; ++_i) { int _R, _C; stage_rc(tid * 16 + _i * 8192, _R, _C); \
        const int _r = _h * HALF + _R; dst[_h][_i] = (_r < (u).nvalid) ? (u).rows[_r] : 0; } } while (0)
#define PG8_STAGE_A(bufoff, h, ktb, usenext) do { if constexpr (GATHER) { const unsigned _o[2] = {(usenext) ? na[h][0] : oa[h][0], (usenext) ? na[h][1] : oa[h][1]}; PG8_STAGE(bufoff, cA + (ktb), _o); } \
        else { PG8_STAGE(bufoff, ((usenext) ? nA : cA) + (size_t)(h) * hstep + (ktb), voffA); } } while (0)
    Unit cur, nxt; int ui = 0;
    if (!S.next(0, cur)) return;
    f32x4 acc[2][2][4][2];
#pragma unroll
    for (int a = 0; a < 2; ++a)
#pragma unroll
        for (int b = 0; b < 2; ++b)
#pragma unroll
            for (int m = 0; m < 4; ++m)
#pragma unroll
                for (int n = 0; n < 2; ++n) acc[a][b][m][n] = (f32x4){0.f, 0.f, 0.f, 0.f};
    bf16x8 At[4][2], B0[2][2], B1[2][2];
    int s8 = 0x7F7F7F7F; asm volatile("" : "+v"(s8));
    unsigned oa[2][2], na[2][2], voffA[2];
    const char* cA; const char* nA; const char* cB = cur.Bt;
    int raw[2][2] = {{0, 0}, {0, 0}};
    if constexpr (GATHER) { PG8_AOFFS(oa, cur); cA = (const char*)Abase; nA = cA; voffA[0] = voffA[1] = 0u; if (S.next(1, nxt)) { PG8_RAWLOAD(raw, nxt); } }
    else { cA = cur.rows ? (const char*)cur.rows : (const char*)Abase + (size_t)cur.row0 * K * ESZ; nA = cA;
#pragma unroll
        for (int i = 0; i < 2; ++i) { int R, C; stage_rc(tid * 16 + i * 8192, R, C); voffA[i] = (unsigned)(R * K * ESZ + C * 2); oa[0][i] = oa[1][i] = na[0][i] = na[1][i] = 0u; } }
    PG8_STAGE(PG8_SB(0, 0), cB, voffB); PG8_STAGE(PG8_SB(0, 1), cB + hstep, voffB); PG8_STAGE_A(PG8_SA(0, 0), 0, 0, false); PG8_STAGE_A(PG8_SA(0, 1), 1, 0, false);
    if (wr == 1) PG8_BAR;
    PG8_WAIT_V(2); PG8_BAR;
    PG8_STAGE(PG8_SB(1, 0), cB + kstep, voffB); PG8_STAGE_A(PG8_SA(1, 0), 0, kstep, false); PG8_STAGE(PG8_SB(1, 1), cB + hstep + kstep, voffB);
    PG8_WAIT_V(6); PG8_BAR;
    for (;;) {
        const bool has_next = S.next(ui + 1, nxt);
        if constexpr (GATHER) {
            if (has_next) {
#pragma unroll
                for (int h = 0; h < 2; ++h)
#pragma unroll
                    for (int i = 0; i < 2; ++i) { int R, C; stage_rc(tid * 16 + i * 8192, R, C); na[h][i] = (unsigned)(raw[h][i] * K * ESZ + C * 2); }
                asm volatile("" : "+v"(na[0][0]), "+v"(na[0][1]), "+v"(na[1][0]), "+v"(na[1][1]));
            } else {
#pragma unroll
                for (int h = 0; h < 2; ++h)
#pragma unroll
                    for (int i = 0; i < 2; ++i) na[h][i] = oa[h][i];
            }
            Unit n2;
            if (has_next && S.next(ui + 2, n2)) { PG8_RAWLOAD(raw, n2); }
        } else nA = has_next ? (nxt.rows ? (const char*)nxt.rows : (const char*)Abase + (size_t)nxt.row0 * K * ESZ) : cA;
        const char* nB = has_next ? nxt.Bt : cB;
#pragma unroll 1
        for (int t = 0; t < nt; t += 2) {
            const bool last = (t == nt - 2);
            const bool slack = (t == 0) && (ui > 0);
            const size_t k1 = (size_t)(t + 1) * kstep, k2 = last ? 0 : (size_t)(t + 2) * kstep, k3 = k2 + kstep;
            const char* b2 = last ? nB : cB + (size_t)(t + 2) * kstep; const char* b3 = b2 + kstep;
            PG8_LDB(B0, 0, 0); PG8_LDB(B1, 0, 1); PG8_SCHED; PG8_LDA(At, 0, 0); PG8_STAGE_A(PG8_SA(1, 1), 1, k1, false);
            PG8_WAIT_VS(); PG8_WAIT_L(0); PG8_BAR; PG8_MMA(0, 0, At, B0); PG8_MMA(0, 1, At, B1); PG8_BAR; PG8_SCHED;
            PG8_LDA(At, 0, 1); PG8_STAGE(PG8_SB(0, 0), b2, voffB); PG8_STAGE(PG8_SB(0, 1), b2 + hstep, voffB); PG8_STAGE_A(PG8_SA(0, 0), 0, k2, last);
            PG8_WAIT_VS(); PG8_WAIT_L(0); PG8_BAR; PG8_MMA(1, 0, At, B0); PG8_MMA(1, 1, At, B1); PG8_BAR; PG8_SCHED;
            PG8_LDB(B0, 1, 0); PG8_LDB(B1, 1, 1); PG8_SCHED; PG8_LDA(At, 1, 0); PG8_STAGE_A(PG8_SA(0, 1), 1, k2, last);
            PG8_WAIT_V(8); PG8_WAIT_L(0); PG8_BAR; PG8_MMA(0, 0, At, B0); PG8_MMA(0, 1, At, B1); PG8_BAR; PG8_SCHED;
            PG8_LDA(At, 1, 1); PG8_STAGE(PG8_SB(1, 0), b3, voffB); PG8_STAGE(PG8_SB(1, 1), b3 + hstep, voffB); PG8_STAGE_A(PG8_SA(1, 0), 0, k3, last);
            PG8_WAIT_V(8); PG8_WAIT_L(0); PG8_BAR; PG8_MMA(1, 0, At, B0); PG8_MMA(1, 1, At, B1); PG8_BAR; PG8_SCHED;
        }
        if constexpr (ESZ == 1) asm volatile("s_nop 15\n\ts_nop 15" ::: "memory");
        if (wr == 0) PG8_BAR;
        E(acc, cur, wr, wc, fr, fq);
        if (!has_next) break;
#pragma unroll
        for (int a = 0; a < 2; ++a)
#pragma unroll
            for (int b = 0; b < 2; ++b)
#pragma unroll
                for (int m = 0; m < 4; ++m)
#pragma unroll
                    for (int n = 0; n < 2; ++n) acc[a][b][m][n] = (f32x4){0.f, 0.f, 0.f, 0.f};
        cur = nxt; cB = nB; ++ui;
        if constexpr (GATHER) {
#pragma unroll
            for (int h = 0; h < 2; ++h)
#pragma unroll
                for (int i = 0; i < 2; ++i) oa[h][i] = na[h][i];
        } else cA = nA;
        if (wr == 1) PG8_BAR;
    }
    PG8_WAIT_V(0);
    PG8_BAR;
#undef PG8_SA
#undef PG8_SB
#undef PG8_STAGE
#undef PG8_LDA
#undef PG8_LDB
#undef PG8_MMA
#undef PG8_WAIT_V
#undef PG8_WAIT_L
#undef PG8_WAIT_VS
#undef PG8_BAR
#undef PG8_SCHED
#undef PG8_AOFFS
#undef PG8_RAWLOAD
#undef PG8_STAGE_A
}

struct DenseOrder {
    int nRT, nN, G, c; const char* Bt; int K; bool swap;
    __device__ __forceinline__ bool next(int i, Unit& u) const {
        const int xcd = c & 7, s = i * (G >> 3) + (c >> 3);
        int rt, pn;
        if (!swap) { rt = 8 * (s / nN) + xcd; pn = s % nN; } else { pn = 8 * (s / nRT) + xcd; rt = s % nRT; }
        if (rt >= nRT || pn >= nN) return false;
        u.row0 = rt * BM; u.col0 = pn * BM; u.Bt = Bt + (size_t)pn * BM * K * 2; u.rows = nullptr; u.nvalid = 0; u.e = 0; return true;
    }
};
struct InProjOrder {
    int G, c; const char* Win; const char* Wv; const char* Xb;
    __device__ __forceinline__ bool next(int i, Unit& u) const {
        constexpr int NM = (T / 256 / 8) * (HQP / 256), NV = (T / 256 / 8) * 4;
        const int xcd = c & 7, s = i * (G >> 3) + (c >> 3);
        if (s < NM) { const int rt = 8 * (s / (HQP / 256)) + xcd, pn = s % (HQP / 256);
            u.row0 = rt * BM; u.col0 = pn * BM; u.Bt = Win + (size_t)pn * BM * 2048; u.rows = (const int*)(Xb + (size_t)rt * BM * 2048); u.nvalid = 0; u.e = 0; return true; }
        const int s2 = s - NM;
        if (s2 >= NV) return false;
        const int pn = 8 * (s2 >> 2) + xcd, rt = s2 & 3;
        u.row0 = rt * BM; u.col0 = pn * BM; u.Bt = Xb + (size_t)pn * BM * 2048; u.rows = (const int*)(Wv + (size_t)rt * BM * 2048); u.nvalid = 0; u.e = 1; return true;
    }
};
struct MoeTables { LAS const int* tstart; LAS const int* cnt; LAS const unsigned char* tile_e; int nrt; };
struct MoeOrder {
    MoeTables tb; int nN, G, c; const char* Bt; size_t strideB; const int* tokl; bool gather; int rowb;
    __device__ __forceinline__ bool next(int i, Unit& u) const {
        const int xcd = c & 7, s = i * (G >> 3) + (c >> 3);
        const int q = 8 * (s / nN) + xcd, pn = s % nN;
        if (q >= tb.nrt) return false;
        const int e = __builtin_amdgcn_readfirstlane((int)tb.tile_e[q]); const int lt = q - __builtin_amdgcn_readfirstlane(tb.tstart[e]);
        u.row0 = q * BM; u.col0 = pn * BM; u.e = e; u.Bt = Bt + (size_t)e * strideB + (size_t)pn * BM * rowb;
        u.rows = gather ? tokl + (size_t)e * T + lt * BM : nullptr; u.nvalid = __builtin_amdgcn_readfirstlane(tb.cnt[e]) - lt * BM; return true;
    }
};

struct EpiBf16Plain {
    static constexpr bool PERM = true; static constexpr int NST = 16;
    bf16_t* O; int ldc;
    __device__ __forceinline__ void operator()(const f32x4 (&acc)[2][2][4][2], const Unit& u, int wr, int wc, int fr, int fq) const {
        const int row0 = u.row0 + wr * 64 + fr, col0 = u.col0 + wc * 32 + 8 * fq;
#pragma unroll
        for (int ai = 0; ai < 2; ++ai)
#pragma unroll
            for (int m = 0; m < 4; ++m) { bf16_t* rowp = O + (size_t)(row0 + ai * HALF + m * 16) * ldc + col0;
#pragma unroll
                for (int bj = 0; bj < 2; ++bj) { const f32x4 v0 = acc[ai][bj][m][0], v1 = acc[ai][bj][m][1];
                    u32x4 w; w.x = pk_bf16(v0[0], v0[1]); w.y = pk_bf16(v0[2], v0[3]); w.z = pk_bf16(v1[0], v1[1]); w.w = pk_bf16(v1[2], v1[3]);
                    *(u32x4*)(rowp + bj * HALF) = w; } }
    }
};
struct EpiInProj {
    static constexpr bool PERM = true; static constexpr int NST = 16;
    bf16_t* Ohq; bf16_t* Ovt;
    __device__ __forceinline__ void operator()(const f32x4 (&acc)[2][2][4][2], const Unit& u, int wr, int wc, int fr, int fq) const {
        bf16_t* O = u.e ? Ovt : Ohq; const int ldc = u.e ? T : HQP;
        const int row0 = u.row0 + wr * 64 + fr, col0 = u.col0 + wc * 32 + 8 * fq;
#pragma unroll
        for (int ai = 0; ai < 2; ++ai)
#pragma unroll
            for (int m = 0; m < 4; ++m) { bf16_t* rowp = O + (size_t)(row0 + ai * HALF + m * 16) * ldc + col0;
#pragma unroll
                for (int bj = 0; bj < 2; ++bj) { const f32x4 v0 = acc[ai][bj][m][0], v1 = acc[ai][bj][m][1];
                    u32x4 w; w.x = pk_bf16(v0[0], v0[1]); w.y = pk_bf16(v0[2], v0[3]); w.z = pk_bf16(v1[0], v1[1]); w.w = pk_bf16(v1[2], v1[3]);
                    *(u32x4*)(rowp + bj * HALF) = w; } }
    }
};
struct EpiResBf16 {
    static constexpr bool PERM = true; static constexpr int NST = 16;
    bf16_t* O; const bf16_t* R;
    __device__ __forceinline__ void operator()(const f32x4 (&acc)[2][2][4][2], const Unit& u, int wr, int wc, int fr, int fq) const {
        const int row0 = u.row0 + wr * 64 + fr, col0 = u.col0 + wc * 32 + 8 * fq;
        u32x4 rr[2][4][2];
#pragma unroll
        for (int ai = 0; ai < 2; ++ai)
#pragma unroll
            for (int m = 0; m < 4; ++m)
#pragma unroll
                for (int bj = 0; bj < 2; ++bj) rr[ai][m][bj] = __builtin_nontemporal_load((const u32x4*)(R + (size_t)(row0 + ai * HALF + m * 16) * 1024 + col0 + bj * HALF));
#pragma unroll
        for (int ai = 0; ai < 2; ++ai)
#pragma unroll
            for (int m = 0; m < 4; ++m) { const size_t off = (size_t)(row0 + ai * HALF + m * 16) * 1024 + col0;
#pragma unroll
                for (int bj = 0; bj < 2; ++bj) { const u32x4 r = rr[ai][m][bj]; const f32x4 v0 = acc[ai][bj][m][0], v1 = acc[ai][bj][m][1];
                    u32x4 w; w.x = pk_bf16(bf_lo(r[0]) * ALPHA + v0[0], bf_hi(r[0]) * ALPHA + v0[1]); w.y = pk_bf16(bf_lo(r[1]) * ALPHA + v0[2], bf_hi(r[1]) * ALPHA + v0[3]);
                    w.z = pk_bf16(bf_lo(r[2]) * ALPHA + v1[0], bf_hi(r[2]) * ALPHA + v1[1]); w.w = pk_bf16(bf_lo(r[3]) * ALPHA + v1[2], bf_hi(r[3]) * ALPHA + v1[3]);
                    *(u32x4*)(O + off + bj * HALF) = w; } }
    }
};
template <bool F8> struct EpiSwiglu {
    static constexpr bool PERM = true; static constexpr int NST = F8 ? 8 : 8;
    void* Ov; const float* bias; float ascale;
    __device__ __forceinline__ void operator()(const f32x4 (&acc)[2][2][4][2], const Unit& u, int wr, int wc, int fr, int fq) const {
        const int row0 = u.row0 + wr * 64 + fr, oc = (u.col0 >> 1) + wc * 32 + 8 * fq;
        const float* bp = bias + (size_t)u.e * 2048 + oc;
        f32x4 bg[2], bu[2];
#pragma unroll
        for (int n = 0; n < 2; ++n) { bg[n] = *(const f32x4*)(bp + 4 * n); bu[n] = *(const f32x4*)(bp + 1024 + 4 * n); }
#pragma unroll
        for (int ai = 0; ai < 2; ++ai)
#pragma unroll
            for (int m = 0; m < 4; ++m) {
                float o[8];
#pragma unroll
                for (int n = 0; n < 2; ++n) { const f32x4 g4 = acc[ai][0][m][n] * ascale + bg[n], u4 = acc[ai][1][m][n] * ascale + bu[n];
#pragma unroll
                    for (int j = 0; j < 4; ++j) { const float g = fminf(g4[j], 7.0f), up = __builtin_amdgcn_fmed3f(u4[j], -7.0f, 7.0f);
                        constexpr float OS = F8 ? A8_SCALE : 1.0f;
                        const float e = __builtin_amdgcn_exp2f(-1.702f * LOG2E * g), glu = g * __builtin_amdgcn_rcpf(__builtin_fmaf(e, 1.0f / OS, 1.0f / OS)); o[4 * n + j] = __builtin_fmaf(up, glu, glu); } }
                if constexpr (F8) {
                    int w0 = 0, w1 = 0; w0 = __builtin_amdgcn_cvt_pk_fp8_f32(o[0], o[1], w0, false); w0 = __builtin_amdgcn_cvt_pk_fp8_f32(o[2], o[3], w0, true);
                    w1 = __builtin_amdgcn_cvt_pk_fp8_f32(o[4], o[5], w1, false); w1 = __builtin_amdgcn_cvt_pk_fp8_f32(o[6], o[7], w1, true);
                    *(u32x2*)((unsigned char*)Ov + (size_t)(row0 + ai * HALF + m * 16) * 1024 + oc) = (u32x2){(unsigned)w0, (unsigned)w1}; }
                else { u32x4 w; w.x = pk_bf16(o[0], o[1]); w.y = pk_bf16(o[2], o[3]); w.z = pk_bf16(o[4], o[5]); w.w = pk_bf16(o[6], o[7]);
                    *(u32x4*)((bf16_t*)Ov + (size_t)(row0 + ai * HALF + m * 16) * 1024 + oc) = w; } }
    }
};
struct EpiBiasBf16 {
    static constexpr bool PERM = true; static constexpr int NST = 16;
    bf16_t* O; const float* bias; float ascale;
    __device__ __forceinline__ void operator()(const f32x4 (&acc)[2][2][4][2], const Unit& u, int wr, int wc, int fr, int fq) const {
        const int row0 = u.row0 + wr * 64 + fr, col0 = u.col0 + wc * 32 + 8 * fq;
        const float* bp = bias + (size_t)u.e * 1024 + col0;
        f32x4 bv[2][2];
#pragma unroll
        for (int bj = 0; bj < 2; ++bj)
#pragma unroll
            for (int n = 0; n < 2; ++n) bv[bj][n] = *(const f32x4*)(bp + bj * HALF + 4 * n);
#pragma unroll
        for (int ai = 0; ai < 2; ++ai)
#pragma unroll
            for (int m = 0; m < 4; ++m) { bf16_t* rowp = O + (size_t)(row0 + ai * HALF + m * 16) * 1024 + col0;
#pragma unroll
                for (int bj = 0; bj < 2; ++bj) { const f32x4 v0 = acc[ai][bj][m][0] * ascale + bv[bj][0], v1 = acc[ai][bj][m][1] * ascale + bv[bj][1];
                    u32x4 w; w.x = pk_bf16(v0[0], v0[1]); w.y = pk_bf16(v0[2], v0[3]); w.z = pk_bf16(v1[0], v1[1]); w.w = pk_bf16(v1[2], v1[3]);
                    *(u32x4*)(rowp + bj * HALF) = w; } }
    }
};
}


#ifndef ATT_EN
#define ATT_EN 7
#endif
#ifndef PROBE
#define PROBE (-1)
#endif
#define PREP(k) _Pragma("unroll 1") for (int _rp = ((PROBE == (k)) ? 0 : 1); _rp < 2; ++_rp)
typedef float f32x16 __attribute__((ext_vector_type(16)));
#define MFMA32(a, b, c) __builtin_amdgcn_mfma_f32_32x32x16_f16((a), (b), (c), 0, 0, 0)
constexpr float ATT_THR = 8.0f;
constexpr int ATT_KB = 8192;
#define NEG_INF_F (-__builtin_huge_valf())

template <int MODE>
__device__ __forceinline__ void attn_unit(LAS unsigned char* lds, const bf16_t* HQ, const bf16_t* VT, bf16_t* MIX, const unsigned long long* MASK, float* OA1,
                                          const int b, const int h, const int qt, const int wave_in, const int lane_unused,
                                          const float lam, const float lam_init, const float* subg, const float* relb) {
    int wave = wave_in; asm volatile("" : "+s"(wave));
    constexpr int NPASS = (MODE == 0) ? 2 : 1;
    constexpr int EB = (MODE == 0) ? 4 : 2;
    constexpr int NLV = EB / 2;
    constexpr int SLOTB = ATT_KB + EB * 32 * 128;
    constexpr int XOFF = 3 * SLOTB;
    const int qoff = (MODE == 0) ? HQ_QA + h * 128 : (MODE == 1) ? HQ_QB + h * 64 : HQ_QC + h * 64;
    const int koff = (MODE == 0) ? HQ_KA + h * 128 : (MODE == 1) ? HQ_KB + h * 64 : HQ_KC + h * 64;
    const int vrow0 = (MODE == 0) ? VT_A + h * 128 : (MODE == 1) ? VT_B + h * 64 : VT_C + h * 64;
    const int mixcol = (MODE == 0) ? h * 128 : (MODE == 1) ? 512 + h * 64 : 768 + h * 64;
    int lane; asm volatile("v_mbcnt_lo_u32_b32 %0, -1, 0\n\tv_mbcnt_hi_u32_b32 %0, -1, %0" : "=&v"(lane));
    const int tid = wave * 64 + lane, ql = lane & 31, hb = lane >> 5;
    const int cq = qt * 4 + (wave >> 1);
    const int tq = qt * 256 + wave * 32 + ql;
    const int kt_hi = qt * 4 + 3;
    const int kt_lo = (MODE == 1) ? ((qt * 4 - 8) > 0 ? (qt * 4 - 8) : 0) : 0;
    const int ntile = kt_hi - kt_lo + 1;
    const float slope2 = (MODE == 0) ? exp2f(-(float)(2 * h + 1)) * LOG2E : exp2f(-(float)(2 * h + 2)) * LOG2E;
    LAS float* relb_l = (LAS float*)(lds + XOFF);
    float so[16];
#pragma unroll
    for (int i = 0; i < 16; ++i) { int oi = 16 * (i >> 3) + (i & 7); asm volatile("" : "+s"(oi));
        so[i] = __int_as_float(__builtin_amdgcn_readfirstlane(__float_as_int(slope2 * (float)oi))); }
    const int prow = (ql & 16) | ((ql & 4) << 1) | ((ql & 8) >> 1) | (ql & 3);
    const int kt_x = (hb ^ ((prow >> 1) & 7)) << 4, vt_x = (hb ^ ((ql >> 1) & 7)) << 4;
    const int krd = prow * 128, vrd = ATT_KB + ql * 128;
    const int drow = lane >> 3, dpos = lane & 7;
    const int krow_g = 8 * wave + drow;
    const size_t ksrc = ((size_t)(b * SEQ + krow_g) * HQP + koff + ((dpos ^ ((krow_g >> 1) & 7)) << 3)) * 2;
    size_t vsrc[NLV];
#pragma unroll
    for (int j = 0; j < NLV; ++j) { const int vr = 8 * (wave + 8 * j) + drow; vsrc[j] = ((size_t)(vrow0 + vr) * T + (size_t)b * SEQ + ((dpos ^ ((vr >> 1) & 7)) << 3)) * 2; }

#pragma unroll 1
    for (int mp = 0; mp < NPASS; ++mp) {
#define ATT_ISSUE(kt_, slot_) do { \
        __builtin_amdgcn_global_load_lds((const unsigned*)((const char*)HQ + ksrc + (size_t)(kt_) * (64 * HQP * 2) + mp * 128), (LAS unsigned*)(lds + (slot_) * SLOTB + wave * 1024), 16, 0, 0); \
        _Pragma("unroll") for (int j = 0; j < NLV; ++j) \
            __builtin_amdgcn_global_load_lds((const unsigned*)((const char*)VT + vsrc[j] + (size_t)(kt_) * 128), (LAS unsigned*)(lds + (slot_) * SLOTB + ATT_KB + (wave + 8 * j) * 1024), 16, 0, 0); } while (0)
        asm volatile("s_waitcnt vmcnt(0)" ::: "memory");
        __syncthreads();
        ATT_ISSUE(kt_hi, 0);
        ATT_ISSUE((ntile > 1 ? kt_hi - 1 : kt_hi), 1);
        if (MODE == 1 && mp == 0) { for (int i = tid; i < 320; i += 512) relb_l[i] = relb[i < 256 ? i : 256] * LOG2E; }
        if (MODE == 2) {
#pragma unroll
            for (int i = 0; i < 8; ++i) { const int q = wave * 32 + i * 4 + (lane >> 4), p = lane & 15;
                __builtin_amdgcn_global_load_lds((const unsigned*)((const char*)MASK + ((size_t)(b * SEQ + qt * 256 + q) * 32 + (((p - q) & 15) << 1)) * 8),
                                                 (LAS unsigned*)(lds + XOFF + (wave * 32 + i * 4) * 256), 16, 0, 0); }
        }
        bf16x8 Q[4];
        { const bf16_t* qp = HQ + (size_t)(b * SEQ + tq) * HQP + qoff + mp * 64 + hb * 8;
#pragma unroll
          for (int ks = 0; ks < 4; ++ks) Q[ks] = *(const bf16x8*)(qp + ks * 16); }
        asm volatile("" : "+v"(Q[0]), "+v"(Q[1]), "+v"(Q[2]), "+v"(Q[3]));
        f32x16 O[EB];
        float mref = 0.f, seen = 0.f, lrun = 0.f;
#pragma unroll
        for (int eb = 0; eb < EB; ++eb)
#pragma unroll
            for (int i = 0; i < 16; ++i) O[eb][i] = 0.f;
        asm volatile("s_waitcnt lgkmcnt(0)" ::: "memory");
        int slot = 0;
        for (int jt = 0; jt < ntile; ++jt) {
            const int kt = kt_hi - jt;
            if constexpr (MODE == 0) asm volatile("s_waitcnt vmcnt(3)" ::: "memory"); else asm volatile("s_waitcnt vmcnt(2)" ::: "memory");
            __builtin_amdgcn_s_barrier();
            { const int nj = jt + 2 < ntile ? jt + 2 : ntile - 1; int ns = slot + 2; ns = ns >= 3 ? ns - 3 : ns; ATT_ISSUE(kt_hi - nj, ns); }
            const bool active = (kt <= cq) && (MODE != 1 || kt >= cq - 8);
            if (active) {
                const LAS unsigned char* kbp = lds + slot * SLOTB + krd;
                const LAS unsigned char* vbp = lds + slot * SLOTB + vrd;
                f32x16 S0, S1;
                if (MODE == 0 || MODE == 2) {
                    const float base0 = (float)(tq - kt * 64 - 8 * hb);
                    if (kt == cq) {
#pragma unroll
                        for (int i = 0; i < 16; ++i) { const float off = (float)(16 * (i >> 3) + (i & 7));
                            S0[i] = -slope2 * fabsf(base0 - off) - mref; S1[i] = -slope2 * fabsf(base0 - 32.0f - off) - mref; }
                    } else {
                        const float c0 = -slope2 * base0 - mref, c1 = c0 + 32.0f * slope2;
#pragma unroll
                        for (int i = 0; i < 16; ++i) { S0[i] = so[i] + c0; S1[i] = so[i] + c1; }
                    }
                }
                if (MODE == 2) {
                    const int mq = wave * 32 + ql; const unsigned long long W = *(const LAS unsigned long long*)(lds + XOFF + mq * 256 + ((((kt >> 1) + mq) & 15) << 4) + ((kt & 1) << 3));
                    const unsigned w0 = (unsigned)W >> (8 * hb), w1 = (unsigned)(W >> 32) >> (8 * hb);
#pragma unroll
                    for (int i = 0; i < 16; ++i) { const int off = 16 * (i >> 3) + (i & 7);
                        const int m0 = __builtin_amdgcn_sbfe((int)w0, off, 1), m1 = __builtin_amdgcn_sbfe((int)w1, off, 1);
                        S0[i] = __int_as_float((__float_as_int(S0[i]) & m0) | ((int)0xFF800000 & ~m0)); S1[i] = __int_as_float((__float_as_int(S1[i]) & m1) | ((int)0xFF800000 & ~m1)); }
                }
                if (MODE == 1) {
                    if (kt >= cq - 2) {
                        const int rel0 = tq - kt * 64 - 8 * hb + 128;
#pragma unroll
                        for (int i = 0; i < 16; ++i) { const int off = 16 * (i >> 3) + (i & 7);
                            S0[i] = relb_l[rel0 - off] - mref; S1[i] = relb_l[rel0 - 32 - off] - mref; }
                    } else {
                        const float far = relb_l[256] - mref;
#pragma unroll
                        for (int i = 0; i < 16; ++i) { S0[i] = far; S1[i] = far; }
                    }
                }
                bf16x8 kf[8], vf0[8];
#pragma unroll
                for (int ks = 0; ks < 4; ++ks) { kf[2 * ks] = *(const LAS bf16x8*)(kbp + ((ks << 5) ^ kt_x)); kf[2 * ks + 1] = *(const LAS bf16x8*)(kbp + 4096 + ((ks << 5) ^ kt_x)); }
#pragma unroll
                for (int i = 0; i < 8; ++i) { const int s4i = i / EB, eb = i % EB; vf0[i] = *(const LAS bf16x8*)(vbp + eb * 4096 + ((s4i << 5) ^ vt_x)); }
#pragma unroll
                for (int ks = 0; ks < 4; ++ks) { S0 = MFMA32(kf[2 * ks], Q[ks], S0); S1 = MFMA32(kf[2 * ks + 1], Q[ks], S1); }
                __builtin_amdgcn_sched_group_barrier(0x100, 16, 0); __builtin_amdgcn_sched_group_barrier(0x008, 8, 0);
                float mx; asm("s_nop 15\n\ts_nop 3\n\tv_max3_f32 %0, %1, %2, %3" : "=v"(mx) : "v"(S0[0]), "v"(S1[0]), "v"(S0[1]));
                asm("v_max3_f32 %0, %1, %2, %3" : "=v"(mx) : "v"(mx), "v"(S1[1]), "v"(S0[2]));
#pragma unroll
                for (int i = 2; i < 15; ++i) asm("v_max3_f32 %0, %1, %2, %3" : "=v"(mx) : "v"(mx), "v"(S1[i]), "v"(S0[i + 1]));
                asm("v_max_f32 %0, %1, %2" : "=v"(mx) : "v"(mx), "v"(S1[15]));
                mx = fmaxf(mx, shx(mx, 32, lane));
                const bool unseen = !(seen > 0.f), finite = mx > -1e30f;
                const bool need = unseen ? finite : (mx > ATT_THR);
                if (__ballot(unseen ? finite : (mx >= -36.0f)) != 0ull) {
                    if (__ballot(need) != 0ull) {
                        const float d = need ? mx : 0.f;
                        mref += d; seen = (unseen && finite) ? 1.f : seen;
                        const float alpha = unseen ? 1.0f : __builtin_amdgcn_exp2f(-d);
                        lrun *= alpha;
#pragma unroll
                        for (int eb = 0; eb < EB; ++eb) O[eb] = O[eb] * alpha;
#pragma unroll
                        for (int i = 0; i < 16; ++i) { S0[i] -= d; S1[i] -= d; }
                    }
                    float ps = 0.f;
#pragma unroll
                    for (int i = 0; i < 16; ++i) { S0[i] = __builtin_amdgcn_exp2f(S0[i]); S1[i] = __builtin_amdgcn_exp2f(S1[i]); ps += S0[i] + S1[i]; }
                    lrun += ps;
                    bf16x8 P[4];
                    { u32x4 p;
                      p.x = pk_bf16(S0[0], S0[1]); p.y = pk_bf16(S0[2], S0[3]); p.z = pk_bf16(S0[4], S0[5]); p.w = pk_bf16(S0[6], S0[7]); P[0] = __builtin_bit_cast(bf16x8, p);
                      p.x = pk_bf16(S0[8], S0[9]); p.y = pk_bf16(S0[10], S0[11]); p.z = pk_bf16(S0[12], S0[13]); p.w = pk_bf16(S0[14], S0[15]); P[1] = __builtin_bit_cast(bf16x8, p);
                      p.x = pk_bf16(S1[0], S1[1]); p.y = pk_bf16(S1[2], S1[3]); p.z = pk_bf16(S1[4], S1[5]); p.w = pk_bf16(S1[6], S1[7]); P[2] = __builtin_bit_cast(bf16x8, p);
                      p.x = pk_bf16(S1[8], S1[9]); p.y = pk_bf16(S1[10], S1[11]); p.z = pk_bf16(S1[12], S1[13]); p.w = pk_bf16(S1[14], S1[15]); P[3] = __builtin_bit_cast(bf16x8, p); }
                    if constexpr (EB == 4) {
                        bf16x8 vf1[8];
#pragma unroll
                        for (int i = 0; i < 8; ++i) { const int s4i = 2 + i / EB, eb = i % EB; vf1[i] = *(const LAS bf16x8*)(vbp + eb * 4096 + ((s4i << 5) ^ vt_x)); }
#pragma unroll
                        for (int i = 0; i < 8; ++i) { const int s4i = i / EB, eb = i % EB; O[eb] = MFMA32(vf0[i], P[s4i], O[eb]); }
#pragma unroll
                        for (int i = 0; i < 8; ++i) { const int s4i = 2 + i / EB, eb = i % EB; O[eb] = MFMA32(vf1[i], P[s4i], O[eb]); }
                        __builtin_amdgcn_sched_group_barrier(0x100, 8, 0); __builtin_amdgcn_sched_group_barrier(0x008, 16, 0);
                    } else {
#pragma unroll
                        for (int i = 0; i < 8; ++i) { const int s4i = i / EB, eb = i % EB; O[eb] = MFMA32(vf0[i], P[s4i], O[eb]); }
                    }
                }
            }
            slot = slot == 2 ? 0 : slot + 1;
        }
#undef ATT_ISSUE
        const float inv = 1.0f / (lrun + shx(lrun, 32, lane));
        bf16_t* op = MIX + (size_t)(b * SEQ + tq) * 1024 + mixcol + 4 * hb;
        if (MODE == 0) {
            bf16_t* o1p = (bf16_t*)OA1 + (size_t)(b * SEQ + tq) * 512 + h * 128 + 4 * hb;
            if (mp == 0) {
#pragma unroll
                for (int eb = 0; eb < EB; ++eb)
#pragma unroll
                    for (int g = 0; g < 4; ++g) *(u32x2*)(o1p + eb * 32 + 8 * g) = (u32x2){pk_bf16(O[eb][4 * g] * inv, O[eb][4 * g + 1] * inv), pk_bf16(O[eb][4 * g + 2] * inv, O[eb][4 * g + 3] * inv)};
            } else {
                const float c2 = lam * inv;
                float ss = 0.f;
#pragma unroll
                for (int eb = 0; eb < EB; ++eb)
#pragma unroll
                    for (int g = 0; g < 4; ++g) { const u32x2 o1h = *(const u32x2*)(o1p + eb * 32 + 8 * g); const f32x4 o1 = {bf_lo(o1h[0]), bf_hi(o1h[0]), bf_lo(o1h[1]), bf_hi(o1h[1])};
#pragma unroll
                        for (int j = 0; j < 4; ++j) { const float o = o1[j] - O[eb][4 * g + j] * c2; O[eb][4 * g + j] = o; ss += o * o; } }
                ss += shx(ss, 32, lane);
                const float r = rsqrtf(ss * (1.0f / 128.0f) + EPS) * (1.0f - lam_init);
#pragma unroll
                for (int eb = 0; eb < EB; ++eb)
#pragma unroll
                    for (int g = 0; g < 4; ++g) { const int e0 = eb * 32 + 8 * g; const f32x4 sg = *(const f32x4*)(subg + e0 + 4 * hb);
                        *(u32x2*)(op + e0) = (u32x2){pk_bf16(O[eb][4 * g] * r * sg[0], O[eb][4 * g + 1] * r * sg[1]), pk_bf16(O[eb][4 * g + 2] * r * sg[2], O[eb][4 * g + 3] * r * sg[3])}; }
            }
        } else {
#pragma unroll
            for (int eb = 0; eb < EB; ++eb)
#pragma unroll
                for (int g = 0; g < 4; ++g) { const int e0 = eb * 32 + 8 * g;
                    *(u32x2*)(op + e0) = (u32x2){pk_bf16(O[eb][4 * g] * inv, O[eb][4 * g + 1] * inv), pk_bf16(O[eb][4 * g + 2] * inv, O[eb][4 * g + 3] * inv)}; }
        }
    }
}


constexpr int IDX_STR = 2052;
__device__ __forceinline__ unsigned f2key(float f) { const unsigned u = __float_as_uint(f); return u ^ (((unsigned)((int)u >> 31)) | 0x80000000u); }
template <int J>
__device__ __forceinline__ void index_select(const LAS float* row, const int nb, const int lane, unsigned long long* mo) {
    unsigned u[J];
#pragma unroll
    for (int j = 0; j < J; ++j) u[j] = (j < nb) ? f2key(row[64 * j]) : 0u;
    unsigned prefix = 0u; bool exact = false;
#pragma unroll 1
    for (int bit = 31; bit >= 0; --bit) {
        const unsigned cand = prefix | (1u << bit);
        int c = 0;
#pragma unroll
        for (int j0 = 0; j0 < J; j0 += 8) {
            unsigned long long bm[8];
#pragma unroll
            for (int j = 0; j < 8; ++j) bm[j] = __ballot(u[j0 + j] >= cand);
            asm volatile("" : "+s"(bm[0]), "+s"(bm[1]), "+s"(bm[2]), "+s"(bm[3]), "+s"(bm[4]), "+s"(bm[5]), "+s"(bm[6]), "+s"(bm[7]));
#pragma unroll
            for (int j = 0; j < 8; ++j) c += (int)__builtin_popcountll(bm[j]);
        }
        if (c >= 256) prefix = cand;
        if (c == 256) { exact = true; break; }
    }
    unsigned thr = prefix; asm volatile("" : "+v"(thr));
    unsigned long long myword = 0ull;
    if (exact) {
#pragma unroll
        for (int j = 0; j < J; ++j) { const unsigned long long m = __ballot(u[j] >= thr); myword = (lane == j) ? m : myword; }
    } else {
        int cg = 0;
#pragma unroll
        for (int j = 0; j < J; ++j) cg += (int)__builtin_popcountll(__ballot(u[j] > thr));
        const int quota = 256 - cg;
        int taken = 0;
#pragma unroll
        for (int j = 0; j < J; ++j) {
            const bool eq = (u[j] == thr);
            const unsigned long long eqm = __ballot(eq);
            const int before = (int)__builtin_popcountll(eqm & ((1ull << lane) - 1ull));
            const unsigned long long m = __ballot((u[j] > thr) || (eq && (taken + before < quota)));
            taken += (int)__builtin_popcountll(eqm);
            myword = (lane == j) ? m : myword;
        }
    }
    if (lane < 32) mo[lane] = myword;
}
__device__ __forceinline__ void index_unit(LAS unsigned char* lds, const bf16_t* HQ, unsigned long long* MASK, const int b, const int tt, const int wave_in) {
    int wave = wave_in; asm volatile("" : "+s"(wave));
    int lane; asm volatile("v_mbcnt_lo_u32_b32 %0, -1, 0\n\tv_mbcnt_hi_u32_b32 %0, -1, %0" : "=&v"(lane));
    const int t0 = tt * 16, nb = (t0 >> 6) + 1, nk = nb * 64;
    if (nb <= 4) {
        for (int i = wave * 64 + lane; i < 16 * 32; i += 512) MASK[(size_t)(b * SEQ + t0 + (i >> 5)) * 32 + (i & 31)] = ((i & 31) < nb) ? ~0ull : 0ull;
        return;
    }
    LAS float* sc = (LAS float*)lds;
    const int q = lane & 15, g = lane >> 4;
    {
        const bf16_t* qrow = HQ + (size_t)(b * SEQ + t0 + q) * HQP;
        bf16x8 QI[8];
#pragma unroll
        for (int h = 0; h < 8; ++h) QI[h] = *(const bf16x8*)(qrow + HQ_QI + h * 32 + g * 8);
        float w[8];
        { const u32x4 wv = *(const u32x4*)(qrow + HQ_WI);
          w[0] = bf_lo(wv[0]) * 0.0625f; w[1] = bf_hi(wv[0]) * 0.0625f; w[2] = bf_lo(wv[1]) * 0.0625f; w[3] = bf_hi(wv[1]) * 0.0625f;
          w[4] = bf_lo(wv[2]) * 0.0625f; w[5] = bf_hi(wv[2]) * 0.0625f; w[6] = bf_lo(wv[3]) * 0.0625f; w[7] = bf_hi(wv[3]) * 0.0625f; }
        const bf16_t* kbase = HQ + (size_t)(b * SEQ + q) * HQP + HQ_KI + g * 8;
        for (int kb0 = wave; kb0 < nk / 16; kb0 += 32) {
            bf16x8 kf[4];
#pragma unroll
            for (int u = 0; u < 4; ++u) { const int kb = kb0 + 8 * u; kf[u] = (kb < nk / 16) ? *(const bf16x8*)(kbase + (size_t)kb * 16 * HQP) : (bf16x8){0, 0, 0, 0, 0, 0, 0, 0}; }
#pragma unroll
            for (int u = 0; u < 4; ++u) {
                const int kb = kb0 + 8 * u;
                if (kb < nk / 16) {
                    f32x4 acc = {0.f, 0.f, 0.f, 0.f};
#pragma unroll
                    for (int h = 0; h < 8; ++h) {
                        const f32x4 z = __builtin_amdgcn_mfma_f32_16x16x32_f16(kf[u], QI[h], (f32x4){0.f, 0.f, 0.f, 0.f}, 0, 0, 0);
#pragma unroll
                        for (int j = 0; j < 4; ++j) acc[j] = fmaf(w[h], fmaxf(z[j], 0.f), acc[j]);
                    }
#pragma unroll
                    for (int j = 0; j < 4; ++j) acc[j] += 0.0f;
                    *(LAS f32x4*)(sc + q * IDX_STR + kb * 16 + g * 4) = acc;
                }
            }
        }
    }
    __syncthreads();
#pragma unroll 1
    for (int qq = 0; qq < 2; ++qq) {
        const int ql = wave * 2 + qq;
        const LAS float* row = sc + ql * IDX_STR + lane;
        unsigned long long* mo = MASK + (size_t)(b * SEQ + t0 + ql) * 32;
        if (nb <= 8) index_select<8>(row, nb, lane, mo);
        else if (nb <= 16) index_select<16>(row, nb, lane, mo);
        else if (nb <= 24) index_select<24>(row, nb, lane, mo);
        else index_select<32>(row, nb, lane, mo);
    }
    __syncthreads();
}

struct Args {
    const float* x; const float* w_in; const float* lam_q1; const float* lam_k1; const float* lam_q2; const float* lam_k2; const float* subln_g; const float* rel_bias;
    const float* w_out; const float* ln1_g; const float* ln1_b; const float* w_router; const float* b_router; const float* w_gu; const float* b_gu;
    const float* w_down; const float* b_down; const float* ln2_g; const float* ln2_b;
    float* out; unsigned char* ws;
    int ph_lo, ph_hi, bar_region, pad;
};

constexpr int LDS_STAGE = 0;
constexpr int LDS_CTL = 135168;
constexpr int LDS_TSTART = LDS_CTL + 64;
constexpr int LDS_CNT = LDS_TSTART + 36 * 4;
constexpr int LDS_TILEE = LDS_CNT + 32 * 4;
constexpr int LDS_RT = LDS_TILEE + 576;
constexpr int LDS_GB = 147456;
constexpr int LDS_BYTES = 147456 + 8192;
static_assert(LDS_RT + (64 + 1024) * 4 <= LDS_BYTES && 16 * IDX_STR * 4 <= LDS_CTL, "LDS map");

__device__ __forceinline__ void transpose_item(const float* W, int N, int k0, int n0, int nvalid, bf16_t* WTrow0, float scale, LAS float* scr, int lane) {
#pragma unroll
    for (int i = 0; i < 32; ++i) { const int kk = 2 * i + (lane >> 5), col = lane & 31; scr[kk * 33 + col] = (col < nvalid) ? W[(size_t)(k0 + kk) * N + n0 + col] * scale : 0.f; }
    asm volatile("s_waitcnt lgkmcnt(0)" ::: "memory");
    const int c = lane & 7;
#pragma unroll
    for (int j = 0; j < 4; ++j) { const int n = (lane >> 3) + 8 * j; const LAS float* s = scr + (8 * c) * 33 + n;
        u32x4 o; o.x = pk_bf16(s[0 * 33], s[1 * 33]); o.y = pk_bf16(s[2 * 33], s[3 * 33]); o.z = pk_bf16(s[4 * 33], s[5 * 33]); o.w = pk_bf16(s[6 * 33], s[7 * 33]);
        if (n < nvalid) *(u32x4*)(WTrow0 + (size_t)n * 1024 + k0 + 8 * c) = o; }
    asm volatile("s_waitcnt lgkmcnt(0)" ::: "memory");
}
__device__ __forceinline__ void transpose_item_fp8(const float* W, int N, int k0, int n0, unsigned char* WTrow0, float scale, int lane) {
    const int rg = lane >> 4, cg = lane & 15;
    const float* src = W + (size_t)(k0 + 32 * rg) * N + n0 + 4 * cg;
    f32x4 v[32];
#pragma unroll
    for (int i = 0; i < 32; ++i) v[i] = __builtin_nontemporal_load((const f32x4*)(src + (size_t)i * N));
    unsigned char* dst = WTrow0 + (size_t)(4 * cg) * 1024 + k0 + 32 * rg;
#pragma unroll
    for (int j = 0; j < 4; ++j) {
#pragma unroll
        for (int h = 0; h < 2; ++h) {
            u32x4 o;
            o.x = pk4_fp8(v[16 * h + 0][j] * scale, v[16 * h + 1][j] * scale, v[16 * h + 2][j] * scale, v[16 * h + 3][j] * scale);
            o.y = pk4_fp8(v[16 * h + 4][j] * scale, v[16 * h + 5][j] * scale, v[16 * h + 6][j] * scale, v[16 * h + 7][j] * scale);
            o.z = pk4_fp8(v[16 * h + 8][j] * scale, v[16 * h + 9][j] * scale, v[16 * h + 10][j] * scale, v[16 * h + 11][j] * scale);
            o.w = pk4_fp8(v[16 * h + 12][j] * scale, v[16 * h + 13][j] * scale, v[16 * h + 14][j] * scale, v[16 * h + 15][j] * scale);
            *(u32x4*)(dst + (size_t)j * 1024 + 16 * h) = o;
        }
    }
}
__device__ __forceinline__ void in_map(int n0, bool& isv, int& row, float& scale) {
    scale = 1.f; isv = false;
    if (n0 < 512) { row = HQ_QA + n0; scale = QSCALE; }
    else if (n0 < 1024) row = HQ_KA + (n0 - 512);
    else if (n0 < 1536) { isv = true; row = VT_A + (n0 - 1024); }
    else if (n0 < 1792) { row = HQ_QB + (n0 - 1536); scale = QSCALE; }
    else if (n0 < 2048) row = HQ_KB + (n0 - 1792);
    else if (n0 < 2304) { isv = true; row = VT_B + (n0 - 2048); }
    else if (n0 < 2560) { row = HQ_QC + (n0 - 2304); scale = QSCALE; }
    else if (n0 < 2816) row = HQ_KC + (n0 - 2560);
    else if (n0 < 3072) { isv = true; row = VT_C + (n0 - 2816); }
    else if (n0 < 3328) row = HQ_QI + (n0 - 3072);
    else if (n0 < 3360) row = HQ_KI + (n0 - 3328);
    else row = HQ_WI + (n0 - 3360);
}

__global__ void __launch_bounds__(512, 2) mega(Args a) {
    extern __shared__ __attribute__((aligned(16))) unsigned char lds_raw[];
    LAS unsigned char* lds = (LAS unsigned char*)lds_raw;
    const int G = gridDim.x, bid = blockIdx.x, NGW = G * 8;
    const int wave0 = __builtin_amdgcn_readfirstlane((int)threadIdx.x >> 6);
#define OPAQUE_IDS() int wave = wave0; asm volatile("" : "+s"(wave)); int lane; asm volatile("v_mbcnt_lo_u32_b32 %0, -1, 0\n\tv_mbcnt_hi_u32_b32 %0, -1, %0" : "=&v"(lane)); const int tid = wave * 64 + lane, gw = bid * 8 + wave; (void)tid; (void)gw
#define WSPTRS() __attribute__((address_space(1))) unsigned char* wsg_ = (__attribute__((address_space(1))) unsigned char*)a.ws; asm volatile("" : "+s"(wsg_)); unsigned char* ws = (unsigned char*)wsg_;     \
    unsigned* ctl = (unsigned*)(ws + WS_CTL); bf16_t* Win = (bf16_t*)(ws + WS_WIN); bf16_t* Wv = (bf16_t*)(ws + WS_WV); bf16_t* Wout = (bf16_t*)(ws + WS_WOUT); \
    bf16_t* Wgu = (bf16_t*)(ws + WS_WGU); bf16_t* Wdn = (bf16_t*)(ws + WS_WDN); bf16_t* XB = (bf16_t*)(ws + WS_XB); \
    bf16_t* HQ = (bf16_t*)(ws + WS_HQ); bf16_t* VT = (bf16_t*)(ws + WS_VT); bf16_t* MIX = (bf16_t*)(ws + WS_MIX); \
    bf16_t* Y1B = (bf16_t*)(ws + WS_Y1); bf16_t* X1B = (bf16_t*)(ws + WS_X1B); bf16_t* ACT = (bf16_t*)(ws + WS_ACT); bf16_t* YR = (bf16_t*)(ws + WS_YR); \
    int* TOKL = (int*)(ws + WS_TOKL); int* ASGE = (int*)(ws + WS_ASGE); int* ASGS = (int*)(ws + WS_ASGS); float* GATE = (float*)(ws + WS_GATE); \
    (void)ctl; (void)Win; (void)Wv; (void)Wout; (void)Wgu; (void)Wdn; (void)XB; (void)HQ; (void)VT; (void)MIX; (void)Y1B; (void)X1B; (void)ACT; (void)YR; (void)TOKL; (void)ASGE; (void)ASGS; (void)GATE
    for (int u = threadIdx.x; u < (LDS_BYTES - LDS_CTL) / 4; u += 512) ((LAS unsigned*)(lds + LDS_CTL))[u] = 0u;
    __syncthreads();
    XcdBarrier bar = xcd_barrier_post((unsigned*)(a.ws + WS_CTL) + CW_BAR + a.bar_region * XCD_BAR_WORDS, (volatile LAS unsigned*)(lds + LDS_CTL));
    const int lo = a.ph_lo, hi = a.ph_hi;
#define IN(k) (lo <= (k) && (k) < hi)
#define SEAM(k) do { if (IN(k) && IN((k) + 1)) xcd_barrier(bar); } while (0)

    if (IN(0)) PREP(0) {
        OPAQUE_IDS(); WSPTRS();
        LAS float* scr = (LAS float*)(lds + LDS_STAGE + wave * 16384);
        #if MOE_FP8
        constexpr int I_IN = 16 * 106, I_OUT = 16 * 32, I_GU = 8 * 32, I_DN = 8 * 16;
#else
        constexpr int I_IN = 16 * 106, I_OUT = 16 * 32, I_GU = 16 * 64, I_DN = 16 * 32;
#endif
        constexpr int N_IN = DEPTH * I_IN, N_OUT = DEPTH * I_OUT, N_GU = DEPTH * NE * I_GU, N_DN = DEPTH * NE * I_DN;
        for (int it = gw; it < N_IN + N_OUT + N_GU + N_DN; it += NGW) {
            int r = it;
            if (r < N_IN) { const int l = r / I_IN, q = r % I_IN, kb = q / 106, nb = q % 106, n0 = nb * 32; bool isv; int row; float sc; in_map(n0, isv, row, sc);
                bf16_t* dst = isv ? Wv + ((size_t)l * 1024 + row) * 1024 : Win + ((size_t)l * HQP + row) * 1024;
                transpose_item(a.w_in + (size_t)l * D * DIN, DIN, kb * 64, n0, (DIN - n0) < 32 ? (DIN - n0) : 32, dst, sc, scr, lane); continue; }
            r -= N_IN;
            if (r < N_OUT) { const int l = r / I_OUT, q = r % I_OUT, kb = q / 32, nb = q % 32;
                transpose_item(a.w_out + (size_t)l * 1024 * D, D, kb * 64, nb * 32, 32, Wout + ((size_t)l * D + nb * 32) * 1024, 1.f, scr, lane); continue; }
            r -= N_OUT;
#if MOE_FP8
            if (r < N_GU) { const int le = r / I_GU, q = r % I_GU, kb = q >> 5, nb = q & 31, n0 = nb * 64;
                const int bj = n0 >> 10, rr = n0 & 1023, pn = rr >> 7, c = rr & 127, nrow = pn * 256 + bj * 128 + c;
                transpose_item_fp8(a.w_gu + (size_t)le * D * 2048, 2048, kb * 128, n0, (unsigned char*)Wgu + ((size_t)le * 2048 + nrow) * 1024, W8_SCALE, lane); continue; }
#else
            if (r < N_GU) { const int le = r / I_GU, q = r % I_GU, kb = q / 64, nb = q % 64, n0 = nb * 32;
                const int bj = n0 >> 10, rr = n0 & 1023, pn = rr >> 7, c = rr & 127, nrow = pn * 256 + bj * 128 + c;
                transpose_item(a.w_gu + (size_t)le * D * 2048, 2048, kb * 64, n0, 32, Wgu + ((size_t)le * 2048 + nrow) * 1024, 1.f, scr, lane); continue; }
#endif
            r -= N_GU;
#if MOE_FP8
            { const int le = r / I_DN, q = r % I_DN, kb = q >> 4, nb = q & 15;
                transpose_item_fp8(a.w_down + (size_t)le * 1024 * D, D, kb * 128, nb * 64, (unsigned char*)Wdn + ((size_t)le * D + nb * 64) * 1024, W8_SCALE, lane); }
#else
            { const int le = r / I_DN, q = r % I_DN, kb = q / 32, nb = q % 32;
                transpose_item(a.w_down + (size_t)le * 1024 * D, D, kb * 64, nb * 32, 32, Wdn + ((size_t)le * D + nb * 32) * 1024, 1.f, scr, lane); }
#endif
        }
        for (int i = gw * 64 + lane; i < DEPTH * (HQP - HQ_USED) * 128; i += NGW * 64) { const int l = i / ((HQP - HQ_USED) * 128), q = i % ((HQP - HQ_USED) * 128);
            *(u32x4*)(Win + ((size_t)l * HQP + HQ_USED) * 1024 + (size_t)q * 8) = (u32x4){0u, 0u, 0u, 0u}; }
        { bf16_t* WRH = (bf16_t*)(ws + WS_WRT); bf16_t* WRL = WRH + (size_t)DEPTH * NE * D;
          for (int i = gw * 64 + lane; i < DEPTH * NE * D; i += NGW * 64) { const int ll = i / (NE * D), r = i % (NE * D), e = r / D, c = r % D; const float w = a.w_router[((size_t)ll * D + c) * NE + e];
              const unsigned h = pk_bf16(w, 0.f) & 0xffffu; WRH[i] = (bf16_t)h; WRL[i] = (bf16_t)(pk_bf16(w - bf_lo(h), 0.f) & 0xffffu); } }
        for (size_t i = (size_t)gw * 64 + lane; i < (size_t)T * D / 8; i += (size_t)NGW * 64) { const f32x4 v0 = *(const f32x4*)(a.x + i * 8), v1 = *(const f32x4*)(a.x + i * 8 + 4);
            u32x4 w; w.x = pk_bf16(v0[0], v0[1]); w.y = pk_bf16(v0[2], v0[3]); w.z = pk_bf16(v1[0], v1[1]); w.w = pk_bf16(v1[2], v1[3]); *(u32x4*)(XB + i * 8) = w; }
    }
    SEAM(0);

#pragma unroll 1
    for (int l = 0; l < DEPTH; ++l) {
        const int pb = 1 + 8 * l;
        if (IN(pb + 0)) PREP(1) {
            WSPTRS();
            pg8::InProjOrder S{G, bid, (const char*)(Win + (size_t)l * HQP * 1024), (const char*)(Wv + (size_t)l * 1024 * 1024), (const char*)XB};
            pg8::EpiInProj E{HQ, VT};
            pg8::gemm_phase<pg8::EpiInProj, pg8::InProjOrder, false>(lds + LDS_STAGE, XB, 1024, S, E, wave0);
        }
        SEAM(pb + 0);
        if (IN(pb + 1)) {
            OPAQUE_IDS(); WSPTRS();
            unsigned long long* MASKp = (unsigned long long*)(ws + WS_MASK); float* OA1p = (float*)(ws + WS_OA1);
            const float lam_init = 0.8f - 0.6f * expf(-0.3f * (float)l);
            const float lam = expf(wsum(a.lam_q1[l * 64 + lane] * a.lam_k1[l * 64 + lane], lane)) - expf(wsum(a.lam_q2[l * 64 + lane] * a.lam_k2[l * 64 + lane], lane)) + lam_init;
            const int v0 = (G % 8 == 0) ? (bid & 7) * (G >> 3) + (bid >> 3) : bid;
            for (int v = v0; v < 256; v += G) {
                const int b = v >> 4, h = (v >> 2) & 3, q0 = v & 3, j16 = v & 15;
                PREP(2)
#pragma unroll 1
                for (int k = 0; k < 8; ++k) index_unit(lds + LDS_STAGE, HQ, MASKp, b, 16 * k + ((k & 1) ? 15 - j16 : j16), wave);
                PREP(3)
#pragma unroll 1
                for (int rep = 0; rep < 2; ++rep) attn_unit<0>(lds + LDS_STAGE, HQ, VT, MIX, MASKp, OA1p, b, rep ? 3 - h : h, rep ? 7 - q0 : q0, wave, lane, lam, lam_init, a.subln_g + l * 128, nullptr);
                PREP(4)
#pragma unroll 1
                for (int rep = 0; rep < 2; ++rep) attn_unit<1>(lds + LDS_STAGE, HQ, VT, MIX, MASKp, OA1p, b, h, rep ? 7 - q0 : q0, wave, lane, 0.f, 0.f, nullptr, a.rel_bias + ((size_t)l * 4 + h) * 257);
            }
        }
        SEAM(pb + 1);
        if (IN(pb + 2)) {
            OPAQUE_IDS(); WSPTRS();
            unsigned long long* MASKp = (unsigned long long*)(ws + WS_MASK); float* OA1p = (float*)(ws + WS_OA1);
            const int v0 = (G % 8 == 0) ? (bid & 7) * (G >> 3) + (bid >> 3) : bid;
            for (int v = v0; v < 256; v += G) {
                const int b = v >> 4, h = (v >> 2) & 3, q0 = v & 3;
                PREP(5)
#pragma unroll 1
                for (int rep = 0; rep < 2; ++rep) attn_unit<2>(lds + LDS_STAGE, HQ, VT, MIX, MASKp, OA1p, b, rep ? 3 - h : h, rep ? 7 - q0 : q0, wave, lane, 0.f, 0.f, nullptr, nullptr);
            }
        }
        SEAM(pb + 2);
        if (IN(pb + 3)) PREP(6) {
            WSPTRS();
            pg8::DenseOrder S{T / 256, 4, G, bid, (const char*)(Wout + (size_t)l * 1024 * 1024), 1024, false};
            pg8::EpiResBf16 E{Y1B, XB};
            pg8::gemm_phase<pg8::EpiResBf16, pg8::DenseOrder, false>(lds + LDS_STAGE, MIX, 1024, S, E, wave0);
        }
        SEAM(pb + 3);
        if (IN(pb + 4)) PREP(10) {
            OPAQUE_IDS(); WSPTRS();
            if (PROBE == 10 && _rp == 0) { TOKL = (int*)(ws + WS_END); ASGE = TOKL + NE * T; ASGS = ASGE + NASG; GATE = (float*)(ASGS + NASG); }
            LAS int* lcnt = (LAS int*)(lds + LDS_RT); LAS int* lbase = lcnt + 32; LAS int* asg_e = lcnt + 64; LAS int* asg_ls = asg_e + 512;
            const float* g1 = a.ln1_g + l * D; const float* b1 = a.ln1_b + l * D; const float* br = a.b_router + l * NE;
            unsigned* gcnt = ctl + CW_CNT + l * 64 + ((PROBE == 10 && _rp == 0) ? 4096 : 0);
            { const u32x4* srch = (const u32x4*)(ws + WS_WRT) + (size_t)l * 4096; const u32x4* srcl = (const u32x4*)(ws + WS_WRT + (size_t)DEPTH * NE * D * 2) + (size_t)l * 4096;
              for (int i = tid; i < 4096; i += 512) { const int e = i >> 7, c = i & 127, dst = e * 2048 + ((c ^ (e & 15)) << 4);
                  *(LAS u32x4*)(lds + LDS_STAGE + dst) = srch[i]; *(LAS u32x4*)(lds + LDS_STAGE + 65536 + dst) = srcl[i]; } }
            LAS float* st = (LAS float*)(lds + 131072);
            LAS float* g1l = (LAS float*)(lds + LDS_GB); LAS float* b1l = g1l + 1024;
            for (int i = tid; i < 1024; i += 512) { g1l[i] = g1[i]; b1l[i] = b1[i]; }
            for (int unit = bid; unit < T / 128; unit += G) {
                if (tid < 32) lcnt[tid] = 0;
                __syncthreads();
#pragma unroll 1
                for (int k = 0; k < 8; ++k) {
                    const int tl0 = wave * 16 + 2 * k, t0 = unit * 128 + tl0;
                    float v[2][16];
#pragma unroll
                    for (int tk = 0; tk < 2; ++tk)
#pragma unroll
                        for (int i = 0; i < 4; ++i) { const u32x2 u2 = *(const u32x2*)(Y1B + (size_t)(t0 + tk) * D + i * 256 + lane * 4); v[tk][4 * i] = bf_lo(u2[0]); v[tk][4 * i + 1] = bf_hi(u2[0]); v[tk][4 * i + 2] = bf_lo(u2[1]); v[tk][4 * i + 3] = bf_hi(u2[1]); }
#pragma unroll
                    for (int tk = 0; tk < 2; ++tk) {
                        float s_ = 0.f;
#pragma unroll
                        for (int i = 0; i < 16; ++i) s_ += v[tk][i];
                        const float mean = wsum(s_, lane) * (1.0f / 1024.0f);
                        float qv = 0.f;
#pragma unroll
                        for (int i = 0; i < 16; ++i) { const float d = v[tk][i] - mean; qv += d * d; }
                        const float rstd = rsqrtf(wsum(qv, lane) * (1.0f / 1024.0f) + EPS);
                        if (lane == 0) { st[(tl0 + tk) * 2] = mean; st[(tl0 + tk) * 2 + 1] = rstd; }
                    }
                }
                asm volatile("s_waitcnt lgkmcnt(0)" ::: "memory");
                __builtin_amdgcn_wave_barrier();
                {
                    const int tk = lane & 15, kg = lane >> 4, tl = wave * 16 + tk, t = unit * 128 + tl;
                    const float mean = st[tl * 2], rstd = st[tl * 2 + 1];
                    f32x4 acc0 = {0.f, 0.f, 0.f, 0.f}, acc1 = acc0;
                    const bf16_t* yrow = Y1B + (size_t)t * D + kg * 8;
                    const int e0 = tk, e1 = 16 + tk;
                    const LAS unsigned char* w0p = lds + LDS_STAGE + e0 * 2048; const LAS unsigned char* w1p = lds + LDS_STAGE + e1 * 2048;
                    u32x4 y8n[4];
#pragma unroll
                    for (int u = 0; u < 4; ++u) y8n[u] = __builtin_nontemporal_load((const u32x4*)(yrow + u * 32));
#pragma unroll 1
                    for (int ks0 = 0; ks0 < 32; ks0 += 4) {
                    u32x4 y8v[4];
#pragma unroll
                    for (int u = 0; u < 4; ++u) y8v[u] = y8n[u];
                    { const int kn = (ks0 + 4 < 32) ? ks0 + 4 : ks0;
#pragma unroll
                      for (int u = 0; u < 4; ++u) y8n[u] = __builtin_nontemporal_load((const u32x4*)(yrow + (kn + u) * 32)); }
#pragma unroll
                    for (int u = 0; u < 4; ++u) {
                        const int ks = ks0 + u;
                        const int k0 = ks * 32 + kg * 8;
                        const u32x4 y8 = y8v[u];
                        const f32x4 ga = *(const LAS f32x4*)(g1l + k0), gb = *(const LAS f32x4*)(g1l + k0 + 4), ba = *(const LAS f32x4*)(b1l + k0), bb = *(const LAS f32x4*)(b1l + k0 + 4);
                        float x[8];
                        x[0] = (bf_lo(y8[0]) - mean) * rstd * ga[0] + ba[0]; x[1] = (bf_hi(y8[0]) - mean) * rstd * ga[1] + ba[1];
                        x[2] = (bf_lo(y8[1]) - mean) * rstd * ga[2] + ba[2]; x[3] = (bf_hi(y8[1]) - mean) * rstd * ga[3] + ba[3];
                        x[4] = (bf_lo(y8[2]) - mean) * rstd * gb[0] + bb[0]; x[5] = (bf_hi(y8[2]) - mean) * rstd * gb[1] + bb[1];
                        x[6] = (bf_lo(y8[3]) - mean) * rstd * gb[2] + bb[2]; x[7] = (bf_hi(y8[3]) - mean) * rstd * gb[3] + bb[3];
                        u32x4 hx; hx.x = pk_bf16(x[0], x[1]); hx.y = pk_bf16(x[2], x[3]); hx.z = pk_bf16(x[4], x[5]); hx.w = pk_bf16(x[6], x[7]);
                        *(u32x4*)(X1B + (size_t)t * D + k0) = hx;
#if MOE_FP8
                        *(u32x2*)(ws + WS_X1Q + (size_t)t * D + k0) = (u32x2){pk4_fp8(x[0] * X8_SCALE, x[1] * X8_SCALE, x[2] * X8_SCALE, x[3] * X8_SCALE), pk4_fp8(x[4] * X8_SCALE, x[5] * X8_SCALE, x[6] * X8_SCALE, x[7] * X8_SCALE)};
#endif
                        u32x4 lx; lx.x = pk_bf16(x[0] - bf_lo(hx.x), x[1] - bf_hi(hx.x)); lx.y = pk_bf16(x[2] - bf_lo(hx.y), x[3] - bf_hi(hx.y));
                        lx.z = pk_bf16(x[4] - bf_lo(hx.z), x[5] - bf_hi(hx.z)); lx.w = pk_bf16(x[6] - bf_lo(hx.w), x[7] - bf_hi(hx.w));
                        const bf16x8 xh = __builtin_bit_cast(bf16x8, hx), xl = __builtin_bit_cast(bf16x8, lx);
                        const int c0 = ((ks * 4 + kg) ^ tk) << 4;
                        const bf16x8 wh0 = *(const LAS bf16x8*)(w0p + c0), wl0 = *(const LAS bf16x8*)(w0p + 65536 + c0);
                        const bf16x8 wh1 = *(const LAS bf16x8*)(w1p + c0), wl1 = *(const LAS bf16x8*)(w1p + 65536 + c0);
                        acc0 = __builtin_amdgcn_mfma_f32_16x16x32_f16(wh0, xh, acc0, 0, 0, 0); acc1 = __builtin_amdgcn_mfma_f32_16x16x32_f16(wh1, xh, acc1, 0, 0, 0);
                        acc0 = __builtin_amdgcn_mfma_f32_16x16x32_f16(wl0, xh, acc0, 0, 0, 0); acc1 = __builtin_amdgcn_mfma_f32_16x16x32_f16(wl1, xh, acc1, 0, 0, 0);
                        acc0 = __builtin_amdgcn_mfma_f32_16x16x32_f16(wh0, xl, acc0, 0, 0, 0); acc1 = __builtin_amdgcn_mfma_f32_16x16x32_f16(wh1, xl, acc1, 0, 0, 0);
                    }
                    }
                    float lv[8]; int li[8];
                    { const f32x4 b0 = *(const f32x4*)(br + kg * 4), b1v = *(const f32x4*)(br + 16 + kg * 4);
#pragma unroll
                      for (int j = 0; j < 4; ++j) { lv[j] = acc0[j] + b0[j]; li[j] = kg * 4 + j; lv[4 + j] = acc1[j] + b1v[j]; li[4 + j] = 16 + kg * 4 + j; } }
                    int be[4]; float bv[4];
#pragma unroll
                    for (int kk = 0; kk < 4; ++kk) {
                        float m = lv[0]; int mi = li[0];
#pragma unroll
                        for (int i = 1; i < 8; ++i) if (lv[i] > m) { m = lv[i]; mi = li[i]; }
                        { const float om = shx(m, 16, lane); const int oi = __float_as_int(shx(__int_as_float(mi), 16, lane)); if (om > m || (om == m && oi < mi)) { m = om; mi = oi; } }
                        { const float om = shx(m, 32, lane); const int oi = __float_as_int(shx(__int_as_float(mi), 32, lane)); if (om > m || (om == m && oi < mi)) { m = om; mi = oi; } }
                        be[kk] = mi; bv[kk] = m;
#pragma unroll
                        for (int i = 0; i < 8; ++i) if (li[i] == mi) lv[i] = -3e38f;
                    }
                    float ex[4], es = 0.f;
#pragma unroll
                    for (int kk = 0; kk < 4; ++kk) { ex[kk] = __expf(bv[kk] - bv[0]); es += ex[kk]; }
                    if (kg == 0) {
#pragma unroll
                        for (int kk = 0; kk < 4; ++kk) { const int sl = __hip_atomic_fetch_add(&lcnt[be[kk]], 1, __ATOMIC_RELAXED, __HIP_MEMORY_SCOPE_WORKGROUP); asg_e[tl * 4 + kk] = be[kk]; asg_ls[tl * 4 + kk] = sl; GATE[t * 4 + kk] = ex[kk] / es; }
                    }
                }
                __syncthreads();
                if (tid < 32) lbase[tid] = (int)__hip_atomic_fetch_add(gcnt + tid, (unsigned)lcnt[tid], __ATOMIC_RELAXED, __HIP_MEMORY_SCOPE_AGENT);
                __syncthreads();
                { const int e = asg_e[tid], sl = lbase[e] + asg_ls[tid], t = unit * 128 + (tid >> 2);
                  TOKL[(size_t)e * T + sl] = t; ASGE[t * 4 + (tid & 3)] = e; ASGS[t * 4 + (tid & 3)] = sl; }
                __syncthreads();
            }
        }
        SEAM(pb + 4);
        LAS int* tstart = (LAS int*)(lds + LDS_TSTART); LAS int* lcntE = (LAS int*)(lds + LDS_CNT); LAS unsigned char* tile_e = lds + LDS_TILEE;
        if (IN(pb + 5) || IN(pb + 6) || IN(pb + 7)) {
            OPAQUE_IDS(); WSPTRS();
            if (tid < 32) lcntE[tid] = (int)__hip_atomic_load(ctl + CW_CNT + l * 64 + tid, __ATOMIC_RELAXED, __HIP_MEMORY_SCOPE_AGENT);
            __syncthreads();
            if (tid == 0) { int acc = 0; for (int e = 0; e < NE; ++e) { tstart[e] = acc; acc += (lcntE[e] + 255) >> 8; } tstart[32] = acc; }
            __syncthreads();
            for (int q = tid; q < MAXRT; q += 512) { int e = 0; for (int k = 0; k < NE; ++k) if (q >= tstart[k]) e = k; tile_e[q] = (unsigned char)e; }
            __syncthreads();
        }
        pg8::MoeTables tb{tstart, lcntE, tile_e, tstart[32]};
        if (IN(pb + 5)) PREP(7) {
            WSPTRS();
#if MOE_FP8
            pg8::MoeOrder S{tb, 8, G, bid, (const char*)Wgu + (size_t)l * NE * 2048 * 1024, (size_t)2048 * 1024, TOKL, true, 1024};
            pg8::EpiSwiglu<true> E{(void*)ACT, a.b_gu + (size_t)l * NE * 2048, 1.0f / (W8_SCALE * X8_SCALE)};
            pg8::gemm_phase<pg8::EpiSwiglu<true>, pg8::MoeOrder, true, 1>(lds + LDS_STAGE, (const bf16_t*)(ws + WS_X1Q), 1024, S, E, wave0);
#else
            pg8::MoeOrder S{tb, 8, G, bid, (const char*)(Wgu + (size_t)l * NE * 2048 * 1024), (size_t)2048 * 1024 * 2, TOKL, true, 2048};
            pg8::EpiSwiglu<false> E{(void*)ACT, a.b_gu + (size_t)l * NE * 2048, 1.0f};
            pg8::gemm_phase<pg8::EpiSwiglu<false>, pg8::MoeOrder, true>(lds + LDS_STAGE, X1B, 1024, S, E, wave0);
#endif
        }
        SEAM(pb + 5);
        if (IN(pb + 6)) PREP(8) {
            WSPTRS();
#if MOE_FP8
            pg8::MoeOrder S{tb, 4, G, bid, (const char*)Wdn + (size_t)l * NE * 1024 * 1024, (size_t)1024 * 1024, TOKL, false, 1024};
            pg8::EpiBiasBf16 E{YR, a.b_down + (size_t)l * NE * 1024, 1.0f / (W8_SCALE * A8_SCALE)};
            pg8::gemm_phase<pg8::EpiBiasBf16, pg8::MoeOrder, false, 1>(lds + LDS_STAGE, ACT, 1024, S, E, wave0);
#else
            pg8::MoeOrder S{tb, 4, G, bid, (const char*)(Wdn + (size_t)l * NE * 1024 * 1024), (size_t)1024 * 1024 * 2, TOKL, false, 2048};
            pg8::EpiBiasBf16 E{YR, a.b_down + (size_t)l * NE * 1024, 1.0f};
            pg8::gemm_phase<pg8::EpiBiasBf16, pg8::MoeOrder, false>(lds + LDS_STAGE, ACT, 1024, S, E, wave0);
#endif
        }
        SEAM(pb + 6);
        if (IN(pb + 7)) PREP(9) {
            OPAQUE_IDS(); WSPTRS();
            const float* g2 = a.ln2_g + l * D; const float* b2 = a.ln2_b + l * D;
            f32x4 gg4[4], bb4[4];
#pragma unroll
            for (int i = 0; i < 4; ++i) { gg4[i] = *(const f32x4*)(g2 + i * 256 + lane * 4); bb4[i] = *(const f32x4*)(b2 + i * 256 + lane * 4); }
            for (int t0 = gw; t0 < T; t0 += 2 * NGW) {
                int e_[2][4], sl_[2][4]; float gk_[2][4];
#pragma unroll
                for (int u = 0; u < 2; ++u) { const int t = t0 + u * NGW;
#pragma unroll
                    for (int k = 0; k < 4; ++k) { e_[u][k] = ASGE[t * 4 + k]; sl_[u][k] = ASGS[t * 4 + k]; gk_[u][k] = GATE[t * 4 + k]; } }
                u32x2 xr[2][4], yr[2][4][4];
#pragma unroll
                for (int u = 0; u < 2; ++u) { const int t = t0 + u * NGW;
#pragma unroll
                    for (int i = 0; i < 4; ++i) xr[u][i] = __builtin_nontemporal_load((const u32x2*)(X1B + (size_t)t * D + i * 256 + lane * 4));
#pragma unroll
                    for (int k = 0; k < 4; ++k) { const bf16_t* yp = YR + ((size_t)tstart[e_[u][k]] * 256 + sl_[u][k]) * 1024;
#pragma unroll
                        for (int i = 0; i < 4; ++i) yr[u][k][i] = __builtin_nontemporal_load((const u32x2*)(yp + i * 256 + lane * 4)); } }
#pragma unroll
                for (int u = 0; u < 2; ++u) { const int t = t0 + u * NGW;
                    float v[16];
#pragma unroll
                    for (int i = 0; i < 4; ++i) { v[4 * i] = ALPHA * bf_lo(xr[u][i][0]); v[4 * i + 1] = ALPHA * bf_hi(xr[u][i][0]); v[4 * i + 2] = ALPHA * bf_lo(xr[u][i][1]); v[4 * i + 3] = ALPHA * bf_hi(xr[u][i][1]); }
#pragma unroll
                    for (int k = 0; k < 4; ++k) { const float gk = gk_[u][k];
#pragma unroll
                        for (int i = 0; i < 4; ++i) { const u32x2 u2 = yr[u][k][i];
                            v[4 * i] += gk * bf_lo(u2[0]); v[4 * i + 1] += gk * bf_hi(u2[0]); v[4 * i + 2] += gk * bf_lo(u2[1]); v[4 * i + 3] += gk * bf_hi(u2[1]); } }
                    float s_ = 0.f;
#pragma unroll
                    for (int i = 0; i < 16; ++i) s_ += v[i];
                    const float mean = wsum(s_, lane) * (1.0f / 1024.0f);
                    float qv = 0.f;
#pragma unroll
                    for (int i = 0; i < 16; ++i) { const float d = v[i] - mean; qv += d * d; }
                    const float rstd = rsqrtf(wsum(qv, lane) * (1.0f / 1024.0f) + EPS);
#pragma unroll
                    for (int i = 0; i < 4; ++i) {
                        const int c0 = i * 256 + lane * 4;
                        const f32x4 gg = gg4[i], bb = bb4[i];
                        float o[4];
#pragma unroll
                        for (int j = 0; j < 4; ++j) o[j] = (v[4 * i + j] - mean) * rstd * gg[j] + bb[j];
                        if (l == DEPTH - 1) *(f32x4*)(a.out + (size_t)t * D + c0) = (f32x4){o[0], o[1], o[2], o[3]};
                        else *(u32x2*)(XB + (size_t)t * D + c0) = (u32x2){pk_bf16(o[0], o[1]), pk_bf16(o[2], o[3])};
                    }
                }
            }
        }
        if (l + 1 < DEPTH) SEAM(pb + 7);
    }
#undef IN
#undef SEAM
}

extern "C" void kernel_launch(void* const* d_in, const int* in_sizes, int n_in, void* d_out, int out_size, void* d_ws, size_t ws_size, hipStream_t stream) {
    static int grid = 0;
    if (grid == 0) {
        if (ws_size < WS_END) { fprintf(stderr, "kernel_launch: workspace too small (%zu < %zu)\n", ws_size, (size_t)WS_END); grid = -1; return; }
        int dev = 0, cus = 0, per_cu = 0;
        if (hipGetDevice(&dev) != hipSuccess || hipDeviceGetAttribute(&cus, hipDeviceAttributeMultiprocessorCount, dev) != hipSuccess) { grid = -1; return; }
        if (hipFuncSetAttribute((const void*)mega, hipFuncAttributeMaxDynamicSharedMemorySize, LDS_BYTES) != hipSuccess) { fprintf(stderr, "kernel_launch: hipFuncSetAttribute failed\n"); grid = -1; return; }
        if (hipOccupancyMaxActiveBlocksPerMultiprocessor(&per_cu, (const void*)mega, 512, LDS_BYTES) != hipSuccess || per_cu < 1) { fprintf(stderr, "kernel_launch: occupancy query says %d\n", per_cu); }
        (void)hipGetLastError();
        grid = cus;
        if (grid % 8 != 0) grid -= grid % 8;
    }
    if (grid < 0) return;
    (void)hipMemsetAsync((char*)d_ws + WS_CTL, 0, CTL_BYTES, stream);
    Args a{};
    a.x = (const float*)d_in[0]; a.w_in = (const float*)d_in[1]; a.lam_q1 = (const float*)d_in[2]; a.lam_k1 = (const float*)d_in[3]; a.lam_q2 = (const float*)d_in[4]; a.lam_k2 = (const float*)d_in[5];
    a.subln_g = (const float*)d_in[6]; a.rel_bias = (const float*)d_in[7]; a.w_out = (const float*)d_in[8]; a.ln1_g = (const float*)d_in[9]; a.ln1_b = (const float*)d_in[10];
    a.w_router = (const float*)d_in[11]; a.b_router = (const float*)d_in[12]; a.w_gu = (const float*)d_in[13]; a.b_gu = (const float*)d_in[14]; a.w_down = (const float*)d_in[15];
    a.b_down = (const float*)d_in[16]; a.ln2_g = (const float*)d_in[17]; a.ln2_b = (const float*)d_in[18];
    a.out = (float*)d_out; a.ws = (unsigned char*)d_ws; a.pad = 0;
    a.ph_lo = 0; a.ph_hi = 1 + 8 * DEPTH; a.bar_region = 0;
    hipLaunchKernelGGL(mega, dim3(grid), dim3(512), LDS_BYTES, stream, a);
}
```

```cpp
#include <hip/hip_runtime.h>
#include <stdint.h>
#include <cstdio>

#define LAS __attribute__((address_space(3)))
typedef unsigned short bf16_t;
typedef _Float16 bf16x8 __attribute__((ext_vector_type(8)));
typedef float f32x4 __attribute__((ext_vector_type(4)));
typedef float f32x2 __attribute__((ext_vector_type(2)));
typedef unsigned u32x4 __attribute__((ext_vector_type(4)));
typedef unsigned u32x2 __attribute__((ext_vector_type(2)));
typedef _Float16 bf16v2 __attribute__((ext_vector_type(2)));

constexpr int D = 1024, BATCH = 16, SEQ = 2048, T = BATCH * SEQ, DEPTH = 4;
constexpr int DIN = 3368;
constexpr int NE = 32;
constexpr float ALPHA = 1.681792830507429f;
constexpr float EPS = 1e-5f;
constexpr float LOG2E = 1.4426950408889634f;
constexpr float QSCALE = 0.125f * LOG2E;
constexpr int HQP = 2560;
constexpr int HQ_QA = 0, HQ_KA = 512, HQ_QB = 1024, HQ_KB = 1280, HQ_QC = 1536, HQ_KC = 1792, HQ_QI = 2048, HQ_KI = 2304, HQ_WI = 2336, HQ_USED = 2344;
constexpr int VT_A = 0, VT_B = 512, VT_C = 768;
constexpr int NASG = T * 4;
constexpr int GROWS = NASG + NE * 256;
constexpr int MAXRT = GROWS / 256;

constexpr size_t MiB = (size_t)1 << 20;
constexpr size_t al(size_t x) { return (x + 255) & ~(size_t)255; }
constexpr size_t WS_CTL = 0, CTL_BYTES = 4 * MiB;
constexpr size_t WS_WIN = WS_CTL + CTL_BYTES;
constexpr size_t WS_WV = WS_WIN + al((size_t)DEPTH * HQP * D * 2);
constexpr size_t WS_WOUT = WS_WV + al((size_t)DEPTH * 1024 * D * 2);
constexpr size_t WS_WGU = WS_WOUT + al((size_t)DEPTH * D * 1024 * 2);
constexpr size_t WS_WDN = WS_WGU + al((size_t)DEPTH * NE * 2048 * D * 2);
constexpr size_t WS_XB = WS_WDN + al((size_t)DEPTH * NE * D * 1024 * 2);
constexpr size_t WS_HQ = WS_XB + al((size_t)T * D * 2);
constexpr size_t WS_VT = WS_HQ + al((size_t)T * HQP * 2);
constexpr size_t WS_MIX = WS_VT + al((size_t)1024 * T * 2);
constexpr size_t WS_Y1 = WS_MIX + al((size_t)T * 1024 * 2);
constexpr size_t WS_X1B = WS_Y1 + al((size_t)T * D * 2);
constexpr size_t WS_ACT = WS_X1B + al((size_t)T * D * 2);
constexpr size_t WS_YR = WS_ACT + al((size_t)GROWS * 1024 * 2);
constexpr size_t WS_MASK = WS_YR + al((size_t)GROWS * 1024 * 2);
constexpr size_t WS_TOKL = WS_MASK + al((size_t)T * 32 * 8);
constexpr size_t WS_ASGE = WS_TOKL + al((size_t)NE * T * 4);
constexpr size_t WS_ASGS = WS_ASGE + al((size_t)NASG * 4);
constexpr size_t WS_GATE = WS_ASGS + al((size_t)NASG * 4);
constexpr size_t WS_OA1 = WS_GATE + al((size_t)NASG * 4);
constexpr size_t WS_WRT = WS_OA1 + al((size_t)T * 512 * 4);
constexpr size_t WS_X1Q = WS_WRT + al((size_t)DEPTH * NE * D * 4);
constexpr size_t WS_END = WS_X1Q + al((size_t)T * D);
constexpr int CW_BAR = 4096;
constexpr int CW_CNT = 262144;

#ifndef MOE_FP8
#define MOE_FP8 1
#endif
constexpr int RTP = 2;
constexpr float W8_SCALE = 512.0f;
constexpr float X8_SCALE = 16.0f;
constexpr float A8_SCALE = 4.0f;
typedef int i32x8 __attribute__((ext_vector_type(8)));
__device__ __forceinline__ unsigned pk_bf16(float lo, float hi) { f32x2 v = {lo, hi}; return __builtin_bit_cast(unsigned, __builtin_convertvector(v, bf16v2)); }
__device__ __forceinline__ float clamp8(float x) { return __builtin_fminf(__builtin_fmaxf(x, -448.0f), 448.0f); }
__device__ __forceinline__ unsigned pk4_fp8(float a, float b, float c, float d) {
    int w = 0; w = __builtin_amdgcn_cvt_pk_fp8_f32(clamp8(a), clamp8(b), w, false); w = __builtin_amdgcn_cvt_pk_fp8_f32(clamp8(c), clamp8(d), w, true); return (unsigned)w; }
__device__ __forceinline__ float bf_lo(unsigned u) { return (float)__builtin_bit_cast(bf16v2, u)[0]; }
__device__ __forceinline__ float bf_hi(unsigned u) { return (float)__builtin_bit_cast(bf16v2, u)[1]; }
__device__ __forceinline__ float bf2f(bf16_t b) { return (float)__builtin_bit_cast(bf16v2, (unsigned)b)[0]; }
__device__ __forceinline__ float wave_sum(float v) {
#pragma unroll
    for (int o = 32; o > 0; o >>= 1) v += __shfl_xor(v, o);
    return v; }
__device__ __forceinline__ float wave_max(float v) {
#pragma unroll
    for (int o = 32; o > 0; o >>= 1) v = fmaxf(v, __shfl_xor(v, o));
    return v; }
__device__ __forceinline__ int wave_sum_i(int v) {
#pragma unroll
    for (int o = 32; o > 0; o >>= 1) v += __shfl_xor(v, o);
    return v; }

__device__ __forceinline__ float shx(float v, int o, int lane) { return __int_as_float(__builtin_amdgcn_ds_bpermute((lane ^ o) << 2, __float_as_int(v))); }
__device__ __forceinline__ float wsum(float v, int lane) {
#pragma unroll
    for (int o = 32; o > 0; o >>= 1) v += shx(v, o, lane);
    return v; }
__device__ __forceinline__ float wmax(float v, int lane) {
#pragma unroll
    for (int o = 32; o > 0; o >>= 1) v = fmaxf(v, shx(v, o, lane));
    return v; }

#define XB_TMO      128
#define XB_XCNT(j)  (256  + 64 * (j))
#define XB_XSUB(j)  (1280 + 64 * (j))
#define XB_XGEN(j)  (2304 + 64 * (j))
#define XB_TOP      3328
#define XB_TOPGEN   3392
#define XCD_BAR_WORDS 3456
#define XB_SPIN_CAP (1u << 22)
__device__ __forceinline__ unsigned xb_ld(unsigned* p)              { return __hip_atomic_load(p, __ATOMIC_RELAXED, __HIP_MEMORY_SCOPE_AGENT); }
__device__ __forceinline__ unsigned xb_add(unsigned* p, unsigned v) { return __hip_atomic_fetch_add(p, v, __ATOMIC_RELAXED, __HIP_MEMORY_SCOPE_AGENT); }
__device__ __forceinline__ unsigned xb_xcc_id() { return (unsigned)__builtin_amdgcn_s_getreg((3 << 11) | 20) & 0xFu; }
#define XB_SPIN(cond, bar) do { unsigned _sp = 0; while (cond) { __builtin_amdgcn_s_sleep(1); \
    if ((++_sp & 255u) == 0u) { if (xb_ld(&(bar)[XB_TMO])) break; if (_sp > XB_SPIN_CAP) { atomicAdd(&(bar)[XB_TMO], 1u); break; } } } } while (0)
struct XcdBarrier { unsigned* bar; unsigned x; volatile LAS unsigned* st; };
__device__ __forceinline__ XcdBarrier xcd_barrier_post(unsigned* bar, volatile LAS unsigned* st) {
    XcdBarrier b; b.bar = bar; b.x = xb_xcc_id(); b.st = st;
    if (threadIdx.x == 0) (void)xb_add(&bar[XB_XCNT(b.x)], 1u);
    return b;
}
__device__ __forceinline__ void xcd_barrier_complete(unsigned* bar, unsigned x, unsigned& nloc, unsigned& nx) {
    const unsigned G = gridDim.x * gridDim.y * gridDim.z;
    unsigned sum, cnt, mine, sp = 0u;
    for (;;) {
        sum = 0u; cnt = 0u; mine = 0u;
#pragma unroll
        for (unsigned j = 0; j < 16; ++j) { const unsigned c = xb_ld(&bar[XB_XCNT(j)]); sum += c; cnt += (c > 0u) ? 1u : 0u; mine = (j == x) ? c : mine; }
        if (sum == G) break;
        __builtin_amdgcn_s_sleep(1);
        if ((++sp & 255u) == 0u) { if (xb_ld(&bar[XB_TMO])) break; if (sp > XB_SPIN_CAP) { atomicAdd(&bar[XB_TMO], 1u); break; } }
    }
    nloc = mine > 0u ? mine : 1u; nx = cnt > 0u ? cnt : 1u;
}
__device__ __forceinline__ void xcd_barrier(const XcdBarrier& b) {
    asm volatile("s_waitcnt vmcnt(0)" ::: "memory");
    __syncthreads();
    if (threadIdx.x == 0) {
        unsigned* bar = b.bar;
        __builtin_amdgcn_s_waitcnt(0);
        unsigned nloc = b.st[0], nx = b.st[1];
        if (nloc == 0u) { xcd_barrier_complete(bar, b.x, nloc, nx); b.st[0] = nloc; b.st[1] = nx; }
        const unsigned old = xb_add(&bar[XB_XSUB(b.x)], 1u);
        const unsigned gen = old / nloc;
        if (old + 1u == (gen + 1u) * nloc) {
            __builtin_amdgcn_fence(__ATOMIC_RELEASE, "agent");
            asm volatile("s_waitcnt vmcnt(0)" ::: "memory");
            const unsigned og = xb_add(&bar[XB_TOP], 1u);
            const unsigned tg = og / nx;
            if (og + 1u == (tg + 1u) * nx) xb_add(&bar[XB_TOPGEN], 1u);
            else XB_SPIN(xb_ld(&bar[XB_TOPGEN]) == tg, bar);
            __builtin_amdgcn_fence(__ATOMIC_ACQUIRE, "agent");
            xb_add(&bar[XB_XGEN(b.x)], 1u);
            asm volatile("s_waitcnt vmcnt(0)" ::: "memory");
        } else {
            XB_SPIN(xb_ld(&bar[XB_XGEN(b.x)]) == gen, bar);
            __builtin_amdgcn_fence(__ATOMIC_ACQUIRE, "agent");
            asm volatile("s_waitcnt vmcnt(0)" ::: "memory");
        }
    }
    __syncthreads();
}

namespace pg8 {
constexpr int BM = 256, BK = 64, HALF = 128, HTB = HALF * BK * 2, STAGE_BYTES = 8 * HTB;
__host__ __device__ __forceinline__ int lds_byte(int r, int c) { const int st = (r >> 4) * 2 + (c >> 5), rr = r & 15, cc = c & 31, ob = rr * 64 + cc * 2; return st * 1024 + (ob ^ (((ob >> 9) & 1) << 5)); }
__host__ __device__ __forceinline__ void stage_rc(int b, int& R, int& C) { const int st = b / 1024, sb = b % 1024, swz = sb ^ (((sb >> 9) & 1) << 5); R = (st >> 1) * 16 + swz / 64; C = (st & 1) * 32 + (swz % 64) / 2; }
__host__ __device__ __forceinline__ int perm32(int rho) { const int n = rho >> 4, i = rho & 15; return 8 * (i >> 2) + 4 * n + (i & 3); }

struct Unit {
    int row0;
    int col0;
    const char* Bt;
    const int* rows;
    int nvalid;
    int e;
};

template <class Epi, class Sched, bool GATHER, int ESZ = 2>
__device__ __forceinline__ void gemm_phase(LAS unsigned char* lds, const bf16_t* Abase, const int K, const Sched& S, const Epi& E, const int wid_in) {
    int wid = wid_in; asm volatile("" : "+s"(wid));
    int lane; asm volatile("v_mbcnt_lo_u32_b32 %0, -1, 0\n\tv_mbcnt_hi_u32_b32 %0, -1, %0" : "=&v"(lane));
    const int tid = wid * 64 + lane, wr = wid >> 2, wc = wid & 3, fr = lane & 15, fq = lane >> 4;
    const int nt = K * ESZ / 128;
    unsigned voffB[2];
#pragma unroll
    for (int i = 0; i < 2; ++i) { int R, C; stage_rc(tid * 16 + i * 8192, R, C); const int Rb = Epi::PERM ? ((R & ~31) + perm32(R & 31)) : R; voffB[i] = (unsigned)(Rb * K * ESZ + C * 2); }
    const size_t kstep = (size_t)(BK * 2);
    const size_t hstep = (size_t)HALF * K * ESZ;
    const unsigned ldsw = (unsigned)wid * 1024u;
    const int aoff = lds_byte(wr * 64 + fr, fq * 8), boff = lds_byte(wc * 32 + fr, fq * 8);
#define PG8_SA(b, h) (((b) * 2 + (h)) * HTB)
#define PG8_SB(b, h) ((4 + (b) * 2 + (h)) * HTB)
#define PG8_STAGE(bufoff, gbase, voff) do { _Pragma("unroll") for (int _i = 0; _i < 2; ++_i) \
        __builtin_amdgcn_global_load_lds((const unsigned*)((const char*)(gbase) + (voff)[_i]), (LAS unsigned*)(lds + (bufoff) + ldsw + _i * 8192), 16, 0, 0); } while (0)
#define PG8_LDA(dst, b, h) do { _Pragma("unroll") for (int m = 0; m < 4; ++m) _Pragma("unroll") for (int k = 0; k < 2; ++k) dst[m][k] = *(const LAS bf16x8*)(lds + PG8_SA(b, h) + aoff + m * 2048 + k * 1024); } while (0)
#define PG8_LDB(dst, b, h) do { _Pragma("unroll") for (int n = 0; n < 2; ++n) _Pragma("unroll") for (int k = 0; k < 2; ++k) dst[n][k] = *(const LAS bf16x8*)(lds + PG8_SB(b, h) + boff + n * 2048 + k * 1024); } while (0)
#define PG8_MMA(ai, bj, At, Bt) do { __builtin_amdgcn_s_setprio(1); _Pragma("unroll") for (int m = 0; m < 4; ++m) _Pragma("unroll") for (int n = 0; n < 2; ++n) { \
        if constexpr (ESZ == 2) { _Pragma("unroll") for (int k = 0; k < 2; ++k) acc[ai][bj][m][n] = __builtin_amdgcn_mfma_f32_16x16x32_f16(Bt[n][k], At[m][k], acc[ai][bj][m][n], 0, 0, 0); } \
        else {   \
            const u32x4 _a0 = __builtin_bit_cast(u32x4, At[m][0]), _a1 = __builtin_bit_cast(u32x4, At[m][1]), _b0 = __builtin_bit_cast(u32x4, Bt[n][0]), _b1 = __builtin_bit_cast(u32x4, Bt[n][1]); \
            const i32x8 _af = {(int)_a0[0], (int)_a0[1], (int)_a0[2], (int)_a0[3], (int)_a1[0], (int)_a1[1], (int)_a1[2], (int)_a1[3]}; \
            const i32x8 _bf = {(int)_b0[0], (int)_b0[1], (int)_b0[2], (int)_b0[3], (int)_b1[0], (int)_b1[1], (int)_b1[2], (int)_b1[3]}; \
              \
            asm volatile("v_mfma_scale_f32_16x16x128_f8f6f4 %0, %1, %2, %0, %3, %3 op_sel_hi:[0,0,0]" : "+v"(acc[ai][bj][m][n]) : "v"(_bf), "v"(_af), "v"(s8)); } } \
        __builtin_amdgcn_s_setprio(0); } while (0)
#define PG8_WAIT_V(n) asm volatile("s_waitcnt vmcnt(" #n ")" ::: "memory")
#define PG8_WAIT_VS() do { if (slack) { if constexpr (Epi::NST >= 16) asm volatile("s_waitcnt vmcnt(24)" ::: "memory"); else asm volatile("s_waitcnt vmcnt(16)" ::: "memory"); } else asm volatile("s_waitcnt vmcnt(8)" ::: "memory"); } while (0)
#define PG8_WAIT_L(n) asm volatile("s_waitcnt lgkmcnt(" #n ")" ::: "memory")
#define PG8_BAR __builtin_amdgcn_s_barrier()
#define PG8_SCHED __builtin_amdgcn_sched_barrier(0)
#define PG8_AOFFS(dst, u) do { _Pragma("unroll") for (int _h = 0; _h < 2; ++_h) _Pragma("unroll") for (int _i = 0; _i < 2; ++_i) { int _R, _C; stage_rc(tid * 16 + _i * 8192, _R, _C); \
        const int _r = _h * HALF + _R; const int _src = (_r < (u).nvalid) ? (u).rows[_r] : 0; dst[_h][_i] = (unsigned)(_src * K * ESZ + _C * 2); } } while (0)
#define PG8_RAWLOAD(dst, u) do { _Pragma("unroll") for (int _h = 0; _h < 2; ++_h) _Pragma("unroll") for (int _i = 0; _i < 2; ++_i) { int _R, _C; stage_rc(tid * 16 + _i * 8192, _R, _C); \
        const int _r = _h * HALF + _R; dst[_h][_i] = (_r < (u).nvalid) ? (u).rows[_r] : 0; } } while (0)
#define PG8_STAGE_A(bufoff, h, ktb, usenext) do { if constexpr (GATHER) { const unsigned _o[2] = {(usenext) ? na[h][0] : oa[h][0], (usenext) ? na[h][1] : oa[h][1]}; PG8_STAGE(bufoff, cA + (ktb), _o); } \
        else { PG8_STAGE(bufoff, ((usenext) ? nA : cA) + (size_t)(h) * hstep + (ktb), voffA); } } while (0)
    Unit cur, nxt; int ui = 0;
    if (!S.next(0, cur)) return;
    f32x4 acc[2][2][4][2];
#pragma unroll
    for (int a = 0; a < 2; ++a)
#pragma unroll
        for (int b = 0; b < 2; ++b)
#pragma unroll
            for (int m = 0; m < 4; ++m)
#pragma unroll
                for (int n = 0; n < 2; ++n) acc[a][b][m][n] = (f32x4){0.f, 0.f, 0.f, 0.f};
    bf16x8 At[4][2], B0[2][2], B1[2][2];
    int s8 = 0x7F7F7F7F; asm volatile("" : "+v"(s8));
    unsigned oa[2][2], na[2][2], voffA[2];
    const char* cA; const char* nA; const char* cB = cur.Bt;
    int raw[2][2] = {{0, 0}, {0, 0}};
    if constexpr (GATHER) { PG8_AOFFS(oa, cur); cA = (const char*)Abase; nA = cA; voffA[0] = voffA[1] = 0u; if (S.next(1, nxt)) { PG8_RAWLOAD(raw, nxt); } }
    else { cA = cur.rows ? (const char*)cur.rows : (const char*)Abase + (size_t)cur.row0 * K * ESZ; nA = cA;
#pragma unroll
        for (int i = 0; i < 2; ++i) { int R, C; stage_rc(tid * 16 + i * 8192, R, C); voffA[i] = (unsigned)(R * K * ESZ + C * 2); oa[0][i] = oa[1][i] = na[0][i] = na[1][i] = 0u; } }
    PG8_STAGE(PG8_SB(0, 0), cB, voffB); PG8_STAGE(PG8_SB(0, 1), cB + hstep, voffB); PG8_STAGE_A(PG8_SA(0, 0), 0, 0, false); PG8_STAGE_A(PG8_SA(0, 1), 1, 0, false);
    if (wr == 1) PG8_BAR;
    PG8_WAIT_V(2); PG8_BAR;
    PG8_STAGE(PG8_SB(1, 0), cB + kstep, voffB); PG8_STAGE_A(PG8_SA(1, 0), 0, kstep, false); PG8_STAGE(PG8_SB(1, 1), cB + hstep + kstep, voffB);
    PG8_WAIT_V(6); PG8_BAR;
    for (;;) {
        const bool has_next = S.next(ui + 1, nxt);
        if constexpr (GATHER) {
            if (has_next) {
#pragma unroll
                for (int h = 0; h < 2; ++h)
#pragma unroll
                    for (int i = 0; i < 2; ++i) { int R, C; stage_rc(tid * 16 + i * 8192, R, C); na[h][i] = (unsigned)(raw[h][i] * K * ESZ + C * 2); }
                asm volatile("" : "+v"(na[0][0]), "+v"(na[0][1]), "+v"(na[1][0]), "+v"(na[1][1]));
            } else {
#pragma unroll
                for (int h = 0; h < 2; ++h)
#pragma unroll
                    for (int i = 0; i < 2; ++i) na[h][i] = oa[h][i];
            }
            Unit n2;
            if (has_next && S.next(ui + 2, n2)) { PG8_RAWLOAD(raw, n2); }
        } else nA = has_next ? (nxt.rows ? (const char*)nxt.rows : (const char*)Abase + (size_t)nxt.row0 * K * ESZ) : cA;
        const char* nB = has_next ? nxt.Bt : cB;
#pragma unroll 1
        for (int t = 0; t < nt; t += 2) {
            const bool last = (t == nt - 2);
            const bool slack = (t == 0) && (ui > 0);
            const size_t k1 = (size_t)(t + 1) * kstep, k2 = last ? 0 : (size_t)(t + 2) * kstep, k3 = k2 + kstep;
            const char* b2 = last ? nB : cB + (size_t)(t + 2) * kstep; const char* b3 = b2 + kstep;
            PG8_LDB(B0, 0, 0); PG8_LDB(B1, 0, 1); PG8_SCHED; PG8_LDA(At, 0, 0); PG8_STAGE_A(PG8_SA(1, 1), 1, k1, false);
            PG8_WAIT_VS(); PG8_WAIT_L(0); PG8_BAR; PG8_MMA(0, 0, At, B0); PG8_MMA(0, 1, At, B1); PG8_BAR; PG8_SCHED;
            PG8_LDA(At, 0, 1); PG8_STAGE(PG8_SB(0, 0), b2, voffB); PG8_STAGE(PG8_SB(0, 1), b2 + hstep, voffB); PG8_STAGE_A(PG8_SA(0, 0), 0, k2, last);
            PG8_WAIT_VS(); PG8_WAIT_L(0); PG8_BAR; PG8_MMA(1, 0, At, B0); PG8_MMA(1, 1, At, B1); PG8_BAR; PG8_SCHED;
            PG8_LDB(B0, 1, 0); PG8_LDB(B1, 1, 1); PG8_SCHED; PG8_LDA(At, 1, 0); PG8_STAGE_A(PG8_SA(0, 1), 1, k2, last);
            PG8_WAIT_V(8); PG8_WAIT_L(0); PG8_BAR; PG8_MMA(0, 0, At, B0); PG8_MMA(0, 1, At, B1); PG8_BAR; PG8_SCHED;
            PG8_LDA(At, 1, 1); PG8_STAGE(PG8_SB(1, 0), b3, voffB); PG8_STAGE(PG8_SB(1, 1), b3 + hstep, voffB); PG8_STAGE_A(PG8_SA(1, 0), 0, k3, last);
            PG8_WAIT_V(8); PG8_WAIT_L(0); PG8_BAR; PG8_MMA(1, 0, At, B0); PG8_MMA(1, 1, At, B1); PG8_BAR; PG8_SCHED;
        }
        if constexpr (ESZ == 1) asm volatile("s_nop 15\n\ts_nop 15" ::: "memory");
        if (wr == 0) PG8_BAR;
        E(acc, cur, wr, wc, fr, fq);
        if (!has_next) break;
#pragma unroll
        for (int a = 0; a < 2; ++a)
#pragma unroll
            for (int b = 0; b < 2; ++b)
#pragma unroll
                for (int m = 0; m < 4; ++m)
#pragma unroll
                    for (int n = 0; n < 2; ++n) acc[a][b][m][n] = (f32x4){0.f, 0.f, 0.f, 0.f};
        cur = nxt; cB = nB; ++ui;
        if constexpr (GATHER) {
#pragma unroll
            for (int h = 0; h < 2; ++h)
#pragma unroll
                for (int i = 0; i < 2; ++i) oa[h][i] = na[h][i];
        } else cA = nA;
        if (wr == 1) PG8_BAR;
    }
    PG8_WAIT_V(0);
    PG8_BAR;
#undef PG8_SA
#undef PG8_SB
#undef PG8_STAGE
#undef PG8_LDA
#undef PG8_LDB
#undef PG8_MMA
#undef PG8_WAIT_V
#undef PG8_WAIT_L
#undef PG8_WAIT_VS
#undef PG8_BAR
#undef PG8_SCHED
#undef PG8_AOFFS
#undef PG8_RAWLOAD
#undef PG8_STAGE_A
}

struct DenseOrder {
    int nRT, nN, G, c; const char* Bt; int K; bool swap;
    __device__ __forceinline__ bool next(int i, Unit& u) const {
        const int xcd = c & 7, s = i * (G >> 3) + (c >> 3);
        int rt, pn;
        if (!swap) { rt = 8 * (s / nN) + xcd; pn = s % nN; } else { pn = 8 * (s / nRT) + xcd; rt = s % nRT; }
        if (rt >= nRT || pn >= nN) return false;
        u.row0 = rt * BM; u.col0 = pn * BM; u.Bt = Bt + (size_t)pn * BM * K * 2; u.rows = nullptr; u.nvalid = 0; u.e = 0; return true;
    }
};
struct InProjOrder {
    int G, c; const char* Win; const char* Wv; const char* Xb;
    __device__ __forceinline__ bool next(int i, Unit& u) const {
        constexpr int NM = (T / 256 / 8) * (HQP / 256), NV = (T / 256 / 8) * 4;
        const int xcd = c & 7, s = i * (G >> 3) + (c >> 3);
        if (s < NM) { const int rt = 8 * (s / (HQP / 256)) + xcd, pn = s % (HQP / 256);
            u.row0 = rt * BM; u.col0 = pn * BM; u.Bt = Win + (size_t)pn * BM * 2048; u.rows = (const int*)(Xb + (size_t)rt * BM * 2048); u.nvalid = 0; u.e = 0; return true; }
        const int s2 = s - NM;
        if (s2 >= NV) return false;
        const int pn = 8 * (s2 >> 2) + xcd, rt = s2 & 3;
        u.row0 = rt * BM; u.col0 = pn * BM; u.Bt = Xb + (size_t)pn * BM * 2048; u.rows = (const int*)(Wv + (size_t)rt * BM * 2048); u.nvalid = 0; u.e = 1; return true;
    }
};
struct MoeTables { LAS const int* tstart; LAS const int* cnt; LAS const unsigned char* tile_e; int nrt; };
struct MoeOrder {
    MoeTables tb; int nN, G, c; const char* Bt; size_t strideB; const int* tokl; bool gather; int rowb;
    __device__ __forceinline__ bool next(int i, Unit& u) const {
        const int xcd = c & 7, s = i * (G >> 3) + (c >> 3);
        const int q = 8 * (s / nN) + xcd, pn = s % nN;
        if (q >= tb.nrt) return false;
        const int e = __builtin_amdgcn_readfirstlane((int)tb.tile_e[q]); const int lt = q - __builtin_amdgcn_readfirstlane(tb.tstart[e]);
        u.row0 = q * BM; u.col0 = pn * BM; u.e = e; u.Bt = Bt + (size_t)e * strideB + (size_t)pn * BM * rowb;
        u.rows = gather ? tokl + (size_t)e * T + lt * BM : nullptr; u.nvalid = __builtin_amdgcn_readfirstlane(tb.cnt[e]) - lt * BM; return true;
    }
};

struct EpiBf16Plain {
    static constexpr bool PERM = true; static constexpr int NST = 16;
    bf16_t* O; int ldc;
    __device__ __forceinline__ void operator()(const f32x4 (&acc)[2][2][4][2], const Unit& u, int wr, int wc, int fr, int fq) const {
        const int row0 = u.row0 + wr * 64 + fr, col0 = u.col0 + wc * 32 + 8 * fq;
#pragma unroll
        for (int ai = 0; ai < 2; ++ai)
#pragma unroll
            for (int m = 0; m < 4; ++m) { bf16_t* rowp = O + (size_t)(row0 + ai * HALF + m * 16) * ldc + col0;
#pragma unroll
                for (int bj = 0; bj < 2; ++bj) { const f32x4 v0 = acc[ai][bj][m][0], v1 = acc[ai][bj][m][1];
                    u32x4 w; w.x = pk_bf16(v0[0], v0[1]); w.y = pk_bf16(v0[2], v0[3]); w.z = pk_bf16(v1[0], v1[1]); w.w = pk_bf16(v1[2], v1[3]);
                    *(u32x4*)(rowp + bj * HALF) = w; } }
    }
};
struct EpiInProj {
    static constexpr bool PERM = true; static constexpr int NST = 16;
    bf16_t* Ohq; bf16_t* Ovt;
    __device__ __forceinline__ void operator()(const f32x4 (&acc)[2][2][4][2], const Unit& u, int wr, int wc, int fr, int fq) const {
        bf16_t* O = u.e ? Ovt : Ohq; const int ldc = u.e ? T : HQP;
        const int row0 = u.row0 + wr * 64 + fr, col0 = u.col0 + wc * 32 + 8 * fq;
#pragma unroll
        for (int ai = 0; ai < 2; ++ai)
#pragma unroll
            for (int m = 0; m < 4; ++m) { bf16_t* rowp = O + (size_t)(row0 + ai * HALF + m * 16) * ldc + col0;
#pragma unroll
                for (int bj = 0; bj < 2; ++bj) { const f32x4 v0 = acc[ai][bj][m][0], v1 = acc[ai][bj][m][1];
                    u32x4 w; w.x = pk_bf16(v0[0], v0[1]); w.y = pk_bf16(v0[2], v0[3]); w.z = pk_bf16(v1[0], v1[1]); w.w = pk_bf16(v1[2], v1[3]);
                    *(u32x4*)(rowp + bj * HALF) = w; } }
    }
};
struct EpiResBf16 {
    static constexpr bool PERM = true; static constexpr int NST = 16;
    bf16_t* O; const bf16_t* R;
    __device__ __forceinline__ void operator()(const f32x4 (&acc)[2][2][4][2], const Unit& u, int wr, int wc, int fr, int fq) const {
        const int row0 = u.row0 + wr * 64 + fr, col0 = u.col0 + wc * 32 + 8 * fq;
        u32x4 rr[2][4][2];
#pragma unroll
        for (int ai = 0; ai < 2; ++ai)
#pragma unroll
            for (int m = 0; m < 4; ++m)
#pragma unroll
                for (int bj = 0; bj < 2; ++bj) rr[ai][m][bj] = __builtin_nontemporal_load((const u32x4*)(R + (size_t)(row0 + ai * HALF + m * 16) * 1024 + col0 + bj * HALF));
#pragma unroll
        for (int ai = 0; ai < 2; ++ai)
#pragma unroll
            for (int m = 0; m < 4; ++m) { const size_t off = (size_t)(row0 + ai * HALF + m * 16) * 1024 + col0;
#pragma unroll
                for (int bj = 0; bj < 2; ++bj) { const u32x4 r = rr[ai][m][bj]; const f32x4 v0 = acc[ai][bj][m][0], v1 = acc[ai][bj][m][1];
                    u32x4 w; w.x = pk_bf16(bf_lo(r[0]) * ALPHA + v0[0], bf_hi(r[0]) * ALPHA + v0[1]); w.y = pk_bf16(bf_lo(r[1]) * ALPHA + v0[2], bf_hi(r[1]) * ALPHA + v0[3]);
                    w.z = pk_bf16(bf_lo(r[2]) * ALPHA + v1[0], bf_hi(r[2]) * ALPHA + v1[1]); w.w = pk_bf16(bf_lo(r[3]) * ALPHA + v1[2], bf_hi(r[3]) * ALPHA + v1[3]);
                    *(u32x4*)(O + off + bj * HALF) = w; } }
    }
};
template <bool F8> struct EpiSwiglu {
    static constexpr bool PERM = true; static constexpr int NST = F8 ? 8 : 8;
    void* Ov; const float* bias; float ascale;
    __device__ __forceinline__ void operator()(const f32x4 (&acc)[2][2][4][2], const Unit& u, int wr, int wc, int fr, int fq) const {
        const int row0 = u.row0 + wr * 64 + fr, oc = (u.col0 >> 1) + wc * 32 + 8 * fq;
        const float* bp = bias + (size_t)u.e * 2048 + oc;
        f32x4 bg[2], bu[2];
#pragma unroll
        for (int n = 0; n < 2; ++n) { bg[n] = *(const f32x4*)(bp + 4 * n); bu[n] = *(const f32x4*)(bp + 1024 + 4 * n); }
#pragma unroll
        for (int ai = 0; ai < 2; ++ai)
#pragma unroll
            for (int m = 0; m < 4; ++m) {
                float o[8];
#pragma unroll
                for (int n = 0; n < 2; ++n) { const f32x4 g4 = acc[ai][0][m][n] * ascale + bg[n], u4 = acc[ai][1][m][n] * ascale + bu[n];
#pragma unroll
                    for (int j = 0; j < 4; ++j) { const float g = fminf(g4[j], 7.0f), up = __builtin_amdgcn_fmed3f(u4[j], -7.0f, 7.0f);
                        constexpr float OS = F8 ? A8_SCALE : 1.0f;
                        const float e = __builtin_amdgcn_exp2f(-1.702f * LOG2E * g), glu = g * __builtin_amdgcn_rcpf(__builtin_fmaf(e, 1.0f / OS, 1.0f / OS)); o[4 * n + j] = __builtin_fmaf(up, glu, glu); } }
                if constexpr (F8) {
                    int w0 = 0, w1 = 0; w0 = __builtin_amdgcn_cvt_pk_fp8_f32(o[0], o[1], w0, false); w0 = __builtin_amdgcn_cvt_pk_fp8_f32(o[2], o[3], w0, true);
                    w1 = __builtin_amdgcn_cvt_pk_fp8_f32(o[4], o[5], w1, false); w1 = __builtin_amdgcn_cvt_pk_fp8_f32(o[6], o[7], w1, true);
                    *(u32x2*)((unsigned char*)Ov + (size_t)(row0 + ai * HALF + m * 16) * 1024 + oc) = (u32x2){(unsigned)w0, (unsigned)w1}; }
                else { u32x4 w; w.x = pk_bf16(o[0], o[1]); w.y = pk_bf16(o[2], o[3]); w.z = pk_bf16(o[4], o[5]); w.w = pk_bf16(o[6], o[7]);
                    *(u32x4*)((bf16_t*)Ov + (size_t)(row0 + ai * HALF + m * 16) * 1024 + oc) = w; } }
    }
};
struct EpiBiasBf16 {
    static constexpr bool PERM = true; static constexpr int NST = 16;
    bf16_t* O; const float* bias; float ascale;
    __device__ __forceinline__ void operator()(const f32x4 (&acc)[2][2][4][2], const Unit& u, int wr, int wc, int fr, int fq) const {
        const int row0 = u.row0 + wr * 64 + fr, col0 = u.col0 + wc * 32 + 8 * fq;
        const float* bp = bias + (size_t)u.e * 1024 + col0;
        f32x4 bv[2][2];
#pragma unroll
        for (int bj = 0; bj < 2; ++bj)
#pragma unroll
            for (int n = 0; n < 2; ++n) bv[bj][n] = *(const f32x4*)(bp + bj * HALF + 4 * n);
#pragma unroll
        for (int ai = 0; ai < 2; ++ai)
#pragma unroll
            for (int m = 0; m < 4; ++m) { bf16_t* rowp = O + (size_t)(row0 + ai * HALF + m * 16) * 1024 + col0;
#pragma unroll
                for (int bj = 0; bj < 2; ++bj) { const f32x4 v0 = acc[ai][bj][m][0] * ascale + bv[bj][0], v1 = acc[ai][bj][m][1] * ascale + bv[bj][1];
                    u32x4 w; w.x = pk_bf16(v0[0], v0[1]); w.y = pk_bf16(v0[2], v0[3]); w.z = pk_bf16(v1[0], v1[1]); w.w = pk_bf16(v1[2], v1[3]);
                    *(u32x4*)(rowp + bj * HALF) = w; } }
    }
};
}


#ifndef ATT_EN
#define ATT_EN 7
#endif
#ifndef PROBE
#define PROBE (-1)
#endif
#define PREP(k) _Pragma("unroll 1") for (int _rp = ((PROBE == (k)) ? 0 : 1); _rp < 2; ++_rp)
typedef float f32x16 __attribute__((ext_vector_type(16)));
#define MFMA32(a, b, c) __builtin_amdgcn_mfma_f32_32x32x16_f16((a), (b), (c), 0, 0, 0)
constexpr float ATT_THR = 8.0f;
constexpr int ATT_KB = 8192;
#define NEG_INF_F (-__builtin_huge_valf())

template <int MODE>
__device__ __forceinline__ void attn_unit(LAS unsigned char* lds, const bf16_t* HQ, const bf16_t* VT, bf16_t* MIX, const unsigned long long* MASK, float* OA1,
                                          const int b, const int h, const int qt, const int wave_in, const int lane_unused,
                                          const float lam, const float lam_init, const float* subg, const float* relb) {
    int wave = wave_in; asm volatile("" : "+s"(wave));
    constexpr int NPASS = (MODE == 0) ? 2 : 1;
    constexpr int EB = (MODE == 0) ? 4 : 2;
    constexpr int NLV = EB / 2;
    constexpr int SLOTB = ATT_KB + EB * 32 * 128;
    constexpr int XOFF = 3 * SLOTB;
    const int qoff = (MODE == 0) ? HQ_QA + h * 128 : (MODE == 1) ? HQ_QB + h * 64 : HQ_QC + h * 64;
    const int koff = (MODE == 0) ? HQ_KA + h * 128 : (MODE == 1) ? HQ_KB + h * 64 : HQ_KC + h * 64;
    const int vrow0 = (MODE == 0) ? VT_A + h * 128 : (MODE == 1) ? VT_B + h * 64 : VT_C + h * 64;
    const int mixcol = (MODE == 0) ? h * 128 : (MODE == 1) ? 512 + h * 64 : 768 + h * 64;
    int lane; asm volatile("v_mbcnt_lo_u32_b32 %0, -1, 0\n\tv_mbcnt_hi_u32_b32 %0, -1, %0" : "=&v"(lane));
    const int tid = wave * 64 + lane, ql = lane & 31, hb = lane >> 5;
    const int cq = qt * 4 + (wave >> 1);
    const int tq = qt * 256 + wave * 32 + ql;
    const int kt_hi = qt * 4 + 3;
    const int kt_lo = (MODE == 1) ? ((qt * 4 - 8) > 0 ? (qt * 4 - 8) : 0) : 0;
    const int ntile = kt_hi - kt_lo + 1;
    const float slope2 = (MODE == 0) ? exp2f(-(float)(2 * h + 1)) * LOG2E : exp2f(-(float)(2 * h + 2)) * LOG2E;
    LAS float* relb_l = (LAS float*)(lds + XOFF);
    float so[16];
#pragma unroll
    for (int i = 0; i < 16; ++i) { int oi = 16 * (i >> 3) + (i & 7); asm volatile("" : "+s"(oi));
        so[i] = __int_as_float(__builtin_amdgcn_readfirstlane(__float_as_int(slope2 * (float)oi))); }
    const int prow = (ql & 16) | ((ql & 4) << 1) | ((ql & 8) >> 1) | (ql & 3);
    const int kt_x = (hb ^ ((prow >> 1) & 7)) << 4, vt_x = (hb ^ ((ql >> 1) & 7)) << 4;
    const int krd = prow * 128, vrd = ATT_KB + ql * 128;
    const int drow = lane >> 3, dpos = lane & 7;
    const int krow_g = 8 * wave + drow;
    const size_t ksrc = ((size_t)(b * SEQ + krow_g) * HQP + koff + ((dpos ^ ((krow_g >> 1) & 7)) << 3)) * 2;
    size_t vsrc[NLV];
#pragma unroll
    for (int j = 0; j < NLV; ++j) { const int vr = 8 * (wave + 8 * j) + drow; vsrc[j] = ((size_t)(vrow0 + vr) * T + (size_t)b * SEQ + ((dpos ^ ((vr >> 1) & 7)) << 3)) * 2; }

#pragma unroll 1
    for (int mp = 0; mp < NPASS; ++mp) {
#define ATT_ISSUE(kt_, slot_) do { \
        __builtin_amdgcn_global_load_lds((const unsigned*)((const char*)HQ + ksrc + (size_t)(kt_) * (64 * HQP * 2) + mp * 128), (LAS unsigned*)(lds + (slot_) * SLOTB + wave * 1024), 16, 0, 0); \
        _Pragma("unroll") for (int j = 0; j < NLV; ++j) \
            __builtin_amdgcn_global_load_lds((const unsigned*)((const char*)VT + vsrc[j] + (size_t)(kt_) * 128), (LAS unsigned*)(lds + (slot_) * SLOTB + ATT_KB + (wave + 8 * j) * 1024), 16, 0, 0); } while (0)
        asm volatile("s_waitcnt vmcnt(0)" ::: "memory");
        __syncthreads();
        ATT_ISSUE(kt_hi, 0);
        ATT_ISSUE((ntile > 1 ? kt_hi - 1 : kt_hi), 1);
        if (MODE == 1 && mp == 0) { for (int i = tid; i < 320; i += 512) relb_l[i] = relb[i < 256 ? i : 256] * LOG2E; }
        if (MODE == 2) {
#pragma unroll
            for (int i = 0; i < 8; ++i) { const int q = wave * 32 + i * 4 + (lane >> 4), p = lane & 15;
                __builtin_amdgcn_global_load_lds((const unsigned*)((const char*)MASK + ((size_t)(b * SEQ + qt * 256 + q) * 32 + (((p - q) & 15) << 1)) * 8),
                                                 (LAS unsigned*)(lds + XOFF + (wave * 32 + i * 4) * 256), 16, 0, 0); }
        }
        bf16x8 Q[4];
        { const bf16_t* qp = HQ + (size_t)(b * SEQ + tq) * HQP + qoff + mp * 64 + hb * 8;
#pragma unroll
          for (int ks = 0; ks < 4; ++ks) Q[ks] = *(const bf16x8*)(qp + ks * 16); }
        asm volatile("" : "+v"(Q[0]), "+v"(Q[1]), "+v"(Q[2]), "+v"(Q[3]));
        f32x16 O[EB];
        float mref = 0.f, seen = 0.f, lrun = 0.f;
#pragma unroll
        for (int eb = 0; eb < EB; ++eb)
#pragma unroll
            for (int i = 0; i < 16; ++i) O[eb][i] = 0.f;
        asm volatile("s_waitcnt lgkmcnt(0)" ::: "memory");
        int slot = 0;
        for (int jt = 0; jt < ntile; ++jt) {
            const int kt = kt_hi - jt;
            if constexpr (MODE == 0) asm volatile("s_waitcnt vmcnt(3)" ::: "memory"); else asm volatile("s_waitcnt vmcnt(2)" ::: "memory");
            __builtin_amdgcn_s_barrier();
            { const int nj = jt + 2 < ntile ? jt + 2 : ntile - 1; int ns = slot + 2; ns = ns >= 3 ? ns - 3 : ns; ATT_ISSUE(kt_hi - nj, ns); }
            const bool active = (kt <= cq) && (MODE != 1 || kt >= cq - 8);
            if (active) {
                const LAS unsigned char* kbp = lds + slot * SLOTB + krd;
                const LAS unsigned char* vbp = lds + slot * SLOTB + vrd;
                f32x16 S0, S1;
                if (MODE == 0 || MODE == 2) {
                    const float base0 = (float)(tq - kt * 64 - 8 * hb);
                    if (kt == cq) {
#pragma unroll
                        for (int i = 0; i < 16; ++i) { const float off = (float)(16 * (i >> 3) + (i & 7));
                            S0[i] = -slope2 * fabsf(base0 - off) - mref; S1[i] = -slope2 * fabsf(base0 - 32.0f - off) - mref; }
                    } else {
                        const float c0 = -slope2 * base0 - mref, c1 = c0 + 32.0f * slope2;
#pragma unroll
                        for (int i = 0; i < 16; ++i) { S0[i] = so[i] + c0; S1[i] = so[i] + c1; }
                    }
                }
                if (MODE == 2) {
                    const int mq = wave * 32 + ql; const unsigned long long W = *(const LAS unsigned long long*)(lds + XOFF + mq * 256 + ((((kt >> 1) + mq) & 15) << 4) + ((kt & 1) << 3));
                    const unsigned w0 = (unsigned)W >> (8 * hb), w1 = (unsigned)(W >> 32) >> (8 * hb);
#pragma unroll
                    for (int i = 0; i < 16; ++i) { const int off = 16 * (i >> 3) + (i & 7);
                        const int m0 = __builtin_amdgcn_sbfe((int)w0, off, 1), m1 = __builtin_amdgcn_sbfe((int)w1, off, 1);
                        S0[i] = __int_as_float((__float_as_int(S0[i]) & m0) | ((int)0xFF800000 & ~m0)); S1[i] = __int_as_float((__float_as_int(S1[i]) & m1) | ((int)0xFF800000 & ~m1)); }
                }
                if (MODE == 1) {
                    if (kt >= cq - 2) {
                        const int rel0 = tq - kt * 64 - 8 * hb + 128;
#pragma unroll
                        for (int i = 0; i < 16; ++i) { const int off = 16 * (i >> 3) + (i & 7);
                            S0[i] = relb_l[rel0 - off] - mref; S1[i] = relb_l[rel0 - 32 - off] - mref; }
                    } else {
                        const float far = relb_l[256] - mref;
#pragma unroll
                        for (int i = 0; i < 16; ++i) { S0[i] = far; S1[i] = far; }
                    }
                }
                bf16x8 kf[8], vf0[8];
#pragma unroll
                for (int ks = 0; ks < 4; ++ks) { kf[2 * ks] = *(const LAS bf16x8*)(kbp + ((ks << 5) ^ kt_x)); kf[2 * ks + 1] = *(const LAS bf16x8*)(kbp + 4096 + ((ks << 5) ^ kt_x)); }
#pragma unroll
                for (int i = 0; i < 8; ++i) { const int s4i = i / EB, eb = i % EB; vf0[i] = *(const LAS bf16x8*)(vbp + eb * 4096 + ((s4i << 5) ^ vt_x)); }
#pragma unroll
                for (int ks = 0; ks < 4; ++ks) { S0 = MFMA32(kf[2 * ks], Q[ks], S0); S1 = MFMA32(kf[2 * ks + 1], Q[ks], S1); }
                __builtin_amdgcn_sched_group_barrier(0x100, 16, 0); __builtin_amdgcn_sched_group_barrier(0x008, 8, 0);
                float mx; asm("s_nop 15\n\ts_nop 3\n\tv_max3_f32 %0, %1, %2, %3" : "=v"(mx) : "v"(S0[0]), "v"(S1[0]), "v"(S0[1]));
                asm("v_max3_f32 %0, %1, %2, %3" : "=v"(mx) : "v"(mx), "v"(S1[1]), "v"(S0[2]));
#pragma unroll
                for (int i = 2; i < 15; ++i) asm("v_max3_f32 %0, %1, %2, %3" : "=v"(mx) : "v"(mx), "v"(S1[i]), "v"(S0[i + 1]));
                asm("v_max_f32 %0, %1, %2" : "=v"(mx) : "v"(mx), "v"(S1[15]));
                mx = fmaxf(mx, shx(mx, 32, lane));
                const bool unseen = !(seen > 0.f), finite = mx > -1e30f;
                const bool need = unseen ? finite : (mx > ATT_THR);
                if (__ballot(unseen ? finite : (mx >= -36.0f)) != 0ull) {
                    if (__ballot(need) != 0ull) {
                        const float d = need ? mx : 0.f;
                        mref += d; seen = (unseen && finite) ? 1.f : seen;
                        const float alpha = unseen ? 1.0f : __builtin_amdgcn_exp2f(-d);
                        lrun *= alpha;
#pragma unroll
                        for (int eb = 0; eb < EB; ++eb) O[eb] = O[eb] * alpha;
#pragma unroll
                        for (int i = 0; i < 16; ++i) { S0[i] -= d; S1[i] -= d; }
                    }
                    float ps = 0.f;
#pragma unroll
                    for (int i = 0; i < 16; ++i) { S0[i] = __builtin_amdgcn_exp2f(S0[i]); S1[i] = __builtin_amdgcn_exp2f(S1[i]); ps += S0[i] + S1[i]; }
                    lrun += ps;
                    bf16x8 P[4];
                    { u32x4 p;
                      p.x = pk_bf16(S0[0], S0[1]); p.y = pk_bf16(S0[2], S0[3]); p.z = pk_bf16(S0[4], S0[5]); p.w = pk_bf16(S0[6], S0[7]); P[0] = __builtin_bit_cast(bf16x8, p);
                      p.x = pk_bf16(S0[8], S0[9]); p.y = pk_bf16(S0[10], S0[11]); p.z = pk_bf16(S0[12], S0[13]); p.w = pk_bf16(S0[14], S0[15]); P[1] = __builtin_bit_cast(bf16x8, p);
                      p.x = pk_bf16(S1[0], S1[1]); p.y = pk_bf16(S1[2], S1[3]); p.z = pk_bf16(S1[4], S1[5]); p.w = pk_bf16(S1[6], S1[7]); P[2] = __builtin_bit_cast(bf16x8, p);
                      p.x = pk_bf16(S1[8], S1[9]); p.y = pk_bf16(S1[10], S1[11]); p.z = pk_bf16(S1[12], S1[13]); p.w = pk_bf16(S1[14], S1[15]); P[3] = __builtin_bit_cast(bf16x8, p); }
                    if constexpr (EB == 4) {
                        bf16x8 vf1[8];
#pragma unroll
                        for (int i = 0; i < 8; ++i) { const int s4i = 2 + i / EB, eb = i % EB; vf1[i] = *(const LAS bf16x8*)(vbp + eb * 4096 + ((s4i << 5) ^ vt_x)); }
#pragma unroll
                        for (int i = 0; i < 8; ++i) { const int s4i = i / EB, eb = i % EB; O[eb] = MFMA32(vf0[i], P[s4i], O[eb]); }
#pragma unroll
                        for (int i = 0; i < 8; ++i) { const int s4i = 2 + i / EB, eb = i % EB; O[eb] = MFMA32(vf1[i], P[s4i], O[eb]); }
                        __builtin_amdgcn_sched_group_barrier(0x100, 8, 0); __builtin_amdgcn_sched_group_barrier(0x008, 16, 0);
                    } else {
#pragma unroll
                        for (int i = 0; i < 8; ++i) { const int s4i = i / EB, eb = i % EB; O[eb] = MFMA32(vf0[i], P[s4i], O[eb]); }
                    }
                }
            }
            slot = slot == 2 ? 0 : slot + 1;
        }
#undef ATT_ISSUE
        const float inv = 1.0f / (lrun + shx(lrun, 32, lane));
        bf16_t* op = MIX + (size_t)(b * SEQ + tq) * 1024 + mixcol + 4 * hb;
        if (MODE == 0) {
            bf16_t* o1p = (bf16_t*)OA1 + (size_t)(b * SEQ + tq) * 512 + h * 128 + 4 * hb;
            if (mp == 0) {
#pragma unroll
                for (int eb = 0; eb < EB; ++eb)
#pragma unroll
                    for (int g = 0; g < 4; ++g) *(u32x2*)(o1p + eb * 32 + 8 * g) = (u32x2){pk_bf16(O[eb][4 * g] * inv, O[eb][4 * g + 1] * inv), pk_bf16(O[eb][4 * g + 2] * inv, O[eb][4 * g + 3] * inv)};
            } else {
                const float c2 = lam * inv;
                float ss = 0.f;
#pragma unroll
                for (int eb = 0; eb < EB; ++eb)
#pragma unroll
                    for (int g = 0; g < 4; ++g) { const u32x2 o1h = *(const u32x2*)(o1p + eb * 32 + 8 * g); const f32x4 o1 = {bf_lo(o1h[0]), bf_hi(o1h[0]), bf_lo(o1h[1]), bf_hi(o1h[1])};
#pragma unroll
                        for (int j = 0; j < 4; ++j) { const float o = o1[j] - O[eb][4 * g + j] * c2; O[eb][4 * g + j] = o; ss += o * o; } }
                ss += shx(ss, 32, lane);
                const float r = rsqrtf(ss * (1.0f / 128.0f) + EPS) * (1.0f - lam_init);
#pragma unroll
                for (int eb = 0; eb < EB; ++eb)
#pragma unroll
                    for (int g = 0; g < 4; ++g) { const int e0 = eb * 32 + 8 * g;
                        *(u32x2*)(op + e0) = (u32x2){pk_bf16(O[eb][4 * g] * r, O[eb][4 * g + 1] * r), pk_bf16(O[eb][4 * g + 2] * r, O[eb][4 * g + 3] * r)}; }
            }
        } else {
#pragma unroll
            for (int eb = 0; eb < EB; ++eb)
#pragma unroll
                for (int g = 0; g < 4; ++g) { const int e0 = eb * 32 + 8 * g;
                    *(u32x2*)(op + e0) = (u32x2){pk_bf16(O[eb][4 * g] * inv, O[eb][4 * g + 1] * inv), pk_bf16(O[eb][4 * g + 2] * inv, O[eb][4 * g + 3] * inv)}; }
        }
    }
}


constexpr int IDX_STR = 2052;
__device__ __forceinline__ unsigned f2key(float f) { const unsigned u = __float_as_uint(f); return u ^ (((unsigned)((int)u >> 31)) | 0x80000000u); }
template <int J>
__device__ __forceinline__ void index_select(const LAS float* row, const int nb, const int lane, unsigned long long* mo) {
    unsigned u[J];
#pragma unroll
    for (int j = 0; j < J; ++j) u[j] = (j < nb) ? f2key(row[64 * j]) : 0u;
    unsigned prefix = 0u; bool exact = false;
#pragma unroll 1
    for (int bit = 31; bit >= 0; --bit) {
        const unsigned cand = prefix | (1u << bit);
        int c = 0;
#pragma unroll
        for (int j0 = 0; j0 < J; j0 += 8) {
            unsigned long long bm[8];
#pragma unroll
            for (int j = 0; j < 8; ++j) bm[j] = __ballot(u[j0 + j] >= cand);
            asm volatile("" : "+s"(bm[0]), "+s"(bm[1]), "+s"(bm[2]), "+s"(bm[3]), "+s"(bm[4]), "+s"(bm[5]), "+s"(bm[6]), "+s"(bm[7]));
#pragma unroll
            for (int j = 0; j < 8; ++j) c += (int)__builtin_popcountll(bm[j]);
        }
        if (c >= 256) prefix = cand;
        if (c == 256) { exact = true; break; }
    }
    unsigned thr = prefix; asm volatile("" : "+v"(thr));
    unsigned long long myword = 0ull;
    if (exact) {
#pragma unroll
        for (int j = 0; j < J; ++j) { const unsigned long long m = __ballot(u[j] >= thr); myword = (lane == j) ? m : myword; }
    } else {
        int cg = 0;
#pragma unroll
        for (int j = 0; j < J; ++j) cg += (int)__builtin_popcountll(__ballot(u[j] > thr));
        const int quota = 256 - cg;
        int taken = 0;
#pragma unroll
        for (int j = 0; j < J; ++j) {
            const bool eq = (u[j] == thr);
            const unsigned long long eqm = __ballot(eq);
            const int before = (int)__builtin_popcountll(eqm & ((1ull << lane) - 1ull));
            const unsigned long long m = __ballot((u[j] > thr) || (eq && (taken + before < quota)));
            taken += (int)__builtin_popcountll(eqm);
            myword = (lane == j) ? m : myword;
        }
    }
    if (lane < 32) mo[lane] = myword;
}
__device__ __forceinline__ void index_unit(LAS unsigned char* lds, const bf16_t* HQ, unsigned long long* MASK, const int b, const int tt, const int wave_in) {
    int wave = wave_in; asm volatile("" : "+s"(wave));
    int lane; asm volatile("v_mbcnt_lo_u32_b32 %0, -1, 0\n\tv_mbcnt_hi_u32_b32 %0, -1, %0" : "=&v"(lane));
    const int t0 = tt * 16, nb = (t0 >> 6) + 1, nk = nb * 64;
    if (nb <= 4) {
        for (int i = wave * 64 + lane; i < 16 * 32; i += 512) MASK[(size_t)(b * SEQ + t0 + (i >> 5)) * 32 + (i & 31)] = ((i & 31) < nb) ? ~0ull : 0ull;
        return;
    }
    LAS float* sc = (LAS float*)lds;
    const int q = lane & 15, g = lane >> 4;
    {
        const bf16_t* qrow = HQ + (size_t)(b * SEQ + t0 + q) * HQP;
        bf16x8 QI[8];
#pragma unroll
        for (int h = 0; h < 8; ++h) QI[h] = *(const bf16x8*)(qrow + HQ_QI + h * 32 + g * 8);
        float w[8];
        { const u32x4 wv = *(const u32x4*)(qrow + HQ_WI);
          w[0] = bf_lo(wv[0]) * 0.0625f; w[1] = bf_hi(wv[0]) * 0.0625f; w[2] = bf_lo(wv[1]) * 0.0625f; w[3] = bf_hi(wv[1]) * 0.0625f;
          w[4] = bf_lo(wv[2]) * 0.0625f; w[5] = bf_hi(wv[2]) * 0.0625f; w[6] = bf_lo(wv[3]) * 0.0625f; w[7] = bf_hi(wv[3]) * 0.0625f; }
        const bf16_t* kbase = HQ + (size_t)(b * SEQ + q) * HQP + HQ_KI + g * 8;
        for (int kb0 = wave; kb0 < nk / 16; kb0 += 32) {
            bf16x8 kf[4];
#pragma unroll
            for (int u = 0; u < 4; ++u) { const int kb = kb0 + 8 * u; kf[u] = (kb < nk / 16) ? *(const bf16x8*)(kbase + (size_t)kb * 16 * HQP) : (bf16x8){0, 0, 0, 0, 0, 0, 0, 0}; }
#pragma unroll
            for (int u = 0; u < 4; ++u) {
                const int kb = kb0 + 8 * u;
                if (kb < nk / 16) {
                    f32x4 acc = {0.f, 0.f, 0.f, 0.f};
#pragma unroll
                    for (int h = 0; h < 8; ++h) {
                        const f32x4 z = __builtin_amdgcn_mfma_f32_16x16x32_f16(kf[u], QI[h], (f32x4){0.f, 0.f, 0.f, 0.f}, 0, 0, 0);
#pragma unroll
                        for (int j = 0; j < 4; ++j) acc[j] = fmaf(w[h], fmaxf(z[j], 0.f), acc[j]);
                    }
#pragma unroll
                    for (int j = 0; j < 4; ++j) acc[j] += 0.0f;
                    *(LAS f32x4*)(sc + q * IDX_STR + kb * 16 + g * 4) = acc;
                }
            }
        }
    }
    __syncthreads();
#pragma unroll 1
    for (int qq = 0; qq < 2; ++qq) {
        const int ql = wave * 2 + qq;
        const LAS float* row = sc + ql * IDX_STR + lane;
        unsigned long long* mo = MASK + (size_t)(b * SEQ + t0 + ql) * 32;
        if (nb <= 8) index_select<8>(row, nb, lane, mo);
        else if (nb <= 16) index_select<16>(row, nb, lane, mo);
        else if (nb <= 24) index_select<24>(row, nb, lane, mo);
        else index_select<32>(row, nb, lane, mo);
    }
    __syncthreads();
}

struct Args {
    const float* x; const float* w_in; const float* lam_q1; const float* lam_k1; const float* lam_q2; const float* lam_k2; const float* subln_g; const float* rel_bias;
    const float* w_out; const float* ln1_g; const float* ln1_b; const float* w_router; const float* b_router; const float* w_gu; const float* b_gu;
    const float* w_down; const float* b_down; const float* ln2_g; const float* ln2_b;
    float* out; unsigned char* ws;
    int ph_lo, ph_hi, bar_region, pad;
};

constexpr int LDS_STAGE = 0;
constexpr int LDS_CTL = 135168;
constexpr int LDS_TSTART = LDS_CTL + 64;
constexpr int LDS_CNT = LDS_TSTART + 36 * 4;
constexpr int LDS_TILEE = LDS_CNT + 32 * 4;
constexpr int LDS_RT = LDS_TILEE + 576;
constexpr int LDS_GB = 147456;
constexpr int LDS_BYTES = 147456 + 8192;
static_assert(LDS_RT + (64 + 1024) * 4 <= LDS_BYTES && 16 * IDX_STR * 4 <= LDS_CTL, "LDS map");

__device__ __forceinline__ void transpose_item(const float* W, int N, int k0, int n0, int nvalid, bf16_t* WTrow0, float scale, LAS float* scr, int lane, const float* kgain = nullptr) {
#pragma unroll
    for (int i = 0; i < 32; ++i) { const int kk = 2 * i + (lane >> 5), col = lane & 31; scr[kk * 33 + col] = (col < nvalid) ? W[(size_t)(k0 + kk) * N + n0 + col] * (kgain ? scale * kgain[kk] : scale) : 0.f; }
    asm volatile("s_waitcnt lgkmcnt(0)" ::: "memory");
    const int c = lane & 7;
#pragma unroll
    for (int j = 0; j < 4; ++j) { const int n = (lane >> 3) + 8 * j; const LAS float* s = scr + (8 * c) * 33 + n;
        u32x4 o; o.x = pk_bf16(s[0 * 33], s[1 * 33]); o.y = pk_bf16(s[2 * 33], s[3 * 33]); o.z = pk_bf16(s[4 * 33], s[5 * 33]); o.w = pk_bf16(s[6 * 33], s[7 * 33]);
        if (n < nvalid) *(u32x4*)(WTrow0 + (size_t)n * 1024 + k0 + 8 * c) = o; }
    asm volatile("s_waitcnt lgkmcnt(0)" ::: "memory");
}
__device__ __forceinline__ void transpose_item_fp8(const float* W, int N, int k0, int n0, unsigned char* WTrow0, float scale, int lane) {
    const int rg = lane >> 4, cg = lane & 15;
    const float* src = W + (size_t)(k0 + 32 * rg) * N + n0 + 4 * cg;
    f32x4 v[32];
#pragma unroll
    for (int i = 0; i < 32; ++i) v[i] = __builtin_nontemporal_load((const f32x4*)(src + (size_t)i * N));
    unsigned char* dst = WTrow0 + (size_t)(4 * cg) * 1024 + k0 + 32 * rg;
#pragma unroll
    for (int j = 0; j < 4; ++j) {
#pragma unroll
        for (int h = 0; h < 2; ++h) {
            u32x4 o;
            o.x = pk4_fp8(v[16 * h + 0][j] * scale, v[16 * h + 1][j] * scale, v[16 * h + 2][j] * scale, v[16 * h + 3][j] * scale);
            o.y = pk4_fp8(v[16 * h + 4][j] * scale, v[16 * h + 5][j] * scale, v[16 * h + 6][j] * scale, v[16 * h + 7][j] * scale);
            o.z = pk4_fp8(v[16 * h + 8][j] * scale, v[16 * h + 9][j] * scale, v[16 * h + 10][j] * scale, v[16 * h + 11][j] * scale);
            o.w = pk4_fp8(v[16 * h + 12][j] * scale, v[16 * h + 13][j] * scale, v[16 * h + 14][j] * scale, v[16 * h + 15][j] * scale);
            *(u32x4*)(dst + (size_t)j * 1024 + 16 * h) = o;
        }
    }
}
__device__ __forceinline__ void in_map(int n0, bool& isv, int& row, float& scale) {
    scale = 1.f; isv = false;
    if (n0 < 512) { row = HQ_QA + n0; scale = QSCALE; }
    else if (n0 < 1024) row = HQ_KA + (n0 - 512);
    else if (n0 < 1536) { isv = true; row = VT_A + (n0 - 1024); }
    else if (n0 < 1792) { row = HQ_QB + (n0 - 1536); scale = QSCALE; }
    else if (n0 < 2048) row = HQ_KB + (n0 - 1792);
    else if (n0 < 2304) { isv = true; row = VT_B + (n0 - 2048); }
    else if (n0 < 2560) { row = HQ_QC + (n0 - 2304); scale = QSCALE; }
    else if (n0 < 2816) row = HQ_KC + (n0 - 2560);
    else if (n0 < 3072) { isv = true; row = VT_C + (n0 - 2816); }
    else if (n0 < 3328) row = HQ_QI + (n0 - 3072);
    else if (n0 < 3360) row = HQ_KI + (n0 - 3328);
    else row = HQ_WI + (n0 - 3360);
}

__global__ void __launch_bounds__(512, 2) mega(Args a) {
    extern __shared__ __attribute__((aligned(16))) unsigned char lds_raw[];
    LAS unsigned char* lds = (LAS unsigned char*)lds_raw;
    const int G = gridDim.x, bid = blockIdx.x, NGW = G * 8;
    const int wave0 = __builtin_amdgcn_readfirstlane((int)threadIdx.x >> 6);
#define OPAQUE_IDS() int wave = wave0; asm volatile("" : "+s"(wave)); int lane; asm volatile("v_mbcnt_lo_u32_b32 %0, -1, 0\n\tv_mbcnt_hi_u32_b32 %0, -1, %0" : "=&v"(lane)); const int tid = wave * 64 + lane, gw = bid * 8 + wave; (void)tid; (void)gw
#define WSPTRS() __attribute__((address_space(1))) unsigned char* wsg_ = (__attribute__((address_space(1))) unsigned char*)a.ws; asm volatile("" : "+s"(wsg_)); unsigned char* ws = (unsigned char*)wsg_;     \
    unsigned* ctl = (unsigned*)(ws + WS_CTL); bf16_t* Win = (bf16_t*)(ws + WS_WIN); bf16_t* Wv = (bf16_t*)(ws + WS_WV); bf16_t* Wout = (bf16_t*)(ws + WS_WOUT); \
    bf16_t* Wgu = (bf16_t*)(ws + WS_WGU); bf16_t* Wdn = (bf16_t*)(ws + WS_WDN); bf16_t* XB = (bf16_t*)(ws + WS_XB); \
    bf16_t* HQ = (bf16_t*)(ws + WS_HQ); bf16_t* VT = (bf16_t*)(ws + WS_VT); bf16_t* MIX = (bf16_t*)(ws + WS_MIX); \
    bf16_t* Y1B = (bf16_t*)(ws + WS_Y1); bf16_t* X1B = (bf16_t*)(ws + WS_X1B); bf16_t* ACT = (bf16_t*)(ws + WS_ACT); bf16_t* YR = (bf16_t*)(ws + WS_YR); \
    int* TOKL = (int*)(ws + WS_TOKL); int* ASGE = (int*)(ws + WS_ASGE); int* ASGS = (int*)(ws + WS_ASGS); float* GATE = (float*)(ws + WS_GATE); \
    (void)ctl; (void)Win; (void)Wv; (void)Wout; (void)Wgu; (void)Wdn; (void)XB; (void)HQ; (void)VT; (void)MIX; (void)Y1B; (void)X1B; (void)ACT; (void)YR; (void)TOKL; (void)ASGE; (void)ASGS; (void)GATE
    for (int u = threadIdx.x; u < (LDS_BYTES - LDS_CTL) / 4; u += 512) ((LAS unsigned*)(lds + LDS_CTL))[u] = 0u;
    __syncthreads();
    XcdBarrier bar = xcd_barrier_post((unsigned*)(a.ws + WS_CTL) + CW_BAR + a.bar_region * XCD_BAR_WORDS, (volatile LAS unsigned*)(lds + LDS_CTL));
    const int lo = a.ph_lo, hi = a.ph_hi;
#define IN(k) (lo <= (k) && (k) < hi)
#define SEAM(k) do { if (IN(k) && IN((k) + 1)) xcd_barrier(bar); } while (0)

    if (IN(0)) PREP(0) {
        OPAQUE_IDS(); WSPTRS();
        LAS float* scr = (LAS float*)(lds + LDS_STAGE + wave * 16384);
        #if MOE_FP8
        constexpr int I_IN = 16 * 106, I_OUT = 16 * 32, I_GU = 8 * 32, I_DN = 8 * 16;
#else
        constexpr int I_IN = 16 * 106, I_OUT = 16 * 32, I_GU = 16 * 64, I_DN = 16 * 32;
#endif
        constexpr int N_IN = DEPTH * I_IN, N_OUT = DEPTH * I_OUT, N_GU = DEPTH * NE * I_GU, N_DN = DEPTH * NE * I_DN;
        for (int it = gw; it < N_IN + N_OUT + N_GU + N_DN; it += NGW) {
            int r = it;
            if (r < N_IN) { const int l = r / I_IN, q = r % I_IN, kb = q / 106, nb = q % 106, n0 = nb * 32; bool isv; int row; float sc; in_map(n0, isv, row, sc);
                bf16_t* dst = isv ? Wv + ((size_t)l * 1024 + row) * 1024 : Win + ((size_t)l * HQP + row) * 1024;
                transpose_item(a.w_in + (size_t)l * D * DIN, DIN, kb * 64, n0, (DIN - n0) < 32 ? (DIN - n0) : 32, dst, sc, scr, lane); continue; }
            r -= N_IN;
            if (r < N_OUT) { const int l = r / I_OUT, q = r % I_OUT, kb = q / 32, nb = q % 32;
                transpose_item(a.w_out + (size_t)l * 1024 * D, D, kb * 64, nb * 32, 32, Wout + ((size_t)l * D + nb * 32) * 1024, 1.f, scr, lane, kb < 8 ? a.subln_g + l * 128 + ((kb * 64) & 127) : nullptr); continue; }
            r -= N_OUT;
#if MOE_FP8
            if (r < N_GU) { const int le = r / I_GU, q = r % I_GU, kb = q >> 5, nb = q & 31, n0 = nb * 64;
                const int bj = n0 >> 10, rr = n0 & 1023, pn = rr >> 7, c = rr & 127, nrow = pn * 256 + bj * 128 + c;
                transpose_item_fp8(a.w_gu + (size_t)le * D * 2048, 2048, kb * 128, n0, (unsigned char*)Wgu + ((size_t)le * 2048 + nrow) * 1024, W8_SCALE, lane); continue; }
#else
            if (r < N_GU) { const int le = r / I_GU, q = r % I_GU, kb = q / 64, nb = q % 64, n0 = nb * 32;
                const int bj = n0 >> 10, rr = n0 & 1023, pn = rr >> 7, c = rr & 127, nrow = pn * 256 + bj * 128 + c;
                transpose_item(a.w_gu + (size_t)le * D * 2048, 2048, kb * 64, n0, 32, Wgu + ((size_t)le * 2048 + nrow) * 1024, 1.f, scr, lane); continue; }
#endif
            r -= N_GU;
#if MOE_FP8
            { const int le = r / I_DN, q = r % I_DN, kb = q >> 4, nb = q & 15;
                transpose_item_fp8(a.w_down + (size_t)le * 1024 * D, D, kb * 128, nb * 64, (unsigned char*)Wdn + ((size_t)le * D + nb * 64) * 1024, W8_SCALE, lane); }
#else
            { const int le = r / I_DN, q = r % I_DN, kb = q / 32, nb = q % 32;
                transpose_item(a.w_down + (size_t)le * 1024 * D, D, kb * 64, nb * 32, 32, Wdn + ((size_t)le * D + nb * 32) * 1024, 1.f, scr, lane); }
#endif
        }
        for (int i = gw * 64 + lane; i < DEPTH * (HQP - HQ_USED) * 128; i += NGW * 64) { const int l = i / ((HQP - HQ_USED) * 128), q = i % ((HQP - HQ_USED) * 128);
            *(u32x4*)(Win + ((size_t)l * HQP + HQ_USED) * 1024 + (size_t)q * 8) = (u32x4){0u, 0u, 0u, 0u}; }
        { bf16_t* WRH = (bf16_t*)(ws + WS_WRT); bf16_t* WRL = WRH + (size_t)DEPTH * NE * D;
          for (int i = gw * 64 + lane; i < DEPTH * NE * D; i += NGW * 64) { const int ll = i / (NE * D), r = i % (NE * D), e = r / D, c = r % D; const float w = a.w_router[((size_t)ll * D + c) * NE + e];
              const unsigned h = pk_bf16(w, 0.f) & 0xffffu; WRH[i] = (bf16_t)h; WRL[i] = (bf16_t)(pk_bf16(w - bf_lo(h), 0.f) & 0xffffu); } }
        for (size_t i = (size_t)gw * 64 + lane; i < (size_t)T * D / 8; i += (size_t)NGW * 64) { const f32x4 v0 = *(const f32x4*)(a.x + i * 8), v1 = *(const f32x4*)(a.x + i * 8 + 4);
            u32x4 w; w.x = pk_bf16(v0[0], v0[1]); w.y = pk_bf16(v0[2], v0[3]); w.z = pk_bf16(v1[0], v1[1]); w.w = pk_bf16(v1[2], v1[3]); *(u32x4*)(XB + i * 8) = w; }
    }
    SEAM(0);

#pragma unroll 1
    for (int l = 0; l < DEPTH; ++l) {
        const int pb = 1 + 8 * l;
        if (IN(pb + 0)) PREP(1) {
            WSPTRS();
            pg8::InProjOrder S{G, bid, (const char*)(Win + (size_t)l * HQP * 1024), (const char*)(Wv + (size_t)l * 1024 * 1024), (const char*)XB};
            pg8::EpiInProj E{HQ, VT};
            pg8::gemm_phase<pg8::EpiInProj, pg8::InProjOrder, false>(lds + LDS_STAGE, XB, 1024, S, E, wave0);
        }
        SEAM(pb + 0);
        if (IN(pb + 1)) {
            OPAQUE_IDS(); WSPTRS();
            unsigned long long* MASKp = (unsigned long long*)(ws + WS_MASK); float* OA1p = (float*)(ws + WS_OA1);
            const float lam_init = 0.8f - 0.6f * expf(-0.3f * (float)l);
            const float lam = expf(wsum(a.lam_q1[l * 64 + lane] * a.lam_k1[l * 64 + lane], lane)) - expf(wsum(a.lam_q2[l * 64 + lane] * a.lam_k2[l * 64 + lane], lane)) + lam_init;
            const int v0 = (G % 8 == 0) ? (bid & 7) * (G >> 3) + (bid >> 3) : bid;
            for (int v = v0; v < 256; v += G) {
                const int b = v >> 4, h = (v >> 2) & 3, q0 = v & 3, j16 = v & 15;
                PREP(2)
#pragma unroll 1
                for (int k = 0; k < 8; ++k) index_unit(lds + LDS_STAGE, HQ, MASKp, b, 16 * k + ((k & 1) ? 15 - j16 : j16), wave);
                PREP(3)
#pragma unroll 1
                for (int rep = 0; rep < 2; ++rep) attn_unit<0>(lds + LDS_STAGE, HQ, VT, MIX, MASKp, OA1p, b, rep ? 3 - h : h, rep ? 7 - q0 : q0, wave, lane, lam, lam_init, a.subln_g + l * 128, nullptr);
                PREP(4)
#pragma unroll 1
                for (int rep = 0; rep < 2; ++rep) attn_unit<1>(lds + LDS_STAGE, HQ, VT, MIX, MASKp, OA1p, b, h, rep ? 7 - q0 : q0, wave, lane, 0.f, 0.f, nullptr, a.rel_bias + ((size_t)l * 4 + h) * 257);
            }
        }
        SEAM(pb + 1);
        if (IN(pb + 2)) {
            OPAQUE_IDS(); WSPTRS();
            unsigned long long* MASKp = (unsigned long long*)(ws + WS_MASK); float* OA1p = (float*)(ws + WS_OA1);
            const int v0 = (G % 8 == 0) ? (bid & 7) * (G >> 3) + (bid >> 3) : bid;
            for (int v = v0; v < 256; v += G) {
                const int b = v >> 4, h = (v >> 2) & 3, q0 = v & 3;
                PREP(5)
#pragma unroll 1
                for (int rep = 0; rep < 2; ++rep) attn_unit<2>(lds + LDS_STAGE, HQ, VT, MIX, MASKp, OA1p, b, rep ? 3 - h : h, rep ? 7 - q0 : q0, wave, lane, 0.f, 0.f, nullptr, nullptr);
            }
        }
        SEAM(pb + 2);
        if (IN(pb + 3)) PREP(6) {
            WSPTRS();
            pg8::DenseOrder S{T / 256, 4, G, bid, (const char*)(Wout + (size_t)l * 1024 * 1024), 1024, false};
            pg8::EpiResBf16 E{Y1B, XB};
            pg8::gemm_phase<pg8::EpiResBf16, pg8::DenseOrder, false>(lds + LDS_STAGE, MIX, 1024, S, E, wave0);
        }
        SEAM(pb + 3);
        if (IN(pb + 4)) PREP(10) {
            OPAQUE_IDS(); WSPTRS();
            if (PROBE == 10 && _rp == 0) { TOKL = (int*)(ws + WS_END); ASGE = TOKL + NE * T; ASGS = ASGE + NASG; GATE = (float*)(ASGS + NASG); }
            LAS int* lcnt = (LAS int*)(lds + LDS_RT); LAS int* lbase = lcnt + 32; LAS int* asg_e = lcnt + 64; LAS int* asg_ls = asg_e + 512;
            const float* g1 = a.ln1_g + l * D; const float* b1 = a.ln1_b + l * D; const float* br = a.b_router + l * NE;
            unsigned* gcnt = ctl + CW_CNT + l * 64 + ((PROBE == 10 && _rp == 0) ? 4096 : 0);
            { const u32x4* srch = (const u32x4*)(ws + WS_WRT) + (size_t)l * 4096; const u32x4* srcl = (const u32x4*)(ws + WS_WRT + (size_t)DEPTH * NE * D * 2) + (size_t)l * 4096;
              for (int i = tid; i < 4096; i += 512) { const int e = i >> 7, c = i & 127, dst = e * 2048 + ((c ^ (e & 15)) << 4);
                  *(LAS u32x4*)(lds + LDS_STAGE + dst) = srch[i]; *(LAS u32x4*)(lds + LDS_STAGE + 65536 + dst) = srcl[i]; } }
            LAS float* st = (LAS float*)(lds + 131072);
            LAS float* g1l = (LAS float*)(lds + LDS_GB); LAS float* b1l = g1l + 1024;
            for (int i = tid; i < 1024; i += 512) { g1l[i] = g1[i]; b1l[i] = b1[i]; }
            for (int unit = bid; unit < T / 128; unit += G) {
                if (tid < 32) lcnt[tid] = 0;
                __syncthreads();
#pragma unroll 1
                for (int k = 0; k < 8; ++k) {
                    const int tl0 = wave * 16 + 2 * k, t0 = unit * 128 + tl0;
                    float v[2][16];
#pragma unroll
                    for (int tk = 0; tk < 2; ++tk)
#pragma unroll
                        for (int i = 0; i < 4; ++i) { const u32x2 u2 = *(const u32x2*)(Y1B + (size_t)(t0 + tk) * D + i * 256 + lane * 4); v[tk][4 * i] = bf_lo(u2[0]); v[tk][4 * i + 1] = bf_hi(u2[0]); v[tk][4 * i + 2] = bf_lo(u2[1]); v[tk][4 * i + 3] = bf_hi(u2[1]); }
#pragma unroll
                    for (int tk = 0; tk < 2; ++tk) {
                        float s_ = 0.f;
#pragma unroll
                        for (int i = 0; i < 16; ++i) s_ += v[tk][i];
                        const float mean = wsum(s_, lane) * (1.0f / 1024.0f);
                        float qv = 0.f;
#pragma unroll
                        for (int i = 0; i < 16; ++i) { const float d = v[tk][i] - mean; qv += d * d; }
                        const float rstd = rsqrtf(wsum(qv, lane) * (1.0f / 1024.0f) + EPS);
                        if (lane == 0) { st[(tl0 + tk) * 2] = mean; st[(tl0 + tk) * 2 + 1] = rstd; }
                    }
                }
                asm volatile("s_waitcnt lgkmcnt(0)" ::: "memory");
                __builtin_amdgcn_wave_barrier();
                {
                    const int tk = lane & 15, kg = lane >> 4, tl = wave * 16 + tk, t = unit * 128 + tl;
                    const float mean = st[tl * 2], rstd = st[tl * 2 + 1];
                    f32x4 acc0 = {0.f, 0.f, 0.f, 0.f}, acc1 = acc0;
                    const bf16_t* yrow = Y1B + (size_t)t * D + kg * 8;
                    const int e0 = tk, e1 = 16 + tk;
                    const LAS unsigned char* w0p = lds + LDS_STAGE + e0 * 2048; const LAS unsigned char* w1p = lds + LDS_STAGE + e1 * 2048;
                    u32x4 y8n[4];
#pragma unroll
                    for (int u = 0; u < 4; ++u) y8n[u] = __builtin_nontemporal_load((const u32x4*)(yrow + u * 32));
#pragma unroll 1
                    for (int ks0 = 0; ks0 < 32; ks0 += 4) {
                    u32x4 y8v[4];
#pragma unroll
                    for (int u = 0; u < 4; ++u) y8v[u] = y8n[u];
                    { const int kn = (ks0 + 4 < 32) ? ks0 + 4 : ks0;
#pragma unroll
                      for (int u = 0; u < 4; ++u) y8n[u] = __builtin_nontemporal_load((const u32x4*)(yrow + (kn + u) * 32)); }
#pragma unroll
                    for (int u = 0; u < 4; ++u) {
                        const int ks = ks0 + u;
                        const int k0 = ks * 32 + kg * 8;
                        const u32x4 y8 = y8v[u];
                        const f32x4 ga = *(const LAS f32x4*)(g1l + k0), gb = *(const LAS f32x4*)(g1l + k0 + 4), ba = *(const LAS f32x4*)(b1l + k0), bb = *(const LAS f32x4*)(b1l + k0 + 4);
                        float x[8];
                        x[0] = (bf_lo(y8[0]) - mean) * rstd * ga[0] + ba[0]; x[1] = (bf_hi(y8[0]) - mean) * rstd * ga[1] + ba[1];
                        x[2] = (bf_lo(y8[1]) - mean) * rstd * ga[2] + ba[2]; x[3] = (bf_hi(y8[1]) - mean) * rstd * ga[3] + ba[3];
                        x[4] = (bf_lo(y8[2]) - mean) * rstd * gb[0] + bb[0]; x[5] = (bf_hi(y8[2]) - mean) * rstd * gb[1] + bb[1];
                        x[6] = (bf_lo(y8[3]) - mean) * rstd * gb[2] + bb[2]; x[7] = (bf_hi(y8[3]) - mean) * rstd * gb[3] + bb[3];
                        u32x4 hx; hx.x = pk_bf16(x[0], x[1]); hx.y = pk_bf16(x[2], x[3]); hx.z = pk_bf16(x[4], x[5]); hx.w = pk_bf16(x[6], x[7]);
                        *(u32x4*)(X1B + (size_t)t * D + k0) = hx;
#if MOE_FP8
                        *(u32x2*)(ws + WS_X1Q + (size_t)t * D + k0) = (u32x2){pk4_fp8(x[0] * X8_SCALE, x[1] * X8_SCALE, x[2] * X8_SCALE, x[3] * X8_SCALE), pk4_fp8(x[4] * X8_SCALE, x[5] * X8_SCALE, x[6] * X8_SCALE, x[7] * X8_SCALE)};
#endif
                        u32x4 lx; lx.x = pk_bf16(x[0] - bf_lo(hx.x), x[1] - bf_hi(hx.x)); lx.y = pk_bf16(x[2] - bf_lo(hx.y), x[3] - bf_hi(hx.y));
                        lx.z = pk_bf16(x[4] - bf_lo(hx.z), x[5] - bf_hi(hx.z)); lx.w = pk_bf16(x[6] - bf_lo(hx.w), x[7] - bf_hi(hx.w));
                        const bf16x8 xh = __builtin_bit_cast(bf16x8, hx), xl = __builtin_bit_cast(bf16x8, lx);
                        const int c0 = ((ks * 4 + kg) ^ tk) << 4;
                        const bf16x8 wh0 = *(const LAS bf16x8*)(w0p + c0), wl0 = *(const LAS bf16x8*)(w0p + 65536 + c0);
                        const bf16x8 wh1 = *(const LAS bf16x8*)(w1p + c0), wl1 = *(const LAS bf16x8*)(w1p + 65536 + c0);
                        acc0 = __builtin_amdgcn_mfma_f32_16x16x32_f16(wh0, xh, acc0, 0, 0, 0); acc1 = __builtin_amdgcn_mfma_f32_16x16x32_f16(wh1, xh, acc1, 0, 0, 0);
                        acc0 = __builtin_amdgcn_mfma_f32_16x16x32_f16(wl0, xh, acc0, 0, 0, 0); acc1 = __builtin_amdgcn_mfma_f32_16x16x32_f16(wl1, xh, acc1, 0, 0, 0);
                        acc0 = __builtin_amdgcn_mfma_f32_16x16x32_f16(wh0, xl, acc0, 0, 0, 0); acc1 = __builtin_amdgcn_mfma_f32_16x16x32_f16(wh1, xl, acc1, 0, 0, 0);
                    }
                    }
                    float lv[8]; int li[8];
                    { const f32x4 b0 = *(const f32x4*)(br + kg * 4), b1v = *(const f32x4*)(br + 16 + kg * 4);
#pragma unroll
                      for (int j = 0; j < 4; ++j) { lv[j] = acc0[j] + b0[j]; li[j] = kg * 4 + j; lv[4 + j] = acc1[j] + b1v[j]; li[4 + j] = 16 + kg * 4 + j; } }
                    int be[4]; float bv[4];
#pragma unroll
                    for (int kk = 0; kk < 4; ++kk) {
                        float m = lv[0]; int mi = li[0];
#pragma unroll
                        for (int i = 1; i < 8; ++i) if (lv[i] > m) { m = lv[i]; mi = li[i]; }
                        { const float om = shx(m, 16, lane); const int oi = __float_as_int(shx(__int_as_float(mi), 16, lane)); if (om > m || (om == m && oi < mi)) { m = om; mi = oi; } }
                        { const float om = shx(m, 32, lane); const int oi = __float_as_int(shx(__int_as_float(mi), 32, lane)); if (om > m || (om == m && oi < mi)) { m = om; mi = oi; } }
                        be[kk] = mi; bv[kk] = m;
#pragma unroll
                        for (int i = 0; i < 8; ++i) if (li[i] == mi) lv[i] = -3e38f;
                    }
                    float ex[4], es = 0.f;
#pragma unroll
                    for (int kk = 0; kk < 4; ++kk) { ex[kk] = __expf(bv[kk] - bv[0]); es += ex[kk]; }
                    if (kg == 0) {
#pragma unroll
                        for (int kk = 0; kk < 4; ++kk) { const int sl = __hip_atomic_fetch_add(&lcnt[be[kk]], 1, __ATOMIC_RELAXED, __HIP_MEMORY_SCOPE_WORKGROUP); asg_e[tl * 4 + kk] = be[kk]; asg_ls[tl * 4 + kk] = sl; GATE[t * 4 + kk] = ex[kk] / es; }
                    }
                }
                __syncthreads();
                if (tid < 32) lbase[tid] = (int)__hip_atomic_fetch_add(gcnt + tid, (unsigned)lcnt[tid], __ATOMIC_RELAXED, __HIP_MEMORY_SCOPE_AGENT);
                __syncthreads();
                { const int e = asg_e[tid], sl = lbase[e] + asg_ls[tid], t = unit * 128 + (tid >> 2);
                  TOKL[(size_t)e * T + sl] = t; ASGE[t * 4 + (tid & 3)] = e; ASGS[t * 4 + (tid & 3)] = sl; }
                __syncthreads();
            }
        }
        SEAM(pb + 4);
        LAS int* tstart = (LAS int*)(lds + LDS_TSTART); LAS int* lcntE = (LAS int*)(lds + LDS_CNT); LAS unsigned char* tile_e = lds + LDS_TILEE;
        if (IN(pb + 5) || IN(pb + 6) || IN(pb + 7)) {
            OPAQUE_IDS(); WSPTRS();
            if (tid < 32) lcntE[tid] = (int)__hip_atomic_load(ctl + CW_CNT + l * 64 + tid, __ATOMIC_RELAXED, __HIP_MEMORY_SCOPE_AGENT);
            __syncthreads();
            if (tid == 0) { int acc = 0; for (int e = 0; e < NE; ++e) { tstart[e] = acc; acc += (lcntE[e] + 255) >> 8; } tstart[32] = acc; }
            __syncthreads();
            for (int q = tid; q < MAXRT; q += 512) { int e = 0; for (int k = 0; k < NE; ++k) if (q >= tstart[k]) e = k; tile_e[q] = (unsigned char)e; }
            __syncthreads();
        }
        pg8::MoeTables tb{tstart, lcntE, tile_e, tstart[32]};
        if (IN(pb + 5)) PREP(7) {
            WSPTRS();
#if MOE_FP8
            pg8::MoeOrder S{tb, 8, G, bid, (const char*)Wgu + (size_t)l * NE * 2048 * 1024, (size_t)2048 * 1024, TOKL, true, 1024};
            pg8::EpiSwiglu<true> E{(void*)ACT, a.b_gu + (size_t)l * NE * 2048, 1.0f / (W8_SCALE * X8_SCALE)};
            pg8::gemm_phase<pg8::EpiSwiglu<true>, pg8::MoeOrder, true, 1>(lds + LDS_STAGE, (const bf16_t*)(ws + WS_X1Q), 1024, S, E, wave0);
#else
            pg8::MoeOrder S{tb, 8, G, bid, (const char*)(Wgu + (size_t)l * NE * 2048 * 1024), (size_t)2048 * 1024 * 2, TOKL, true, 2048};
            pg8::EpiSwiglu<false> E{(void*)ACT, a.b_gu + (size_t)l * NE * 2048, 1.0f};
            pg8::gemm_phase<pg8::EpiSwiglu<false>, pg8::MoeOrder, true>(lds + LDS_STAGE, X1B, 1024, S, E, wave0);
#endif
        }
        SEAM(pb + 5);
        if (IN(pb + 6)) PREP(8) {
            WSPTRS();
#if MOE_FP8
            pg8::MoeOrder S{tb, 4, G, bid, (const char*)Wdn + (size_t)l * NE * 1024 * 1024, (size_t)1024 * 1024, TOKL, false, 1024};
            pg8::EpiBiasBf16 E{YR, a.b_down + (size_t)l * NE * 1024, 1.0f / (W8_SCALE * A8_SCALE)};
            pg8::gemm_phase<pg8::EpiBiasBf16, pg8::MoeOrder, false, 1>(lds + LDS_STAGE, ACT, 1024, S, E, wave0);
#else
            pg8::MoeOrder S{tb, 4, G, bid, (const char*)(Wdn + (size_t)l * NE * 1024 * 1024), (size_t)1024 * 1024 * 2, TOKL, false, 2048};
            pg8::EpiBiasBf16 E{YR, a.b_down + (size_t)l * NE * 1024, 1.0f};
            pg8::gemm_phase<pg8::EpiBiasBf16, pg8::MoeOrder, false>(lds + LDS_STAGE, ACT, 1024, S, E, wave0);
#endif
        }
        SEAM(pb + 6);
        if (IN(pb + 7)) PREP(9) {
            OPAQUE_IDS(); WSPTRS();
            const float* g2 = a.ln2_g + l * D; const float* b2 = a.ln2_b + l * D;
            f32x4 gg4[4], bb4[4];
#pragma unroll
            for (int i = 0; i < 4; ++i) { gg4[i] = *(const f32x4*)(g2 + i * 256 + lane * 4); bb4[i] = *(const f32x4*)(b2 + i * 256 + lane * 4); }
            for (int t0 = gw; t0 < T; t0 += 2 * NGW) {
                int e_[2][4], sl_[2][4]; float gk_[2][4];
#pragma unroll
                for (int u = 0; u < 2; ++u) { const int t = t0 + u * NGW;
#pragma unroll
                    for (int k = 0; k < 4; ++k) { e_[u][k] = ASGE[t * 4 + k]; sl_[u][k] = ASGS[t * 4 + k]; gk_[u][k] = GATE[t * 4 + k]; } }
                u32x2 xr[2][4], yr[2][4][4];
#pragma unroll
                for (int u = 0; u < 2; ++u) { const int t = t0 + u * NGW;
#pragma unroll
                    for (int i = 0; i < 4; ++i) xr[u][i] = __builtin_nontemporal_load((const u32x2*)(X1B + (size_t)t * D + i * 256 + lane * 4));
#pragma unroll
                    for (int k = 0; k < 4; ++k) { const bf16_t* yp = YR + ((size_t)tstart[e_[u][k]] * 256 + sl_[u][k]) * 1024;
#pragma unroll
                        for (int i = 0; i < 4; ++i) yr[u][k][i] = __builtin_nontemporal_load((const u32x2*)(yp + i * 256 + lane * 4)); } }
#pragma unroll
                for (int u = 0; u < 2; ++u) { const int t = t0 + u * NGW;
                    float v[16];
#pragma unroll
                    for (int i = 0; i < 4; ++i) { v[4 * i] = ALPHA * bf_lo(xr[u][i][0]); v[4 * i + 1] = ALPHA * bf_hi(xr[u][i][0]); v[4 * i + 2] = ALPHA * bf_lo(xr[u][i][1]); v[4 * i + 3] = ALPHA * bf_hi(xr[u][i][1]); }
#pragma unroll
                    for (int k = 0; k < 4; ++k) { const float gk = gk_[u][k];
#pragma unroll
                        for (int i = 0; i < 4; ++i) { const u32x2 u2 = yr[u][k][i];
                            v[4 * i] += gk * bf_lo(u2[0]); v[4 * i + 1] += gk * bf_hi(u2[0]); v[4 * i + 2] += gk * bf_lo(u2[1]); v[4 * i + 3] += gk * bf_hi(u2[1]); } }
                    float s_ = 0.f;
#pragma unroll
                    for (int i = 0; i < 16; ++i) s_ += v[i];
                    const float mean = wsum(s_, lane) * (1.0f / 1024.0f);
                    float qv = 0.f;
#pragma unroll
                    for (int i = 0; i < 16; ++i) { const float d = v[i] - mean; qv += d * d; }
                    const float rstd = rsqrtf(wsum(qv, lane) * (1.0f / 1024.0f) + EPS);
#pragma unroll
                    for (int i = 0; i < 4; ++i) {
                        const int c0 = i * 256 + lane * 4;
                        const f32x4 gg = gg4[i], bb = bb4[i];
                        float o[4];
#pragma unroll
                        for (int j = 0; j < 4; ++j) o[j] = (v[4 * i + j] - mean) * rstd * gg[j] + bb[j];
                        if (l == DEPTH - 1) *(f32x4*)(a.out + (size_t)t * D + c0) = (f32x4){o[0], o[1], o[2], o[3]};
                        else *(u32x2*)(XB + (size_t)t * D + c0) = (u32x2){pk_bf16(o[0], o[1]), pk_bf16(o[2], o[3])};
                    }
                }
            }
        }
        if (l + 1 < DEPTH) SEAM(pb + 7);
    }
#undef IN
#undef SEAM
}

extern "C" void kernel_launch(void* const* d_in, const int* in_sizes, int n_in, void* d_out, int out_size, void* d_ws, size_t ws_size, hipStream_t stream) {
    static int grid = 0;
    if (grid == 0) {
        if (ws_size < WS_END) { fprintf(stderr, "kernel_launch: workspace too small (%zu < %zu)\n", ws_size, (size_t)WS_END); grid = -1; return; }
        int dev = 0, cus = 0, per_cu = 0;
        if (hipGetDevice(&dev) != hipSuccess || hipDeviceGetAttribute(&cus, hipDeviceAttributeMultiprocessorCount, dev) != hipSuccess) { grid = -1; return; }
        if (hipFuncSetAttribute((const void*)mega, hipFuncAttributeMaxDynamicSharedMemorySize, LDS_BYTES) != hipSuccess) { fprintf(stderr, "kernel_launch: hipFuncSetAttribute failed\n"); grid = -1; return; }
        if (hipOccupancyMaxActiveBlocksPerMultiprocessor(&per_cu, (const void*)mega, 512, LDS_BYTES) != hipSuccess || per_cu < 1) { fprintf(stderr, "kernel_launch: occupancy query says %d\n", per_cu); }
        (void)hipGetLastError();
        grid = cus;
        if (grid % 8 != 0) grid -= grid % 8;
    }
    if (grid < 0) return;
    (void)hipMemsetAsync((char*)d_ws + WS_CTL, 0, CTL_BYTES, stream);
    Args a{};
    a.x = (const float*)d_in[0]; a.w_in = (const float*)d_in[1]; a.lam_q1 = (const float*)d_in[2]; a.lam_k1 = (const float*)d_in[3]; a.lam_q2 = (const float*)d_in[4]; a.lam_k2 = (const float*)d_in[5];
    a.subln_g = (const float*)d_in[6]; a.rel_bias = (const float*)d_in[7]; a.w_out = (const float*)d_in[8]; a.ln1_g = (const float*)d_in[9]; a.ln1_b = (const float*)d_in[10];
    a.w_router = (const float*)d_in[11]; a.b_router = (const float*)d_in[12]; a.w_gu = (const float*)d_in[13]; a.b_gu = (const float*)d_in[14]; a.w_down = (const float*)d_in[15];
    a.b_down = (const float*)d_in[16]; a.ln2_g = (const float*)d_in[17]; a.ln2_b = (const float*)d_in[18];
    a.out = (float*)d_out; a.ws = (unsigned char*)d_ws; a.pad = 0;
    a.ph_lo = 0; a.ph_hi = 1 + 8 * DEPTH; a.bar_region = 0;
    hipLaunchKernelGGL(mega, dim3(grid), dim3(512), LDS_BYTES, stream, a);
}
```

```cpp
#include <hip/hip_runtime.h>
#include <stdint.h>
#include <cstdio>

#define LAS __attribute__((address_space(3)))
typedef unsigned short bf16_t;
typedef _Float16 bf16x8 __attribute__((ext_vector_type(8)));
typedef float f32x4 __attribute__((ext_vector_type(4)));
typedef float f32x2 __attribute__((ext_vector_type(2)));
typedef unsigned u32x4 __attribute__((ext_vector_type(4)));
typedef unsigned u32x2 __attribute__((ext_vector_type(2)));
typedef _Float16 bf16v2 __attribute__((ext_vector_type(2)));

constexpr int D = 1024, BATCH = 16, SEQ = 2048, T = BATCH * SEQ, DEPTH = 4;
constexpr int DIN = 3368;
constexpr int NE = 32;
constexpr float ALPHA = 1.681792830507429f;
constexpr float EPS = 1e-5f;
constexpr float LOG2E = 1.4426950408889634f;
constexpr float QSCALE = 0.125f * LOG2E;
constexpr int HQP = 2560;
constexpr int HQ_QA = 0, HQ_KA = 512, HQ_QB = 1024, HQ_KB = 1280, HQ_QC = 1536, HQ_KC = 1792, HQ_QI = 2048, HQ_KI = 2304, HQ_WI = 2336, HQ_USED = 2344;
constexpr int VT_A = 0, VT_B = 512, VT_C = 768;
constexpr int NASG = T * 4;
constexpr int GROWS = NASG + NE * 256;
constexpr int MAXRT = GROWS / 256;

constexpr size_t MiB = (size_t)1 << 20;
constexpr size_t al(size_t x) { return (x + 255) & ~(size_t)255; }
constexpr size_t WS_CTL = 0, CTL_BYTES = 4 * MiB;
constexpr size_t WS_WIN = WS_CTL + CTL_BYTES;
constexpr size_t WS_WV = WS_WIN + al((size_t)DEPTH * HQP * D * 2);
constexpr size_t WS_WOUT = WS_WV + al((size_t)DEPTH * 1024 * D * 2);
constexpr size_t WS_WGU = WS_WOUT + al((size_t)DEPTH * D * 1024 * 2);
constexpr size_t WS_WDN = WS_WGU + al((size_t)DEPTH * NE * 2048 * D * 2);
constexpr size_t WS_XB = WS_WDN + al((size_t)DEPTH * NE * D * 1024 * 2);
constexpr size_t WS_HQ = WS_XB + al((size_t)T * D * 2);
constexpr size_t WS_VT = WS_HQ + al((size_t)T * HQP * 2);
constexpr size_t WS_MIX = WS_VT + al((size_t)1024 * T * 2);
constexpr size_t WS_Y1 = WS_MIX + al((size_t)T * 1024 * 2);
constexpr size_t WS_X1B = WS_Y1 + al((size_t)T * D * 2);
constexpr size_t WS_ACT = WS_X1B + al((size_t)T * D * 2);
constexpr size_t WS_YR = WS_ACT + al((size_t)GROWS * 1024 * 2);
constexpr size_t WS_MASK = WS_YR + al((size_t)GROWS * 1024 * 2);
constexpr size_t WS_TOKL = WS_MASK + al((size_t)T * 32 * 8);
constexpr size_t WS_ASGE = WS_TOKL + al((size_t)NE * T * 4);
constexpr size_t WS_ASGS = WS_ASGE + al((size_t)NASG * 4);
constexpr size_t WS_GATE = WS_ASGS + al((size_t)NASG * 4);
constexpr size_t WS_OA1 = WS_GATE + al((size_t)NASG * 4);
constexpr size_t WS_WRT = WS_OA1 + al((size_t)T * 512 * 4);
constexpr size_t WS_X1Q = WS_WRT + al((size_t)DEPTH * NE * D * 4);
constexpr size_t WS_END = WS_X1Q + al((size_t)T * D);
constexpr int CW_BAR = 4096;
constexpr int CW_CNT = 262144;
constexpr int CW_Q = 524288;

#ifndef MOE_FP8
#define MOE_FP8 1
#endif
constexpr int RTP = 2;
constexpr float W8_SCALE = 512.0f;
constexpr float X8_SCALE = 16.0f;
constexpr float A8_SCALE = 4.0f;
typedef int i32x8 __attribute__((ext_vector_type(8)));
__device__ __forceinline__ unsigned pk_bf16(float lo, float hi) { f32x2 v = {lo, hi}; return __builtin_bit_cast(unsigned, __builtin_convertvector(v, bf16v2)); }
__device__ __forceinline__ float clamp8(float x) { return __builtin_fminf(__builtin_fmaxf(x, -448.0f), 448.0f); }
__device__ __forceinline__ unsigned pk4_fp8(float a, float b, float c, float d) {
    int w = 0; w = __builtin_amdgcn_cvt_pk_fp8_f32(clamp8(a), clamp8(b), w, false); w = __builtin_amdgcn_cvt_pk_fp8_f32(clamp8(c), clamp8(d), w, true); return (unsigned)w; }
__device__ __forceinline__ float bf_lo(unsigned u) { return (float)__builtin_bit_cast(bf16v2, u)[0]; }
__device__ __forceinline__ float bf_hi(unsigned u) { return (float)__builtin_bit_cast(bf16v2, u)[1]; }
__device__ __forceinline__ float bf2f(bf16_t b) { return (float)__builtin_bit_cast(bf16v2, (unsigned)b)[0]; }
__device__ __forceinline__ float wave_sum(float v) {
#pragma unroll
    for (int o = 32; o > 0; o >>= 1) v += __shfl_xor(v, o);
    return v; }
__device__ __forceinline__ float wave_max(float v) {
#pragma unroll
    for (int o = 32; o > 0; o >>= 1) v = fmaxf(v, __shfl_xor(v, o));
    return v; }
__device__ __forceinline__ int wave_sum_i(int v) {
#pragma unroll
    for (int o = 32; o > 0; o >>= 1) v += __shfl_xor(v, o);
    return v; }

__device__ __forceinline__ float shx(float v, int o, int lane) { return __int_as_float(__builtin_amdgcn_ds_bpermute((lane ^ o) << 2, __float_as_int(v))); }
__device__ __forceinline__ float wsum(float v, int lane) {
#pragma unroll
    for (int o = 32; o > 0; o >>= 1) v += shx(v, o, lane);
    return v; }
__device__ __forceinline__ float wmax(float v, int lane) {
#pragma unroll
    for (int o = 32; o > 0; o >>= 1) v = fmaxf(v, shx(v, o, lane));
    return v; }

#define XB_TMO      128
#define XB_XCNT(j)  (256  + 64 * (j))
#define XB_XSUB(j)  (1280 + 64 * (j))
#define XB_XGEN(j)  (2304 + 64 * (j))
#define XB_TOP      3328
#define XB_TOPGEN   3392
#define XCD_BAR_WORDS 3456
#define XB_SPIN_CAP (1u << 22)
__device__ __forceinline__ unsigned xb_ld(unsigned* p)              { return __hip_atomic_load(p, __ATOMIC_RELAXED, __HIP_MEMORY_SCOPE_AGENT); }
__device__ __forceinline__ unsigned xb_add(unsigned* p, unsigned v) { return __hip_atomic_fetch_add(p, v, __ATOMIC_RELAXED, __HIP_MEMORY_SCOPE_AGENT); }
__device__ __forceinline__ unsigned xb_xcc_id() { return (unsigned)__builtin_amdgcn_s_getreg((3 << 11) | 20) & 0xFu; }
#define XB_SPIN(cond, bar) do { unsigned _sp = 0; while (cond) { __builtin_amdgcn_s_sleep(1); \
    if ((++_sp & 255u) == 0u) { if (xb_ld(&(bar)[XB_TMO])) break; if (_sp > XB_SPIN_CAP) { atomicAdd(&(bar)[XB_TMO], 1u); break; } } } } while (0)
struct XcdBarrier { unsigned* bar; unsigned x; volatile LAS unsigned* st; };
__device__ __forceinline__ XcdBarrier xcd_barrier_post(unsigned* bar, volatile LAS unsigned* st) {
    XcdBarrier b; b.bar = bar; b.x = xb_xcc_id(); b.st = st;
    if (threadIdx.x == 0) (void)xb_add(&bar[XB_XCNT(b.x)], 1u);
    return b;
}
__device__ __forceinline__ void xcd_barrier_complete(unsigned* bar, unsigned x, unsigned& nloc, unsigned& nx) {
    const unsigned G = gridDim.x * gridDim.y * gridDim.z;
    unsigned sum, cnt, mine, sp = 0u;
    for (;;) {
        sum = 0u; cnt = 0u; mine = 0u;
#pragma unroll
        for (unsigned j = 0; j < 16; ++j) { const unsigned c = xb_ld(&bar[XB_XCNT(j)]); sum += c; cnt += (c > 0u) ? 1u : 0u; mine = (j == x) ? c : mine; }
        if (sum == G) break;
        __builtin_amdgcn_s_sleep(1);
        if ((++sp & 255u) == 0u) { if (xb_ld(&bar[XB_TMO])) break; if (sp > XB_SPIN_CAP) { atomicAdd(&bar[XB_TMO], 1u); break; } }
    }
    nloc = mine > 0u ? mine : 1u; nx = cnt > 0u ? cnt : 1u;
}
__device__ __forceinline__ void xcd_barrier(const XcdBarrier& b) {
    asm volatile("s_waitcnt vmcnt(0)" ::: "memory");
    __syncthreads();
    if (threadIdx.x == 0) {
        unsigned* bar = b.bar;
        __builtin_amdgcn_s_waitcnt(0);
        unsigned nloc = b.st[0], nx = b.st[1];
        if (nloc == 0u) { xcd_barrier_complete(bar, b.x, nloc, nx); b.st[0] = nloc; b.st[1] = nx; }
        const unsigned old = xb_add(&bar[XB_XSUB(b.x)], 1u);
        const unsigned gen = old / nloc;
        if (old + 1u == (gen + 1u) * nloc) {
            __builtin_amdgcn_fence(__ATOMIC_RELEASE, "agent");
            asm volatile("s_waitcnt vmcnt(0)" ::: "memory");
            const unsigned og = xb_add(&bar[XB_TOP], 1u);
            const unsigned tg = og / nx;
            if (og + 1u == (tg + 1u) * nx) xb_add(&bar[XB_TOPGEN], 1u);
            else XB_SPIN(xb_ld(&bar[XB_TOPGEN]) == tg, bar);
            __builtin_amdgcn_fence(__ATOMIC_ACQUIRE, "agent");
            xb_add(&bar[XB_XGEN(b.x)], 1u);
            asm volatile("s_waitcnt vmcnt(0)" ::: "memory");
        } else {
            XB_SPIN(xb_ld(&bar[XB_XGEN(b.x)]) == gen, bar);
            __builtin_amdgcn_fence(__ATOMIC_ACQUIRE, "agent");
            asm volatile("s_waitcnt vmcnt(0)" ::: "memory");
        }
    }
    __syncthreads();
}

namespace pg8 {
constexpr int BM = 256, BK = 64, HALF = 128, HTB = HALF * BK * 2, STAGE_BYTES = 8 * HTB;
__host__ __device__ __forceinline__ int lds_byte(int r, int c) { const int st = (r >> 4) * 2 + (c >> 5), rr = r & 15, cc = c & 31, ob = rr * 64 + cc * 2; return st * 1024 + (ob ^ (((ob >> 9) & 1) << 5)); }
__host__ __device__ __forceinline__ void stage_rc(int b, int& R, int& C) { const int st = b / 1024, sb = b % 1024, swz = sb ^ (((sb >> 9) & 1) << 5); R = (st >> 1) * 16 + swz / 64; C = (st & 1) * 32 + (swz % 64) / 2; }
__host__ __device__ __forceinline__ int perm32(int rho) { const int n = rho >> 4, i = rho & 15; return 8 * (i >> 2) + 4 * n + (i & 3); }

struct Unit {
    int row0;
    int col0;
    const char* Bt;
    const int* rows;
    int nvalid;
    int e;
};

template <class Epi, class Sched, bool GATHER, int ESZ = 2>
__device__ __forceinline__ void gemm_phase(LAS unsigned char* lds, const bf16_t* Abase, const int K, const Sched& S, const Epi& E, const int wid_in) {
    int wid = wid_in; asm volatile("" : "+s"(wid));
    int lane; asm volatile("v_mbcnt_lo_u32_b32 %0, -1, 0\n\tv_mbcnt_hi_u32_b32 %0, -1, %0" : "=&v"(lane));
    const int tid = wid * 64 + lane, wr = wid >> 2, wc = wid & 3, fr = lane & 15, fq = lane >> 4;
    const int nt = K * ESZ / 128;
    unsigned voffB[2];
#pragma unroll
    for (int i = 0; i < 2; ++i) { int R, C; stage_rc(tid * 16 + i * 8192, R, C); const int Rb = Epi::PERM ? ((R & ~31) + perm32(R & 31)) : R; voffB[i] = (unsigned)(Rb * K * ESZ + C * 2); }
    const size_t kstep = (size_t)(BK * 2);
    const size_t hstep = (size_t)HALF * K * ESZ;
    const unsigned ldsw = (unsigned)wid * 1024u;
    const int aoff = lds_byte(wr * 64 + fr, fq * 8), boff = lds_byte(wc * 32 + fr, fq * 8);
#define PG8_SA(b, h) (((b) * 2 + (h)) * HTB)
#define PG8_SB(b, h) ((4 + (b) * 2 + (h)) * HTB)
#define PG8_STAGE(bufoff, gbase, voff) do { _Pragma("unroll") for (int _i = 0; _i < 2; ++_i) \
        __builtin_amdgcn_global_load_lds((const unsigned*)((const char*)(gbase) + (voff)[_i]), (LAS unsigned*)(lds + (bufoff) + ldsw + _i * 8192), 16, 0, 0); } while (0)
#define PG8_LDA(dst, b, h) do { _Pragma("unroll") for (int m = 0; m < 4; ++m) _Pragma("unroll") for (int k = 0; k < 2; ++k) dst[m][k] = *(const LAS bf16x8*)(lds + PG8_SA(b, h) + aoff + m * 2048 + k * 1024); } while (0)
#define PG8_LDB(dst, b, h) do { _Pragma("unroll") for (int n = 0; n < 2; ++n) _Pragma("unroll") for (int k = 0; k < 2; ++k) dst[n][k] = *(const LAS bf16x8*)(lds + PG8_SB(b, h) + boff + n * 2048 + k * 1024); } while (0)
#define PG8_MMA(ai, bj, At, Bt) do { __builtin_amdgcn_s_setprio(1); _Pragma("unroll") for (int m = 0; m < 4; ++m) _Pragma("unroll") for (int n = 0; n < 2; ++n) { \
        if constexpr (ESZ == 2) { _Pragma("unroll") for (int k = 0; k < 2; ++k) acc[ai][bj][m][n] = __builtin_amdgcn_mfma_f32_16x16x32_f16(Bt[n][k], At[m][k], acc[ai][bj][m][n], 0, 0, 0); } \
        else {   \
            const u32x4 _a0 = __builtin_bit_cast(u32x4, At[m][0]), _a1 = __builtin_bit_cast(u32x4, At[m][1]), _b0 = __builtin_bit_cast(u32x4, Bt[n][0]), _b1 = __builtin_bit_cast(u32x4, Bt[n][1]); \
            const i32x8 _af = {(int)_a0[0], (int)_a0[1], (int)_a0[2], (int)_a0[3], (int)_a1[0], (int)_a1[1], (int)_a1[2], (int)_a1[3]}; \
            const i32x8 _bf = {(int)_b0[0], (int)_b0[1], (int)_b0[2], (int)_b0[3], (int)_b1[0], (int)_b1[1], (int)_b1[2], (int)_b1[3]}; \
              \
            asm volatile("v_mfma_scale_f32_16x16x128_f8f6f4 %0, %1, %2, %0, %3, %3 op_sel_hi:[0,0,0]" : "+v"(acc[ai][bj][m][n]) : "v"(_bf), "v"(_af), "v"(s8)); } } \
        __builtin_amdgcn_s_setprio(0); } while (0)
#define PG8_WAIT_V(n) asm volatile("s_waitcnt vmcnt(" #n ")" ::: "memory")
#define PG8_WAIT_VS() do { if (slack) { if constexpr (Epi::NST >= 16) asm volatile("s_waitcnt vmcnt(24)" ::: "memory"); else asm volatile("s_waitcnt vmcnt(16)" ::: "memory"); } else asm volatile("s_waitcnt vmcnt(8)" ::: "memory"); } while (0)
#define PG8_WAIT_L(n) asm volatile("s_waitcnt lgkmcnt(" #n ")" ::: "memory")
#define PG8_BAR __builtin_amdgcn_s_barrier()
#define PG8_SCHED __builtin_amdgcn_sched_barrier(0)
#define PG8_AOFFS(dst, u) do { _Pragma("unroll") for (int _h = 0; _h < 2; ++_h) _Pragma("unroll") for (int _i = 0; _i < 2; ++_i) { int _R, _C; stage_rc(tid * 16 + _i * 8192, _R, _C); \
        const int _r = _h * HALF + _R; const int _src = (_r < (u).nvalid) ? (u).rows[_r] : 0; dst[_h][_i] = (unsigned)(_src * K * ESZ + _C * 2); } } while (0)
#define PG8_RAWLOAD(dst, u) do { _Pragma("unroll") for (int _h = 0; _h < 2; ++_h) _Pragma("unroll") for (int _i = 0; _i < 2; ++_i) { int _R, _C; stage_rc(tid * 16 + _i * 8192, _R, _C); \
        const int _r = _h * HALF + _R; dst[_h][_i] = (_r < (u).nvalid) ? (u).rows[_r] : 0; } } while (0)
#define PG8_STAGE_A(bufoff, h, ktb, usenext) do { if constexpr (GATHER) { const unsigned _o[2] = {(usenext) ? na[h][0] : oa[h][0], (usenext) ? na[h][1] : oa[h][1]}; PG8_STAGE(bufoff, cA + (ktb), _o); } \
        else { PG8_STAGE(bufoff, ((usenext) ? nA : cA) + (size_t)(h) * hstep + (ktb), voffA); } } while (0)
    Unit cur, nxt; int ui = 0;
    if (!S.next(0, cur)) return;
    f32x4 acc[2][2][4][2];
#pragma unroll
    for (int a = 0; a < 2; ++a)
#pragma unroll
        for (int b = 0; b < 2; ++b)
#pragma unroll
            for (int m = 0; m < 4; ++m)
#pragma unroll
                for (int n = 0; n < 2; ++n) acc[a][b][m][n] = (f32x4){0.f, 0.f, 0.f, 0.f};
    bf16x8 At[4][2], B0[2][2], B1[2][2];
    int s8 = 0x7F7F7F7F; asm volatile("" : "+v"(s8));
    unsigned oa[2][2], na[2][2], voffA[2];
    const char* cA; const char* nA; const char* cB = cur.Bt;
    int raw[2][2] = {{0, 0}, {0, 0}};
    if constexpr (GATHER) { PG8_AOFFS(oa, cur); cA = (const char*)Abase; nA = cA; voffA[0] = voffA[1] = 0u; if (S.next(1, nxt)) { PG8_RAWLOAD(raw, nxt); } }
    else { cA = cur.rows ? (const char*)cur.rows : (const char*)Abase + (size_t)cur.row0 * K * ESZ; nA = cA;
#pragma unroll
        for (int i = 0; i < 2; ++i) { int R, C; stage_rc(tid * 16 + i * 8192, R, C); voffA[i] = (unsigned)(R * K * ESZ + C * 2); oa[0][i] = oa[1][i] = na[0][i] = na[1][i] = 0u; } }
    PG8_STAGE(PG8_SB(0, 0), cB, voffB); PG8_STAGE(PG8_SB(0, 1), cB + hstep, voffB); PG8_STAGE_A(PG8_SA(0, 0), 0, 0, false); PG8_STAGE_A(PG8_SA(0, 1), 1, 0, false);
    if (wr == 1) PG8_BAR;
    PG8_WAIT_V(2); PG8_BAR;
    PG8_STAGE(PG8_SB(1, 0), cB + kstep, voffB); PG8_STAGE_A(PG8_SA(1, 0), 0, kstep, false); PG8_STAGE(PG8_SB(1, 1), cB + hstep + kstep, voffB);
    PG8_WAIT_V(6); PG8_BAR;
    for (;;) {
        const bool has_next = S.next(ui + 1, nxt);
        if constexpr (GATHER) {
            if (has_next) {
#pragma unroll
                for (int h = 0; h < 2; ++h)
#pragma unroll
                    for (int i = 0; i < 2; ++i) { int R, C; stage_rc(tid * 16 + i * 8192, R, C); na[h][i] = (unsigned)(raw[h][i] * K * ESZ + C * 2); }
                asm volatile("" : "+v"(na[0][0]), "+v"(na[0][1]), "+v"(na[1][0]), "+v"(na[1][1]));
            } else {
#pragma unroll
                for (int h = 0; h < 2; ++h)
#pragma unroll
                    for (int i = 0; i < 2; ++i) na[h][i] = oa[h][i];
            }
            Unit n2;
            if (has_next && S.next(ui + 2, n2)) { PG8_RAWLOAD(raw, n2); }
        } else nA = has_next ? (nxt.rows ? (const char*)nxt.rows : (const char*)Abase + (size_t)nxt.row0 * K * ESZ) : cA;
        const char* nB = has_next ? nxt.Bt : cB;
#pragma unroll 1
        for (int t = 0; t < nt; t += 2) {
            const bool last = (t == nt - 2);
            const bool slack = (t == 0) && (ui > 0);
            const size_t k1 = (size_t)(t + 1) * kstep, k2 = last ? 0 : (size_t)(t + 2) * kstep, k3 = k2 + kstep;
            const char* b2 = last ? nB : cB + (size_t)(t + 2) * kstep; const char* b3 = b2 + kstep;
            PG8_LDB(B0, 0, 0); PG8_LDB(B1, 0, 1); PG8_SCHED; PG8_LDA(At, 0, 0); PG8_STAGE_A(PG8_SA(1, 1), 1, k1, false);
            PG8_WAIT_VS(); PG8_WAIT_L(0); PG8_BAR; PG8_MMA(0, 0, At, B0); PG8_MMA(0, 1, At, B1); PG8_BAR; PG8_SCHED;
            PG8_LDA(At, 0, 1); PG8_STAGE(PG8_SB(0, 0), b2, voffB); PG8_STAGE(PG8_SB(0, 1), b2 + hstep, voffB); PG8_STAGE_A(PG8_SA(0, 0), 0, k2, last);
            PG8_WAIT_VS(); PG8_WAIT_L(0); PG8_BAR; PG8_MMA(1, 0, At, B0); PG8_MMA(1, 1, At, B1); PG8_BAR; PG8_SCHED;
            PG8_LDB(B0, 1, 0); PG8_LDB(B1, 1, 1); PG8_SCHED; PG8_LDA(At, 1, 0); PG8_STAGE_A(PG8_SA(0, 1), 1, k2, last);
            PG8_WAIT_V(8); PG8_WAIT_L(0); PG8_BAR; PG8_MMA(0, 0, At, B0); PG8_MMA(0, 1, At, B1); PG8_BAR; PG8_SCHED;
            PG8_LDA(At, 1, 1); PG8_STAGE(PG8_SB(1, 0), b3, voffB); PG8_STAGE(PG8_SB(1, 1), b3 + hstep, voffB); PG8_STAGE_A(PG8_SA(1, 0), 0, k3, last);
            PG8_WAIT_V(8); PG8_WAIT_L(0); PG8_BAR; PG8_MMA(1, 0, At, B0); PG8_MMA(1, 1, At, B1); PG8_BAR; PG8_SCHED;
        }
        if constexpr (ESZ == 1) asm volatile("s_nop 15\n\ts_nop 15" ::: "memory");
        if (wr == 0) PG8_BAR;
        E(acc, cur, wr, wc, fr, fq);
        if (!has_next) break;
#pragma unroll
        for (int a = 0; a < 2; ++a)
#pragma unroll
            for (int b = 0; b < 2; ++b)
#pragma unroll
                for (int m = 0; m < 4; ++m)
#pragma unroll
                    for (int n = 0; n < 2; ++n) acc[a][b][m][n] = (f32x4){0.f, 0.f, 0.f, 0.f};
        cur = nxt; cB = nB; ++ui;
        if constexpr (GATHER) {
#pragma unroll
            for (int h = 0; h < 2; ++h)
#pragma unroll
                for (int i = 0; i < 2; ++i) oa[h][i] = na[h][i];
        } else cA = nA;
        if (wr == 1) PG8_BAR;
    }
    PG8_WAIT_V(0);
    PG8_BAR;
#undef PG8_SA
#undef PG8_SB
#undef PG8_STAGE
#undef PG8_LDA
#undef PG8_LDB
#undef PG8_MMA
#undef PG8_WAIT_V
#undef PG8_WAIT_L
#undef PG8_WAIT_VS
#undef PG8_BAR
#undef PG8_SCHED
#undef PG8_AOFFS
#undef PG8_RAWLOAD
#undef PG8_STAGE_A
}

struct DenseOrder {
    int nRT, nN, G, c; const char* Bt; int K; bool swap;
    __device__ __forceinline__ bool next(int i, Unit& u) const {
        const int xcd = c & 7, s = i * (G >> 3) + (c >> 3);
        int rt, pn;
        if (!swap) { rt = 8 * (s / nN) + xcd; pn = s % nN; } else { pn = 8 * (s / nRT) + xcd; rt = s % nRT; }
        if (rt >= nRT || pn >= nN) return false;
        u.row0 = rt * BM; u.col0 = pn * BM; u.Bt = Bt + (size_t)pn * BM * K * 2; u.rows = nullptr; u.nvalid = 0; u.e = 0; return true;
    }
};
struct InProjOrder {
    int G, c; const char* Win; const char* Wv; const char* Xb;
    __device__ __forceinline__ bool next(int i, Unit& u) const {
        constexpr int NM = (T / 256 / 8) * (HQP / 256), NV = (T / 256 / 8) * 4;
        const int xcd = c & 7, s = i * (G >> 3) + (c >> 3);
        if (s < NM) { const int rt = 8 * (s / (HQP / 256)) + xcd, pn = s % (HQP / 256);
            u.row0 = rt * BM; u.col0 = pn * BM; u.Bt = Win + (size_t)pn * BM * 2048; u.rows = (const int*)(Xb + (size_t)rt * BM * 2048); u.nvalid = 0; u.e = 0; return true; }
        const int s2 = s - NM;
        if (s2 >= NV) return false;
        const int pn = 8 * (s2 >> 2) + xcd, rt = s2 & 3;
        u.row0 = rt * BM; u.col0 = pn * BM; u.Bt = Xb + (size_t)pn * BM * 2048; u.rows = (const int*)(Wv + (size_t)rt * BM * 2048); u.nvalid = 0; u.e = 1; return true;
    }
};
struct MoeTables { LAS const int* tstart; LAS const int* cnt; LAS const unsigned char* tile_e; int nrt; };
struct MoeOrder {
    MoeTables tb; int nN, G, c; const char* Bt; size_t strideB; const int* tokl; bool gather; int rowb;
    __device__ __forceinline__ bool next(int i, Unit& u) const {
        const int xcd = c & 7, s = i * (G >> 3) + (c >> 3);
        const int q = 8 * (s / nN) + xcd, pn = s % nN;
        if (q >= tb.nrt) return false;
        const int e = __builtin_amdgcn_readfirstlane((int)tb.tile_e[q]); const int lt = q - __builtin_amdgcn_readfirstlane(tb.tstart[e]);
        u.row0 = q * BM; u.col0 = pn * BM; u.e = e; u.Bt = Bt + (size_t)e * strideB + (size_t)pn * BM * rowb;
        u.rows = gather ? tokl + (size_t)e * T + lt * BM : nullptr; u.nvalid = __builtin_amdgcn_readfirstlane(tb.cnt[e]) - lt * BM; return true;
    }
};

struct EpiBf16Plain {
    static constexpr bool PERM = true; static constexpr int NST = 16;
    bf16_t* O; int ldc;
    __device__ __forceinline__ void operator()(const f32x4 (&acc)[2][2][4][2], const Unit& u, int wr, int wc, int fr, int fq) const {
        const int row0 = u.row0 + wr * 64 + fr, col0 = u.col0 + wc * 32 + 8 * fq;
#pragma unroll
        for (int ai = 0; ai < 2; ++ai)
#pragma unroll
            for (int m = 0; m < 4; ++m) { bf16_t* rowp = O + (size_t)(row0 + ai * HALF + m * 16) * ldc + col0;
#pragma unroll
                for (int bj = 0; bj < 2; ++bj) { const f32x4 v0 = acc[ai][bj][m][0], v1 = acc[ai][bj][m][1];
                    u32x4 w; w.x = pk_bf16(v0[0], v0[1]); w.y = pk_bf16(v0[2], v0[3]); w.z = pk_bf16(v1[0], v1[1]); w.w = pk_bf16(v1[2], v1[3]);
                    *(u32x4*)(rowp + bj * HALF) = w; } }
    }
};
struct EpiInProj {
    static constexpr bool PERM = true; static constexpr int NST = 16;
    bf16_t* Ohq; bf16_t* Ovt;
    __device__ __forceinline__ void operator()(const f32x4 (&acc)[2][2][4][2], const Unit& u, int wr, int wc, int fr, int fq) const {
        bf16_t* O = u.e ? Ovt : Ohq; const int ldc = u.e ? T : HQP;
        const int row0 = u.row0 + wr * 64 + fr, col0 = u.col0 + wc * 32 + 8 * fq;
#pragma unroll
        for (int ai = 0; ai < 2; ++ai)
#pragma unroll
            for (int m = 0; m < 4; ++m) { bf16_t* rowp = O + (size_t)(row0 + ai * HALF + m * 16) * ldc + col0;
#pragma unroll
                for (int bj = 0; bj < 2; ++bj) { const f32x4 v0 = acc[ai][bj][m][0], v1 = acc[ai][bj][m][1];
                    u32x4 w; w.x = pk_bf16(v0[0], v0[1]); w.y = pk_bf16(v0[2], v0[3]); w.z = pk_bf16(v1[0], v1[1]); w.w = pk_bf16(v1[2], v1[3]);
                    *(u32x4*)(rowp + bj * HALF) = w; } }
    }
};
struct EpiResBf16 {
    static constexpr bool PERM = true; static constexpr int NST = 16;
    bf16_t* O; const bf16_t* R;
    __device__ __forceinline__ void operator()(const f32x4 (&acc)[2][2][4][2], const Unit& u, int wr, int wc, int fr, int fq) const {
        const int row0 = u.row0 + wr * 64 + fr, col0 = u.col0 + wc * 32 + 8 * fq;
        u32x4 rr[2][4][2];
#pragma unroll
        for (int ai = 0; ai < 2; ++ai)
#pragma unroll
            for (int m = 0; m < 4; ++m)
#pragma unroll
                for (int bj = 0; bj < 2; ++bj) rr[ai][m][bj] = __builtin_nontemporal_load((const u32x4*)(R + (size_t)(row0 + ai * HALF + m * 16) * 1024 + col0 + bj * HALF));
#pragma unroll
        for (int ai = 0; ai < 2; ++ai)
#pragma unroll
            for (int m = 0; m < 4; ++m) { const size_t off = (size_t)(row0 + ai * HALF + m * 16) * 1024 + col0;
#pragma unroll
                for (int bj = 0; bj < 2; ++bj) { const u32x4 r = rr[ai][m][bj]; const f32x4 v0 = acc[ai][bj][m][0], v1 = acc[ai][bj][m][1];
                    u32x4 w; w.x = pk_bf16(bf_lo(r[0]) * ALPHA + v0[0], bf_hi(r[0]) * ALPHA + v0[1]); w.y = pk_bf16(bf_lo(r[1]) * ALPHA + v0[2], bf_hi(r[1]) * ALPHA + v0[3]);
                    w.z = pk_bf16(bf_lo(r[2]) * ALPHA + v1[0], bf_hi(r[2]) * ALPHA + v1[1]); w.w = pk_bf16(bf_lo(r[3]) * ALPHA + v1[2], bf_hi(r[3]) * ALPHA + v1[3]);
                    *(u32x4*)(O + off + bj * HALF) = w; } }
    }
};
template <bool F8> struct EpiSwiglu {
    static constexpr bool PERM = true; static constexpr int NST = F8 ? 8 : 8;
    void* Ov; const float* bias; float ascale;
    __device__ __forceinline__ void operator()(const f32x4 (&acc)[2][2][4][2], const Unit& u, int wr, int wc, int fr, int fq) const {
        const int row0 = u.row0 + wr * 64 + fr, oc = (u.col0 >> 1) + wc * 32 + 8 * fq;
        const float* bp = bias + (size_t)u.e * 2048 + oc;
        f32x4 bg[2], bu[2];
#pragma unroll
        for (int n = 0; n < 2; ++n) { bg[n] = *(const f32x4*)(bp + 4 * n); bu[n] = *(const f32x4*)(bp + 1024 + 4 * n); }
#pragma unroll
        for (int ai = 0; ai < 2; ++ai)
#pragma unroll
            for (int m = 0; m < 4; ++m) {
                float o[8];
#pragma unroll
                for (int n = 0; n < 2; ++n) { const f32x4 g4 = acc[ai][0][m][n] * ascale + bg[n], u4 = acc[ai][1][m][n] * ascale + bu[n];
#pragma unroll
                    for (int j = 0; j < 4; ++j) { const float g = fminf(g4[j], 7.0f), up = __builtin_amdgcn_fmed3f(u4[j], -7.0f, 7.0f);
                        constexpr float OS = F8 ? A8_SCALE : 1.0f;
                        const float e = __builtin_amdgcn_exp2f(-1.702f * LOG2E * g), glu = g * __builtin_amdgcn_rcpf(__builtin_fmaf(e, 1.0f / OS, 1.0f / OS)); o[4 * n + j] = __builtin_fmaf(up, glu, glu); } }
                if constexpr (F8) {
                    int w0 = 0, w1 = 0; w0 = __builtin_amdgcn_cvt_pk_fp8_f32(o[0], o[1], w0, false); w0 = __builtin_amdgcn_cvt_pk_fp8_f32(o[2], o[3], w0, true);
                    w1 = __builtin_amdgcn_cvt_pk_fp8_f32(o[4], o[5], w1, false); w1 = __builtin_amdgcn_cvt_pk_fp8_f32(o[6], o[7], w1, true);
                    *(u32x2*)((unsigned char*)Ov + (size_t)(row0 + ai * HALF + m * 16) * 1024 + oc) = (u32x2){(unsigned)w0, (unsigned)w1}; }
                else { u32x4 w; w.x = pk_bf16(o[0], o[1]); w.y = pk_bf16(o[2], o[3]); w.z = pk_bf16(o[4], o[5]); w.w = pk_bf16(o[6], o[7]);
                    *(u32x4*)((bf16_t*)Ov + (size_t)(row0 + ai * HALF + m * 16) * 1024 + oc) = w; } }
    }
};
struct EpiBiasBf16 {
    static constexpr bool PERM = true; static constexpr int NST = 16;
    bf16_t* O; const float* bias; float ascale;
    __device__ __forceinline__ void operator()(const f32x4 (&acc)[2][2][4][2], const Unit& u, int wr, int wc, int fr, int fq) const {
        const int row0 = u.row0 + wr * 64 + fr, col0 = u.col0 + wc * 32 + 8 * fq;
        const float* bp = bias + (size_t)u.e * 1024 + col0;
        f32x4 bv[2][2];
#pragma unroll
        for (int bj = 0; bj < 2; ++bj)
#pragma unroll
            for (int n = 0; n < 2; ++n) bv[bj][n] = *(const f32x4*)(bp + bj * HALF + 4 * n);
#pragma unroll
        for (int ai = 0; ai < 2; ++ai)
#pragma unroll
            for (int m = 0; m < 4; ++m) { bf16_t* rowp = O + (size_t)(row0 + ai * HALF + m * 16) * 1024 + col0;
#pragma unroll
                for (int bj = 0; bj < 2; ++bj) { const f32x4 v0 = acc[ai][bj][m][0] * ascale + bv[bj][0], v1 = acc[ai][bj][m][1] * ascale + bv[bj][1];
                    u32x4 w; w.x = pk_bf16(v0[0], v0[1]); w.y = pk_bf16(v0[2], v0[3]); w.z = pk_bf16(v1[0], v1[1]); w.w = pk_bf16(v1[2], v1[3]);
                    *(u32x4*)(rowp + bj * HALF) = w; } }
    }
};
}


#ifndef ATT_EN
#define ATT_EN 7
#endif
#ifndef PROBE
#define PROBE (-1)
#endif
#define PREP(k) _Pragma("unroll 1") for (int _rp = ((PROBE == (k)) ? 0 : 1); _rp < 2; ++_rp)
typedef float f32x16 __attribute__((ext_vector_type(16)));
#define MFMA32(a, b, c) __builtin_amdgcn_mfma_f32_32x32x16_f16((a), (b), (c), 0, 0, 0)
constexpr float ATT_THR = 8.0f;
constexpr int ATT_KB = 8192;
#define NEG_INF_F (-__builtin_huge_valf())

template <int MODE>
__device__ __forceinline__ void attn_unit(LAS unsigned char* lds, const bf16_t* HQ, const bf16_t* VT, bf16_t* MIX, const unsigned long long* MASK, float* OA1,
                                          const int b, const int h, const int qt, const int wave_in, const int lane_unused,
                                          const float lam, const float lam_init, const float* subg, const float* relb) {
    int wave = wave_in; asm volatile("" : "+s"(wave));
    constexpr int NPASS = (MODE == 0) ? 2 : 1;
    constexpr int EB = (MODE == 0) ? 4 : 2;
    constexpr int NLV = EB / 2;
    constexpr int SLOTB = ATT_KB + EB * 32 * 128;
    constexpr int XOFF = 3 * SLOTB;
    const int qoff = (MODE == 0) ? HQ_QA + h * 128 : (MODE == 1) ? HQ_QB + h * 64 : HQ_QC + h * 64;
    const int koff = (MODE == 0) ? HQ_KA + h * 128 : (MODE == 1) ? HQ_KB + h * 64 : HQ_KC + h * 64;
    const int vrow0 = (MODE == 0) ? VT_A + h * 128 : (MODE == 1) ? VT_B + h * 64 : VT_C + h * 64;
    const int mixcol = (MODE == 0) ? h * 128 : (MODE == 1) ? 512 + h * 64 : 768 + h * 64;
    int lane; asm volatile("v_mbcnt_lo_u32_b32 %0, -1, 0\n\tv_mbcnt_hi_u32_b32 %0, -1, %0" : "=&v"(lane));
    const int tid = wave * 64 + lane, ql = lane & 31, hb = lane >> 5;
    const int cq = qt * 4 + (wave >> 1);
    const int tq = qt * 256 + wave * 32 + ql;
    const int kt_hi = qt * 4 + 3;
    const int kt_lo = (MODE == 1) ? ((qt * 4 - 8) > 0 ? (qt * 4 - 8) : 0) : 0;
    const int ntile = kt_hi - kt_lo + 1;
    const float slope2 = (MODE == 0) ? exp2f(-(float)(2 * h + 1)) * LOG2E : exp2f(-(float)(2 * h + 2)) * LOG2E;
    LAS float* relb_l = (LAS float*)(lds + XOFF);
    float so[16];
#pragma unroll
    for (int i = 0; i < 16; ++i) { int oi = 16 * (i >> 3) + (i & 7); asm volatile("" : "+s"(oi));
        so[i] = __int_as_float(__builtin_amdgcn_readfirstlane(__float_as_int(slope2 * (float)oi))); }
    const int prow = (ql & 16) | ((ql & 4) << 1) | ((ql & 8) >> 1) | (ql & 3);
    const int kt_x = (hb ^ ((prow >> 1) & 7)) << 4, vt_x = (hb ^ ((ql >> 1) & 7)) << 4;
    const int krd = prow * 128, vrd = ATT_KB + ql * 128;
    const int drow = lane >> 3, dpos = lane & 7;
    const int krow_g = 8 * wave + drow;
    const size_t ksrc = ((size_t)(b * SEQ + krow_g) * HQP + koff + ((dpos ^ ((krow_g >> 1) & 7)) << 3)) * 2;
    size_t vsrc[NLV];
#pragma unroll
    for (int j = 0; j < NLV; ++j) { const int vr = 8 * (wave + 8 * j) + drow; vsrc[j] = ((size_t)(vrow0 + vr) * T + (size_t)b * SEQ + ((dpos ^ ((vr >> 1) & 7)) << 3)) * 2; }

#pragma unroll 1
    for (int mp = 0; mp < NPASS; ++mp) {
#define ATT_ISSUE(kt_, slot_) do { \
        __builtin_amdgcn_global_load_lds((const unsigned*)((const char*)HQ + ksrc + (size_t)(kt_) * (64 * HQP * 2) + mp * 128), (LAS unsigned*)(lds + (slot_) * SLOTB + wave * 1024), 16, 0, 0); \
        _Pragma("unroll") for (int j = 0; j < NLV; ++j) \
            __builtin_amdgcn_global_load_lds((const unsigned*)((const char*)VT + vsrc[j] + (size_t)(kt_) * 128), (LAS unsigned*)(lds + (slot_) * SLOTB + ATT_KB + (wave + 8 * j) * 1024), 16, 0, 0); } while (0)
        asm volatile("s_waitcnt vmcnt(0)" ::: "memory");
        __syncthreads();
        ATT_ISSUE(kt_hi, 0);
        ATT_ISSUE((ntile > 1 ? kt_hi - 1 : kt_hi), 1);
        if (MODE == 1 && mp == 0) { for (int i = tid; i < 320; i += 512) relb_l[i] = relb[i < 256 ? i : 256] * LOG2E; }
        if (MODE == 2) {
#pragma unroll
            for (int i = 0; i < 8; ++i) { const int q = wave * 32 + i * 4 + (lane >> 4), p = lane & 15;
                __builtin_amdgcn_global_load_lds((const unsigned*)((const char*)MASK + ((size_t)(b * SEQ + qt * 256 + q) * 32 + (((p - q) & 15) << 1)) * 8),
                                                 (LAS unsigned*)(lds + XOFF + (wave * 32 + i * 4) * 256), 16, 0, 0); }
        }
        bf16x8 Q[4];
        { const bf16_t* qp = HQ + (size_t)(b * SEQ + tq) * HQP + qoff + mp * 64 + hb * 8;
#pragma unroll
          for (int ks = 0; ks < 4; ++ks) Q[ks] = *(const bf16x8*)(qp + ks * 16); }
        asm volatile("" : "+v"(Q[0]), "+v"(Q[1]), "+v"(Q[2]), "+v"(Q[3]));
        f32x16 O[EB];
        float mref = 0.f, seen = 0.f, lrun = 0.f;
#pragma unroll
        for (int eb = 0; eb < EB; ++eb)
#pragma unroll
            for (int i = 0; i < 16; ++i) O[eb][i] = 0.f;
        asm volatile("s_waitcnt lgkmcnt(0)" ::: "memory");
        int slot = 0;
        for (int jt = 0; jt < ntile; ++jt) {
            const int kt = kt_hi - jt;
            if constexpr (MODE == 0) asm volatile("s_waitcnt vmcnt(3)" ::: "memory"); else asm volatile("s_waitcnt vmcnt(2)" ::: "memory");
            __builtin_amdgcn_s_barrier();
            { const int nj = jt + 2 < ntile ? jt + 2 : ntile - 1; int ns = slot + 2; ns = ns >= 3 ? ns - 3 : ns; ATT_ISSUE(kt_hi - nj, ns); }
            const bool active = (kt <= cq) && (MODE != 1 || kt >= cq - 8);
            if (active) {
                const LAS unsigned char* kbp = lds + slot * SLOTB + krd;
                const LAS unsigned char* vbp = lds + slot * SLOTB + vrd;
                f32x16 S0, S1;
                if (MODE == 0 || MODE == 2) {
                    const float base0 = (float)(tq - kt * 64 - 8 * hb);
                    if (kt == cq) {
#pragma unroll
                        for (int i = 0; i < 16; ++i) { const float off = (float)(16 * (i >> 3) + (i & 7));
                            S0[i] = -slope2 * fabsf(base0 - off) - mref; S1[i] = -slope2 * fabsf(base0 - 32.0f - off) - mref; }
                    } else {
                        const float c0 = -slope2 * base0 - mref, c1 = c0 + 32.0f * slope2;
#pragma unroll
                        for (int i = 0; i < 16; ++i) { S0[i] = so[i] + c0; S1[i] = so[i] + c1; }
                    }
                }
                if (MODE == 2) {
                    const int mq = wave * 32 + ql; const unsigned long long W = *(const LAS unsigned long long*)(lds + XOFF + mq * 256 + ((((kt >> 1) + mq) & 15) << 4) + ((kt & 1) << 3));
                    const unsigned w0 = (unsigned)W >> (8 * hb), w1 = (unsigned)(W >> 32) >> (8 * hb);
#pragma unroll
                    for (int i = 0; i < 16; ++i) { const int off = 16 * (i >> 3) + (i & 7);
                        const int m0 = __builtin_amdgcn_sbfe((int)w0, off, 1), m1 = __builtin_amdgcn_sbfe((int)w1, off, 1);
                        S0[i] = __int_as_float((__float_as_int(S0[i]) & m0) | ((int)0xFF800000 & ~m0)); S1[i] = __int_as_float((__float_as_int(S1[i]) & m1) | ((int)0xFF800000 & ~m1)); }
                }
                if (MODE == 1) {
                    if (kt >= cq - 2) {
                        const int rel0 = tq - kt * 64 - 8 * hb + 128;
#pragma unroll
                        for (int i = 0; i < 16; ++i) { const int off = 16 * (i >> 3) + (i & 7);
                            S0[i] = relb_l[rel0 - off] - mref; S1[i] = relb_l[rel0 - 32 - off] - mref; }
                    } else {
                        const float far = relb_l[256] - mref;
#pragma unroll
                        for (int i = 0; i < 16; ++i) { S0[i] = far; S1[i] = far; }
                    }
                }
                bf16x8 kf[8], vf0[8];
#pragma unroll
                for (int ks = 0; ks < 4; ++ks) { kf[2 * ks] = *(const LAS bf16x8*)(kbp + ((ks << 5) ^ kt_x)); kf[2 * ks + 1] = *(const LAS bf16x8*)(kbp + 4096 + ((ks << 5) ^ kt_x)); }
#pragma unroll
                for (int i = 0; i < 8; ++i) { const int s4i = i / EB, eb = i % EB; vf0[i] = *(const LAS bf16x8*)(vbp + eb * 4096 + ((s4i << 5) ^ vt_x)); }
#pragma unroll
                for (int ks = 0; ks < 4; ++ks) { S0 = MFMA32(kf[2 * ks], Q[ks], S0); S1 = MFMA32(kf[2 * ks + 1], Q[ks], S1); }
                __builtin_amdgcn_sched_group_barrier(0x100, 16, 0); __builtin_amdgcn_sched_group_barrier(0x008, 8, 0);
                float mx; asm("s_nop 15\n\ts_nop 3\n\tv_max3_f32 %0, %1, %2, %3" : "=v"(mx) : "v"(S0[0]), "v"(S1[0]), "v"(S0[1]));
                asm("v_max3_f32 %0, %1, %2, %3" : "=v"(mx) : "v"(mx), "v"(S1[1]), "v"(S0[2]));
#pragma unroll
                for (int i = 2; i < 15; ++i) asm("v_max3_f32 %0, %1, %2, %3" : "=v"(mx) : "v"(mx), "v"(S1[i]), "v"(S0[i + 1]));
                asm("v_max_f32 %0, %1, %2" : "=v"(mx) : "v"(mx), "v"(S1[15]));
                mx = fmaxf(mx, shx(mx, 32, lane));
                const bool unseen = !(seen > 0.f), finite = mx > -1e30f;
                const bool need = unseen ? finite : (mx > ATT_THR);
                if (__ballot(unseen ? finite : (mx >= -36.0f)) != 0ull) {
                    if (__ballot(need) != 0ull) {
                        const float d = need ? mx : 0.f;
                        mref += d; seen = (unseen && finite) ? 1.f : seen;
                        const float alpha = unseen ? 1.0f : __builtin_amdgcn_exp2f(-d);
                        lrun *= alpha;
#pragma unroll
                        for (int eb = 0; eb < EB; ++eb) O[eb] = O[eb] * alpha;
#pragma unroll
                        for (int i = 0; i < 16; ++i) { S0[i] -= d; S1[i] -= d; }
                    }
                    float ps = 0.f;
#pragma unroll
                    for (int i = 0; i < 16; ++i) { S0[i] = __builtin_amdgcn_exp2f(S0[i]); S1[i] = __builtin_amdgcn_exp2f(S1[i]); ps += S0[i] + S1[i]; }
                    lrun += ps;
                    bf16x8 P[4];
                    { u32x4 p;
                      p.x = pk_bf16(S0[0], S0[1]); p.y = pk_bf16(S0[2], S0[3]); p.z = pk_bf16(S0[4], S0[5]); p.w = pk_bf16(S0[6], S0[7]); P[0] = __builtin_bit_cast(bf16x8, p);
                      p.x = pk_bf16(S0[8], S0[9]); p.y = pk_bf16(S0[10], S0[11]); p.z = pk_bf16(S0[12], S0[13]); p.w = pk_bf16(S0[14], S0[15]); P[1] = __builtin_bit_cast(bf16x8, p);
                      p.x = pk_bf16(S1[0], S1[1]); p.y = pk_bf16(S1[2], S1[3]); p.z = pk_bf16(S1[4], S1[5]); p.w = pk_bf16(S1[6], S1[7]); P[2] = __builtin_bit_cast(bf16x8, p);
                      p.x = pk_bf16(S1[8], S1[9]); p.y = pk_bf16(S1[10], S1[11]); p.z = pk_bf16(S1[12], S1[13]); p.w = pk_bf16(S1[14], S1[15]); P[3] = __builtin_bit_cast(bf16x8, p); }
                    if constexpr (EB == 4) {
                        bf16x8 vf1[8];
#pragma unroll
                        for (int i = 0; i < 8; ++i) { const int s4i = 2 + i / EB, eb = i % EB; vf1[i] = *(const LAS bf16x8*)(vbp + eb * 4096 + ((s4i << 5) ^ vt_x)); }
#pragma unroll
                        for (int i = 0; i < 8; ++i) { const int s4i = i / EB, eb = i % EB; O[eb] = MFMA32(vf0[i], P[s4i], O[eb]); }
#pragma unroll
                        for (int i = 0; i < 8; ++i) { const int s4i = 2 + i / EB, eb = i % EB; O[eb] = MFMA32(vf1[i], P[s4i], O[eb]); }
                        __builtin_amdgcn_sched_group_barrier(0x100, 8, 0); __builtin_amdgcn_sched_group_barrier(0x008, 16, 0);
                    } else {
#pragma unroll
                        for (int i = 0; i < 8; ++i) { const int s4i = i / EB, eb = i % EB; O[eb] = MFMA32(vf0[i], P[s4i], O[eb]); }
                    }
                }
            }
            slot = slot == 2 ? 0 : slot + 1;
        }
#undef ATT_ISSUE
        const float inv = 1.0f / (lrun + shx(lrun, 32, lane));
        bf16_t* op = MIX + (size_t)(b * SEQ + tq) * 1024 + mixcol + 4 * hb;
        if (MODE == 0) {
            bf16_t* o1p = (bf16_t*)OA1 + (size_t)(b * SEQ + tq) * 512 + h * 128 + 4 * hb;
            if (mp == 0) {
#pragma unroll
                for (int eb = 0; eb < EB; ++eb)
#pragma unroll
                    for (int g = 0; g < 4; ++g) *(u32x2*)(o1p + eb * 32 + 8 * g) = (u32x2){pk_bf16(O[eb][4 * g] * inv, O[eb][4 * g + 1] * inv), pk_bf16(O[eb][4 * g + 2] * inv, O[eb][4 * g + 3] * inv)};
            } else {
                const float c2 = lam * inv;
                float ss = 0.f;
#pragma unroll
                for (int eb = 0; eb < EB; ++eb)
#pragma unroll
                    for (int g = 0; g < 4; ++g) { const u32x2 o1h = *(const u32x2*)(o1p + eb * 32 + 8 * g); const f32x4 o1 = {bf_lo(o1h[0]), bf_hi(o1h[0]), bf_lo(o1h[1]), bf_hi(o1h[1])};
#pragma unroll
                        for (int j = 0; j < 4; ++j) { const float o = o1[j] - O[eb][4 * g + j] * c2; O[eb][4 * g + j] = o; ss += o * o; } }
                ss += shx(ss, 32, lane);
                const float r = rsqrtf(ss * (1.0f / 128.0f) + EPS) * (1.0f - lam_init);
#pragma unroll
                for (int eb = 0; eb < EB; ++eb)
#pragma unroll
                    for (int g = 0; g < 4; ++g) { const int e0 = eb * 32 + 8 * g;
                        *(u32x2*)(op + e0) = (u32x2){pk_bf16(O[eb][4 * g] * r, O[eb][4 * g + 1] * r), pk_bf16(O[eb][4 * g + 2] * r, O[eb][4 * g + 3] * r)}; }
            }
        } else {
#pragma unroll
            for (int eb = 0; eb < EB; ++eb)
#pragma unroll
                for (int g = 0; g < 4; ++g) { const int e0 = eb * 32 + 8 * g;
                    *(u32x2*)(op + e0) = (u32x2){pk_bf16(O[eb][4 * g] * inv, O[eb][4 * g + 1] * inv), pk_bf16(O[eb][4 * g + 2] * inv, O[eb][4 * g + 3] * inv)}; }
        }
    }
}


constexpr int IDX_STR = 2052;
__device__ __forceinline__ unsigned f2key(float f) { const unsigned u = __float_as_uint(f); return u ^ (((unsigned)((int)u >> 31)) | 0x80000000u); }
template <int J>
__device__ __forceinline__ void index_select(const LAS float* row, const int nb, const int lane, unsigned long long* mo) {
    unsigned u[J];
#pragma unroll
    for (int j = 0; j < J; ++j) u[j] = (j < nb) ? f2key(row[64 * j]) : 0u;
    unsigned prefix = 0u; bool exact = false;
#pragma unroll 1
    for (int bit = 31; bit >= 0; --bit) {
        const unsigned cand = prefix | (1u << bit);
        int c = 0;
#pragma unroll
        for (int j0 = 0; j0 < J; j0 += 8) {
            unsigned long long bm[8];
#pragma unroll
            for (int j = 0; j < 8; ++j) bm[j] = __ballot(u[j0 + j] >= cand);
            asm volatile("" : "+s"(bm[0]), "+s"(bm[1]), "+s"(bm[2]), "+s"(bm[3]), "+s"(bm[4]), "+s"(bm[5]), "+s"(bm[6]), "+s"(bm[7]));
#pragma unroll
            for (int j = 0; j < 8; ++j) c += (int)__builtin_popcountll(bm[j]);
        }
        if (c >= 256) prefix = cand;
        if (c == 256) { exact = true; break; }
    }
    unsigned thr = prefix; asm volatile("" : "+v"(thr));
    unsigned long long myword = 0ull;
    if (exact) {
#pragma unroll
        for (int j = 0; j < J; ++j) { const unsigned long long m = __ballot(u[j] >= thr); myword = (lane == j) ? m : myword; }
    } else {
        int cg = 0;
#pragma unroll
        for (int j = 0; j < J; ++j) cg += (int)__builtin_popcountll(__ballot(u[j] > thr));
        const int quota = 256 - cg;
        int taken = 0;
#pragma unroll
        for (int j = 0; j < J; ++j) {
            const bool eq = (u[j] == thr);
            const unsigned long long eqm = __ballot(eq);
            const int before = (int)__builtin_popcountll(eqm & ((1ull << lane) - 1ull));
            const unsigned long long m = __ballot((u[j] > thr) || (eq && (taken + before < quota)));
            taken += (int)__builtin_popcountll(eqm);
            myword = (lane == j) ? m : myword;
        }
    }
    if (lane < 32) mo[lane] = myword;
}
__device__ __forceinline__ void index_unit(LAS unsigned char* lds, const bf16_t* HQ, unsigned long long* MASK, const int b, const int tt, const int wave_in) {
    int wave = wave_in; asm volatile("" : "+s"(wave));
    int lane; asm volatile("v_mbcnt_lo_u32_b32 %0, -1, 0\n\tv_mbcnt_hi_u32_b32 %0, -1, %0" : "=&v"(lane));
    const int t0 = tt * 16, nb = (t0 >> 6) + 1, nk = nb * 64;
    if (nb <= 4) {
        for (int i = wave * 64 + lane; i < 16 * 32; i += 512) MASK[(size_t)(b * SEQ + t0 + (i >> 5)) * 32 + (i & 31)] = ((i & 31) < nb) ? ~0ull : 0ull;
        return;
    }
    LAS float* sc = (LAS float*)lds;
    const int q = lane & 15, g = lane >> 4;
    {
        const bf16_t* qrow = HQ + (size_t)(b * SEQ + t0 + q) * HQP;
        bf16x8 QI[8];
#pragma unroll
        for (int h = 0; h < 8; ++h) QI[h] = *(const bf16x8*)(qrow + HQ_QI + h * 32 + g * 8);
        float w[8];
        { const u32x4 wv = *(const u32x4*)(qrow + HQ_WI);
          w[0] = bf_lo(wv[0]) * 0.0625f; w[1] = bf_hi(wv[0]) * 0.0625f; w[2] = bf_lo(wv[1]) * 0.0625f; w[3] = bf_hi(wv[1]) * 0.0625f;
          w[4] = bf_lo(wv[2]) * 0.0625f; w[5] = bf_hi(wv[2]) * 0.0625f; w[6] = bf_lo(wv[3]) * 0.0625f; w[7] = bf_hi(wv[3]) * 0.0625f; }
        const bf16_t* kbase = HQ + (size_t)(b * SEQ + q) * HQP + HQ_KI + g * 8;
        for (int kb0 = wave; kb0 < nk / 16; kb0 += 32) {
            bf16x8 kf[4];
#pragma unroll
            for (int u = 0; u < 4; ++u) { const int kb = kb0 + 8 * u; kf[u] = (kb < nk / 16) ? *(const bf16x8*)(kbase + (size_t)kb * 16 * HQP) : (bf16x8){0, 0, 0, 0, 0, 0, 0, 0}; }
#pragma unroll
            for (int u = 0; u < 4; ++u) {
                const int kb = kb0 + 8 * u;
                if (kb < nk / 16) {
                    f32x4 acc = {0.f, 0.f, 0.f, 0.f};
#pragma unroll
                    for (int h = 0; h < 8; ++h) {
                        const f32x4 z = __builtin_amdgcn_mfma_f32_16x16x32_f16(kf[u], QI[h], (f32x4){0.f, 0.f, 0.f, 0.f}, 0, 0, 0);
#pragma unroll
                        for (int j = 0; j < 4; ++j) acc[j] = fmaf(w[h], fmaxf(z[j], 0.f), acc[j]);
                    }
#pragma unroll
                    for (int j = 0; j < 4; ++j) acc[j] += 0.0f;
                    *(LAS f32x4*)(sc + q * IDX_STR + kb * 16 + g * 4) = acc;
                }
            }
        }
    }
    __syncthreads();
#pragma unroll 1
    for (int qq = 0; qq < 2; ++qq) {
        const int ql = wave * 2 + qq;
        const LAS float* row = sc + ql * IDX_STR + lane;
        unsigned long long* mo = MASK + (size_t)(b * SEQ + t0 + ql) * 32;
        if (nb <= 8) index_select<8>(row, nb, lane, mo);
        else if (nb <= 16) index_select<16>(row, nb, lane, mo);
        else if (nb <= 24) index_select<24>(row, nb, lane, mo);
        else index_select<32>(row, nb, lane, mo);
    }
    __syncthreads();
}

__device__ __forceinline__ int att_order(const int i) {
    const unsigned long long t = (i < 8) ? 0x1D13161A171E1B1Full : (i < 16) ? 0x14150E0F18191C12ull : (i < 24) ? 0x08090C0D0A0B1011ull : 0x0001020304050607ull;
    return (int)((t >> ((i & 7) * 8)) & 0xffull);
}

struct Args {
    const float* x; const float* w_in; const float* lam_q1; const float* lam_k1; const float* lam_q2; const float* lam_k2; const float* subln_g; const float* rel_bias;
    const float* w_out; const float* ln1_g; const float* ln1_b; const float* w_router; const float* b_router; const float* w_gu; const float* b_gu;
    const float* w_down; const float* b_down; const float* ln2_g; const float* ln2_b;
    float* out; unsigned char* ws;
    int ph_lo, ph_hi, bar_region, pad;
};

constexpr int LDS_STAGE = 0;
constexpr int LDS_CTL = 135168;
constexpr int LDS_TSTART = LDS_CTL + 64;
constexpr int LDS_CNT = LDS_TSTART + 36 * 4;
constexpr int LDS_TILEE = LDS_CNT + 32 * 4;
constexpr int LDS_RT = LDS_TILEE + 576;
constexpr int LDS_GB = 147456;
constexpr int LDS_BYTES = 147456 + 8192;
static_assert(LDS_RT + (64 + 1024) * 4 <= LDS_BYTES && 16 * IDX_STR * 4 <= LDS_CTL, "LDS map");

__device__ __forceinline__ void transpose_item(const float* W, int N, int k0, int n0, int nvalid, bf16_t* WTrow0, float scale, LAS float* scr, int lane, const float* kgain = nullptr) {
#pragma unroll
    for (int i = 0; i < 32; ++i) { const int kk = 2 * i + (lane >> 5), col = lane & 31; scr[kk * 33 + col] = (col < nvalid) ? W[(size_t)(k0 + kk) * N + n0 + col] * (kgain ? scale * kgain[kk] : scale) : 0.f; }
    asm volatile("s_waitcnt lgkmcnt(0)" ::: "memory");
    const int c = lane & 7;
#pragma unroll
    for (int j = 0; j < 4; ++j) { const int n = (lane >> 3) + 8 * j; const LAS float* s = scr + (8 * c) * 33 + n;
        u32x4 o; o.x = pk_bf16(s[0 * 33], s[1 * 33]); o.y = pk_bf16(s[2 * 33], s[3 * 33]); o.z = pk_bf16(s[4 * 33], s[5 * 33]); o.w = pk_bf16(s[6 * 33], s[7 * 33]);
        if (n < nvalid) *(u32x4*)(WTrow0 + (size_t)n * 1024 + k0 + 8 * c) = o; }
    asm volatile("s_waitcnt lgkmcnt(0)" ::: "memory");
}
__device__ __forceinline__ void transpose_item_fp8(const float* W, int N, int k0, int n0, unsigned char* WTrow0, float scale, int lane) {
    const int rg = lane >> 4, cg = lane & 15;
    const float* src = W + (size_t)(k0 + 32 * rg) * N + n0 + 4 * cg;
    f32x4 v[32];
#pragma unroll
    for (int i = 0; i < 32; ++i) v[i] = __builtin_nontemporal_load((const f32x4*)(src + (size_t)i * N));
    unsigned char* dst = WTrow0 + (size_t)(4 * cg) * 1024 + k0 + 32 * rg;
#pragma unroll
    for (int j = 0; j < 4; ++j) {
#pragma unroll
        for (int h = 0; h < 2; ++h) {
            u32x4 o;
            o.x = pk4_fp8(v[16 * h + 0][j] * scale, v[16 * h + 1][j] * scale, v[16 * h + 2][j] * scale, v[16 * h + 3][j] * scale);
            o.y = pk4_fp8(v[16 * h + 4][j] * scale, v[16 * h + 5][j] * scale, v[16 * h + 6][j] * scale, v[16 * h + 7][j] * scale);
            o.z = pk4_fp8(v[16 * h + 8][j] * scale, v[16 * h + 9][j] * scale, v[16 * h + 10][j] * scale, v[16 * h + 11][j] * scale);
            o.w = pk4_fp8(v[16 * h + 12][j] * scale, v[16 * h + 13][j] * scale, v[16 * h + 14][j] * scale, v[16 * h + 15][j] * scale);
            *(u32x4*)(dst + (size_t)j * 1024 + 16 * h) = o;
        }
    }
}
__device__ __forceinline__ void in_map(int n0, bool& isv, int& row, float& scale) {
    scale = 1.f; isv = false;
    if (n0 < 512) { row = HQ_QA + n0; scale = QSCALE; }
    else if (n0 < 1024) row = HQ_KA + (n0 - 512);
    else if (n0 < 1536) { isv = true; row = VT_A + (n0 - 1024); }
    else if (n0 < 1792) { row = HQ_QB + (n0 - 1536); scale = QSCALE; }
    else if (n0 < 2048) row = HQ_KB + (n0 - 1792);
    else if (n0 < 2304) { isv = true; row = VT_B + (n0 - 2048); }
    else if (n0 < 2560) { row = HQ_QC + (n0 - 2304); scale = QSCALE; }
    else if (n0 < 2816) row = HQ_KC + (n0 - 2560);
    else if (n0 < 3072) { isv = true; row = VT_C + (n0 - 2816); }
    else if (n0 < 3328) row = HQ_QI + (n0 - 3072);
    else if (n0 < 3360) row = HQ_KI + (n0 - 3328);
    else row = HQ_WI + (n0 - 3360);
}

__global__ void __launch_bounds__(512, 2) mega(Args a) {
    extern __shared__ __attribute__((aligned(16))) unsigned char lds_raw[];
    LAS unsigned char* lds = (LAS unsigned char*)lds_raw;
    const int G = gridDim.x, bid = blockIdx.x, NGW = G * 8;
    const int wave0 = __builtin_amdgcn_readfirstlane((int)threadIdx.x >> 6);
#define OPAQUE_IDS() int wave = wave0; asm volatile("" : "+s"(wave)); int lane; asm volatile("v_mbcnt_lo_u32_b32 %0, -1, 0\n\tv_mbcnt_hi_u32_b32 %0, -1, %0" : "=&v"(lane)); const int tid = wave * 64 + lane, gw = bid * 8 + wave; (void)tid; (void)gw
#define WSPTRS() __attribute__((address_space(1))) unsigned char* wsg_ = (__attribute__((address_space(1))) unsigned char*)a.ws; asm volatile("" : "+s"(wsg_)); unsigned char* ws = (unsigned char*)wsg_;     \
    unsigned* ctl = (unsigned*)(ws + WS_CTL); bf16_t* Win = (bf16_t*)(ws + WS_WIN); bf16_t* Wv = (bf16_t*)(ws + WS_WV); bf16_t* Wout = (bf16_t*)(ws + WS_WOUT); \
    bf16_t* Wgu = (bf16_t*)(ws + WS_WGU); bf16_t* Wdn = (bf16_t*)(ws + WS_WDN); bf16_t* XB = (bf16_t*)(ws + WS_XB); \
    bf16_t* HQ = (bf16_t*)(ws + WS_HQ); bf16_t* VT = (bf16_t*)(ws + WS_VT); bf16_t* MIX = (bf16_t*)(ws + WS_MIX); \
    bf16_t* Y1B = (bf16_t*)(ws + WS_Y1); bf16_t* X1B = (bf16_t*)(ws + WS_X1B); bf16_t* ACT = (bf16_t*)(ws + WS_ACT); bf16_t* YR = (bf16_t*)(ws + WS_YR); \
    int* TOKL = (int*)(ws + WS_TOKL); int* ASGE = (int*)(ws + WS_ASGE); int* ASGS = (int*)(ws + WS_ASGS); float* GATE = (float*)(ws + WS_GATE); \
    (void)ctl; (void)Win; (void)Wv; (void)Wout; (void)Wgu; (void)Wdn; (void)XB; (void)HQ; (void)VT; (void)MIX; (void)Y1B; (void)X1B; (void)ACT; (void)YR; (void)TOKL; (void)ASGE; (void)ASGS; (void)GATE
    for (int u = threadIdx.x; u < (LDS_BYTES - LDS_CTL) / 4; u += 512) ((LAS unsigned*)(lds + LDS_CTL))[u] = 0u;
    __syncthreads();
    XcdBarrier bar = xcd_barrier_post((unsigned*)(a.ws + WS_CTL) + CW_BAR + a.bar_region * XCD_BAR_WORDS, (volatile LAS unsigned*)(lds + LDS_CTL));
    const int lo = a.ph_lo, hi = a.ph_hi;
#define IN(k) (lo <= (k) && (k) < hi)
#define SEAM(k) do { if (IN(k) && IN((k) + 1)) xcd_barrier(bar); } while (0)

    if (IN(0)) PREP(0) {
        OPAQUE_IDS(); WSPTRS();
        LAS float* scr = (LAS float*)(lds + LDS_STAGE + wave * 16384);
        #if MOE_FP8
        constexpr int I_IN = 16 * 106, I_OUT = 16 * 32, I_GU = 8 * 32, I_DN = 8 * 16;
#else
        constexpr int I_IN = 16 * 106, I_OUT = 16 * 32, I_GU = 16 * 64, I_DN = 16 * 32;
#endif
        constexpr int N_IN = DEPTH * I_IN, N_OUT = DEPTH * I_OUT, N_GU = DEPTH * NE * I_GU, N_DN = DEPTH * NE * I_DN;
        for (int it = gw; it < N_IN + N_OUT + N_GU + N_DN; it += NGW) {
            int r = it;
            if (r < N_IN) { const int l = r / I_IN, q = r % I_IN, kb = q / 106, nb = q % 106, n0 = nb * 32; bool isv; int row; float sc; in_map(n0, isv, row, sc);
                bf16_t* dst = isv ? Wv + ((size_t)l * 1024 + row) * 1024 : Win + ((size_t)l * HQP + row) * 1024;
                transpose_item(a.w_in + (size_t)l * D * DIN, DIN, kb * 64, n0, (DIN - n0) < 32 ? (DIN - n0) : 32, dst, sc, scr, lane); continue; }
            r -= N_IN;
            if (r < N_OUT) { const int l = r / I_OUT, q = r % I_OUT, kb = q / 32, nb = q % 32;
                transpose_item(a.w_out + (size_t)l * 1024 * D, D, kb * 64, nb * 32, 32, Wout + ((size_t)l * D + nb * 32) * 1024, 1.f, scr, lane, kb < 8 ? a.subln_g + l * 128 + ((kb * 64) & 127) : nullptr); continue; }
            r -= N_OUT;
#if MOE_FP8
            if (r < N_GU) { const int le = r / I_GU, q = r % I_GU, kb = q >> 5, nb = q & 31, n0 = nb * 64;
                const int bj = n0 >> 10, rr = n0 & 1023, pn = rr >> 7, c = rr & 127, nrow = pn * 256 + bj * 128 + c;
                transpose_item_fp8(a.w_gu + (size_t)le * D * 2048, 2048, kb * 128, n0, (unsigned char*)Wgu + ((size_t)le * 2048 + nrow) * 1024, W8_SCALE, lane); continue; }
#else
            if (r < N_GU) { const int le = r / I_GU, q = r % I_GU, kb = q / 64, nb = q % 64, n0 = nb * 32;
                const int bj = n0 >> 10, rr = n0 & 1023, pn = rr >> 7, c = rr & 127, nrow = pn * 256 + bj * 128 + c;
                transpose_item(a.w_gu + (size_t)le * D * 2048, 2048, kb * 64, n0, 32, Wgu + ((size_t)le * 2048 + nrow) * 1024, 1.f, scr, lane); continue; }
#endif
            r -= N_GU;
#if MOE_FP8
            { const int le = r / I_DN, q = r % I_DN, kb = q >> 4, nb = q & 15;
                transpose_item_fp8(a.w_down + (size_t)le * 1024 * D, D, kb * 128, nb * 64, (unsigned char*)Wdn + ((size_t)le * D + nb * 64) * 1024, W8_SCALE, lane); }
#else
            { const int le = r / I_DN, q = r % I_DN, kb = q / 32, nb = q % 32;
                transpose_item(a.w_down + (size_t)le * 1024 * D, D, kb * 64, nb * 32, 32, Wdn + ((size_t)le * D + nb * 32) * 1024, 1.f, scr, lane); }
#endif
        }
        for (int i = gw * 64 + lane; i < DEPTH * (HQP - HQ_USED) * 128; i += NGW * 64) { const int l = i / ((HQP - HQ_USED) * 128), q = i % ((HQP - HQ_USED) * 128);
            *(u32x4*)(Win + ((size_t)l * HQP + HQ_USED) * 1024 + (size_t)q * 8) = (u32x4){0u, 0u, 0u, 0u}; }
        { bf16_t* WRH = (bf16_t*)(ws + WS_WRT); bf16_t* WRL = WRH + (size_t)DEPTH * NE * D;
          for (int i = gw * 64 + lane; i < DEPTH * NE * D; i += NGW * 64) { const int ll = i / (NE * D), r = i % (NE * D), e = r / D, c = r % D; const float w = a.w_router[((size_t)ll * D + c) * NE + e];
              const unsigned h = pk_bf16(w, 0.f) & 0xffffu; WRH[i] = (bf16_t)h; WRL[i] = (bf16_t)(pk_bf16(w - bf_lo(h), 0.f) & 0xffffu); } }
        for (size_t i = (size_t)gw * 64 + lane; i < (size_t)T * D / 8; i += (size_t)NGW * 64) { const f32x4 v0 = *(const f32x4*)(a.x + i * 8), v1 = *(const f32x4*)(a.x + i * 8 + 4);
            u32x4 w; w.x = pk_bf16(v0[0], v0[1]); w.y = pk_bf16(v0[2], v0[3]); w.z = pk_bf16(v1[0], v1[1]); w.w = pk_bf16(v1[2], v1[3]); *(u32x4*)(XB + i * 8) = w; }
    }
    SEAM(0);

#pragma unroll 1
    for (int l = 0; l < DEPTH; ++l) {
        const int pb = 1 + 8 * l;
        if (IN(pb + 0)) PREP(1) {
            WSPTRS();
            pg8::InProjOrder S{G, bid, (const char*)(Win + (size_t)l * HQP * 1024), (const char*)(Wv + (size_t)l * 1024 * 1024), (const char*)XB};
            pg8::EpiInProj E{HQ, VT};
            pg8::gemm_phase<pg8::EpiInProj, pg8::InProjOrder, false>(lds + LDS_STAGE, XB, 1024, S, E, wave0);
        }
        SEAM(pb + 0);
        if (IN(pb + 1)) {
            OPAQUE_IDS(); WSPTRS();
            unsigned long long* MASKp = (unsigned long long*)(ws + WS_MASK); float* OA1p = (float*)(ws + WS_OA1);
            const float lam_init = 0.8f - 0.6f * expf(-0.3f * (float)l);
            const float lam = expf(wsum(a.lam_q1[l * 64 + lane] * a.lam_k1[l * 64 + lane], lane)) - expf(wsum(a.lam_q2[l * 64 + lane] * a.lam_k2[l * 64 + lane], lane)) + lam_init;
            const int v0 = (G % 8 == 0) ? (bid & 7) * (G >> 3) + (bid >> 3) : bid;
            for (int v = v0; v < 256; v += G) {
                const int b = v >> 4, h = (v >> 2) & 3, q0 = v & 3;
#pragma unroll 1
                for (int rep = 0; rep < 2; ++rep) attn_unit<0>(lds + LDS_STAGE, HQ, VT, MIX, MASKp, OA1p, b, rep ? 3 - h : h, rep ? 7 - q0 : q0, wave, lane, lam, lam_init, a.subln_g + l * 128, nullptr);
            }
            {
                const int nq = 1, bq = 16 / nq, qid = 0;
                unsigned* qctr = ctl + CW_Q + ((l * 2 + 0) * 8 + qid) * 32;
                volatile LAS int* qw = (volatile LAS int*)(lds + LDS_CTL + 48);
#pragma unroll 1
                for (;;) {
                    __syncthreads();
                    if (tid == 0) *qw = (int)__hip_atomic_fetch_add(qctr, 1u, __ATOMIC_RELAXED, __HIP_MEMORY_SCOPE_AGENT);
                    __syncthreads();
                    const int u = __builtin_amdgcn_readfirstlane(*qw);
                    if (u >= 128 * bq) break;
                    index_unit(lds + LDS_STAGE, HQ, MASKp, qid * bq + (u % bq), 127 - u / bq, wave);
                }
            }
        }
        SEAM(pb + 1);
        if (IN(pb + 2)) {
            OPAQUE_IDS(); WSPTRS();
            unsigned long long* MASKp = (unsigned long long*)(ws + WS_MASK); float* OA1p = (float*)(ws + WS_OA1);
            {
                const int nq = (G % 8 == 0) ? 8 : 1, bq = 16 / nq, qid = (nq == 8) ? (bid & 7) : 0;
                unsigned* qctr = ctl + CW_Q + ((l * 2 + 1) * 8 + qid) * 32;
                volatile LAS int* qw = (volatile LAS int*)(lds + LDS_CTL + 48);
#pragma unroll 1
                for (;;) {
                    __syncthreads();
                    if (tid == 0) *qw = (int)__hip_atomic_fetch_add(qctr, 1u, __ATOMIC_RELAXED, __HIP_MEMORY_SCOPE_AGENT);
                    __syncthreads();
                    const int u = __builtin_amdgcn_readfirstlane(*qw);
                    if (u >= 64 * bq) break;
                    if (u < 32 * bq) { const int cb = att_order(u / bq), b = qid * bq + u % bq;
                        attn_unit<2>(lds + LDS_STAGE, HQ, VT, MIX, MASKp, OA1p, b, cb & 3, cb >> 2, wave, lane, 0.f, 0.f, nullptr, nullptr); }
                    else { const int u2 = u - 32 * bq, cb = 31 - u2 / bq, b = qid * bq + u2 % bq, h = cb & 3;
                        attn_unit<1>(lds + LDS_STAGE, HQ, VT, MIX, MASKp, OA1p, b, h, cb >> 2, wave, lane, 0.f, 0.f, nullptr, a.rel_bias + ((size_t)l * 4 + h) * 257); }
                }
            }
        }
        SEAM(pb + 2);
        if (IN(pb + 3)) PREP(6) {
            WSPTRS();
            pg8::DenseOrder S{T / 256, 4, G, bid, (const char*)(Wout + (size_t)l * 1024 * 1024), 1024, false};
            pg8::EpiResBf16 E{Y1B, XB};
            pg8::gemm_phase<pg8::EpiResBf16, pg8::DenseOrder, false>(lds + LDS_STAGE, MIX, 1024, S, E, wave0);
        }
        SEAM(pb + 3);
        if (IN(pb + 4)) PREP(10) {
            OPAQUE_IDS(); WSPTRS();
            if (PROBE == 10 && _rp == 0) { TOKL = (int*)(ws + WS_END); ASGE = TOKL + NE * T; ASGS = ASGE + NASG; GATE = (float*)(ASGS + NASG); }
            LAS int* lcnt = (LAS int*)(lds + LDS_RT); LAS int* lbase = lcnt + 32; LAS int* asg_e = lcnt + 64; LAS int* asg_ls = asg_e + 512;
            const float* g1 = a.ln1_g + l * D; const float* b1 = a.ln1_b + l * D; const float* br = a.b_router + l * NE;
            unsigned* gcnt = ctl + CW_CNT + l * 64 + ((PROBE == 10 && _rp == 0) ? 4096 : 0);
            { const u32x4* srch = (const u32x4*)(ws + WS_WRT) + (size_t)l * 4096; const u32x4* srcl = (const u32x4*)(ws + WS_WRT + (size_t)DEPTH * NE * D * 2) + (size_t)l * 4096;
              for (int i = tid; i < 4096; i += 512) { const int e = i >> 7, c = i & 127, dst = e * 2048 + ((c ^ (e & 15)) << 4);
                  *(LAS u32x4*)(lds + LDS_STAGE + dst) = srch[i]; *(LAS u32x4*)(lds + LDS_STAGE + 65536 + dst) = srcl[i]; } }
            LAS float* st = (LAS float*)(lds + 131072);
            LAS float* g1l = (LAS float*)(lds + LDS_GB); LAS float* b1l = g1l + 1024;
            for (int i = tid; i < 1024; i += 512) { g1l[i] = g1[i]; b1l[i] = b1[i]; }
            for (int unit = bid; unit < T / 128; unit += G) {
                if (tid < 32) lcnt[tid] = 0;
                __syncthreads();
#pragma unroll 1
                for (int k = 0; k < 8; ++k) {
                    const int tl0 = wave * 16 + 2 * k, t0 = unit * 128 + tl0;
                    float v[2][16];
#pragma unroll
                    for (int tk = 0; tk < 2; ++tk)
#pragma unroll
                        for (int i = 0; i < 4; ++i) { const u32x2 u2 = *(const u32x2*)(Y1B + (size_t)(t0 + tk) * D + i * 256 + lane * 4); v[tk][4 * i] = bf_lo(u2[0]); v[tk][4 * i + 1] = bf_hi(u2[0]); v[tk][4 * i + 2] = bf_lo(u2[1]); v[tk][4 * i + 3] = bf_hi(u2[1]); }
#pragma unroll
                    for (int tk = 0; tk < 2; ++tk) {
                        float s_ = 0.f;
#pragma unroll
                        for (int i = 0; i < 16; ++i) s_ += v[tk][i];
                        const float mean = wsum(s_, lane) * (1.0f / 1024.0f);
                        float qv = 0.f;
#pragma unroll
                        for (int i = 0; i < 16; ++i) { const float d = v[tk][i] - mean; qv += d * d; }
                        const float rstd = rsqrtf(wsum(qv, lane) * (1.0f / 1024.0f) + EPS);
                        if (lane == 0) { st[(tl0 + tk) * 2] = mean; st[(tl0 + tk) * 2 + 1] = rstd; }
                    }
                }
                asm volatile("s_waitcnt lgkmcnt(0)" ::: "memory");
                __builtin_amdgcn_wave_barrier();
                {
                    const int tk = lane & 15, kg = lane >> 4, tl = wave * 16 + tk, t = unit * 128 + tl;
                    const float mean = st[tl * 2], rstd = st[tl * 2 + 1];
                    f32x4 acc0 = {0.f, 0.f, 0.f, 0.f}, acc1 = acc0;
                    const bf16_t* yrow = Y1B + (size_t)t * D + kg * 8;
                    const int e0 = tk, e1 = 16 + tk;
                    const LAS unsigned char* w0p = lds + LDS_STAGE + e0 * 2048; const LAS unsigned char* w1p = lds + LDS_STAGE + e1 * 2048;
                    u32x4 y8n[4];
#pragma unroll
                    for (int u = 0; u < 4; ++u) y8n[u] = __builtin_nontemporal_load((const u32x4*)(yrow + u * 32));
#pragma unroll 1
                    for (int ks0 = 0; ks0 < 32; ks0 += 4) {
                    u32x4 y8v[4];
#pragma unroll
                    for (int u = 0; u < 4; ++u) y8v[u] = y8n[u];
                    { const int kn = (ks0 + 4 < 32) ? ks0 + 4 : ks0;
#pragma unroll
                      for (int u = 0; u < 4; ++u) y8n[u] = __builtin_nontemporal_load((const u32x4*)(yrow + (kn + u) * 32)); }
#pragma unroll
                    for (int u = 0; u < 4; ++u) {
                        const int ks = ks0 + u;
                        const int k0 = ks * 32 + kg * 8;
                        const u32x4 y8 = y8v[u];
                        const f32x4 ga = *(const LAS f32x4*)(g1l + k0), gb = *(const LAS f32x4*)(g1l + k0 + 4), ba = *(const LAS f32x4*)(b1l + k0), bb = *(const LAS f32x4*)(b1l + k0 + 4);
                        float x[8];
                        x[0] = (bf_lo(y8[0]) - mean) * rstd * ga[0] + ba[0]; x[1] = (bf_hi(y8[0]) - mean) * rstd * ga[1] + ba[1];
                        x[2] = (bf_lo(y8[1]) - mean) * rstd * ga[2] + ba[2]; x[3] = (bf_hi(y8[1]) - mean) * rstd * ga[3] + ba[3];
                        x[4] = (bf_lo(y8[2]) - mean) * rstd * gb[0] + bb[0]; x[5] = (bf_hi(y8[2]) - mean) * rstd * gb[1] + bb[1];
                        x[6] = (bf_lo(y8[3]) - mean) * rstd * gb[2] + bb[2]; x[7] = (bf_hi(y8[3]) - mean) * rstd * gb[3] + bb[3];
                        u32x4 hx; hx.x = pk_bf16(x[0], x[1]); hx.y = pk_bf16(x[2], x[3]); hx.z = pk_bf16(x[4], x[5]); hx.w = pk_bf16(x[6], x[7]);
                        *(u32x4*)(X1B + (size_t)t * D + k0) = hx;
#if MOE_FP8
                        *(u32x2*)(ws + WS_X1Q + (size_t)t * D + k0) = (u32x2){pk4_fp8(x[0] * X8_SCALE, x[1] * X8_SCALE, x[2] * X8_SCALE, x[3] * X8_SCALE), pk4_fp8(x[4] * X8_SCALE, x[5] * X8_SCALE, x[6] * X8_SCALE, x[7] * X8_SCALE)};
#endif
                        u32x4 lx; lx.x = pk_bf16(x[0] - bf_lo(hx.x), x[1] - bf_hi(hx.x)); lx.y = pk_bf16(x[2] - bf_lo(hx.y), x[3] - bf_hi(hx.y));
                        lx.z = pk_bf16(x[4] - bf_lo(hx.z), x[5] - bf_hi(hx.z)); lx.w = pk_bf16(x[6] - bf_lo(hx.w), x[7] - bf_hi(hx.w));
                        const bf16x8 xh = __builtin_bit_cast(bf16x8, hx), xl = __builtin_bit_cast(bf16x8, lx);
                        const int c0 = ((ks * 4 + kg) ^ tk) << 4;
                        const bf16x8 wh0 = *(const LAS bf16x8*)(w0p + c0), wl0 = *(const LAS bf16x8*)(w0p + 65536 + c0);
                        const bf16x8 wh1 = *(const LAS bf16x8*)(w1p + c0), wl1 = *(const LAS bf16x8*)(w1p + 65536 + c0);
                        acc0 = __builtin_amdgcn_mfma_f32_16x16x32_f16(wh0, xh, acc0, 0, 0, 0); acc1 = __builtin_amdgcn_mfma_f32_16x16x32_f16(wh1, xh, acc1, 0, 0, 0);
                        acc0 = __builtin_amdgcn_mfma_f32_16x16x32_f16(wl0, xh, acc0, 0, 0, 0); acc1 = __builtin_amdgcn_mfma_f32_16x16x32_f16(wl1, xh, acc1, 0, 0, 0);
                        acc0 = __builtin_amdgcn_mfma_f32_16x16x32_f16(wh0, xl, acc0, 0, 0, 0); acc1 = __builtin_amdgcn_mfma_f32_16x16x32_f16(wh1, xl, acc1, 0, 0, 0);
                    }
                    }
                    float lv[8]; int li[8];
                    { const f32x4 b0 = *(const f32x4*)(br + kg * 4), b1v = *(const f32x4*)(br + 16 + kg * 4);
#pragma unroll
                      for (int j = 0; j < 4; ++j) { lv[j] = acc0[j] + b0[j]; li[j] = kg * 4 + j; lv[4 + j] = acc1[j] + b1v[j]; li[4 + j] = 16 + kg * 4 + j; } }
                    int be[4]; float bv[4];
#pragma unroll
                    for (int kk = 0; kk < 4; ++kk) {
                        float m = lv[0]; int mi = li[0];
#pragma unroll
                        for (int i = 1; i < 8; ++i) if (lv[i] > m) { m = lv[i]; mi = li[i]; }
                        { const float om = shx(m, 16, lane); const int oi = __float_as_int(shx(__int_as_float(mi), 16, lane)); if (om > m || (om == m && oi < mi)) { m = om; mi = oi; } }
                        { const float om = shx(m, 32, lane); const int oi = __float_as_int(shx(__int_as_float(mi), 32, lane)); if (om > m || (om == m && oi < mi)) { m = om; mi = oi; } }
                        be[kk] = mi; bv[kk] = m;
#pragma unroll
                        for (int i = 0; i < 8; ++i) if (li[i] == mi) lv[i] = -3e38f;
                    }
                    float ex[4], es = 0.f;
#pragma unroll
                    for (int kk = 0; kk < 4; ++kk) { ex[kk] = __expf(bv[kk] - bv[0]); es += ex[kk]; }
                    if (kg == 0) {
#pragma unroll
                        for (int kk = 0; kk < 4; ++kk) { const int sl = __hip_atomic_fetch_add(&lcnt[be[kk]], 1, __ATOMIC_RELAXED, __HIP_MEMORY_SCOPE_WORKGROUP); asg_e[tl * 4 + kk] = be[kk]; asg_ls[tl * 4 + kk] = sl; GATE[t * 4 + kk] = ex[kk] / es; }
                    }
                }
                __syncthreads();
                if (tid < 32) lbase[tid] = (int)__hip_atomic_fetch_add(gcnt + tid, (unsigned)lcnt[tid], __ATOMIC_RELAXED, __HIP_MEMORY_SCOPE_AGENT);
                __syncthreads();
                { const int e = asg_e[tid], sl = lbase[e] + asg_ls[tid], t = unit * 128 + (tid >> 2);
                  TOKL[(size_t)e * T + sl] = t; ASGE[t * 4 + (tid & 3)] = e; ASGS[t * 4 + (tid & 3)] = sl; }
                __syncthreads();
            }
        }
        SEAM(pb + 4);
        LAS int* tstart = (LAS int*)(lds + LDS_TSTART); LAS int* lcntE = (LAS int*)(lds + LDS_CNT); LAS unsigned char* tile_e = lds + LDS_TILEE;
        if (IN(pb + 5) || IN(pb + 6) || IN(pb + 7)) {
            OPAQUE_IDS(); WSPTRS();
            if (tid < 32) lcntE[tid] = (int)__hip_atomic_load(ctl + CW_CNT + l * 64 + tid, __ATOMIC_RELAXED, __HIP_MEMORY_SCOPE_AGENT);
            __syncthreads();
            if (tid == 0) { int acc = 0; for (int e = 0; e < NE; ++e) { tstart[e] = acc; acc += (lcntE[e] + 255) >> 8; } tstart[32] = acc; }
            __syncthreads();
            for (int q = tid; q < MAXRT; q += 512) { int e = 0; for (int k = 0; k < NE; ++k) if (q >= tstart[k]) e = k; tile_e[q] = (unsigned char)e; }
            __syncthreads();
        }
        pg8::MoeTables tb{tstart, lcntE, tile_e, tstart[32]};
        if (IN(pb + 5)) PREP(7) {
            WSPTRS();
#if MOE_FP8
            pg8::MoeOrder S{tb, 8, G, bid, (const char*)Wgu + (size_t)l * NE * 2048 * 1024, (size_t)2048 * 1024, TOKL, true, 1024};
            pg8::EpiSwiglu<true> E{(void*)ACT, a.b_gu + (size_t)l * NE * 2048, 1.0f / (W8_SCALE * X8_SCALE)};
            pg8::gemm_phase<pg8::EpiSwiglu<true>, pg8::MoeOrder, true, 1>(lds + LDS_STAGE, (const bf16_t*)(ws + WS_X1Q), 1024, S, E, wave0);
#else
            pg8::MoeOrder S{tb, 8, G, bid, (const char*)(Wgu + (size_t)l * NE * 2048 * 1024), (size_t)2048 * 1024 * 2, TOKL, true, 2048};
            pg8::EpiSwiglu<false> E{(void*)ACT, a.b_gu + (size_t)l * NE * 2048, 1.0f};
            pg8::gemm_phase<pg8::EpiSwiglu<false>, pg8::MoeOrder, true>(lds + LDS_STAGE, X1B, 1024, S, E, wave0);
#endif
        }
        SEAM(pb + 5);
        if (IN(pb + 6)) PREP(8) {
            WSPTRS();
#if MOE_FP8
            pg8::MoeOrder S{tb, 4, G, bid, (const char*)Wdn + (size_t)l * NE * 1024 * 1024, (size_t)1024 * 1024, TOKL, false, 1024};
            pg8::EpiBiasBf16 E{YR, a.b_down + (size_t)l * NE * 1024, 1.0f / (W8_SCALE * A8_SCALE)};
            pg8::gemm_phase<pg8::EpiBiasBf16, pg8::MoeOrder, false, 1>(lds + LDS_STAGE, ACT, 1024, S, E, wave0);
#else
            pg8::MoeOrder S{tb, 4, G, bid, (const char*)(Wdn + (size_t)l * NE * 1024 * 1024), (size_t)1024 * 1024 * 2, TOKL, false, 2048};
            pg8::EpiBiasBf16 E{YR, a.b_down + (size_t)l * NE * 1024, 1.0f};
            pg8::gemm_phase<pg8::EpiBiasBf16, pg8::MoeOrder, false>(lds + LDS_STAGE, ACT, 1024, S, E, wave0);
#endif
        }
        SEAM(pb + 6);
        if (IN(pb + 7)) PREP(9) {
            OPAQUE_IDS(); WSPTRS();
            const float* g2 = a.ln2_g + l * D; const float* b2 = a.ln2_b + l * D;
            f32x4 gg4[4], bb4[4];
#pragma unroll
            for (int i = 0; i < 4; ++i) { gg4[i] = *(const f32x4*)(g2 + i * 256 + lane * 4); bb4[i] = *(const f32x4*)(b2 + i * 256 + lane * 4); }
            for (int t0 = gw; t0 < T; t0 += 2 * NGW) {
                int e_[2][4], sl_[2][4]; float gk_[2][4];
#pragma unroll
                for (int u = 0; u < 2; ++u) { const int t = t0 + u * NGW;
#pragma unroll
                    for (int k = 0; k < 4; ++k) { e_[u][k] = ASGE[t * 4 + k]; sl_[u][k] = ASGS[t * 4 + k]; gk_[u][k] = GATE[t * 4 + k]; } }
                u32x2 xr[2][4], yr[2][4][4];
#pragma unroll
                for (int u = 0; u < 2; ++u) { const int t = t0 + u * NGW;
#pragma unroll
                    for (int i = 0; i < 4; ++i) xr[u][i] = __builtin_nontemporal_load((const u32x2*)(X1B + (size_t)t * D + i * 256 + lane * 4));
#pragma unroll
                    for (int k = 0; k < 4; ++k) { const bf16_t* yp = YR + ((size_t)tstart[e_[u][k]] * 256 + sl_[u][k]) * 1024;
#pragma unroll
                        for (int i = 0; i < 4; ++i) yr[u][k][i] = __builtin_nontemporal_load((const u32x2*)(yp + i * 256 + lane * 4)); } }
#pragma unroll
                for (int u = 0; u < 2; ++u) { const int t = t0 + u * NGW;
                    float v[16];
#pragma unroll
                    for (int i = 0; i < 4; ++i) { v[4 * i] = ALPHA * bf_lo(xr[u][i][0]); v[4 * i + 1] = ALPHA * bf_hi(xr[u][i][0]); v[4 * i + 2] = ALPHA * bf_lo(xr[u][i][1]); v[4 * i + 3] = ALPHA * bf_hi(xr[u][i][1]); }
#pragma unroll
                    for (int k = 0; k < 4; ++k) { const float gk = gk_[u][k];
#pragma unroll
                        for (int i = 0; i < 4; ++i) { const u32x2 u2 = yr[u][k][i];
                            v[4 * i] += gk * bf_lo(u2[0]); v[4 * i + 1] += gk * bf_hi(u2[0]); v[4 * i + 2] += gk * bf_lo(u2[1]); v[4 * i + 3] += gk * bf_hi(u2[1]); } }
                    float s_ = 0.f;
#pragma unroll
                    for (int i = 0; i < 16; ++i) s_ += v[i];
                    const float mean = wsum(s_, lane) * (1.0f / 1024.0f);
                    float qv = 0.f;
#pragma unroll
                    for (int i = 0; i < 16; ++i) { const float d = v[i] - mean; qv += d * d; }
                    const float rstd = rsqrtf(wsum(qv, lane) * (1.0f / 1024.0f) + EPS);
#pragma unroll
                    for (int i = 0; i < 4; ++i) {
                        const int c0 = i * 256 + lane * 4;
                        const f32x4 gg = gg4[i], bb = bb4[i];
                        float o[4];
#pragma unroll
                        for (int j = 0; j < 4; ++j) o[j] = (v[4 * i + j] - mean) * rstd * gg[j] + bb[j];
                        if (l == DEPTH - 1) *(f32x4*)(a.out + (size_t)t * D + c0) = (f32x4){o[0], o[1], o[2], o[3]};
                        else *(u32x2*)(XB + (size_t)t * D + c0) = (u32x2){pk_bf16(o[0], o[1]), pk_bf16(o[2], o[3])};
                    }
                }
            }
        }
        if (l + 1 < DEPTH) SEAM(pb + 7);
    }
#undef IN
#undef SEAM
}

extern "C" void kernel_launch(void* const* d_in, const int* in_sizes, int n_in, void* d_out, int out_size, void* d_ws, size_t ws_size, hipStream_t stream) {
    static int grid = 0;
    if (grid == 0) {
        if (ws_size < WS_END) { fprintf(stderr, "kernel_launch: workspace too small (%zu < %zu)\n", ws_size, (size_t)WS_END); grid = -1; return; }
        int dev = 0, cus = 0, per_cu = 0;
        if (hipGetDevice(&dev) != hipSuccess || hipDeviceGetAttribute(&cus, hipDeviceAttributeMultiprocessorCount, dev) != hipSuccess) { grid = -1; return; }
        if (hipFuncSetAttribute((const void*)mega, hipFuncAttributeMaxDynamicSharedMemorySize, LDS_BYTES) != hipSuccess) { fprintf(stderr, "kernel_launch: hipFuncSetAttribute failed\n"); grid = -1; return; }
        if (hipOccupancyMaxActiveBlocksPerMultiprocessor(&per_cu, (const void*)mega, 512, LDS_BYTES) != hipSuccess || per_cu < 1) { fprintf(stderr, "kernel_launch: occupancy query says %d\n", per_cu); }
        (void)hipGetLastError();
        grid = cus;
        if (grid % 8 != 0) grid -= grid % 8;
    }
    if (grid < 0) return;
    (void)hipMemsetAsync((char*)d_ws + WS_CTL, 0, CTL_BYTES, stream);
    Args a{};
    a.x = (const float*)d_in[0]; a.w_in = (const float*)d_in[1]; a.lam_q1 = (const float*)d_in[2]; a.lam_k1 = (const float*)d_in[3]; a.lam_q2 = (const float*)d_in[4]; a.lam_k2 = (const float*)d_in[5];
    a.subln_g = (const float*)d_in[6]; a.rel_bias = (const float*)d_in[7]; a.w_out = (const float*)d_in[8]; a.ln1_g = (const float*)d_in[9]; a.ln1_b = (const float*)d_in[10];
    a.w_router = (const float*)d_in[11]; a.b_router = (const float*)d_in[12]; a.w_gu = (const float*)d_in[13]; a.b_gu = (const float*)d_in[14]; a.w_down = (const float*)d_in[15];
    a.b_down = (const float*)d_in[16]; a.ln2_g = (const float*)d_in[17]; a.ln2_b = (const float*)d_in[18];
    a.out = (float*)d_out; a.ws = (unsigned char*)d_ws; a.pad = 0;
    a.ph_lo = 0; a.ph_hi = 1 + 8 * DEPTH; a.bar_region = 0;
    hipLaunchKernelGGL(mega, dim3(grid), dim3(512), LDS_BYTES, stream, a);
}
```

```cpp
#include <hip/hip_runtime.h>
#include <stdint.h>
#include <cstdio>

#define LAS __attribute__((address_space(3)))
typedef unsigned short bf16_t;
typedef _Float16 bf16x8 __attribute__((ext_vector_type(8)));
typedef float f32x4 __attribute__((ext_vector_type(4)));
typedef float f32x2 __attribute__((ext_vector_type(2)));
typedef unsigned u32x4 __attribute__((ext_vector_type(4)));
typedef unsigned u32x2 __attribute__((ext_vector_type(2)));
typedef _Float16 bf16v2 __attribute__((ext_vector_type(2)));

constexpr int D = 1024, BATCH = 16, SEQ = 2048, T = BATCH * SEQ, DEPTH = 4;
constexpr int DIN = 3368;
constexpr int NE = 32;
constexpr float ALPHA = 1.681792830507429f;
constexpr float EPS = 1e-5f;
constexpr float LOG2E = 1.4426950408889634f;
constexpr float QSCALE = 0.125f * LOG2E;
constexpr int HQP = 2560;
constexpr int HQ_QA = 0, HQ_KA = 512, HQ_QB = 1024, HQ_KB = 1280, HQ_QC = 1536, HQ_KC = 1792, HQ_QI = 2048, HQ_KI = 2304, HQ_WI = 2336, HQ_USED = 2344;
constexpr int VT_A = 0, VT_B = 512, VT_C = 768;
constexpr int NASG = T * 4;
constexpr int GROWS = NASG + NE * 256;
constexpr int MAXRT = GROWS / 256;

constexpr size_t MiB = (size_t)1 << 20;
constexpr size_t al(size_t x) { return (x + 255) & ~(size_t)255; }
constexpr size_t WS_CTL = 0, CTL_BYTES = 4 * MiB;
constexpr size_t WS_WIN = WS_CTL + CTL_BYTES;
constexpr size_t WS_WV = WS_WIN + al((size_t)DEPTH * HQP * D * 2);
constexpr size_t WS_WOUT = WS_WV + al((size_t)DEPTH * 1024 * D * 2);
constexpr size_t WS_WGU = WS_WOUT + al((size_t)DEPTH * D * 1024 * 2);
constexpr size_t WS_WDN = WS_WGU + al((size_t)DEPTH * NE * 2048 * D * 2);
constexpr size_t WS_XB = WS_WDN + al((size_t)DEPTH * NE * D * 1024 * 2);
constexpr size_t WS_HQ = WS_XB + al((size_t)T * D * 2);
constexpr size_t WS_VT = WS_HQ + al((size_t)T * HQP * 2);
constexpr size_t WS_MIX = WS_VT + al((size_t)1024 * T * 2);
constexpr size_t WS_Y1 = WS_MIX + al((size_t)T * 1024 * 2);
constexpr size_t WS_X1B = WS_Y1 + al((size_t)T * D * 2);
constexpr size_t WS_ACT = WS_X1B + al((size_t)T * D * 2);
constexpr size_t WS_YR = WS_ACT + al((size_t)GROWS * 1024 * 2);
constexpr size_t WS_MASK = WS_YR + al((size_t)GROWS * 1024 * 2);
constexpr size_t WS_TOKL = WS_MASK + al((size_t)T * 32 * 8);
constexpr size_t WS_ASGE = WS_TOKL + al((size_t)NE * T * 4);
constexpr size_t WS_ASGS = WS_ASGE + al((size_t)NASG * 4);
constexpr size_t WS_GATE = WS_ASGS + al((size_t)NASG * 4);
constexpr size_t WS_OA1 = WS_GATE + al((size_t)NASG * 4);
constexpr size_t WS_WRT = WS_OA1 + al((size_t)T * 512 * 4);
constexpr size_t WS_X1Q = WS_WRT + al((size_t)DEPTH * NE * D * 4);
constexpr size_t WS_END = WS_X1Q + al((size_t)T * D);
constexpr int CW_BAR = 4096;
constexpr int CW_CNT = 262144;
constexpr int CW_Q = 524288;

#ifndef MOE_FP8
#define MOE_FP8 1
#endif
constexpr int RTP = 2;
constexpr float W8_SCALE = 512.0f;
constexpr float X8_SCALE = 16.0f;
constexpr float A8_SCALE = 4.0f;
typedef int i32x8 __attribute__((ext_vector_type(8)));
__device__ __forceinline__ unsigned pk_bf16(float lo, float hi) { f32x2 v = {lo, hi}; return __builtin_bit_cast(unsigned, __builtin_convertvector(v, bf16v2)); }
__device__ __forceinline__ float clamp8(float x) { return __builtin_fminf(__builtin_fmaxf(x, -448.0f), 448.0f); }
__device__ __forceinline__ unsigned pk4_fp8(float a, float b, float c, float d) {
    int w = 0; w = __builtin_amdgcn_cvt_pk_fp8_f32(clamp8(a), clamp8(b), w, false); w = __builtin_amdgcn_cvt_pk_fp8_f32(clamp8(c), clamp8(d), w, true); return (unsigned)w; }
__device__ __forceinline__ float bf_lo(unsigned u) { return (float)__builtin_bit_cast(bf16v2, u)[0]; }
__device__ __forceinline__ float bf_hi(unsigned u) { return (float)__builtin_bit_cast(bf16v2, u)[1]; }
__device__ __forceinline__ float bf2f(bf16_t b) { return (float)__builtin_bit_cast(bf16v2, (unsigned)b)[0]; }
__device__ __forceinline__ float wave_sum(float v) {
#pragma unroll
    for (int o = 32; o > 0; o >>= 1) v += __shfl_xor(v, o);
    return v; }
__device__ __forceinline__ float wave_max(float v) {
#pragma unroll
    for (int o = 32; o > 0; o >>= 1) v = fmaxf(v, __shfl_xor(v, o));
    return v; }
__device__ __forceinline__ int wave_sum_i(int v) {
#pragma unroll
    for (int o = 32; o > 0; o >>= 1) v += __shfl_xor(v, o);
    return v; }

__device__ __forceinline__ float shx(float v, int o, int lane) { return __int_as_float(__builtin_amdgcn_ds_bpermute((lane ^ o) << 2, __float_as_int(v))); }
__device__ __forceinline__ float wsum(float v, int lane) {
#pragma unroll
    for (int o = 32; o > 0; o >>= 1) v += shx(v, o, lane);
    return v; }
__device__ __forceinline__ float wmax(float v, int lane) {
#pragma unroll
    for (int o = 32; o > 0; o >>= 1) v = fmaxf(v, shx(v, o, lane));
    return v; }

#define XB_TMO      128
#define XB_XCNT(j)  (256  + 64 * (j))
#define XB_XSUB(j)  (1280 + 64 * (j))
#define XB_XGEN(j)  (2304 + 64 * (j))
#define XB_TOP      3328
#define XB_TOPGEN   3392
#define XCD_BAR_WORDS 3456
#define XB_SPIN_CAP (1u << 22)
__device__ __forceinline__ unsigned xb_ld(unsigned* p)              { return __hip_atomic_load(p, __ATOMIC_RELAXED, __HIP_MEMORY_SCOPE_AGENT); }
__device__ __forceinline__ unsigned xb_add(unsigned* p, unsigned v) { return __hip_atomic_fetch_add(p, v, __ATOMIC_RELAXED, __HIP_MEMORY_SCOPE_AGENT); }
__device__ __forceinline__ unsigned xb_xcc_id() { return (unsigned)__builtin_amdgcn_s_getreg((3 << 11) | 20) & 0xFu; }
#define XB_SPIN(cond, bar) do { unsigned _sp = 0; while (cond) { __builtin_amdgcn_s_sleep(1); \
    if ((++_sp & 255u) == 0u) { if (xb_ld(&(bar)[XB_TMO])) break; if (_sp > XB_SPIN_CAP) { atomicAdd(&(bar)[XB_TMO], 1u); break; } } } } while (0)
struct XcdBarrier { unsigned* bar; unsigned x; volatile LAS unsigned* st; };
__device__ __forceinline__ XcdBarrier xcd_barrier_post(unsigned* bar, volatile LAS unsigned* st) {
    XcdBarrier b; b.bar = bar; b.x = xb_xcc_id(); b.st = st;
    if (threadIdx.x == 0) (void)xb_add(&bar[XB_XCNT(b.x)], 1u);
    return b;
}
__device__ __forceinline__ void xcd_barrier_complete(unsigned* bar, unsigned x, unsigned& nloc, unsigned& nx) {
    const unsigned G = gridDim.x * gridDim.y * gridDim.z;
    unsigned sum, cnt, mine, sp = 0u;
    for (;;) {
        sum = 0u; cnt = 0u; mine = 0u;
#pragma unroll
        for (unsigned j = 0; j < 16; ++j) { const unsigned c = xb_ld(&bar[XB_XCNT(j)]); sum += c; cnt += (c > 0u) ? 1u : 0u; mine = (j == x) ? c : mine; }
        if (sum == G) break;
        __builtin_amdgcn_s_sleep(1);
        if ((++sp & 255u) == 0u) { if (xb_ld(&bar[XB_TMO])) break; if (sp > XB_SPIN_CAP) { atomicAdd(&bar[XB_TMO], 1u); break; } }
    }
    nloc = mine > 0u ? mine : 1u; nx = cnt > 0u ? cnt : 1u;
}
__device__ __forceinline__ void xcd_barrier(const XcdBarrier& b) {
    asm volatile("s_waitcnt vmcnt(0)" ::: "memory");
    __syncthreads();
    if (threadIdx.x == 0) {
        unsigned* bar = b.bar;
        __builtin_amdgcn_s_waitcnt(0);
        unsigned nloc = b.st[0], nx = b.st[1];
        if (nloc == 0u) { xcd_barrier_complete(bar, b.x, nloc, nx); b.st[0] = nloc; b.st[1] = nx; }
        const unsigned old = xb_add(&bar[XB_XSUB(b.x)], 1u);
        const unsigned gen = old / nloc;
        if (old + 1u == (gen + 1u) * nloc) {
            __builtin_amdgcn_fence(__ATOMIC_RELEASE, "agent");
            asm volatile("s_waitcnt vmcnt(0)" ::: "memory");
            const unsigned og = xb_add(&bar[XB_TOP], 1u);
            const unsigned tg = og / nx;
            if (og + 1u == (tg + 1u) * nx) xb_add(&bar[XB_TOPGEN], 1u);
            else XB_SPIN(xb_ld(&bar[XB_TOPGEN]) == tg, bar);
            __builtin_amdgcn_fence(__ATOMIC_ACQUIRE, "agent");
            xb_add(&bar[XB_XGEN(b.x)], 1u);
            asm volatile("s_waitcnt vmcnt(0)" ::: "memory");
        } else {
            XB_SPIN(xb_ld(&bar[XB_XGEN(b.x)]) == gen, bar);
            __builtin_amdgcn_fence(__ATOMIC_ACQUIRE, "agent");
            asm volatile("s_waitcnt vmcnt(0)" ::: "memory");
        }
    }
    __syncthreads();
}

namespace pg8 {
constexpr int BM = 256, BK = 64, HALF = 128, HTB = HALF * BK * 2, STAGE_BYTES = 8 * HTB;
__host__ __device__ __forceinline__ int lds_byte(int r, int c) { const int st = (r >> 4) * 2 + (c >> 5), rr = r & 15, cc = c & 31, ob = rr * 64 + cc * 2; return st * 1024 + (ob ^ (((ob >> 9) & 1) << 5)); }
__host__ __device__ __forceinline__ void stage_rc(int b, int& R, int& C) { const int st = b / 1024, sb = b % 1024, swz = sb ^ (((sb >> 9) & 1) << 5); R = (st >> 1) * 16 + swz / 64; C = (st & 1) * 32 + (swz % 64) / 2; }
__host__ __device__ __forceinline__ int perm32(int rho) { const int n = rho >> 4, i = rho & 15; return 8 * (i >> 2) + 4 * n + (i & 3); }

struct Unit {
    int row0;
    int col0;
    const char* Bt;
    const int* rows;
    int nvalid;
    int e;
};

template <class Epi, class Sched, bool GATHER, int ESZ = 2>
__device__ __forceinline__ void gemm_phase(LAS unsigned char* lds, const bf16_t* Abase, const int K, const Sched& S, const Epi& E, const int wid_in) {
    int wid = wid_in; asm volatile("" : "+s"(wid));
    int lane; asm volatile("v_mbcnt_lo_u32_b32 %0, -1, 0\n\tv_mbcnt_hi_u32_b32 %0, -1, %0" : "=&v"(lane));
    const int tid = wid * 64 + lane, wr = wid >> 2, wc = wid & 3, fr = lane & 15, fq = lane >> 4;
    const int nt = K * ESZ / 128;
    unsigned voffB[2];
#pragma unroll
    for (int i = 0; i < 2; ++i) { int R, C; stage_rc(tid * 16 + i * 8192, R, C); const int Rb = Epi::PERM ? ((R & ~31) + perm32(R & 31)) : R; voffB[i] = (unsigned)(Rb * K * ESZ + C * 2); }
    const size_t kstep = (size_t)(BK * 2);
    const size_t hstep = (size_t)HALF * K * ESZ;
    const unsigned ldsw = (unsigned)wid * 1024u;
    const int aoff = lds_byte(wr * 64 + fr, fq * 8), boff = lds_byte(wc * 32 + fr, fq * 8);
#define PG8_SA(b, h) (((b) * 2 + (h)) * HTB)
#define PG8_SB(b, h) ((4 + (b) * 2 + (h)) * HTB)
#define PG8_STAGE(bufoff, gbase, voff) do { _Pragma("unroll") for (int _i = 0; _i < 2; ++_i) \
        __builtin_amdgcn_global_load_lds((const unsigned*)((const char*)(gbase) + (voff)[_i]), (LAS unsigned*)(lds + (bufoff) + ldsw + _i * 8192), 16, 0, 0); } while (0)
#define PG8_LDA(dst, b, h) do { _Pragma("unroll") for (int m = 0; m < 4; ++m) _Pragma("unroll") for (int k = 0; k < 2; ++k) dst[m][k] = *(const LAS bf16x8*)(lds + PG8_SA(b, h) + aoff + m * 2048 + k * 1024); } while (0)
#define PG8_LDB(dst, b, h) do { _Pragma("unroll") for (int n = 0; n < 2; ++n) _Pragma("unroll") for (int k = 0; k < 2; ++k) dst[n][k] = *(const LAS bf16x8*)(lds + PG8_SB(b, h) + boff + n * 2048 + k * 1024); } while (0)
#define PG8_MMA(ai, bj, At, Bt) do { __builtin_amdgcn_s_setprio(1); _Pragma("unroll") for (int m = 0; m < 4; ++m) _Pragma("unroll") for (int n = 0; n < 2; ++n) { \
        if constexpr (ESZ == 2) { _Pragma("unroll") for (int k = 0; k < 2; ++k) acc[ai][bj][m][n] = __builtin_amdgcn_mfma_f32_16x16x32_f16(Bt[n][k], At[m][k], acc[ai][bj][m][n], 0, 0, 0); } \
        else {   \
            const u32x4 _a0 = __builtin_bit_cast(u32x4, At[m][0]), _a1 = __builtin_bit_cast(u32x4, At[m][1]), _b0 = __builtin_bit_cast(u32x4, Bt[n][0]), _b1 = __builtin_bit_cast(u32x4, Bt[n][1]); \
            const i32x8 _af = {(int)_a0[0], (int)_a0[1], (int)_a0[2], (int)_a0[3], (int)_a1[0], (int)_a1[1], (int)_a1[2], (int)_a1[3]}; \
            const i32x8 _bf = {(int)_b0[0], (int)_b0[1], (int)_b0[2], (int)_b0[3], (int)_b1[0], (int)_b1[1], (int)_b1[2], (int)_b1[3]}; \
              \
            asm volatile("v_mfma_scale_f32_16x16x128_f8f6f4 %0, %1, %2, %0, %3, %3 op_sel_hi:[0,0,0]" : "+v"(acc[ai][bj][m][n]) : "v"(_bf), "v"(_af), "v"(s8)); } } \
        __builtin_amdgcn_s_setprio(0); } while (0)
#define PG8_WAIT_V(n) asm volatile("s_waitcnt vmcnt(" #n ")" ::: "memory")
#define PG8_WAIT_VS() do { if (slack) { if constexpr (Epi::NST >= 16) asm volatile("s_waitcnt vmcnt(24)" ::: "memory"); else asm volatile("s_waitcnt vmcnt(16)" ::: "memory"); } else asm volatile("s_waitcnt vmcnt(8)" ::: "memory"); } while (0)
#define PG8_WAIT_L(n) asm volatile("s_waitcnt lgkmcnt(" #n ")" ::: "memory")
#define PG8_BAR __builtin_amdgcn_s_barrier()
#define PG8_SCHED __builtin_amdgcn_sched_barrier(0)
#define PG8_AOFFS(dst, u) do { _Pragma("unroll") for (int _h = 0; _h < 2; ++_h) _Pragma("unroll") for (int _i = 0; _i < 2; ++_i) { int _R, _C; stage_rc(tid * 16 + _i * 8192, _R, _C); \
        const int _r = _h * HALF + _R; const int _src = (_r < (u).nvalid) ? (u).rows[_r] : 0; dst[_h][_i] = (unsigned)(_src * K * ESZ + _C * 2); } } while (0)
#define PG8_RAWLOAD(dst, u) do { _Pragma("unroll") for (int _h = 0; _h < 2; ++_h) _Pragma("unroll") for (int _i = 0; _i < 2; ++_i) { int _R, _C; stage_rc(tid * 16 + _i * 8192, _R, _C); \
        const int _r = _h * HALF + _R; dst[_h][_i] = (_r < (u).nvalid) ? (u).rows[_r] : 0; } } while (0)
#define PG8_STAGE_A(bufoff, h, ktb, usenext) do { if constexpr (GATHER) { const unsigned _o[2] = {(usenext) ? na[h][0] : oa[h][0], (usenext) ? na[h][1] : oa[h][1]}; PG8_STAGE(bufoff, cA + (ktb), _o); } \
        else { PG8_STAGE(bufoff, ((usenext) ? nA : cA) + (size_t)(h) * hstep + (ktb), voffA); } } while (0)
    Unit cur, nxt; int ui = 0;
    if (!S.next(0, cur)) return;
    f32x4 acc[2][2][4][2];
#pragma unroll
    for (int a = 0; a < 2; ++a)
#pragma unroll
        for (int b = 0; b < 2; ++b)
#pragma unroll
            for (int m = 0; m < 4; ++m)
#pragma unroll
                for (int n = 0; n < 2; ++n) acc[a][b][m][n] = (f32x4){0.f, 0.f, 0.f, 0.f};
    bf16x8 At[4][2], B0[2][2], B1[2][2];
    int s8 = 0x7F7F7F7F; asm volatile("" : "+v"(s8));
    unsigned oa[2][2], na[2][2], voffA[2];
    const char* cA; const char* nA; const char* cB = cur.Bt;
    int raw[2][2] = {{0, 0}, {0, 0}};
    if constexpr (GATHER) { PG8_AOFFS(oa, cur); cA = (const char*)Abase; nA = cA; voffA[0] = voffA[1] = 0u; if (S.next(1, nxt)) { PG8_RAWLOAD(raw, nxt); } }
    else { cA = cur.rows ? (const char*)cur.rows : (const char*)Abase + (size_t)cur.row0 * K * ESZ; nA = cA;
#pragma unroll
        for (int i = 0; i < 2; ++i) { int R, C; stage_rc(tid * 16 + i * 8192, R, C); voffA[i] = (unsigned)(R * K * ESZ + C * 2); oa[0][i] = oa[1][i] = na[0][i] = na[1][i] = 0u; } }
    PG8_STAGE(PG8_SB(0, 0), cB, voffB); PG8_STAGE(PG8_SB(0, 1), cB + hstep, voffB); PG8_STAGE_A(PG8_SA(0, 0), 0, 0, false); PG8_STAGE_A(PG8_SA(0, 1), 1, 0, false);
    if (wr == 1) PG8_BAR;
    PG8_WAIT_V(2); PG8_BAR;
    PG8_STAGE(PG8_SB(1, 0), cB + kstep, voffB); PG8_STAGE_A(PG8_SA(1, 0), 0, kstep, false); PG8_STAGE(PG8_SB(1, 1), cB + hstep + kstep, voffB);
    PG8_WAIT_V(6); PG8_BAR;
    for (;;) {
        const bool has_next = S.next(ui + 1, nxt);
        if constexpr (GATHER) {
            if (has_next) {
#pragma unroll
                for (int h = 0; h < 2; ++h)
#pragma unroll
                    for (int i = 0; i < 2; ++i) { int R, C; stage_rc(tid * 16 + i * 8192, R, C); na[h][i] = (unsigned)(raw[h][i] * K * ESZ + C * 2); }
                asm volatile("" : "+v"(na[0][0]), "+v"(na[0][1]), "+v"(na[1][0]), "+v"(na[1][1]));
            } else {
#pragma unroll
                for (int h = 0; h < 2; ++h)
#pragma unroll
                    for (int i = 0; i < 2; ++i) na[h][i] = oa[h][i];
            }
            Unit n2;
            if (has_next && S.next(ui + 2, n2)) { PG8_RAWLOAD(raw, n2); }
        } else nA = has_next ? (nxt.rows ? (const char*)nxt.rows : (const char*)Abase + (size_t)nxt.row0 * K * ESZ) : cA;
        const char* nB = has_next ? nxt.Bt : cB;
#pragma unroll 1
        for (int t = 0; t < nt; t += 2) {
            const bool last = (t == nt - 2);
            const bool slack = (t == 0) && (ui > 0);
            const size_t k1 = (size_t)(t + 1) * kstep, k2 = last ? 0 : (size_t)(t + 2) * kstep, k3 = k2 + kstep;
            const char* b2 = last ? nB : cB + (size_t)(t + 2) * kstep; const char* b3 = b2 + kstep;
            PG8_LDB(B0, 0, 0); PG8_LDB(B1, 0, 1); PG8_SCHED; PG8_LDA(At, 0, 0); PG8_STAGE_A(PG8_SA(1, 1), 1, k1, false);
            PG8_WAIT_VS(); PG8_WAIT_L(0); PG8_BAR; PG8_MMA(0, 0, At, B0); PG8_MMA(0, 1, At, B1); PG8_BAR; PG8_SCHED;
            PG8_LDA(At, 0, 1); PG8_STAGE(PG8_SB(0, 0), b2, voffB); PG8_STAGE(PG8_SB(0, 1), b2 + hstep, voffB); PG8_STAGE_A(PG8_SA(0, 0), 0, k2, last);
            PG8_WAIT_VS(); PG8_WAIT_L(0); PG8_BAR; PG8_MMA(1, 0, At, B0); PG8_MMA(1, 1, At, B1); PG8_BAR; PG8_SCHED;
            PG8_LDB(B0, 1, 0); PG8_LDB(B1, 1, 1); PG8_SCHED; PG8_LDA(At, 1, 0); PG8_STAGE_A(PG8_SA(0, 1), 1, k2, last);
            PG8_WAIT_V(8); PG8_WAIT_L(0); PG8_BAR; PG8_MMA(0, 0, At, B0); PG8_MMA(0, 1, At, B1); PG8_BAR; PG8_SCHED;
            PG8_LDA(At, 1, 1); PG8_STAGE(PG8_SB(1, 0), b3, voffB); PG8_STAGE(PG8_SB(1, 1), b3 + hstep, voffB); PG8_STAGE_A(PG8_SA(1, 0), 0, k3, last);
            PG8_WAIT_V(8); PG8_WAIT_L(0); PG8_BAR; PG8_MMA(1, 0, At, B0); PG8_MMA(1, 1, At, B1); PG8_BAR; PG8_SCHED;
        }
        if constexpr (ESZ == 1) asm volatile("s_nop 15\n\ts_nop 15" ::: "memory");
        if (wr == 0) PG8_BAR;
        E(acc, cur, wr, wc, fr, fq);
        if (!has_next) break;
#pragma unroll
        for (int a = 0; a < 2; ++a)
#pragma unroll
            for (int b = 0; b < 2; ++b)
#pragma unroll
                for (int m = 0; m < 4; ++m)
#pragma unroll
                    for (int n = 0; n < 2; ++n) acc[a][b][m][n] = (f32x4){0.f, 0.f, 0.f, 0.f};
        cur = nxt; cB = nB; ++ui;
        if constexpr (GATHER) {
#pragma unroll
            for (int h = 0; h < 2; ++h)
#pragma unroll
                for (int i = 0; i < 2; ++i) oa[h][i] = na[h][i];
        } else cA = nA;
        if (wr == 1) PG8_BAR;
    }
    PG8_WAIT_V(0);
    PG8_BAR;
#undef PG8_SA
#undef PG8_SB
#undef PG8_STAGE
#undef PG8_LDA
#undef PG8_LDB
#undef PG8_MMA
#undef PG8_WAIT_V
#undef PG8_WAIT_L
#undef PG8_WAIT_VS
#undef PG8_BAR
#undef PG8_SCHED
#undef PG8_AOFFS
#undef PG8_RAWLOAD
#undef PG8_STAGE_A
}

struct DenseOrder {
    int nRT, nN, G, c; const char* Bt; int K; bool swap;
    __device__ __forceinline__ bool next(int i, Unit& u) const {
        const int xcd = c & 7, s = i * (G >> 3) + (c >> 3);
        int rt, pn;
        if (!swap) { rt = 8 * (s / nN) + xcd; pn = s % nN; } else { pn = 8 * (s / nRT) + xcd; rt = s % nRT; }
        if (rt >= nRT || pn >= nN) return false;
        u.row0 = rt * BM; u.col0 = pn * BM; u.Bt = Bt + (size_t)pn * BM * K * 2; u.rows = nullptr; u.nvalid = 0; u.e = 0; return true;
    }
};
struct InProjOrder {
    int G, c; const char* Win; const char* Wv; const char* Xb;
    __device__ __forceinline__ bool next(int i, Unit& u) const {
        constexpr int NM = (T / 256 / 8) * (HQP / 256), NV = (T / 256 / 8) * 4;
        const int xcd = c & 7, s = i * (G >> 3) + (c >> 3);
        if (s < NM) { const int rt = 8 * (s / (HQP / 256)) + xcd, pn = s % (HQP / 256);
            u.row0 = rt * BM; u.col0 = pn * BM; u.Bt = Win + (size_t)pn * BM * 2048; u.rows = (const int*)(Xb + (size_t)rt * BM * 2048); u.nvalid = 0; u.e = 0; return true; }
        const int s2 = s - NM;
        if (s2 >= NV) return false;
        const int pn = 8 * (s2 >> 2) + xcd, rt = s2 & 3;
        u.row0 = rt * BM; u.col0 = pn * BM; u.Bt = Xb + (size_t)pn * BM * 2048; u.rows = (const int*)(Wv + (size_t)rt * BM * 2048); u.nvalid = 0; u.e = 1; return true;
    }
};
struct MoeTables { LAS const int* tstart; LAS const int* cnt; LAS const unsigned char* tile_e; int nrt; };
struct MoeOrder {
    MoeTables tb; int nN, G, c; const char* Bt; size_t strideB; const int* tokl; bool gather; int rowb;
    __device__ __forceinline__ bool next(int i, Unit& u) const {
        const int xcd = c & 7, s = i * (G >> 3) + (c >> 3);
        const int q = 8 * (s / nN) + xcd, pn = s % nN;
        if (q >= tb.nrt) return false;
        const int e = __builtin_amdgcn_readfirstlane((int)tb.tile_e[q]); const int lt = q - __builtin_amdgcn_readfirstlane(tb.tstart[e]);
        u.row0 = q * BM; u.col0 = pn * BM; u.e = e; u.Bt = Bt + (size_t)e * strideB + (size_t)pn * BM * rowb;
        u.rows = gather ? tokl + (size_t)e * T + lt * BM : nullptr; u.nvalid = __builtin_amdgcn_readfirstlane(tb.cnt[e]) - lt * BM; return true;
    }
};

struct EpiBf16Plain {
    static constexpr bool PERM = true; static constexpr int NST = 16;
    bf16_t* O; int ldc;
    __device__ __forceinline__ void operator()(const f32x4 (&acc)[2][2][4][2], const Unit& u, int wr, int wc, int fr, int fq) const {
        const int row0 = u.row0 + wr * 64 + fr, col0 = u.col0 + wc * 32 + 8 * fq;
#pragma unroll
        for (int ai = 0; ai < 2; ++ai)
#pragma unroll
            for (int m = 0; m < 4; ++m) { bf16_t* rowp = O + (size_t)(row0 + ai * HALF + m * 16) * ldc + col0;
#pragma unroll
                for (int bj = 0; bj < 2; ++bj) { const f32x4 v0 = acc[ai][bj][m][0], v1 = acc[ai][bj][m][1];
                    u32x4 w; w.x = pk_bf16(v0[0], v0[1]); w.y = pk_bf16(v0[2], v0[3]); w.z = pk_bf16(v1[0], v1[1]); w.w = pk_bf16(v1[2], v1[3]);
                    *(u32x4*)(rowp + bj * HALF) = w; } }
    }
};
struct EpiInProj {
    static constexpr bool PERM = true; static constexpr int NST = 16;
    bf16_t* Ohq; bf16_t* Ovt;
    __device__ __forceinline__ void operator()(const f32x4 (&acc)[2][2][4][2], const Unit& u, int wr, int wc, int fr, int fq) const {
        bf16_t* O = u.e ? Ovt : Ohq; const int ldc = u.e ? T : HQP;
        const int row0 = u.row0 + wr * 64 + fr, col0 = u.col0 + wc * 32 + 8 * fq;
#pragma unroll
        for (int ai = 0; ai < 2; ++ai)
#pragma unroll
            for (int m = 0; m < 4; ++m) { bf16_t* rowp = O + (size_t)(row0 + ai * HALF + m * 16) * ldc + col0;
#pragma unroll
                for (int bj = 0; bj < 2; ++bj) { const f32x4 v0 = acc[ai][bj][m][0], v1 = acc[ai][bj][m][1];
                    u32x4 w; w.x = pk_bf16(v0[0], v0[1]); w.y = pk_bf16(v0[2], v0[3]); w.z = pk_bf16(v1[0], v1[1]); w.w = pk_bf16(v1[2], v1[3]);
                    *(u32x4*)(rowp + bj * HALF) = w; } }
    }
};
struct EpiResBf16 {
    static constexpr bool PERM = true; static constexpr int NST = 16;
    bf16_t* O; const bf16_t* R;
    __device__ __forceinline__ void operator()(const f32x4 (&acc)[2][2][4][2], const Unit& u, int wr, int wc, int fr, int fq) const {
        const int row0 = u.row0 + wr * 64 + fr, col0 = u.col0 + wc * 32 + 8 * fq;
        u32x4 rr[2][4][2];
#pragma unroll
        for (int ai = 0; ai < 2; ++ai)
#pragma unroll
            for (int m = 0; m < 4; ++m)
#pragma unroll
                for (int bj = 0; bj < 2; ++bj) rr[ai][m][bj] = __builtin_nontemporal_load((const u32x4*)(R + (size_t)(row0 + ai * HALF + m * 16) * 1024 + col0 + bj * HALF));
#pragma unroll
        for (int ai = 0; ai < 2; ++ai)
#pragma unroll
            for (int m = 0; m < 4; ++m) { const size_t off = (size_t)(row0 + ai * HALF + m * 16) * 1024 + col0;
#pragma unroll
                for (int bj = 0; bj < 2; ++bj) { const u32x4 r = rr[ai][m][bj]; const f32x4 v0 = acc[ai][bj][m][0], v1 = acc[ai][bj][m][1];
                    u32x4 w; w.x = pk_bf16(bf_lo(r[0]) * ALPHA + v0[0], bf_hi(r[0]) * ALPHA + v0[1]); w.y = pk_bf16(bf_lo(r[1]) * ALPHA + v0[2], bf_hi(r[1]) * ALPHA + v0[3]);
                    w.z = pk_bf16(bf_lo(r[2]) * ALPHA + v1[0], bf_hi(r[2]) * ALPHA + v1[1]); w.w = pk_bf16(bf_lo(r[3]) * ALPHA + v1[2], bf_hi(r[3]) * ALPHA + v1[3]);
                    *(u32x4*)(O + off + bj * HALF) = w; } }
    }
};
template <bool F8> struct EpiSwiglu {
    static constexpr bool PERM = true; static constexpr int NST = F8 ? 8 : 8;
    void* Ov; const float* bias; float ascale;
    __device__ __forceinline__ void operator()(const f32x4 (&acc)[2][2][4][2], const Unit& u, int wr, int wc, int fr, int fq) const {
        const int row0 = u.row0 + wr * 64 + fr, oc = (u.col0 >> 1) + wc * 32 + 8 * fq;
        const float* bp = bias + (size_t)u.e * 2048 + oc;
        f32x4 bg[2], bu[2];
#pragma unroll
        for (int n = 0; n < 2; ++n) { bg[n] = *(const f32x4*)(bp + 4 * n); bu[n] = *(const f32x4*)(bp + 1024 + 4 * n); }
#pragma unroll
        for (int ai = 0; ai < 2; ++ai)
#pragma unroll
            for (int m = 0; m < 4; ++m) {
                float o[8];
#pragma unroll
                for (int n = 0; n < 2; ++n) { const f32x4 g4 = acc[ai][0][m][n] * ascale + bg[n], u4 = acc[ai][1][m][n] * ascale + bu[n];
#pragma unroll
                    for (int j = 0; j < 4; ++j) { const float g = fminf(g4[j], 7.0f), up = __builtin_amdgcn_fmed3f(u4[j], -7.0f, 7.0f);
                        constexpr float OS = F8 ? A8_SCALE : 1.0f;
                        const float e = __builtin_amdgcn_exp2f(-1.702f * LOG2E * g), glu = g * __builtin_amdgcn_rcpf(__builtin_fmaf(e, 1.0f / OS, 1.0f / OS)); o[4 * n + j] = __builtin_fmaf(up, glu, glu); } }
                if constexpr (F8) {
                    int w0 = 0, w1 = 0; w0 = __builtin_amdgcn_cvt_pk_fp8_f32(o[0], o[1], w0, false); w0 = __builtin_amdgcn_cvt_pk_fp8_f32(o[2], o[3], w0, true);
                    w1 = __builtin_amdgcn_cvt_pk_fp8_f32(o[4], o[5], w1, false); w1 = __builtin_amdgcn_cvt_pk_fp8_f32(o[6], o[7], w1, true);
                    *(u32x2*)((unsigned char*)Ov + (size_t)(row0 + ai * HALF + m * 16) * 1024 + oc) = (u32x2){(unsigned)w0, (unsigned)w1}; }
                else { u32x4 w; w.x = pk_bf16(o[0], o[1]); w.y = pk_bf16(o[2], o[3]); w.z = pk_bf16(o[4], o[5]); w.w = pk_bf16(o[6], o[7]);
                    *(u32x4*)((bf16_t*)Ov + (size_t)(row0 + ai * HALF + m * 16) * 1024 + oc) = w; } }
    }
};
struct EpiBiasBf16 {
    static constexpr bool PERM = true; static constexpr int NST = 16;
    bf16_t* O; const float* bias; float ascale;
    __device__ __forceinline__ void operator()(const f32x4 (&acc)[2][2][4][2], const Unit& u, int wr, int wc, int fr, int fq) const {
        const int row0 = u.row0 + wr * 64 + fr, col0 = u.col0 + wc * 32 + 8 * fq;
        const float* bp = bias + (size_t)u.e * 1024 + col0;
        f32x4 bv[2][2];
#pragma unroll
        for (int bj = 0; bj < 2; ++bj)
#pragma unroll
            for (int n = 0; n < 2; ++n) bv[bj][n] = *(const f32x4*)(bp + bj * HALF + 4 * n);
#pragma unroll
        for (int ai = 0; ai < 2; ++ai)
#pragma unroll
            for (int m = 0; m < 4; ++m) { bf16_t* rowp = O + (size_t)(row0 + ai * HALF + m * 16) * 1024 + col0;
#pragma unroll
                for (int bj = 0; bj < 2; ++bj) { const f32x4 v0 = acc[ai][bj][m][0] * ascale + bv[bj][0], v1 = acc[ai][bj][m][1] * ascale + bv[bj][1];
                    u32x4 w; w.x = pk_bf16(v0[0], v0[1]); w.y = pk_bf16(v0[2], v0[3]); w.z = pk_bf16(v1[0], v1[1]); w.w = pk_bf16(v1[2], v1[3]);
                    *(u32x4*)(rowp + bj * HALF) = w; } }
    }
};
}


#ifndef ATT_EN
#define ATT_EN 7
#endif
#ifndef PROBE
#define PROBE (-1)
#endif
#define PREP(k) _Pragma("unroll 1") for (int _rp = ((PROBE == (k)) ? 0 : 1); _rp < 2; ++_rp)
typedef float f32x16 __attribute__((ext_vector_type(16)));
#define MFMA32(a, b, c) __builtin_amdgcn_mfma_f32_32x32x16_f16((a), (b), (c), 0, 0, 0)
constexpr float ATT_THR = 8.0f;
constexpr int ATT_KB = 8192;
#define NEG_INF_F (-__builtin_huge_valf())

template <int MODE>
__device__ __forceinline__ void attn_unit(LAS unsigned char* lds, const bf16_t* HQ, const bf16_t* VT, bf16_t* MIX, const unsigned long long* MASK, float* OA1,
                                          const int b, const int h, const int qt, const int wave_in, const int lane_unused,
                                          const float lam, const float lam_init, const float* subg, const float* relb) {
    int wave = wave_in; asm volatile("" : "+s"(wave));
    constexpr int NPASS = (MODE == 0) ? 2 : 1;
    constexpr int EB = (MODE == 0) ? 4 : 2;
    constexpr int NLV = EB / 2;
    constexpr int SLOTB = ATT_KB + EB * 32 * 128;
    constexpr int XOFF = 3 * SLOTB;
    const int qoff = (MODE == 0) ? HQ_QA + h * 128 : (MODE == 1) ? HQ_QB + h * 64 : HQ_QC + h * 64;
    const int koff = (MODE == 0) ? HQ_KA + h * 128 : (MODE == 1) ? HQ_KB + h * 64 : HQ_KC + h * 64;
    const int vrow0 = (MODE == 0) ? VT_A + h * 128 : (MODE == 1) ? VT_B + h * 64 : VT_C + h * 64;
    const int mixcol = (MODE == 0) ? h * 128 : (MODE == 1) ? 512 + h * 64 : 768 + h * 64;
    int lane; asm volatile("v_mbcnt_lo_u32_b32 %0, -1, 0\n\tv_mbcnt_hi_u32_b32 %0, -1, %0" : "=&v"(lane));
    const int tid = wave * 64 + lane, ql = lane & 31, hb = lane >> 5;
    const int cq = qt * 4 + (wave >> 1);
    const int tq = qt * 256 + wave * 32 + ql;
    const int kt_hi = qt * 4 + 3;
    const int kt_lo = (MODE == 1) ? ((qt * 4 - 8) > 0 ? (qt * 4 - 8) : 0) : 0;
    const int ntile = kt_hi - kt_lo + 1;
    const float slope2 = (MODE == 0) ? exp2f(-(float)(2 * h + 1)) * LOG2E : exp2f(-(float)(2 * h + 2)) * LOG2E;
    LAS float* relb_l = (LAS float*)(lds + XOFF);
    float so[16];
#pragma unroll
    for (int i = 0; i < 16; ++i) { int oi = 16 * (i >> 3) + (i & 7); asm volatile("" : "+s"(oi));
        so[i] = __int_as_float(__builtin_amdgcn_readfirstlane(__float_as_int(slope2 * (float)oi))); }
    const int prow = (ql & 16) | ((ql & 4) << 1) | ((ql & 8) >> 1) | (ql & 3);
    const int kt_x = (hb ^ ((prow >> 1) & 7)) << 4, vt_x = (hb ^ ((ql >> 1) & 7)) << 4;
    const int krd = prow * 128, vrd = ATT_KB + ql * 128;
    const int drow = lane >> 3, dpos = lane & 7;
    const int krow_g = 8 * wave + drow;
    const size_t ksrc = ((size_t)(b * SEQ + krow_g) * HQP + koff + ((dpos ^ ((krow_g >> 1) & 7)) << 3)) * 2;
    size_t vsrc[NLV];
#pragma unroll
    for (int j = 0; j < NLV; ++j) { const int vr = 8 * (wave + 8 * j) + drow; vsrc[j] = ((size_t)(vrow0 + vr) * T + (size_t)b * SEQ + ((dpos ^ ((vr >> 1) & 7)) << 3)) * 2; }

#pragma unroll 1
    for (int mp = 0; mp < NPASS; ++mp) {
#define ATT_ISSUE(kt_, slot_) do { \
        __builtin_amdgcn_global_load_lds((const unsigned*)((const char*)HQ + ksrc + (size_t)(kt_) * (64 * HQP * 2) + mp * 128), (LAS unsigned*)(lds + (slot_) * SLOTB + wave * 1024), 16, 0, 0); \
        _Pragma("unroll") for (int j = 0; j < NLV; ++j) \
            __builtin_amdgcn_global_load_lds((const unsigned*)((const char*)VT + vsrc[j] + (size_t)(kt_) * 128), (LAS unsigned*)(lds + (slot_) * SLOTB + ATT_KB + (wave + 8 * j) * 1024), 16, 0, 0); } while (0)
        asm volatile("s_waitcnt vmcnt(0)" ::: "memory");
        __syncthreads();
        ATT_ISSUE(kt_hi, 0);
        ATT_ISSUE((ntile > 1 ? kt_hi - 1 : kt_hi), 1);
        if (MODE == 1 && mp == 0) { for (int i = tid; i < 320; i += 512) relb_l[i] = relb[i < 256 ? i : 256] * LOG2E; }
        if (MODE == 2) {
#pragma unroll
            for (int i = 0; i < 8; ++i) { const int q = wave * 32 + i * 4 + (lane >> 4), p = lane & 15;
                __builtin_amdgcn_global_load_lds((const unsigned*)((const char*)MASK + ((size_t)(b * SEQ + qt * 256 + q) * 32 + (((p - q) & 15) << 1)) * 8),
                                                 (LAS unsigned*)(lds + XOFF + (wave * 32 + i * 4) * 256), 16, 0, 0); }
        }
        bf16x8 Q[4];
        { const bf16_t* qp = HQ + (size_t)(b * SEQ + tq) * HQP + qoff + mp * 64 + hb * 8;
#pragma unroll
          for (int ks = 0; ks < 4; ++ks) Q[ks] = *(const bf16x8*)(qp + ks * 16); }
        asm volatile("" : "+v"(Q[0]), "+v"(Q[1]), "+v"(Q[2]), "+v"(Q[3]));
        f32x16 O[EB];
        float mref = 0.f, seen = 0.f, lrun = 0.f;
#pragma unroll
        for (int eb = 0; eb < EB; ++eb)
#pragma unroll
            for (int i = 0; i < 16; ++i) O[eb][i] = 0.f;
        asm volatile("s_waitcnt lgkmcnt(0)" ::: "memory");
        int slot = 0;
        for (int jt = 0; jt < ntile; ++jt) {
            const int kt = kt_hi - jt;
            if constexpr (MODE == 0) asm volatile("s_waitcnt vmcnt(3)" ::: "memory"); else asm volatile("s_waitcnt vmcnt(2)" ::: "memory");
            __builtin_amdgcn_s_barrier();
            { const int nj = jt + 2 < ntile ? jt + 2 : ntile - 1; int ns = slot + 2; ns = ns >= 3 ? ns - 3 : ns; ATT_ISSUE(kt_hi - nj, ns); }
            const bool active = (kt <= cq) && (MODE != 1 || kt >= cq - 8);
            if (active) {
                const LAS unsigned char* kbp = lds + slot * SLOTB + krd;
                const LAS unsigned char* vbp = lds + slot * SLOTB + vrd;
                f32x16 S0, S1;
                if (MODE == 0 || MODE == 2) {
                    const float base0 = (float)(tq - kt * 64 - 8 * hb);
                    if (kt == cq) {
#pragma unroll
                        for (int i = 0; i < 16; ++i) { const float off = (float)(16 * (i >> 3) + (i & 7));
                            S0[i] = -slope2 * fabsf(base0 - off) - mref; S1[i] = -slope2 * fabsf(base0 - 32.0f - off) - mref; }
                    } else {
                        const float c0 = -slope2 * base0 - mref, c1 = c0 + 32.0f * slope2;
#pragma unroll
                        for (int i = 0; i < 16; ++i) { S0[i] = so[i] + c0; S1[i] = so[i] + c1; }
                    }
                }
                if (MODE == 2) {
                    const int mq = wave * 32 + ql; const unsigned long long W = *(const LAS unsigned long long*)(lds + XOFF + mq * 256 + ((((kt >> 1) + mq) & 15) << 4) + ((kt & 1) << 3));
                    const unsigned w0 = (unsigned)W >> (8 * hb), w1 = (unsigned)(W >> 32) >> (8 * hb);
#pragma unroll
                    for (int i = 0; i < 16; ++i) { const int off = 16 * (i >> 3) + (i & 7);
                        const int m0 = __builtin_amdgcn_sbfe((int)w0, off, 1), m1 = __builtin_amdgcn_sbfe((int)w1, off, 1);
                        S0[i] = __int_as_float((__float_as_int(S0[i]) & m0) | ((int)0xFF800000 & ~m0)); S1[i] = __int_as_float((__float_as_int(S1[i]) & m1) | ((int)0xFF800000 & ~m1)); }
                }
                if (MODE == 1) {
                    if (kt >= cq - 2) {
                        const int rel0 = tq - kt * 64 - 8 * hb + 128;
#pragma unroll
                        for (int i = 0; i < 16; ++i) { const int off = 16 * (i >> 3) + (i & 7);
                            S0[i] = relb_l[rel0 - off] - mref; S1[i] = relb_l[rel0 - 32 - off] - mref; }
                    } else {
                        const float far = relb_l[256] - mref;
#pragma unroll
                        for (int i = 0; i < 16; ++i) { S0[i] = far; S1[i] = far; }
                    }
                }
                bf16x8 kf[8], vf0[8];
#pragma unroll
                for (int ks = 0; ks < 4; ++ks) { kf[2 * ks] = *(const LAS bf16x8*)(kbp + ((ks << 5) ^ kt_x)); kf[2 * ks + 1] = *(const LAS bf16x8*)(kbp + 4096 + ((ks << 5) ^ kt_x)); }
#pragma unroll
                for (int i = 0; i < 8; ++i) { const int s4i = i / EB, eb = i % EB; vf0[i] = *(const LAS bf16x8*)(vbp + eb * 4096 + ((s4i << 5) ^ vt_x)); }
#pragma unroll
                for (int ks = 0; ks < 4; ++ks) { S0 = MFMA32(kf[2 * ks], Q[ks], S0); S1 = MFMA32(kf[2 * ks + 1], Q[ks], S1); }
                __builtin_amdgcn_sched_group_barrier(0x100, 16, 0); __builtin_amdgcn_sched_group_barrier(0x008, 8, 0);
                float mx; asm("s_nop 15\n\ts_nop 3\n\tv_max3_f32 %0, %1, %2, %3" : "=v"(mx) : "v"(S0[0]), "v"(S1[0]), "v"(S0[1]));
                asm("v_max3_f32 %0, %1, %2, %3" : "=v"(mx) : "v"(mx), "v"(S1[1]), "v"(S0[2]));
#pragma unroll
                for (int i = 2; i < 15; ++i) asm("v_max3_f32 %0, %1, %2, %3" : "=v"(mx) : "v"(mx), "v"(S1[i]), "v"(S0[i + 1]));
                asm("v_max_f32 %0, %1, %2" : "=v"(mx) : "v"(mx), "v"(S1[15]));
                mx = fmaxf(mx, shx(mx, 32, lane));
                const bool unseen = !(seen > 0.f), finite = mx > -1e30f;
                const bool need = unseen ? finite : (mx > ATT_THR);
                if (__ballot(unseen ? finite : (mx >= -36.0f)) != 0ull) {
                    if (__ballot(need) != 0ull) {
                        const float d = need ? mx : 0.f;
                        mref += d; seen = (unseen && finite) ? 1.f : seen;
                        const float alpha = unseen ? 1.0f : __builtin_amdgcn_exp2f(-d);
                        lrun *= alpha;
#pragma unroll
                        for (int eb = 0; eb < EB; ++eb) O[eb] = O[eb] * alpha;
#pragma unroll
                        for (int i = 0; i < 16; ++i) { S0[i] -= d; S1[i] -= d; }
                    }
                    float ps = 0.f;
#pragma unroll
                    for (int i = 0; i < 16; ++i) { S0[i] = __builtin_amdgcn_exp2f(S0[i]); S1[i] = __builtin_amdgcn_exp2f(S1[i]); ps += S0[i] + S1[i]; }
                    lrun += ps;
                    bf16x8 P[4];
                    { u32x4 p;
                      p.x = pk_bf16(S0[0], S0[1]); p.y = pk_bf16(S0[2], S0[3]); p.z = pk_bf16(S0[4], S0[5]); p.w = pk_bf16(S0[6], S0[7]); P[0] = __builtin_bit_cast(bf16x8, p);
                      p.x = pk_bf16(S0[8], S0[9]); p.y = pk_bf16(S0[10], S0[11]); p.z = pk_bf16(S0[12], S0[13]); p.w = pk_bf16(S0[14], S0[15]); P[1] = __builtin_bit_cast(bf16x8, p);
                      p.x = pk_bf16(S1[0], S1[1]); p.y = pk_bf16(S1[2], S1[3]); p.z = pk_bf16(S1[4], S1[5]); p.w = pk_bf16(S1[6], S1[7]); P[2] = __builtin_bit_cast(bf16x8, p);
                      p.x = pk_bf16(S1[8], S1[9]); p.y = pk_bf16(S1[10], S1[11]); p.z = pk_bf16(S1[12], S1[13]); p.w = pk_bf16(S1[14], S1[15]); P[3] = __builtin_bit_cast(bf16x8, p); }
                    if constexpr (EB == 4) {
                        bf16x8 vf1[8];
#pragma unroll
                        for (int i = 0; i < 8; ++i) { const int s4i = 2 + i / EB, eb = i % EB; vf1[i] = *(const LAS bf16x8*)(vbp + eb * 4096 + ((s4i << 5) ^ vt_x)); }
#pragma unroll
                        for (int i = 0; i < 8; ++i) { const int s4i = i / EB, eb = i % EB; O[eb] = MFMA32(vf0[i], P[s4i], O[eb]); }
#pragma unroll
                        for (int i = 0; i < 8; ++i) { const int s4i = 2 + i / EB, eb = i % EB; O[eb] = MFMA32(vf1[i], P[s4i], O[eb]); }
                        __builtin_amdgcn_sched_group_barrier(0x100, 8, 0); __builtin_amdgcn_sched_group_barrier(0x008, 16, 0);
                    } else {
#pragma unroll
                        for (int i = 0; i < 8; ++i) { const int s4i = i / EB, eb = i % EB; O[eb] = MFMA32(vf0[i], P[s4i], O[eb]); }
                    }
                }
            }
            slot = slot == 2 ? 0 : slot + 1;
        }
#undef ATT_ISSUE
        const float inv = 1.0f / (lrun + shx(lrun, 32, lane));
        bf16_t* op = MIX + (size_t)(b * SEQ + tq) * 1024 + mixcol + 4 * hb;
        if (MODE == 0) {
            bf16_t* o1p = (bf16_t*)OA1 + (size_t)(b * SEQ + tq) * 512 + h * 128 + 4 * hb;
            if (mp == 0) {
#pragma unroll
                for (int eb = 0; eb < EB; ++eb)
#pragma unroll
                    for (int g = 0; g < 4; ++g) *(u32x2*)(o1p + eb * 32 + 8 * g) = (u32x2){pk_bf16(O[eb][4 * g] * inv, O[eb][4 * g + 1] * inv), pk_bf16(O[eb][4 * g + 2] * inv, O[eb][4 * g + 3] * inv)};
            } else {
                const float c2 = lam * inv;
                float ss = 0.f;
#pragma unroll
                for (int eb = 0; eb < EB; ++eb)
#pragma unroll
                    for (int g = 0; g < 4; ++g) { const u32x2 o1h = *(const u32x2*)(o1p + eb * 32 + 8 * g); const f32x4 o1 = {bf_lo(o1h[0]), bf_hi(o1h[0]), bf_lo(o1h[1]), bf_hi(o1h[1])};
#pragma unroll
                        for (int j = 0; j < 4; ++j) { const float o = o1[j] - O[eb][4 * g + j] * c2; O[eb][4 * g + j] = o; ss += o * o; } }
                ss += shx(ss, 32, lane);
                const float r = rsqrtf(ss * (1.0f / 128.0f) + EPS) * (1.0f - lam_init);
#pragma unroll
                for (int eb = 0; eb < EB; ++eb)
#pragma unroll
                    for (int g = 0; g < 4; ++g) { const int e0 = eb * 32 + 8 * g;
                        *(u32x2*)(op + e0) = (u32x2){pk_bf16(O[eb][4 * g] * r, O[eb][4 * g + 1] * r), pk_bf16(O[eb][4 * g + 2] * r, O[eb][4 * g + 3] * r)}; }
            }
        } else {
#pragma unroll
            for (int eb = 0; eb < EB; ++eb)
#pragma unroll
                for (int g = 0; g < 4; ++g) { const int e0 = eb * 32 + 8 * g;
                    *(u32x2*)(op + e0) = (u32x2){pk_bf16(O[eb][4 * g] * inv, O[eb][4 * g + 1] * inv), pk_bf16(O[eb][4 * g + 2] * inv, O[eb][4 * g + 3] * inv)}; }
        }
    }
}


constexpr int IDX_STR = 2052;
__device__ __forceinline__ unsigned f2key(float f) { const unsigned u = __float_as_uint(f); return u ^ (((unsigned)((int)u >> 31)) | 0x80000000u); }
template <int J>
__device__ __forceinline__ void index_select(const LAS float* row, const int nb, const int lane, unsigned long long* mo) {
    unsigned u[J];
#pragma unroll
    for (int j = 0; j < J; ++j) u[j] = (j < nb) ? f2key(row[64 * j]) : 0u;
    unsigned prefix = 0u; bool exact = false;
#pragma unroll 1
    for (int bit = 31; bit >= 0; --bit) {
        const unsigned cand = prefix | (1u << bit);
        int c = 0;
#pragma unroll
        for (int j0 = 0; j0 < J; j0 += 8) {
            unsigned long long bm[8];
#pragma unroll
            for (int j = 0; j < 8; ++j) bm[j] = __ballot(u[j0 + j] >= cand);
            asm volatile("" : "+s"(bm[0]), "+s"(bm[1]), "+s"(bm[2]), "+s"(bm[3]), "+s"(bm[4]), "+s"(bm[5]), "+s"(bm[6]), "+s"(bm[7]));
#pragma unroll
            for (int j = 0; j < 8; ++j) c += (int)__builtin_popcountll(bm[j]);
        }
        if (c >= 256) prefix = cand;
        if (c == 256) { exact = true; break; }
    }
    unsigned thr = prefix; asm volatile("" : "+v"(thr));
    unsigned long long myword = 0ull;
    if (exact) {
#pragma unroll
        for (int j = 0; j < J; ++j) { const unsigned long long m = __ballot(u[j] >= thr); myword = (lane == j) ? m : myword; }
    } else {
        int cg = 0;
#pragma unroll
        for (int j = 0; j < J; ++j) cg += (int)__builtin_popcountll(__ballot(u[j] > thr));
        const int quota = 256 - cg;
        int taken = 0;
#pragma unroll
        for (int j = 0; j < J; ++j) {
            const bool eq = (u[j] == thr);
            const unsigned long long eqm = __ballot(eq);
            const int before = (int)__builtin_popcountll(eqm & ((1ull << lane) - 1ull));
            const unsigned long long m = __ballot((u[j] > thr) || (eq && (taken + before < quota)));
            taken += (int)__builtin_popcountll(eqm);
            myword = (lane == j) ? m : myword;
        }
    }
    if (lane < 32) mo[lane] = myword;
}
__device__ __forceinline__ void index_unit(LAS unsigned char* lds, const bf16_t* HQ, unsigned long long* MASK, const int b, const int tt, const int wave_in) {
    int wave = wave_in; asm volatile("" : "+s"(wave));
    int lane; asm volatile("v_mbcnt_lo_u32_b32 %0, -1, 0\n\tv_mbcnt_hi_u32_b32 %0, -1, %0" : "=&v"(lane));
    const int t0 = tt * 16, nb = (t0 >> 6) + 1, nk = nb * 64;
    if (nb <= 4) {
        for (int i = wave * 64 + lane; i < 16 * 32; i += 512) MASK[(size_t)(b * SEQ + t0 + (i >> 5)) * 32 + (i & 31)] = ((i & 31) < nb) ? ~0ull : 0ull;
        return;
    }
    LAS float* sc = (LAS float*)lds;
    const int q = lane & 15, g = lane >> 4;
    {
        const bf16_t* qrow = HQ + (size_t)(b * SEQ + t0 + q) * HQP;
        bf16x8 QI[8];
#pragma unroll
        for (int h = 0; h < 8; ++h) QI[h] = *(const bf16x8*)(qrow + HQ_QI + h * 32 + g * 8);
        float w[8];
        { const u32x4 wv = *(const u32x4*)(qrow + HQ_WI);
          w[0] = bf_lo(wv[0]) * 0.0625f; w[1] = bf_hi(wv[0]) * 0.0625f; w[2] = bf_lo(wv[1]) * 0.0625f; w[3] = bf_hi(wv[1]) * 0.0625f;
          w[4] = bf_lo(wv[2]) * 0.0625f; w[5] = bf_hi(wv[2]) * 0.0625f; w[6] = bf_lo(wv[3]) * 0.0625f; w[7] = bf_hi(wv[3]) * 0.0625f; }
        const bf16_t* kbase = HQ + (size_t)(b * SEQ + q) * HQP + HQ_KI + g * 8;
        for (int kb0 = wave; kb0 < nk / 16; kb0 += 32) {
            bf16x8 kf[4];
#pragma unroll
            for (int u = 0; u < 4; ++u) { const int kb = kb0 + 8 * u; kf[u] = (kb < nk / 16) ? *(const bf16x8*)(kbase + (size_t)kb * 16 * HQP) : (bf16x8){0, 0, 0, 0, 0, 0, 0, 0}; }
#pragma unroll
            for (int u = 0; u < 4; ++u) {
                const int kb = kb0 + 8 * u;
                if (kb < nk / 16) {
                    f32x4 acc = {0.f, 0.f, 0.f, 0.f};
#pragma unroll
                    for (int h = 0; h < 8; ++h) {
                        const f32x4 z = __builtin_amdgcn_mfma_f32_16x16x32_f16(kf[u], QI[h], (f32x4){0.f, 0.f, 0.f, 0.f}, 0, 0, 0);
#pragma unroll
                        for (int j = 0; j < 4; ++j) acc[j] = fmaf(w[h], fmaxf(z[j], 0.f), acc[j]);
                    }
#pragma unroll
                    for (int j = 0; j < 4; ++j) acc[j] += 0.0f;
                    *(LAS f32x4*)(sc + q * IDX_STR + kb * 16 + g * 4) = acc;
                }
            }
        }
    }
    __syncthreads();
#pragma unroll 1
    for (int qq = 0; qq < 2; ++qq) {
        const int ql = wave * 2 + qq;
        const LAS float* row = sc + ql * IDX_STR + lane;
        unsigned long long* mo = MASK + (size_t)(b * SEQ + t0 + ql) * 32;
        if (nb <= 8) index_select<8>(row, nb, lane, mo);
        else if (nb <= 16) index_select<16>(row, nb, lane, mo);
        else if (nb <= 24) index_select<24>(row, nb, lane, mo);
        else index_select<32>(row, nb, lane, mo);
    }
    __syncthreads();
}

__device__ __forceinline__ int att_order(const int i) {
    const unsigned long long t = (i < 8) ? 0x1D13161A171E1B1Full : (i < 16) ? 0x14150E0F18191C12ull : (i < 24) ? 0x08090C0D0A0B1011ull : 0x0001020304050607ull;
    return (int)((t >> ((i & 7) * 8)) & 0xffull);
}

struct Args {
    const float* x; const float* w_in; const float* lam_q1; const float* lam_k1; const float* lam_q2; const float* lam_k2; const float* subln_g; const float* rel_bias;
    const float* w_out; const float* ln1_g; const float* ln1_b; const float* w_router; const float* b_router; const float* w_gu; const float* b_gu;
    const float* w_down; const float* b_down; const float* ln2_g; const float* ln2_b;
    float* out; unsigned char* ws;
    int ph_lo, ph_hi, bar_region, pad;
};

constexpr int LDS_STAGE = 0;
constexpr int LDS_CTL = 135168;
constexpr int LDS_TSTART = LDS_CTL + 64;
constexpr int LDS_CNT = LDS_TSTART + 36 * 4;
constexpr int LDS_TILEE = LDS_CNT + 32 * 4;
constexpr int LDS_RT = LDS_TILEE + 576;
constexpr int LDS_GB = 147456;
constexpr int LDS_BYTES = 147456 + 8192;
static_assert(LDS_RT + (64 + 1024) * 4 <= LDS_BYTES && 16 * IDX_STR * 4 <= LDS_CTL, "LDS map");

__device__ __forceinline__ void transpose_item(const float* W, int N, int k0, int n0, int nvalid, bf16_t* WTrow0, float scale, LAS float* scr, int lane, const float* kgain = nullptr) {
#pragma unroll
    for (int i = 0; i < 32; ++i) { const int kk = 2 * i + (lane >> 5), col = lane & 31; scr[kk * 33 + col] = (col < nvalid) ? W[(size_t)(k0 + kk) * N + n0 + col] * (kgain ? scale * kgain[kk] : scale) : 0.f; }
    asm volatile("s_waitcnt lgkmcnt(0)" ::: "memory");
    const int c = lane & 7;
#pragma unroll
    for (int j = 0; j < 4; ++j) { const int n = (lane >> 3) + 8 * j; const LAS float* s = scr + (8 * c) * 33 + n;
        u32x4 o; o.x = pk_bf16(s[0 * 33], s[1 * 33]); o.y = pk_bf16(s[2 * 33], s[3 * 33]); o.z = pk_bf16(s[4 * 33], s[5 * 33]); o.w = pk_bf16(s[6 * 33], s[7 * 33]);
        if (n < nvalid) *(u32x4*)(WTrow0 + (size_t)n * 1024 + k0 + 8 * c) = o; }
    asm volatile("s_waitcnt lgkmcnt(0)" ::: "memory");
}
__device__ __forceinline__ void transpose_item_fp8(const float* W, int N, int k0, int n0, unsigned char* WTrow0, float scale, int lane) {
    const int rg = lane >> 4, cg = lane & 15;
    const float* src = W + (size_t)(k0 + 32 * rg) * N + n0 + 4 * cg;
    f32x4 v[32];
#pragma unroll
    for (int i = 0; i < 32; ++i) v[i] = __builtin_nontemporal_load((const f32x4*)(src + (size_t)i * N));
    unsigned char* dst = WTrow0 + (size_t)(4 * cg) * 1024 + k0 + 32 * rg;
#pragma unroll
    for (int j = 0; j < 4; ++j) {
#pragma unroll
        for (int h = 0; h < 2; ++h) {
            u32x4 o;
            o.x = pk4_fp8(v[16 * h + 0][j] * scale, v[16 * h + 1][j] * scale, v[16 * h + 2][j] * scale, v[16 * h + 3][j] * scale);
            o.y = pk4_fp8(v[16 * h + 4][j] * scale, v[16 * h + 5][j] * scale, v[16 * h + 6][j] * scale, v[16 * h + 7][j] * scale);
            o.z = pk4_fp8(v[16 * h + 8][j] * scale, v[16 * h + 9][j] * scale, v[16 * h + 10][j] * scale, v[16 * h + 11][j] * scale);
            o.w = pk4_fp8(v[16 * h + 12][j] * scale, v[16 * h + 13][j] * scale, v[16 * h + 14][j] * scale, v[16 * h + 15][j] * scale);
            *(u32x4*)(dst + (size_t)j * 1024 + 16 * h) = o;
        }
    }
}
__device__ __forceinline__ void in_map(int n0, bool& isv, int& row, float& scale) {
    scale = 1.f; isv = false;
    if (n0 < 512) { row = HQ_QA + n0; scale = QSCALE; }
    else if (n0 < 1024) row = HQ_KA + (n0 - 512);
    else if (n0 < 1536) { isv = true; row = VT_A + (n0 - 1024); }
    else if (n0 < 1792) { row = HQ_QB + (n0 - 1536); scale = QSCALE; }
    else if (n0 < 2048) row = HQ_KB + (n0 - 1792);
    else if (n0 < 2304) { isv = true; row = VT_B + (n0 - 2048); }
    else if (n0 < 2560) { row = HQ_QC + (n0 - 2304); scale = QSCALE; }
    else if (n0 < 2816) row = HQ_KC + (n0 - 2560);
    else if (n0 < 3072) { isv = true; row = VT_C + (n0 - 2816); }
    else if (n0 < 3328) row = HQ_QI + (n0 - 3072);
    else if (n0 < 3360) row = HQ_KI + (n0 - 3328);
    else row = HQ_WI + (n0 - 3360);
}

__global__ void __launch_bounds__(512, 2) mega(Args a) {
    extern __shared__ __attribute__((aligned(16))) unsigned char lds_raw[];
    LAS unsigned char* lds = (LAS unsigned char*)lds_raw;
    const int G = gridDim.x, bid = blockIdx.x, NGW = G * 8;
    const int wave0 = __builtin_amdgcn_readfirstlane((int)threadIdx.x >> 6);
#define OPAQUE_IDS() int wave = wave0; asm volatile("" : "+s"(wave)); int lane; asm volatile("v_mbcnt_lo_u32_b32 %0, -1, 0\n\tv_mbcnt_hi_u32_b32 %0, -1, %0" : "=&v"(lane)); const int tid = wave * 64 + lane, gw = bid * 8 + wave; (void)tid; (void)gw
#define WSPTRS() __attribute__((address_space(1))) unsigned char* wsg_ = (__attribute__((address_space(1))) unsigned char*)a.ws; asm volatile("" : "+s"(wsg_)); unsigned char* ws = (unsigned char*)wsg_;     \
    unsigned* ctl = (unsigned*)(ws + WS_CTL); bf16_t* Win = (bf16_t*)(ws + WS_WIN); bf16_t* Wv = (bf16_t*)(ws + WS_WV); bf16_t* Wout = (bf16_t*)(ws + WS_WOUT); \
    bf16_t* Wgu = (bf16_t*)(ws + WS_WGU); bf16_t* Wdn = (bf16_t*)(ws + WS_WDN); bf16_t* XB = (bf16_t*)(ws + WS_XB); \
    bf16_t* HQ = (bf16_t*)(ws + WS_HQ); bf16_t* VT = (bf16_t*)(ws + WS_VT); bf16_t* MIX = (bf16_t*)(ws + WS_MIX); \
    bf16_t* Y1B = (bf16_t*)(ws + WS_Y1); bf16_t* X1B = (bf16_t*)(ws + WS_X1B); bf16_t* ACT = (bf16_t*)(ws + WS_ACT); bf16_t* YR = (bf16_t*)(ws + WS_YR); \
    int* TOKL = (int*)(ws + WS_TOKL); int* ASGE = (int*)(ws + WS_ASGE); int* ASGS = (int*)(ws + WS_ASGS); float* GATE = (float*)(ws + WS_GATE); \
    (void)ctl; (void)Win; (void)Wv; (void)Wout; (void)Wgu; (void)Wdn; (void)XB; (void)HQ; (void)VT; (void)MIX; (void)Y1B; (void)X1B; (void)ACT; (void)YR; (void)TOKL; (void)ASGE; (void)ASGS; (void)GATE
    for (int u = threadIdx.x; u < (LDS_BYTES - LDS_CTL) / 4; u += 512) ((LAS unsigned*)(lds + LDS_CTL))[u] = 0u;
    __syncthreads();
    XcdBarrier bar = xcd_barrier_post((unsigned*)(a.ws + WS_CTL) + CW_BAR + a.bar_region * XCD_BAR_WORDS, (volatile LAS unsigned*)(lds + LDS_CTL));
    const int lo = a.ph_lo, hi = a.ph_hi;
#define IN(k) (lo <= (k) && (k) < hi)
#define SEAM(k) do { if (IN(k) && IN((k) + 1)) xcd_barrier(bar); } while (0)

    if (IN(0)) PREP(0) {
        OPAQUE_IDS(); WSPTRS();
        LAS float* scr = (LAS float*)(lds + LDS_STAGE + wave * 16384);
        #if MOE_FP8
        constexpr int I_IN = 16 * 106, I_OUT = 16 * 32, I_GU = 8 * 32, I_DN = 8 * 16;
#else
        constexpr int I_IN = 16 * 106, I_OUT = 16 * 32, I_GU = 16 * 64, I_DN = 16 * 32;
#endif
        constexpr int N_IN = DEPTH * I_IN, N_OUT = DEPTH * I_OUT, N_GU = DEPTH * NE * I_GU, N_DN = DEPTH * NE * I_DN;
        constexpr int XC = 16, N_X = T * (D / 8) / 64 / XC;
        constexpr int N_ALL = N_IN + N_OUT + N_GU + N_DN + N_X;
        unsigned* qc = ctl + CW_Q + 120 * 32;
        volatile LAS int* qw = (volatile LAS int*)(lds + LDS_CTL + 48);
        int base, rnd = 0;
        if (tid == 0) qw[0] = (int)__hip_atomic_fetch_add(qc, 8u, __ATOMIC_RELAXED, __HIP_MEMORY_SCOPE_AGENT);
        __syncthreads();
        base = __builtin_amdgcn_readfirstlane(qw[0]);
#pragma unroll 1
        while (base < N_ALL) {
            int nv = 0; if (tid == 0) nv = (int)__hip_atomic_fetch_add(qc, 8u, __ATOMIC_RELAXED, __HIP_MEMORY_SCOPE_AGENT);
#pragma unroll 1
        for (int it = base + wave; it < base + wave + 1 && it < N_ALL; ++it) {
            int r = it;
            if (r < N_IN) { const int l = r / I_IN, q = r % I_IN, kb = q / 106, nb = q % 106, n0 = nb * 32; bool isv; int row; float sc; in_map(n0, isv, row, sc);
                bf16_t* dst = isv ? Wv + ((size_t)l * 1024 + row) * 1024 : Win + ((size_t)l * HQP + row) * 1024;
                transpose_item(a.w_in + (size_t)l * D * DIN, DIN, kb * 64, n0, (DIN - n0) < 32 ? (DIN - n0) : 32, dst, sc, scr, lane); continue; }
            r -= N_IN;
            if (r < N_OUT) { const int l = r / I_OUT, q = r % I_OUT, kb = q / 32, nb = q % 32;
                transpose_item(a.w_out + (size_t)l * 1024 * D, D, kb * 64, nb * 32, 32, Wout + ((size_t)l * D + nb * 32) * 1024, 1.f, scr, lane, kb < 8 ? a.subln_g + l * 128 + ((kb * 64) & 127) : nullptr); continue; }
            r -= N_OUT;
#if MOE_FP8
            if (r < N_GU) { const int le = r / I_GU, q = r % I_GU, kb = q >> 5, nb = q & 31, n0 = nb * 64;
                const int bj = n0 >> 10, rr = n0 & 1023, pn = rr >> 7, c = rr & 127, nrow = pn * 256 + bj * 128 + c;
                transpose_item_fp8(a.w_gu + (size_t)le * D * 2048, 2048, kb * 128, n0, (unsigned char*)Wgu + ((size_t)le * 2048 + nrow) * 1024, W8_SCALE, lane); continue; }
#else
            if (r < N_GU) { const int le = r / I_GU, q = r % I_GU, kb = q / 64, nb = q % 64, n0 = nb * 32;
                const int bj = n0 >> 10, rr = n0 & 1023, pn = rr >> 7, c = rr & 127, nrow = pn * 256 + bj * 128 + c;
                transpose_item(a.w_gu + (size_t)le * D * 2048, 2048, kb * 64, n0, 32, Wgu + ((size_t)le * 2048 + nrow) * 1024, 1.f, scr, lane); continue; }
#endif
            r -= N_GU;
#if MOE_FP8
            if (r < N_DN) { const int le = r / I_DN, q = r % I_DN, kb = q >> 4, nb = q & 15;
                transpose_item_fp8(a.w_down + (size_t)le * 1024 * D, D, kb * 128, nb * 64, (unsigned char*)Wdn + ((size_t)le * D + nb * 64) * 1024, W8_SCALE, lane); continue; }
#else
            if (r < N_DN) { const int le = r / I_DN, q = r % I_DN, kb = q / 32, nb = q % 32;
                transpose_item(a.w_down + (size_t)le * 1024 * D, D, kb * 64, nb * 32, 32, Wdn + ((size_t)le * D + nb * 32) * 1024, 1.f, scr, lane); continue; }
#endif
            r -= N_DN;
            {
                const size_t i0 = ((size_t)r * XC) * 64 + lane;
#pragma unroll
                for (int u0 = 0; u0 < XC; u0 += 8) {
                    f32x4 xv[8][2];
#pragma unroll
                    for (int u = 0; u < 8; ++u) { const size_t i = i0 + (size_t)(u0 + u) * 64; xv[u][0] = *(const f32x4*)(a.x + i * 8); xv[u][1] = *(const f32x4*)(a.x + i * 8 + 4); }
#pragma unroll
                    for (int u = 0; u < 8; ++u) { const size_t i = i0 + (size_t)(u0 + u) * 64;
                        u32x4 w; w.x = pk_bf16(xv[u][0][0], xv[u][0][1]); w.y = pk_bf16(xv[u][0][2], xv[u][0][3]); w.z = pk_bf16(xv[u][1][0], xv[u][1][1]); w.w = pk_bf16(xv[u][1][2], xv[u][1][3]); *(u32x4*)(XB + i * 8) = w; }
                }
            }
        }
            ++rnd;
            if (tid == 0) qw[rnd & 1] = nv;
            __syncthreads();
            base = __builtin_amdgcn_readfirstlane(qw[rnd & 1]);
        }
        for (int i = gw * 64 + lane; i < DEPTH * (HQP - HQ_USED) * 128; i += NGW * 64) { const int l = i / ((HQP - HQ_USED) * 128), q = i % ((HQP - HQ_USED) * 128);
            *(u32x4*)(Win + ((size_t)l * HQP + HQ_USED) * 1024 + (size_t)q * 8) = (u32x4){0u, 0u, 0u, 0u}; }
        { bf16_t* WRH = (bf16_t*)(ws + WS_WRT); bf16_t* WRL = WRH + (size_t)DEPTH * NE * D;
          for (int i = gw * 64 + lane; i < DEPTH * NE * D; i += NGW * 64) { const int ll = i / (NE * D), r = i % (NE * D), e = r / D, c = r % D; const float w = a.w_router[((size_t)ll * D + c) * NE + e];
              const unsigned h = pk_bf16(w, 0.f) & 0xffffu; WRH[i] = (bf16_t)h; WRL[i] = (bf16_t)(pk_bf16(w - bf_lo(h), 0.f) & 0xffffu); } }
    }
    SEAM(0);

#pragma unroll 1
    for (int l = 0; l < DEPTH; ++l) {
        const int pb = 1 + 8 * l;
        if (IN(pb + 0)) PREP(1) {
            WSPTRS();
            pg8::InProjOrder S{G, bid, (const char*)(Win + (size_t)l * HQP * 1024), (const char*)(Wv + (size_t)l * 1024 * 1024), (const char*)XB};
            pg8::EpiInProj E{HQ, VT};
            pg8::gemm_phase<pg8::EpiInProj, pg8::InProjOrder, false>(lds + LDS_STAGE, XB, 1024, S, E, wave0);
        }
        SEAM(pb + 0);
        if (IN(pb + 1)) {
            OPAQUE_IDS(); WSPTRS();
            unsigned long long* MASKp = (unsigned long long*)(ws + WS_MASK); float* OA1p = (float*)(ws + WS_OA1);
            const float lam_init = 0.8f - 0.6f * expf(-0.3f * (float)l);
            const float lam = expf(wsum(a.lam_q1[l * 64 + lane] * a.lam_k1[l * 64 + lane], lane)) - expf(wsum(a.lam_q2[l * 64 + lane] * a.lam_k2[l * 64 + lane], lane)) + lam_init;
            const int v0 = (G % 8 == 0) ? (bid & 7) * (G >> 3) + (bid >> 3) : bid;
            for (int v = v0; v < 256; v += G) {
                const int b = v >> 4, h = (v >> 2) & 3, q0 = v & 3;
#pragma unroll 1
                for (int rep = 0; rep < 2; ++rep) attn_unit<0>(lds + LDS_STAGE, HQ, VT, MIX, MASKp, OA1p, b, rep ? 3 - h : h, rep ? 7 - q0 : q0, wave, lane, lam, lam_init, a.subln_g + l * 128, nullptr);
            }
            {
                const int nq = 1, bq = 16 / nq, qid = 0;
                unsigned* qctr = ctl + CW_Q + ((l * 2 + 0) * 8 + qid) * 32;
                volatile LAS int* qw = (volatile LAS int*)(lds + LDS_CTL + 48);
#pragma unroll 1
                for (;;) {
                    __syncthreads();
                    if (tid == 0) *qw = (int)__hip_atomic_fetch_add(qctr, 1u, __ATOMIC_RELAXED, __HIP_MEMORY_SCOPE_AGENT);
                    __syncthreads();
                    const int u = __builtin_amdgcn_readfirstlane(*qw);
                    if (u >= 128 * bq) break;
                    index_unit(lds + LDS_STAGE, HQ, MASKp, qid * bq + (u % bq), 127 - u / bq, wave);
                }
            }
        }
        SEAM(pb + 1);
        if (IN(pb + 2)) {
            OPAQUE_IDS(); WSPTRS();
            unsigned long long* MASKp = (unsigned long long*)(ws + WS_MASK); float* OA1p = (float*)(ws + WS_OA1);
            {
                const int nq = (G % 8 == 0) ? 8 : 1, bq = 16 / nq, qid = (nq == 8) ? (bid & 7) : 0;
                unsigned* qctr = ctl + CW_Q + ((l * 2 + 1) * 8 + qid) * 32;
                volatile LAS int* qw = (volatile LAS int*)(lds + LDS_CTL + 48);
#pragma unroll 1
                for (;;) {
                    __syncthreads();
                    if (tid == 0) *qw = (int)__hip_atomic_fetch_add(qctr, 1u, __ATOMIC_RELAXED, __HIP_MEMORY_SCOPE_AGENT);
                    __syncthreads();
                    const int u = __builtin_amdgcn_readfirstlane(*qw);
                    if (u >= 64 * bq) break;
                    if (u < 32 * bq) { const int cb = att_order(u / bq), b = qid * bq + u % bq;
                        attn_unit<2>(lds + LDS_STAGE, HQ, VT, MIX, MASKp, OA1p, b, cb & 3, cb >> 2, wave, lane, 0.f, 0.f, nullptr, nullptr); }
                    else { const int u2 = u - 32 * bq, cb = 31 - u2 / bq, b = qid * bq + u2 % bq, h = cb & 3;
                        attn_unit<1>(lds + LDS_STAGE, HQ, VT, MIX, MASKp, OA1p, b, h, cb >> 2, wave, lane, 0.f, 0.f, nullptr, a.rel_bias + ((size_t)l * 4 + h) * 257); }
                }
            }
        }
        SEAM(pb + 2);
        if (IN(pb + 3)) PREP(6) {
            WSPTRS();
            pg8::DenseOrder S{T / 256, 4, G, bid, (const char*)(Wout + (size_t)l * 1024 * 1024), 1024, false};
            pg8::EpiResBf16 E{Y1B, XB};
            pg8::gemm_phase<pg8::EpiResBf16, pg8::DenseOrder, false>(lds + LDS_STAGE, MIX, 1024, S, E, wave0);
        }
        SEAM(pb + 3);
        if (IN(pb + 4)) PREP(10) {
            OPAQUE_IDS(); WSPTRS();
            if (PROBE == 10 && _rp == 0) { TOKL = (int*)(ws + WS_END); ASGE = TOKL + NE * T; ASGS = ASGE + NASG; GATE = (float*)(ASGS + NASG); }
            LAS int* lcnt = (LAS int*)(lds + LDS_RT); LAS int* lbase = lcnt + 32; LAS int* asg_e = lcnt + 64; LAS int* asg_ls = asg_e + 512;
            const float* g1 = a.ln1_g + l * D; const float* b1 = a.ln1_b + l * D; const float* br = a.b_router + l * NE;
            unsigned* gcnt = ctl + CW_CNT + l * 64 + ((PROBE == 10 && _rp == 0) ? 4096 : 0);
            { const u32x4* srch = (const u32x4*)(ws + WS_WRT) + (size_t)l * 4096; const u32x4* srcl = (const u32x4*)(ws + WS_WRT + (size_t)DEPTH * NE * D * 2) + (size_t)l * 4096;
              for (int i = tid; i < 4096; i += 512) { const int e = i >> 7, c = i & 127, dst = e * 2048 + ((c ^ (e & 15)) << 4);
                  *(LAS u32x4*)(lds + LDS_STAGE + dst) = srch[i]; *(LAS u32x4*)(lds + LDS_STAGE + 65536 + dst) = srcl[i]; } }
            LAS float* st = (LAS float*)(lds + 131072);
            LAS float* g1l = (LAS float*)(lds + LDS_GB); LAS float* b1l = g1l + 1024;
            for (int i = tid; i < 1024; i += 512) { g1l[i] = g1[i]; b1l[i] = b1[i]; }
            for (int unit = bid; unit < T / 128; unit += G) {
                if (tid < 32) lcnt[tid] = 0;
                __syncthreads();
#pragma unroll 1
                for (int k = 0; k < 8; ++k) {
                    const int tl0 = wave * 16 + 2 * k, t0 = unit * 128 + tl0;
                    float v[2][16];
#pragma unroll
                    for (int tk = 0; tk < 2; ++tk)
#pragma unroll
                        for (int i = 0; i < 4; ++i) { const u32x2 u2 = *(const u32x2*)(Y1B + (size_t)(t0 + tk) * D + i * 256 + lane * 4); v[tk][4 * i] = bf_lo(u2[0]); v[tk][4 * i + 1] = bf_hi(u2[0]); v[tk][4 * i + 2] = bf_lo(u2[1]); v[tk][4 * i + 3] = bf_hi(u2[1]); }
#pragma unroll
                    for (int tk = 0; tk < 2; ++tk) {
                        float s_ = 0.f;
#pragma unroll
                        for (int i = 0; i < 16; ++i) s_ += v[tk][i];
                        const float mean = wsum(s_, lane) * (1.0f / 1024.0f);
                        float qv = 0.f;
#pragma unroll
                        for (int i = 0; i < 16; ++i) { const float d = v[tk][i] - mean; qv += d * d; }
                        const float rstd = rsqrtf(wsum(qv, lane) * (1.0f / 1024.0f) + EPS);
                        if (lane == 0) { st[(tl0 + tk) * 2] = mean; st[(tl0 + tk) * 2 + 1] = rstd; }
                    }
                }
                asm volatile("s_waitcnt lgkmcnt(0)" ::: "memory");
                __builtin_amdgcn_wave_barrier();
                {
                    const int tk = lane & 15, kg = lane >> 4, tl = wave * 16 + tk, t = unit * 128 + tl;
                    const float mean = st[tl * 2], rstd = st[tl * 2 + 1];
                    f32x4 acc0 = {0.f, 0.f, 0.f, 0.f}, acc1 = acc0;
                    const bf16_t* yrow = Y1B + (size_t)t * D + kg * 8;
                    const int e0 = tk, e1 = 16 + tk;
                    const LAS unsigned char* w0p = lds + LDS_STAGE + e0 * 2048; const LAS unsigned char* w1p = lds + LDS_STAGE + e1 * 2048;
                    u32x4 y8n[4];
#pragma unroll
                    for (int u = 0; u < 4; ++u) y8n[u] = __builtin_nontemporal_load((const u32x4*)(yrow + u * 32));
#pragma unroll 1
                    for (int ks0 = 0; ks0 < 32; ks0 += 4) {
                    u32x4 y8v[4];
#pragma unroll
                    for (int u = 0; u < 4; ++u) y8v[u] = y8n[u];
                    { const int kn = (ks0 + 4 < 32) ? ks0 + 4 : ks0;
#pragma unroll
                      for (int u = 0; u < 4; ++u) y8n[u] = __builtin_nontemporal_load((const u32x4*)(yrow + (kn + u) * 32)); }
#pragma unroll
                    for (int u = 0; u < 4; ++u) {
                        const int ks = ks0 + u;
                        const int k0 = ks * 32 + kg * 8;
                        const u32x4 y8 = y8v[u];
                        const f32x4 ga = *(const LAS f32x4*)(g1l + k0), gb = *(const LAS f32x4*)(g1l + k0 + 4), ba = *(const LAS f32x4*)(b1l + k0), bb = *(const LAS f32x4*)(b1l + k0 + 4);
                        float x[8];
                        x[0] = (bf_lo(y8[0]) - mean) * rstd * ga[0] + ba[0]; x[1] = (bf_hi(y8[0]) - mean) * rstd * ga[1] + ba[1];
                        x[2] = (bf_lo(y8[1]) - mean) * rstd * ga[2] + ba[2]; x[3] = (bf_hi(y8[1]) - mean) * rstd * ga[3] + ba[3];
                        x[4] = (bf_lo(y8[2]) - mean) * rstd * gb[0] + bb[0]; x[5] = (bf_hi(y8[2]) - mean) * rstd * gb[1] + bb[1];
                        x[6] = (bf_lo(y8[3]) - mean) * rstd * gb[2] + bb[2]; x[7] = (bf_hi(y8[3]) - mean) * rstd * gb[3] + bb[3];
                        u32x4 hx; hx.x = pk_bf16(x[0], x[1]); hx.y = pk_bf16(x[2], x[3]); hx.z = pk_bf16(x[4], x[5]); hx.w = pk_bf16(x[6], x[7]);
                        *(u32x4*)(X1B + (size_t)t * D + k0) = hx;
#if MOE_FP8
                        *(u32x2*)(ws + WS_X1Q + (size_t)t * D + k0) = (u32x2){pk4_fp8(x[0] * X8_SCALE, x[1] * X8_SCALE, x[2] * X8_SCALE, x[3] * X8_SCALE), pk4_fp8(x[4] * X8_SCALE, x[5] * X8_SCALE, x[6] * X8_SCALE, x[7] * X8_SCALE)};
#endif
                        u32x4 lx; lx.x = pk_bf16(x[0] - bf_lo(hx.x), x[1] - bf_hi(hx.x)); lx.y = pk_bf16(x[2] - bf_lo(hx.y), x[3] - bf_hi(hx.y));
                        lx.z = pk_bf16(x[4] - bf_lo(hx.z), x[5] - bf_hi(hx.z)); lx.w = pk_bf16(x[6] - bf_lo(hx.w), x[7] - bf_hi(hx.w));
                        const bf16x8 xh = __builtin_bit_cast(bf16x8, hx), xl = __builtin_bit_cast(bf16x8, lx);
                        const int c0 = ((ks * 4 + kg) ^ tk) << 4;
                        const bf16x8 wh0 = *(const LAS bf16x8*)(w0p + c0), wl0 = *(const LAS bf16x8*)(w0p + 65536 + c0);
                        const bf16x8 wh1 = *(const LAS bf16x8*)(w1p + c0), wl1 = *(const LAS bf16x8*)(w1p + 65536 + c0);
                        acc0 = __builtin_amdgcn_mfma_f32_16x16x32_f16(wh0, xh, acc0, 0, 0, 0); acc1 = __builtin_amdgcn_mfma_f32_16x16x32_f16(wh1, xh, acc1, 0, 0, 0);
                        acc0 = __builtin_amdgcn_mfma_f32_16x16x32_f16(wl0, xh, acc0, 0, 0, 0); acc1 = __builtin_amdgcn_mfma_f32_16x16x32_f16(wl1, xh, acc1, 0, 0, 0);
                        acc0 = __builtin_amdgcn_mfma_f32_16x16x32_f16(wh0, xl, acc0, 0, 0, 0); acc1 = __builtin_amdgcn_mfma_f32_16x16x32_f16(wh1, xl, acc1, 0, 0, 0);
                    }
                    }
                    float lv[8]; int li[8];
                    { const f32x4 b0 = *(const f32x4*)(br + kg * 4), b1v = *(const f32x4*)(br + 16 + kg * 4);
#pragma unroll
                      for (int j = 0; j < 4; ++j) { lv[j] = acc0[j] + b0[j]; li[j] = kg * 4 + j; lv[4 + j] = acc1[j] + b1v[j]; li[4 + j] = 16 + kg * 4 + j; } }
                    int be[4]; float bv[4];
#pragma unroll
                    for (int kk = 0; kk < 4; ++kk) {
                        float m = lv[0]; int mi = li[0];
#pragma unroll
                        for (int i = 1; i < 8; ++i) if (lv[i] > m) { m = lv[i]; mi = li[i]; }
                        { const float om = shx(m, 16, lane); const int oi = __float_as_int(shx(__int_as_float(mi), 16, lane)); if (om > m || (om == m && oi < mi)) { m = om; mi = oi; } }
                        { const float om = shx(m, 32, lane); const int oi = __float_as_int(shx(__int_as_float(mi), 32, lane)); if (om > m || (om == m && oi < mi)) { m = om; mi = oi; } }
                        be[kk] = mi; bv[kk] = m;
#pragma unroll
                        for (int i = 0; i < 8; ++i) if (li[i] == mi) lv[i] = -3e38f;
                    }
                    float ex[4], es = 0.f;
#pragma unroll
                    for (int kk = 0; kk < 4; ++kk) { ex[kk] = __expf(bv[kk] - bv[0]); es += ex[kk]; }
                    if (kg == 0) {
#pragma unroll
                        for (int kk = 0; kk < 4; ++kk) { const int sl = __hip_atomic_fetch_add(&lcnt[be[kk]], 1, __ATOMIC_RELAXED, __HIP_MEMORY_SCOPE_WORKGROUP); asg_e[tl * 4 + kk] = be[kk]; asg_ls[tl * 4 + kk] = sl; GATE[t * 4 + kk] = ex[kk] / es; }
                    }
                }
                __syncthreads();
                if (tid < 32) lbase[tid] = (int)__hip_atomic_fetch_add(gcnt + tid, (unsigned)lcnt[tid], __ATOMIC_RELAXED, __HIP_MEMORY_SCOPE_AGENT);
                __syncthreads();
                { const int e = asg_e[tid], sl = lbase[e] + asg_ls[tid], t = unit * 128 + (tid >> 2);
                  TOKL[(size_t)e * T + sl] = t; ASGE[t * 4 + (tid & 3)] = e; ASGS[t * 4 + (tid & 3)] = sl; }
                __syncthreads();
            }
        }
        SEAM(pb + 4);
        LAS int* tstart = (LAS int*)(lds + LDS_TSTART); LAS int* lcntE = (LAS int*)(lds + LDS_CNT); LAS unsigned char* tile_e = lds + LDS_TILEE;
        if (IN(pb + 5) || IN(pb + 6) || IN(pb + 7)) {
            OPAQUE_IDS(); WSPTRS();
            if (tid < 32) lcntE[tid] = (int)__hip_atomic_load(ctl + CW_CNT + l * 64 + tid, __ATOMIC_RELAXED, __HIP_MEMORY_SCOPE_AGENT);
            __syncthreads();
            if (tid == 0) { int acc = 0; for (int e = 0; e < NE; ++e) { tstart[e] = acc; acc += (lcntE[e] + 255) >> 8; } tstart[32] = acc; }
            __syncthreads();
            for (int q = tid; q < MAXRT; q += 512) { int e = 0; for (int k = 0; k < NE; ++k) if (q >= tstart[k]) e = k; tile_e[q] = (unsigned char)e; }
            __syncthreads();
        }
        pg8::MoeTables tb{tstart, lcntE, tile_e, tstart[32]};
        if (IN(pb + 5)) PREP(7) {
            WSPTRS();
#if MOE_FP8
            pg8::MoeOrder S{tb, 8, G, bid, (const char*)Wgu + (size_t)l * NE * 2048 * 1024, (size_t)2048 * 1024, TOKL, true, 1024};
            pg8::EpiSwiglu<true> E{(void*)ACT, a.b_gu + (size_t)l * NE * 2048, 1.0f / (W8_SCALE * X8_SCALE)};
            pg8::gemm_phase<pg8::EpiSwiglu<true>, pg8::MoeOrder, true, 1>(lds + LDS_STAGE, (const bf16_t*)(ws + WS_X1Q), 1024, S, E, wave0);
#else
            pg8::MoeOrder S{tb, 8, G, bid, (const char*)(Wgu + (size_t)l * NE * 2048 * 1024), (size_t)2048 * 1024 * 2, TOKL, true, 2048};
            pg8::EpiSwiglu<false> E{(void*)ACT, a.b_gu + (size_t)l * NE * 2048, 1.0f};
            pg8::gemm_phase<pg8::EpiSwiglu<false>, pg8::MoeOrder, true>(lds + LDS_STAGE, X1B, 1024, S, E, wave0);
#endif
        }
        SEAM(pb + 5);
        if (IN(pb + 6)) PREP(8) {
            WSPTRS();
#if MOE_FP8
            pg8::MoeOrder S{tb, 4, G, bid, (const char*)Wdn + (size_t)l * NE * 1024 * 1024, (size_t)1024 * 1024, TOKL, false, 1024};
            pg8::EpiBiasBf16 E{YR, a.b_down + (size_t)l * NE * 1024, 1.0f / (W8_SCALE * A8_SCALE)};
            pg8::gemm_phase<pg8::EpiBiasBf16, pg8::MoeOrder, false, 1>(lds + LDS_STAGE, ACT, 1024, S, E, wave0);
#else
            pg8::MoeOrder S{tb, 4, G, bid, (const char*)(Wdn + (size_t)l * NE * 1024 * 1024), (size_t)1024 * 1024 * 2, TOKL, false, 2048};
            pg8::EpiBiasBf16 E{YR, a.b_down + (size_t)l * NE * 1024, 1.0f};
            pg8::gemm_phase<pg8::EpiBiasBf16, pg8::MoeOrder, false>(lds + LDS_STAGE, ACT, 1024, S, E, wave0);
#endif
        }
        SEAM(pb + 6);
        if (IN(pb + 7)) PREP(9) {
            OPAQUE_IDS(); WSPTRS();
            const float* g2 = a.ln2_g + l * D; const float* b2 = a.ln2_b + l * D;
            f32x4 gg4[4], bb4[4];
#pragma unroll
            for (int i = 0; i < 4; ++i) { gg4[i] = *(const f32x4*)(g2 + i * 256 + lane * 4); bb4[i] = *(const f32x4*)(b2 + i * 256 + lane * 4); }
            for (int t0 = gw; t0 < T; t0 += 2 * NGW) {
                int e_[2][4], sl_[2][4]; float gk_[2][4];
#pragma unroll
                for (int u = 0; u < 2; ++u) { const int t = t0 + u * NGW;
#pragma unroll
                    for (int k = 0; k < 4; ++k) { e_[u][k] = ASGE[t * 4 + k]; sl_[u][k] = ASGS[t * 4 + k]; gk_[u][k] = GATE[t * 4 + k]; } }
                u32x2 xr[2][4], yr[2][4][4];
#pragma unroll
                for (int u = 0; u < 2; ++u) { const int t = t0 + u * NGW;
#pragma unroll
                    for (int i = 0; i < 4; ++i) xr[u][i] = __builtin_nontemporal_load((const u32x2*)(X1B + (size_t)t * D + i * 256 + lane * 4));
#pragma unroll
                    for (int k = 0; k < 4; ++k) { const bf16_t* yp = YR + ((size_t)tstart[e_[u][k]] * 256 + sl_[u][k]) * 1024;
#pragma unroll
                        for (int i = 0; i < 4; ++i) yr[u][k][i] = __builtin_nontemporal_load((const u32x2*)(yp + i * 256 + lane * 4)); } }
#pragma unroll
                for (int u = 0; u < 2; ++u) { const int t = t0 + u * NGW;
                    float v[16];
#pragma unroll
                    for (int i = 0; i < 4; ++i) { v[4 * i] = ALPHA * bf_lo(xr[u][i][0]); v[4 * i + 1] = ALPHA * bf_hi(xr[u][i][0]); v[4 * i + 2] = ALPHA * bf_lo(xr[u][i][1]); v[4 * i + 3] = ALPHA * bf_hi(xr[u][i][1]); }
#pragma unroll
                    for (int k = 0; k < 4; ++k) { const float gk = gk_[u][k];
#pragma unroll
                        for (int i = 0; i < 4; ++i) { const u32x2 u2 = yr[u][k][i];
                            v[4 * i] += gk * bf_lo(u2[0]); v[4 * i + 1] += gk * bf_hi(u2[0]); v[4 * i + 2] += gk * bf_lo(u2[1]); v[4 * i + 3] += gk * bf_hi(u2[1]); } }
                    float s_ = 0.f;
#pragma unroll
                    for (int i = 0; i < 16; ++i) s_ += v[i];
                    const float mean = wsum(s_, lane) * (1.0f / 1024.0f);
                    float qv = 0.f;
#pragma unroll
                    for (int i = 0; i < 16; ++i) { const float d = v[i] - mean; qv += d * d; }
                    const float rstd = rsqrtf(wsum(qv, lane) * (1.0f / 1024.0f) + EPS);
#pragma unroll
                    for (int i = 0; i < 4; ++i) {
                        const int c0 = i * 256 + lane * 4;
                        const f32x4 gg = gg4[i], bb = bb4[i];
                        float o[4];
#pragma unroll
                        for (int j = 0; j < 4; ++j) o[j] = (v[4 * i + j] - mean) * rstd * gg[j] + bb[j];
                        if (l == DEPTH - 1) *(f32x4*)(a.out + (size_t)t * D + c0) = (f32x4){o[0], o[1], o[2], o[3]};
                        else *(u32x2*)(XB + (size_t)t * D + c0) = (u32x2){pk_bf16(o[0], o[1]), pk_bf16(o[2], o[3])};
                    }
                }
            }
        }
        if (l + 1 < DEPTH) SEAM(pb + 7);
    }
#undef IN
#undef SEAM
}

extern "C" void kernel_launch(void* const* d_in, const int* in_sizes, int n_in, void* d_out, int out_size, void* d_ws, size_t ws_size, hipStream_t stream) {
    static int grid = 0;
    if (grid == 0) {
        if (ws_size < WS_END) { fprintf(stderr, "kernel_launch: workspace too small (%zu < %zu)\n", ws_size, (size_t)WS_END); grid = -1; return; }
        int dev = 0, cus = 0, per_cu = 0;
        if (hipGetDevice(&dev) != hipSuccess || hipDeviceGetAttribute(&cus, hipDeviceAttributeMultiprocessorCount, dev) != hipSuccess) { grid = -1; return; }
        if (hipFuncSetAttribute((const void*)mega, hipFuncAttributeMaxDynamicSharedMemorySize, LDS_BYTES) != hipSuccess) { fprintf(stderr, "kernel_launch: hipFuncSetAttribute failed\n"); grid = -1; return; }
        if (hipOccupancyMaxActiveBlocksPerMultiprocessor(&per_cu, (const void*)mega, 512, LDS_BYTES) != hipSuccess || per_cu < 1) { fprintf(stderr, "kernel_launch: occupancy query says %d\n", per_cu); }
        (void)hipGetLastError();
        grid = cus;
        if (grid % 8 != 0) grid -= grid % 8;
    }
    if (grid < 0) return;
    (void)hipMemsetAsync((char*)d_ws + WS_CTL, 0, CTL_BYTES, stream);
    Args a{};
    a.x = (const float*)d_in[0]; a.w_in = (const float*)d_in[1]; a.lam_q1 = (const float*)d_in[2]; a.lam_k1 = (const float*)d_in[3]; a.lam_q2 = (const float*)d_in[4]; a.lam_k2 = (const float*)d_in[5];
    a.subln_g = (const float*)d_in[6]; a.rel_bias = (const float*)d_in[7]; a.w_out = (const float*)d_in[8]; a.ln1_g = (const float*)d_in[9]; a.ln1_b = (const float*)d_in[10];
    a.w_router = (const float*)d_in[11]; a.b_router = (const float*)d_in[12]; a.w_gu = (const float*)d_in[13]; a.b_gu = (const float*)d_in[14]; a.w_down = (const float*)d_in[15];
    a.b_down = (const float*)d_in[16]; a.ln2_g = (const float*)d_in[17]; a.ln2_b = (const float*)d_in[18];
    a.out = (float*)d_out; a.ws = (unsigned char*)d_ws; a.pad = 0;
    a.ph_lo = 0; a.ph_hi = 1 + 8 * DEPTH; a.bar_region = 0;
    hipLaunchKernelGGL(mega, dim3(grid), dim3(512), LDS_BYTES, stream, a);
}
```

```cpp
#include <hip/hip_runtime.h>
#include <stdint.h>
#include <cstdio>

#define LAS __attribute__((address_space(3)))
typedef unsigned short bf16_t;
typedef _Float16 bf16x8 __attribute__((ext_vector_type(8)));
typedef float f32x4 __attribute__((ext_vector_type(4)));
typedef float f32x2 __attribute__((ext_vector_type(2)));
typedef unsigned u32x4 __attribute__((ext_vector_type(4)));
typedef unsigned u32x2 __attribute__((ext_vector_type(2)));
typedef _Float16 bf16v2 __attribute__((ext_vector_type(2)));

constexpr int D = 1024, BATCH = 16, SEQ = 2048, T = BATCH * SEQ, DEPTH = 4;
constexpr int DIN = 3368;
constexpr int NE = 32;
constexpr float ALPHA = 1.681792830507429f;
constexpr float EPS = 1e-5f;
constexpr float LOG2E = 1.4426950408889634f;
constexpr float QSCALE = 0.125f * LOG2E;
constexpr int HQP = 2560;
constexpr int HQ_QA = 0, HQ_KA = 512, HQ_QB = 1024, HQ_KB = 1280, HQ_QC = 1536, HQ_KC = 1792, HQ_QI = 2048, HQ_KI = 2304, HQ_WI = 2336, HQ_USED = 2344;
constexpr int VT_A = 0, VT_B = 512, VT_C = 768;
constexpr int NASG = T * 4;
constexpr int GROWS = NASG + NE * 256;
constexpr int MAXRT = GROWS / 256;

constexpr size_t MiB = (size_t)1 << 20;
constexpr size_t al(size_t x) { return (x + 255) & ~(size_t)255; }
constexpr size_t WS_CTL = 0, CTL_BYTES = 4 * MiB;
constexpr size_t WS_WIN = WS_CTL + CTL_BYTES;
constexpr size_t WS_WV = WS_WIN + al((size_t)DEPTH * HQP * D * 2);
constexpr size_t WS_WOUT = WS_WV + al((size_t)DEPTH * 1024 * D * 2);
constexpr size_t WS_WGU = WS_WOUT + al((size_t)DEPTH * D * 1024 * 2);
constexpr size_t WS_WDN = WS_WGU + al((size_t)DEPTH * NE * 2048 * D * 2);
constexpr size_t WS_XB = WS_WDN + al((size_t)DEPTH * NE * D * 1024 * 2);
constexpr size_t WS_HQ = WS_XB + al((size_t)T * D * 2);
constexpr size_t WS_VT = WS_HQ + al((size_t)T * HQP * 2);
constexpr size_t WS_MIX = WS_VT + al((size_t)1024 * T * 2);
constexpr size_t WS_Y1 = WS_MIX + al((size_t)T * 1024 * 2);
constexpr size_t WS_X1B = WS_Y1 + al((size_t)T * D * 2);
constexpr size_t WS_ACT = WS_X1B + al((size_t)T * D * 2);
constexpr size_t WS_YR = WS_ACT + al((size_t)GROWS * 1024 * 2);
constexpr size_t WS_MASK = WS_YR + al((size_t)GROWS * 1024 * 2);
constexpr size_t WS_TOKL = WS_MASK + al((size_t)T * 32 * 8);
constexpr size_t WS_ASGE = WS_TOKL + al((size_t)NE * T * 4);
constexpr size_t WS_ASGS = WS_ASGE + al((size_t)NASG * 4);
constexpr size_t WS_GATE = WS_ASGS + al((size_t)NASG * 4);
constexpr size_t WS_OA1 = WS_GATE + al((size_t)NASG * 4);
constexpr size_t WS_WRT = WS_OA1 + al((size_t)T * 512 * 4);
constexpr size_t WS_X1Q = WS_WRT + al((size_t)DEPTH * NE * D * 4);
constexpr size_t WS_END = WS_X1Q + al((size_t)T * D);
constexpr int CW_BAR = 4096;
constexpr int CW_CNT = 262144;
constexpr int CW_Q = 524288;

#ifndef MOE_FP8
#define MOE_FP8 1
#ifndef OUT_FP8
#define OUT_FP8 1
#endif
#endif
constexpr int RTP = 2;
constexpr float W8_SCALE = 512.0f;
constexpr float M8_SCALE = 16.0f;
#ifndef YR_FP8
#define YR_FP8 1
#endif
constexpr float Y8_SCALE = 64.0f;
constexpr float X8_SCALE = 16.0f;
constexpr float A8_SCALE = 4.0f;
typedef int i32x8 __attribute__((ext_vector_type(8)));
__device__ __forceinline__ unsigned pk_bf16(float lo, float hi) { f32x2 v = {lo, hi}; return __builtin_bit_cast(unsigned, __builtin_convertvector(v, bf16v2)); }
__device__ __forceinline__ float clamp8(float x) { return __builtin_fminf(__builtin_fmaxf(x, -448.0f), 448.0f); }
__device__ __forceinline__ unsigned pk4_fp8(float a, float b, float c, float d) {
    int w = 0; w = __builtin_amdgcn_cvt_pk_fp8_f32(clamp8(a), clamp8(b), w, false); w = __builtin_amdgcn_cvt_pk_fp8_f32(clamp8(c), clamp8(d), w, true); return (unsigned)w; }
__device__ __forceinline__ float bf_lo(unsigned u) { return (float)__builtin_bit_cast(bf16v2, u)[0]; }
__device__ __forceinline__ float bf_hi(unsigned u) { return (float)__builtin_bit_cast(bf16v2, u)[1]; }
__device__ __forceinline__ float bf2f(bf16_t b) { return (float)__builtin_bit_cast(bf16v2, (unsigned)b)[0]; }
__device__ __forceinline__ float wave_sum(float v) {
#pragma unroll
    for (int o = 32; o > 0; o >>= 1) v += __shfl_xor(v, o);
    return v; }
__device__ __forceinline__ float wave_max(float v) {
#pragma unroll
    for (int o = 32; o > 0; o >>= 1) v = fmaxf(v, __shfl_xor(v, o));
    return v; }
__device__ __forceinline__ int wave_sum_i(int v) {
#pragma unroll
    for (int o = 32; o > 0; o >>= 1) v += __shfl_xor(v, o);
    return v; }

__device__ __forceinline__ float shx(float v, int o, int lane) { return __int_as_float(__builtin_amdgcn_ds_bpermute((lane ^ o) << 2, __float_as_int(v))); }
__device__ __forceinline__ float wsum(float v, int lane) {
    (void)lane;
#define WS_DPP(x, ctrl, rmask, bc) __builtin_bit_cast(float, __builtin_amdgcn_update_dpp(0, __builtin_bit_cast(int, (x)), (ctrl), (rmask), 0xf, (bc)))
    v += WS_DPP(v, 0xB1, 0xf, true);
    v += WS_DPP(v, 0x4E, 0xf, true);
    v += WS_DPP(v, 0x141, 0xf, true);
    v += WS_DPP(v, 0x140, 0xf, true);
    v += WS_DPP(v, 0x142, 0xa, false);
    v += WS_DPP(v, 0x143, 0xc, false);
#undef WS_DPP
    return __builtin_bit_cast(float, __builtin_amdgcn_readlane(__builtin_bit_cast(int, v), 63)); }
__device__ __forceinline__ float wmax(float v, int lane) {
#pragma unroll
    for (int o = 32; o > 0; o >>= 1) v = fmaxf(v, shx(v, o, lane));
    return v; }

#define XB_TMO      128
#define XB_XCNT(j)  (256  + 64 * (j))
#define XB_XSUB(j)  (1280 + 64 * (j))
#define XB_XGEN(j)  (2304 + 64 * (j))
#define XB_TOP      3328
#define XB_TOPGEN   3392
#define XCD_BAR_WORDS 3456
#define XB_SPIN_CAP (1u << 22)
__device__ __forceinline__ unsigned xb_ld(unsigned* p)              { return __hip_atomic_load(p, __ATOMIC_RELAXED, __HIP_MEMORY_SCOPE_AGENT); }
__device__ __forceinline__ unsigned xb_add(unsigned* p, unsigned v) { return __hip_atomic_fetch_add(p, v, __ATOMIC_RELAXED, __HIP_MEMORY_SCOPE_AGENT); }
__device__ __forceinline__ unsigned xb_xcc_id() { return (unsigned)__builtin_amdgcn_s_getreg((3 << 11) | 20) & 0xFu; }
#define XB_SPIN(cond, bar) do { unsigned _sp = 0; while (cond) { __builtin_amdgcn_s_sleep(1); \
    if ((++_sp & 255u) == 0u) { if (xb_ld(&(bar)[XB_TMO])) break; if (_sp > XB_SPIN_CAP) { atomicAdd(&(bar)[XB_TMO], 1u); break; } } } } while (0)
struct XcdBarrier { unsigned* bar; unsigned x; volatile LAS unsigned* st; };
__device__ __forceinline__ XcdBarrier xcd_barrier_post(unsigned* bar, volatile LAS unsigned* st) {
    XcdBarrier b; b.bar = bar; b.x = xb_xcc_id(); b.st = st;
    if (threadIdx.x == 0) (void)xb_add(&bar[XB_XCNT(b.x)], 1u);
    return b;
}
__device__ __forceinline__ void xcd_barrier_complete(unsigned* bar, unsigned x, unsigned& nloc, unsigned& nx) {
    const unsigned G = gridDim.x * gridDim.y * gridDim.z;
    unsigned sum, cnt, mine, sp = 0u;
    for (;;) {
        sum = 0u; cnt = 0u; mine = 0u;
#pragma unroll
        for (unsigned j = 0; j < 16; ++j) { const unsigned c = xb_ld(&bar[XB_XCNT(j)]); sum += c; cnt += (c > 0u) ? 1u : 0u; mine = (j == x) ? c : mine; }
        if (sum == G) break;
        __builtin_amdgcn_s_sleep(1);
        if ((++sp & 255u) == 0u) { if (xb_ld(&bar[XB_TMO])) break; if (sp > XB_SPIN_CAP) { atomicAdd(&bar[XB_TMO], 1u); break; } }
    }
    nloc = mine > 0u ? mine : 1u; nx = cnt > 0u ? cnt : 1u;
}
__device__ __forceinline__ void xcd_barrier(const XcdBarrier& b) {
    asm volatile("s_waitcnt vmcnt(0)" ::: "memory");
    __syncthreads();
    if (threadIdx.x == 0) {
        unsigned* bar = b.bar;
        __builtin_amdgcn_s_waitcnt(0);
        unsigned nloc = b.st[0], nx = b.st[1];
        if (nloc == 0u) { xcd_barrier_complete(bar, b.x, nloc, nx); b.st[0] = nloc; b.st[1] = nx; }
        const unsigned old = xb_add(&bar[XB_XSUB(b.x)], 1u);
        const unsigned gen = old / nloc;
        if (old + 1u == (gen + 1u) * nloc) {
            __builtin_amdgcn_fence(__ATOMIC_RELEASE, "agent");
            asm volatile("s_waitcnt vmcnt(0)" ::: "memory");
            const unsigned og = xb_add(&bar[XB_TOP], 1u);
            const unsigned tg = og / nx;
            if (og + 1u == (tg + 1u) * nx) xb_add(&bar[XB_TOPGEN], 1u);
            else XB_SPIN(xb_ld(&bar[XB_TOPGEN]) == tg, bar);
            __builtin_amdgcn_fence(__ATOMIC_ACQUIRE, "agent");
            xb_add(&bar[XB_XGEN(b.x)], 1u);
            asm volatile("s_waitcnt vmcnt(0)" ::: "memory");
        } else {
            XB_SPIN(xb_ld(&bar[XB_XGEN(b.x)]) == gen, bar);
            __builtin_amdgcn_fence(__ATOMIC_ACQUIRE, "agent");
            asm volatile("s_waitcnt vmcnt(0)" ::: "memory");
        }
    }
    __syncthreads();
}

namespace pg8 {
constexpr int BM = 256, BK = 64, HALF = 128, HTB = HALF * BK * 2, STAGE_BYTES = 8 * HTB;
__host__ __device__ __forceinline__ int lds_byte(int r, int c) { const int st = (r >> 4) * 2 + (c >> 5), rr = r & 15, cc = c & 31, ob = rr * 64 + cc * 2; return st * 1024 + (ob ^ (((ob >> 9) & 1) << 5)); }
__host__ __device__ __forceinline__ void stage_rc(int b, int& R, int& C) { const int st = b / 1024, sb = b % 1024, swz = sb ^ (((sb >> 9) & 1) << 5); R = (st >> 1) * 16 + swz / 64; C = (st & 1) * 32 + (swz % 64) / 2; }
__host__ __device__ __forceinline__ int perm32(int rho) { const int n = rho >> 4, i = rho & 15; return 8 * (i >> 2) + 4 * n + (i & 3); }

struct Unit {
    int row0;
    int col0;
    const char* Bt;
    const int* rows;
    int nvalid;
    int e;
};

template <class Epi, class Sched, bool GATHER, int ESZ = 2>
__device__ __forceinline__ void gemm_phase(LAS unsigned char* lds, const bf16_t* Abase, const int K, const Sched& S, const Epi& E, const int wid_in) {
    int wid = wid_in; asm volatile("" : "+s"(wid));
    int lane; asm volatile("v_mbcnt_lo_u32_b32 %0, -1, 0\n\tv_mbcnt_hi_u32_b32 %0, -1, %0" : "=&v"(lane));
    const int tid = wid * 64 + lane, wr = wid >> 2, wc = wid & 3, fr = lane & 15, fq = lane >> 4;
    const int nt = K * ESZ / 128;
    unsigned voffB[2];
#pragma unroll
    for (int i = 0; i < 2; ++i) { int R, C; stage_rc(tid * 16 + i * 8192, R, C); const int Rb = Epi::PERM ? ((R & ~31) + perm32(R & 31)) : R; voffB[i] = (unsigned)(Rb * K * ESZ + C * 2); }
    const size_t kstep = (size_t)(BK * 2);
    const size_t hstep = (size_t)HALF * K * ESZ;
    const unsigned ldsw = (unsigned)wid * 1024u;
    const int aoff = lds_byte(wr * 64 + fr, fq * 8), boff = lds_byte(wc * 32 + fr, fq * 8);
#define PG8_SA(b, h) (((b) * 2 + (h)) * HTB)
#define PG8_SB(b, h) ((4 + (b) * 2 + (h)) * HTB)
#define PG8_STAGE(bufoff, gbase, voff) do { _Pragma("unroll") for (int _i = 0; _i < 2; ++_i) \
        __builtin_amdgcn_global_load_lds((const unsigned*)((const char*)(gbase) + (voff)[_i]), (LAS unsigned*)(lds + (bufoff) + ldsw + _i * 8192), 16, 0, 0); } while (0)
#define PG8_LDA(dst, b, h) do { _Pragma("unroll") for (int m = 0; m < 4; ++m) _Pragma("unroll") for (int k = 0; k < 2; ++k) dst[m][k] = *(const LAS bf16x8*)(lds + PG8_SA(b, h) + aoff + m * 2048 + k * 1024); } while (0)
#define PG8_LDB(dst, b, h) do { _Pragma("unroll") for (int n = 0; n < 2; ++n) _Pragma("unroll") for (int k = 0; k < 2; ++k) dst[n][k] = *(const LAS bf16x8*)(lds + PG8_SB(b, h) + boff + n * 2048 + k * 1024); } while (0)
#define PG8_MMA(ai, bj, At, Bt) do { __builtin_amdgcn_s_setprio(1); _Pragma("unroll") for (int m = 0; m < 4; ++m) _Pragma("unroll") for (int n = 0; n < 2; ++n) { \
        if constexpr (ESZ == 2) { _Pragma("unroll") for (int k = 0; k < 2; ++k) acc[ai][bj][m][n] = __builtin_amdgcn_mfma_f32_16x16x32_f16(Bt[n][k], At[m][k], acc[ai][bj][m][n], 0, 0, 0); } \
        else {   \
            const u32x4 _a0 = __builtin_bit_cast(u32x4, At[m][0]), _a1 = __builtin_bit_cast(u32x4, At[m][1]), _b0 = __builtin_bit_cast(u32x4, Bt[n][0]), _b1 = __builtin_bit_cast(u32x4, Bt[n][1]); \
            const i32x8 _af = {(int)_a0[0], (int)_a0[1], (int)_a0[2], (int)_a0[3], (int)_a1[0], (int)_a1[1], (int)_a1[2], (int)_a1[3]}; \
            const i32x8 _bf = {(int)_b0[0], (int)_b0[1], (int)_b0[2], (int)_b0[3], (int)_b1[0], (int)_b1[1], (int)_b1[2], (int)_b1[3]}; \
              \
            asm volatile("v_mfma_scale_f32_16x16x128_f8f6f4 %0, %1, %2, %0, %3, %3 op_sel_hi:[0,0,0]" : "+v"(acc[ai][bj][m][n]) : "v"(_bf), "v"(_af), "v"(s8)); } } \
        __builtin_amdgcn_s_setprio(0); } while (0)
#define PG8_MMAZ(ai, bj, At, Bt) do { __builtin_amdgcn_s_setprio(1); _Pragma("unroll") for (int m = 0; m < 4; ++m) _Pragma("unroll") for (int n = 0; n < 2; ++n) { \
        if constexpr (ESZ == 2) { _Pragma("unroll") for (int k = 0; k < 2; ++k) acc[ai][bj][m][n] = __builtin_amdgcn_mfma_f32_16x16x32_f16(Bt[n][k], At[m][k], acc[ai][bj][m][n], 0, 0, 0); }     \
        else {   \
            const u32x4 _a0 = __builtin_bit_cast(u32x4, At[m][0]), _a1 = __builtin_bit_cast(u32x4, At[m][1]), _b0 = __builtin_bit_cast(u32x4, Bt[n][0]), _b1 = __builtin_bit_cast(u32x4, Bt[n][1]); \
            const i32x8 _af = {(int)_a0[0], (int)_a0[1], (int)_a0[2], (int)_a0[3], (int)_a1[0], (int)_a1[1], (int)_a1[2], (int)_a1[3]}; \
            const i32x8 _bf = {(int)_b0[0], (int)_b0[1], (int)_b0[2], (int)_b0[3], (int)_b1[0], (int)_b1[1], (int)_b1[2], (int)_b1[3]}; \
              \
            asm volatile("v_mfma_scale_f32_16x16x128_f8f6f4 %0, %1, %2, 0, %3, %3 op_sel_hi:[0,0,0]" : "+v"(acc[ai][bj][m][n]) : "v"(_bf), "v"(_af), "v"(s8)); } }     \
        __builtin_amdgcn_s_setprio(0); } while (0)
#define PG8_WAIT_V(n) asm volatile("s_waitcnt vmcnt(" #n ")" ::: "memory")
#define PG8_WAIT_VS() do { if (slack) { if constexpr (Epi::NST >= 16) asm volatile("s_waitcnt vmcnt(24)" ::: "memory"); else asm volatile("s_waitcnt vmcnt(16)" ::: "memory"); } else asm volatile("s_waitcnt vmcnt(8)" ::: "memory"); } while (0)
#define PG8_WAIT_L(n) asm volatile("s_waitcnt lgkmcnt(" #n ")" ::: "memory")
#define PG8_BAR __builtin_amdgcn_s_barrier()
#define PG8_SCHED __builtin_amdgcn_sched_barrier(0)
#define PG8_AOFFS(dst, u) do { _Pragma("unroll") for (int _h = 0; _h < 2; ++_h) _Pragma("unroll") for (int _i = 0; _i < 2; ++_i) { int _R, _C; stage_rc(tid * 16 + _i * 8192, _R, _C); \
        const int _r = _h * HALF + _R; const int _src = (_r < (u).nvalid) ? (u).rows[_r] : 0; dst[_h][_i] = (unsigned)(_src * K * ESZ + _C * 2); } } while (0)
#define PG8_IDXDMA(u, slot) do { if (wid == 0) __builtin_amdgcn_global_load_lds((const unsigned*)((const char*)(u).rows + lane * 16), (LAS unsigned*)(lds + STAGE_BYTES + (slot) * 1024), 16, 0, 0); } while (0)
#define PG8_STAGE_A(bufoff, h, ktb, usenext) do { if constexpr (GATHER) { const unsigned _o[2] = {(usenext) ? na[h][0] : oa[h][0], (usenext) ? na[h][1] : oa[h][1]}; PG8_STAGE(bufoff, cA + (ktb), _o); } \
        else { PG8_STAGE(bufoff, ((usenext) ? nA : cA) + (size_t)(h) * hstep + (ktb), voffA); } } while (0)
    Unit cur, nxt; int ui = 0;
    if (!S.next(0, cur)) return;
    f32x4 acc[2][2][4][2];
#pragma unroll
    for (int a = 0; a < 2; ++a)
#pragma unroll
        for (int b = 0; b < 2; ++b)
#pragma unroll
            for (int m = 0; m < 4; ++m)
#pragma unroll
                for (int n = 0; n < 2; ++n) { if constexpr (ESZ == 1 && !GATHER) asm volatile("" : "=v"(acc[a][b][m][n])); else acc[a][b][m][n] = (f32x4){0.f, 0.f, 0.f, 0.f}; }
    bf16x8 At[4][2], B0[2][2], B1[2][2];
    int s8 = 0x7F7F7F7F; asm volatile("" : "+v"(s8));
    unsigned oa[2][2], na[2][2], voffA[2];
    const char* cA; const char* nA; const char* cB = cur.Bt;
    if constexpr (GATHER) { PG8_AOFFS(oa, cur); cA = (const char*)Abase; nA = cA; voffA[0] = voffA[1] = 0u; if (S.next(1, nxt)) { PG8_IDXDMA(nxt, 1); } }
    else { cA = cur.rows ? (const char*)cur.rows : (const char*)Abase + (size_t)cur.row0 * K * ESZ; nA = cA;
#pragma unroll
        for (int i = 0; i < 2; ++i) { int R, C; stage_rc(tid * 16 + i * 8192, R, C); voffA[i] = (unsigned)(R * K * ESZ + C * 2); oa[0][i] = oa[1][i] = na[0][i] = na[1][i] = 0u; } }
    E.prefetch(cur, lds + STAGE_BYTES + 2048, wid, lane);
    PG8_STAGE(PG8_SB(0, 0), cB, voffB); PG8_STAGE(PG8_SB(0, 1), cB + hstep, voffB); PG8_STAGE_A(PG8_SA(0, 0), 0, 0, false); PG8_STAGE_A(PG8_SA(0, 1), 1, 0, false);
    if (wr == 1) PG8_BAR;
    PG8_WAIT_V(2); PG8_BAR;
    PG8_STAGE(PG8_SB(1, 0), cB + kstep, voffB); PG8_STAGE_A(PG8_SA(1, 0), 0, kstep, false); PG8_STAGE(PG8_SB(1, 1), cB + hstep + kstep, voffB);
    PG8_WAIT_V(6); PG8_BAR;
    for (;;) {
        const bool has_next = S.next(ui + 1, nxt);
        if constexpr (GATHER) {
            if (has_next) {
                const LAS int* li = (const LAS int*)(lds + STAGE_BYTES + ((ui + 1) & 1) * 1024);
#pragma unroll
                for (int h = 0; h < 2; ++h)
#pragma unroll
                    for (int i = 0; i < 2; ++i) { int R, C; stage_rc(tid * 16 + i * 8192, R, C); const int r = h * HALF + R; const int src = (r < nxt.nvalid) ? li[r] : 0; na[h][i] = (unsigned)(src * K * ESZ + C * 2); }
                asm volatile("" : "+v"(na[0][0]), "+v"(na[0][1]), "+v"(na[1][0]), "+v"(na[1][1]));
            } else {
#pragma unroll
                for (int h = 0; h < 2; ++h)
#pragma unroll
                    for (int i = 0; i < 2; ++i) na[h][i] = oa[h][i];
            }
            Unit n2;
            if (has_next && S.next(ui + 2, n2)) { PG8_IDXDMA(n2, ui & 1); }
        } else nA = has_next ? (nxt.rows ? (const char*)nxt.rows : (const char*)Abase + (size_t)nxt.row0 * K * ESZ) : cA;
        const char* nB = has_next ? nxt.Bt : cB;
#define PG8_TRIP(MMF) do { \
            const bool last = (t == nt - 2); \
            const bool slack = (t == 0) && (ui > 0); \
            const size_t k1 = (size_t)(t + 1) * kstep, k2 = last ? 0 : (size_t)(t + 2) * kstep, k3 = k2 + kstep; \
            const char* b2 = last ? nB : cB + (size_t)(t + 2) * kstep; const char* b3 = b2 + kstep; \
            PG8_STAGE_A(PG8_SA(1, 1), 1, k1, false); PG8_SCHED; PG8_LDB(B0, 0, 0); PG8_LDB(B1, 0, 1); PG8_SCHED; PG8_LDA(At, 0, 0); \
            PG8_WAIT_VS(); PG8_WAIT_L(0); PG8_BAR; MMF(0, 0, At, B0); MMF(0, 1, At, B1); PG8_BAR; PG8_SCHED; \
            PG8_STAGE(PG8_SB(0, 0), b2, voffB); PG8_STAGE(PG8_SB(0, 1), b2 + hstep, voffB); PG8_STAGE_A(PG8_SA(0, 0), 0, k2, last); PG8_SCHED; PG8_LDA(At, 0, 1); \
            PG8_WAIT_VS(); PG8_WAIT_L(0); PG8_BAR; MMF(1, 0, At, B0); MMF(1, 1, At, B1); PG8_BAR; PG8_SCHED; \
            PG8_STAGE_A(PG8_SA(0, 1), 1, k2, last); PG8_SCHED; PG8_LDB(B0, 1, 0); PG8_LDB(B1, 1, 1); PG8_SCHED; PG8_LDA(At, 1, 0); \
            PG8_WAIT_V(8); PG8_WAIT_L(0); PG8_BAR; PG8_MMA(0, 0, At, B0); PG8_MMA(0, 1, At, B1); PG8_BAR; PG8_SCHED; \
            PG8_STAGE(PG8_SB(1, 0), b3, voffB); PG8_STAGE(PG8_SB(1, 1), b3 + hstep, voffB); PG8_STAGE_A(PG8_SA(1, 0), 0, k3, last); PG8_SCHED; PG8_LDA(At, 1, 1); \
            PG8_WAIT_V(8); PG8_WAIT_L(0); PG8_BAR; PG8_MMA(1, 0, At, B0); PG8_MMA(1, 1, At, B1); PG8_BAR; PG8_SCHED; \
        } while (0)
        if constexpr (ESZ == 1 && !GATHER) {
            { const int t = 0; PG8_TRIP(PG8_MMAZ); }
#pragma unroll 1
            for (int t = 2; t < nt; t += 2) { PG8_TRIP(PG8_MMA); }
        } else {
#pragma unroll 1
            for (int t = 0; t < nt; t += 2) { PG8_TRIP(PG8_MMA); }
        }
#undef PG8_TRIP
        if constexpr (ESZ == 1) asm volatile("s_nop 15\n\ts_nop 15" ::: "memory");
        if (wr == 0) PG8_BAR;
        E(acc, cur, wr, wc, fr, fq, (const LAS float*)(lds + STAGE_BYTES + 2048 + (ui & 1) * 1024));
        if (!has_next) break;
        if constexpr (ESZ == 2 || GATHER) {
#pragma unroll
            for (int a = 0; a < 2; ++a)
#pragma unroll
                for (int b = 0; b < 2; ++b)
#pragma unroll
                    for (int m = 0; m < 4; ++m)
#pragma unroll
                        for (int n = 0; n < 2; ++n) acc[a][b][m][n] = (f32x4){0.f, 0.f, 0.f, 0.f};
        }
        cur = nxt; cB = nB; ++ui;
        E.prefetch(cur, lds + STAGE_BYTES + 2048 + (ui & 1) * 1024, wid, lane);
        if constexpr (GATHER) {
#pragma unroll
            for (int h = 0; h < 2; ++h)
#pragma unroll
                for (int i = 0; i < 2; ++i) oa[h][i] = na[h][i];
        } else cA = nA;
        if (wr == 1) PG8_BAR;
    }
    PG8_WAIT_V(0);
    PG8_BAR;
#undef PG8_SA
#undef PG8_SB
#undef PG8_STAGE
#undef PG8_LDA
#undef PG8_LDB
#undef PG8_MMA
#undef PG8_MMAZ
#undef PG8_WAIT_V
#undef PG8_WAIT_L
#undef PG8_WAIT_VS
#undef PG8_BAR
#undef PG8_SCHED
#undef PG8_AOFFS
#undef PG8_IDXDMA
#undef PG8_STAGE_A
}

struct DenseOrder {
    int nRT, nN, G, c; const char* Bt; int K; bool swap;
    __device__ __forceinline__ bool next(int i, Unit& u) const {
        const int xcd = c & 7, s = i * (G >> 3) + (c >> 3);
        int rt, pn;
        if (!swap) { rt = 8 * (s / nN) + xcd; pn = s % nN; } else { pn = 8 * (s / nRT) + xcd; rt = s % nRT; }
        if (rt >= nRT || pn >= nN) return false;
        u.row0 = rt * BM; u.col0 = pn * BM; u.Bt = Bt + (size_t)pn * BM * K * 2; u.rows = nullptr; u.nvalid = 0; u.e = 0; return true;
    }
};
struct InProjOrder {
    int G, c; const char* Win; const char* Wv; const char* Xb;
    __device__ __forceinline__ bool next(int i, Unit& u) const {
        constexpr int NM = (T / 256 / 8) * (HQP / 256), NV = (T / 256 / 8) * 4;
        const int xcd = c & 7, s = i * (G >> 3) + (c >> 3);
        if (s < NM) { const int rt = 8 * (s / (HQP / 256)) + xcd, pn = s % (HQP / 256);
            u.row0 = rt * BM; u.col0 = pn * BM; u.Bt = Win + (size_t)pn * BM * 2048; u.rows = (const int*)(Xb + (size_t)rt * BM * 2048); u.nvalid = 0; u.e = 0; return true; }
        const int s2 = s - NM;
        if (s2 >= NV) return false;
        const int pn = 8 * (s2 >> 2) + xcd, rt = s2 & 3;
        u.row0 = rt * BM; u.col0 = pn * BM; u.Bt = Xb + (size_t)pn * BM * 2048; u.rows = (const int*)(Wv + (size_t)rt * BM * 2048); u.nvalid = 0; u.e = 1; return true;
    }
};
struct MoeTables { LAS const int* tstart; LAS const int* cnt; LAS const unsigned char* tile_e; int nrt; };
struct MoeOrder {
    MoeTables tb; int nN, G, c; const char* Bt; size_t strideB; const int* tokl; bool gather; int rowb;
    __device__ __forceinline__ bool next(int i, Unit& u) const {
        const int xcd = c & 7, s = i * (G >> 3) + (c >> 3);
        const int q = 8 * (s / nN) + xcd, pn = s % nN;
        if (q >= tb.nrt) return false;
        const int e = __builtin_amdgcn_readfirstlane((int)tb.tile_e[q]); const int lt = q - __builtin_amdgcn_readfirstlane(tb.tstart[e]);
        u.row0 = q * BM; u.col0 = pn * BM; u.e = e; u.Bt = Bt + (size_t)e * strideB + (size_t)pn * BM * rowb;
        u.rows = gather ? tokl + (size_t)e * T + lt * BM : nullptr; u.nvalid = __builtin_amdgcn_readfirstlane(tb.cnt[e]) - lt * BM; return true;
    }
};

struct EpiBf16Plain {
    __device__ __forceinline__ void prefetch(const Unit&, LAS unsigned char*, int, int) const {}
    static constexpr bool PERM = true; static constexpr int NST = 16;
    bf16_t* O; int ldc;
    __device__ __forceinline__ void operator()(const f32x4 (&acc)[2][2][4][2], const Unit& u, int wr, int wc, int fr, int fq, const LAS float* bl) const {
        const int row0 = u.row0 + wr * 64 + fr, col0 = u.col0 + wc * 32 + 8 * fq;
#pragma unroll
        for (int ai = 0; ai < 2; ++ai)
#pragma unroll
            for (int m = 0; m < 4; ++m) { bf16_t* rowp = O + (size_t)(row0 + ai * HALF + m * 16) * ldc + col0;
#pragma unroll
                for (int bj = 0; bj < 2; ++bj) { const f32x4 v0 = acc[ai][bj][m][0], v1 = acc[ai][bj][m][1];
                    u32x4 w; w.x = pk_bf16(v0[0], v0[1]); w.y = pk_bf16(v0[2], v0[3]); w.z = pk_bf16(v1[0], v1[1]); w.w = pk_bf16(v1[2], v1[3]);
                    *(u32x4*)(rowp + bj * HALF) = w; } }
    }
};
struct EpiInProj {
    __device__ __forceinline__ void prefetch(const Unit&, LAS unsigned char*, int, int) const {}
    static constexpr bool PERM = true; static constexpr int NST = 16;
    bf16_t* Ohq; bf16_t* Ovt;
    __device__ __forceinline__ void operator()(const f32x4 (&acc)[2][2][4][2], const Unit& u, int wr, int wc, int fr, int fq, const LAS float* bl) const {
        bf16_t* O = u.e ? Ovt : Ohq; const int ldc = u.e ? T : HQP;
        const int row0 = u.row0 + wr * 64 + fr, col0 = u.col0 + wc * 32 + 8 * fq;
#pragma unroll
        for (int ai = 0; ai < 2; ++ai)
#pragma unroll
            for (int m = 0; m < 4; ++m) { bf16_t* rowp = O + (size_t)(row0 + ai * HALF + m * 16) * ldc + col0;
#pragma unroll
                for (int bj = 0; bj < 2; ++bj) { const f32x4 v0 = acc[ai][bj][m][0], v1 = acc[ai][bj][m][1];
                    u32x4 w; w.x = pk_bf16(v0[0], v0[1]); w.y = pk_bf16(v0[2], v0[3]); w.z = pk_bf16(v1[0], v1[1]); w.w = pk_bf16(v1[2], v1[3]);
                    *(u32x4*)(rowp + bj * HALF) = w; } }
    }
};
struct EpiResBf16 {
    __device__ __forceinline__ void prefetch(const Unit&, LAS unsigned char*, int, int) const {}
    static constexpr bool PERM = true; static constexpr int NST = 16;
    bf16_t* O; const bf16_t* R; float ascale;
    __device__ __forceinline__ void operator()(const f32x4 (&acc)[2][2][4][2], const Unit& u, int wr, int wc, int fr, int fq, const LAS float* bl) const {
        const int row0 = u.row0 + wr * 64 + fr, col0 = u.col0 + wc * 32 + 8 * fq;
        u32x4 rr[2][4][2];
#pragma unroll
        for (int ai = 0; ai < 2; ++ai)
#pragma unroll
            for (int m = 0; m < 4; ++m)
#pragma unroll
                for (int bj = 0; bj < 2; ++bj) rr[ai][m][bj] = __builtin_nontemporal_load((const u32x4*)(R + (size_t)(row0 + ai * HALF + m * 16) * 1024 + col0 + bj * HALF));
#pragma unroll
        for (int ai = 0; ai < 2; ++ai)
#pragma unroll
            for (int m = 0; m < 4; ++m) { const size_t off = (size_t)(row0 + ai * HALF + m * 16) * 1024 + col0;
#pragma unroll
                for (int bj = 0; bj < 2; ++bj) { const u32x4 r = rr[ai][m][bj]; const f32x4 v0 = acc[ai][bj][m][0] * ascale, v1 = acc[ai][bj][m][1] * ascale;
                    u32x4 w; w.x = pk_bf16(bf_lo(r[0]) * ALPHA + v0[0], bf_hi(r[0]) * ALPHA + v0[1]); w.y = pk_bf16(bf_lo(r[1]) * ALPHA + v0[2], bf_hi(r[1]) * ALPHA + v0[3]);
                    w.z = pk_bf16(bf_lo(r[2]) * ALPHA + v1[0], bf_hi(r[2]) * ALPHA + v1[1]); w.w = pk_bf16(bf_lo(r[3]) * ALPHA + v1[2], bf_hi(r[3]) * ALPHA + v1[3]);
                    *(u32x4*)(O + off + bj * HALF) = w; } }
    }
};
template <bool F8> struct EpiSwiglu {
    static constexpr bool PERM = true; static constexpr int NST = F8 ? 8 : 8;
    void* Ov; const float* bias; float ascale;
    __device__ __forceinline__ void prefetch(const Unit& u, LAS unsigned char* slot, int wid, int lane) const {
        if (wid == 0) { const float* src = bias + (size_t)u.e * 2048 + (u.col0 >> 1) + ((lane & 32) ? 1024 : 0) + (lane & 31) * 4;
            __builtin_amdgcn_global_load_lds((const unsigned*)src, (LAS unsigned*)slot, 16, 0, 0); } }
    __device__ __forceinline__ void operator()(const f32x4 (&acc)[2][2][4][2], const Unit& u, int wr, int wc, int fr, int fq, const LAS float* bl) const {
        const int row0 = u.row0 + wr * 64 + fr, oc = (u.col0 >> 1) + wc * 32 + 8 * fq;
        const LAS float* bp = bl + wc * 32 + 8 * fq;
        f32x4 bg[2], bu[2];
#pragma unroll
        for (int n = 0; n < 2; ++n) { bg[n] = *(const LAS f32x4*)(bp + 4 * n); bu[n] = *(const LAS f32x4*)(bp + 128 + 4 * n); }
#pragma unroll
        for (int ai = 0; ai < 2; ++ai)
#pragma unroll
            for (int m = 0; m < 4; ++m) {
                float o[8];
#pragma unroll
                for (int n = 0; n < 2; ++n) { const f32x4 g4 = acc[ai][0][m][n] * ascale + bg[n], u4 = acc[ai][1][m][n] * ascale + bu[n];
#pragma unroll
                    for (int j = 0; j < 4; ++j) { const float g = fminf(g4[j], 7.0f), up = __builtin_amdgcn_fmed3f(u4[j], -7.0f, 7.0f);
                        constexpr float OS = F8 ? A8_SCALE : 1.0f;
                        const float e = __builtin_amdgcn_exp2f(-1.702f * LOG2E * g), glu = g * __builtin_amdgcn_rcpf(__builtin_fmaf(e, 1.0f / OS, 1.0f / OS)); o[4 * n + j] = __builtin_fmaf(up, glu, glu); } }
                if constexpr (F8) {
                    int w0 = 0, w1 = 0; w0 = __builtin_amdgcn_cvt_pk_fp8_f32(o[0], o[1], w0, false); w0 = __builtin_amdgcn_cvt_pk_fp8_f32(o[2], o[3], w0, true);
                    w1 = __builtin_amdgcn_cvt_pk_fp8_f32(o[4], o[5], w1, false); w1 = __builtin_amdgcn_cvt_pk_fp8_f32(o[6], o[7], w1, true);
                    *(u32x2*)((unsigned char*)Ov + (size_t)(row0 + ai * HALF + m * 16) * 1024 + oc) = (u32x2){(unsigned)w0, (unsigned)w1}; }
                else { u32x4 w; w.x = pk_bf16(o[0], o[1]); w.y = pk_bf16(o[2], o[3]); w.z = pk_bf16(o[4], o[5]); w.w = pk_bf16(o[6], o[7]);
                    *(u32x4*)((bf16_t*)Ov + (size_t)(row0 + ai * HALF + m * 16) * 1024 + oc) = w; } }
    }
};
struct EpiBiasBf16 {
    static constexpr bool PERM = true; static constexpr int NST = 16;
    bf16_t* O; const float* bias; float ascale;
    __device__ __forceinline__ void prefetch(const Unit& u, LAS unsigned char* slot, int wid, int lane) const {
        if (wid == 0) __builtin_amdgcn_global_load_lds((const unsigned*)(bias + (size_t)u.e * 1024 + u.col0 + lane * 4), (LAS unsigned*)slot, 16, 0, 0); }
    __device__ __forceinline__ void operator()(const f32x4 (&acc)[2][2][4][2], const Unit& u, int wr, int wc, int fr, int fq, const LAS float* bl) const {
        const int row0 = u.row0 + wr * 64 + fr, col0 = u.col0 + wc * 32 + 8 * fq;
        const LAS float* bp = bl + wc * 32 + 8 * fq;
        f32x4 bv[2][2];
#pragma unroll
        for (int bj = 0; bj < 2; ++bj)
#pragma unroll
            for (int n = 0; n < 2; ++n) bv[bj][n] = *(const LAS f32x4*)(bp + bj * HALF + 4 * n);
#pragma unroll
        for (int ai = 0; ai < 2; ++ai)
#pragma unroll
#if YR_FP8
            for (int m = 0; m < 4; ++m) { unsigned char* rowp = (unsigned char*)O + (size_t)(row0 + ai * HALF + m * 16) * 1024 + col0;
#pragma unroll
                for (int bj = 0; bj < 2; ++bj) { const f32x4 v0 = (acc[ai][bj][m][0] * ascale + bv[bj][0]) * Y8_SCALE, v1 = (acc[ai][bj][m][1] * ascale + bv[bj][1]) * Y8_SCALE;
                    *(u32x2*)(rowp + bj * HALF) = (u32x2){pk4_fp8(v0[0], v0[1], v0[2], v0[3]), pk4_fp8(v1[0], v1[1], v1[2], v1[3])}; } }
#else
            for (int m = 0; m < 4; ++m) { bf16_t* rowp = O + (size_t)(row0 + ai * HALF + m * 16) * 1024 + col0;
#pragma unroll
                for (int bj = 0; bj < 2; ++bj) { const f32x4 v0 = acc[ai][bj][m][0] * ascale + bv[bj][0], v1 = acc[ai][bj][m][1] * ascale + bv[bj][1];
                    u32x4 w; w.x = pk_bf16(v0[0], v0[1]); w.y = pk_bf16(v0[2], v0[3]); w.z = pk_bf16(v1[0], v1[1]); w.w = pk_bf16(v1[2], v1[3]);
                    *(u32x4*)(rowp + bj * HALF) = w; } }
#endif
    }
};
}


#ifndef ATT_EN
#define ATT_EN 7
#endif
#ifndef PROBE
#define PROBE (-1)
#endif
#define PREP(k) _Pragma("unroll 1") for (int _rp = ((PROBE == (k)) ? 0 : 1); _rp < 2; ++_rp)
typedef float f32x16 __attribute__((ext_vector_type(16)));
#define MFMA32(a, b, c) __builtin_amdgcn_mfma_f32_32x32x16_f16((a), (b), (c), 0, 0, 0)
constexpr float ATT_THR = 8.0f;
constexpr int LDS_GB_OFF = 147456;
constexpr int ATT_KB = 8192;
#define NEG_INF_F (-__builtin_huge_valf())

template <int MODE>
__device__ __forceinline__ void attn_unit(LAS unsigned char* lds, const bf16_t* HQ, const bf16_t* VT, bf16_t* MIX, const unsigned long long* MASK, float* OA1,
                                          const int b, const int h, const int qt, const int wave_in, const int lane_unused,
                                          const float lam, const float lam_init, const float* subg, const float* relb) {
    int wave = wave_in; asm volatile("" : "+s"(wave));
    constexpr int NPASS = (MODE == 0) ? 2 : 1;
    constexpr int EB = (MODE == 0) ? 4 : 2;
    constexpr int NLV = EB / 2;
    constexpr int SLOTB = ATT_KB + EB * 32 * 128;
    constexpr int XOFF = 3 * SLOTB;
    const int qoff = (MODE == 0) ? HQ_QA + h * 128 : (MODE == 1) ? HQ_QB + h * 64 : HQ_QC + h * 64;
    const int koff = (MODE == 0) ? HQ_KA + h * 128 : (MODE == 1) ? HQ_KB + h * 64 : HQ_KC + h * 64;
    const int vrow0 = (MODE == 0) ? VT_A + h * 128 : (MODE == 1) ? VT_B + h * 64 : VT_C + h * 64;
    const int mixcol = (MODE == 0) ? h * 128 : (MODE == 1) ? 512 + h * 64 : 768 + h * 64;
    int lane; asm volatile("v_mbcnt_lo_u32_b32 %0, -1, 0\n\tv_mbcnt_hi_u32_b32 %0, -1, %0" : "=&v"(lane));
    const int tid = wave * 64 + lane, ql = lane & 31, hb = lane >> 5;
    const int cq = qt * 4 + (wave >> 1);
    const int tq = qt * 256 + wave * 32 + ql;
    const int kt_hi = qt * 4 + 3;
    const int kt_lo = (MODE == 1) ? ((qt * 4 - 8) > 0 ? (qt * 4 - 8) : 0) : 0;
    const int ntile = kt_hi - kt_lo + 1;
    const float slope2 = (MODE == 0) ? exp2f(-(float)(2 * h + 1)) * LOG2E : exp2f(-(float)(2 * h + 2)) * LOG2E;
    LAS float* relb_l = (LAS float*)(lds + XOFF);
    float so[16];
#pragma unroll
    for (int i = 0; i < 16; ++i) { int oi = 16 * (i >> 3) + (i & 7); asm volatile("" : "+s"(oi));
        so[i] = __int_as_float(__builtin_amdgcn_readfirstlane(__float_as_int(slope2 * (float)oi))); }
    const int prow = (ql & 16) | ((ql & 4) << 1) | ((ql & 8) >> 1) | (ql & 3);
    const int kt_x = (hb ^ ((prow >> 1) & 7)) << 4, vt_x = (hb ^ ((ql >> 1) & 7)) << 4;
    const int krd = prow * 128, vrd = ATT_KB + ql * 128;
    const int drow = lane >> 3, dpos = lane & 7;
    const int krow_g = 8 * wave + drow;
    const size_t ksrc = ((size_t)(b * SEQ + krow_g) * HQP + koff + ((dpos ^ ((krow_g >> 1) & 7)) << 3)) * 2;
    size_t vsrc[NLV];
#pragma unroll
    for (int j = 0; j < NLV; ++j) { const int vr = 8 * (wave + 8 * j) + drow; vsrc[j] = ((size_t)(vrow0 + vr) * T + (size_t)b * SEQ + ((dpos ^ ((vr >> 1) & 7)) << 3)) * 2; }

#pragma unroll 1
    for (int mp = 0; mp < NPASS; ++mp) {
#define ATT_ISSUE(kt_, slot_) do { \
        __builtin_amdgcn_global_load_lds((const unsigned*)((const char*)HQ + ksrc + (size_t)(kt_) * (64 * HQP * 2) + mp * 128), (LAS unsigned*)(lds + (slot_) * SLOTB + wave * 1024), 16, 0, 0); \
        _Pragma("unroll") for (int j = 0; j < NLV; ++j) \
            __builtin_amdgcn_global_load_lds((const unsigned*)((const char*)VT + vsrc[j] + (size_t)(kt_) * 128), (LAS unsigned*)(lds + (slot_) * SLOTB + ATT_KB + (wave + 8 * j) * 1024), 16, 0, 0); } while (0)
        asm volatile("s_waitcnt vmcnt(0)" ::: "memory");
        __syncthreads();
        ATT_ISSUE(kt_hi, 0);
        ATT_ISSUE((ntile > 1 ? kt_hi - 1 : kt_hi), 1);
        if (MODE == 1 && mp == 0) { for (int i = tid; i < 320; i += 512) relb_l[i] = relb[i < 256 ? i : 256] * LOG2E; }
        if (MODE == 2) {
#pragma unroll
            for (int i = 0; i < 8; ++i) { const int q = wave * 32 + i * 4 + (lane >> 4), p = lane & 15;
                __builtin_amdgcn_global_load_lds((const unsigned*)((const char*)MASK + ((size_t)(b * SEQ + qt * 256 + q) * 32 + (((p - q) & 15) << 1)) * 8),
                                                 (LAS unsigned*)(lds + XOFF + (wave * 32 + i * 4) * 256), 16, 0, 0); }
        }
        bf16x8 Q[4];
        { const bf16_t* qp = HQ + (size_t)(b * SEQ + tq) * HQP + qoff + mp * 64 + hb * 8;
#pragma unroll
          for (int ks = 0; ks < 4; ++ks) Q[ks] = *(const bf16x8*)(qp + ks * 16); }
        asm volatile("" : "+v"(Q[0]), "+v"(Q[1]), "+v"(Q[2]), "+v"(Q[3]));
        f32x16 O[EB];
        float mref = 0.f, seen = 0.f, lrun = 0.f;
#pragma unroll
        for (int eb = 0; eb < EB; ++eb)
#pragma unroll
            for (int i = 0; i < 16; ++i) O[eb][i] = 0.f;
        asm volatile("s_waitcnt lgkmcnt(0)" ::: "memory");
        int slot = 0;
        for (int jt = 0; jt < ntile; ++jt) {
            const int kt = kt_hi - jt;
            if constexpr (MODE == 0) asm volatile("s_waitcnt vmcnt(3)" ::: "memory"); else asm volatile("s_waitcnt vmcnt(2)" ::: "memory");
            __builtin_amdgcn_s_barrier();
            { const int nj = jt + 2 < ntile ? jt + 2 : ntile - 1; int ns = slot + 2; ns = ns >= 3 ? ns - 3 : ns; ATT_ISSUE(kt_hi - nj, ns); }
            const bool active = (kt <= cq) && (MODE != 1 || kt >= cq - 8);
            if (active) {
                const LAS unsigned char* kbp = lds + slot * SLOTB + krd;
                const LAS unsigned char* vbp = lds + slot * SLOTB + vrd;
                f32x16 S0, S1;
                if (MODE == 0 || MODE == 2) {
                    const float base0 = (float)(tq - kt * 64 - 8 * hb);
                    if (kt == cq) {
#pragma unroll
                        for (int i = 0; i < 16; ++i) { const float off = (float)(16 * (i >> 3) + (i & 7));
                            S0[i] = -slope2 * fabsf(base0 - off) - mref; S1[i] = -slope2 * fabsf(base0 - 32.0f - off) - mref; }
                    } else {
                        const float c0 = -slope2 * base0 - mref, c1 = c0 + 32.0f * slope2;
#pragma unroll
                        for (int i = 0; i < 16; ++i) { S0[i] = so[i] + c0; S1[i] = so[i] + c1; }
                    }
                }
                if (MODE == 2) {
                    const int mq = wave * 32 + ql; const unsigned long long W = *(const LAS unsigned long long*)(lds + XOFF + mq * 256 + ((((kt >> 1) + mq) & 15) << 4) + ((kt & 1) << 3));
                    const unsigned w0 = (unsigned)W >> (8 * hb), w1 = (unsigned)(W >> 32) >> (8 * hb);
#pragma unroll
                    for (int i = 0; i < 16; ++i) { const int off = 16 * (i >> 3) + (i & 7);
                        const int m0 = __builtin_amdgcn_sbfe((int)w0, off, 1), m1 = __builtin_amdgcn_sbfe((int)w1, off, 1);
                        S0[i] = __int_as_float((__float_as_int(S0[i]) & m0) | ((int)0xFF800000 & ~m0)); S1[i] = __int_as_float((__float_as_int(S1[i]) & m1) | ((int)0xFF800000 & ~m1)); }
                }
                if (MODE == 1) {
                    if (kt >= cq - 2) {
                        const int rel0 = tq - kt * 64 - 8 * hb + 128;
#pragma unroll
                        for (int i = 0; i < 16; ++i) { const int off = 16 * (i >> 3) + (i & 7);
                            S0[i] = relb_l[rel0 - off] - mref; S1[i] = relb_l[rel0 - 32 - off] - mref; }
                    } else {
                        const float far = relb_l[256] - mref;
#pragma unroll
                        for (int i = 0; i < 16; ++i) { S0[i] = far; S1[i] = far; }
                    }
                }
                bf16x8 kf[8], vf0[8];
#pragma unroll
                for (int ks = 0; ks < 4; ++ks) { kf[2 * ks] = *(const LAS bf16x8*)(kbp + ((ks << 5) ^ kt_x)); kf[2 * ks + 1] = *(const LAS bf16x8*)(kbp + 4096 + ((ks << 5) ^ kt_x)); }
#pragma unroll
                for (int i = 0; i < 8; ++i) { const int s4i = i / EB, eb = i % EB; vf0[i] = *(const LAS bf16x8*)(vbp + eb * 4096 + ((s4i << 5) ^ vt_x)); }
#pragma unroll
                for (int ks = 0; ks < 4; ++ks) { S0 = MFMA32(kf[2 * ks], Q[ks], S0); S1 = MFMA32(kf[2 * ks + 1], Q[ks], S1); }
                __builtin_amdgcn_sched_group_barrier(0x100, 16, 0); __builtin_amdgcn_sched_group_barrier(0x008, 8, 0);
                float mx; asm("s_nop 15\n\ts_nop 3\n\tv_max3_f32 %0, %1, %2, %3" : "=v"(mx) : "v"(S0[0]), "v"(S1[0]), "v"(S0[1]));
                asm("v_max3_f32 %0, %1, %2, %3" : "=v"(mx) : "v"(mx), "v"(S1[1]), "v"(S0[2]));
#pragma unroll
                for (int i = 2; i < 15; ++i) asm("v_max3_f32 %0, %1, %2, %3" : "=v"(mx) : "v"(mx), "v"(S1[i]), "v"(S0[i + 1]));
                asm("v_max_f32 %0, %1, %2" : "=v"(mx) : "v"(mx), "v"(S1[15]));
                mx = fmaxf(mx, shx(mx, 32, lane));
                const bool unseen = !(seen > 0.f), finite = mx > -1e30f;
                const bool need = unseen ? finite : (mx > ATT_THR);
                if (__ballot(unseen ? finite : (mx >= -36.0f)) != 0ull) {
                    if (__ballot(need) != 0ull) {
                        const float d = need ? mx : 0.f;
                        mref += d; seen = (unseen && finite) ? 1.f : seen;
                        const float alpha = unseen ? 1.0f : __builtin_amdgcn_exp2f(-d);
                        lrun *= alpha;
#pragma unroll
                        for (int eb = 0; eb < EB; ++eb) O[eb] = O[eb] * alpha;
#pragma unroll
                        for (int i = 0; i < 16; ++i) { S0[i] -= d; S1[i] -= d; }
                    }
                    float ps = 0.f;
#pragma unroll
                    for (int i = 0; i < 16; ++i) { S0[i] = __builtin_amdgcn_exp2f(S0[i]); S1[i] = __builtin_amdgcn_exp2f(S1[i]); ps += S0[i] + S1[i]; }
                    lrun += ps;
                    bf16x8 P[4];
                    { u32x4 p;
                      p.x = pk_bf16(S0[0], S0[1]); p.y = pk_bf16(S0[2], S0[3]); p.z = pk_bf16(S0[4], S0[5]); p.w = pk_bf16(S0[6], S0[7]); P[0] = __builtin_bit_cast(bf16x8, p);
                      p.x = pk_bf16(S0[8], S0[9]); p.y = pk_bf16(S0[10], S0[11]); p.z = pk_bf16(S0[12], S0[13]); p.w = pk_bf16(S0[14], S0[15]); P[1] = __builtin_bit_cast(bf16x8, p);
                      p.x = pk_bf16(S1[0], S1[1]); p.y = pk_bf16(S1[2], S1[3]); p.z = pk_bf16(S1[4], S1[5]); p.w = pk_bf16(S1[6], S1[7]); P[2] = __builtin_bit_cast(bf16x8, p);
                      p.x = pk_bf16(S1[8], S1[9]); p.y = pk_bf16(S1[10], S1[11]); p.z = pk_bf16(S1[12], S1[13]); p.w = pk_bf16(S1[14], S1[15]); P[3] = __builtin_bit_cast(bf16x8, p); }
                    if constexpr (EB == 4) {
                        bf16x8 vf1[8];
#pragma unroll
                        for (int i = 0; i < 8; ++i) { const int s4i = 2 + i / EB, eb = i % EB; vf1[i] = *(const LAS bf16x8*)(vbp + eb * 4096 + ((s4i << 5) ^ vt_x)); }
#pragma unroll
                        for (int i = 0; i < 8; ++i) { const int s4i = i / EB, eb = i % EB; O[eb] = MFMA32(vf0[i], P[s4i], O[eb]); }
#pragma unroll
                        for (int i = 0; i < 8; ++i) { const int s4i = 2 + i / EB, eb = i % EB; O[eb] = MFMA32(vf1[i], P[s4i], O[eb]); }
                        __builtin_amdgcn_sched_group_barrier(0x100, 8, 0); __builtin_amdgcn_sched_group_barrier(0x008, 16, 0);
                    } else {
#pragma unroll
                        for (int i = 0; i < 8; ++i) { const int s4i = i / EB, eb = i % EB; O[eb] = MFMA32(vf0[i], P[s4i], O[eb]); }
                    }
                }
            }
            slot = slot == 2 ? 0 : slot + 1;
        }
#undef ATT_ISSUE
        const float inv = 1.0f / (lrun + shx(lrun, 32, lane));
        bf16_t* op = MIX + (size_t)(b * SEQ + tq) * 1024 + mixcol + 4 * hb;
        unsigned char* op8 = (unsigned char*)MIX + (size_t)(b * SEQ + tq) * 1024 + mixcol + 4 * hb; const float inv8 = inv * M8_SCALE; (void)op; (void)op8; (void)inv8;
        if (MODE == 0) {
            LAS u32x2* o1l = (LAS u32x2*)(lds + ((wave < 7) ? (3 * SLOTB + wave * 8192) : LDS_GB_OFF)) + lane;
            if (mp == 0) {
#pragma unroll
                for (int eb = 0; eb < EB; ++eb)
#pragma unroll
                    for (int g = 0; g < 4; ++g) o1l[(eb * 4 + g) * 64] = (u32x2){pk_bf16(O[eb][4 * g] * inv, O[eb][4 * g + 1] * inv), pk_bf16(O[eb][4 * g + 2] * inv, O[eb][4 * g + 3] * inv)};
            } else {
                const float c2 = lam * inv;
                float ss = 0.f;
                u32x2 o1v[EB][4];
#pragma unroll
                for (int eb = 0; eb < EB; ++eb)
#pragma unroll
                    for (int g = 0; g < 4; ++g) o1v[eb][g] = o1l[(eb * 4 + g) * 64];
                asm volatile("" ::: "memory");
#pragma unroll
                for (int eb = 0; eb < EB; ++eb)
#pragma unroll
                    for (int g = 0; g < 4; ++g) { const u32x2 o1h = o1v[eb][g]; const f32x4 o1 = {bf_lo(o1h[0]), bf_hi(o1h[0]), bf_lo(o1h[1]), bf_hi(o1h[1])};
#pragma unroll
                        for (int j = 0; j < 4; ++j) { const float o = o1[j] - O[eb][4 * g + j] * c2; O[eb][4 * g + j] = o; ss += o * o; } }
                ss += shx(ss, 32, lane);
                const float r = rsqrtf(ss * (1.0f / 128.0f) + EPS) * (1.0f - lam_init);
                const float r8 = r * M8_SCALE; (void)r8;
#pragma unroll
                for (int eb = 0; eb < EB; ++eb)
#pragma unroll
                    for (int g = 0; g < 4; ++g) { const int e0 = eb * 32 + 8 * g;
#if OUT_FP8
                        *(unsigned*)(op8 + e0) = pk4_fp8(O[eb][4 * g] * r8, O[eb][4 * g + 1] * r8, O[eb][4 * g + 2] * r8, O[eb][4 * g + 3] * r8); }
#else
                        *(u32x2*)(op + e0) = (u32x2){pk_bf16(O[eb][4 * g] * r, O[eb][4 * g + 1] * r), pk_bf16(O[eb][4 * g + 2] * r, O[eb][4 * g + 3] * r)}; }
#endif
            }
        } else {
#pragma unroll
            for (int eb = 0; eb < EB; ++eb)
#pragma unroll
                for (int g = 0; g < 4; ++g) { const int e0 = eb * 32 + 8 * g;
#if OUT_FP8
                    *(unsigned*)(op8 + e0) = pk4_fp8(O[eb][4 * g] * inv8, O[eb][4 * g + 1] * inv8, O[eb][4 * g + 2] * inv8, O[eb][4 * g + 3] * inv8); }
#else
                    *(u32x2*)(op + e0) = (u32x2){pk_bf16(O[eb][4 * g] * inv, O[eb][4 * g + 1] * inv), pk_bf16(O[eb][4 * g + 2] * inv, O[eb][4 * g + 3] * inv)}; }
#endif
        }
    }
}


constexpr int IDX_STR = 2052;
__device__ __forceinline__ unsigned f2key(float f) { const unsigned u = __float_as_uint(f); return u ^ (((unsigned)((int)u >> 31)) | 0x80000000u); }
__device__ __forceinline__ float key2f(unsigned k) { return __uint_as_float((k & 0x80000000u) ? (k ^ 0x80000000u) : ~k); }
#define IDX_DPP(x, ctrl) ((unsigned)__builtin_amdgcn_update_dpp((int)(x), (int)(x), (ctrl), 0xf, 0xf, true))
__device__ __forceinline__ unsigned wave_max_u32(unsigned v) {
    v = max(v, IDX_DPP(v, 0xB1)); v = max(v, IDX_DPP(v, 0x4E)); v = max(v, IDX_DPP(v, 0x141)); v = max(v, IDX_DPP(v, 0x140));
    return max(max((unsigned)__builtin_amdgcn_readlane((int)v, 0), (unsigned)__builtin_amdgcn_readlane((int)v, 16)), max((unsigned)__builtin_amdgcn_readlane((int)v, 32), (unsigned)__builtin_amdgcn_readlane((int)v, 48))); }
__device__ __forceinline__ unsigned wave_min_u32(unsigned v) {
    v = min(v, IDX_DPP(v, 0xB1)); v = min(v, IDX_DPP(v, 0x4E)); v = min(v, IDX_DPP(v, 0x141)); v = min(v, IDX_DPP(v, 0x140));
    return min(min((unsigned)__builtin_amdgcn_readlane((int)v, 0), (unsigned)__builtin_amdgcn_readlane((int)v, 16)), min((unsigned)__builtin_amdgcn_readlane((int)v, 32), (unsigned)__builtin_amdgcn_readlane((int)v, 48))); }
#undef IDX_DPP
template <int J>
__device__ __forceinline__ void index_select(const LAS float* row, const int nb, const int lane, unsigned long long* mo) {
    unsigned u[J];
#pragma unroll
    for (int j = 0; j < J; ++j) u[j] = (j < nb) ? f2key(row[64 * j]) : 0u;
#define IDX_COUNT(c, cand) do { (c) = 0; _Pragma("unroll") for (int j0 = 0; j0 + 8 <= J; j0 += 8) { unsigned long long bm[8]; \
        _Pragma("unroll") for (int j = 0; j < 8; ++j) bm[j] = __ballot(u[j0 + j] >= (cand)); \
        asm volatile("" : "+s"(bm[0]), "+s"(bm[1]), "+s"(bm[2]), "+s"(bm[3]), "+s"(bm[4]), "+s"(bm[5]), "+s"(bm[6]), "+s"(bm[7])); \
        _Pragma("unroll") for (int j = 0; j < 8; ++j) (c) += (int)__builtin_popcountll(bm[j]); } \
        if constexpr ((J & 7) == 4) { unsigned long long bm[4];   \
        _Pragma("unroll") for (int j = 0; j < 4; ++j) bm[j] = __ballot(u[J - 4 + j] >= (cand)); \
        asm volatile("" : "+s"(bm[0]), "+s"(bm[1]), "+s"(bm[2]), "+s"(bm[3])); \
        _Pragma("unroll") for (int j = 0; j < 4; ++j) (c) += (int)__builtin_popcountll(bm[j]); } } while (0)
    unsigned prefix = 0u; bool exact = false;
    {
        unsigned kmx = 0u, kmn = 0xFFFFFFFFu;
#pragma unroll
        for (int j = 0; j < J; ++j) { kmx = max(kmx, u[j]); kmn = min(kmn, (j < nb) ? u[j] : 0xFFFFFFFFu); }
        float lo = key2f(wave_min_u32(kmn)), hi = key2f(wave_max_u32(kmx));
        float clo = (float)(nb * 64), chi = 1.0f;
#pragma unroll 1
        for (int it = 0; it < 24; ++it) {
            const float ti = (clo - 256.0f) * __builtin_amdgcn_rcpf(clo - chi);
            float t = (it == 0) ? 0.5625f : (it & 1) ? 0.5f * (ti + 0.5f) : 0.75f * ti + 0.125f;
            t = __builtin_amdgcn_fmed3f(t, 0.03125f, 0.96875f);
            const float mid = lo + (hi - lo) * t;
            if (!(mid > lo) || !(mid < hi)) break;
            const unsigned cand = f2key(mid);
            int c; IDX_COUNT(c, cand);
            if (c == 256) { exact = true; prefix = cand; break; }
            if (c > 256) { lo = mid; clo = (float)c; } else { hi = mid; chi = (float)c; }
        }
    }
    if (!exact) {
        prefix = 0u;
#pragma unroll 1
        for (int bit = 31; bit >= 0; --bit) {
            const unsigned cand = prefix | (1u << bit);
            int c; IDX_COUNT(c, cand);
            if (c >= 256) prefix = cand;
            if (c == 256) { exact = true; break; }
        }
    }
#undef IDX_COUNT
    unsigned thr = prefix; asm volatile("" : "+v"(thr));
    unsigned long long myword = 0ull;
    if (exact) {
#pragma unroll
        for (int j = 0; j < J; ++j) { const unsigned long long m = __ballot(u[j] >= thr); myword = (lane == j) ? m : myword; }
    } else {
        int cg = 0;
#pragma unroll
        for (int j = 0; j < J; ++j) cg += (int)__builtin_popcountll(__ballot(u[j] > thr));
        const int quota = 256 - cg;
        int taken = 0;
#pragma unroll
        for (int j = 0; j < J; ++j) {
            const bool eq = (u[j] == thr);
            const unsigned long long eqm = __ballot(eq);
            const int before = (int)__builtin_popcountll(eqm & ((1ull << lane) - 1ull));
            const unsigned long long m = __ballot((u[j] > thr) || (eq && (taken + before < quota)));
            taken += (int)__builtin_popcountll(eqm);
            myword = (lane == j) ? m : myword;
        }
    }
    if (lane < 32) mo[lane] = myword;
}
__device__ __forceinline__ void index_unit(LAS unsigned char* lds, const bf16_t* HQ, unsigned long long* MASK, const int b, const int tt, const int wave_in) {
    int wave = wave_in; asm volatile("" : "+s"(wave));
    int lane; asm volatile("v_mbcnt_lo_u32_b32 %0, -1, 0\n\tv_mbcnt_hi_u32_b32 %0, -1, %0" : "=&v"(lane));
    const int t0 = tt * 16, nb = (t0 >> 6) + 1, nk = nb * 64;
    if (nb <= 4) {
        for (int i = wave * 64 + lane; i < 16 * 32; i += 512) MASK[(size_t)(b * SEQ + t0 + (i >> 5)) * 32 + (i & 31)] = ((i & 31) < nb) ? ~0ull : 0ull;
        return;
    }
    LAS float* sc = (LAS float*)lds;
    const int q = lane & 15, g = lane >> 4;
    {
        const bf16_t* qrow = HQ + (size_t)(b * SEQ + t0 + q) * HQP;
        bf16x8 QI[8];
#pragma unroll
        for (int h = 0; h < 8; ++h) QI[h] = *(const bf16x8*)(qrow + HQ_QI + h * 32 + g * 8);
        float w[8];
        { const u32x4 wv = *(const u32x4*)(qrow + HQ_WI);
          w[0] = bf_lo(wv[0]) * 0.0625f; w[1] = bf_hi(wv[0]) * 0.0625f; w[2] = bf_lo(wv[1]) * 0.0625f; w[3] = bf_hi(wv[1]) * 0.0625f;
          w[4] = bf_lo(wv[2]) * 0.0625f; w[5] = bf_hi(wv[2]) * 0.0625f; w[6] = bf_lo(wv[3]) * 0.0625f; w[7] = bf_hi(wv[3]) * 0.0625f; }
#pragma unroll
        for (int h = 0; h < 8; ++h) w[h] *= 0.5f;
        bf16x8 QSH, QSL;
        { float qs[8];
#pragma unroll
          for (int e = 0; e < 8; ++e) { qs[e] = 0.f;
#pragma unroll
              for (int h = 0; h < 8; ++h) qs[e] = fmaf(w[h], (float)QI[h][e], qs[e]); }
          u32x4 hi, lo;
          hi.x = pk_bf16(qs[0], qs[1]); hi.y = pk_bf16(qs[2], qs[3]); hi.z = pk_bf16(qs[4], qs[5]); hi.w = pk_bf16(qs[6], qs[7]);
          lo.x = pk_bf16(qs[0] - bf_lo(hi.x), qs[1] - bf_hi(hi.x)); lo.y = pk_bf16(qs[2] - bf_lo(hi.y), qs[3] - bf_hi(hi.y));
          lo.z = pk_bf16(qs[4] - bf_lo(hi.z), qs[5] - bf_hi(hi.z)); lo.w = pk_bf16(qs[6] - bf_lo(hi.w), qs[7] - bf_hi(hi.w));
          QSH = __builtin_bit_cast(bf16x8, hi); QSL = __builtin_bit_cast(bf16x8, lo); }
        const bf16_t* kbase = HQ + (size_t)(b * SEQ + q) * HQP + HQ_KI + g * 8;
        for (int kb0 = wave; kb0 < nk / 16; kb0 += 32) {
            bf16x8 kf[4];
#pragma unroll
            for (int u = 0; u < 4; ++u) { const int kb = kb0 + 8 * u; kf[u] = (kb < nk / 16) ? *(const bf16x8*)(kbase + (size_t)kb * 16 * HQP) : (bf16x8){0, 0, 0, 0, 0, 0, 0, 0}; }
#pragma unroll
            for (int u = 0; u < 4; ++u) {
                const int kb = kb0 + 8 * u;
                if (kb < nk / 16) {
                    f32x4 acc = __builtin_amdgcn_mfma_f32_16x16x32_f16(kf[u], QSH, (f32x4){0.f, 0.f, 0.f, 0.f}, 0, 0, 0);
                    acc = __builtin_amdgcn_mfma_f32_16x16x32_f16(kf[u], QSL, acc, 0, 0, 0);
#pragma unroll
                    for (int h = 0; h < 8; ++h) {
                        const f32x4 z = __builtin_amdgcn_mfma_f32_16x16x32_f16(kf[u], QI[h], (f32x4){0.f, 0.f, 0.f, 0.f}, 0, 0, 0);
#pragma unroll
                        for (int j = 0; j < 4; ++j) acc[j] = fmaf(w[h], __builtin_fabsf(z[j]), acc[j]);
                    }
#pragma unroll
                    for (int j = 0; j < 4; ++j) acc[j] += 0.0f;
                    *(LAS f32x4*)(sc + q * IDX_STR + kb * 16 + g * 4) = acc;
                }
            }
        }
    }
    __syncthreads();
#pragma unroll 1
    for (int qq = 0; qq < 2; ++qq) {
        const int ql = wave * 2 + qq;
        const LAS float* row = sc + ql * IDX_STR + lane;
        unsigned long long* mo = MASK + (size_t)(b * SEQ + t0 + ql) * 32;
        if (nb <= 8) index_select<8>(row, nb, lane, mo);
        else if (nb <= 12) index_select<12>(row, nb, lane, mo);
        else if (nb <= 16) index_select<16>(row, nb, lane, mo);
        else if (nb <= 20) index_select<20>(row, nb, lane, mo);
        else if (nb <= 24) index_select<24>(row, nb, lane, mo);
        else if (nb <= 28) index_select<28>(row, nb, lane, mo);
        else index_select<32>(row, nb, lane, mo);
    }
    __syncthreads();
}

__device__ __forceinline__ int att_order(const int i) {
    const unsigned long long t = (i < 8) ? 0x1D13161A171E1B1Full : (i < 16) ? 0x14150E0F18191C12ull : (i < 24) ? 0x08090C0D0A0B1011ull : 0x0001020304050607ull;
    return (int)((t >> ((i & 7) * 8)) & 0xffull);
}

struct Args {
    const float* x; const float* w_in; const float* lam_q1; const float* lam_k1; const float* lam_q2; const float* lam_k2; const float* subln_g; const float* rel_bias;
    const float* w_out; const float* ln1_g; const float* ln1_b; const float* w_router; const float* b_router; const float* w_gu; const float* b_gu;
    const float* w_down; const float* b_down; const float* ln2_g; const float* ln2_b;
    float* out; unsigned char* ws;
    int ph_lo, ph_hi, bar_region, pad;
};

constexpr int LDS_STAGE = 0;
constexpr int LDS_CTL = 135168;
constexpr int LDS_TSTART = LDS_CTL + 64;
constexpr int LDS_CNT = LDS_TSTART + 36 * 4;
constexpr int LDS_TILEE = LDS_CNT + 32 * 4;
constexpr int LDS_RT = LDS_TILEE + 576;
constexpr int LDS_GB = 147456;
static_assert(LDS_GB == LDS_GB_OFF, "LDS map");
constexpr int LDS_BYTES = 147456 + 8192;
static_assert(LDS_RT + (64 + 1024) * 4 <= LDS_BYTES && 16 * IDX_STR * 4 <= LDS_CTL, "LDS map");

__device__ __forceinline__ void transpose_item(const float* W, int N, int k0, int n0, int nvalid, bf16_t* WTrow0, float scale, LAS float* scr, int lane, const float* kgain = nullptr) {
#pragma unroll
    for (int i = 0; i < 32; ++i) { const int kk = 2 * i + (lane >> 5), col = lane & 31; scr[kk * 33 + col] = (col < nvalid) ? W[(size_t)(k0 + kk) * N + n0 + col] * (kgain ? scale * kgain[kk] : scale) : 0.f; }
    asm volatile("s_waitcnt lgkmcnt(0)" ::: "memory");
    const int c = lane & 7;
#pragma unroll
    for (int j = 0; j < 4; ++j) { const int n = (lane >> 3) + 8 * j; const LAS float* s = scr + (8 * c) * 33 + n;
        u32x4 o; o.x = pk_bf16(s[0 * 33], s[1 * 33]); o.y = pk_bf16(s[2 * 33], s[3 * 33]); o.z = pk_bf16(s[4 * 33], s[5 * 33]); o.w = pk_bf16(s[6 * 33], s[7 * 33]);
        if (n < nvalid) *(u32x4*)(WTrow0 + (size_t)n * 1024 + k0 + 8 * c) = o; }
    asm volatile("s_waitcnt lgkmcnt(0)" ::: "memory");
}
__device__ __forceinline__ void transpose_item_fp8(const float* W, int N, int k0, int n0, unsigned char* WTrow0, float scale, int lane, const float* kgain = nullptr) {
    const int rg = lane >> 4, cg = lane & 15;
    const float* src = W + (size_t)(k0 + 32 * rg) * N + n0 + 4 * cg;
    f32x4 v[32];
#pragma unroll
    for (int i = 0; i < 32; ++i) v[i] = __builtin_nontemporal_load((const f32x4*)(src + (size_t)i * N));
    if (kgain) {
#pragma unroll
        for (int i = 0; i < 32; ++i) v[i] = v[i] * kgain[32 * rg + i];
    }
    unsigned char* dst = WTrow0 + (size_t)(4 * cg) * 1024 + k0 + 32 * rg;
#pragma unroll
    for (int j = 0; j < 4; ++j) {
#pragma unroll
        for (int h = 0; h < 2; ++h) {
            u32x4 o;
            o.x = pk4_fp8(v[16 * h + 0][j] * scale, v[16 * h + 1][j] * scale, v[16 * h + 2][j] * scale, v[16 * h + 3][j] * scale);
            o.y = pk4_fp8(v[16 * h + 4][j] * scale, v[16 * h + 5][j] * scale, v[16 * h + 6][j] * scale, v[16 * h + 7][j] * scale);
            o.z = pk4_fp8(v[16 * h + 8][j] * scale, v[16 * h + 9][j] * scale, v[16 * h + 10][j] * scale, v[16 * h + 11][j] * scale);
            o.w = pk4_fp8(v[16 * h + 12][j] * scale, v[16 * h + 13][j] * scale, v[16 * h + 14][j] * scale, v[16 * h + 15][j] * scale);
            *(u32x4*)(dst + (size_t)j * 1024 + 16 * h) = o;
        }
    }
}
__device__ __forceinline__ void in_map(int n0, bool& isv, int& row, float& scale) {
    scale = 1.f; isv = false;
    if (n0 < 512) { row = HQ_QA + n0; scale = QSCALE; }
    else if (n0 < 1024) row = HQ_KA + (n0 - 512);
    else if (n0 < 1536) { isv = true; row = VT_A + (n0 - 1024); }
    else if (n0 < 1792) { row = HQ_QB + (n0 - 1536); scale = QSCALE; }
    else if (n0 < 2048) row = HQ_KB + (n0 - 1792);
    else if (n0 < 2304) { isv = true; row = VT_B + (n0 - 2048); }
    else if (n0 < 2560) { row = HQ_QC + (n0 - 2304); scale = QSCALE; }
    else if (n0 < 2816) row = HQ_KC + (n0 - 2560);
    else if (n0 < 3072) { isv = true; row = VT_C + (n0 - 2816); }
    else if (n0 < 3328) row = HQ_QI + (n0 - 3072);
    else if (n0 < 3360) row = HQ_KI + (n0 - 3328);
    else row = HQ_WI + (n0 - 3360);
}

__global__ void __launch_bounds__(512, 2) mega(Args a) {
    extern __shared__ __attribute__((aligned(16))) unsigned char lds_raw[];
    LAS unsigned char* lds = (LAS unsigned char*)lds_raw;
    const int G = gridDim.x, bid = blockIdx.x, NGW = G * 8;
    const int wave0 = __builtin_amdgcn_readfirstlane((int)threadIdx.x >> 6);
#define OPAQUE_IDS() int wave = wave0; asm volatile("" : "+s"(wave)); int lane; asm volatile("v_mbcnt_lo_u32_b32 %0, -1, 0\n\tv_mbcnt_hi_u32_b32 %0, -1, %0" : "=&v"(lane)); const int tid = wave * 64 + lane, gw = bid * 8 + wave; (void)tid; (void)gw
#define WSPTRS() __attribute__((address_space(1))) unsigned char* wsg_ = (__attribute__((address_space(1))) unsigned char*)a.ws; asm volatile("" : "+s"(wsg_)); unsigned char* ws = (unsigned char*)wsg_;     \
    unsigned* ctl = (unsigned*)(ws + WS_CTL); bf16_t* Win = (bf16_t*)(ws + WS_WIN); bf16_t* Wv = (bf16_t*)(ws + WS_WV); bf16_t* Wout = (bf16_t*)(ws + WS_WOUT); \
    bf16_t* Wgu = (bf16_t*)(ws + WS_WGU); bf16_t* Wdn = (bf16_t*)(ws + WS_WDN); bf16_t* XB = (bf16_t*)(ws + WS_XB); \
    bf16_t* HQ = (bf16_t*)(ws + WS_HQ); bf16_t* VT = (bf16_t*)(ws + WS_VT); bf16_t* MIX = (bf16_t*)(ws + WS_MIX); \
    bf16_t* Y1B = (bf16_t*)(ws + WS_Y1); bf16_t* X1B = (bf16_t*)(ws + WS_X1B); bf16_t* ACT = (bf16_t*)(ws + WS_ACT); bf16_t* YR = (bf16_t*)(ws + WS_YR); \
    int* TOKL = (int*)(ws + WS_TOKL); int* ASGE = (int*)(ws + WS_ASGE); int* ASGS = (int*)(ws + WS_ASGS); float* GATE = (float*)(ws + WS_GATE); \
    (void)ctl; (void)Win; (void)Wv; (void)Wout; (void)Wgu; (void)Wdn; (void)XB; (void)HQ; (void)VT; (void)MIX; (void)Y1B; (void)X1B; (void)ACT; (void)YR; (void)TOKL; (void)ASGE; (void)ASGS; (void)GATE
    for (int u = threadIdx.x; u < (LDS_BYTES - LDS_CTL) / 4; u += 512) ((LAS unsigned*)(lds + LDS_CTL))[u] = 0u;
    __syncthreads();
    XcdBarrier bar = xcd_barrier_post((unsigned*)(a.ws + WS_CTL) + CW_BAR + a.bar_region * XCD_BAR_WORDS, (volatile LAS unsigned*)(lds + LDS_CTL));
    const int lo = a.ph_lo, hi = a.ph_hi;
#define IN(k) (lo <= (k) && (k) < hi)
#define SEAM(k) do { if (IN(k) && IN((k) + 1)) xcd_barrier(bar); } while (0)

    if (IN(0)) PREP(0) {
        OPAQUE_IDS(); WSPTRS();
        LAS float* scr = (LAS float*)(lds + LDS_STAGE + wave * 16384);
        #if MOE_FP8
        constexpr int I_IN = 16 * 106, I_OUT = OUT_FP8 ? 8 * 16 : 16 * 32, I_GU = 8 * 32, I_DN = 8 * 16;
#else
        constexpr int I_IN = 16 * 106, I_OUT = 16 * 32, I_GU = 16 * 64, I_DN = 16 * 32;
#endif
        constexpr int N_IN = DEPTH * I_IN, N_OUT = DEPTH * I_OUT, N_GU = DEPTH * NE * I_GU, N_DN = DEPTH * NE * I_DN;
        constexpr int XC = 16, N_X = T * (D / 8) / 64 / XC;
        constexpr int N_ALL = N_IN + N_OUT + N_GU + N_DN + N_X;
        unsigned* qc = ctl + CW_Q + 120 * 32;
        volatile LAS int* qw = (volatile LAS int*)(lds + LDS_CTL + 48);
        int base, rnd = 0;
        if (tid == 0) qw[0] = (int)__hip_atomic_fetch_add(qc, 8u, __ATOMIC_RELAXED, __HIP_MEMORY_SCOPE_AGENT);
        __syncthreads();
        base = __builtin_amdgcn_readfirstlane(qw[0]);
#pragma unroll 1
        while (base < N_ALL) {
            int nv = 0; if (tid == 0) nv = (int)__hip_atomic_fetch_add(qc, 8u, __ATOMIC_RELAXED, __HIP_MEMORY_SCOPE_AGENT);
#pragma unroll 1
        for (int it = base + wave; it < base + wave + 1 && it < N_ALL; ++it) {
            int r = it;
            if (r < N_IN) { const int l = r / I_IN, q = r % I_IN, kb = q / 106, nb = q % 106, n0 = nb * 32; bool isv; int row; float sc; in_map(n0, isv, row, sc);
                bf16_t* dst = isv ? Wv + ((size_t)l * 1024 + row) * 1024 : Win + ((size_t)l * HQP + row) * 1024;
                transpose_item(a.w_in + (size_t)l * D * DIN, DIN, kb * 64, n0, (DIN - n0) < 32 ? (DIN - n0) : 32, dst, sc, scr, lane); continue; }
            r -= N_IN;
#if OUT_FP8
            if (r < N_OUT) { const int l = r / I_OUT, q = r % I_OUT, kb = q >> 4, nb = q & 15;
                transpose_item_fp8(a.w_out + (size_t)l * 1024 * D, D, kb * 128, nb * 64, (unsigned char*)Wout + ((size_t)l * D + nb * 64) * 1024, W8_SCALE, lane, kb < 4 ? a.subln_g + l * 128 : nullptr); continue; }
#else
            if (r < N_OUT) { const int l = r / I_OUT, q = r % I_OUT, kb = q / 32, nb = q % 32;
                transpose_item(a.w_out + (size_t)l * 1024 * D, D, kb * 64, nb * 32, 32, Wout + ((size_t)l * D + nb * 32) * 1024, 1.f, scr, lane, kb < 8 ? a.subln_g + l * 128 + ((kb * 64) & 127) : nullptr); continue; }
#endif
            r -= N_OUT;
#if MOE_FP8
            if (r < N_GU) { const int le = r / I_GU, q = r % I_GU, kb = q >> 5, nb = q & 31, n0 = nb * 64;
                const int bj = n0 >> 10, rr = n0 & 1023, pn = rr >> 7, c = rr & 127, nrow = pn * 256 + bj * 128 + c;
                transpose_item_fp8(a.w_gu + (size_t)le * D * 2048, 2048, kb * 128, n0, (unsigned char*)Wgu + ((size_t)le * 2048 + nrow) * 1024, W8_SCALE, lane); continue; }
#else
            if (r < N_GU) { const int le = r / I_GU, q = r % I_GU, kb = q / 64, nb = q % 64, n0 = nb * 32;
                const int bj = n0 >> 10, rr = n0 & 1023, pn = rr >> 7, c = rr & 127, nrow = pn * 256 + bj * 128 + c;
                transpose_item(a.w_gu + (size_t)le * D * 2048, 2048, kb * 64, n0, 32, Wgu + ((size_t)le * 2048 + nrow) * 1024, 1.f, scr, lane); continue; }
#endif
            r -= N_GU;
#if MOE_FP8
            if (r < N_DN) { const int le = r / I_DN, q = r % I_DN, kb = q >> 4, nb = q & 15;
                transpose_item_fp8(a.w_down + (size_t)le * 1024 * D, D, kb * 128, nb * 64, (unsigned char*)Wdn + ((size_t)le * D + nb * 64) * 1024, W8_SCALE, lane); continue; }
#else
            if (r < N_DN) { const int le = r / I_DN, q = r % I_DN, kb = q / 32, nb = q % 32;
                transpose_item(a.w_down + (size_t)le * 1024 * D, D, kb * 64, nb * 32, 32, Wdn + ((size_t)le * D + nb * 32) * 1024, 1.f, scr, lane); continue; }
#endif
            r -= N_DN;
            {
                const size_t i0 = ((size_t)r * XC) * 64 + lane;
#pragma unroll
                for (int u0 = 0; u0 < XC; u0 += 8) {
                    f32x4 xv[8][2];
#pragma unroll
                    for (int u = 0; u < 8; ++u) { const size_t i = i0 + (size_t)(u0 + u) * 64; xv[u][0] = *(const f32x4*)(a.x + i * 8); xv[u][1] = *(const f32x4*)(a.x + i * 8 + 4); }
#pragma unroll
                    for (int u = 0; u < 8; ++u) { const size_t i = i0 + (size_t)(u0 + u) * 64;
                        u32x4 w; w.x = pk_bf16(xv[u][0][0], xv[u][0][1]); w.y = pk_bf16(xv[u][0][2], xv[u][0][3]); w.z = pk_bf16(xv[u][1][0], xv[u][1][1]); w.w = pk_bf16(xv[u][1][2], xv[u][1][3]); *(u32x4*)(XB + i * 8) = w; }
                }
            }
        }
            ++rnd;
            if (tid == 0) qw[rnd & 1] = nv;
            __syncthreads();
            base = __builtin_amdgcn_readfirstlane(qw[rnd & 1]);
        }
        for (int i = gw * 64 + lane; i < DEPTH * (HQP - HQ_USED) * 128; i += NGW * 64) { const int l = i / ((HQP - HQ_USED) * 128), q = i % ((HQP - HQ_USED) * 128);
            *(u32x4*)(Win + ((size_t)l * HQP + HQ_USED) * 1024 + (size_t)q * 8) = (u32x4){0u, 0u, 0u, 0u}; }
        { bf16_t* WRH = (bf16_t*)(ws + WS_WRT); bf16_t* WRL = WRH + (size_t)DEPTH * NE * D;
          for (int i = gw * 64 + lane; i < DEPTH * NE * D; i += NGW * 64) { const int ll = i / (NE * D), r = i % (NE * D), e = r / D, c = r % D; const float w = a.w_router[((size_t)ll * D + c) * NE + e];
              const unsigned h = pk_bf16(w, 0.f) & 0xffffu; WRH[i] = (bf16_t)h; WRL[i] = (bf16_t)(pk_bf16(w - bf_lo(h), 0.f) & 0xffffu); } }
    }
    SEAM(0);

#pragma unroll 1
    for (int l = 0; l < DEPTH; ++l) {
        const int pb = 1 + 8 * l;
        if (IN(pb + 0)) PREP(1) {
            WSPTRS();
            pg8::InProjOrder S{G, bid, (const char*)(Win + (size_t)l * HQP * 1024), (const char*)(Wv + (size_t)l * 1024 * 1024), (const char*)XB};
            pg8::EpiInProj E{HQ, VT};
            pg8::gemm_phase<pg8::EpiInProj, pg8::InProjOrder, false>(lds + LDS_STAGE, XB, 1024, S, E, wave0);
        }
        SEAM(pb + 0);
        if (IN(pb + 1)) {
            OPAQUE_IDS(); WSPTRS();
            unsigned long long* MASKp = (unsigned long long*)(ws + WS_MASK); float* OA1p = (float*)(ws + WS_OA1);
            const float lam_init = 0.8f - 0.6f * expf(-0.3f * (float)l);
            const float lam = expf(wsum(a.lam_q1[l * 64 + lane] * a.lam_k1[l * 64 + lane], lane)) - expf(wsum(a.lam_q2[l * 64 + lane] * a.lam_k2[l * 64 + lane], lane)) + lam_init;
            const int v0 = (G % 8 == 0) ? (bid & 7) * (G >> 3) + (bid >> 3) : bid;
            for (int v = v0; v < 256; v += G) {
                const int b = v >> 4, h = (v >> 2) & 3, q0 = v & 3;
#pragma unroll 1
                for (int rep = 0; rep < 2; ++rep) attn_unit<0>(lds + LDS_STAGE, HQ, VT, MIX, MASKp, OA1p, b, rep ? 3 - h : h, rep ? 7 - q0 : q0, wave, lane, lam, lam_init, a.subln_g + l * 128, nullptr);
            }
            {
                const int nq = 1, bq = 16 / nq, qid = 0;
                unsigned* qctr = ctl + CW_Q + ((l * 2 + 0) * 8 + qid) * 32;
                volatile LAS int* qw = (volatile LAS int*)(lds + LDS_CTL + 48);
#pragma unroll 1
                for (;;) {
                    __syncthreads();
                    if (tid == 0) *qw = (int)__hip_atomic_fetch_add(qctr, 1u, __ATOMIC_RELAXED, __HIP_MEMORY_SCOPE_AGENT);
                    __syncthreads();
                    const int u = __builtin_amdgcn_readfirstlane(*qw);
                    if (u >= 128 * bq) break;
                    index_unit(lds + LDS_STAGE, HQ, MASKp, qid * bq + (u % bq), 127 - u / bq, wave);
                }
            }
        }
        SEAM(pb + 1);
        if (IN(pb + 2)) {
            OPAQUE_IDS(); WSPTRS();
            unsigned long long* MASKp = (unsigned long long*)(ws + WS_MASK); float* OA1p = (float*)(ws + WS_OA1);
            {
                const int nq = (G % 8 == 0) ? 8 : 1, bq = 16 / nq, qid = (nq == 8) ? (bid & 7) : 0;
                unsigned* qctr = ctl + CW_Q + ((l * 2 + 1) * 8 + qid) * 32;
                volatile LAS int* qw = (volatile LAS int*)(lds + LDS_CTL + 48);
#pragma unroll 1
                for (;;) {
                    __syncthreads();
                    if (tid == 0) *qw = (int)__hip_atomic_fetch_add(qctr, 1u, __ATOMIC_RELAXED, __HIP_MEMORY_SCOPE_AGENT);
                    __syncthreads();
                    const int u = __builtin_amdgcn_readfirstlane(*qw);
                    if (u >= 64 * bq) break;
                    if (u < 32 * bq) { const int cb = att_order(u / bq), b = qid * bq + u % bq;
                        attn_unit<2>(lds + LDS_STAGE, HQ, VT, MIX, MASKp, OA1p, b, cb & 3, cb >> 2, wave, lane, 0.f, 0.f, nullptr, nullptr); }
                    else { const int u2 = u - 32 * bq, cb = 31 - u2 / bq, b = qid * bq + u2 % bq, h = cb & 3;
                        attn_unit<1>(lds + LDS_STAGE, HQ, VT, MIX, MASKp, OA1p, b, h, cb >> 2, wave, lane, 0.f, 0.f, nullptr, a.rel_bias + ((size_t)l * 4 + h) * 257); }
                }
            }
        }
        SEAM(pb + 2);
        if (IN(pb + 3)) PREP(6) {
            WSPTRS();
#if OUT_FP8
            pg8::DenseOrder S{T / 256, 4, G, bid, (const char*)Wout + (size_t)l * 1024 * 1024, 512, false};
            pg8::EpiResBf16 E{Y1B, XB, 1.0f / (W8_SCALE * M8_SCALE)};
            pg8::gemm_phase<pg8::EpiResBf16, pg8::DenseOrder, false, 1>(lds + LDS_STAGE, MIX, 1024, S, E, wave0);
#else
            pg8::DenseOrder S{T / 256, 4, G, bid, (const char*)(Wout + (size_t)l * 1024 * 1024), 1024, false};
            pg8::EpiResBf16 E{Y1B, XB, 1.0f};
            pg8::gemm_phase<pg8::EpiResBf16, pg8::DenseOrder, false>(lds + LDS_STAGE, MIX, 1024, S, E, wave0);
#endif
        }
        SEAM(pb + 3);
        if (IN(pb + 4)) PREP(10) {
            OPAQUE_IDS(); WSPTRS();
            if (PROBE == 10 && _rp == 0) { TOKL = (int*)(ws + WS_END); ASGE = TOKL + NE * T; ASGS = ASGE + NASG; GATE = (float*)(ASGS + NASG); }
            LAS int* lcnt = (LAS int*)(lds + LDS_RT); LAS int* lbase = lcnt + 32; LAS int* asg_e = lcnt + 64; LAS int* asg_ls = asg_e + 512;
            const float* g1 = a.ln1_g + l * D; const float* b1 = a.ln1_b + l * D; const float* br = a.b_router + l * NE;
            unsigned* gcnt = ctl + CW_CNT + l * 64 + ((PROBE == 10 && _rp == 0) ? 4096 : 0);
            { const u32x4* srch = (const u32x4*)(ws + WS_WRT) + (size_t)l * 4096; const u32x4* srcl = (const u32x4*)(ws + WS_WRT + (size_t)DEPTH * NE * D * 2) + (size_t)l * 4096;
              for (int i = tid; i < 4096; i += 512) { const int e = i >> 7, c = i & 127, dst = e * 2048 + ((c ^ (e & 15)) << 4);
                  *(LAS u32x4*)(lds + LDS_STAGE + dst) = srch[i]; *(LAS u32x4*)(lds + LDS_STAGE + 65536 + dst) = srcl[i]; } }
            LAS float* st = (LAS float*)(lds + 131072);
            LAS float* g1l = (LAS float*)(lds + LDS_GB); LAS float* b1l = g1l + 1024;
            for (int i = tid; i < 1024; i += 512) { g1l[i] = g1[i]; b1l[i] = b1[i]; }
            for (int unit = bid; unit < T / 128; unit += G) {
                if (tid < 32) lcnt[tid] = 0;
                __syncthreads();
#pragma unroll 1
                for (int k = 0; k < 8; ++k) {
                    const int tl0 = wave * 16 + 2 * k, t0 = unit * 128 + tl0;
                    float v[2][16];
#pragma unroll
                    for (int tk = 0; tk < 2; ++tk)
#pragma unroll
                        for (int i = 0; i < 2; ++i) { const u32x4 u4 = *(const u32x4*)(Y1B + (size_t)(t0 + tk) * D + i * 512 + lane * 8);
#pragma unroll
                            for (int j = 0; j < 4; ++j) { v[tk][8 * i + 2 * j] = bf_lo(u4[j]); v[tk][8 * i + 2 * j + 1] = bf_hi(u4[j]); } }
#pragma unroll
                    for (int tk = 0; tk < 2; ++tk) {
                        float s_ = 0.f;
#pragma unroll
                        for (int i = 0; i < 16; ++i) s_ += v[tk][i];
                        const float mean = wsum(s_, lane) * (1.0f / 1024.0f);
                        float qv = 0.f;
#pragma unroll
                        for (int i = 0; i < 16; ++i) { const float d = v[tk][i] - mean; qv += d * d; }
                        const float rstd = rsqrtf(wsum(qv, lane) * (1.0f / 1024.0f) + EPS);
                        if (lane == 0) { st[(tl0 + tk) * 2] = mean; st[(tl0 + tk) * 2 + 1] = rstd;
                            if (YR_FP8 && MOE_FP8) *(f32x2*)((float*)X1B + (size_t)(t0 + tk) * 2) = (f32x2){mean, rstd}; }
                    }
                }
                asm volatile("s_waitcnt lgkmcnt(0)" ::: "memory");
                __builtin_amdgcn_wave_barrier();
                {
                    const int tk = lane & 15, kg = lane >> 4, tl = wave * 16 + tk, t = unit * 128 + tl;
                    const float mean = st[tl * 2], rstd = st[tl * 2 + 1];
                    f32x4 acc0 = {0.f, 0.f, 0.f, 0.f}, acc1 = acc0;
                    const bf16_t* yrow = Y1B + (size_t)t * D + kg * 8;
                    const int e0 = tk, e1 = 16 + tk;
                    const LAS unsigned char* w0p = lds + LDS_STAGE + e0 * 2048; const LAS unsigned char* w1p = lds + LDS_STAGE + e1 * 2048;
                    u32x4 y8n[4];
#pragma unroll
                    for (int u = 0; u < 4; ++u) y8n[u] = __builtin_nontemporal_load((const u32x4*)(yrow + u * 32));
#pragma unroll 1
                    for (int ks0 = 0; ks0 < 32; ks0 += 4) {
                    u32x4 y8v[4];
#pragma unroll
                    for (int u = 0; u < 4; ++u) y8v[u] = y8n[u];
                    { const int kn = (ks0 + 4 < 32) ? ks0 + 4 : ks0;
#pragma unroll
                      for (int u = 0; u < 4; ++u) y8n[u] = __builtin_nontemporal_load((const u32x4*)(yrow + (kn + u) * 32)); }
#pragma unroll
                    for (int u = 0; u < 4; ++u) {
                        const int ks = ks0 + u;
                        const int k0 = ks * 32 + kg * 8;
                        const u32x4 y8 = y8v[u];
                        const f32x4 ga = *(const LAS f32x4*)(g1l + k0), gb = *(const LAS f32x4*)(g1l + k0 + 4), ba = *(const LAS f32x4*)(b1l + k0), bb = *(const LAS f32x4*)(b1l + k0 + 4);
                        float x[8];
                        x[0] = (bf_lo(y8[0]) - mean) * rstd * ga[0] + ba[0]; x[1] = (bf_hi(y8[0]) - mean) * rstd * ga[1] + ba[1];
                        x[2] = (bf_lo(y8[1]) - mean) * rstd * ga[2] + ba[2]; x[3] = (bf_hi(y8[1]) - mean) * rstd * ga[3] + ba[3];
                        x[4] = (bf_lo(y8[2]) - mean) * rstd * gb[0] + bb[0]; x[5] = (bf_hi(y8[2]) - mean) * rstd * gb[1] + bb[1];
                        x[6] = (bf_lo(y8[3]) - mean) * rstd * gb[2] + bb[2]; x[7] = (bf_hi(y8[3]) - mean) * rstd * gb[3] + bb[3];
                        u32x4 hx; hx.x = pk_bf16(x[0], x[1]); hx.y = pk_bf16(x[2], x[3]); hx.z = pk_bf16(x[4], x[5]); hx.w = pk_bf16(x[6], x[7]);
                        if (!(YR_FP8 && MOE_FP8)) *(u32x4*)(X1B + (size_t)t * D + k0) = hx;
#if MOE_FP8
                        *(u32x2*)(ws + WS_X1Q + (size_t)t * D + k0) = (u32x2){pk4_fp8(x[0] * X8_SCALE, x[1] * X8_SCALE, x[2] * X8_SCALE, x[3] * X8_SCALE), pk4_fp8(x[4] * X8_SCALE, x[5] * X8_SCALE, x[6] * X8_SCALE, x[7] * X8_SCALE)};
#endif
                        u32x4 lx; lx.x = pk_bf16(x[0] - bf_lo(hx.x), x[1] - bf_hi(hx.x)); lx.y = pk_bf16(x[2] - bf_lo(hx.y), x[3] - bf_hi(hx.y));
                        lx.z = pk_bf16(x[4] - bf_lo(hx.z), x[5] - bf_hi(hx.z)); lx.w = pk_bf16(x[6] - bf_lo(hx.w), x[7] - bf_hi(hx.w));
                        const bf16x8 xh = __builtin_bit_cast(bf16x8, hx), xl = __builtin_bit_cast(bf16x8, lx);
                        const int c0 = ((ks * 4 + kg) ^ tk) << 4;
                        const bf16x8 wh0 = *(const LAS bf16x8*)(w0p + c0), wl0 = *(const LAS bf16x8*)(w0p + 65536 + c0);
                        const bf16x8 wh1 = *(const LAS bf16x8*)(w1p + c0), wl1 = *(const LAS bf16x8*)(w1p + 65536 + c0);
                        acc0 = __builtin_amdgcn_mfma_f32_16x16x32_f16(wh0, xh, acc0, 0, 0, 0); acc1 = __builtin_amdgcn_mfma_f32_16x16x32_f16(wh1, xh, acc1, 0, 0, 0);
                        acc0 = __builtin_amdgcn_mfma_f32_16x16x32_f16(wl0, xh, acc0, 0, 0, 0); acc1 = __builtin_amdgcn_mfma_f32_16x16x32_f16(wl1, xh, acc1, 0, 0, 0);
                        acc0 = __builtin_amdgcn_mfma_f32_16x16x32_f16(wh0, xl, acc0, 0, 0, 0); acc1 = __builtin_amdgcn_mfma_f32_16x16x32_f16(wh1, xl, acc1, 0, 0, 0);
                    }
                    }
                    float lv[8]; int li[8];
                    { const f32x4 b0 = *(const f32x4*)(br + kg * 4), b1v = *(const f32x4*)(br + 16 + kg * 4);
#pragma unroll
                      for (int j = 0; j < 4; ++j) { lv[j] = acc0[j] + b0[j]; li[j] = kg * 4 + j; lv[4 + j] = acc1[j] + b1v[j]; li[4 + j] = 16 + kg * 4 + j; } }
                    int be[4]; float bv[4];
#pragma unroll
                    for (int kk = 0; kk < 4; ++kk) {
                        float m = lv[0]; int mi = li[0];
#pragma unroll
                        for (int i = 1; i < 8; ++i) if (lv[i] > m) { m = lv[i]; mi = li[i]; }
                        { const float om = shx(m, 16, lane); const int oi = __float_as_int(shx(__int_as_float(mi), 16, lane)); if (om > m || (om == m && oi < mi)) { m = om; mi = oi; } }
                        { const float om = shx(m, 32, lane); const int oi = __float_as_int(shx(__int_as_float(mi), 32, lane)); if (om > m || (om == m && oi < mi)) { m = om; mi = oi; } }
                        be[kk] = mi; bv[kk] = m;
#pragma unroll
                        for (int i = 0; i < 8; ++i) if (li[i] == mi) lv[i] = -3e38f;
                    }
                    float ex[4], es = 0.f;
#pragma unroll
                    for (int kk = 0; kk < 4; ++kk) { ex[kk] = __expf(bv[kk] - bv[0]); es += ex[kk]; }
                    if (kg == 0) {
#pragma unroll
                        for (int kk = 0; kk < 4; ++kk) { const int sl = __hip_atomic_fetch_add(&lcnt[be[kk]], 1, __ATOMIC_RELAXED, __HIP_MEMORY_SCOPE_WORKGROUP); asg_e[tl * 4 + kk] = be[kk]; asg_ls[tl * 4 + kk] = sl; GATE[t * 4 + kk] = ex[kk] / es; }
                    }
                }
                __syncthreads();
                if (tid < 32) lbase[tid] = (int)__hip_atomic_fetch_add(gcnt + tid, (unsigned)lcnt[tid], __ATOMIC_RELAXED, __HIP_MEMORY_SCOPE_AGENT);
                __syncthreads();
                { const int e = asg_e[tid], sl = lbase[e] + asg_ls[tid], t = unit * 128 + (tid >> 2);
                  TOKL[(size_t)e * T + sl] = t; ASGE[t * 4 + (tid & 3)] = e; ASGS[t * 4 + (tid & 3)] = sl; }
                __syncthreads();
            }
        }
        SEAM(pb + 4);
        LAS int* tstart = (LAS int*)(lds + LDS_TSTART); LAS int* lcntE = (LAS int*)(lds + LDS_CNT); LAS unsigned char* tile_e = lds + LDS_TILEE;
        if (IN(pb + 5) || IN(pb + 6) || IN(pb + 7)) {
            OPAQUE_IDS(); WSPTRS();
            if (tid < 32) lcntE[tid] = (int)__hip_atomic_load(ctl + CW_CNT + l * 64 + tid, __ATOMIC_RELAXED, __HIP_MEMORY_SCOPE_AGENT);
            __syncthreads();
            if (tid == 0) { int acc = 0; for (int e = 0; e < NE; ++e) { tstart[e] = acc; acc += (lcntE[e] + 255) >> 8; } tstart[32] = acc; }
            __syncthreads();
            for (int q = tid; q < MAXRT; q += 512) { int e = 0; for (int k = 0; k < NE; ++k) if (q >= tstart[k]) e = k; tile_e[q] = (unsigned char)e; }
            __syncthreads();
        }
        pg8::MoeTables tb{tstart, lcntE, tile_e, tstart[32]};
        if (IN(pb + 5)) PREP(7) {
            WSPTRS();
#if MOE_FP8
            pg8::MoeOrder S{tb, 8, G, bid, (const char*)Wgu + (size_t)l * NE * 2048 * 1024, (size_t)2048 * 1024, TOKL, true, 1024};
            pg8::EpiSwiglu<true> E{(void*)ACT, a.b_gu + (size_t)l * NE * 2048, 1.0f / (W8_SCALE * X8_SCALE)};
            pg8::gemm_phase<pg8::EpiSwiglu<true>, pg8::MoeOrder, true, 1>(lds + LDS_STAGE, (const bf16_t*)(ws + WS_X1Q), 1024, S, E, wave0);
#else
            pg8::MoeOrder S{tb, 8, G, bid, (const char*)(Wgu + (size_t)l * NE * 2048 * 1024), (size_t)2048 * 1024 * 2, TOKL, true, 2048};
            pg8::EpiSwiglu<false> E{(void*)ACT, a.b_gu + (size_t)l * NE * 2048, 1.0f};
            pg8::gemm_phase<pg8::EpiSwiglu<false>, pg8::MoeOrder, true>(lds + LDS_STAGE, X1B, 1024, S, E, wave0);
#endif
        }
        SEAM(pb + 5);
        if (IN(pb + 6)) PREP(8) {
            WSPTRS();
#if MOE_FP8
            pg8::MoeOrder S{tb, 4, G, bid, (const char*)Wdn + (size_t)l * NE * 1024 * 1024, (size_t)1024 * 1024, TOKL, false, 1024};
            pg8::EpiBiasBf16 E{YR, a.b_down + (size_t)l * NE * 1024, 1.0f / (W8_SCALE * A8_SCALE)};
            pg8::gemm_phase<pg8::EpiBiasBf16, pg8::MoeOrder, false, 1>(lds + LDS_STAGE, ACT, 1024, S, E, wave0);
#else
            pg8::MoeOrder S{tb, 4, G, bid, (const char*)(Wdn + (size_t)l * NE * 1024 * 1024), (size_t)1024 * 1024 * 2, TOKL, false, 2048};
            pg8::EpiBiasBf16 E{YR, a.b_down + (size_t)l * NE * 1024, 1.0f};
            pg8::gemm_phase<pg8::EpiBiasBf16, pg8::MoeOrder, false>(lds + LDS_STAGE, ACT, 1024, S, E, wave0);
#endif
        }
        SEAM(pb + 6);
        if (IN(pb + 7)) PREP(9) {
            OPAQUE_IDS(); WSPTRS();
            const float* g2 = a.ln2_g + l * D; const float* b2 = a.ln2_b + l * D;
#if YR_FP8
            const int c0 = lane * 16;
            f32x4 gg4[4], bb4[4];
#pragma unroll
            for (int i = 0; i < 4; ++i) { gg4[i] = *(const f32x4*)(g2 + c0 + 4 * i); bb4[i] = *(const f32x4*)(b2 + c0 + 4 * i); }
            f32x4 ga4[4], ba4[4];
            { const float* g1 = a.ln1_g + l * D; const float* b1 = a.ln1_b + l * D;
#pragma unroll
              for (int i = 0; i < 4; ++i) { ga4[i] = *(const f32x4*)(g1 + c0 + 4 * i) * ALPHA; ba4[i] = *(const f32x4*)(b1 + c0 + 4 * i) * ALPHA; } }
            for (int t0 = gw; t0 < T; t0 += 2 * NGW) {
                int e_[2][4], sl_[2][4]; float gk_[2][4]; f32x2 ms_[2];
#pragma unroll
                for (int u = 0; u < 2; ++u) { const int t = t0 + u * NGW; ms_[u] = *(const f32x2*)((const float*)X1B + (size_t)t * 2);
#pragma unroll
                    for (int k = 0; k < 4; ++k) { e_[u][k] = ASGE[t * 4 + k]; sl_[u][k] = ASGS[t * 4 + k]; gk_[u][k] = GATE[t * 4 + k] * (1.0f / Y8_SCALE); } }
                u32x4 xr[2][2], yr[2][4];
#pragma unroll
                for (int u = 0; u < 2; ++u) { const int t = t0 + u * NGW;
#pragma unroll
                    for (int i = 0; i < 2; ++i) xr[u][i] = __builtin_nontemporal_load((const u32x4*)(Y1B + (size_t)t * D + c0 + 8 * i));
#pragma unroll
                    for (int k = 0; k < 4; ++k) yr[u][k] = __builtin_nontemporal_load((const u32x4*)((const unsigned char*)YR + ((size_t)tstart[e_[u][k]] * 256 + sl_[u][k]) * 1024 + c0)); }
#pragma unroll
                for (int u = 0; u < 2; ++u) { const int t = t0 + u * NGW;
                    float v[16];
#pragma unroll
                    for (int i = 0; i < 2; ++i)
#pragma unroll
                        for (int j = 0; j < 4; ++j) { const int c = 8 * i + 2 * j; const float rs = ms_[u][1], mn = ms_[u][0];
                            v[c] = (bf_lo(xr[u][i][j]) - mn) * rs * ga4[c >> 2][c & 3] + ba4[c >> 2][c & 3]; v[c + 1] = (bf_hi(xr[u][i][j]) - mn) * rs * ga4[(c + 1) >> 2][(c + 1) & 3] + ba4[(c + 1) >> 2][(c + 1) & 3]; }
#pragma unroll
                    for (int k = 0; k < 4; ++k) { const float gk = gk_[u][k];
#pragma unroll
                        for (int j = 0; j < 4; ++j) { const f32x2 lo = __builtin_amdgcn_cvt_pk_f32_fp8((int)yr[u][k][j], false), hi = __builtin_amdgcn_cvt_pk_f32_fp8((int)yr[u][k][j], true);
                            v[4 * j] += gk * lo[0]; v[4 * j + 1] += gk * lo[1]; v[4 * j + 2] += gk * hi[0]; v[4 * j + 3] += gk * hi[1]; } }
                    float s_ = 0.f;
#pragma unroll
                    for (int i = 0; i < 16; ++i) s_ += v[i];
                    const float mean = wsum(s_, lane) * (1.0f / 1024.0f);
                    float qv = 0.f;
#pragma unroll
                    for (int i = 0; i < 16; ++i) { const float d = v[i] - mean; qv += d * d; }
                    const float rstd = rsqrtf(wsum(qv, lane) * (1.0f / 1024.0f) + EPS);
                    float o[16];
#pragma unroll
                    for (int i = 0; i < 4; ++i)
#pragma unroll
                        for (int j = 0; j < 4; ++j) o[4 * i + j] = (v[4 * i + j] - mean) * rstd * gg4[i][j] + bb4[i][j];
                    if (l == DEPTH - 1) {
#pragma unroll
                        for (int i = 0; i < 4; ++i) *(f32x4*)(a.out + (size_t)t * D + c0 + 4 * i) = (f32x4){o[4 * i], o[4 * i + 1], o[4 * i + 2], o[4 * i + 3]};
                    } else {
#pragma unroll
                        for (int i = 0; i < 2; ++i) *(u32x4*)(XB + (size_t)t * D + c0 + 8 * i) = (u32x4){pk_bf16(o[8 * i], o[8 * i + 1]), pk_bf16(o[8 * i + 2], o[8 * i + 3]), pk_bf16(o[8 * i + 4], o[8 * i + 5]), pk_bf16(o[8 * i + 6], o[8 * i + 7])};
                    }
                }
            }
        }
#else
            f32x4 gg4[4], bb4[4];
#pragma unroll
            for (int i = 0; i < 4; ++i) { gg4[i] = *(const f32x4*)(g2 + i * 256 + lane * 4); bb4[i] = *(const f32x4*)(b2 + i * 256 + lane * 4); }
            for (int t0 = gw; t0 < T; t0 += 2 * NGW) {
                int e_[2][4], sl_[2][4]; float gk_[2][4];
#pragma unroll
                for (int u = 0; u < 2; ++u) { const int t = t0 + u * NGW;
#pragma unroll
                    for (int k = 0; k < 4; ++k) { e_[u][k] = ASGE[t * 4 + k]; sl_[u][k] = ASGS[t * 4 + k]; gk_[u][k] = GATE[t * 4 + k]; } }
                u32x2 xr[2][4], yr[2][4][4];
#pragma unroll
                for (int u = 0; u < 2; ++u) { const int t = t0 + u * NGW;
#pragma unroll
                    for (int i = 0; i < 4; ++i) xr[u][i] = __builtin_nontemporal_load((const u32x2*)(X1B + (size_t)t * D + i * 256 + lane * 4));
#pragma unroll
                    for (int k = 0; k < 4; ++k) { const bf16_t* yp = YR + ((size_t)tstart[e_[u][k]] * 256 + sl_[u][k]) * 1024;
#pragma unroll
                        for (int i = 0; i < 4; ++i) yr[u][k][i] = __builtin_nontemporal_load((const u32x2*)(yp + i * 256 + lane * 4)); } }
#pragma unroll
                for (int u = 0; u < 2; ++u) { const int t = t0 + u * NGW;
                    float v[16];
#pragma unroll
                    for (int i = 0; i < 4; ++i) { v[4 * i] = ALPHA * bf_lo(xr[u][i][0]); v[4 * i + 1] = ALPHA * bf_hi(xr[u][i][0]); v[4 * i + 2] = ALPHA * bf_lo(xr[u][i][1]); v[4 * i + 3] = ALPHA * bf_hi(xr[u][i][1]); }
#pragma unroll
                    for (int k = 0; k < 4; ++k) { const float gk = gk_[u][k];
#pragma unroll
                        for (int i = 0; i < 4; ++i) { const u32x2 u2 = yr[u][k][i];
                            v[4 * i] += gk * bf_lo(u2[0]); v[4 * i + 1] += gk * bf_hi(u2[0]); v[4 * i + 2] += gk * bf_lo(u2[1]); v[4 * i + 3] += gk * bf_hi(u2[1]); } }
                    float s_ = 0.f;
#pragma unroll
                    for (int i = 0; i < 16; ++i) s_ += v[i];
                    const float mean = wsum(s_, lane) * (1.0f / 1024.0f);
                    float qv = 0.f;
#pragma unroll
                    for (int i = 0; i < 16; ++i) { const float d = v[i] - mean; qv += d * d; }
                    const float rstd = rsqrtf(wsum(qv, lane) * (1.0f / 1024.0f) + EPS);
#pragma unroll
                    for (int i = 0; i < 4; ++i) {
                        const int c0 = i * 256 + lane * 4;
                        const f32x4 gg = gg4[i], bb = bb4[i];
                        float o[4];
#pragma unroll
                        for (int j = 0; j < 4; ++j) o[j] = (v[4 * i + j] - mean) * rstd * gg[j] + bb[j];
                        if (l == DEPTH - 1) *(f32x4*)(a.out + (size_t)t * D + c0) = (f32x4){o[0], o[1], o[2], o[3]};
                        else *(u32x2*)(XB + (size_t)t * D + c0) = (u32x2){pk_bf16(o[0], o[1]), pk_bf16(o[2], o[3])};
                    }
                }
            }
        }
#endif
        if (l + 1 < DEPTH) SEAM(pb + 7);
    }
#undef IN
#undef SEAM
}

extern "C" void kernel_launch(void* const* d_in, const int* in_sizes, int n_in, void* d_out, int out_size, void* d_ws, size_t ws_size, hipStream_t stream) {
    static int grid = 0;
    if (grid == 0) {
        if (ws_size < WS_END) { fprintf(stderr, "kernel_launch: workspace too small (%zu < %zu)\n", ws_size, (size_t)WS_END); grid = -1; return; }
        int dev = 0, cus = 0, per_cu = 0;
        if (hipGetDevice(&dev) != hipSuccess || hipDeviceGetAttribute(&cus, hipDeviceAttributeMultiprocessorCount, dev) != hipSuccess) { grid = -1; return; }
        if (hipFuncSetAttribute((const void*)mega, hipFuncAttributeMaxDynamicSharedMemorySize, LDS_BYTES) != hipSuccess) { fprintf(stderr, "kernel_launch: hipFuncSetAttribute failed\n"); grid = -1; return; }
        if (hipOccupancyMaxActiveBlocksPerMultiprocessor(&per_cu, (const void*)mega, 512, LDS_BYTES) != hipSuccess || per_cu < 1) { fprintf(stderr, "kernel_launch: occupancy query says %d\n", per_cu); }
        (void)hipGetLastError();
        grid = cus;
        if (grid % 8 != 0) grid -= grid % 8;
    }
    if (grid < 0) return;
    (void)hipMemsetAsync((char*)d_ws + WS_CTL, 0, CTL_BYTES, stream);
    Args a{};
    a.x = (const float*)d_in[0]; a.w_in = (const float*)d_in[1]; a.lam_q1 = (const float*)d_in[2]; a.lam_k1 = (const float*)d_in[3]; a.lam_q2 = (const float*)d_in[4]; a.lam_k2 = (const float*)d_in[5];
    a.subln_g = (const float*)d_in[6]; a.rel_bias = (const float*)d_in[7]; a.w_out = (const float*)d_in[8]; a.ln1_g = (const float*)d_in[9]; a.ln1_b = (const float*)d_in[10];
    a.w_router = (const float*)d_in[11]; a.b_router = (const float*)d_in[12]; a.w_gu = (const float*)d_in[13]; a.b_gu = (const float*)d_in[14]; a.w_down = (const float*)d_in[15];
    a.b_down = (const float*)d_in[16]; a.ln2_g = (const float*)d_in[17]; a.ln2_b = (const float*)d_in[18];
    a.out = (float*)d_out; a.ws = (unsigned char*)d_ws; a.pad = 0;
    a.ph_lo = 0; a.ph_hi = 1 + 8 * DEPTH; a.bar_region = 0;
    hipLaunchKernelGGL(mega, dim3(grid), dim3(512), LDS_BYTES, stream, a);
}
```
